# Optimizing an MI355X kernel written in HIP

```python
import jax, jax.numpy as jnp
from jax import lax
import numpy as np

D_MODEL = 2048
BATCH = 1
SEQ = 16384
DEPTH = 1

EPS = 1e-6
NSA_HEAD_DIM = 128
NSA_HEADS = D_MODEL // 256
NSA_KV_GROUPS = 2
NSA_HPG = NSA_HEADS // NSA_KV_GROUPS
NSA_WIDTH = NSA_HEADS * NSA_HEAD_DIM
NSA_KV_WIDTH = NSA_KV_GROUPS * NSA_HEAD_DIM
CMP_BLOCK = 32
CMP_STRIDE = 16
SLC_BLOCK = 64
SLC_TOPK = 16
WINDOW = 512
Q_BLOCK = 128
SEL_BIG = 1e6
RWKV_HEAD_DIM = 64
RWKV_HEADS = D_MODEL // 128
RWKV_WIDTH = RWKV_HEADS * RWKV_HEAD_DIM
W_RANK = 64
A_RANK = 64
G_RANK = 160
LNX_EPS = 64e-5
NSA_COLS = NSA_WIDTH + 6 * NSA_KV_WIDTH + 3 * NSA_HEADS
RWKV_COLS = 3 * RWKV_WIDTH + W_RANK + A_RANK + G_RANK
IN_COLS = NSA_COLS + RWKV_COLS
MIX_WIDTH = NSA_WIDTH + RWKV_WIDTH
MEM_TOKENS = 256
MEM_HEADS = 4
MEM_HEAD_DIM = D_MODEL // MEM_HEADS
N_GROUPS = 4
EXPERTS_PER_GROUP = 8
N_EXPERTS = N_GROUPS * EXPERTS_PER_GROUP
TOP_K_INNER = 2
EXPERT_FF = 256

kernel_name = "hymba_nsa_rwkv7_hiermoe_layer"


def rmsnorm(x, g):
    xf = x.astype(jnp.float32)
    y = xf * lax.rsqrt(jnp.mean(xf * xf, axis=-1, keepdims=True) + EPS)
    return (y * g.astype(jnp.float32)).astype(x.dtype)


def split_cols(z, sizes):
    offs = np.cumsum([0] + list(sizes))
    return [z[..., int(offs[i]):int(offs[i + 1])] for i in range(len(sizes))]


def token_shift(z):
    return jnp.pad(z, ((0, 0), (1, 0), (0, 0)))[:, :-1]


def masked_softmax(s, mask):
    s = jnp.where(mask, s.astype(jnp.float32), -1e30)
    m = jnp.max(s, axis=-1, keepdims=True)
    e = jnp.where(mask, jnp.exp(s - m), 0.0)
    return e / jnp.maximum(jnp.sum(e, axis=-1, keepdims=True), 1e-30)


def compress_kv(kv, pos, w1, w2):
    B, T, G, Dh = kv.shape
    n_cmp = (T - CMP_BLOCK) // CMP_STRIDE + 1
    idx = jnp.arange(n_cmp)[:, None] * CMP_STRIDE + jnp.arange(CMP_BLOCK)[None, :]
    blocks = kv[:, idx] + pos[None, None, :, None, :]
    blocks = jnp.transpose(blocks, (0, 1, 3, 2, 4)).reshape(B, n_cmp, G, CMP_BLOCK * Dh)
    return jax.nn.gelu(blocks @ w1) @ w2


def nsa_mixer(q, kc, vc, ks, vs, kw, vw, gate_logits,
              cmp_pos_k, cmp_w1_k, cmp_w2_k, cmp_pos_v, cmp_w1_v, cmp_w2_v):
    B, T, _ = q.shape
    G, P, Dh = NSA_KV_GROUPS, NSA_HPG, NSA_HEAD_DIM
    scale = Dh ** -0.5

    def kv4(t):
        return t.reshape(B, T, G, Dh)

    q = q.reshape(B, T, G, P, Dh)
    gates = jax.nn.sigmoid(gate_logits.reshape(B, T, 3, G, P))
    k_cmp = compress_kv(kv4(kc), cmp_pos_k, cmp_w1_k, cmp_w2_k)
    v_cmp = compress_kv(kv4(vc), cmp_pos_v, cmp_w1_v, cmp_w2_v)
    n_cmp = k_cmp.shape[1]
    cmp_start = jnp.arange(n_cmp) * CMP_STRIDE
    cmp_end = cmp_start + CMP_BLOCK - 1
    n_sel = T // SLC_BLOCK
    sel_start = jnp.arange(n_sel) * SLC_BLOCK
    overlap = (jnp.minimum(cmp_start[:, None] + CMP_BLOCK, sel_start[None, :] + SLC_BLOCK)
               - jnp.maximum(cmp_start[:, None], sel_start[None, :]))
    cmp_to_sel = jnp.clip(overlap, 0, None).astype(jnp.float32) / CMP_BLOCK
    top_n = min(SLC_TOPK, n_sel)
    k_blk = jnp.transpose(kv4(ks).reshape(B, n_sel, SLC_BLOCK, G, Dh), (0, 3, 1, 2, 4))
    v_blk = jnp.transpose(kv4(vs).reshape(B, n_sel, SLC_BLOCK, G, Dh), (0, 3, 1, 2, 4))
    pad = ((0, 0), (WINDOW, 0), (0, 0), (0, 0))
    k_win = jnp.pad(kv4(kw), pad)
    v_win = jnp.pad(kv4(vw), pad)
    b_ix = jnp.arange(B)[:, None, None, None]
    g_ix = jnp.arange(G)[None, None, :, None]
    sel_j = jnp.arange(n_sel)
    slc_off = jnp.arange(SLC_BLOCK)
    win_off = jnp.arange(WINDOW + Q_BLOCK) - WINDOW

    def query_block(qi):
        q0 = qi * Q_BLOCK
        qpos = q0 + jnp.arange(Q_BLOCK)
        qb = lax.dynamic_slice_in_dim(q, q0, Q_BLOCK, axis=1)
        gb = lax.dynamic_slice_in_dim(gates, q0, Q_BLOCK, axis=1)
        s_c = jnp.einsum("bqgpd,bcgd->bqgpc", qb, k_cmp) * scale
        p_c = masked_softmax(s_c, (cmp_end[None, :] <= qpos[:, None])[None, :, None, None, :])
        o_c = jnp.einsum("bqgpc,bcgd->bqgpd", p_c.astype(v_cmp.dtype), v_cmp)
        p_sel = jnp.einsum("bqgpc,cs->bqgs", p_c, cmp_to_sel)
        blk = qpos // SLC_BLOCK
        forced = ((sel_j[None, :] == 0) | (sel_j[None, :] == blk[:, None])
                  | (sel_j[None, :] == blk[:, None] - 1))
        future = sel_j[None, :] > blk[:, None]
        score = jnp.where(future[None, :, None, :], -SEL_BIG,
                          p_sel + SEL_BIG * forced[None, :, None, :].astype(jnp.float32))
        _, sel_idx = lax.top_k(score, top_n)
        k_s = k_blk[b_ix, g_ix, sel_idx].reshape(B, Q_BLOCK, G, top_n * SLC_BLOCK, Dh)
        v_s = v_blk[b_ix, g_ix, sel_idx].reshape(B, Q_BLOCK, G, top_n * SLC_BLOCK, Dh)
        kpos_s = (sel_idx[..., None] * SLC_BLOCK + slc_off).reshape(B, Q_BLOCK, G, top_n * SLC_BLOCK)
        s_s = jnp.einsum("bqgpd,bqgnd->bqgpn", qb, k_s) * scale
        p_s = masked_softmax(s_s, (kpos_s <= qpos[None, :, None, None])[:, :, :, None, :])
        o_s = jnp.einsum("bqgpn,bqgnd->bqgpd", p_s.astype(v_s.dtype), v_s)
        k_w = lax.dynamic_slice_in_dim(k_win, q0, WINDOW + Q_BLOCK, axis=1)
        v_w = lax.dynamic_slice_in_dim(v_win, q0, WINDOW + Q_BLOCK, axis=1)
        kpos_w = q0 + win_off
        diff = qpos[:, None] - kpos_w[None, :]
        mask_w = (diff >= 0) & (diff < WINDOW) & (kpos_w[None, :] >= 0)
        s_w = jnp.einsum("bqgpd,bkgd->bqgpk", qb, k_w) * scale
        p_w = masked_softmax(s_w, mask_w[None, :, None, None, :])
        o_w = jnp.einsum("bqgpk,bkgd->bqgpd", p_w.astype(v_w.dtype), v_w)
        o = (gb[:, :, 0, :, :, None] * o_c + gb[:, :, 1, :, :, None] * o_s
             + gb[:, :, 2, :, :, None] * o_w)
        return o.reshape(B, Q_BLOCK, NSA_WIDTH)

    out = lax.map(query_block, jnp.arange(T // Q_BLOCK))
    return jnp.transpose(out, (1, 0, 2, 3)).reshape(B, T, NSA_WIDTH)


def rwkv7_scan(r, w, k, v, kk, a):
    B, T, H, N = r.shape

    def step(S, inp):
        r_t, w_t, k_t, v_t, kk_t, a_t = inp
        sa = jnp.einsum("bhij,bhj->bhi", S, -kk_t)
        S = (S * w_t[:, :, None, :] + sa[..., None] * (kk_t * a_t)[:, :, None, :]
             + v_t[..., None] * k_t[:, :, None, :])
        return S, jnp.einsum("bhij,bhj->bhi", S, r_t)

    xs = tuple(jnp.moveaxis(t.astype(jnp.float32), 1, 0) for t in (r, w, k, v, kk, a))
    _, y = lax.scan(step, jnp.zeros((B, H, N, N), jnp.float32), xs)
    return jnp.moveaxis(y, 0, 1)


def rwkv7_mixer(z, mu, w0, w_up, a0, a_up, g_up, k_k, k_a, r_k, lnx_g, lnx_b):
    B, T, _ = z.shape
    z = z + (token_shift(z) - z) * mu
    r, k, v, wd, ad, gd = split_cols(z, [RWKV_WIDTH] * 3 + [W_RANK, A_RANK, G_RANK])
    w_log = -jax.nn.softplus(-(w0 + jnp.tanh(wd) @ w_up)) - 0.5
    decay = jnp.exp(-jnp.exp(w_log.astype(jnp.float32)))
    a = jax.nn.sigmoid(a0 + ad @ a_up)
    g = jax.nn.sigmoid(gd) @ g_up

    def heads(t):
        return t.reshape(B, T, RWKV_HEADS, RWKV_HEAD_DIM)

    kk = heads(k * k_k).astype(jnp.float32)
    kk = kk * lax.rsqrt(jnp.maximum(jnp.sum(kk * kk, axis=-1, keepdims=True), 1e-24))
    k = k * (1.0 + (a - 1.0) * k_a)
    r_h, k_h, v_h = heads(r), heads(k), heads(v)
    y = rwkv7_scan(r_h, heads(decay), k_h, v_h, kk, heads(a))
    mean = jnp.mean(y, axis=-1, keepdims=True)
    var = jnp.mean(jnp.square(y - mean), axis=-1, keepdims=True)
    y = ((y - mean) * lax.rsqrt(var + LNX_EPS)).reshape(B, T, RWKV_WIDTH) * lnx_g + lnx_b
    bonus = jnp.sum(r_h * k_h * r_k, axis=-1, keepdims=True) * v_h
    y = y + bonus.reshape(B, T, RWKV_WIDTH)
    return (y * g).astype(z.dtype)


def memory_attention(h, m, wq, wk, wv, wo):
    B, T, _ = h.shape
    M = m.shape[1]
    q = (h @ wq).reshape(B, T, MEM_HEADS, MEM_HEAD_DIM)
    k = (m @ wk).reshape(B, M, MEM_HEADS, MEM_HEAD_DIM)
    v = (m @ wv).reshape(B, M, MEM_HEADS, MEM_HEAD_DIM)
    s = jnp.einsum("bthd,bmhd->bhtm", q, k).astype(jnp.float32) * MEM_HEAD_DIM ** -0.5
    p = jax.nn.softmax(s, axis=-1)
    o = jnp.einsum("bhtm,bmhd->bthd", p.astype(v.dtype), v).reshape(B, T, MEM_HEADS * MEM_HEAD_DIM)
    return o @ wo


def hier_moe(h, wg_r, bg_r, we_r, be_r, w_gate, w_up, w_down):
    B, T, D = h.shape
    hf = h.reshape(B * T, D)
    n = hf.shape[0]
    p_group = jax.nn.softmax((hf @ wg_r + bg_r).astype(jnp.float32), axis=-1)
    pg_top, g_idx = lax.top_k(p_group, 1)
    e_logits = (hf @ we_r + be_r).reshape(n, N_GROUPS, EXPERTS_PER_GROUP)
    e_logits = jnp.take_along_axis(e_logits, g_idx[:, :, None], axis=1)[:, 0]
    p_exp = jax.nn.softmax(e_logits.astype(jnp.float32), axis=-1)
    pe_top, e_idx = lax.top_k(p_exp, TOP_K_INNER)
    wts = pg_top * pe_top / jnp.sum(pe_top, axis=-1, keepdims=True)
    flat = g_idx * EXPERTS_PER_GROUP + e_idx
    combine = jnp.sum(jax.nn.one_hot(flat, N_EXPERTS, dtype=jnp.float32) * wts[..., None],
                      axis=1).astype(h.dtype)
    y = jnp.zeros_like(hf)
    for grp in range(N_GROUPS):
        sl = slice(grp * EXPERTS_PER_GROUP, (grp + 1) * EXPERTS_PER_GROUP)
        hid = (jax.nn.silu(jnp.einsum("nd,edf->nef", hf, w_gate[sl]))
               * jnp.einsum("nd,edf->nef", hf, w_up[sl]))
        y = y + jnp.einsum("nef,efd->nd", hid * combine[:, sl, None], w_down[sl])
    return y.reshape(B, T, D)


def setup_inputs(seed: int = 0) -> dict:
    key = jax.random.key(seed)
    keys = iter(jax.random.split(key, 64))
    L = DEPTH

    def nrm(shape, scale):
        return jax.random.normal(next(keys), shape, jnp.float32) * scale

    def unif(shape, lo, hi):
        return jax.random.uniform(next(keys), shape, jnp.float32, lo, hi)

    def gain(n):
        return 1.0 + nrm((L, n), 0.02)

    return {
        "x": nrm((BATCH, SEQ, D_MODEL), 1.0),
        "mem": nrm((BATCH, MEM_TOKENS, D_MODEL), 1.0),
        "ln1_g": gain(D_MODEL),
        "w_in": nrm((L, D_MODEL, IN_COLS), D_MODEL ** -0.5),
        "cmp_pos_k": nrm((L, CMP_BLOCK, NSA_HEAD_DIM), 0.02),
        "cmp_w1_k": nrm((L, CMP_BLOCK * NSA_HEAD_DIM, NSA_HEAD_DIM), (CMP_BLOCK * NSA_HEAD_DIM) ** -0.5),
        "cmp_w2_k": nrm((L, NSA_HEAD_DIM, NSA_HEAD_DIM), NSA_HEAD_DIM ** -0.5),
        "cmp_pos_v": nrm((L, CMP_BLOCK, NSA_HEAD_DIM), 0.02),
        "cmp_w1_v": nrm((L, CMP_BLOCK * NSA_HEAD_DIM, NSA_HEAD_DIM), (CMP_BLOCK * NSA_HEAD_DIM) ** -0.5),
        "cmp_w2_v": nrm((L, NSA_HEAD_DIM, NSA_HEAD_DIM), NSA_HEAD_DIM ** -0.5),
        "nsa_norm_g": gain(NSA_WIDTH),
        "rwkv_mu": unif((L, RWKV_COLS), 0.0, 1.0),
        "rwkv_w0": unif((L, RWKV_WIDTH), -5.0, 1.0),
        "rwkv_w_up": nrm((L, W_RANK, RWKV_WIDTH), 0.5 * W_RANK ** -0.5),
        "rwkv_a0": nrm((L, RWKV_WIDTH), 0.1),
        "rwkv_a_up": nrm((L, A_RANK, RWKV_WIDTH), 0.5 * A_RANK ** -0.5),
        "rwkv_g_up": nrm((L, G_RANK, RWKV_WIDTH), G_RANK ** -0.5),
        "rwkv_k_k": 0.85 + nrm((L, RWKV_WIDTH), 0.02),
        "rwkv_k_a": 1.0 + nrm((L, RWKV_WIDTH), 0.02),
        "rwkv_r_k": nrm((L, RWKV_HEADS, RWKV_HEAD_DIM), 0.1),
        "rwkv_lnx_g": gain(RWKV_WIDTH),
        "rwkv_lnx_b": nrm((L, RWKV_WIDTH), 0.01),
        "w_out": nrm((L, MIX_WIDTH, D_MODEL), MIX_WIDTH ** -0.5),
        "ln_mem_g": gain(D_MODEL),
        "ln2_g": gain(D_MODEL),
        "wq_mem": nrm((L, D_MODEL, MEM_HEADS * MEM_HEAD_DIM), D_MODEL ** -0.5),
        "wk_mem": nrm((L, D_MODEL, MEM_HEADS * MEM_HEAD_DIM), D_MODEL ** -0.5),
        "wv_mem": nrm((L, D_MODEL, MEM_HEADS * MEM_HEAD_DIM), D_MODEL ** -0.5),
        "wo_mem": nrm((L, MEM_HEADS * MEM_HEAD_DIM, D_MODEL), (MEM_HEADS * MEM_HEAD_DIM) ** -0.5),
        "ln3_g": gain(D_MODEL),
        "router_group_w": nrm((L, D_MODEL, N_GROUPS), D_MODEL ** -0.5),
        "router_group_b": nrm((L, N_GROUPS), 0.01),
        "router_expert_w": nrm((L, D_MODEL, N_EXPERTS), D_MODEL ** -0.5),
        "router_expert_b": nrm((L, N_EXPERTS), 0.01),
        "moe_w_gate": nrm((L, N_EXPERTS, D_MODEL, EXPERT_FF), D_MODEL ** -0.5),
        "moe_w_up": nrm((L, N_EXPERTS, D_MODEL, EXPERT_FF), D_MODEL ** -0.5),
        "moe_w_down": nrm((L, N_EXPERTS, EXPERT_FF, D_MODEL), EXPERT_FF ** -0.5),
        "lnf_g": 1.0 + nrm((D_MODEL,), 0.02),
    }


def reference(x, mem, ln1_g, w_in, cmp_pos_k, cmp_w1_k, cmp_w2_k, cmp_pos_v, cmp_w1_v, cmp_w2_v,
              nsa_norm_g, rwkv_mu, rwkv_w0, rwkv_w_up, rwkv_a0, rwkv_a_up, rwkv_g_up, rwkv_k_k,
              rwkv_k_a, rwkv_r_k, rwkv_lnx_g, rwkv_lnx_b, w_out, ln_mem_g, ln2_g, wq_mem, wk_mem,
              wv_mem, wo_mem, ln3_g, router_group_w, router_group_b, router_expert_w,
              router_expert_b, moe_w_gate, moe_w_up, moe_w_down, lnf_g):
    for l in range(DEPTH):
        h = rmsnorm(x, ln1_g[l])
        z = h @ w_in[l]
        z_nsa, z_rwkv = z[..., :NSA_COLS], z[..., NSA_COLS:]
        q, kc, vc, ks, vs, kw, vw, gl = split_cols(
            z_nsa, [NSA_WIDTH] + [NSA_KV_WIDTH] * 6 + [3 * NSA_HEADS])
        y_a = nsa_mixer(q, kc, vc, ks, vs, kw, vw, gl, cmp_pos_k[l], cmp_w1_k[l], cmp_w2_k[l],
                        cmp_pos_v[l], cmp_w1_v[l], cmp_w2_v[l])
        y_a = rmsnorm(y_a, nsa_norm_g[l])
        y_b = rwkv7_mixer(z_rwkv, rwkv_mu[l], rwkv_w0[l], rwkv_w_up[l], rwkv_a0[l], rwkv_a_up[l],
                          rwkv_g_up[l], rwkv_k_k[l], rwkv_k_a[l], rwkv_r_k[l], rwkv_lnx_g[l],
                          rwkv_lnx_b[l])
        x = x + jnp.concatenate([y_a.astype(x.dtype), y_b.astype(x.dtype)], axis=-1) @ w_out[l]
        x = x + memory_attention(rmsnorm(x, ln2_g[l]), rmsnorm(mem, ln_mem_g[l]),
                                 wq_mem[l], wk_mem[l], wv_mem[l], wo_mem[l])
        x = x + hier_moe(rmsnorm(x, ln3_g[l]), router_group_w[l], router_group_b[l],
                         router_expert_w[l], router_expert_b[l], moe_w_gate[l], moe_w_up[l],
                         moe_w_down[l])
    return rmsnorm(x, lnf_g)
```

```cpp
#include <hip/hip_runtime.h>
#include <cstdio>
#include <cstdint>

#ifndef MK_ONE_LAUNCH
#define MK_ONE_LAUNCH 0
#endif

#define LAS __attribute__((address_space(3)))
#define GAS __attribute__((address_space(1)))
typedef _Float16 f16;
typedef _Float16 f16x8 __attribute__((ext_vector_type(8)));
typedef _Float16 f16x4 __attribute__((ext_vector_type(4)));
typedef _Float16 f16x2 __attribute__((ext_vector_type(2)));
typedef float f32x4 __attribute__((ext_vector_type(4)));
typedef float f32x2 __attribute__((ext_vector_type(2)));
typedef unsigned u32x4 __attribute__((ext_vector_type(4)));
typedef unsigned u32x2 __attribute__((ext_vector_type(2)));

constexpr int T = 16384, D = 2048, NZ = 6144;
constexpr int ZQ = 0, ZKC = 1024, ZVC = 1280, ZKS = 1536, ZVS = 1792, ZKW = 2048, ZVW = 2304, ZR = 2560, ZK = 3584, ZV = 4608, ZWD = 5632, ZAD = 5696, ZGD = 5760, ZGL = 5920;
constexpr int NCMP = 1023;
constexpr int NEXP = 32, EFF = 256, MAXSLOT = 40960, MAXTILES = 160;
constexpr float EPS = 1e-6f;

constexpr size_t MiB = 1u << 20;
constexpr size_t WS_CTL = 0, CTL_ZERO_BYTES = 64 * 1024;
constexpr size_t WS_MEMN = 1 * MiB, WS_KM = 2 * MiB, WS_VM = 3 * MiB, WS_KCMP = 4 * MiB, WS_VCMP = 5 * MiB, WS_TOK = 6 * MiB, WS_CMPB = 7 * MiB;
constexpr size_t WS_WQK = 8 * MiB, WS_VOT = 12 * MiB, WS_WIN = 16 * MiB, WS_WOUT = 40 * MiB, WS_WQ16 = 48 * MiB, WS_WKT = 56 * MiB, WS_WVT = 64 * MiB, WS_WOT = 72 * MiB;
constexpr size_t WS_WGU = 80 * MiB, WS_WD = 144 * MiB, WS_H = 176 * MiB, WS_Z = 240 * MiB, WS_ONSA = 432 * MiB, WS_END = 512 * MiB;
constexpr size_t WS_MIX = WS_H, WS_P = WS_H, WS_H2 = WS_Z, WS_X1 = 304 * MiB, WS_S = WS_ONSA, WS_HID = 16 * MiB;
constexpr size_t WS_Y0 = 176 * MiB, WS_Y1 = 432 * MiB;
constexpr size_t TK_E = 0, TK_W = 128 * 1024, TK_SLOT = 256 * 1024, TK_STOK = 384 * 1024, TK_SW = 576 * 1024;
constexpr int CW_BAR = 0;
constexpr int CW_CNT = 4096, CW_CUR = 4160, CW_OFF = 4224, CW_NT = 4288  , CW_NGU = 4289, CW_NDN = 4290;
constexpr int CW_UGU = 6144  , CW_UDN = 8192  ;
static_assert((CW_UDN + MAXTILES * 8 * 2) * 4 <= (int)CTL_ZERO_BYTES, "ctl");

constexpr int RING_BYTES = 131072, MISC_OFF = RING_BYTES + 320, LDS_BYTES = 147456;

__device__ __forceinline__ unsigned pkh(float a, float b) { f16x2 v = {(f16)a, (f16)b}; return __builtin_bit_cast(unsigned, v); }
__device__ __forceinline__ float wave_sum(float v) {
#pragma unroll
    for (int o = 1; o < 64; o <<= 1) v += __shfl_xor(v, o);
    return v;
}
__device__ __forceinline__ float wave_max(float v) {
#pragma unroll
    for (int o = 1; o < 64; o <<= 1) v = fmaxf(v, __shfl_xor(v, o));
    return v;
}
#define LDS_WAIT() asm volatile("s_waitcnt lgkmcnt(0)" ::: "memory")
#define VM_WAIT() asm volatile("s_waitcnt vmcnt(0)" ::: "memory")
__device__ __forceinline__ float sigmoidf_(float x) { return 1.f / (1.f + __expf(-x)); }

namespace pg8 {
constexpr int BM = 256, BK = 64, HALF = 128, HTB = HALF * BK * 2, STAGE_BYTES = 8 * HTB, NXCD = 8, WGM = 8;
__host__ __device__ __forceinline__ int lds_byte(int r, int c) { const int st = (r >> 4) * 2 + (c >> 5), rr = r & 15, cc = c & 31, ob = rr * 64 + cc * 2; return st * 1024 + (ob ^ (((ob >> 9) & 1) << 5)); }
__host__ __device__ __forceinline__ void stage_rc(int b, int& R, int& C) { const int st = b / 1024, sb = b % 1024, swz = sb ^ (((sb >> 9) & 1) << 5); R = (st >> 1) * 16 + swz / 64; C = (st & 1) * 32 + (swz % 64) / 2; }
__host__ __device__ __forceinline__ int perm32(int rho) { const int n = rho >> 4, i = rho & 15; return 8 * (i >> 2) + 4 * n + (i & 3); }

struct Unit { int pm, pn; };
struct Gemm { const f16* A; const f16* Bt; int lda, ldb, K; const int* gather; };

struct StaticOrder {
    int nM, nN, nwg, G, c;
    __host__ __device__ void init(int M, int N, int G_, int c_) { nM = M / BM; nN = N / BM; nwg = nM * nN; G = G_; c = c_; }
    __host__ __device__ bool next(int i, Unit& u) const {
        const long L = (long)i * G + c; if (L >= nwg) return false;
        int wgid = (int)L; { const int q = nwg / NXCD, r = nwg % NXCD, xcd = wgid % NXCD, off = wgid / NXCD; wgid = (xcd < r ? xcd * (q + 1) : r * (q + 1) + (xcd - r) * q) + off; }
        const int nig = WGM * nN, gid = wgid / nig, fm = gid * WGM, gsz = (nM - fm) < WGM ? (nM - fm) : WGM;
        u.pm = fm + ((wgid % nig) % gsz); u.pn = (wgid % nig) / gsz; return true;
    }
};
struct TableOrder {
    const int2* tab; int n, G, c;
    __device__ bool next(int i, Unit& u) const { const int L = i * G + c; if (L >= n) return false; const int2 v = tab[L]; u.pm = v.x; u.pn = v.y; return true; }
};

struct EpiF16 {
    static constexpr bool PERM = true;
    f16* O; int ldc; float scale;
    __device__ __forceinline__ void operator()(const f32x4 (&acc)[2][2][4][2], const Unit& u, int wr, int wc, int fr, int fq) const {
        const int row0 = u.pm * BM + wr * 64 + fr, col0 = u.pn * BM + wc * 32 + 8 * fq;
#pragma unroll
        for (int ai = 0; ai < 2; ++ai)
#pragma unroll
            for (int m = 0; m < 4; ++m) { f16* rowp = O + (size_t)(row0 + ai * HALF + m * 16) * ldc + col0;
#pragma unroll
                for (int bj = 0; bj < 2; ++bj) { const f32x4 v0 = acc[ai][bj][m][0] * scale, v1 = acc[ai][bj][m][1] * scale;
                    u32x4 w; w.x = pkh(v0[0], v0[1]); w.y = pkh(v0[2], v0[3]); w.z = pkh(v1[0], v1[1]); w.w = pkh(v1[2], v1[3]);
                    *(u32x4*)(rowp + bj * HALF) = w; } }
    }
};
struct EpiF32 {
    static constexpr bool PERM = false;
    float* C; const float* R; int ldc;
    __device__ __forceinline__ void operator()(const f32x4 (&acc)[2][2][4][2], const Unit& u, int wr, int wc, int fr, int fq) const {
        const int row0 = u.pm * BM + wr * 64 + fr, col0 = u.pn * BM + wc * 32 + 4 * fq;
#pragma unroll
        for (int ai = 0; ai < 2; ++ai)
#pragma unroll
            for (int m = 0; m < 4; ++m) { const size_t ro = (size_t)(row0 + ai * HALF + m * 16) * ldc + col0;
#pragma unroll
                for (int bj = 0; bj < 2; ++bj)
#pragma unroll
                    for (int n = 0; n < 2; ++n) { f32x4 v = acc[ai][bj][m][n]; if (R) v = v + *(const f32x4*)(R + ro + bj * HALF + n * 16); *(f32x4*)(C + ro + bj * HALF + n * 16) = v; } }
    }
};
struct EpiSilu {
    static constexpr bool PERM = true;
    f16* O;
    __device__ __forceinline__ void operator()(const f32x4 (&acc)[2][2][4][2], const Unit& u, int wr, int wc, int fr, int fq) const {
        const int row0 = u.pm * BM + wr * 64 + fr, col0 = (u.pn & 1) * 128 + wc * 32 + 8 * fq;
#pragma unroll
        for (int ai = 0; ai < 2; ++ai)
#pragma unroll
            for (int m = 0; m < 4; ++m) { f16* rowp = O + (size_t)(row0 + ai * HALF + m * 16) * EFF + col0;
                float h[8];
#pragma unroll
                for (int n = 0; n < 2; ++n)
#pragma unroll
                    for (int e = 0; e < 4; ++e) { const float gt = acc[ai][0][m][n][e], up = acc[ai][1][m][n][e]; h[n * 4 + e] = gt / (1.f + __expf(-gt)) * up; }
                u32x4 w; w.x = pkh(h[0], h[1]); w.y = pkh(h[2], h[3]); w.z = pkh(h[4], h[5]); w.w = pkh(h[6], h[7]);
                *(u32x4*)rowp = w; }
    }
};
struct EpiDown {
    static constexpr bool PERM = true;
    unsigned char* ws;
    __device__ __forceinline__ void operator()(const f32x4 (&acc)[2][2][4][2], const Unit& u, int wr, int wc, int fr, int fq) const {
        f16* tile = (f16*)(ws + (u.pm < 128 ? WS_Y0 + (size_t)u.pm * MiB : WS_Y1 + (size_t)(u.pm - 128) * MiB));
        const int r0 = wr * 64 + fr, col0 = (u.pn & 7) * BM + wc * 32 + 8 * fq;
#pragma unroll
        for (int ai = 0; ai < 2; ++ai)
#pragma unroll
            for (int m = 0; m < 4; ++m) { f16* rowp = tile + (size_t)(r0 + ai * HALF + m * 16) * D + col0;
#pragma unroll
                for (int bj = 0; bj < 2; ++bj) { const f32x4 v0 = acc[ai][bj][m][0], v1 = acc[ai][bj][m][1];
                    u32x4 w; w.x = pkh(v0[0], v0[1]); w.y = pkh(v0[2], v0[3]); w.z = pkh(v1[0], v1[1]); w.w = pkh(v1[2], v1[3]);
                    *(u32x4*)(rowp + bj * HALF) = w; } }
    }
};

template <class Epi, class Sched, bool ALIGN_EPI>
__device__ __forceinline__ void gemm_phase(LAS unsigned char* lds, const Gemm g, const Sched& S, const Epi& E) {
    const int tid = threadIdx.x, wid = __builtin_amdgcn_readfirstlane(tid >> 6), lane = tid & 63, wr = wid >> 2, wc = wid & 3, fr = lane & 15, fq = lane >> 4;
    const int K = g.K, nt = K / BK;
    int RA[2], CA[2]; unsigned voffB[2];
#pragma unroll
    for (int i = 0; i < 2; ++i) { int R, C; stage_rc(tid * 16 + i * 8192, R, C); const int Rb = Epi::PERM ? ((R & ~31) + perm32(R & 31)) : R;
        RA[i] = R; CA[i] = C; voffB[i] = (unsigned)(Rb * g.ldb + C) * 2u; }
    const size_t kstep = (size_t)(BK * 2);
    const size_t hstepB = (size_t)HALF * g.ldb * 2, tstepB = 2 * hstepB;
    const unsigned ldsw = (unsigned)wid * 1024u;
    const int aoff = lds_byte(wr * 64 + fr, fq * 8), boff = lds_byte(wc * 32 + fr, fq * 8);
    const char* Ab = (const char*)g.A;
#define PG8_SA(b, h) (((b) * 2 + (h)) * HTB)
#define PG8_SB(b, h) ((4 + (b) * 2 + (h)) * HTB)
#define PG8_STAGE(bufoff, gbase, voff) do { _Pragma("unroll") for (int _i = 0; _i < 2; ++_i) \
        __builtin_amdgcn_global_load_lds((const unsigned*)((const char*)(gbase) + (voff)[_i]), (LAS unsigned*)(lds + (bufoff) + ldsw + _i * 8192), 16, 0, 0); } while (0)
#define PG8_STAGE_A(bufoff, OFFS, h, kb) do { _Pragma("unroll") for (int _i = 0; _i < 2; ++_i) \
        __builtin_amdgcn_global_load_lds((const unsigned*)(Ab + (size_t)(kb) + (OFFS)[h][_i]), (LAS unsigned*)(lds + (bufoff) + ldsw + _i * 8192), 16, 0, 0); } while (0)
#define PG8_LDA(dst, b, h) do { _Pragma("unroll") for (int m = 0; m < 4; ++m) _Pragma("unroll") for (int k = 0; k < 2; ++k) dst[m][k] = *(const LAS f16x8*)(lds + PG8_SA(b, h) + aoff + m * 2048 + k * 1024); } while (0)
#define PG8_LDB(dst, b, h) do { _Pragma("unroll") for (int n = 0; n < 2; ++n) _Pragma("unroll") for (int k = 0; k < 2; ++k) dst[n][k] = *(const LAS f16x8*)(lds + PG8_SB(b, h) + boff + n * 2048 + k * 1024); } while (0)
#define PG8_MMA(ai, bj, At, Bt) do { __builtin_amdgcn_s_setprio(1); _Pragma("unroll") for (int m = 0; m < 4; ++m) _Pragma("unroll") for (int n = 0; n < 2; ++n) _Pragma("unroll") for (int k = 0; k < 2; ++k) \
        acc[ai][bj][m][n] = __builtin_amdgcn_mfma_f32_16x16x32_f16(Bt[n][k], At[m][k], acc[ai][bj][m][n], 0, 0, 0); __builtin_amdgcn_s_setprio(0); } while (0)
#define PG8_WAIT_V(n) asm volatile("s_waitcnt vmcnt(" #n ")" ::: "memory")
#define PG8_WAIT_L(n) asm volatile("s_waitcnt lgkmcnt(" #n ")" ::: "memory")
#define PG8_BAR __builtin_amdgcn_s_barrier()
#define PG8_SCHED __builtin_amdgcn_sched_barrier(0)
#define PG8_OFFS(dst, U) do { _Pragma("unroll") for (int _h = 0; _h < 2; ++_h) _Pragma("unroll") for (int _i = 0; _i < 2; ++_i) { \
        const int _r = (U).pm * BM + _h * HALF + RA[_i]; const int _row = g.gather ? g.gather[_r] : _r; dst[_h][_i] = ((unsigned)_row * (unsigned)g.lda + (unsigned)CA[_i]) * 2u; } } while (0)
    Unit cur, nxt; int ui = 0;
    if (!S.next(0, cur)) return;
    f32x4 acc[2][2][4][2];
#pragma unroll
    for (int a = 0; a < 2; ++a)
#pragma unroll
        for (int b = 0; b < 2; ++b)
#pragma unroll
            for (int m = 0; m < 4; ++m)
#pragma unroll
                for (int n = 0; n < 2; ++n) acc[a][b][m][n] = (f32x4){0.f, 0.f, 0.f, 0.f};
    f16x8 At[4][2], B0[2][2], B1[2][2];
    unsigned offC[2][2], offN[2][2];
    PG8_OFFS(offC, cur);
    const char* cB = (const char*)g.Bt + (size_t)cur.pn * tstepB;
    PG8_STAGE(PG8_SB(0, 0), cB, voffB); PG8_STAGE(PG8_SB(0, 1), cB + hstepB, voffB); PG8_STAGE_A(PG8_SA(0, 0), offC, 0, 0); PG8_STAGE_A(PG8_SA(0, 1), offC, 1, 0);
    if (wr == 1) PG8_BAR;
    PG8_WAIT_V(2); PG8_BAR;
    PG8_STAGE(PG8_SB(1, 0), cB + kstep, voffB); PG8_STAGE_A(PG8_SA(1, 0), offC, 0, kstep); PG8_STAGE(PG8_SB(1, 1), cB + hstepB + kstep, voffB);
    PG8_WAIT_V(6); PG8_BAR;
    for (;;) {
        const bool has_next = S.next(ui + 1, nxt);
        if (has_next) { PG8_OFFS(offN, nxt); } else {
#pragma unroll
            for (int _h = 0; _h < 2; ++_h)
#pragma unroll
                for (int _i = 0; _i < 2; ++_i) offN[_h][_i] = offC[_h][_i]; }
        const char* nB = has_next ? (const char*)g.Bt + (size_t)nxt.pn * tstepB : cB;
#pragma nounroll
        for (int t = 0; t < nt; t += 2) {
            const bool last = (t == nt - 2);
            const size_t kb1 = (size_t)(t + 1) * kstep;
            const size_t kb2 = last ? 0 : (size_t)(t + 2) * kstep, kb3 = kb2 + kstep;
            unsigned o2[2][2];
#pragma unroll
            for (int _h = 0; _h < 2; ++_h)
#pragma unroll
                for (int _i = 0; _i < 2; ++_i) o2[_h][_i] = last ? offN[_h][_i] : offC[_h][_i];
            const char* b2 = last ? nB : cB + (size_t)(t + 2) * kstep; const char* b3 = b2 + kstep;
            PG8_LDB(B0, 0, 0); PG8_LDB(B1, 0, 1); PG8_SCHED; PG8_LDA(At, 0, 0); PG8_STAGE_A(PG8_SA(1, 1), offC, 1, kb1);
            PG8_WAIT_V(8); PG8_WAIT_L(0); PG8_BAR; PG8_MMA(0, 0, At, B0); PG8_MMA(0, 1, At, B1); PG8_BAR; PG8_SCHED;
            PG8_LDA(At, 0, 1); PG8_STAGE(PG8_SB(0, 0), b2, voffB); PG8_STAGE(PG8_SB(0, 1), b2 + hstepB, voffB); PG8_STAGE_A(PG8_SA(0, 0), o2, 0, kb2);
            PG8_WAIT_V(8); PG8_WAIT_L(0); PG8_BAR; PG8_MMA(1, 0, At, B0); PG8_MMA(1, 1, At, B1); PG8_BAR; PG8_SCHED;
            PG8_LDB(B0, 1, 0); PG8_LDB(B1, 1, 1); PG8_SCHED; PG8_LDA(At, 1, 0); PG8_STAGE_A(PG8_SA(0, 1), o2, 1, kb2);
            PG8_WAIT_V(8); PG8_WAIT_L(0); PG8_BAR; PG8_MMA(0, 0, At, B0); PG8_MMA(0, 1, At, B1); PG8_BAR; PG8_SCHED;
            PG8_LDA(At, 1, 1); PG8_STAGE(PG8_SB(1, 0), b3, voffB); PG8_STAGE(PG8_SB(1, 1), b3 + hstepB, voffB); PG8_STAGE_A(PG8_SA(1, 0), o2, 0, kb3);
            PG8_WAIT_V(8); PG8_WAIT_L(0); PG8_BAR; PG8_MMA(1, 0, At, B0); PG8_MMA(1, 1, At, B1); PG8_BAR; PG8_SCHED;
        }
        if constexpr (ALIGN_EPI) { if (wr == 0) PG8_BAR; }
        E(acc, cur, wr, wc, fr, fq);
        if (!has_next) break;
#pragma unroll
        for (int a = 0; a < 2; ++a)
#pragma unroll
            for (int b = 0; b < 2; ++b)
#pragma unroll
                for (int m = 0; m < 4; ++m)
#pragma unroll
                    for (int n = 0; n < 2; ++n) acc[a][b][m][n] = (f32x4){0.f, 0.f, 0.f, 0.f};
        cur = nxt; cB = nB; ++ui;
#pragma unroll
        for (int _h = 0; _h < 2; ++_h)
#pragma unroll
            for (int _i = 0; _i < 2; ++_i) offC[_h][_i] = offN[_h][_i];
        if constexpr (ALIGN_EPI) { if (wr == 1) PG8_BAR; }
    }
    PG8_WAIT_V(0);
    if constexpr (!ALIGN_EPI) { if (wr == 0) PG8_BAR; }
    PG8_BAR;
#undef PG8_SA
#undef PG8_SB
#undef PG8_STAGE
#undef PG8_STAGE_A
#undef PG8_LDA
#undef PG8_LDB
#undef PG8_MMA
#undef PG8_WAIT_V
#undef PG8_WAIT_L
#undef PG8_BAR
#undef PG8_SCHED
#undef PG8_OFFS
}
}

#define XB_TMO      128
#define XB_XCNT(j)  (256  + 64 * (j))
#define XB_XSUB(j)  (1280 + 64 * (j))
#define XB_XGEN(j)  (2304 + 64 * (j))
#define XB_TOP      3328
#define XB_TOPGEN   3392
#define XCD_BAR_WORDS 3456
#define XB_SPIN_CAP (1u << 22)
__device__ __forceinline__ unsigned xb_ld(unsigned* p)              { return __hip_atomic_load(p, __ATOMIC_RELAXED, __HIP_MEMORY_SCOPE_AGENT); }
__device__ __forceinline__ unsigned xb_add(unsigned* p, unsigned v) { return __hip_atomic_fetch_add(p, v, __ATOMIC_RELAXED, __HIP_MEMORY_SCOPE_AGENT); }
__device__ __forceinline__ unsigned xb_xcc_id() { return (unsigned)__builtin_amdgcn_s_getreg((3 << 11) | 20) & 0xFu; }
#define XB_SPIN(cond, bar) do { unsigned _sp = 0; while (cond) { __builtin_amdgcn_s_sleep(1); \
    if ((++_sp & 255u) == 0u) { if (xb_ld(&(bar)[XB_TMO])) break; if (_sp > XB_SPIN_CAP) { atomicAdd(&(bar)[XB_TMO], 1u); break; } } } } while (0)
struct XcdBarrier { unsigned* bar; unsigned x; volatile LAS unsigned* st; };
__device__ __forceinline__ XcdBarrier xcd_barrier_post(unsigned* bar, volatile LAS unsigned* st) {
    XcdBarrier b; b.bar = bar; b.x = xb_xcc_id(); b.st = st;
    if (threadIdx.x == 0) (void)xb_add(&bar[XB_XCNT(b.x)], 1u);
    return b;
}
__device__ __forceinline__ void xcd_barrier_complete(unsigned* bar, unsigned x, unsigned& nloc, unsigned& nx) {
    const unsigned G = gridDim.x * gridDim.y * gridDim.z;
    unsigned sum, cnt, mine, sp = 0u;
    for (;;) {
        sum = 0u; cnt = 0u; mine = 0u;
#pragma unroll
        for (unsigned j = 0; j < 16; ++j) { const unsigned c = xb_ld(&bar[XB_XCNT(j)]); sum += c; cnt += (c > 0u) ? 1u : 0u; mine = (j == x) ? c : mine; }
        if (sum == G) break;
        __builtin_amdgcn_s_sleep(1);
        if ((++sp & 255u) == 0u) { if (xb_ld(&bar[XB_TMO])) break; if (sp > XB_SPIN_CAP) { atomicAdd(&bar[XB_TMO], 1u); break; } }
    }
    nloc = mine > 0u ? mine : 1u; nx = cnt > 0u ? cnt : 1u;
}
__device__ __forceinline__ void xcd_barrier(const XcdBarrier& b) {
    asm volatile("s_waitcnt vmcnt(0)" ::: "memory");
    __syncthreads();
    if (threadIdx.x == 0) {
        unsigned* bar = b.bar;
        __builtin_amdgcn_s_waitcnt(0);
        unsigned nloc = b.st[0], nx = b.st[1];
        if (nloc == 0u) { xcd_barrier_complete(bar, b.x, nloc, nx); b.st[0] = nloc; b.st[1] = nx; }
        const unsigned old = xb_add(&bar[XB_XSUB(b.x)], 1u);
        const unsigned gen = old / nloc;
        if (old + 1u == (gen + 1u) * nloc) {
            __builtin_amdgcn_fence(__ATOMIC_RELEASE, "agent");
            asm volatile("s_waitcnt vmcnt(0)" ::: "memory");
            const unsigned og = xb_add(&bar[XB_TOP], 1u);
            const unsigned tg = og / nx;
            if (og + 1u == (tg + 1u) * nx) xb_add(&bar[XB_TOPGEN], 1u);
            else XB_SPIN(xb_ld(&bar[XB_TOPGEN]) == tg, bar);
            __builtin_amdgcn_fence(__ATOMIC_ACQUIRE, "agent");
            xb_add(&bar[XB_XGEN(b.x)], 1u);
            asm volatile("s_waitcnt vmcnt(0)" ::: "memory");
        } else {
            XB_SPIN(xb_ld(&bar[XB_XGEN(b.x)]) == gen, bar);
            __builtin_amdgcn_fence(__ATOMIC_ACQUIRE, "agent");
            asm volatile("s_waitcnt vmcnt(0)" ::: "memory");
        }
    }
    __syncthreads();
}

struct Args { const float* in[38]; float* out; unsigned char* ws; int ph_lo, ph_hi; };
enum { I_X = 0, I_MEM, I_LN1, I_WIN, I_PK, I_W1K, I_W2K, I_PV, I_W1V, I_W2V, I_NSAG, I_MU, I_W0, I_WUP, I_A0, I_AUP, I_GUP, I_KK, I_KA, I_RK, I_LNXG, I_LNXB,
       I_WOUT, I_LNMEM, I_LN2, I_WQ, I_WK, I_WV, I_WO, I_LN3, I_RGW, I_RGB, I_REW, I_REB, I_MG, I_MU2, I_MD, I_LNF };

__device__ __forceinline__ void tr_item(const float* src, int sld, int k0, int scol0, int nvalid, f16* dst, size_t drow0, int dld, LAS float* scr, int lane) {
    const int nl = lane & 31;
#pragma unroll 8
    for (int i = 0; i < 32; ++i) { const int kk = 2 * i + (lane >> 5); scr[kk * 33 + nl] = (nl < nvalid) ? src[(size_t)(k0 + kk) * sld + scol0 + nl] : 0.f; }
    LDS_WAIT(); asm volatile("" ::: "memory");
    const int c = lane & 7;
#pragma unroll
    for (int j = 0; j < 4; ++j) { const int n = (lane >> 3) + 8 * j; const LAS float* s = scr + (8 * c) * 33 + n;
        u32x4 o; o.x = pkh(s[0 * 33], s[1 * 33]); o.y = pkh(s[2 * 33], s[3 * 33]); o.z = pkh(s[4 * 33], s[5 * 33]); o.w = pkh(s[6 * 33], s[7 * 33]);
        *(u32x4*)(dst + (drow0 + n) * (size_t)dld + k0 + 8 * c) = o; }
    LDS_WAIT(); asm volatile("" ::: "memory");
}
__device__ __forceinline__ void tr_matrix(const float* src, int K, int N, f16* dst, LAS float* scr, int gw, int NGW, int lane) {
    const int nblk = N / 32, items = (K / 64) * nblk;
    for (int it = gw; it < items; it += NGW) { const int kb = it / nblk, nb = it % nblk; tr_item(src, N, kb * 64, nb * 32, 32, dst, (size_t)nb * 32, K, scr, lane); }
}
__device__ __forceinline__ void rms_row(const float* xrow, const float* gain, f16* o16, int lane) {
    const f32x4* xr = (const f32x4*)xrow + lane; f32x4 v[8]; float s = 0.f;
#pragma unroll
    for (int j = 0; j < 8; ++j) { v[j] = xr[64 * j]; s += v[j].x * v[j].x + v[j].y * v[j].y + v[j].z * v[j].z + v[j].w * v[j].w; }
    const float rstd = rsqrtf(wave_sum(s) * (1.f / D) + EPS);
    const f32x4* gr = (const f32x4*)gain + lane;
    u32x2* o8 = (u32x2*)o16 + lane;
#pragma unroll
    for (int j = 0; j < 8; ++j) { const f32x4 gg = gr[64 * j]; u32x2 w; w.x = pkh(v[j].x * rstd * gg.x, v[j].y * rstd * gg.y); w.y = pkh(v[j].z * rstd * gg.z, v[j].w * rstd * gg.w); o8[64 * j] = w; }
}

__device__ __forceinline__ void p0_prologue(const Args& a, LAS unsigned char* lds) {
    const int tid = threadIdx.x, lane = tid & 63, wave = tid >> 6;
    const int gw = blockIdx.x * 8 + wave, NGW = gridDim.x * 8;
    LAS float* scr = (LAS float*)(lds + wave * 16384);
    unsigned char* ws = a.ws;
    { f16* dst = (f16*)(ws + WS_WIN); const float* src = a.in[I_WIN];
      const int nblk = NZ / 32, items = (D / 64) * nblk;
      for (int it = gw; it < items; it += NGW) { const int kb = it / nblk, nb = it % nblk, n0 = nb * 32;
          int sc = 0, nv = 32; if (n0 < 2560) sc = n0; else if (n0 < 5920) sc = n0 + 24; else if (n0 == 5920) { sc = 2560; nv = 24; } else { sc = 0; nv = 0; }
          tr_item(src, 5944, kb * 64, sc, nv, dst, (size_t)n0, D, scr, lane); } }
    tr_matrix(a.in[I_WOUT], D, D, (f16*)(ws + WS_WOUT), scr, gw, NGW, lane);
    tr_matrix(a.in[I_WK], D, D, (f16*)(ws + WS_WKT), scr, gw, NGW, lane);
    tr_matrix(a.in[I_WV], D, D, (f16*)(ws + WS_WVT), scr, gw, NGW, lane);
    tr_matrix(a.in[I_WO], D, D, (f16*)(ws + WS_WOT), scr, gw, NGW, lane);
    { const f32x4* s = (const f32x4*)a.in[I_WQ]; u32x2* d = (u32x2*)(ws + WS_WQ16);
      for (size_t i = (size_t)blockIdx.x * 512 + tid; i < (size_t)D * D / 4; i += (size_t)gridDim.x * 512) { const f32x4 v = s[i]; u32x2 w; w.x = pkh(v.x, v.y); w.y = pkh(v.z, v.w); d[i] = w; } }
    { f16* dst = (f16*)(ws + WS_WGU); const int items = NEXP * (D / 64) * 16;
      for (int it = gw; it < items; it += NGW) { const int e = it / ((D / 64) * 16), r = it % ((D / 64) * 16), kb = r / 16, nb = r % 16, j0 = nb * 32, jt = j0 / 256, jj = j0 % 256;
          const float* src = (jj < 128 ? a.in[I_MG] : a.in[I_MU2]) + (size_t)e * D * EFF; const int sc = jt * 128 + (jj & 127);
          tr_item(src, EFF, kb * 64, sc, 32, dst, (size_t)e * 512 + j0, D, scr, lane); } }
    { f16* dst = (f16*)(ws + WS_WD); const int items = NEXP * (EFF / 64) * (D / 32);
      for (int it = gw; it < items; it += NGW) { const int e = it / ((EFF / 64) * (D / 32)), r = it % ((EFF / 64) * (D / 32)), kb = r / (D / 32), nb = r % (D / 32);
          tr_item(a.in[I_MD] + (size_t)e * EFF * D, D, kb * 64, nb * 32, 32, dst, (size_t)e * D + nb * 32, EFF, scr, lane); } }
    for (int m = gw; m < T; m += NGW) rms_row(a.in[I_X] + (size_t)m * D, a.in[I_LN1], (f16*)(ws + WS_H) + (size_t)m * D, lane);
    for (int m = gw; m < 256; m += NGW) rms_row(a.in[I_MEM] + (size_t)m * D, a.in[I_LNMEM], (f16*)(ws + WS_MEMN) + (size_t)m * D, lane);
}

__device__ __forceinline__ float gelu_tanh(float x) { const float u = 0.7978845608028654f * (x + 0.044715f * x * x * x); return 0.5f * x * (1.f + tanhf(u)); }
__device__ __forceinline__ void p_compress(const Args& a, LAS unsigned char* lds) {
    const int tid = threadIdx.x, grp = tid >> 7, j = tid & 127;
    LAS float* in = (LAS float*)(lds + grp * 20480); LAS float* hid = in + 4096;
    const f16* z = (const f16*)(a.ws + WS_Z);
    const int NIT = 2 * NCMP * 2;
    for (int base = blockIdx.x * 4; base < NIT; base += gridDim.x * 4) {
        const int item = base + grp; const bool valid = item < NIT;
        const int kv = valid ? item / (NCMP * 2) : 0, r = valid ? item % (NCMP * 2) : 0, c = r >> 1, g = r & 1;
        const float* pos = a.in[kv ? I_PV : I_PK]; const float* w1 = a.in[kv ? I_W1V : I_W1K]; const float* w2 = a.in[kv ? I_W2V : I_W2K];
        __syncthreads();
        for (int i = j; i < 4096; i += 128) { const int l = i >> 7, d = i & 127; in[i] = (float)z[(size_t)(16 * c + l) * NZ + (kv ? ZVC : ZKC) + g * 128 + d] + pos[i]; }
        __syncthreads();
        float acc = 0.f;
        for (int i = 0; i < 4096; i += 4) { const f32x4 x4 = *(const LAS f32x4*)(in + i);
            acc += x4.x * w1[(size_t)i * 128 + j] + x4.y * w1[(size_t)(i + 1) * 128 + j] + x4.z * w1[(size_t)(i + 2) * 128 + j] + x4.w * w1[(size_t)(i + 3) * 128 + j]; }
        hid[j] = gelu_tanh(acc);
        __syncthreads();
        float o = 0.f;
        for (int i = 0; i < 128; ++i) o += hid[i] * w2[i * 128 + j];
        if (valid) ((float*)(a.ws + (kv ? WS_VCMP : WS_KCMP)))[((size_t)c * 2 + g) * 128 + j] = o;
    }
}

__device__ __forceinline__ void p_nsa_naive(const Args& a, LAS unsigned char* lds, int bid, int nb) {
    const int tid = threadIdx.x, half = tid >> 8, t256 = tid & 255, p = t256 >> 6, lane = tid & 63;
    LAS float* qs = (LAS float*)(lds + half * 24576); LAS float* pc = qs + 512; LAS float* psel = pc + 4096; LAS int* sl = (LAS int*)(psel + 256);
    const f16* z = (const f16*)(a.ws + WS_Z); const float* kcmp = (const float*)(a.ws + WS_KCMP); const float* vcmp = (const float*)(a.ws + WS_VCMP);
    float* onsa = (float*)(a.ws + WS_ONSA);
    const float scale = 0.08838834764831845f;
    for (int base = bid * 2; base < T * 2; base += nb * 2) {
        const int item = base + half; const int t = item >> 1, g = item & 1;
        const f16* zrow = z + (size_t)t * NZ; const int hq = g * 4 + p;
        __syncthreads();
        for (int d = lane; d < 128; d += 64) qs[p * 128 + d] = (float)zrow[ZQ + hq * 128 + d];
        LDS_WAIT();
        const int nvalid = t >= 31 ? ((t - 31) >> 4) + 1 : 0;
        float mx = -INFINITY;
        for (int c = lane; c < nvalid; c += 64) { const f32x4* kr = (const f32x4*)(kcmp + ((size_t)c * 2 + g) * 128); float s = 0.f;
#pragma unroll 8
            for (int d4 = 0; d4 < 32; ++d4) { const f32x4 k4 = kr[d4]; const f32x4 q4 = *(const LAS f32x4*)(qs + p * 128 + d4 * 4); s += q4.x * k4.x + q4.y * k4.y + q4.z * k4.z + q4.w * k4.w; }
            s *= scale; pc[p * 1024 + c] = s; mx = fmaxf(mx, s); }
        mx = wave_max(mx);
        float sum = 0.f;
        for (int c = lane; c < nvalid; c += 64) { const float e = __expf(pc[p * 1024 + c] - mx); pc[p * 1024 + c] = e; sum += e; }
        sum = wave_sum(sum); const float inv = 1.f / fmaxf(sum, 1e-30f);
        for (int c = lane; c < 1024; c += 64) pc[p * 1024 + c] = c < nvalid ? pc[p * 1024 + c] * inv : 0.f;
        LDS_WAIT();
        float oc0 = 0.f, oc1 = 0.f;
#pragma unroll 8
        for (int c = 0; c < nvalid; ++c) { const float pv = pc[p * 1024 + c]; const float* vr = vcmp + ((size_t)c * 2 + g) * 128; oc0 += pv * vr[lane]; oc1 += pv * vr[lane + 64]; }
        __syncthreads();
        { const int s = t256; float acc = 0.f;
#pragma unroll
          for (int pp = 0; pp < 4; ++pp) { const LAS float* P = pc + pp * 1024 + 4 * s; acc += P[0] + P[1] + P[2] + 0.5f * P[3] + (s > 0 ? 0.5f * P[-1] : 0.f); }
          psel[s] = acc; }
        __syncthreads();
        const int blk = t >> 6;
        if (p == 0) {
            int n = 0;
            if (lane == 0) { sl[1 + n] = 0; } n++;
            if (blk >= 1) { if (lane == 0) sl[1 + n] = blk; n++; }
            if (blk >= 2) { if (lane == 0) sl[1 + n] = blk - 1; n++; }
            const int ncand = blk >= 3 ? blk - 2 : 0;
            if (ncand <= 13) { for (int s = 1 + lane; s <= blk - 2; s += 64) sl[1 + n + (s - 1)] = s; n += ncand; }
            else {
                float v[4];
#pragma unroll
                for (int jj = 0; jj < 4; ++jj) { const int s = 1 + lane + 64 * jj; v[jj] = (s <= blk - 2) ? psel[s] : -1.f; }
                for (int it = 0; it < 13; ++it) {
                    float bv = v[0]; int bi = 1 + lane;
#pragma unroll
                    for (int jj = 1; jj < 4; ++jj) { if (v[jj] > bv) { bv = v[jj]; bi = 1 + lane + 64 * jj; } }
#pragma unroll
                    for (int o = 1; o < 64; o <<= 1) { const float ov = __shfl_xor(bv, o); const int oi = __shfl_xor(bi, o); if (ov > bv || (ov == bv && oi < bi)) { bv = ov; bi = oi; } }
                    if (lane == 0) sl[1 + n] = bi; n++;
#pragma unroll
                    for (int jj = 0; jj < 4; ++jj) if (bi == 1 + lane + 64 * jj) v[jj] = -1.f;
                }
            }
            if (lane == 0) sl[0] = n;
            LDS_WAIT();
        }
        __syncthreads();
        const int nsel = sl[0];
        mx = -INFINITY;
        for (int n = 0; n < nsel; ++n) { const int kpos = sl[1 + n] * 64 + lane; float s = -INFINITY;
            if (kpos <= t) { const f16x8* kr = (const f16x8*)(z + (size_t)kpos * NZ + ZKS + g * 128); s = 0.f;
#pragma unroll 4
                for (int d8 = 0; d8 < 16; ++d8) { const f16x8 k8 = kr[d8]; const LAS float* q = qs + p * 128 + d8 * 8;
#pragma unroll
                    for (int e = 0; e < 8; ++e) s += q[e] * (float)k8[e]; }
                s *= scale; }
            pc[p * 1024 + n * 64 + lane] = s; mx = fmaxf(mx, s); }
        mx = wave_max(mx);
        sum = 0.f;
        for (int n = 0; n < nsel; ++n) { const float s = pc[p * 1024 + n * 64 + lane]; const float e = (s == -INFINITY) ? 0.f : __expf(s - mx); pc[p * 1024 + n * 64 + lane] = e; sum += e; }
        sum = wave_sum(sum); const float invs = 1.f / fmaxf(sum, 1e-30f);
        LDS_WAIT();
        float os0 = 0.f, os1 = 0.f;
        for (int n = 0; n < nsel; ++n) { const int k0 = sl[1 + n] * 64;
            for (int jj = 0; jj < 64; ++jj) { const int kpos = k0 + jj; if (kpos > t) break; const float pv = pc[p * 1024 + n * 64 + jj]; const f16* vr = z + (size_t)kpos * NZ + ZVS + g * 128;
                os0 += pv * (float)vr[lane]; os1 += pv * (float)vr[lane + 64]; } }
        const int lo = t >= 511 ? t - 511 : 0, nw = t - lo + 1;
        mx = -INFINITY;
        for (int i = lane; i < nw; i += 64) { const f16x8* kr = (const f16x8*)(z + (size_t)(lo + i) * NZ + ZKW + g * 128); float s = 0.f;
#pragma unroll 4
            for (int d8 = 0; d8 < 16; ++d8) { const f16x8 k8 = kr[d8]; const LAS float* q = qs + p * 128 + d8 * 8;
#pragma unroll
                for (int e = 0; e < 8; ++e) s += q[e] * (float)k8[e]; }
            s *= scale; pc[p * 1024 + i] = s; mx = fmaxf(mx, s); }
        mx = wave_max(mx);
        sum = 0.f;
        for (int i = lane; i < nw; i += 64) { const float e = __expf(pc[p * 1024 + i] - mx); pc[p * 1024 + i] = e; sum += e; }
        sum = wave_sum(sum); const float invw = 1.f / fmaxf(sum, 1e-30f);
        LDS_WAIT();
        float ow0 = 0.f, ow1 = 0.f;
#pragma unroll 8
        for (int i = 0; i < nw; ++i) { const float pv = pc[p * 1024 + i]; const f16* vr = z + (size_t)(lo + i) * NZ + ZVW + g * 128; ow0 += pv * (float)vr[lane]; ow1 += pv * (float)vr[lane + 64]; }
        const float gc = sigmoidf_((float)zrow[ZGL + 0 * 8 + hq]), gs = sigmoidf_((float)zrow[ZGL + 1 * 8 + hq]), gw_ = sigmoidf_((float)zrow[ZGL + 2 * 8 + hq]);
        onsa[(size_t)t * 1024 + hq * 128 + lane] = gc * oc0 + gs * os0 * invs + gw_ * ow0 * invw;
        onsa[(size_t)t * 1024 + hq * 128 + lane + 64] = gc * oc1 + gs * os1 * invs + gw_ * ow1 * invw;
    }
}

__device__ __forceinline__ void p_rwkv_naive(const Args& a, LAS unsigned char* lds, int h) {
    const int tid = threadIdx.x; if (tid >= 64) return; const int i = tid;
    LAS float* Wl = (LAS float*)lds;
    LAS float* vin = Wl + 288 * 64;
    LAS float* vw = vin + 288; LAS float* vkk = vw + 64; LAS float* vb = vkk + 64; LAS float* vkp = vb + 64; LAS float* vr = vkp + 64;
    const int ch = h * 64 + i;
    for (int j = 0; j < 64; ++j) { Wl[j * 64 + i] = a.in[I_WUP][j * 1024 + ch]; Wl[(64 + j) * 64 + i] = a.in[I_AUP][j * 1024 + ch]; }
    for (int j = 0; j < 160; ++j) Wl[(128 + j) * 64 + i] = a.in[I_GUP][j * 1024 + ch];
    const float* mu = a.in[I_MU];
    const float mu_r = mu[ch], mu_k = mu[1024 + ch], mu_v = mu[2048 + ch], mu_wd = mu[3072 + i], mu_ad = mu[3136 + i], mu_g0 = mu[3200 + i], mu_g1 = mu[3264 + i], mu_g2 = (i < 32) ? mu[3328 + i] : 0.f;
    const float w0 = a.in[I_W0][ch], a0 = a.in[I_A0][ch], k_k = a.in[I_KK][ch], k_a = a.in[I_KA][ch], r_k = a.in[I_RK][ch], lg = a.in[I_LNXG][ch], lb = a.in[I_LNXB][ch];
    const f16* z = (const f16*)(a.ws + WS_Z); f16* mix = (f16*)(a.ws + WS_MIX);
    float S[64];
#pragma unroll
    for (int j = 0; j < 64; ++j) S[j] = 0.f;
    float pr = 0.f, pk = 0.f, pv = 0.f, pwd = 0.f, pad = 0.f, pg0 = 0.f, pg1 = 0.f, pg2 = 0.f;
    const f16* zr = z;
    float cr = (float)zr[ZR + ch], ck = (float)zr[ZK + ch], cv = (float)zr[ZV + ch], cwd = (float)zr[ZWD + i], cad = (float)zr[ZAD + i], cg0 = (float)zr[ZGD + i], cg1 = (float)zr[ZGD + 64 + i], cg2 = (i < 32) ? (float)zr[ZGD + 128 + i] : 0.f;
    LDS_WAIT();
    for (int t = 0; t < T; ++t) {
        float nr = 0.f, nk = 0.f, nv = 0.f, nwd = 0.f, nad = 0.f, ng0 = 0.f, ng1 = 0.f, ng2 = 0.f;
        if (t + 1 < T) { const f16* zn = z + (size_t)(t + 1) * NZ; nr = (float)zn[ZR + ch]; nk = (float)zn[ZK + ch]; nv = (float)zn[ZV + ch]; nwd = (float)zn[ZWD + i]; nad = (float)zn[ZAD + i];
            ng0 = (float)zn[ZGD + i]; ng1 = (float)zn[ZGD + 64 + i]; ng2 = (i < 32) ? (float)zn[ZGD + 128 + i] : 0.f; }
        const float r = cr + (pr - cr) * mu_r, k = ck + (pk - ck) * mu_k, v = cv + (pv - cv) * mu_v;
        const float wd = cwd + (pwd - cwd) * mu_wd, ad = cad + (pad - cad) * mu_ad, g0 = cg0 + (pg0 - cg0) * mu_g0, g1 = cg1 + (pg1 - cg1) * mu_g1, g2 = cg2 + (pg2 - cg2) * mu_g2;
        vin[i] = tanhf(wd); vin[64 + i] = ad; vin[128 + i] = sigmoidf_(g0); vin[192 + i] = sigmoidf_(g1); if (i < 32) vin[256 + i] = sigmoidf_(g2);
        LDS_WAIT();
        float wpre = w0, apre = a0, gg = 0.f;
#pragma unroll 8
        for (int j = 0; j < 64; ++j) { wpre += vin[j] * Wl[j * 64 + i]; apre += vin[64 + j] * Wl[(64 + j) * 64 + i]; }
#pragma unroll 8
        for (int j = 0; j < 160; ++j) gg += vin[128 + j] * Wl[(128 + j) * 64 + i];
        const float y0 = -wpre; const float sp = fmaxf(y0, 0.f) + log1pf(__expf(-fabsf(y0)));
        const float wlog = -sp - 0.5f; const float dec = __expf(-__expf(wlog));
        const float av = sigmoidf_(apre);
        const float kkr = k * k_k; const float ss = wave_sum(kkr * kkr); const float kk = kkr * rsqrtf(fmaxf(ss, 1e-24f));
        const float kp = k * (1.f + (av - 1.f) * k_a);
        vw[i] = dec; vkk[i] = kk; vb[i] = kk * av; vkp[i] = kp; vr[i] = r;
        LDS_WAIT();
        float sa = 0.f;
#pragma unroll
        for (int j = 0; j < 64; j += 4) { const f32x4 k4 = *(const LAS f32x4*)(vkk + j); sa -= S[j] * k4.x + S[j + 1] * k4.y + S[j + 2] * k4.z + S[j + 3] * k4.w; }
        float y = 0.f;
#pragma unroll
        for (int j = 0; j < 64; j += 4) { const f32x4 w4 = *(const LAS f32x4*)(vw + j), b4 = *(const LAS f32x4*)(vb + j), p4 = *(const LAS f32x4*)(vkp + j), r4 = *(const LAS f32x4*)(vr + j);
            S[j] = S[j] * w4.x + sa * b4.x + v * p4.x; S[j + 1] = S[j + 1] * w4.y + sa * b4.y + v * p4.y; S[j + 2] = S[j + 2] * w4.z + sa * b4.z + v * p4.z; S[j + 3] = S[j + 3] * w4.w + sa * b4.w + v * p4.w;
            y += S[j] * r4.x + S[j + 1] * r4.y + S[j + 2] * r4.z + S[j + 3] * r4.w; }
        const float mean = wave_sum(y) * (1.f / 64.f); const float dv = y - mean; const float var = wave_sum(dv * dv) * (1.f / 64.f);
        const float yn = dv * rsqrtf(var + 64e-5f) * lg + lb;
        const float bonus = wave_sum(r * kp * r_k) * v;
        mix[(size_t)t * D + 1024 + ch] = (f16)((yn + bonus) * gg);
        pr = cr; pk = ck; pv = cv; pwd = cwd; pad = cad; pg0 = cg0; pg1 = cg1; pg2 = cg2;
        cr = nr; ck = nk; cv = nv; cwd = nwd; cad = nad; cg0 = ng0; cg1 = ng1; cg2 = ng2;
        LDS_WAIT();
    }
}

__device__ __forceinline__ void p_router(const Args& a, LAS unsigned char* lds) {
    const int tid = threadIdx.x, lane = tid & 63, wave = tid >> 6, gw = blockIdx.x * 8 + wave, NGW = gridDim.x * 8;
    const float* x2 = (const float*)(a.ws + WS_X1); f16* h3 = (f16*)a.out;
    unsigned* ctl = (unsigned*)(a.ws + WS_CTL);
    int* tke = (int*)(a.ws + WS_TOK + TK_E); float* tkw = (float*)(a.ws + WS_TOK + TK_W);
    const float* Wg = a.in[I_RGW]; const float* We = a.in[I_REW];
    for (int m = gw; m < T; m += NGW) {
        const f32x4* xr = (const f32x4*)(x2 + (size_t)m * D) + lane; f32x4 v[8]; float s = 0.f;
#pragma unroll
        for (int j = 0; j < 8; ++j) { v[j] = xr[64 * j]; s += v[j].x * v[j].x + v[j].y * v[j].y + v[j].z * v[j].z + v[j].w * v[j].w; }
        const float rstd = rsqrtf(wave_sum(s) * (1.f / D) + EPS);
        const f32x4* gr = (const f32x4*)a.in[I_LN3] + lane; u32x2* o8 = (u32x2*)(h3 + (size_t)m * D) + lane;
#pragma unroll
        for (int j = 0; j < 8; ++j) { const f32x4 gg = gr[64 * j]; v[j].x *= rstd * gg.x; v[j].y *= rstd * gg.y; v[j].z *= rstd * gg.z; v[j].w *= rstd * gg.w;
            u32x2 w; w.x = pkh(v[j].x, v[j].y); w.y = pkh(v[j].z, v[j].w); o8[64 * j] = w; }
        LAS float* xs = (LAS float*)(lds + wave * 8192);
#pragma unroll
        for (int j = 0; j < 8; ++j) *(LAS f32x4*)(xs + j * 256 + lane * 4) = v[j];
        LDS_WAIT();
        float lg[4] = {0.f, 0.f, 0.f, 0.f};
#pragma unroll 2
        for (int k = 0; k < 32; ++k) { const int i = k * 64 + lane; const float xv = xs[i]; const f32x4 w4 = *(const f32x4*)(Wg + (size_t)i * 4);
            lg[0] += xv * w4.x; lg[1] += xv * w4.y; lg[2] += xv * w4.z; lg[3] += xv * w4.w; }
#pragma unroll
        for (int c = 0; c < 4; ++c) lg[c] = wave_sum(lg[c]) + a.in[I_RGB][c];
        int gi = 0; float gm = lg[0];
#pragma unroll
        for (int c = 1; c < 4; ++c) if (lg[c] > gm) { gm = lg[c]; gi = c; }
        float gs = 0.f;
#pragma unroll
        for (int c = 0; c < 4; ++c) gs += __expf(lg[c] - gm);
        const float pg = 1.f / gs;
        float le[8] = {0.f, 0.f, 0.f, 0.f, 0.f, 0.f, 0.f, 0.f};
#pragma unroll 2
        for (int k = 0; k < 32; ++k) { const int i = k * 64 + lane; const float xv = xs[i]; const f32x4* wp = (const f32x4*)(We + (size_t)i * 32 + gi * 8); const f32x4 wa = wp[0], wb = wp[1];
            le[0] += xv * wa.x; le[1] += xv * wa.y; le[2] += xv * wa.z; le[3] += xv * wa.w; le[4] += xv * wb.x; le[5] += xv * wb.y; le[6] += xv * wb.z; le[7] += xv * wb.w; }
#pragma unroll
        for (int c = 0; c < 8; ++c) le[c] = wave_sum(le[c]) + a.in[I_REB][gi * 8 + c];
        LDS_WAIT();
        int e1 = 0; float m1 = le[0];
#pragma unroll
        for (int c = 1; c < 8; ++c) if (le[c] > m1) { m1 = le[c]; e1 = c; }
        int e2 = -1; float m2 = -INFINITY;
#pragma unroll
        for (int c = 0; c < 8; ++c) if (c != e1 && le[c] > m2) { m2 = le[c]; e2 = c; }
        const float p1 = 1.f, p2 = __expf(m2 - m1);
        const float w1 = pg * p1 / (p1 + p2), w2 = pg * p2 / (p1 + p2);
        if (lane == 0) { const int E1 = gi * 8 + e1, E2 = gi * 8 + e2; tke[m * 2] = E1; tke[m * 2 + 1] = E2; tkw[m * 2] = w1; tkw[m * 2 + 1] = w2;
            atomicAdd(&ctl[CW_CNT + E1], 1u); atomicAdd(&ctl[CW_CNT + E2], 1u); }
    }
}
__device__ __forceinline__ void p_offsets(const Args& a) {
    if (blockIdx.x != 0) return;
    unsigned* ctl = (unsigned*)(a.ws + WS_CTL); int* stok = (int*)(a.ws + WS_TOK + TK_STOK); float* sw = (float*)(a.ws + WS_TOK + TK_SW);
    const int tid = threadIdx.x;
    if (tid == 0) {
        int off = 0, ngu = 0, ndn = 0; int2* ugu = (int2*)(ctl + CW_UGU); int2* udn = (int2*)(ctl + CW_UDN);
        for (int e = 0; e < NEXP; ++e) { const int n = (int)ctl[CW_CNT + e]; ctl[CW_OFF + e] = (unsigned)off; const int nt = (n + 255) / 256;
            for (int rt = 0; rt < nt; ++rt) { const int pm = off / 256 + rt; for (int jt = 0; jt < 2; ++jt) ugu[ngu++] = make_int2(pm, e * 2 + jt); for (int jt = 0; jt < 8; ++jt) udn[ndn++] = make_int2(pm, e * 8 + jt); }
            off += nt * 256; }
        ctl[CW_OFF + NEXP] = (unsigned)off; ctl[CW_NT] = (unsigned)(off / 256); ctl[CW_NGU] = (unsigned)ngu; ctl[CW_NDN] = (unsigned)ndn;
    }
    __syncthreads();
    for (int e = 0; e < NEXP; ++e) { const int n = (int)ctl[CW_CNT + e], off = (int)ctl[CW_OFF + e], end = (int)ctl[CW_OFF + e + 1];
        for (int s = off + n + tid; s < end; s += 512) { stok[s] = 0; sw[s] = 0.f; } }
}
__device__ __forceinline__ void p_slots(const Args& a) {
    unsigned* ctl = (unsigned*)(a.ws + WS_CTL);
    const int* tke = (const int*)(a.ws + WS_TOK + TK_E); const float* tkw = (const float*)(a.ws + WS_TOK + TK_W); int* tks = (int*)(a.ws + WS_TOK + TK_SLOT);
    int* stok = (int*)(a.ws + WS_TOK + TK_STOK); float* sw = (float*)(a.ws + WS_TOK + TK_SW);
    for (int i = blockIdx.x * 512 + threadIdx.x; i < T * 2; i += gridDim.x * 512) { const int e = tke[i]; const int slot = (int)ctl[CW_OFF + e] + (int)atomicAdd(&ctl[CW_CUR + e], 1u);
        stok[slot] = i >> 1; sw[slot] = tkw[i]; tks[i] = slot; }
}

constexpr int NPH = 17;
__global__ void __launch_bounds__(512, 2) mega(Args args) {
    extern __shared__ __attribute__((aligned(16))) unsigned char lds_raw[];
    LAS unsigned char* lds = (LAS unsigned char*)lds_raw;
    volatile LAS unsigned* MISC = (volatile LAS unsigned*)(lds + MISC_OFF);
    const int tid = threadIdx.x, lane = tid & 63, wave = tid >> 6;
    const int gw = blockIdx.x * 8 + wave, NGW = gridDim.x * 8, G = gridDim.x;
    unsigned char* ws = args.ws;
    unsigned* ctl = (unsigned*)(ws + WS_CTL);
    for (int u = tid; u < (LDS_BYTES - RING_BYTES) / 4; u += 512) ((LAS unsigned*)(lds + RING_BYTES))[u] = 0u;
    __syncthreads();
    XcdBarrier bar; bar.bar = ctl + CW_BAR; bar.x = 0; bar.st = nullptr;
    const int lo = args.ph_lo, hi = args.ph_hi;
    if (hi - lo > 1) bar = xcd_barrier_post(ctl + CW_BAR, MISC + 8);
#ifndef PHMASK
#define PHMASK 0xFFFFFFFFu
#endif
#define IN(k) (((PHMASK >> (k)) & 1u) && lo <= (k) && (k) < hi)
#define BOTH(k) (IN(k) && IN((k) + 1))
#define GRID_BAR() xcd_barrier(bar)

    if (IN(0)) { p0_prologue(args, lds); if (BOTH(0)) GRID_BAR(); }
    if (IN(1)) {
        { pg8::Gemm g{(const f16*)(ws + WS_H), (const f16*)(ws + WS_WIN), D, D, D, nullptr}; pg8::StaticOrder S; S.init(T, NZ, G, (int)blockIdx.x);
          pg8::EpiF16 E{(f16*)(ws + WS_Z), NZ, 1.f}; pg8::gemm_phase<pg8::EpiF16, pg8::StaticOrder, true>(lds, g, S, E); }
        { const int b = blockIdx.x; const int which = b / 8;
          pg8::Gemm g{(const f16*)(ws + WS_MEMN), (const f16*)(ws + (which == 0 ? WS_WKT : WS_WVT)), D, D, D, nullptr}; pg8::StaticOrder S; S.init(256, D, 8, b < 16 ? b % 8 : 1 << 20);
          pg8::EpiF16 E{(f16*)(ws + (which == 0 ? WS_KM : WS_VM)), D, 1.f}; pg8::gemm_phase<pg8::EpiF16, pg8::StaticOrder, true>(lds, g, S, E); }
        if (BOTH(1)) GRID_BAR();
    }
    if (IN(2)) {
        p_compress(args, lds);
        __syncthreads();
        { const int b = blockIdx.x; const int grp = b / 8, c = b % 8;
          if (grp < 4) { const int h = grp;
              pg8::Gemm g{(const f16*)(ws + WS_KM) + h * 512, (const f16*)(ws + WS_WQ16) + h * 512, D, D, 512, nullptr}; pg8::StaticOrder S; S.init(256, D, 8, c);
              pg8::EpiF16 E{(f16*)(ws + WS_WQK) + (size_t)h * 256 * D, D, 0.04419417382415922f}; pg8::gemm_phase<pg8::EpiF16, pg8::StaticOrder, true>(lds, g, S, E); }
          else if (grp < 8) { const int h = grp - 4;
              pg8::Gemm g{(const f16*)(ws + WS_WOT) + h * 512, (const f16*)(ws + WS_VM) + h * 512, D, D, 512, nullptr}; pg8::StaticOrder S; S.init(D, 256, 8, c);
              pg8::EpiF16 E{(f16*)(ws + WS_VOT) + h * 256, 1024, 1.f}; pg8::gemm_phase<pg8::EpiF16, pg8::StaticOrder, true>(lds, g, S, E); } }
        if (BOTH(2)) GRID_BAR();
    }
    if (IN(3)) {
        if (G >= 32) { if (blockIdx.x < 16) p_rwkv_naive(args, lds, blockIdx.x); else p_nsa_naive(args, lds, blockIdx.x - 16, G - 16); }
        if (BOTH(3)) GRID_BAR();
    }
    if (IN(4)) { if (BOTH(4)) GRID_BAR(); }
    if (IN(5)) {
        const float* onsa = (const float*)(ws + WS_ONSA); f16* mix = (f16*)(ws + WS_MIX);
        for (int m = gw; m < T; m += NGW) { const f32x4* xr = (const f32x4*)(onsa + (size_t)m * 1024) + lane; f32x4 v[4]; float s = 0.f;
#pragma unroll
            for (int j = 0; j < 4; ++j) { v[j] = xr[64 * j]; s += v[j].x * v[j].x + v[j].y * v[j].y + v[j].z * v[j].z + v[j].w * v[j].w; }
            const float rstd = rsqrtf(wave_sum(s) * (1.f / 1024.f) + EPS); const f32x4* gr = (const f32x4*)args.in[I_NSAG] + lane; u32x2* o8 = (u32x2*)(mix + (size_t)m * D) + lane;
#pragma unroll
            for (int j = 0; j < 4; ++j) { const f32x4 gg = gr[64 * j]; u32x2 w; w.x = pkh(v[j].x * rstd * gg.x, v[j].y * rstd * gg.y); w.y = pkh(v[j].z * rstd * gg.z, v[j].w * rstd * gg.w); o8[64 * j] = w; } }
        if (BOTH(5)) GRID_BAR();
    }
    if (IN(6)) {
        pg8::Gemm g{(const f16*)(ws + WS_MIX), (const f16*)(ws + WS_WOUT), D, D, D, nullptr}; pg8::StaticOrder S; S.init(T, D, G, (int)blockIdx.x);
        pg8::EpiF32 E{(float*)(ws + WS_X1), args.in[I_X], D}; pg8::gemm_phase<pg8::EpiF32, pg8::StaticOrder, true>(lds, g, S, E);
        if (BOTH(6)) GRID_BAR();
    }
    if (IN(7)) {
        for (int m = gw; m < T; m += NGW) rms_row((const float*)(ws + WS_X1) + (size_t)m * D, args.in[I_LN2], (f16*)(ws + WS_H2) + (size_t)m * D, lane);
        if (BOTH(7)) GRID_BAR();
    }
    if (IN(8)) {
        pg8::Gemm g{(const f16*)(ws + WS_H2), (const f16*)(ws + WS_WQK), D, D, D, nullptr}; pg8::StaticOrder S; S.init(T, 1024, G, (int)blockIdx.x);
        pg8::EpiF32 E{(float*)(ws + WS_S), nullptr, 1024}; pg8::gemm_phase<pg8::EpiF32, pg8::StaticOrder, true>(lds, g, S, E);
        if (BOTH(8)) GRID_BAR();
    }
    if (IN(9)) {
        const float* Sm = (const float*)(ws + WS_S); f16* P = (f16*)(ws + WS_P);
        for (int it = gw; it < T * 4; it += NGW) { const f32x4 v = *((const f32x4*)(Sm + (size_t)it * 256) + lane);
            const float mx = wave_max(fmaxf(fmaxf(v.x, v.y), fmaxf(v.z, v.w)));
            const float e0 = __expf(v.x - mx), e1 = __expf(v.y - mx), e2 = __expf(v.z - mx), e3 = __expf(v.w - mx);
            const float inv = 1.f / wave_sum(e0 + e1 + e2 + e3);
            u32x2 w; w.x = pkh(e0 * inv, e1 * inv); w.y = pkh(e2 * inv, e3 * inv); *((u32x2*)(P + (size_t)it * 256) + lane) = w; }
        if (BOTH(9)) GRID_BAR();
    }
    if (IN(10)) {
        pg8::Gemm g{(const f16*)(ws + WS_P), (const f16*)(ws + WS_VOT), 1024, 1024, 1024, nullptr}; pg8::StaticOrder S; S.init(T, D, G, (int)blockIdx.x);
        pg8::EpiF32 E{(float*)(ws + WS_X1), (const float*)(ws + WS_X1), D}; pg8::gemm_phase<pg8::EpiF32, pg8::StaticOrder, true>(lds, g, S, E);
        if (BOTH(10)) GRID_BAR();
    }
    if (IN(11)) { p_router(args, lds); if (BOTH(11)) GRID_BAR(); }
    if (IN(12)) { p_offsets(args); if (BOTH(12)) GRID_BAR(); }
    if (IN(13)) { p_slots(args); if (BOTH(13)) GRID_BAR(); }
    if (IN(14)) {
        pg8::Gemm g{(const f16*)args.out, (const f16*)(ws + WS_WGU), D, D, D, (const int*)(ws + WS_TOK + TK_STOK)};
        pg8::TableOrder S{(const int2*)(ctl + CW_UGU), (int)ctl[CW_NGU], G, (int)blockIdx.x};
        pg8::EpiSilu E{(f16*)(ws + WS_HID)}; pg8::gemm_phase<pg8::EpiSilu, pg8::TableOrder, true>(lds, g, S, E);
        if (BOTH(14)) GRID_BAR();
    }
    if (IN(15)) {
        pg8::Gemm g{(const f16*)(ws + WS_HID), (const f16*)(ws + WS_WD), EFF, EFF, EFF, nullptr};
        pg8::TableOrder S{(const int2*)(ctl + CW_UDN), (int)ctl[CW_NDN], G, (int)blockIdx.x};
        pg8::EpiDown E{ws}; pg8::gemm_phase<pg8::EpiDown, pg8::TableOrder, true>(lds, g, S, E);
        if (BOTH(15)) GRID_BAR();
    }
    if (IN(16)) {
        const float* x2 = (const float*)(ws + WS_X1); const int* tks = (const int*)(ws + WS_TOK + TK_SLOT);
        const float* tkw = (const float*)(ws + WS_TOK + TK_W);
        for (int m = gw; m < T; m += NGW) { const int s1 = tks[m * 2], s2 = tks[m * 2 + 1]; const float w1 = tkw[m * 2], w2 = tkw[m * 2 + 1];
            const f16* y1 = (const f16*)(ws + ((s1 >> 8) < 128 ? WS_Y0 + (size_t)(s1 >> 8) * MiB : WS_Y1 + (size_t)((s1 >> 8) - 128) * MiB)) + (size_t)(s1 & 255) * D;
            const f16* y2 = (const f16*)(ws + ((s2 >> 8) < 128 ? WS_Y0 + (size_t)(s2 >> 8) * MiB : WS_Y1 + (size_t)((s2 >> 8) - 128) * MiB)) + (size_t)(s2 & 255) * D;
            const f32x4* xr = (const f32x4*)(x2 + (size_t)m * D) + lane; f32x4 v[8]; float s = 0.f;
#pragma unroll
            for (int j = 0; j < 8; ++j) { v[j] = xr[64 * j]; const f16x4 a1 = *((const f16x4*)y1 + lane + 64 * j), a2 = *((const f16x4*)y2 + lane + 64 * j);
                v[j].x += w1 * (float)a1.x + w2 * (float)a2.x; v[j].y += w1 * (float)a1.y + w2 * (float)a2.y; v[j].z += w1 * (float)a1.z + w2 * (float)a2.z; v[j].w += w1 * (float)a1.w + w2 * (float)a2.w;
                s += v[j].x * v[j].x + v[j].y * v[j].y + v[j].z * v[j].z + v[j].w * v[j].w; }
            const float rstd = rsqrtf(wave_sum(s) * (1.f / D) + EPS); const f32x4* gr = (const f32x4*)args.in[I_LNF] + lane; f32x4* o = (f32x4*)(args.out + (size_t)m * D) + lane;
#pragma unroll
            for (int j = 0; j < 8; ++j) { const f32x4 gg = gr[64 * j]; o[64 * j] = (f32x4){v[j].x * rstd * gg.x, v[j].y * rstd * gg.y, v[j].z * rstd * gg.z, v[j].w * rstd * gg.w}; } }
    }
#undef IN
#undef BOTH
#undef GRID_BAR
}

extern "C" void kernel_launch(void* const* d_in, const int* in_sizes, int n_in, void* d_out, int out_size, void* d_ws, size_t ws_size, hipStream_t stream) {
    static int grid = 0;
    if (grid == 0) {
        if (n_in != 38 || out_size != T * D || ws_size < WS_END) { fprintf(stderr, "kernel_launch: unexpected shapes (n_in %d out %d ws %zu)\n", n_in, out_size, ws_size); grid = -1; return; }
        int dev = 0, cus = 0;
        if (hipGetDevice(&dev) != hipSuccess || hipDeviceGetAttribute(&cus, hipDeviceAttributeMultiprocessorCount, dev) != hipSuccess) { grid = -1; return; }
        if (hipFuncSetAttribute((const void*)mega, hipFuncAttributeMaxDynamicSharedMemorySize, LDS_BYTES) != hipSuccess) { grid = -1; return; }
        int per_cu = 0; (void)hipOccupancyMaxActiveBlocksPerMultiprocessor(&per_cu, (const void*)mega, 512, LDS_BYTES); (void)hipGetLastError();
        grid = cus;
    }
    if (grid < 0) return;
    (void)hipMemsetAsync((char*)d_ws + WS_CTL, 0, CTL_ZERO_BYTES, stream);
    Args a{};
    for (int i = 0; i < 38; ++i) a.in[i] = (const float*)d_in[i];
    a.out = (float*)d_out; a.ws = (unsigned char*)d_ws;
#if MK_ONE_LAUNCH
    a.ph_lo = 0; a.ph_hi = NPH;
    hipLaunchKernelGGL(mega, dim3(grid), dim3(512), LDS_BYTES, stream, a);
#else
    for (int p = 0; p < NPH; ++p) { if (p == 4) continue; a.ph_lo = p; a.ph_hi = p + 1; hipLaunchKernelGGL(mega, dim3(grid), dim3(512), LDS_BYTES, stream, a); }
#endif
}
```

```cpp
#include <hip/hip_runtime.h>
#include <cstdio>
#include <cstdint>

#ifndef MK_ONE_LAUNCH
#define MK_ONE_LAUNCH 1
#endif

#define LAS __attribute__((address_space(3)))
#define GAS __attribute__((address_space(1)))
typedef _Float16 f16;
typedef _Float16 f16x8 __attribute__((ext_vector_type(8)));
typedef _Float16 f16x4 __attribute__((ext_vector_type(4)));
typedef _Float16 f16x2 __attribute__((ext_vector_type(2)));
typedef float f32x4 __attribute__((ext_vector_type(4)));
typedef float f32x2 __attribute__((ext_vector_type(2)));
typedef unsigned u32x4 __attribute__((ext_vector_type(4)));
typedef unsigned u32x2 __attribute__((ext_vector_type(2)));

constexpr int T = 16384, D = 2048, NZ = 6144;
constexpr int ZQ = 0, ZKC = 1024, ZVC = 1280, ZKS = 1536, ZVS = 1792, ZKW = 2048, ZVW = 2304, ZR = 2560, ZK = 3584, ZV = 4608, ZWD = 5632, ZAD = 5696, ZGD = 5760, ZGL = 5920;
constexpr int NCMP = 1023;
constexpr int NEXP = 32, EFF = 256, MAXSLOT = 40960, MAXTILES = 160;
constexpr float EPS = 1e-6f;

constexpr size_t MiB = 1u << 20;
constexpr size_t WS_CTL = 0, CTL_ZERO_BYTES = 64 * 1024;
constexpr size_t WS_MEMN = 1 * MiB, WS_KM = 2 * MiB, WS_VM = 3 * MiB, WS_KCMP = 4 * MiB, WS_VCMP = 5 * MiB, WS_TOK = 6 * MiB, WS_CMPB = 7 * MiB;
constexpr size_t WS_WQK = 8 * MiB, WS_VOT = 12 * MiB, WS_WIN = 16 * MiB, WS_WOUT = 40 * MiB, WS_WQ16 = 48 * MiB, WS_WKT = 56 * MiB, WS_WVT = 64 * MiB, WS_WOT = 72 * MiB;
constexpr size_t WS_WGU = 80 * MiB, WS_WD = 144 * MiB, WS_H = 176 * MiB, WS_Z = 240 * MiB, WS_ONSA = 432 * MiB, WS_END = 512 * MiB;
constexpr size_t WS_MIX = WS_H, WS_P = WS_H, WS_H2 = WS_Z, WS_X1 = 304 * MiB, WS_S = WS_ONSA, WS_HID = 16 * MiB;
constexpr size_t WS_Y0 = 176 * MiB, WS_Y1 = 432 * MiB;
constexpr size_t TK_E = 0, TK_W = 128 * 1024, TK_SLOT = 256 * 1024, TK_STOK = 384 * 1024, TK_SW = 576 * 1024;
constexpr int CW_BAR = 0;
constexpr int CW_CNT = 4096, CW_CUR = 4160, CW_OFF = 4224, CW_NT = 4288  , CW_NGU = 4289, CW_NDN = 4290;
constexpr int CW_UGU = 6144  , CW_UDN = 8192  ;
static_assert((CW_UDN + MAXTILES * 8 * 2) * 4 <= (int)CTL_ZERO_BYTES, "ctl");

constexpr int RING_BYTES = 131072, MISC_OFF = RING_BYTES + 320, LDS_BYTES = 147456;

__device__ __forceinline__ unsigned pkh(float a, float b) { f16x2 v = {(f16)a, (f16)b}; return __builtin_bit_cast(unsigned, v); }
__device__ __forceinline__ float wave_sum(float v) {
#pragma unroll
    for (int o = 1; o < 64; o <<= 1) v += __shfl_xor(v, o);
    return v;
}
__device__ __forceinline__ float wave_max(float v) {
#pragma unroll
    for (int o = 1; o < 64; o <<= 1) v = fmaxf(v, __shfl_xor(v, o));
    return v;
}
#define LDS_WAIT() asm volatile("s_waitcnt lgkmcnt(0)" ::: "memory")
#define VM_WAIT() asm volatile("s_waitcnt vmcnt(0)" ::: "memory")
__device__ __forceinline__ float sigmoidf_(float x) { return 1.f / (1.f + __expf(-x)); }

namespace pg8 {
constexpr int BM = 256, BK = 64, HALF = 128, HTB = HALF * BK * 2, STAGE_BYTES = 8 * HTB, NXCD = 8, WGM = 8;
__host__ __device__ __forceinline__ int lds_byte(int r, int c) { const int st = (r >> 4) * 2 + (c >> 5), rr = r & 15, cc = c & 31, ob = rr * 64 + cc * 2; return st * 1024 + (ob ^ (((ob >> 9) & 1) << 5)); }
__host__ __device__ __forceinline__ void stage_rc(int b, int& R, int& C) { const int st = b / 1024, sb = b % 1024, swz = sb ^ (((sb >> 9) & 1) << 5); R = (st >> 1) * 16 + swz / 64; C = (st & 1) * 32 + (swz % 64) / 2; }
__host__ __device__ __forceinline__ int perm32(int rho) { const int n = rho >> 4, i = rho & 15; return 8 * (i >> 2) + 4 * n + (i & 3); }

struct Unit { int pm, pn; };
struct Gemm { const f16* A; const f16* Bt; int lda, ldb, K; const int* gather; };

struct StaticOrder {
    int nM, nN, nwg, G, c;
    __host__ __device__ void init(int M, int N, int G_, int c_) { nM = M / BM; nN = N / BM; nwg = nM * nN; G = G_; c = c_; }
    __host__ __device__ bool next(int i, Unit& u) const {
        const long L = (long)i * G + c; if (L >= nwg) return false;
        int wgid = (int)L; { const int q = nwg / NXCD, r = nwg % NXCD, xcd = wgid % NXCD, off = wgid / NXCD; wgid = (xcd < r ? xcd * (q + 1) : r * (q + 1) + (xcd - r) * q) + off; }
        const int nig = WGM * nN, gid = wgid / nig, fm = gid * WGM, gsz = (nM - fm) < WGM ? (nM - fm) : WGM;
        u.pm = fm + ((wgid % nig) % gsz); u.pn = (wgid % nig) / gsz; return true;
    }
};
struct TableOrder {
    const int2* tab; int n, G, c;
    __device__ bool next(int i, Unit& u) const { const int L = i * G + c; if (L >= n) return false; const int2 v = tab[L]; u.pm = v.x; u.pn = v.y; return true; }
};

struct EpiF16 {
    static constexpr bool PERM = true;
    f16* O; int ldc; float scale;
    __device__ __forceinline__ void operator()(const f32x4 (&acc)[2][2][4][2], const Unit& u, int wr, int wc, int fr, int fq) const {
        const int row0 = u.pm * BM + wr * 64 + fr, col0 = u.pn * BM + wc * 32 + 8 * fq;
#pragma unroll
        for (int ai = 0; ai < 2; ++ai)
#pragma unroll
            for (int m = 0; m < 4; ++m) { f16* rowp = O + (size_t)(row0 + ai * HALF + m * 16) * ldc + col0;
#pragma unroll
                for (int bj = 0; bj < 2; ++bj) { const f32x4 v0 = acc[ai][bj][m][0] * scale, v1 = acc[ai][bj][m][1] * scale;
                    u32x4 w; w.x = pkh(v0[0], v0[1]); w.y = pkh(v0[2], v0[3]); w.z = pkh(v1[0], v1[1]); w.w = pkh(v1[2], v1[3]);
                    *(u32x4*)(rowp + bj * HALF) = w; } }
    }
};
struct EpiF32 {
    static constexpr bool PERM = false;
    float* C; const float* R; int ldc;
    __device__ __forceinline__ void operator()(const f32x4 (&acc)[2][2][4][2], const Unit& u, int wr, int wc, int fr, int fq) const {
        const int row0 = u.pm * BM + wr * 64 + fr, col0 = u.pn * BM + wc * 32 + 4 * fq;
#pragma unroll
        for (int ai = 0; ai < 2; ++ai)
#pragma unroll
            for (int m = 0; m < 4; ++m) { const size_t ro = (size_t)(row0 + ai * HALF + m * 16) * ldc + col0;
#pragma unroll
                for (int bj = 0; bj < 2; ++bj)
#pragma unroll
                    for (int n = 0; n < 2; ++n) { f32x4 v = acc[ai][bj][m][n]; if (R) v = v + *(const f32x4*)(R + ro + bj * HALF + n * 16); *(f32x4*)(C + ro + bj * HALF + n * 16) = v; } }
    }
};
struct EpiSilu {
    static constexpr bool PERM = true;
    f16* O;
    __device__ __forceinline__ void operator()(const f32x4 (&acc)[2][2][4][2], const Unit& u, int wr, int wc, int fr, int fq) const {
        const int row0 = u.pm * BM + wr * 64 + fr, col0 = (u.pn & 1) * 128 + wc * 32 + 8 * fq;
#pragma unroll
        for (int ai = 0; ai < 2; ++ai)
#pragma unroll
            for (int m = 0; m < 4; ++m) { f16* rowp = O + (size_t)(row0 + ai * HALF + m * 16) * EFF + col0;
                float h[8];
#pragma unroll
                for (int n = 0; n < 2; ++n)
#pragma unroll
                    for (int e = 0; e < 4; ++e) { const float gt = acc[ai][0][m][n][e], up = acc[ai][1][m][n][e]; h[n * 4 + e] = gt / (1.f + __expf(-gt)) * up; }
                u32x4 w; w.x = pkh(h[0], h[1]); w.y = pkh(h[2], h[3]); w.z = pkh(h[4], h[5]); w.w = pkh(h[6], h[7]);
                *(u32x4*)rowp = w; }
    }
};
struct EpiDown {
    static constexpr bool PERM = true;
    unsigned char* ws;
    __device__ __forceinline__ void operator()(const f32x4 (&acc)[2][2][4][2], const Unit& u, int wr, int wc, int fr, int fq) const {
        f16* tile = (f16*)(ws + (u.pm < 128 ? WS_Y0 + (size_t)u.pm * MiB : WS_Y1 + (size_t)(u.pm - 128) * MiB));
        const int r0 = wr * 64 + fr, col0 = (u.pn & 7) * BM + wc * 32 + 8 * fq;
#pragma unroll
        for (int ai = 0; ai < 2; ++ai)
#pragma unroll
            for (int m = 0; m < 4; ++m) { f16* rowp = tile + (size_t)(r0 + ai * HALF + m * 16) * D + col0;
#pragma unroll
                for (int bj = 0; bj < 2; ++bj) { const f32x4 v0 = acc[ai][bj][m][0], v1 = acc[ai][bj][m][1];
                    u32x4 w; w.x = pkh(v0[0], v0[1]); w.y = pkh(v0[2], v0[3]); w.z = pkh(v1[0], v1[1]); w.w = pkh(v1[2], v1[3]);
                    *(u32x4*)(rowp + bj * HALF) = w; } }
    }
};

template <class Epi, class Sched, bool ALIGN_EPI>
__device__ __forceinline__ void gemm_phase(LAS unsigned char* lds, const Gemm g, const Sched& S, const Epi& E) {
    const int tid = threadIdx.x, wid = __builtin_amdgcn_readfirstlane(tid >> 6), lane = tid & 63, wr = wid >> 2, wc = wid & 3, fr = lane & 15, fq = lane >> 4;
    const int K = g.K, nt = K / BK;
    int RA[2], CA[2]; unsigned voffB[2];
#pragma unroll
    for (int i = 0; i < 2; ++i) { int R, C; stage_rc(tid * 16 + i * 8192, R, C); const int Rb = Epi::PERM ? ((R & ~31) + perm32(R & 31)) : R;
        RA[i] = R; CA[i] = C; voffB[i] = (unsigned)(Rb * g.ldb + C) * 2u; }
    const size_t kstep = (size_t)(BK * 2);
    const size_t hstepB = (size_t)HALF * g.ldb * 2, tstepB = 2 * hstepB;
    const unsigned ldsw = (unsigned)wid * 1024u;
    const int aoff = lds_byte(wr * 64 + fr, fq * 8), boff = lds_byte(wc * 32 + fr, fq * 8);
    const char* Ab = (const char*)g.A;
#define PG8_SA(b, h) (((b) * 2 + (h)) * HTB)
#define PG8_SB(b, h) ((4 + (b) * 2 + (h)) * HTB)
#define PG8_STAGE(bufoff, gbase, voff) do { _Pragma("unroll") for (int _i = 0; _i < 2; ++_i) \
        __builtin_amdgcn_global_load_lds((const unsigned*)((const char*)(gbase) + (voff)[_i]), (LAS unsigned*)(lds + (bufoff) + ldsw + _i * 8192), 16, 0, 0); } while (0)
#define PG8_STAGE_A(bufoff, OFFS, h, kb) do { _Pragma("unroll") for (int _i = 0; _i < 2; ++_i) \
        __builtin_amdgcn_global_load_lds((const unsigned*)(Ab + (size_t)(kb) + (OFFS)[h][_i]), (LAS unsigned*)(lds + (bufoff) + ldsw + _i * 8192), 16, 0, 0); } while (0)
#define PG8_LDA(dst, b, h) do { _Pragma("unroll") for (int m = 0; m < 4; ++m) _Pragma("unroll") for (int k = 0; k < 2; ++k) dst[m][k] = *(const LAS f16x8*)(lds + PG8_SA(b, h) + aoff + m * 2048 + k * 1024); } while (0)
#define PG8_LDB(dst, b, h) do { _Pragma("unroll") for (int n = 0; n < 2; ++n) _Pragma("unroll") for (int k = 0; k < 2; ++k) dst[n][k] = *(const LAS f16x8*)(lds + PG8_SB(b, h) + boff + n * 2048 + k * 1024); } while (0)
#define PG8_MMA(ai, bj, At, Bt) do { __builtin_amdgcn_s_setprio(1); _Pragma("unroll") for (int m = 0; m < 4; ++m) _Pragma("unroll") for (int n = 0; n < 2; ++n) _Pragma("unroll") for (int k = 0; k < 2; ++k) \
        acc[ai][bj][m][n] = __builtin_amdgcn_mfma_f32_16x16x32_f16(Bt[n][k], At[m][k], acc[ai][bj][m][n], 0, 0, 0); __builtin_amdgcn_s_setprio(0); } while (0)
#define PG8_WAIT_V(n) asm volatile("s_waitcnt vmcnt(" #n ")" ::: "memory")
#define PG8_WAIT_L(n) asm volatile("s_waitcnt lgkmcnt(" #n ")" ::: "memory")
#define PG8_BAR __builtin_amdgcn_s_barrier()
#define PG8_SCHED __builtin_amdgcn_sched_barrier(0)
#define PG8_OFFS(dst, U) do { _Pragma("unroll") for (int _h = 0; _h < 2; ++_h) _Pragma("unroll") for (int _i = 0; _i < 2; ++_i) { \
        const int _r = (U).pm * BM + _h * HALF + RA[_i]; const int _row = g.gather ? g.gather[_r] : _r; dst[_h][_i] = ((unsigned)_row * (unsigned)g.lda + (unsigned)CA[_i]) * 2u; } } while (0)
    Unit cur, nxt; int ui = 0;
    if (!S.next(0, cur)) return;
    f32x4 acc[2][2][4][2];
#pragma unroll
    for (int a = 0; a < 2; ++a)
#pragma unroll
        for (int b = 0; b < 2; ++b)
#pragma unroll
            for (int m = 0; m < 4; ++m)
#pragma unroll
                for (int n = 0; n < 2; ++n) acc[a][b][m][n] = (f32x4){0.f, 0.f, 0.f, 0.f};
    f16x8 At[4][2], B0[2][2], B1[2][2];
    unsigned offC[2][2], offN[2][2];
    PG8_OFFS(offC, cur);
    const char* cB = (const char*)g.Bt + (size_t)cur.pn * tstepB;
    PG8_STAGE(PG8_SB(0, 0), cB, voffB); PG8_STAGE(PG8_SB(0, 1), cB + hstepB, voffB); PG8_STAGE_A(PG8_SA(0, 0), offC, 0, 0); PG8_STAGE_A(PG8_SA(0, 1), offC, 1, 0);
    if (wr == 1) PG8_BAR;
    PG8_WAIT_V(2); PG8_BAR;
    PG8_STAGE(PG8_SB(1, 0), cB + kstep, voffB); PG8_STAGE_A(PG8_SA(1, 0), offC, 0, kstep); PG8_STAGE(PG8_SB(1, 1), cB + hstepB + kstep, voffB);
    PG8_WAIT_V(6); PG8_BAR;
    for (;;) {
        const bool has_next = S.next(ui + 1, nxt);
        if (has_next) { PG8_OFFS(offN, nxt); } else {
#pragma unroll
            for (int _h = 0; _h < 2; ++_h)
#pragma unroll
                for (int _i = 0; _i < 2; ++_i) offN[_h][_i] = offC[_h][_i]; }
        const char* nB = has_next ? (const char*)g.Bt + (size_t)nxt.pn * tstepB : cB;
#pragma nounroll
        for (int t = 0; t < nt; t += 2) {
            const bool last = (t == nt - 2);
            const size_t kb1 = (size_t)(t + 1) * kstep;
            const size_t kb2 = last ? 0 : (size_t)(t + 2) * kstep, kb3 = kb2 + kstep;
            unsigned o2[2][2];
#pragma unroll
            for (int _h = 0; _h < 2; ++_h)
#pragma unroll
                for (int _i = 0; _i < 2; ++_i) o2[_h][_i] = last ? offN[_h][_i] : offC[_h][_i];
            const char* b2 = last ? nB : cB + (size_t)(t + 2) * kstep; const char* b3 = b2 + kstep;
            PG8_LDB(B0, 0, 0); PG8_LDB(B1, 0, 1); PG8_SCHED; PG8_LDA(At, 0, 0); PG8_STAGE_A(PG8_SA(1, 1), offC, 1, kb1);
            PG8_WAIT_V(8); PG8_WAIT_L(0); PG8_BAR; PG8_MMA(0, 0, At, B0); PG8_MMA(0, 1, At, B1); PG8_BAR; PG8_SCHED;
            PG8_LDA(At, 0, 1); PG8_STAGE(PG8_SB(0, 0), b2, voffB); PG8_STAGE(PG8_SB(0, 1), b2 + hstepB, voffB); PG8_STAGE_A(PG8_SA(0, 0), o2, 0, kb2);
            PG8_WAIT_V(8); PG8_WAIT_L(0); PG8_BAR; PG8_MMA(1, 0, At, B0); PG8_MMA(1, 1, At, B1); PG8_BAR; PG8_SCHED;
            PG8_LDB(B0, 1, 0); PG8_LDB(B1, 1, 1); PG8_SCHED; PG8_LDA(At, 1, 0); PG8_STAGE_A(PG8_SA(0, 1), o2, 1, kb2);
            PG8_WAIT_V(8); PG8_WAIT_L(0); PG8_BAR; PG8_MMA(0, 0, At, B0); PG8_MMA(0, 1, At, B1); PG8_BAR; PG8_SCHED;
            PG8_LDA(At, 1, 1); PG8_STAGE(PG8_SB(1, 0), b3, voffB); PG8_STAGE(PG8_SB(1, 1), b3 + hstepB, voffB); PG8_STAGE_A(PG8_SA(1, 0), o2, 0, kb3);
            PG8_WAIT_V(8); PG8_WAIT_L(0); PG8_BAR; PG8_MMA(1, 0, At, B0); PG8_MMA(1, 1, At, B1); PG8_BAR; PG8_SCHED;
        }
        if constexpr (ALIGN_EPI) { if (wr == 0) PG8_BAR; }
        E(acc, cur, wr, wc, fr, fq);
        if (!has_next) break;
#pragma unroll
        for (int a = 0; a < 2; ++a)
#pragma unroll
            for (int b = 0; b < 2; ++b)
#pragma unroll
                for (int m = 0; m < 4; ++m)
#pragma unroll
                    for (int n = 0; n < 2; ++n) acc[a][b][m][n] = (f32x4){0.f, 0.f, 0.f, 0.f};
        cur = nxt; cB = nB; ++ui;
#pragma unroll
        for (int _h = 0; _h < 2; ++_h)
#pragma unroll
            for (int _i = 0; _i < 2; ++_i) offC[_h][_i] = offN[_h][_i];
        if constexpr (ALIGN_EPI) { if (wr == 1) PG8_BAR; }
    }
    PG8_WAIT_V(0);
    if constexpr (!ALIGN_EPI) { if (wr == 0) PG8_BAR; }
    PG8_BAR;
#undef PG8_SA
#undef PG8_SB
#undef PG8_STAGE
#undef PG8_STAGE_A
#undef PG8_LDA
#undef PG8_LDB
#undef PG8_MMA
#undef PG8_WAIT_V
#undef PG8_WAIT_L
#undef PG8_BAR
#undef PG8_SCHED
#undef PG8_OFFS
}
}

#define XB_TMO      128
#define XB_XCNT(j)  (256  + 64 * (j))
#define XB_XSUB(j)  (1280 + 64 * (j))
#define XB_XGEN(j)  (2304 + 64 * (j))
#define XB_TOP      3328
#define XB_TOPGEN   3392
#define XCD_BAR_WORDS 3456
#define XB_SPIN_CAP (1u << 22)
__device__ __forceinline__ unsigned xb_ld(unsigned* p)              { return __hip_atomic_load(p, __ATOMIC_RELAXED, __HIP_MEMORY_SCOPE_AGENT); }
__device__ __forceinline__ unsigned xb_add(unsigned* p, unsigned v) { return __hip_atomic_fetch_add(p, v, __ATOMIC_RELAXED, __HIP_MEMORY_SCOPE_AGENT); }
__device__ __forceinline__ unsigned xb_xcc_id() { return (unsigned)__builtin_amdgcn_s_getreg((3 << 11) | 20) & 0xFu; }
#define XB_SPIN(cond, bar) do { unsigned _sp = 0; while (cond) { __builtin_amdgcn_s_sleep(1); \
    if ((++_sp & 255u) == 0u) { if (xb_ld(&(bar)[XB_TMO])) break; if (_sp > XB_SPIN_CAP) { atomicAdd(&(bar)[XB_TMO], 1u); break; } } } } while (0)
struct XcdBarrier { unsigned* bar; unsigned x; volatile LAS unsigned* st; };
__device__ __forceinline__ XcdBarrier xcd_barrier_post(unsigned* bar, volatile LAS unsigned* st) {
    XcdBarrier b; b.bar = bar; b.x = xb_xcc_id(); b.st = st;
    if (threadIdx.x == 0) (void)xb_add(&bar[XB_XCNT(b.x)], 1u);
    return b;
}
__device__ __forceinline__ void xcd_barrier_complete(unsigned* bar, unsigned x, unsigned& nloc, unsigned& nx) {
    const unsigned G = gridDim.x * gridDim.y * gridDim.z;
    unsigned sum, cnt, mine, sp = 0u;
    for (;;) {
        sum = 0u; cnt = 0u; mine = 0u;
#pragma unroll
        for (unsigned j = 0; j < 16; ++j) { const unsigned c = xb_ld(&bar[XB_XCNT(j)]); sum += c; cnt += (c > 0u) ? 1u : 0u; mine = (j == x) ? c : mine; }
        if (sum == G) break;
        __builtin_amdgcn_s_sleep(1);
        if ((++sp & 255u) == 0u) { if (xb_ld(&bar[XB_TMO])) break; if (sp > XB_SPIN_CAP) { atomicAdd(&bar[XB_TMO], 1u); break; } }
    }
    nloc = mine > 0u ? mine : 1u; nx = cnt > 0u ? cnt : 1u;
}
__device__ __forceinline__ void xcd_barrier(const XcdBarrier& b) {
    asm volatile("s_waitcnt vmcnt(0)" ::: "memory");
    __syncthreads();
    if (threadIdx.x == 0) {
        unsigned* bar = b.bar;
        __builtin_amdgcn_s_waitcnt(0);
        unsigned nloc = b.st[0], nx = b.st[1];
        if (nloc == 0u) { xcd_barrier_complete(bar, b.x, nloc, nx); b.st[0] = nloc; b.st[1] = nx; }
        const unsigned old = xb_add(&bar[XB_XSUB(b.x)], 1u);
        const unsigned gen = old / nloc;
        if (old + 1u == (gen + 1u) * nloc) {
            __builtin_amdgcn_fence(__ATOMIC_RELEASE, "agent");
            asm volatile("s_waitcnt vmcnt(0)" ::: "memory");
            const unsigned og = xb_add(&bar[XB_TOP], 1u);
            const unsigned tg = og / nx;
            if (og + 1u == (tg + 1u) * nx) xb_add(&bar[XB_TOPGEN], 1u);
            else XB_SPIN(xb_ld(&bar[XB_TOPGEN]) == tg, bar);
            __builtin_amdgcn_fence(__ATOMIC_ACQUIRE, "agent");
            xb_add(&bar[XB_XGEN(b.x)], 1u);
            asm volatile("s_waitcnt vmcnt(0)" ::: "memory");
        } else {
            XB_SPIN(xb_ld(&bar[XB_XGEN(b.x)]) == gen, bar);
            __builtin_amdgcn_fence(__ATOMIC_ACQUIRE, "agent");
            asm volatile("s_waitcnt vmcnt(0)" ::: "memory");
        }
    }
    __syncthreads();
}

struct Args { const float* in[38]; float* out; unsigned char* ws; int ph_lo, ph_hi; };
enum { I_X = 0, I_MEM, I_LN1, I_WIN, I_PK, I_W1K, I_W2K, I_PV, I_W1V, I_W2V, I_NSAG, I_MU, I_W0, I_WUP, I_A0, I_AUP, I_GUP, I_KK, I_KA, I_RK, I_LNXG, I_LNXB,
       I_WOUT, I_LNMEM, I_LN2, I_WQ, I_WK, I_WV, I_WO, I_LN3, I_RGW, I_RGB, I_REW, I_REB, I_MG, I_MU2, I_MD, I_LNF };

__device__ __forceinline__ void tr_item(const float* src, int sld, int k0, int scol0, int nvalid, f16* dst, size_t drow0, int dld, LAS float* scr, int lane) {
    const int nl = lane & 31;
#pragma unroll 8
    for (int i = 0; i < 32; ++i) { const int kk = 2 * i + (lane >> 5); scr[kk * 33 + nl] = (nl < nvalid) ? src[(size_t)(k0 + kk) * sld + scol0 + nl] : 0.f; }
    LDS_WAIT(); asm volatile("" ::: "memory");
    const int c = lane & 7;
#pragma unroll
    for (int j = 0; j < 4; ++j) { const int n = (lane >> 3) + 8 * j; const LAS float* s = scr + (8 * c) * 33 + n;
        u32x4 o; o.x = pkh(s[0 * 33], s[1 * 33]); o.y = pkh(s[2 * 33], s[3 * 33]); o.z = pkh(s[4 * 33], s[5 * 33]); o.w = pkh(s[6 * 33], s[7 * 33]);
        *(u32x4*)(dst + (drow0 + n) * (size_t)dld + k0 + 8 * c) = o; }
    LDS_WAIT(); asm volatile("" ::: "memory");
}
__device__ __forceinline__ void tr_matrix(const float* src, int K, int N, f16* dst, LAS float* scr, int gw, int NGW, int lane) {
    const int nblk = N / 32, items = (K / 64) * nblk;
    for (int it = gw; it < items; it += NGW) { const int kb = it / nblk, nb = it % nblk; tr_item(src, N, kb * 64, nb * 32, 32, dst, (size_t)nb * 32, K, scr, lane); }
}
__device__ __forceinline__ void rms_row(const float* xrow, const float* gain, f16* o16, int lane) {
    const f32x4* xr = (const f32x4*)xrow + lane; f32x4 v[8]; float s = 0.f;
#pragma unroll
    for (int j = 0; j < 8; ++j) { v[j] = xr[64 * j]; s += v[j].x * v[j].x + v[j].y * v[j].y + v[j].z * v[j].z + v[j].w * v[j].w; }
    const float rstd = rsqrtf(wave_sum(s) * (1.f / D) + EPS);
    const f32x4* gr = (const f32x4*)gain + lane;
    u32x2* o8 = (u32x2*)o16 + lane;
#pragma unroll
    for (int j = 0; j < 8; ++j) { const f32x4 gg = gr[64 * j]; u32x2 w; w.x = pkh(v[j].x * rstd * gg.x, v[j].y * rstd * gg.y); w.y = pkh(v[j].z * rstd * gg.z, v[j].w * rstd * gg.w); o8[64 * j] = w; }
}

__device__ __forceinline__ void p0_prologue(const Args& a, LAS unsigned char* lds) {
    const int tid = threadIdx.x, lane = tid & 63, wave = tid >> 6;
    const int gw = blockIdx.x * 8 + wave, NGW = gridDim.x * 8;
    LAS float* scr = (LAS float*)(lds + wave * 16384);
    unsigned char* ws = a.ws;
    { f16* dst = (f16*)(ws + WS_WIN); const float* src = a.in[I_WIN];
      const int nblk = NZ / 32, items = (D / 64) * nblk;
      for (int it = gw; it < items; it += NGW) { const int kb = it / nblk, nb = it % nblk, n0 = nb * 32;
          int sc = 0, nv = 32; if (n0 < 2560) sc = n0; else if (n0 < 5920) sc = n0 + 24; else if (n0 == 5920) { sc = 2560; nv = 24; } else { sc = 0; nv = 0; }
          tr_item(src, 5944, kb * 64, sc, nv, dst, (size_t)n0, D, scr, lane); } }
    tr_matrix(a.in[I_WOUT], D, D, (f16*)(ws + WS_WOUT), scr, gw, NGW, lane);
    tr_matrix(a.in[I_WK], D, D, (f16*)(ws + WS_WKT), scr, gw, NGW, lane);
    tr_matrix(a.in[I_WV], D, D, (f16*)(ws + WS_WVT), scr, gw, NGW, lane);
    tr_matrix(a.in[I_WO], D, D, (f16*)(ws + WS_WOT), scr, gw, NGW, lane);
    { const f32x4* s = (const f32x4*)a.in[I_WQ]; u32x2* d = (u32x2*)(ws + WS_WQ16);
      for (size_t i = (size_t)blockIdx.x * 512 + tid; i < (size_t)D * D / 4; i += (size_t)gridDim.x * 512) { const f32x4 v = s[i]; u32x2 w; w.x = pkh(v.x, v.y); w.y = pkh(v.z, v.w); d[i] = w; } }
    { f16* dst = (f16*)(ws + WS_WGU); const int items = NEXP * (D / 64) * 16;
      for (int it = gw; it < items; it += NGW) { const int e = it / ((D / 64) * 16), r = it % ((D / 64) * 16), kb = r / 16, nb = r % 16, j0 = nb * 32, jt = j0 / 256, jj = j0 % 256;
          const float* src = (jj < 128 ? a.in[I_MG] : a.in[I_MU2]) + (size_t)e * D * EFF; const int sc = jt * 128 + (jj & 127);
          tr_item(src, EFF, kb * 64, sc, 32, dst, (size_t)e * 512 + j0, D, scr, lane); } }
    { f16* dst = (f16*)(ws + WS_WD); const int items = NEXP * (EFF / 64) * (D / 32);
      for (int it = gw; it < items; it += NGW) { const int e = it / ((EFF / 64) * (D / 32)), r = it % ((EFF / 64) * (D / 32)), kb = r / (D / 32), nb = r % (D / 32);
          tr_item(a.in[I_MD] + (size_t)e * EFF * D, D, kb * 64, nb * 32, 32, dst, (size_t)e * D + nb * 32, EFF, scr, lane); } }
    for (int m = gw; m < T; m += NGW) rms_row(a.in[I_X] + (size_t)m * D, a.in[I_LN1], (f16*)(ws + WS_H) + (size_t)m * D, lane);
    for (int m = gw; m < 256; m += NGW) rms_row(a.in[I_MEM] + (size_t)m * D, a.in[I_LNMEM], (f16*)(ws + WS_MEMN) + (size_t)m * D, lane);
}

__device__ __forceinline__ float gelu_tanh(float x) { const float u = 0.7978845608028654f * (x + 0.044715f * x * x * x); return 0.5f * x * (1.f + tanhf(u)); }
__device__ __forceinline__ void p_compress(const Args& a, LAS unsigned char* lds) {
    const int tid = threadIdx.x, grp = tid >> 7, j = tid & 127;
    LAS float* in = (LAS float*)(lds + grp * 20480); LAS float* hid = in + 4096;
    const f16* z = (const f16*)(a.ws + WS_Z);
    const int NIT = 2 * NCMP * 2;
    for (int base = blockIdx.x * 4; base < NIT; base += gridDim.x * 4) {
        const int item = base + grp; const bool valid = item < NIT;
        const int kv = valid ? item / (NCMP * 2) : 0, r = valid ? item % (NCMP * 2) : 0, c = r >> 1, g = r & 1;
        const float* pos = a.in[kv ? I_PV : I_PK]; const float* w1 = a.in[kv ? I_W1V : I_W1K]; const float* w2 = a.in[kv ? I_W2V : I_W2K];
        __syncthreads();
        for (int i = j; i < 4096; i += 128) { const int l = i >> 7, d = i & 127; in[i] = (float)z[(size_t)(16 * c + l) * NZ + (kv ? ZVC : ZKC) + g * 128 + d] + pos[i]; }
        __syncthreads();
        float acc = 0.f;
        for (int i = 0; i < 4096; i += 4) { const f32x4 x4 = *(const LAS f32x4*)(in + i);
            acc += x4.x * w1[(size_t)i * 128 + j] + x4.y * w1[(size_t)(i + 1) * 128 + j] + x4.z * w1[(size_t)(i + 2) * 128 + j] + x4.w * w1[(size_t)(i + 3) * 128 + j]; }
        hid[j] = gelu_tanh(acc);
        __syncthreads();
        float o = 0.f;
        for (int i = 0; i < 128; ++i) o += hid[i] * w2[i * 128 + j];
        if (valid) ((float*)(a.ws + (kv ? WS_VCMP : WS_KCMP)))[((size_t)c * 2 + g) * 128 + j] = o;
    }
}

__device__ __forceinline__ void p_nsa_naive(const Args& a, LAS unsigned char* lds, int bid, int nb) {
    const int tid = threadIdx.x, half = tid >> 8, t256 = tid & 255, p = t256 >> 6, lane = tid & 63;
    LAS float* qs = (LAS float*)(lds + half * 24576); LAS float* pc = qs + 512; LAS float* psel = pc + 4096; LAS int* sl = (LAS int*)(psel + 256);
    const f16* z = (const f16*)(a.ws + WS_Z); const float* kcmp = (const float*)(a.ws + WS_KCMP); const float* vcmp = (const float*)(a.ws + WS_VCMP);
    float* onsa = (float*)(a.ws + WS_ONSA);
    const float scale = 0.08838834764831845f;
    for (int base = bid * 2; base < T * 2; base += nb * 2) {
        const int item = base + half; const int t = item >> 1, g = item & 1;
        const f16* zrow = z + (size_t)t * NZ; const int hq = g * 4 + p;
        __syncthreads();
        for (int d = lane; d < 128; d += 64) qs[p * 128 + d] = (float)zrow[ZQ + hq * 128 + d];
        LDS_WAIT();
        const int nvalid = t >= 31 ? ((t - 31) >> 4) + 1 : 0;
        float mx = -INFINITY;
        for (int c = lane; c < nvalid; c += 64) { const f32x4* kr = (const f32x4*)(kcmp + ((size_t)c * 2 + g) * 128); float s = 0.f;
#pragma unroll 8
            for (int d4 = 0; d4 < 32; ++d4) { const f32x4 k4 = kr[d4]; const f32x4 q4 = *(const LAS f32x4*)(qs + p * 128 + d4 * 4); s += q4.x * k4.x + q4.y * k4.y + q4.z * k4.z + q4.w * k4.w; }
            s *= scale; pc[p * 1024 + c] = s; mx = fmaxf(mx, s); }
        mx = wave_max(mx);
        float sum = 0.f;
        for (int c = lane; c < nvalid; c += 64) { const float e = __expf(pc[p * 1024 + c] - mx); pc[p * 1024 + c] = e; sum += e; }
        sum = wave_sum(sum); const float inv = 1.f / fmaxf(sum, 1e-30f);
        for (int c = lane; c < 1024; c += 64) pc[p * 1024 + c] = c < nvalid ? pc[p * 1024 + c] * inv : 0.f;
        LDS_WAIT();
        float oc0 = 0.f, oc1 = 0.f;
#pragma unroll 8
        for (int c = 0; c < nvalid; ++c) { const float pv = pc[p * 1024 + c]; const float* vr = vcmp + ((size_t)c * 2 + g) * 128; oc0 += pv * vr[lane]; oc1 += pv * vr[lane + 64]; }
        __syncthreads();
        { const int s = t256; float acc = 0.f;
#pragma unroll
          for (int pp = 0; pp < 4; ++pp) { const LAS float* P = pc + pp * 1024 + 4 * s; acc += P[0] + P[1] + P[2] + 0.5f * P[3] + (s > 0 ? 0.5f * P[-1] : 0.f); }
          psel[s] = acc; }
        __syncthreads();
        const int blk = t >> 6;
        if (p == 0) {
            int n = 0;
            if (lane == 0) { sl[1 + n] = 0; } n++;
            if (blk >= 1) { if (lane == 0) sl[1 + n] = blk; n++; }
            if (blk >= 2) { if (lane == 0) sl[1 + n] = blk - 1; n++; }
            const int ncand = blk >= 3 ? blk - 2 : 0;
            if (ncand <= 13) { for (int s = 1 + lane; s <= blk - 2; s += 64) sl[1 + n + (s - 1)] = s; n += ncand; }
            else {
                float v[4];
#pragma unroll
                for (int jj = 0; jj < 4; ++jj) { const int s = 1 + lane + 64 * jj; v[jj] = (s <= blk - 2) ? psel[s] : -1.f; }
                for (int it = 0; it < 13; ++it) {
                    float bv = v[0]; int bi = 1 + lane;
#pragma unroll
                    for (int jj = 1; jj < 4; ++jj) { if (v[jj] > bv) { bv = v[jj]; bi = 1 + lane + 64 * jj; } }
#pragma unroll
                    for (int o = 1; o < 64; o <<= 1) { const float ov = __shfl_xor(bv, o); const int oi = __shfl_xor(bi, o); if (ov > bv || (ov == bv && oi < bi)) { bv = ov; bi = oi; } }
                    if (lane == 0) sl[1 + n] = bi; n++;
#pragma unroll
                    for (int jj = 0; jj < 4; ++jj) if (bi == 1 + lane + 64 * jj) v[jj] = -1.f;
                }
            }
            if (lane == 0) sl[0] = n;
            LDS_WAIT();
        }
        __syncthreads();
        const int nsel = sl[0];
        mx = -INFINITY;
        for (int n = 0; n < nsel; ++n) { const int kpos = sl[1 + n] * 64 + lane; float s = -INFINITY;
            if (kpos <= t) { const f16x8* kr = (const f16x8*)(z + (size_t)kpos * NZ + ZKS + g * 128); s = 0.f;
#pragma unroll 4
                for (int d8 = 0; d8 < 16; ++d8) { const f16x8 k8 = kr[d8]; const LAS float* q = qs + p * 128 + d8 * 8;
#pragma unroll
                    for (int e = 0; e < 8; ++e) s += q[e] * (float)k8[e]; }
                s *= scale; }
            pc[p * 1024 + n * 64 + lane] = s; mx = fmaxf(mx, s); }
        mx = wave_max(mx);
        sum = 0.f;
        for (int n = 0; n < nsel; ++n) { const float s = pc[p * 1024 + n * 64 + lane]; const float e = (s == -INFINITY) ? 0.f : __expf(s - mx); pc[p * 1024 + n * 64 + lane] = e; sum += e; }
        sum = wave_sum(sum); const float invs = 1.f / fmaxf(sum, 1e-30f);
        LDS_WAIT();
        float os0 = 0.f, os1 = 0.f;
        for (int n = 0; n < nsel; ++n) { const int k0 = sl[1 + n] * 64;
            for (int jj = 0; jj < 64; ++jj) { const int kpos = k0 + jj; if (kpos > t) break; const float pv = pc[p * 1024 + n * 64 + jj]; const f16* vr = z + (size_t)kpos * NZ + ZVS + g * 128;
                os0 += pv * (float)vr[lane]; os1 += pv * (float)vr[lane + 64]; } }
        const int lo = t >= 511 ? t - 511 : 0, nw = t - lo + 1;
        mx = -INFINITY;
        for (int i = lane; i < nw; i += 64) { const f16x8* kr = (const f16x8*)(z + (size_t)(lo + i) * NZ + ZKW + g * 128); float s = 0.f;
#pragma unroll 4
            for (int d8 = 0; d8 < 16; ++d8) { const f16x8 k8 = kr[d8]; const LAS float* q = qs + p * 128 + d8 * 8;
#pragma unroll
                for (int e = 0; e < 8; ++e) s += q[e] * (float)k8[e]; }
            s *= scale; pc[p * 1024 + i] = s; mx = fmaxf(mx, s); }
        mx = wave_max(mx);
        sum = 0.f;
        for (int i = lane; i < nw; i += 64) { const float e = __expf(pc[p * 1024 + i] - mx); pc[p * 1024 + i] = e; sum += e; }
        sum = wave_sum(sum); const float invw = 1.f / fmaxf(sum, 1e-30f);
        LDS_WAIT();
        float ow0 = 0.f, ow1 = 0.f;
#pragma unroll 8
        for (int i = 0; i < nw; ++i) { const float pv = pc[p * 1024 + i]; const f16* vr = z + (size_t)(lo + i) * NZ + ZVW + g * 128; ow0 += pv * (float)vr[lane]; ow1 += pv * (float)vr[lane + 64]; }
        const float gc = sigmoidf_((float)zrow[ZGL + 0 * 8 + hq]), gs = sigmoidf_((float)zrow[ZGL + 1 * 8 + hq]), gw_ = sigmoidf_((float)zrow[ZGL + 2 * 8 + hq]);
        onsa[(size_t)t * 1024 + hq * 128 + lane] = gc * oc0 + gs * os0 * invs + gw_ * ow0 * invw;
        onsa[(size_t)t * 1024 + hq * 128 + lane + 64] = gc * oc1 + gs * os1 * invs + gw_ * ow1 * invw;
    }
}

__device__ __forceinline__ void p_rwkv_naive(const Args& a, LAS unsigned char* lds, int h) {
    const int tid = threadIdx.x; if (tid >= 64) return; const int i = tid;
    LAS float* Wl = (LAS float*)lds;
    LAS float* vin = Wl + 288 * 64;
    LAS float* vw = vin + 288; LAS float* vkk = vw + 64; LAS float* vb = vkk + 64; LAS float* vkp = vb + 64; LAS float* vr = vkp + 64;
    const int ch = h * 64 + i;
    for (int j = 0; j < 64; ++j) { Wl[j * 64 + i] = a.in[I_WUP][j * 1024 + ch]; Wl[(64 + j) * 64 + i] = a.in[I_AUP][j * 1024 + ch]; }
    for (int j = 0; j < 160; ++j) Wl[(128 + j) * 64 + i] = a.in[I_GUP][j * 1024 + ch];
    const float* mu = a.in[I_MU];
    const float mu_r = mu[ch], mu_k = mu[1024 + ch], mu_v = mu[2048 + ch], mu_wd = mu[3072 + i], mu_ad = mu[3136 + i], mu_g0 = mu[3200 + i], mu_g1 = mu[3264 + i], mu_g2 = (i < 32) ? mu[3328 + i] : 0.f;
    const float w0 = a.in[I_W0][ch], a0 = a.in[I_A0][ch], k_k = a.in[I_KK][ch], k_a = a.in[I_KA][ch], r_k = a.in[I_RK][ch], lg = a.in[I_LNXG][ch], lb = a.in[I_LNXB][ch];
    const f16* z = (const f16*)(a.ws + WS_Z); f16* mix = (f16*)(a.ws + WS_MIX);
    float S[64];
#pragma unroll
    for (int j = 0; j < 64; ++j) S[j] = 0.f;
    float pr = 0.f, pk = 0.f, pv = 0.f, pwd = 0.f, pad = 0.f, pg0 = 0.f, pg1 = 0.f, pg2 = 0.f;
    const f16* zr = z;
    float cr = (float)zr[ZR + ch], ck = (float)zr[ZK + ch], cv = (float)zr[ZV + ch], cwd = (float)zr[ZWD + i], cad = (float)zr[ZAD + i], cg0 = (float)zr[ZGD + i], cg1 = (float)zr[ZGD + 64 + i], cg2 = (i < 32) ? (float)zr[ZGD + 128 + i] : 0.f;
    LDS_WAIT();
    for (int t = 0; t < T; ++t) {
        float nr = 0.f, nk = 0.f, nv = 0.f, nwd = 0.f, nad = 0.f, ng0 = 0.f, ng1 = 0.f, ng2 = 0.f;
        if (t + 1 < T) { const f16* zn = z + (size_t)(t + 1) * NZ; nr = (float)zn[ZR + ch]; nk = (float)zn[ZK + ch]; nv = (float)zn[ZV + ch]; nwd = (float)zn[ZWD + i]; nad = (float)zn[ZAD + i];
            ng0 = (float)zn[ZGD + i]; ng1 = (float)zn[ZGD + 64 + i]; ng2 = (i < 32) ? (float)zn[ZGD + 128 + i] : 0.f; }
        const float r = cr + (pr - cr) * mu_r, k = ck + (pk - ck) * mu_k, v = cv + (pv - cv) * mu_v;
        const float wd = cwd + (pwd - cwd) * mu_wd, ad = cad + (pad - cad) * mu_ad, g0 = cg0 + (pg0 - cg0) * mu_g0, g1 = cg1 + (pg1 - cg1) * mu_g1, g2 = cg2 + (pg2 - cg2) * mu_g2;
        vin[i] = tanhf(wd); vin[64 + i] = ad; vin[128 + i] = sigmoidf_(g0); vin[192 + i] = sigmoidf_(g1); if (i < 32) vin[256 + i] = sigmoidf_(g2);
        LDS_WAIT();
        float wpre = w0, apre = a0, gg = 0.f;
#pragma unroll 8
        for (int j = 0; j < 64; ++j) { wpre += vin[j] * Wl[j * 64 + i]; apre += vin[64 + j] * Wl[(64 + j) * 64 + i]; }
#pragma unroll 8
        for (int j = 0; j < 160; ++j) gg += vin[128 + j] * Wl[(128 + j) * 64 + i];
        const float y0 = -wpre; const float sp = fmaxf(y0, 0.f) + log1pf(__expf(-fabsf(y0)));
        const float wlog = -sp - 0.5f; const float dec = __expf(-__expf(wlog));
        const float av = sigmoidf_(apre);
        const float kkr = k * k_k; const float ss = wave_sum(kkr * kkr); const float kk = kkr * rsqrtf(fmaxf(ss, 1e-24f));
        const float kp = k * (1.f + (av - 1.f) * k_a);
        vw[i] = dec; vkk[i] = kk; vb[i] = kk * av; vkp[i] = kp; vr[i] = r;
        LDS_WAIT();
        float sa = 0.f;
#pragma unroll
        for (int j = 0; j < 64; j += 4) { const f32x4 k4 = *(const LAS f32x4*)(vkk + j); sa -= S[j] * k4.x + S[j + 1] * k4.y + S[j + 2] * k4.z + S[j + 3] * k4.w; }
        float y = 0.f;
#pragma unroll
        for (int j = 0; j < 64; j += 4) { const f32x4 w4 = *(const LAS f32x4*)(vw + j), b4 = *(const LAS f32x4*)(vb + j), p4 = *(const LAS f32x4*)(vkp + j), r4 = *(const LAS f32x4*)(vr + j);
            S[j] = S[j] * w4.x + sa * b4.x + v * p4.x; S[j + 1] = S[j + 1] * w4.y + sa * b4.y + v * p4.y; S[j + 2] = S[j + 2] * w4.z + sa * b4.z + v * p4.z; S[j + 3] = S[j + 3] * w4.w + sa * b4.w + v * p4.w;
            y += S[j] * r4.x + S[j + 1] * r4.y + S[j + 2] * r4.z + S[j + 3] * r4.w; }
        const float mean = wave_sum(y) * (1.f / 64.f); const float dv = y - mean; const float var = wave_sum(dv * dv) * (1.f / 64.f);
        const float yn = dv * rsqrtf(var + 64e-5f) * lg + lb;
        const float bonus = wave_sum(r * kp * r_k) * v;
        mix[(size_t)t * D + 1024 + ch] = (f16)((yn + bonus) * gg);
        pr = cr; pk = ck; pv = cv; pwd = cwd; pad = cad; pg0 = cg0; pg1 = cg1; pg2 = cg2;
        cr = nr; ck = nk; cv = nv; cwd = nwd; cad = nad; cg0 = ng0; cg1 = ng1; cg2 = ng2;
        LDS_WAIT();
    }
}

__device__ __forceinline__ void p_router(const Args& a, LAS unsigned char* lds) {
    const int tid = threadIdx.x, lane = tid & 63, wave = tid >> 6, gw = blockIdx.x * 8 + wave, NGW = gridDim.x * 8;
    const float* x2 = (const float*)(a.ws + WS_X1); f16* h3 = (f16*)a.out;
    unsigned* ctl = (unsigned*)(a.ws + WS_CTL);
    int* tke = (int*)(a.ws + WS_TOK + TK_E); float* tkw = (float*)(a.ws + WS_TOK + TK_W);
    const float* Wg = a.in[I_RGW]; const float* We = a.in[I_REW];
    for (int m = gw; m < T; m += NGW) {
        const f32x4* xr = (const f32x4*)(x2 + (size_t)m * D) + lane; f32x4 v[8]; float s = 0.f;
#pragma unroll
        for (int j = 0; j < 8; ++j) { v[j] = xr[64 * j]; s += v[j].x * v[j].x + v[j].y * v[j].y + v[j].z * v[j].z + v[j].w * v[j].w; }
        const float rstd = rsqrtf(wave_sum(s) * (1.f / D) + EPS);
        const f32x4* gr = (const f32x4*)a.in[I_LN3] + lane; u32x2* o8 = (u32x2*)(h3 + (size_t)m * D) + lane;
#pragma unroll
        for (int j = 0; j < 8; ++j) { const f32x4 gg = gr[64 * j]; v[j].x *= rstd * gg.x; v[j].y *= rstd * gg.y; v[j].z *= rstd * gg.z; v[j].w *= rstd * gg.w;
            u32x2 w; w.x = pkh(v[j].x, v[j].y); w.y = pkh(v[j].z, v[j].w); o8[64 * j] = w; }
        LAS float* xs = (LAS float*)(lds + wave * 8192);
#pragma unroll
        for (int j = 0; j < 8; ++j) *(LAS f32x4*)(xs + j * 256 + lane * 4) = v[j];
        LDS_WAIT();
        float lg[4] = {0.f, 0.f, 0.f, 0.f};
#pragma unroll 2
        for (int k = 0; k < 32; ++k) { const int i = k * 64 + lane; const float xv = xs[i]; const f32x4 w4 = *(const f32x4*)(Wg + (size_t)i * 4);
            lg[0] += xv * w4.x; lg[1] += xv * w4.y; lg[2] += xv * w4.z; lg[3] += xv * w4.w; }
#pragma unroll
        for (int c = 0; c < 4; ++c) lg[c] = wave_sum(lg[c]) + a.in[I_RGB][c];
        int gi = 0; float gm = lg[0];
#pragma unroll
        for (int c = 1; c < 4; ++c) if (lg[c] > gm) { gm = lg[c]; gi = c; }
        float gs = 0.f;
#pragma unroll
        for (int c = 0; c < 4; ++c) gs += __expf(lg[c] - gm);
        const float pg = 1.f / gs;
        float le[8] = {0.f, 0.f, 0.f, 0.f, 0.f, 0.f, 0.f, 0.f};
#pragma unroll 2
        for (int k = 0; k < 32; ++k) { const int i = k * 64 + lane; const float xv = xs[i]; const f32x4* wp = (const f32x4*)(We + (size_t)i * 32 + gi * 8); const f32x4 wa = wp[0], wb = wp[1];
            le[0] += xv * wa.x; le[1] += xv * wa.y; le[2] += xv * wa.z; le[3] += xv * wa.w; le[4] += xv * wb.x; le[5] += xv * wb.y; le[6] += xv * wb.z; le[7] += xv * wb.w; }
#pragma unroll
        for (int c = 0; c < 8; ++c) le[c] = wave_sum(le[c]) + a.in[I_REB][gi * 8 + c];
        LDS_WAIT();
        int e1 = 0; float m1 = le[0];
#pragma unroll
        for (int c = 1; c < 8; ++c) if (le[c] > m1) { m1 = le[c]; e1 = c; }
        int e2 = -1; float m2 = -INFINITY;
#pragma unroll
        for (int c = 0; c < 8; ++c) if (c != e1 && le[c] > m2) { m2 = le[c]; e2 = c; }
        const float p1 = 1.f, p2 = __expf(m2 - m1);
        const float w1 = pg * p1 / (p1 + p2), w2 = pg * p2 / (p1 + p2);
        if (lane == 0) { const int E1 = gi * 8 + e1, E2 = gi * 8 + e2; tke[m * 2] = E1; tke[m * 2 + 1] = E2; tkw[m * 2] = w1; tkw[m * 2 + 1] = w2;
            atomicAdd(&ctl[CW_CNT + E1], 1u); atomicAdd(&ctl[CW_CNT + E2], 1u); }
    }
}
__device__ __forceinline__ void p_offsets(const Args& a) {
    if (blockIdx.x != 0) return;
    unsigned* ctl = (unsigned*)(a.ws + WS_CTL); int* stok = (int*)(a.ws + WS_TOK + TK_STOK); float* sw = (float*)(a.ws + WS_TOK + TK_SW);
    const int tid = threadIdx.x;
    if (tid == 0) {
        int off = 0, ngu = 0, ndn = 0; int2* ugu = (int2*)(ctl + CW_UGU); int2* udn = (int2*)(ctl + CW_UDN);
        for (int e = 0; e < NEXP; ++e) { const int n = (int)ctl[CW_CNT + e]; ctl[CW_OFF + e] = (unsigned)off; const int nt = (n + 255) / 256;
            for (int rt = 0; rt < nt; ++rt) { const int pm = off / 256 + rt; for (int jt = 0; jt < 2; ++jt) ugu[ngu++] = make_int2(pm, e * 2 + jt); for (int jt = 0; jt < 8; ++jt) udn[ndn++] = make_int2(pm, e * 8 + jt); }
            off += nt * 256; }
        ctl[CW_OFF + NEXP] = (unsigned)off; ctl[CW_NT] = (unsigned)(off / 256); ctl[CW_NGU] = (unsigned)ngu; ctl[CW_NDN] = (unsigned)ndn;
    }
    __syncthreads();
    for (int e = 0; e < NEXP; ++e) { const int n = (int)ctl[CW_CNT + e], off = (int)ctl[CW_OFF + e], end = (int)ctl[CW_OFF + e + 1];
        for (int s = off + n + tid; s < end; s += 512) { stok[s] = 0; sw[s] = 0.f; } }
}
__device__ __forceinline__ void p_slots(const Args& a) {
    unsigned* ctl = (unsigned*)(a.ws + WS_CTL);
    const int* tke = (const int*)(a.ws + WS_TOK + TK_E); const float* tkw = (const float*)(a.ws + WS_TOK + TK_W); int* tks = (int*)(a.ws + WS_TOK + TK_SLOT);
    int* stok = (int*)(a.ws + WS_TOK + TK_STOK); float* sw = (float*)(a.ws + WS_TOK + TK_SW);
    for (int i = blockIdx.x * 512 + threadIdx.x; i < T * 2; i += gridDim.x * 512) { const int e = tke[i]; const int slot = (int)ctl[CW_OFF + e] + (int)atomicAdd(&ctl[CW_CUR + e], 1u);
        stok[slot] = i >> 1; sw[slot] = tkw[i]; tks[i] = slot; }
}

constexpr int NPH = 17;
__global__ void __launch_bounds__(512, 2) mega(Args args) {
    extern __shared__ __attribute__((aligned(16))) unsigned char lds_raw[];
    LAS unsigned char* lds = (LAS unsigned char*)lds_raw;
    volatile LAS unsigned* MISC = (volatile LAS unsigned*)(lds + MISC_OFF);
    const int tid = threadIdx.x, lane = tid & 63, wave = tid >> 6;
    const int gw = blockIdx.x * 8 + wave, NGW = gridDim.x * 8, G = gridDim.x;
    unsigned char* ws = args.ws;
    unsigned* ctl = (unsigned*)(ws + WS_CTL);
    for (int u = tid; u < (LDS_BYTES - RING_BYTES) / 4; u += 512) ((LAS unsigned*)(lds + RING_BYTES))[u] = 0u;
    __syncthreads();
    XcdBarrier bar; bar.bar = ctl + CW_BAR; bar.x = 0; bar.st = nullptr;
    const int lo = args.ph_lo, hi = args.ph_hi;
    if (hi - lo > 1) bar = xcd_barrier_post(ctl + CW_BAR, MISC + 8);
#ifndef PHMASK
#define PHMASK 0xFFFFFFFFu
#endif
#define IN(k) (((PHMASK >> (k)) & 1u) && lo <= (k) && (k) < hi)
#define BOTH(k) (IN(k) && IN((k) + 1))
#define GRID_BAR() xcd_barrier(bar)

    if (IN(0)) { p0_prologue(args, lds); if (BOTH(0)) GRID_BAR(); }
    if (IN(1)) {
        { pg8::Gemm g{(const f16*)(ws + WS_H), (const f16*)(ws + WS_WIN), D, D, D, nullptr}; pg8::StaticOrder S; S.init(T, NZ, G, (int)blockIdx.x);
          pg8::EpiF16 E{(f16*)(ws + WS_Z), NZ, 1.f}; pg8::gemm_phase<pg8::EpiF16, pg8::StaticOrder, true>(lds, g, S, E); }
        { const int b = blockIdx.x; const int which = b / 8;
          pg8::Gemm g{(const f16*)(ws + WS_MEMN), (const f16*)(ws + (which == 0 ? WS_WKT : WS_WVT)), D, D, D, nullptr}; pg8::StaticOrder S; S.init(256, D, 8, b < 16 ? b % 8 : 1 << 20);
          pg8::EpiF16 E{(f16*)(ws + (which == 0 ? WS_KM : WS_VM)), D, 1.f}; pg8::gemm_phase<pg8::EpiF16, pg8::StaticOrder, true>(lds, g, S, E); }
        if (BOTH(1)) GRID_BAR();
    }
    if (IN(2)) {
        p_compress(args, lds);
        __syncthreads();
        { const int b = blockIdx.x; const int grp = b / 8, c = b % 8;
          if (grp < 4) { const int h = grp;
              pg8::Gemm g{(const f16*)(ws + WS_KM) + h * 512, (const f16*)(ws + WS_WQ16) + h * 512, D, D, 512, nullptr}; pg8::StaticOrder S; S.init(256, D, 8, c);
              pg8::EpiF16 E{(f16*)(ws + WS_WQK) + (size_t)h * 256 * D, D, 0.04419417382415922f}; pg8::gemm_phase<pg8::EpiF16, pg8::StaticOrder, true>(lds, g, S, E); }
          else if (grp < 8) { const int h = grp - 4;
              pg8::Gemm g{(const f16*)(ws + WS_WOT) + h * 512, (const f16*)(ws + WS_VM) + h * 512, D, D, 512, nullptr}; pg8::StaticOrder S; S.init(D, 256, 8, c);
              pg8::EpiF16 E{(f16*)(ws + WS_VOT) + h * 256, 1024, 1.f}; pg8::gemm_phase<pg8::EpiF16, pg8::StaticOrder, true>(lds, g, S, E); } }
        if (BOTH(2)) GRID_BAR();
    }
    if (IN(3)) {
        if (G >= 32) { if (blockIdx.x < 16) p_rwkv_naive(args, lds, blockIdx.x); else p_nsa_naive(args, lds, blockIdx.x - 16, G - 16); }
        if (BOTH(3)) GRID_BAR();
    }
    if (IN(4)) { if (BOTH(4)) GRID_BAR(); }
    if (IN(5)) {
        const float* onsa = (const float*)(ws + WS_ONSA); f16* mix = (f16*)(ws + WS_MIX);
        for (int m = gw; m < T; m += NGW) { const f32x4* xr = (const f32x4*)(onsa + (size_t)m * 1024) + lane; f32x4 v[4]; float s = 0.f;
#pragma unroll
            for (int j = 0; j < 4; ++j) { v[j] = xr[64 * j]; s += v[j].x * v[j].x + v[j].y * v[j].y + v[j].z * v[j].z + v[j].w * v[j].w; }
            const float rstd = rsqrtf(wave_sum(s) * (1.f / 1024.f) + EPS); const f32x4* gr = (const f32x4*)args.in[I_NSAG] + lane; u32x2* o8 = (u32x2*)(mix + (size_t)m * D) + lane;
#pragma unroll
            for (int j = 0; j < 4; ++j) { const f32x4 gg = gr[64 * j]; u32x2 w; w.x = pkh(v[j].x * rstd * gg.x, v[j].y * rstd * gg.y); w.y = pkh(v[j].z * rstd * gg.z, v[j].w * rstd * gg.w); o8[64 * j] = w; } }
        if (BOTH(5)) GRID_BAR();
    }
    if (IN(6)) {
        pg8::Gemm g{(const f16*)(ws + WS_MIX), (const f16*)(ws + WS_WOUT), D, D, D, nullptr}; pg8::StaticOrder S; S.init(T, D, G, (int)blockIdx.x);
        pg8::EpiF32 E{(float*)(ws + WS_X1), args.in[I_X], D}; pg8::gemm_phase<pg8::EpiF32, pg8::StaticOrder, true>(lds, g, S, E);
        if (BOTH(6)) GRID_BAR();
    }
    if (IN(7)) {
        for (int m = gw; m < T; m += NGW) rms_row((const float*)(ws + WS_X1) + (size_t)m * D, args.in[I_LN2], (f16*)(ws + WS_H2) + (size_t)m * D, lane);
        if (BOTH(7)) GRID_BAR();
    }
    if (IN(8)) {
        pg8::Gemm g{(const f16*)(ws + WS_H2), (const f16*)(ws + WS_WQK), D, D, D, nullptr}; pg8::StaticOrder S; S.init(T, 1024, G, (int)blockIdx.x);
        pg8::EpiF32 E{(float*)(ws + WS_S), nullptr, 1024}; pg8::gemm_phase<pg8::EpiF32, pg8::StaticOrder, true>(lds, g, S, E);
        if (BOTH(8)) GRID_BAR();
    }
    if (IN(9)) {
        const float* Sm = (const float*)(ws + WS_S); f16* P = (f16*)(ws + WS_P);
        for (int it = gw; it < T * 4; it += NGW) { const f32x4 v = *((const f32x4*)(Sm + (size_t)it * 256) + lane);
            const float mx = wave_max(fmaxf(fmaxf(v.x, v.y), fmaxf(v.z, v.w)));
            const float e0 = __expf(v.x - mx), e1 = __expf(v.y - mx), e2 = __expf(v.z - mx), e3 = __expf(v.w - mx);
            const float inv = 1.f / wave_sum(e0 + e1 + e2 + e3);
            u32x2 w; w.x = pkh(e0 * inv, e1 * inv); w.y = pkh(e2 * inv, e3 * inv); *((u32x2*)(P + (size_t)it * 256) + lane) = w; }
        if (BOTH(9)) GRID_BAR();
    }
    if (IN(10)) {
        pg8::Gemm g{(const f16*)(ws + WS_P), (const f16*)(ws + WS_VOT), 1024, 1024, 1024, nullptr}; pg8::StaticOrder S; S.init(T, D, G, (int)blockIdx.x);
        pg8::EpiF32 E{(float*)(ws + WS_X1), (const float*)(ws + WS_X1), D}; pg8::gemm_phase<pg8::EpiF32, pg8::StaticOrder, true>(lds, g, S, E);
        if (BOTH(10)) GRID_BAR();
    }
    if (IN(11)) { p_router(args, lds); if (BOTH(11)) GRID_BAR(); }
    if (IN(12)) { p_offsets(args); if (BOTH(12)) GRID_BAR(); }
    if (IN(13)) { p_slots(args); if (BOTH(13)) GRID_BAR(); }
    if (IN(14)) {
        pg8::Gemm g{(const f16*)args.out, (const f16*)(ws + WS_WGU), D, D, D, (const int*)(ws + WS_TOK + TK_STOK)};
        pg8::TableOrder S{(const int2*)(ctl + CW_UGU), (int)ctl[CW_NGU], G, (int)blockIdx.x};
        pg8::EpiSilu E{(f16*)(ws + WS_HID)}; pg8::gemm_phase<pg8::EpiSilu, pg8::TableOrder, true>(lds, g, S, E);
        if (BOTH(14)) GRID_BAR();
    }
    if (IN(15)) {
        pg8::Gemm g{(const f16*)(ws + WS_HID), (const f16*)(ws + WS_WD), EFF, EFF, EFF, nullptr};
        pg8::TableOrder S{(const int2*)(ctl + CW_UDN), (int)ctl[CW_NDN], G, (int)blockIdx.x};
        pg8::EpiDown E{ws}; pg8::gemm_phase<pg8::EpiDown, pg8::TableOrder, true>(lds, g, S, E);
        if (BOTH(15)) GRID_BAR();
    }
    if (IN(16)) {
        const float* x2 = (const float*)(ws + WS_X1); const int* tks = (const int*)(ws + WS_TOK + TK_SLOT);
        const float* tkw = (const float*)(ws + WS_TOK + TK_W);
        for (int m = gw; m < T; m += NGW) { const int s1 = tks[m * 2], s2 = tks[m * 2 + 1]; const float w1 = tkw[m * 2], w2 = tkw[m * 2 + 1];
            const f16* y1 = (const f16*)(ws + ((s1 >> 8) < 128 ? WS_Y0 + (size_t)(s1 >> 8) * MiB : WS_Y1 + (size_t)((s1 >> 8) - 128) * MiB)) + (size_t)(s1 & 255) * D;
            const f16* y2 = (const f16*)(ws + ((s2 >> 8) < 128 ? WS_Y0 + (size_t)(s2 >> 8) * MiB : WS_Y1 + (size_t)((s2 >> 8) - 128) * MiB)) + (size_t)(s2 & 255) * D;
            const f32x4* xr = (const f32x4*)(x2 + (size_t)m * D) + lane; f32x4 v[8]; float s = 0.f;
#pragma unroll
            for (int j = 0; j < 8; ++j) { v[j] = xr[64 * j]; const f16x4 a1 = *((const f16x4*)y1 + lane + 64 * j), a2 = *((const f16x4*)y2 + lane + 64 * j);
                v[j].x += w1 * (float)a1.x + w2 * (float)a2.x; v[j].y += w1 * (float)a1.y + w2 * (float)a2.y; v[j].z += w1 * (float)a1.z + w2 * (float)a2.z; v[j].w += w1 * (float)a1.w + w2 * (float)a2.w;
                s += v[j].x * v[j].x + v[j].y * v[j].y + v[j].z * v[j].z + v[j].w * v[j].w; }
            const float rstd = rsqrtf(wave_sum(s) * (1.f / D) + EPS); const f32x4* gr = (const f32x4*)args.in[I_LNF] + lane; f32x4* o = (f32x4*)(args.out + (size_t)m * D) + lane;
#pragma unroll
            for (int j = 0; j < 8; ++j) { const f32x4 gg = gr[64 * j]; o[64 * j] = (f32x4){v[j].x * rstd * gg.x, v[j].y * rstd * gg.y, v[j].z * rstd * gg.z, v[j].w * rstd * gg.w}; } }
    }
#undef IN
#undef BOTH
#undef GRID_BAR
}

extern "C" void kernel_launch(void* const* d_in, const int* in_sizes, int n_in, void* d_out, int out_size, void* d_ws, size_t ws_size, hipStream_t stream) {
    static int grid = 0;
    if (grid == 0) {
        if (n_in != 38 || out_size != T * D || ws_size < WS_END) { fprintf(stderr, "kernel_launch: unexpected shapes (n_in %d out %d ws %zu)\n", n_in, out_size, ws_size); grid = -1; return; }
        int dev = 0, cus = 0;
        if (hipGetDevice(&dev) != hipSuccess || hipDeviceGetAttribute(&cus, hipDeviceAttributeMultiprocessorCount, dev) != hipSuccess) { grid = -1; return; }
        if (hipFuncSetAttribute((const void*)mega, hipFuncAttributeMaxDynamicSharedMemorySize, LDS_BYTES) != hipSuccess) { grid = -1; return; }
        int per_cu = 0; (void)hipOccupancyMaxActiveBlocksPerMultiprocessor(&per_cu, (const void*)mega, 512, LDS_BYTES); (void)hipGetLastError();
        grid = cus;
    }
    if (grid < 0) return;
    (void)hipMemsetAsync((char*)d_ws + WS_CTL, 0, CTL_ZERO_BYTES, stream);
    Args a{};
    for (int i = 0; i < 38; ++i) a.in[i] = (const float*)d_in[i];
    a.out = (float*)d_out; a.ws = (unsigned char*)d_ws;
#if MK_ONE_LAUNCH
    a.ph_lo = 0; a.ph_hi = NPH;
    hipLaunchKernelGGL(mega, dim3(grid), dim3(512), LDS_BYTES, stream, a);
#else
    for (int p = 0; p < NPH; ++p) { if (p == 4) continue; a.ph_lo = p; a.ph_hi = p + 1; hipLaunchKernelGGL(mega, dim3(grid), dim3(512), LDS_BYTES, stream, a); }
#endif
}
```

```cpp
#include <hip/hip_runtime.h>
#include <cstdio>
#include <cstdint>

#ifndef MK_ONE_LAUNCH
#define MK_ONE_LAUNCH 1
#endif

#define LAS __attribute__((address_space(3)))
#define GAS __attribute__((address_space(1)))
typedef _Float16 f16;
typedef _Float16 f16x8 __attribute__((ext_vector_type(8)));
typedef _Float16 f16x4 __attribute__((ext_vector_type(4)));
typedef _Float16 f16x2 __attribute__((ext_vector_type(2)));
typedef float f32x4 __attribute__((ext_vector_type(4)));
typedef float f32x2 __attribute__((ext_vector_type(2)));
typedef unsigned u32x4 __attribute__((ext_vector_type(4)));
typedef unsigned u32x2 __attribute__((ext_vector_type(2)));
typedef __bf16 bf16;
typedef __bf16 bf16x8 __attribute__((ext_vector_type(8)));
typedef __bf16 bf16x4 __attribute__((ext_vector_type(4)));

constexpr int T = 16384, D = 2048, NZ = 6144;
constexpr int ZQ = 0, ZKC = 1024, ZVC = 1280, ZKS = 1536, ZVS = 1792, ZKW = 2048, ZVW = 2304, ZR = 2560, ZK = 3584, ZV = 4608, ZWD = 5632, ZAD = 5696, ZGD = 5760, ZGL = 5920;
constexpr int NCMP = 1023;
constexpr int NEXP = 32, EFF = 256, MAXSLOT = 40960, MAXTILES = 160;
constexpr float EPS = 1e-6f;

constexpr size_t MiB = 1u << 20;
constexpr size_t WS_CTL = 0, CTL_ZERO_BYTES = 64 * 1024;
constexpr size_t WS_MEMN = 1 * MiB, WS_KM = 2 * MiB, WS_VM = 3 * MiB, WS_KCMP = 4 * MiB, WS_VCMP = 5 * MiB, WS_TOK = 6 * MiB, WS_CMPB = 7 * MiB;
constexpr size_t WS_WQK = 8 * MiB, WS_VOT = 12 * MiB, WS_WIN = 16 * MiB, WS_WOUT = 40 * MiB, WS_WQ16 = 48 * MiB, WS_WKT = 56 * MiB, WS_WVT = 64 * MiB, WS_WOT = 72 * MiB;
constexpr size_t WS_WGU = 80 * MiB, WS_WD = 144 * MiB, WS_H = 176 * MiB, WS_Z = 240 * MiB, WS_ONSA = 432 * MiB, WS_END = 512 * MiB;
constexpr size_t WS_MIX = 112 * MiB, WS_P = WS_H, WS_H2 = WS_Z, WS_X1 = 304 * MiB, WS_S = WS_ONSA, WS_HID = 16 * MiB;
constexpr size_t WS_Y0 = 176 * MiB, WS_Y1 = 432 * MiB;
constexpr size_t WS_RS = 200 * MiB, WS_SBON = 232 * MiB;
constexpr size_t WS_WUPT = WS_CMPB + 64 * 1024, WS_AUPT = WS_WUPT + 128 * 1024, WS_GUPT = WS_AUPT + 128 * 1024;
constexpr size_t RO_M = 0, RO_N = 32 * MiB, RO_Q = 64 * MiB, RO_Y = 96 * MiB;
constexpr size_t TK_E = 0, TK_W = 128 * 1024, TK_SLOT = 256 * 1024, TK_STOK = 384 * 1024, TK_SW = 576 * 1024;
constexpr int CW_BAR = 0;
constexpr int CW_Q = 3584;
constexpr int CW_CNT = 4096, CW_CUR = 4160, CW_OFF = 4224, CW_NT = 4288  , CW_NGU = 4289, CW_NDN = 4290;
constexpr int CW_UGU = 6144  , CW_UDN = 8192  ;
static_assert((CW_UDN + MAXTILES * 8 * 2) * 4 <= (int)CTL_ZERO_BYTES, "ctl");

constexpr int RING_BYTES = 131072, LDS_BYTES = 163840, MISC_OFF = LDS_BYTES - 512;

__device__ __forceinline__ unsigned pkh(float a, float b) { f16x2 v = {(f16)a, (f16)b}; return __builtin_bit_cast(unsigned, v); }
__device__ __forceinline__ float wave_sum(float v) {
#pragma unroll
    for (int o = 1; o < 64; o <<= 1) v += __shfl_xor(v, o);
    return v;
}
__device__ __forceinline__ float wave_max(float v) {
#pragma unroll
    for (int o = 1; o < 64; o <<= 1) v = fmaxf(v, __shfl_xor(v, o));
    return v;
}
#define LDS_WAIT() asm volatile("s_waitcnt lgkmcnt(0)" ::: "memory")
#define VM_WAIT() asm volatile("s_waitcnt vmcnt(0)" ::: "memory")
__device__ __forceinline__ float sigmoidf_(float x) { return 1.f / (1.f + __expf(-x)); }

namespace pg8 {
constexpr int BM = 256, BK = 64, HALF = 128, HTB = HALF * BK * 2, STAGE_BYTES = 8 * HTB, NXCD = 8, WGM = 8;
__host__ __device__ __forceinline__ int lds_byte(int r, int c) { const int st = (r >> 4) * 2 + (c >> 5), rr = r & 15, cc = c & 31, ob = rr * 64 + cc * 2; return st * 1024 + (ob ^ (((ob >> 9) & 1) << 5)); }
__host__ __device__ __forceinline__ void stage_rc(int b, int& R, int& C) { const int st = b / 1024, sb = b % 1024, swz = sb ^ (((sb >> 9) & 1) << 5); R = (st >> 1) * 16 + swz / 64; C = (st & 1) * 32 + (swz % 64) / 2; }
__host__ __device__ __forceinline__ int perm32(int rho) { const int n = rho >> 4, i = rho & 15; return 8 * (i >> 2) + 4 * n + (i & 3); }

struct Unit { int pm, pn; };
struct Gemm { const f16* A; const f16* Bt; int lda, ldb, K; const int* gather; };

struct StaticOrder {
    int nM, nN, nwg, G, c;
    __host__ __device__ void init(int M, int N, int G_, int c_) { nM = M / BM; nN = N / BM; nwg = nM * nN; G = G_; c = c_; }
    __host__ __device__ bool next(int i, Unit& u) const {
        const long L = (long)i * G + c; if (L >= nwg) return false;
        int wgid = (int)L; { const int q = nwg / NXCD, r = nwg % NXCD, xcd = wgid % NXCD, off = wgid / NXCD; wgid = (xcd < r ? xcd * (q + 1) : r * (q + 1) + (xcd - r) * q) + off; }
        const int nig = WGM * nN, gid = wgid / nig, fm = gid * WGM, gsz = (nM - fm) < WGM ? (nM - fm) : WGM;
        u.pm = fm + ((wgid % nig) % gsz); u.pn = (wgid % nig) / gsz; return true;
    }
};
struct TableOrder {
    const int2* tab; int n, G, c;
    __device__ bool next(int i, Unit& u) const { const int L = i * G + c; if (L >= n) return false; const int2 v = tab[L]; u.pm = v.x; u.pn = v.y; return true; }
};

struct EpiF16 {
    static constexpr bool PERM = true;
    f16* O; int ldc; float scale;
    __device__ __forceinline__ void operator()(const f32x4 (&acc)[2][2][4][2], const Unit& u, int wr, int wc, int fr, int fq) const {
        const int row0 = u.pm * BM + wr * 64 + fr, col0 = u.pn * BM + wc * 32 + 8 * fq;
#pragma unroll
        for (int ai = 0; ai < 2; ++ai)
#pragma unroll
            for (int m = 0; m < 4; ++m) { f16* rowp = O + (size_t)(row0 + ai * HALF + m * 16) * ldc + col0;
#pragma unroll
                for (int bj = 0; bj < 2; ++bj) { const f32x4 v0 = acc[ai][bj][m][0] * scale, v1 = acc[ai][bj][m][1] * scale;
                    u32x4 w; w.x = pkh(v0[0], v0[1]); w.y = pkh(v0[2], v0[3]); w.z = pkh(v1[0], v1[1]); w.w = pkh(v1[2], v1[3]);
                    *(u32x4*)(rowp + bj * HALF) = w; } }
    }
};
struct EpiF32 {
    static constexpr bool PERM = false;
    float* C; const float* R; int ldc;
    __device__ __forceinline__ void operator()(const f32x4 (&acc)[2][2][4][2], const Unit& u, int wr, int wc, int fr, int fq) const {
        const int row0 = u.pm * BM + wr * 64 + fr, col0 = u.pn * BM + wc * 32 + 4 * fq;
#pragma unroll
        for (int ai = 0; ai < 2; ++ai)
#pragma unroll
            for (int m = 0; m < 4; ++m) { const size_t ro = (size_t)(row0 + ai * HALF + m * 16) * ldc + col0;
#pragma unroll
                for (int bj = 0; bj < 2; ++bj)
#pragma unroll
                    for (int n = 0; n < 2; ++n) { f32x4 v = acc[ai][bj][m][n]; if (R) v = v + *(const f32x4*)(R + ro + bj * HALF + n * 16); *(f32x4*)(C + ro + bj * HALF + n * 16) = v; } }
    }
};
struct EpiSilu {
    static constexpr bool PERM = true;
    f16* O;
    __device__ __forceinline__ void operator()(const f32x4 (&acc)[2][2][4][2], const Unit& u, int wr, int wc, int fr, int fq) const {
        const int row0 = u.pm * BM + wr * 64 + fr, col0 = (u.pn & 1) * 128 + wc * 32 + 8 * fq;
#pragma unroll
        for (int ai = 0; ai < 2; ++ai)
#pragma unroll
            for (int m = 0; m < 4; ++m) { f16* rowp = O + (size_t)(row0 + ai * HALF + m * 16) * EFF + col0;
                float h[8];
#pragma unroll
                for (int n = 0; n < 2; ++n)
#pragma unroll
                    for (int e = 0; e < 4; ++e) { const float gt = acc[ai][0][m][n][e], up = acc[ai][1][m][n][e]; h[n * 4 + e] = gt / (1.f + __expf(-gt)) * up; }
                u32x4 w; w.x = pkh(h[0], h[1]); w.y = pkh(h[2], h[3]); w.z = pkh(h[4], h[5]); w.w = pkh(h[6], h[7]);
                *(u32x4*)rowp = w; }
    }
};
struct EpiDown {
    static constexpr bool PERM = true;
    unsigned char* ws;
    __device__ __forceinline__ void operator()(const f32x4 (&acc)[2][2][4][2], const Unit& u, int wr, int wc, int fr, int fq) const {
        f16* tile = (f16*)(ws + (u.pm < 128 ? WS_Y0 + (size_t)u.pm * MiB : WS_Y1 + (size_t)(u.pm - 128) * MiB));
        const int r0 = wr * 64 + fr, col0 = (u.pn & 7) * BM + wc * 32 + 8 * fq;
#pragma unroll
        for (int ai = 0; ai < 2; ++ai)
#pragma unroll
            for (int m = 0; m < 4; ++m) { f16* rowp = tile + (size_t)(r0 + ai * HALF + m * 16) * D + col0;
#pragma unroll
                for (int bj = 0; bj < 2; ++bj) { const f32x4 v0 = acc[ai][bj][m][0], v1 = acc[ai][bj][m][1];
                    u32x4 w; w.x = pkh(v0[0], v0[1]); w.y = pkh(v0[2], v0[3]); w.z = pkh(v1[0], v1[1]); w.w = pkh(v1[2], v1[3]);
                    *(u32x4*)(rowp + bj * HALF) = w; } }
    }
};

template <class Epi, class Sched, bool ALIGN_EPI>
__device__ __forceinline__ void gemm_phase(LAS unsigned char* lds, const Gemm g, const Sched& S, const Epi& E) {
    const int tid = threadIdx.x, wid = __builtin_amdgcn_readfirstlane(tid >> 6), lane = tid & 63, wr = wid >> 2, wc = wid & 3, fr = lane & 15, fq = lane >> 4;
    const int K = g.K, nt = K / BK;
    int RA[2], CA[2]; unsigned voffB[2];
#pragma unroll
    for (int i = 0; i < 2; ++i) { int R, C; stage_rc(tid * 16 + i * 8192, R, C); const int Rb = Epi::PERM ? ((R & ~31) + perm32(R & 31)) : R;
        RA[i] = R; CA[i] = C; voffB[i] = (unsigned)(Rb * g.ldb + C) * 2u; }
    const size_t kstep = (size_t)(BK * 2);
    const size_t hstepB = (size_t)HALF * g.ldb * 2, tstepB = 2 * hstepB;
    const unsigned ldsw = (unsigned)wid * 1024u;
    const int aoff = lds_byte(wr * 64 + fr, fq * 8), boff = lds_byte(wc * 32 + fr, fq * 8);
    const char* Ab = (const char*)g.A;
#define PG8_SA(b, h) (((b) * 2 + (h)) * HTB)
#define PG8_SB(b, h) ((4 + (b) * 2 + (h)) * HTB)
#define PG8_STAGE(bufoff, gbase, voff) do { _Pragma("unroll") for (int _i = 0; _i < 2; ++_i) \
        __builtin_amdgcn_global_load_lds((const unsigned*)((const char*)(gbase) + (voff)[_i]), (LAS unsigned*)(lds + (bufoff) + ldsw + _i * 8192), 16, 0, 0); } while (0)
#define PG8_STAGE_A(bufoff, OFFS, h, kb) do { _Pragma("unroll") for (int _i = 0; _i < 2; ++_i) \
        __builtin_amdgcn_global_load_lds((const unsigned*)(Ab + (size_t)(kb) + (OFFS)[h][_i]), (LAS unsigned*)(lds + (bufoff) + ldsw + _i * 8192), 16, 0, 0); } while (0)
#define PG8_LDA(dst, b, h) do { _Pragma("unroll") for (int m = 0; m < 4; ++m) _Pragma("unroll") for (int k = 0; k < 2; ++k) dst[m][k] = *(const LAS f16x8*)(lds + PG8_SA(b, h) + aoff + m * 2048 + k * 1024); } while (0)
#define PG8_LDB(dst, b, h) do { _Pragma("unroll") for (int n = 0; n < 2; ++n) _Pragma("unroll") for (int k = 0; k < 2; ++k) dst[n][k] = *(const LAS f16x8*)(lds + PG8_SB(b, h) + boff + n * 2048 + k * 1024); } while (0)
#define PG8_MMA(ai, bj, At, Bt) do { __builtin_amdgcn_s_setprio(1); _Pragma("unroll") for (int m = 0; m < 4; ++m) _Pragma("unroll") for (int n = 0; n < 2; ++n) _Pragma("unroll") for (int k = 0; k < 2; ++k) \
        acc[ai][bj][m][n] = __builtin_amdgcn_mfma_f32_16x16x32_f16(Bt[n][k], At[m][k], acc[ai][bj][m][n], 0, 0, 0); __builtin_amdgcn_s_setprio(0); } while (0)
#define PG8_WAIT_V(n) asm volatile("s_waitcnt vmcnt(" #n ")" ::: "memory")
#define PG8_WAIT_L(n) asm volatile("s_waitcnt lgkmcnt(" #n ")" ::: "memory")
#define PG8_BAR __builtin_amdgcn_s_barrier()
#define PG8_SCHED __builtin_amdgcn_sched_barrier(0)
#define PG8_OFFS(dst, U) do { _Pragma("unroll") for (int _h = 0; _h < 2; ++_h) _Pragma("unroll") for (int _i = 0; _i < 2; ++_i) { \
        const int _r = (U).pm * BM + _h * HALF + RA[_i]; const int _row = g.gather ? g.gather[_r] : _r; dst[_h][_i] = ((unsigned)_row * (unsigned)g.lda + (unsigned)CA[_i]) * 2u; } } while (0)
    Unit cur, nxt; int ui = 0;
    if (!S.next(0, cur)) return;
    f32x4 acc[2][2][4][2];
#pragma unroll
    for (int a = 0; a < 2; ++a)
#pragma unroll
        for (int b = 0; b < 2; ++b)
#pragma unroll
            for (int m = 0; m < 4; ++m)
#pragma unroll
                for (int n = 0; n < 2; ++n) acc[a][b][m][n] = (f32x4){0.f, 0.f, 0.f, 0.f};
    f16x8 At[4][2], B0[2][2], B1[2][2];
    unsigned offC[2][2], offN[2][2];
    PG8_OFFS(offC, cur);
    const char* cB = (const char*)g.Bt + (size_t)cur.pn * tstepB;
    PG8_STAGE(PG8_SB(0, 0), cB, voffB); PG8_STAGE(PG8_SB(0, 1), cB + hstepB, voffB); PG8_STAGE_A(PG8_SA(0, 0), offC, 0, 0); PG8_STAGE_A(PG8_SA(0, 1), offC, 1, 0);
    if (wr == 1) PG8_BAR;
    PG8_WAIT_V(2); PG8_BAR;
    PG8_STAGE(PG8_SB(1, 0), cB + kstep, voffB); PG8_STAGE_A(PG8_SA(1, 0), offC, 0, kstep); PG8_STAGE(PG8_SB(1, 1), cB + hstepB + kstep, voffB);
    PG8_WAIT_V(6); PG8_BAR;
    for (;;) {
        const bool has_next = S.next(ui + 1, nxt);
        if (has_next) { PG8_OFFS(offN, nxt); } else {
#pragma unroll
            for (int _h = 0; _h < 2; ++_h)
#pragma unroll
                for (int _i = 0; _i < 2; ++_i) offN[_h][_i] = offC[_h][_i]; }
        const char* nB = has_next ? (const char*)g.Bt + (size_t)nxt.pn * tstepB : cB;
#pragma nounroll
        for (int t = 0; t < nt; t += 2) {
            const bool last = (t == nt - 2);
            const size_t kb1 = (size_t)(t + 1) * kstep;
            const size_t kb2 = last ? 0 : (size_t)(t + 2) * kstep, kb3 = kb2 + kstep;
            unsigned o2[2][2];
#pragma unroll
            for (int _h = 0; _h < 2; ++_h)
#pragma unroll
                for (int _i = 0; _i < 2; ++_i) o2[_h][_i] = last ? offN[_h][_i] : offC[_h][_i];
            const char* b2 = last ? nB : cB + (size_t)(t + 2) * kstep; const char* b3 = b2 + kstep;
            PG8_LDB(B0, 0, 0); PG8_LDB(B1, 0, 1); PG8_SCHED; PG8_LDA(At, 0, 0); PG8_STAGE_A(PG8_SA(1, 1), offC, 1, kb1);
            PG8_WAIT_V(8); PG8_WAIT_L(0); PG8_BAR; PG8_MMA(0, 0, At, B0); PG8_MMA(0, 1, At, B1); PG8_BAR; PG8_SCHED;
            PG8_LDA(At, 0, 1); PG8_STAGE(PG8_SB(0, 0), b2, voffB); PG8_STAGE(PG8_SB(0, 1), b2 + hstepB, voffB); PG8_STAGE_A(PG8_SA(0, 0), o2, 0, kb2);
            PG8_WAIT_V(8); PG8_WAIT_L(0); PG8_BAR; PG8_MMA(1, 0, At, B0); PG8_MMA(1, 1, At, B1); PG8_BAR; PG8_SCHED;
            PG8_LDB(B0, 1, 0); PG8_LDB(B1, 1, 1); PG8_SCHED; PG8_LDA(At, 1, 0); PG8_STAGE_A(PG8_SA(0, 1), o2, 1, kb2);
            PG8_WAIT_V(8); PG8_WAIT_L(0); PG8_BAR; PG8_MMA(0, 0, At, B0); PG8_MMA(0, 1, At, B1); PG8_BAR; PG8_SCHED;
            PG8_LDA(At, 1, 1); PG8_STAGE(PG8_SB(1, 0), b3, voffB); PG8_STAGE(PG8_SB(1, 1), b3 + hstepB, voffB); PG8_STAGE_A(PG8_SA(1, 0), o2, 0, kb3);
            PG8_WAIT_V(8); PG8_WAIT_L(0); PG8_BAR; PG8_MMA(1, 0, At, B0); PG8_MMA(1, 1, At, B1); PG8_BAR; PG8_SCHED;
        }
        if constexpr (ALIGN_EPI) { if (wr == 0) PG8_BAR; }
        E(acc, cur, wr, wc, fr, fq);
        if (!has_next) break;
#pragma unroll
        for (int a = 0; a < 2; ++a)
#pragma unroll
            for (int b = 0; b < 2; ++b)
#pragma unroll
                for (int m = 0; m < 4; ++m)
#pragma unroll
                    for (int n = 0; n < 2; ++n) acc[a][b][m][n] = (f32x4){0.f, 0.f, 0.f, 0.f};
        cur = nxt; cB = nB; ++ui;
#pragma unroll
        for (int _h = 0; _h < 2; ++_h)
#pragma unroll
            for (int _i = 0; _i < 2; ++_i) offC[_h][_i] = offN[_h][_i];
        if constexpr (ALIGN_EPI) { if (wr == 1) PG8_BAR; }
    }
    PG8_WAIT_V(0);
    if constexpr (!ALIGN_EPI) { if (wr == 0) PG8_BAR; }
    PG8_BAR;
#undef PG8_SA
#undef PG8_SB
#undef PG8_STAGE
#undef PG8_STAGE_A
#undef PG8_LDA
#undef PG8_LDB
#undef PG8_MMA
#undef PG8_WAIT_V
#undef PG8_WAIT_L
#undef PG8_BAR
#undef PG8_SCHED
#undef PG8_OFFS
}
}

#define XB_TMO      128
#define XB_XCNT(j)  (256  + 64 * (j))
#define XB_XSUB(j)  (1280 + 64 * (j))
#define XB_XGEN(j)  (2304 + 64 * (j))
#define XB_TOP      3328
#define XB_TOPGEN   3392
#define XCD_BAR_WORDS 3456
#define XB_SPIN_CAP (1u << 22)
__device__ __forceinline__ unsigned xb_ld(unsigned* p)              { return __hip_atomic_load(p, __ATOMIC_RELAXED, __HIP_MEMORY_SCOPE_AGENT); }
__device__ __forceinline__ unsigned xb_add(unsigned* p, unsigned v) { return __hip_atomic_fetch_add(p, v, __ATOMIC_RELAXED, __HIP_MEMORY_SCOPE_AGENT); }
__device__ __forceinline__ unsigned xb_xcc_id() { return (unsigned)__builtin_amdgcn_s_getreg((3 << 11) | 20) & 0xFu; }
#define XB_SPIN(cond, bar) do { unsigned _sp = 0; while (cond) { __builtin_amdgcn_s_sleep(1); \
    if ((++_sp & 255u) == 0u) { if (xb_ld(&(bar)[XB_TMO])) break; if (_sp > XB_SPIN_CAP) { atomicAdd(&(bar)[XB_TMO], 1u); break; } } } } while (0)
struct XcdBarrier { unsigned* bar; unsigned x; volatile LAS unsigned* st; };
__device__ __forceinline__ XcdBarrier xcd_barrier_post(unsigned* bar, volatile LAS unsigned* st) {
    XcdBarrier b; b.bar = bar; b.x = xb_xcc_id(); b.st = st;
    if (threadIdx.x == 0) (void)xb_add(&bar[XB_XCNT(b.x)], 1u);
    return b;
}
__device__ __forceinline__ void xcd_barrier_complete(unsigned* bar, unsigned x, unsigned& nloc, unsigned& nx) {
    const unsigned G = gridDim.x * gridDim.y * gridDim.z;
    unsigned sum, cnt, mine, sp = 0u;
    for (;;) {
        sum = 0u; cnt = 0u; mine = 0u;
#pragma unroll
        for (unsigned j = 0; j < 16; ++j) { const unsigned c = xb_ld(&bar[XB_XCNT(j)]); sum += c; cnt += (c > 0u) ? 1u : 0u; mine = (j == x) ? c : mine; }
        if (sum == G) break;
        __builtin_amdgcn_s_sleep(1);
        if ((++sp & 255u) == 0u) { if (xb_ld(&bar[XB_TMO])) break; if (sp > XB_SPIN_CAP) { atomicAdd(&bar[XB_TMO], 1u); break; } }
    }
    nloc = mine > 0u ? mine : 1u; nx = cnt > 0u ? cnt : 1u;
}
__device__ __forceinline__ void xcd_barrier(const XcdBarrier& b) {
    asm volatile("s_waitcnt vmcnt(0)" ::: "memory");
    __syncthreads();
    if (threadIdx.x == 0) {
        unsigned* bar = b.bar;
        __builtin_amdgcn_s_waitcnt(0);
        unsigned nloc = b.st[0], nx = b.st[1];
        if (nloc == 0u) { xcd_barrier_complete(bar, b.x, nloc, nx); b.st[0] = nloc; b.st[1] = nx; }
        const unsigned old = xb_add(&bar[XB_XSUB(b.x)], 1u);
        const unsigned gen = old / nloc;
        if (old + 1u == (gen + 1u) * nloc) {
            __builtin_amdgcn_fence(__ATOMIC_RELEASE, "agent");
            asm volatile("s_waitcnt vmcnt(0)" ::: "memory");
            const unsigned og = xb_add(&bar[XB_TOP], 1u);
            const unsigned tg = og / nx;
            if (og + 1u == (tg + 1u) * nx) xb_add(&bar[XB_TOPGEN], 1u);
            else XB_SPIN(xb_ld(&bar[XB_TOPGEN]) == tg, bar);
            __builtin_amdgcn_fence(__ATOMIC_ACQUIRE, "agent");
            xb_add(&bar[XB_XGEN(b.x)], 1u);
            asm volatile("s_waitcnt vmcnt(0)" ::: "memory");
        } else {
            XB_SPIN(xb_ld(&bar[XB_XGEN(b.x)]) == gen, bar);
            __builtin_amdgcn_fence(__ATOMIC_ACQUIRE, "agent");
            asm volatile("s_waitcnt vmcnt(0)" ::: "memory");
        }
    }
    __syncthreads();
}

struct Args { const float* in[38]; float* out; unsigned char* ws; int ph_lo, ph_hi; };
enum { I_X = 0, I_MEM, I_LN1, I_WIN, I_PK, I_W1K, I_W2K, I_PV, I_W1V, I_W2V, I_NSAG, I_MU, I_W0, I_WUP, I_A0, I_AUP, I_GUP, I_KK, I_KA, I_RK, I_LNXG, I_LNXB,
       I_WOUT, I_LNMEM, I_LN2, I_WQ, I_WK, I_WV, I_WO, I_LN3, I_RGW, I_RGB, I_REW, I_REB, I_MG, I_MU2, I_MD, I_LNF };

__device__ __forceinline__ void tr_item(const float* src, int sld, int k0, int scol0, int nvalid, f16* dst, size_t drow0, int dld, LAS float* scr, int lane) {
    const int nl = lane & 31;
#pragma unroll 8
    for (int i = 0; i < 32; ++i) { const int kk = 2 * i + (lane >> 5); scr[kk * 33 + nl] = (nl < nvalid) ? src[(size_t)(k0 + kk) * sld + scol0 + nl] : 0.f; }
    LDS_WAIT(); asm volatile("" ::: "memory");
    const int c = lane & 7;
#pragma unroll
    for (int j = 0; j < 4; ++j) { const int n = (lane >> 3) + 8 * j; const LAS float* s = scr + (8 * c) * 33 + n;
        u32x4 o; o.x = pkh(s[0 * 33], s[1 * 33]); o.y = pkh(s[2 * 33], s[3 * 33]); o.z = pkh(s[4 * 33], s[5 * 33]); o.w = pkh(s[6 * 33], s[7 * 33]);
        *(u32x4*)(dst + (drow0 + n) * (size_t)dld + k0 + 8 * c) = o; }
    LDS_WAIT(); asm volatile("" ::: "memory");
}
__device__ __forceinline__ void tr_matrix(const float* src, int K, int N, f16* dst, LAS float* scr, int gw, int NGW, int lane) {
    const int nblk = N / 32, items = (K / 64) * nblk;
    for (int it = gw; it < items; it += NGW) { const int kb = it / nblk, nb = it % nblk; tr_item(src, N, kb * 64, nb * 32, 32, dst, (size_t)nb * 32, K, scr, lane); }
}
__device__ __forceinline__ void rms_row(const float* xrow, const float* gain, f16* o16, int lane) {
    const f32x4* xr = (const f32x4*)xrow + lane; f32x4 v[8]; float s = 0.f;
#pragma unroll
    for (int j = 0; j < 8; ++j) { v[j] = xr[64 * j]; s += v[j].x * v[j].x + v[j].y * v[j].y + v[j].z * v[j].z + v[j].w * v[j].w; }
    const float rstd = rsqrtf(wave_sum(s) * (1.f / D) + EPS);
    const f32x4* gr = (const f32x4*)gain + lane;
    u32x2* o8 = (u32x2*)o16 + lane;
#pragma unroll
    for (int j = 0; j < 8; ++j) { const f32x4 gg = gr[64 * j]; u32x2 w; w.x = pkh(v[j].x * rstd * gg.x, v[j].y * rstd * gg.y); w.y = pkh(v[j].z * rstd * gg.z, v[j].w * rstd * gg.w); o8[64 * j] = w; }
}

__device__ __forceinline__ void p0_prologue(const Args& a, LAS unsigned char* lds) {
    const int tid = threadIdx.x, lane = tid & 63, wave = tid >> 6;
    const int gw = blockIdx.x * 8 + wave, NGW = gridDim.x * 8;
    LAS float* scr = (LAS float*)(lds + wave * 16384);
    unsigned char* ws = a.ws;
    { f16* dst = (f16*)(ws + WS_WIN); const float* src = a.in[I_WIN];
      const int nblk = NZ / 32, items = (D / 64) * nblk;
      for (int it = gw; it < items; it += NGW) { const int kb = it / nblk, nb = it % nblk, n0 = nb * 32;
          int sc = 0, nv = 32; if (n0 < 2560) sc = n0; else if (n0 < 5920) sc = n0 + 24; else if (n0 == 5920) { sc = 2560; nv = 24; } else { sc = 0; nv = 0; }
          tr_item(src, 5944, kb * 64, sc, nv, dst, (size_t)n0, D, scr, lane); } }
    tr_matrix(a.in[I_WOUT], D, D, (f16*)(ws + WS_WOUT), scr, gw, NGW, lane);
    tr_matrix(a.in[I_WK], D, D, (f16*)(ws + WS_WKT), scr, gw, NGW, lane);
    tr_matrix(a.in[I_WV], D, D, (f16*)(ws + WS_WVT), scr, gw, NGW, lane);
    tr_matrix(a.in[I_WO], D, D, (f16*)(ws + WS_WOT), scr, gw, NGW, lane);
    { const f32x4* s = (const f32x4*)a.in[I_WQ]; u32x2* d = (u32x2*)(ws + WS_WQ16);
      for (size_t i = (size_t)blockIdx.x * 512 + tid; i < (size_t)D * D / 4; i += (size_t)gridDim.x * 512) { const f32x4 v = s[i]; u32x2 w; w.x = pkh(v.x, v.y); w.y = pkh(v.z, v.w); d[i] = w; } }
    { bf16* wu = (bf16*)(ws + WS_WUPT); bf16* au = (bf16*)(ws + WS_AUPT); bf16* gu = (bf16*)(ws + WS_GUPT);
      for (int i = blockIdx.x * 512 + tid; i < 1024 * 64; i += gridDim.x * 512) { const int ch = i >> 6, j = i & 63; wu[i] = (bf16)a.in[I_WUP][j * 1024 + ch]; au[i] = (bf16)a.in[I_AUP][j * 1024 + ch]; }
      for (int i = blockIdx.x * 512 + tid; i < 1024 * 160; i += gridDim.x * 512) { const int ch = i / 160, j = i % 160; gu[i] = (bf16)a.in[I_GUP][j * 1024 + ch]; } }
    for (int m = gw; m < T; m += NGW) rms_row(a.in[I_X] + (size_t)m * D, a.in[I_LN1], (f16*)(ws + WS_H) + (size_t)m * D, lane);
    for (int m = gw; m < 256; m += NGW) rms_row(a.in[I_MEM] + (size_t)m * D, a.in[I_LNMEM], (f16*)(ws + WS_MEMN) + (size_t)m * D, lane);
}

__device__ __forceinline__ void p_moe_weights(const Args& a, LAS unsigned char* lds) {
    const int tid = threadIdx.x, lane = tid & 63, wave = tid >> 6;
    const int gw = blockIdx.x * 8 + wave, NGW = gridDim.x * 8;
    LAS float* scr = (LAS float*)(lds + wave * 16384);
    unsigned char* ws = a.ws;
    { f16* dst = (f16*)(ws + WS_WGU); const int items = NEXP * (D / 64) * 16;
      for (int it = gw; it < items; it += NGW) { const int e = it / ((D / 64) * 16), r = it % ((D / 64) * 16), kb = r / 16, nb = r % 16, j0 = nb * 32, jt = j0 / 256, jj = j0 % 256;
          const float* src = (jj < 128 ? a.in[I_MG] : a.in[I_MU2]) + (size_t)e * D * EFF; const int sc = jt * 128 + (jj & 127);
          tr_item(src, EFF, kb * 64, sc, 32, dst, (size_t)e * 512 + j0, D, scr, lane); } }
    { f16* dst = (f16*)(ws + WS_WD); const int items = NEXP * (EFF / 64) * (D / 32);
      for (int it = gw; it < items; it += NGW) { const int e = it / ((EFF / 64) * (D / 32)), r = it % ((EFF / 64) * (D / 32)), kb = r / (D / 32), nb = r % (D / 32);
          tr_item(a.in[I_MD] + (size_t)e * EFF * D, D, kb * 64, nb * 32, 32, dst, (size_t)e * D + nb * 32, EFF, scr, lane); } }
}

__device__ __forceinline__ float gelu_tanh(float x) { const float u = 0.7978845608028654f * (x + 0.044715f * x * x * x); return 0.5f * x * (1.f + tanhf(u)); }
__device__ __forceinline__ void p_compress(const Args& a, LAS unsigned char* lds) {
    const int tid = threadIdx.x, grp = tid >> 7, j = tid & 127;
    LAS float* in = (LAS float*)(lds + grp * 20480); LAS float* hid = in + 4096;
    const f16* z = (const f16*)(a.ws + WS_Z);
    const int NIT = 2 * NCMP * 2;
    for (int base = blockIdx.x * 4; base < NIT; base += gridDim.x * 4) {
        const int item = base + grp; const bool valid = item < NIT;
        const int kv = valid ? item / (NCMP * 2) : 0, r = valid ? item % (NCMP * 2) : 0, c = r >> 1, g = r & 1;
        const float* pos = a.in[kv ? I_PV : I_PK]; const float* w1 = a.in[kv ? I_W1V : I_W1K]; const float* w2 = a.in[kv ? I_W2V : I_W2K];
        __syncthreads();
        for (int i = j; i < 4096; i += 128) { const int l = i >> 7, d = i & 127; in[i] = (float)z[(size_t)(16 * c + l) * NZ + (kv ? ZVC : ZKC) + g * 128 + d] + pos[i]; }
        __syncthreads();
        float acc = 0.f;
        for (int i = 0; i < 4096; i += 4) { const f32x4 x4 = *(const LAS f32x4*)(in + i);
            acc += x4.x * w1[(size_t)i * 128 + j] + x4.y * w1[(size_t)(i + 1) * 128 + j] + x4.z * w1[(size_t)(i + 2) * 128 + j] + x4.w * w1[(size_t)(i + 3) * 128 + j]; }
        hid[j] = gelu_tanh(acc);
        __syncthreads();
        float o = 0.f;
        for (int i = 0; i < 128; ++i) o += hid[i] * w2[i * 128 + j];
        if (valid) { ((f16*)(a.ws + (kv ? WS_VCMP : WS_KCMP)))[((size_t)c * 2 + g) * 128 + j] = (f16)o; if (c == 0) ((f16*)(a.ws + (kv ? WS_VCMP : WS_KCMP)))[((size_t)1023 * 2 + g) * 128 + j] = (f16)0.f; }
    }
}

__device__ __forceinline__ void p_nsa_naive(const Args& a, LAS unsigned char* lds, int bid, int nb) {
    const int tid = threadIdx.x, half = tid >> 8, t256 = tid & 255, p = t256 >> 6, lane = tid & 63;
    LAS float* qs = (LAS float*)(lds + half * 24576); LAS float* pc = qs + 512; LAS float* psel = pc + 4096; LAS int* sl = (LAS int*)(psel + 256);
    const f16* z = (const f16*)(a.ws + WS_Z); const float* kcmp = (const float*)(a.ws + WS_KCMP); const float* vcmp = (const float*)(a.ws + WS_VCMP);
    float* onsa = (float*)(a.ws + WS_ONSA);
    const float scale = 0.08838834764831845f;
    for (int base = bid * 2; base < T * 2; base += nb * 2) {
        const int item = base + half; const int t = item >> 1, g = item & 1;
        const f16* zrow = z + (size_t)t * NZ; const int hq = g * 4 + p;
        __syncthreads();
        for (int d = lane; d < 128; d += 64) qs[p * 128 + d] = (float)zrow[ZQ + hq * 128 + d];
        LDS_WAIT();
        const int nvalid = t >= 31 ? ((t - 31) >> 4) + 1 : 0;
        float mx = -INFINITY;
        for (int c = lane; c < nvalid; c += 64) { const f32x4* kr = (const f32x4*)(kcmp + ((size_t)c * 2 + g) * 128); float s = 0.f;
#pragma unroll 8
            for (int d4 = 0; d4 < 32; ++d4) { const f32x4 k4 = kr[d4]; const f32x4 q4 = *(const LAS f32x4*)(qs + p * 128 + d4 * 4); s += q4.x * k4.x + q4.y * k4.y + q4.z * k4.z + q4.w * k4.w; }
            s *= scale; pc[p * 1024 + c] = s; mx = fmaxf(mx, s); }
        mx = wave_max(mx);
        float sum = 0.f;
        for (int c = lane; c < nvalid; c += 64) { const float e = __expf(pc[p * 1024 + c] - mx); pc[p * 1024 + c] = e; sum += e; }
        sum = wave_sum(sum); const float inv = 1.f / fmaxf(sum, 1e-30f);
        for (int c = lane; c < 1024; c += 64) pc[p * 1024 + c] = c < nvalid ? pc[p * 1024 + c] * inv : 0.f;
        LDS_WAIT();
        float oc0 = 0.f, oc1 = 0.f;
#pragma unroll 8
        for (int c = 0; c < nvalid; ++c) { const float pv = pc[p * 1024 + c]; const float* vr = vcmp + ((size_t)c * 2 + g) * 128; oc0 += pv * vr[lane]; oc1 += pv * vr[lane + 64]; }
        __syncthreads();
        { const int s = t256; float acc = 0.f;
#pragma unroll
          for (int pp = 0; pp < 4; ++pp) { const LAS float* P = pc + pp * 1024 + 4 * s; acc += P[0] + P[1] + P[2] + 0.5f * P[3] + (s > 0 ? 0.5f * P[-1] : 0.f); }
          psel[s] = acc; }
        __syncthreads();
        const int blk = t >> 6;
        if (p == 0) {
            int n = 0;
            if (lane == 0) { sl[1 + n] = 0; } n++;
            if (blk >= 1) { if (lane == 0) sl[1 + n] = blk; n++; }
            if (blk >= 2) { if (lane == 0) sl[1 + n] = blk - 1; n++; }
            const int ncand = blk >= 3 ? blk - 2 : 0;
            if (ncand <= 13) { for (int s = 1 + lane; s <= blk - 2; s += 64) sl[1 + n + (s - 1)] = s; n += ncand; }
            else {
                float v[4];
#pragma unroll
                for (int jj = 0; jj < 4; ++jj) { const int s = 1 + lane + 64 * jj; v[jj] = (s <= blk - 2) ? psel[s] : -1.f; }
                for (int it = 0; it < 13; ++it) {
                    float bv = v[0]; int bi = 1 + lane;
#pragma unroll
                    for (int jj = 1; jj < 4; ++jj) { if (v[jj] > bv) { bv = v[jj]; bi = 1 + lane + 64 * jj; } }
#pragma unroll
                    for (int o = 1; o < 64; o <<= 1) { const float ov = __shfl_xor(bv, o); const int oi = __shfl_xor(bi, o); if (ov > bv || (ov == bv && oi < bi)) { bv = ov; bi = oi; } }
                    if (lane == 0) sl[1 + n] = bi; n++;
#pragma unroll
                    for (int jj = 0; jj < 4; ++jj) if (bi == 1 + lane + 64 * jj) v[jj] = -1.f;
                }
            }
            if (lane == 0) sl[0] = n;
            LDS_WAIT();
        }
        __syncthreads();
        const int nsel = sl[0];
        mx = -INFINITY;
        for (int n = 0; n < nsel; ++n) { const int kpos = sl[1 + n] * 64 + lane; float s = -INFINITY;
            if (kpos <= t) { const f16x8* kr = (const f16x8*)(z + (size_t)kpos * NZ + ZKS + g * 128); s = 0.f;
#pragma unroll 4
                for (int d8 = 0; d8 < 16; ++d8) { const f16x8 k8 = kr[d8]; const LAS float* q = qs + p * 128 + d8 * 8;
#pragma unroll
                    for (int e = 0; e < 8; ++e) s += q[e] * (float)k8[e]; }
                s *= scale; }
            pc[p * 1024 + n * 64 + lane] = s; mx = fmaxf(mx, s); }
        mx = wave_max(mx);
        sum = 0.f;
        for (int n = 0; n < nsel; ++n) { const float s = pc[p * 1024 + n * 64 + lane]; const float e = (s == -INFINITY) ? 0.f : __expf(s - mx); pc[p * 1024 + n * 64 + lane] = e; sum += e; }
        sum = wave_sum(sum); const float invs = 1.f / fmaxf(sum, 1e-30f);
        LDS_WAIT();
        float os0 = 0.f, os1 = 0.f;
        for (int n = 0; n < nsel; ++n) { const int k0 = sl[1 + n] * 64;
            for (int jj = 0; jj < 64; ++jj) { const int kpos = k0 + jj; if (kpos > t) break; const float pv = pc[p * 1024 + n * 64 + jj]; const f16* vr = z + (size_t)kpos * NZ + ZVS + g * 128;
                os0 += pv * (float)vr[lane]; os1 += pv * (float)vr[lane + 64]; } }
        const int lo = t >= 511 ? t - 511 : 0, nw = t - lo + 1;
        mx = -INFINITY;
        for (int i = lane; i < nw; i += 64) { const f16x8* kr = (const f16x8*)(z + (size_t)(lo + i) * NZ + ZKW + g * 128); float s = 0.f;
#pragma unroll 4
            for (int d8 = 0; d8 < 16; ++d8) { const f16x8 k8 = kr[d8]; const LAS float* q = qs + p * 128 + d8 * 8;
#pragma unroll
                for (int e = 0; e < 8; ++e) s += q[e] * (float)k8[e]; }
            s *= scale; pc[p * 1024 + i] = s; mx = fmaxf(mx, s); }
        mx = wave_max(mx);
        sum = 0.f;
        for (int i = lane; i < nw; i += 64) { const float e = __expf(pc[p * 1024 + i] - mx); pc[p * 1024 + i] = e; sum += e; }
        sum = wave_sum(sum); const float invw = 1.f / fmaxf(sum, 1e-30f);
        LDS_WAIT();
        float ow0 = 0.f, ow1 = 0.f;
#pragma unroll 8
        for (int i = 0; i < nw; ++i) { const float pv = pc[p * 1024 + i]; const f16* vr = z + (size_t)(lo + i) * NZ + ZVW + g * 128; ow0 += pv * (float)vr[lane]; ow1 += pv * (float)vr[lane + 64]; }
        const float gc = sigmoidf_((float)zrow[ZGL + 0 * 8 + hq]), gs = sigmoidf_((float)zrow[ZGL + 1 * 8 + hq]), gw_ = sigmoidf_((float)zrow[ZGL + 2 * 8 + hq]);
        onsa[(size_t)t * 1024 + hq * 128 + lane] = gc * oc0 + gs * os0 * invs + gw_ * ow0 * invw;
        onsa[(size_t)t * 1024 + hq * 128 + lane + 64] = gc * oc1 + gs * os1 * invs + gw_ * ow1 * invw;
    }
}


typedef float f32x16 __attribute__((ext_vector_type(16)));
typedef short v4i16_t __attribute__((ext_vector_type(4)));
constexpr int NS_KB = 0, NS_VB = 32768, NS_PSEL = 65536, NS_PSTR = 257, NS_SELB = NS_PSEL + 64 * NS_PSTR * 4, NS_WANY = NS_SELB + 2048, NS_LIST = NS_WANY + 256, NS_CNT = NS_LIST + 512, NS_UNIT = NS_CNT + 64;
static_assert(NS_UNIT + 64 <= MISC_OFF, "nsa lds");
__device__ __forceinline__ unsigned offb(unsigned row, unsigned ch) { return 256u * row + 16u * (ch ^ (((row & 3u) << 2) | ((row >> 2) & 3u))); }
__device__ __forceinline__ void ns_dma(const f16* g0, size_t gstride, LAS unsigned char* buf, int wv, int lane) {
#pragma unroll
    for (int i = 0; i < 2; ++i) { const int piece = wv * 2 + i, row = 4 * piece + (lane >> 4), slot = lane & 15, ch = slot ^ (((row & 3) << 2) | ((row >> 2) & 3));
        __builtin_amdgcn_global_load_lds((const unsigned*)(g0 + (size_t)row * gstride + ch * 8), (LAS unsigned*)(buf + piece * 1024), 16, 0, 0); }
}
__device__ __forceinline__ void ns_qk(f32x16& s0, f32x16& s1, const LAS unsigned char* kb, const f16x8 (&qf)[8], int rho_, int hh_) {
    unsigned rho = (unsigned)rho_, hh = (unsigned)hh_;
    asm volatile("" : "+v"(rho), "+v"(hh));
    const unsigned xr = ((rho & 3u) << 2) | ((rho >> 2) & 3u);
    const LAS unsigned char* kbase = kb + 256u * rho + 16u * ((hh ^ xr) & 1u); const unsigned xs = xr >> 1;
#pragma unroll
    for (int i = 0; i < 16; ++i) { s0[i] = 0.f; s1[i] = 0.f; }
#pragma unroll
    for (int s = 0; s < 8; ++s) { const LAS unsigned char* ad = kbase + 32u * ((unsigned)s ^ xs);
        const f16x8 a0 = *(const LAS f16x8*)(ad), a1 = *(const LAS f16x8*)(ad + 8192);
        s0 = __builtin_amdgcn_mfma_f32_32x32x16_f16(a0, qf[s], s0, 0, 0, 0); s1 = __builtin_amdgcn_mfma_f32_32x32x16_f16(a1, qf[s], s1, 0, 0, 0); }
}
__device__ __forceinline__ void ns_pv(f32x16 (&O)[4], const LAS unsigned char* vb, const f32x16& p0, const f32x16& p1, int lane_) {
    unsigned lane = (unsigned)lane_;
    asm volatile("" : "+v"(lane));
    const unsigned hh = lane >> 5, blk = (lane >> 4) & 1, q = (lane & 15) >> 2, pp = lane & 3;
    const unsigned x = 2 * blk + (pp >> 1);
    const LAS unsigned char* vbase[2];
#pragma unroll
    for (int t = 0; t < 2; ++t) { const unsigned w = (hh + 2 * t) & 3u; vbase[t] = vb + 256u * (4 * hh + 8 * t + q) + 16u * (x ^ w) + 8u * (pp & 1); }
#pragma unroll
    for (int c = 0; c < 4; ++c) { const unsigned cq = 64u * ((unsigned)c ^ q);
        const LAS unsigned char* b0 = vbase[0] + cq; const LAS unsigned char* b1 = vbase[1] + cq;
#pragma unroll
        for (int kh = 0; kh < 2; ++kh)
#pragma unroll
            for (int sp = 0; sp < 2; ++sp) {
                f16x8 pf;
#pragma unroll
                for (int j = 0; j < 8; ++j) pf[j] = (f16)(kh ? p1[8 * sp + j] : p0[8 * sp + j]);
                const v4i16_t lo = __builtin_amdgcn_ds_read_tr16_b64_v4i16((LAS v4i16_t*)(b0 + 256 * (32 * kh + 16 * sp)));
                const v4i16_t hi = __builtin_amdgcn_ds_read_tr16_b64_v4i16((LAS v4i16_t*)(b1 + 256 * (32 * kh + 16 * sp)));
                typedef short s16x8 __attribute__((ext_vector_type(8)));
                const s16x8 v8 = {lo[0], lo[1], lo[2], lo[3], hi[0], hi[1], hi[2], hi[3]};
                O[c] = __builtin_amdgcn_mfma_f32_32x32x16_f16(__builtin_bit_cast(f16x8, v8), pf, O[c], 0, 0, 0); }
    }
}
#define NS_KIDX(r, hh) ((int)(((r) & 3) + 8 * ((r) >> 2) + 4 * (hh)))
__device__ __forceinline__ void ns_online(f32x16& x0, f32x16& x1, float& m, float& l, f32x16 (&O)[4]) {
    float mx = x0[0];
#pragma unroll
    for (int i = 1; i < 16; ++i) mx = fmaxf(mx, x0[i]);
#pragma unroll
    for (int i = 0; i < 16; ++i) mx = fmaxf(mx, x1[i]);
    mx = fmaxf(mx, __shfl_xor(mx, 32));
    const float mn = fmaxf(m, mx), alpha = __builtin_amdgcn_exp2f(m - mn);
    m = mn; float ls = 0.f;
#pragma unroll
    for (int i = 0; i < 16; ++i) { x0[i] = __builtin_amdgcn_exp2f(x0[i] - mn); x1[i] = __builtin_amdgcn_exp2f(x1[i] - mn); ls += x0[i] + x1[i]; }
    l = l * alpha + ls;
#pragma unroll
    for (int c = 0; c < 4; ++c) O[c] = O[c] * alpha;
}
__device__ __forceinline__ void p_nsa(const Args& a, LAS unsigned char* lds) {
    const int tid = threadIdx.x, lane = tid & 63, w = __builtin_amdgcn_readfirstlane(tid >> 6), rho = lane & 31, hh = lane >> 5, ql = rho >> 2, p = rho & 3;
    const f16* z = (const f16*)(a.ws + WS_Z); const f16* kcmp = (const f16*)(a.ws + WS_KCMP); const f16* vcmp = (const f16*)(a.ws + WS_VCMP);
    float* onsa = (float*)(a.ws + WS_ONSA); unsigned* ctl = (unsigned*)(a.ws + WS_CTL);
    LAS float* psel = (LAS float*)(lds + NS_PSEL); LAS unsigned* selb = (LAS unsigned*)(lds + NS_SELB); LAS unsigned* wany = (LAS unsigned*)(lds + NS_WANY);
    LAS unsigned char* list = lds + NS_LIST; LAS int* cnt = (LAS int*)(lds + NS_CNT); LAS int* unit_s = (LAS int*)(lds + NS_UNIT);
    const float c2 = 0.08838834764831845f * 1.4426950408889634f;
    for (;;) {
        __syncthreads();
        if (tid == 0) unit_s[0] = (int)atomicAdd(&ctl[CW_Q], 1u);
        __syncthreads();
        const int u = unit_s[0]; if (u >= 512) break;
        const int blk = 255 - (u >> 1), g = u & 1, t0 = blk * 64, tq = t0 + 8 * w + ql, hq = g * 4 + p;
        f16x8 qf[8];
        { const f16* qrow = z + (size_t)tq * NZ + ZQ + hq * 128 + 8 * hh;
#pragma unroll
          for (int s = 0; s < 8; ++s) qf[s] = *(const f16x8*)(qrow + 16 * s); }
        const f16* zrow = z + (size_t)tq * NZ;
        const float gate_c = sigmoidf_((float)zrow[ZGL + hq]), gate_s = sigmoidf_((float)zrow[ZGL + 8 + hq]), gate_w = sigmoidf_((float)zrow[ZGL + 16 + hq]);
        f32x16 O[4];
        float* orow = onsa + (size_t)tq * 1024 + hq * 128 + 4 * hh;
#pragma unroll
        for (int c = 0; c < 4; ++c)
#pragma unroll
            for (int i = 0; i < 16; ++i) O[c][i] = 0.f;
        for (int i = lane; i < 8 * NS_PSTR; i += 64) psel[(8 * w) * NS_PSTR + i] = 0.f;
        const int cmax = tq >= 31 ? (tq - 31) >> 4 : -1;
        const int ntc = (4 * blk + 3 + 63) >> 6;
        float m = -1e30f, l = 0.f;
        ns_dma(kcmp + (size_t)g * 128, 256, lds + NS_KB, w, lane);
        VM_WAIT(); __syncthreads();
        for (int i = 0; i < ntc; ++i) {
            if (i + 1 < ntc) ns_dma(kcmp + ((size_t)(64 * (i + 1)) * 2 + g) * 128, 256, lds + NS_KB + ((i + 1) & 1) * 16384, w, lane);
            f32x16 x0, x1; ns_qk(x0, x1, lds + NS_KB + (i & 1) * 16384, qf, rho, hh);
#pragma unroll
            for (int r = 0; r < 16; ++r) { const int c0 = 64 * i + NS_KIDX(r, hh); x0[r] = (c0 <= cmax) ? x0[r] * c2 : -INFINITY; x1[r] = (c0 + 32 <= cmax) ? x1[r] * c2 : -INFINITY; }
            float mx = x0[0];
#pragma unroll
            for (int r = 1; r < 16; ++r) mx = fmaxf(mx, x0[r]);
#pragma unroll
            for (int r = 0; r < 16; ++r) mx = fmaxf(mx, x1[r]);
            mx = fmaxf(mx, __shfl_xor(mx, 32));
            const float mn = fmaxf(m, mx); float ls = 0.f;
#pragma unroll
            for (int r = 0; r < 16; ++r) ls += __builtin_amdgcn_exp2f(x0[r] - mn) + __builtin_amdgcn_exp2f(x1[r] - mn);
            l = l * __builtin_amdgcn_exp2f(m - mn) + ls; m = mn;
            VM_WAIT(); __syncthreads();
        }
        l += __shfl_xor(l, 32);
        const float invl = 1.f / fmaxf(l, 1e-30f);
        ns_dma(kcmp + (size_t)g * 128, 256, lds + NS_KB, w, lane); ns_dma(vcmp + (size_t)g * 128, 256, lds + NS_VB, w, lane);
        VM_WAIT(); __syncthreads();
        for (int i = 0; i < ntc; ++i) {
            if (i + 1 < ntc) { ns_dma(kcmp + ((size_t)(64 * (i + 1)) * 2 + g) * 128, 256, lds + NS_KB + ((i + 1) & 1) * 16384, w, lane); ns_dma(vcmp + ((size_t)(64 * (i + 1)) * 2 + g) * 128, 256, lds + NS_VB + ((i + 1) & 1) * 16384, w, lane); }
            f32x16 x0, x1; ns_qk(x0, x1, lds + NS_KB + (i & 1) * 16384, qf, rho, hh);
#pragma unroll
            for (int r = 0; r < 16; ++r) { const int c0 = 64 * i + NS_KIDX(r, hh);
                x0[r] = (c0 <= cmax) ? __builtin_amdgcn_exp2f(x0[r] * c2 - m) * invl : 0.f; x1[r] = (c0 + 32 <= cmax) ? __builtin_amdgcn_exp2f(x1[r] * c2 - m) * invl : 0.f; }
#pragma unroll
            for (int kh = 0; kh < 2; ++kh)
#pragma unroll
                for (int r4 = 0; r4 < 4; ++r4) {
                    const float pa = kh ? x1[4 * r4] : x0[4 * r4], pb = kh ? x1[4 * r4 + 1] : x0[4 * r4 + 1], pc_ = kh ? x1[4 * r4 + 2] : x0[4 * r4 + 2], pd = kh ? x1[4 * r4 + 3] : x0[4 * r4 + 3];
                    float mainv = pa + pb + pc_ + 0.5f * pd, carry = 0.5f * pd;
                    mainv += __shfl_xor(mainv, 1); mainv += __shfl_xor(mainv, 2); carry += __shfl_xor(carry, 1); carry += __shfl_xor(carry, 2);
                    if (p == 0) { const int sb = 16 * i + 8 * kh + 2 * r4 + hh; float* pr = (float*)(psel + (8 * w + ql) * NS_PSTR + sb); __hip_atomic_fetch_add(pr, mainv, __ATOMIC_RELAXED, __HIP_MEMORY_SCOPE_WORKGROUP); __hip_atomic_fetch_add(pr + 1, carry, __ATOMIC_RELAXED, __HIP_MEMORY_SCOPE_WORKGROUP); }
                }
            ns_pv(O, lds + NS_VB + (i & 1) * 16384, x0, x1, lane);
            VM_WAIT(); __syncthreads();
        }
#pragma unroll
        for (int c = 0; c < 4; ++c) {
#pragma unroll
            for (int r4 = 0; r4 < 4; ++r4) *(f32x4*)(orow + 32 * c + 8 * r4) = (f32x4){O[c][4 * r4] * gate_c, O[c][4 * r4 + 1] * gate_c, O[c][4 * r4 + 2] * gate_c, O[c][4 * r4 + 3] * gate_c};
#pragma unroll
            for (int i = 0; i < 16; ++i) O[c][i] = 0.f; }
        {
            unsigned anyw = 0u;
            for (int qq = 0; qq < 8; ++qq) {
                const LAS float* pr = psel + (8 * w + qq) * NS_PSTR;
                unsigned myw = 0u;
                if (lane == 0) myw |= 1u;
                if (lane == (blk >> 5)) myw |= 1u << (blk & 31);
                if (blk >= 1 && lane == ((blk - 1) >> 5)) myw |= 1u << ((blk - 1) & 31);
                const int ncand = blk >= 3 ? blk - 2 : 0;
                if (ncand <= 13) { if (ncand > 0 && lane == 0) myw |= ((blk - 2 >= 31) ? 0xFFFFFFFFu : ((2u << (blk - 2)) - 1u)) & ~1u; }
                else {
                    float v[4];
#pragma unroll
                    for (int jj = 0; jj < 4; ++jj) { const int s = 1 + lane + 64 * jj; v[jj] = (s <= blk - 2) ? pr[s] : -1.f; }
                    for (int it = 0; it < 13; ++it) {
                        float bv = v[0]; int bi = 1 + lane;
#pragma unroll
                        for (int jj = 1; jj < 4; ++jj) { if (v[jj] > bv) { bv = v[jj]; bi = 1 + lane + 64 * jj; } }
#pragma unroll
                        for (int o = 1; o < 64; o <<= 1) { const float ov = __shfl_xor(bv, o); const int oi = __shfl_xor(bi, o); if (ov > bv || (ov == bv && oi < bi)) { bv = ov; bi = oi; } }
                        if (lane == (bi >> 5)) myw |= 1u << (bi & 31);
#pragma unroll
                        for (int jj = 0; jj < 4; ++jj) if (bi == 1 + lane + 64 * jj) v[jj] = -1.f;
                    }
                }
                if (lane < 8) selb[(8 * w + qq) * 8 + lane] = myw;
                anyw |= myw;
            }
            if (lane < 8) wany[w * 8 + lane] = anyw;
        }
        __syncthreads();
        {
            int need = 0;
            if (w < 4) { const int sblk = 64 * w + lane; unsigned un = 0u;
#pragma unroll
                for (int ww = 0; ww < 8; ++ww) un |= wany[ww * 8 + (sblk >> 5)];
                need = (un >> (sblk & 31)) & 1; }
            const unsigned long long bal = __ballot(need);
            if (w < 4 && lane == 0) cnt[w] = __popcll(bal);
            __syncthreads();
            if (w < 4) { int base = 0;
                for (int ww = 0; ww < w; ++ww) base += cnt[ww];
                if (need) list[base + __popcll(bal & ((1ull << lane) - 1ull))] = (unsigned char)(64 * w + lane); }
            __syncthreads();
        }
        const int nlist = cnt[0] + cnt[1] + cnt[2] + cnt[3];
        m = -1e30f; l = 0.f;
        { const int s0 = list[0]; ns_dma(z + (size_t)(s0 * 64) * NZ + ZKS + g * 128, NZ, lds + NS_KB, w, lane); ns_dma(z + (size_t)(s0 * 64) * NZ + ZVS + g * 128, NZ, lds + NS_VB, w, lane); }
        VM_WAIT(); __syncthreads();
        for (int i = 0; i < nlist; ++i) {
            const int sb = list[i];
            if (i + 1 < nlist) { const int sn = list[i + 1]; ns_dma(z + (size_t)(sn * 64) * NZ + ZKS + g * 128, NZ, lds + NS_KB + ((i + 1) & 1) * 16384, w, lane); ns_dma(z + (size_t)(sn * 64) * NZ + ZVS + g * 128, NZ, lds + NS_VB + ((i + 1) & 1) * 16384, w, lane); }
            const unsigned wneed = (wany[w * 8 + (sb >> 5)] >> (sb & 31)) & 1u;
            if (wneed) {
                const bool rsel = (selb[(8 * w + ql) * 8 + (sb >> 5)] >> (sb & 31)) & 1u;
                f32x16 x0, x1; ns_qk(x0, x1, lds + NS_KB + (i & 1) * 16384, qf, rho, hh);
                const int kp0 = sb * 64;
#pragma unroll
                for (int r = 0; r < 16; ++r) { const int kp = kp0 + NS_KIDX(r, hh); x0[r] = (rsel && kp <= tq) ? x0[r] * c2 : -INFINITY; x1[r] = (rsel && kp + 32 <= tq) ? x1[r] * c2 : -INFINITY; }
                ns_online(x0, x1, m, l, O);
                ns_pv(O, lds + NS_VB + (i & 1) * 16384, x0, x1, lane);
            }
            VM_WAIT(); __syncthreads();
        }
        l += __shfl_xor(l, 32);
        { const float sc = gate_s / fmaxf(l, 1e-30f);
#pragma unroll
          for (int c = 0; c < 4; ++c) {
#pragma unroll
              for (int r4 = 0; r4 < 4; ++r4) { f32x4* op = (f32x4*)(orow + 32 * c + 8 * r4); const f32x4 e = *op; *op = (f32x4){e.x + O[c][4 * r4] * sc, e.y + O[c][4 * r4 + 1] * sc, e.z + O[c][4 * r4 + 2] * sc, e.w + O[c][4 * r4 + 3] * sc}; }
#pragma unroll
              for (int i = 0; i < 16; ++i) O[c][i] = 0.f; } }
        m = -1e30f; l = 0.f;
        const int wb0 = blk >= 8 ? blk - 8 : 0, nwt = blk - wb0 + 1;
        ns_dma(z + (size_t)(wb0 * 64) * NZ + ZKW + g * 128, NZ, lds + NS_KB, w, lane); ns_dma(z + (size_t)(wb0 * 64) * NZ + ZVW + g * 128, NZ, lds + NS_VB, w, lane);
        VM_WAIT(); __syncthreads();
        for (int i = 0; i < nwt; ++i) {
            const int kb = wb0 + i;
            if (i + 1 < nwt) { ns_dma(z + (size_t)((kb + 1) * 64) * NZ + ZKW + g * 128, NZ, lds + NS_KB + ((i + 1) & 1) * 16384, w, lane); ns_dma(z + (size_t)((kb + 1) * 64) * NZ + ZVW + g * 128, NZ, lds + NS_VB + ((i + 1) & 1) * 16384, w, lane); }
            f32x16 x0, x1; ns_qk(x0, x1, lds + NS_KB + (i & 1) * 16384, qf, rho, hh);
            const int kp0 = kb * 64;
#pragma unroll
            for (int r = 0; r < 16; ++r) { const int kp = kp0 + NS_KIDX(r, hh);
                x0[r] = (kp <= tq && kp + 511 >= tq) ? x0[r] * c2 : -INFINITY; x1[r] = (kp + 32 <= tq && kp + 32 + 511 >= tq) ? x1[r] * c2 : -INFINITY; }
            ns_online(x0, x1, m, l, O);
            ns_pv(O, lds + NS_VB + (i & 1) * 16384, x0, x1, lane);
            VM_WAIT(); __syncthreads();
        }
        l += __shfl_xor(l, 32);
        { const float sc = gate_w / fmaxf(l, 1e-30f);
#pragma unroll
          for (int c = 0; c < 4; ++c)
#pragma unroll
              for (int r4 = 0; r4 < 4; ++r4) { f32x4* op = (f32x4*)(orow + 32 * c + 8 * r4); const f32x4 e = *op; *op = (f32x4){e.x + O[c][4 * r4] * sc, e.y + O[c][4 * r4 + 1] * sc, e.z + O[c][4 * r4 + 2] * sc, e.w + O[c][4 * r4 + 3] * sc}; } }
    }
}


constexpr int RS = 72, SLOT = 64 * RS * 2, RW_FS = 68, RW_GCL = 14 * SLOT;
#define RW_SLOT(lds, i) ((LAS bf16*)((lds) + (i) * SLOT))
template <int KS> __device__ __forceinline__ void mm_acc(f32x4 (&acc)[2], const LAS bf16* X, int xs, const LAS bf16* Y, int ys, int w, int lane) {
    const LAS bf16* xp = X + (16 * (w >> 1) + (lane & 15)) * xs + 8 * (lane >> 4);
    const LAS bf16* yp = Y + (32 * (w & 1) + (lane & 15)) * ys + 8 * (lane >> 4);
#pragma unroll
    for (int ks = 0; ks < KS; ++ks) { const bf16x8 av = *(const LAS bf16x8*)(xp + 32 * ks), b0 = *(const LAS bf16x8*)(yp + 32 * ks), b1 = *(const LAS bf16x8*)(yp + 16 * ys + 32 * ks);
        acc[0] = __builtin_amdgcn_mfma_f32_16x16x32_bf16(av, b0, acc[0], 0, 0, 0); acc[1] = __builtin_amdgcn_mfma_f32_16x16x32_bf16(av, b1, acc[1], 0, 0, 0); }
}
__device__ __forceinline__ void acc_zero(f32x4 (&acc)[2]) { acc[0] = (f32x4){0.f, 0.f, 0.f, 0.f}; acc[1] = (f32x4){0.f, 0.f, 0.f, 0.f}; }
__device__ __forceinline__ void st_n(const f32x4 (&acc)[2], LAS bf16* dst, int m0, int n0) {
#pragma unroll
    for (int tn = 0; tn < 2; ++tn)
#pragma unroll
        for (int r = 0; r < 4; ++r) dst[(m0 + r) * RS + n0 + 16 * tn] = (bf16)acc[tn][r];
}
__device__ __forceinline__ void st_t(const f32x4 (&acc)[2], LAS bf16* dst, int m0, int n0) {
#pragma unroll
    for (int tn = 0; tn < 2; ++tn) { const bf16x4 v = {(bf16)acc[tn][0], (bf16)acc[tn][1], (bf16)acc[tn][2], (bf16)acc[tn][3]}; *(LAS bf16x4*)(dst + (n0 + 16 * tn) * RS + m0) = v; }
}
__device__ __forceinline__ void ld_n(f32x4 (&acc)[2], const LAS bf16* src, int m0, int n0) {
#pragma unroll
    for (int tn = 0; tn < 2; ++tn)
#pragma unroll
        for (int r = 0; r < 4; ++r) acc[tn][r] = (float)src[(m0 + r) * RS + n0 + 16 * tn];
}
template <bool INCL> __device__ __forceinline__ void tri_mask(f32x4 (&acc)[2], int m0, int n0) {
#pragma unroll
    for (int tn = 0; tn < 2; ++tn)
#pragma unroll
        for (int r = 0; r < 4; ++r) { const int m = m0 + r, n = n0 + 16 * tn; if (INCL ? (n > m) : (n >= m)) acc[tn][r] = 0.f; }
}
__device__ __forceinline__ void st_acc_g(const f32x4 (&acc)[2], f16* base, int u, int w, int lane) {
#pragma unroll
    for (int tn = 0; tn < 2; ++tn) { const f16x4 v = {(f16)acc[tn][0], (f16)acc[tn][1], (f16)acc[tn][2], (f16)acc[tn][3]}; ((f16x4*)base)[((size_t)u * 16 + w * 2 + tn) * 64 + lane] = v; }
}
__device__ __forceinline__ float fast_tanh(float x) { const float e = __expf(2.f * x); return 1.f - 2.f / (e + 1.f); }

__device__ __forceinline__ void p_rwkv_local(const Args& a, LAS unsigned char* lds) {
    const int tid = threadIdx.x, lane = tid & 63, w = __builtin_amdgcn_readfirstlane(tid >> 6);
    const int m0 = 16 * (w >> 1) + 4 * (lane >> 4), n0 = 32 * (w & 1) + (lane & 15);
    const int et = tid >> 3, cg = tid & 7;
    const f16* z = (const f16*)(a.ws + WS_Z);
    unsigned char* ro = (unsigned char*)a.out;
    LAS float* FW = (LAS float*)(lds + 8 * SLOT); LAS float* FA = FW + 64 * RW_FS; LAS float* TOT = FA + 64 * RW_FS; LAS float* GCL = (LAS float*)(lds + RW_GCL);
    const float* mu = a.in[I_MU];
    for (int u = blockIdx.x; u < 4096; u += gridDim.x) {
        const int c = u >> 4, h = u & 15, t0 = c * 64, ch0 = h * 64 + 8 * cg, uo = h * 256 + c;
        float r_[8], k_[8], v_[8];
        { const int t = t0 + et; const f16* cur = z + (size_t)t * NZ; const f16* prv = cur - NZ; const bool hp = t > 0;
          f16x8 c8, p8; const f16x8 zero8 = {0, 0, 0, 0, 0, 0, 0, 0};
          c8 = *(const f16x8*)(cur + ZR + ch0); p8 = hp ? *(const f16x8*)(prv + ZR + ch0) : zero8;
#pragma unroll
          for (int e = 0; e < 8; ++e) r_[e] = (float)c8[e] + ((float)p8[e] - (float)c8[e]) * mu[ch0 + e];
          c8 = *(const f16x8*)(cur + ZK + ch0); p8 = hp ? *(const f16x8*)(prv + ZK + ch0) : zero8;
#pragma unroll
          for (int e = 0; e < 8; ++e) k_[e] = (float)c8[e] + ((float)p8[e] - (float)c8[e]) * mu[1024 + ch0 + e];
          c8 = *(const f16x8*)(cur + ZV + ch0); p8 = hp ? *(const f16x8*)(prv + ZV + ch0) : zero8;
#pragma unroll
          for (int e = 0; e < 8; ++e) v_[e] = (float)c8[e] + ((float)p8[e] - (float)c8[e]) * mu[2048 + ch0 + e];
          bf16x8 x1, x2;
          c8 = *(const f16x8*)(cur + ZWD + 8 * cg); p8 = hp ? *(const f16x8*)(prv + ZWD + 8 * cg) : zero8;
#pragma unroll
          for (int e = 0; e < 8; ++e) x1[e] = (bf16)fast_tanh((float)c8[e] + ((float)p8[e] - (float)c8[e]) * mu[3072 + 8 * cg + e]);
          c8 = *(const f16x8*)(cur + ZAD + 8 * cg); p8 = hp ? *(const f16x8*)(prv + ZAD + 8 * cg) : zero8;
#pragma unroll
          for (int e = 0; e < 8; ++e) x2[e] = (bf16)((float)c8[e] + ((float)p8[e] - (float)c8[e]) * mu[3136 + 8 * cg + e]);
          *(LAS bf16x8*)(RW_SLOT(lds, 0) + et * RS + 8 * cg) = x1; *(LAS bf16x8*)(RW_SLOT(lds, 1) + et * RS + 8 * cg) = x2;
          *(LAS u32x4*)(RW_SLOT(lds, 2) + et * RS + 8 * cg) = *(const u32x4*)((const bf16*)(a.ws + WS_WUPT) + (size_t)(h * 64 + et) * 64 + 8 * cg);
          *(LAS u32x4*)(RW_SLOT(lds, 3) + et * RS + 8 * cg) = *(const u32x4*)((const bf16*)(a.ws + WS_AUPT) + (size_t)(h * 64 + et) * 64 + 8 * cg); }
        __syncthreads();
        { f32x4 acc[2]; acc_zero(acc); mm_acc<2>(acc, RW_SLOT(lds, 0), RS, RW_SLOT(lds, 2), RS, w, lane);
#pragma unroll
          for (int tn = 0; tn < 2; ++tn)
#pragma unroll
              for (int r = 0; r < 4; ++r) FW[(m0 + r) * RW_FS + n0 + 16 * tn] = acc[tn][r];
          acc_zero(acc); mm_acc<2>(acc, RW_SLOT(lds, 1), RS, RW_SLOT(lds, 3), RS, w, lane);
#pragma unroll
          for (int tn = 0; tn < 2; ++tn)
#pragma unroll
              for (int r = 0; r < 4; ++r) FA[(m0 + r) * RW_FS + n0 + 16 * tn] = acc[tn][r]; }
        __syncthreads();
        float lw_[8], kk_[8], b_[8];
        { float ss = 0.f, sb = 0.f;
#pragma unroll
          for (int e = 0; e < 8; ++e) { const int ch = ch0 + e;
              const float wpre = a.in[I_W0][ch] + FW[et * RW_FS + 8 * cg + e]; const float y0 = -wpre; const float sp = fmaxf(y0, 0.f) + __logf(1.f + __expf(-fabsf(y0)));
              lw_[e] = -__expf(-sp - 0.5f);
              const float av = sigmoidf_(a.in[I_A0][ch] + FA[et * RW_FS + 8 * cg + e]);
              const float kkr = k_[e] * a.in[I_KK][ch]; ss += kkr * kkr; kk_[e] = kkr;
              k_[e] = k_[e] * (1.f + (av - 1.f) * a.in[I_KA][ch]); b_[e] = av;
              sb += r_[e] * k_[e] * a.in[I_RK][ch]; }
          ss += __shfl_xor(ss, 1); ss += __shfl_xor(ss, 2); ss += __shfl_xor(ss, 4);
          sb += __shfl_xor(sb, 1); sb += __shfl_xor(sb, 2); sb += __shfl_xor(sb, 4);
          const float rn = rsqrtf(fmaxf(ss, 1e-24f));
#pragma unroll
          for (int e = 0; e < 8; ++e) { kk_[e] *= rn; b_[e] *= kk_[e]; FW[et * RW_FS + 8 * cg + e] = lw_[e]; }
          if (cg == 0) ((float*)(a.ws + WS_SBON))[(size_t)(t0 + et) * 16 + h] = sb; }
        __syncthreads();
        { const int j = tid & 63, rg = tid >> 6; float run = 0.f;
#pragma unroll
          for (int i = 0; i < 8; ++i) { run += FW[(8 * rg + i) * RW_FS + j]; FW[(8 * rg + i) * RW_FS + j] = run; }
          TOT[rg * 64 + j] = run;
          __syncthreads();
          float off = 0.f;
          for (int q = 0; q < rg; ++q) off += TOT[q * 64 + j];
#pragma unroll
          for (int i = 0; i < 8; ++i) FW[(8 * rg + i) * RW_FS + j] += off; }
        __syncthreads();
        { bf16x8 at, bt, kt, rt;
#pragma unroll
          for (int e = 0; e < 8; ++e) { const int jj = 8 * cg + e; const float cum = FW[et * RW_FS + jj], cl = FW[63 * RW_FS + jj];
              const float eA = __expf(cum - lw_[e]), eN = __expf(-cum), eP = __expf(cum), eH = __expf(cl - cum);
              const float A_ = -kk_[e] * eA;
              at[e] = (bf16)A_; bt[e] = (bf16)(b_[e] * eN); kt[e] = (bf16)(k_[e] * eN); rt[e] = (bf16)(r_[e] * eP);
              RW_SLOT(lds, 1)[jj * RS + et] = (bf16)A_; RW_SLOT(lds, 5)[jj * RS + et] = (bf16)(b_[e] * eH); RW_SLOT(lds, 6)[jj * RS + et] = (bf16)(k_[e] * eH); RW_SLOT(lds, 7)[jj * RS + et] = (bf16)v_[e];
              if (et == 63) GCL[jj] = __expf(cl); }
          *(LAS bf16x8*)(RW_SLOT(lds, 0) + et * RS + 8 * cg) = at; *(LAS bf16x8*)(RW_SLOT(lds, 2) + et * RS + 8 * cg) = bt;
          *(LAS bf16x8*)(RW_SLOT(lds, 3) + et * RS + 8 * cg) = kt; *(LAS bf16x8*)(RW_SLOT(lds, 4) + et * RS + 8 * cg) = rt; }
        __syncthreads();
        { f32x4 acc[2];
          acc_zero(acc); mm_acc<2>(acc, RW_SLOT(lds, 0), RS, RW_SLOT(lds, 2), RS, w, lane); tri_mask<false>(acc, m0, n0);
          st_n(acc, RW_SLOT(lds, 8), m0, n0); st_t(acc, RW_SLOT(lds, 9), m0, n0);
#pragma unroll
          for (int tn = 0; tn < 2; ++tn)
#pragma unroll
              for (int r = 0; r < 4; ++r) if (m0 + r == n0 + 16 * tn) acc[tn][r] += 1.f;
          st_n(acc, RW_SLOT(lds, 13), m0, n0);
          acc_zero(acc); mm_acc<2>(acc, RW_SLOT(lds, 0), RS, RW_SLOT(lds, 3), RS, w, lane); tri_mask<false>(acc, m0, n0); st_t(acc, RW_SLOT(lds, 10), m0, n0);
          acc_zero(acc); mm_acc<2>(acc, RW_SLOT(lds, 4), RS, RW_SLOT(lds, 2), RS, w, lane); tri_mask<true>(acc, m0, n0); st_n(acc, RW_SLOT(lds, 11), m0, n0);
          acc_zero(acc); mm_acc<2>(acc, RW_SLOT(lds, 4), RS, RW_SLOT(lds, 3), RS, w, lane); tri_mask<true>(acc, m0, n0); st_n(acc, RW_SLOT(lds, 12), m0, n0); }
        __syncthreads();
        { f32x4 acc[2];
          acc_zero(acc); mm_acc<2>(acc, RW_SLOT(lds, 8), RS, RW_SLOT(lds, 9), RS, w, lane); st_n(acc, RW_SLOT(lds, 0), m0, n0); st_t(acc, RW_SLOT(lds, 2), m0, n0);
          __syncthreads();
          ld_n(acc, RW_SLOT(lds, 13), m0, n0); mm_acc<2>(acc, RW_SLOT(lds, 13), RS, RW_SLOT(lds, 2), RS, w, lane); st_n(acc, RW_SLOT(lds, 3), m0, n0);
          acc_zero(acc); mm_acc<2>(acc, RW_SLOT(lds, 0), RS, RW_SLOT(lds, 2), RS, w, lane); st_n(acc, RW_SLOT(lds, 8), m0, n0); st_t(acc, RW_SLOT(lds, 9), m0, n0);
          __syncthreads();
          ld_n(acc, RW_SLOT(lds, 3), m0, n0); mm_acc<2>(acc, RW_SLOT(lds, 3), RS, RW_SLOT(lds, 9), RS, w, lane); st_n(acc, RW_SLOT(lds, 13), m0, n0);
          acc_zero(acc); mm_acc<2>(acc, RW_SLOT(lds, 8), RS, RW_SLOT(lds, 9), RS, w, lane); st_n(acc, RW_SLOT(lds, 0), m0, n0); st_t(acc, RW_SLOT(lds, 2), m0, n0);
          __syncthreads();
          ld_n(acc, RW_SLOT(lds, 13), m0, n0); mm_acc<2>(acc, RW_SLOT(lds, 13), RS, RW_SLOT(lds, 2), RS, w, lane); st_n(acc, RW_SLOT(lds, 3), m0, n0);
          acc_zero(acc); mm_acc<2>(acc, RW_SLOT(lds, 0), RS, RW_SLOT(lds, 2), RS, w, lane); st_n(acc, RW_SLOT(lds, 8), m0, n0); st_t(acc, RW_SLOT(lds, 9), m0, n0);
          __syncthreads();
          ld_n(acc, RW_SLOT(lds, 3), m0, n0); mm_acc<2>(acc, RW_SLOT(lds, 3), RS, RW_SLOT(lds, 9), RS, w, lane); st_n(acc, RW_SLOT(lds, 13), m0, n0);
          acc_zero(acc); mm_acc<2>(acc, RW_SLOT(lds, 8), RS, RW_SLOT(lds, 9), RS, w, lane); st_t(acc, RW_SLOT(lds, 2), m0, n0);
          __syncthreads();
          ld_n(acc, RW_SLOT(lds, 13), m0, n0); mm_acc<2>(acc, RW_SLOT(lds, 13), RS, RW_SLOT(lds, 2), RS, w, lane); st_n(acc, RW_SLOT(lds, 3), m0, n0);
          __syncthreads();
          acc_zero(acc); mm_acc<2>(acc, RW_SLOT(lds, 1), RS, RW_SLOT(lds, 3), RS, w, lane); st_n(acc, RW_SLOT(lds, 0), m0, n0);
          acc_zero(acc); mm_acc<2>(acc, RW_SLOT(lds, 3), RS, RW_SLOT(lds, 10), RS, w, lane); st_n(acc, RW_SLOT(lds, 8), m0, n0);
          __syncthreads();
          acc_zero(acc); mm_acc<2>(acc, RW_SLOT(lds, 7), RS, RW_SLOT(lds, 8), RS, w, lane); st_n(acc, RW_SLOT(lds, 9), m0, n0);
          acc_zero(acc); mm_acc<2>(acc, RW_SLOT(lds, 0), RS, RW_SLOT(lds, 11), RS, w, lane);
#pragma unroll
          for (int tn = 0; tn < 2; ++tn) { const int tt = n0 + 16 * tn; const bf16x4 rr = *(const LAS bf16x4*)(RW_SLOT(lds, 4) + tt * RS + m0);
              const bf16x4 o = {(bf16)(acc[tn][0] + (float)rr[0]), (bf16)(acc[tn][1] + (float)rr[1]), (bf16)(acc[tn][2] + (float)rr[2]), (bf16)(acc[tn][3] + (float)rr[3])};
              *(bf16x4*)((bf16*)(ro + RO_Q) + (size_t)uo * 4096 + tt * 64 + m0) = o; }
          acc_zero(acc); mm_acc<2>(acc, RW_SLOT(lds, 0), RS, RW_SLOT(lds, 5), RS, w, lane);
#pragma unroll
          for (int tn = 0; tn < 2; ++tn) { const int jj = n0 + 16 * tn; const float gc = GCL[jj];
              const bf16x4 o = {(bf16)(acc[tn][0] + (m0 == jj ? gc : 0.f)), (bf16)(acc[tn][1] + (m0 + 1 == jj ? gc : 0.f)), (bf16)(acc[tn][2] + (m0 + 2 == jj ? gc : 0.f)), (bf16)(acc[tn][3] + (m0 + 3 == jj ? gc : 0.f))};
              *(bf16x4*)((bf16*)(ro + RO_M) + (size_t)uo * 4096 + jj * 64 + m0) = o; }
          __syncthreads();
          acc_zero(acc); mm_acc<2>(acc, RW_SLOT(lds, 11), RS, RW_SLOT(lds, 9), RS, w, lane); mm_acc<2>(acc, RW_SLOT(lds, 12), RS, RW_SLOT(lds, 7), RS, w, lane); st_acc_g(acc, (f16*)(ro + RO_Y), uo, w, lane);
          acc_zero(acc); mm_acc<2>(acc, RW_SLOT(lds, 9), RS, RW_SLOT(lds, 5), RS, w, lane); mm_acc<2>(acc, RW_SLOT(lds, 7), RS, RW_SLOT(lds, 6), RS, w, lane); st_acc_g(acc, (f16*)(ro + RO_N), uo, w, lane);
        }
    }
}
__device__ __forceinline__ void p_rwkv_scan(const Args& a, LAS unsigned char* lds, int h) {
    const int tid = threadIdx.x, lane = tid & 63, w = __builtin_amdgcn_readfirstlane(tid >> 6);
    const int m0 = 16 * (w >> 1) + 4 * (lane >> 4), n0 = 32 * (w & 1) + (lane & 15), row = tid >> 3, seg = tid & 7;
    const unsigned char* ro = (const unsigned char*)a.out;
    const bf16* Mg = (const bf16*)(ro + RO_M) + (size_t)h * 256 * 4096; const f16x4* Ng = (const f16x4*)(ro + RO_N) + (size_t)h * 256 * 1024; bf16* Sg = (bf16*)(a.ws + WS_RS) + (size_t)h * 256 * 4096;
    f32x4 acc[2]; acc_zero(acc);
    u32x4 mreg = *(const u32x4*)(Mg + row * 64 + seg * 8); f16x4 nreg[2] = {Ng[(w * 2) * 64 + lane], Ng[(w * 2 + 1) * 64 + lane]};
    for (int c = 0; c < 256; ++c) {
        LAS bf16* Sb = RW_SLOT(lds, c & 1); LAS bf16* Mb = RW_SLOT(lds, 2 + (c & 1));
        st_n(acc, Sb, m0, n0);
        *(LAS u32x4*)(Mb + row * RS + seg * 8) = mreg;
        const f16x4 nc0 = nreg[0], nc1 = nreg[1];
        if (c + 1 < 256) { mreg = *(const u32x4*)(Mg + (size_t)(c + 1) * 4096 + row * 64 + seg * 8); nreg[0] = Ng[(size_t)(c + 1) * 1024 + (w * 2) * 64 + lane]; nreg[1] = Ng[(size_t)(c + 1) * 1024 + (w * 2 + 1) * 64 + lane]; }
        __syncthreads();
        *(u32x4*)(Sg + (size_t)c * 4096 + row * 64 + seg * 8) = *(const LAS u32x4*)(Sb + row * RS + seg * 8);
        acc[0] = (f32x4){(float)nc0[0], (float)nc0[1], (float)nc0[2], (float)nc0[3]}; acc[1] = (f32x4){(float)nc1[0], (float)nc1[1], (float)nc1[2], (float)nc1[3]};
        mm_acc<2>(acc, Sb, RS, Mb, RS, w, lane);
    }
}
constexpr int RG_S = 168;
__device__ __forceinline__ void p_rwkv_out(const Args& a, LAS unsigned char* lds) {
    const int tid = threadIdx.x, lane = tid & 63, w = __builtin_amdgcn_readfirstlane(tid >> 6);
    const int m0 = 16 * (w >> 1) + 4 * (lane >> 4), n0 = 32 * (w & 1) + (lane & 15), row = tid >> 3, seg = tid & 7;
    const f16* z = (const f16*)(a.ws + WS_Z); const unsigned char* ro = (const unsigned char*)a.out; f16* mix = (f16*)(a.ws + WS_MIX);
    const float* mu = a.in[I_MU];
    LAS bf16* SG = (LAS bf16*)(lds + 2 * SLOT); LAS bf16* GU = SG + 64 * RG_S; LAS float* RED = (LAS float*)(GU + 64 * RG_S);
    for (int u = blockIdx.x; u < 4096; u += gridDim.x) {
        const int c = u >> 4, h = u & 15, t0 = c * 64, uo = h * 256 + c;
        __syncthreads();
        *(LAS u32x4*)(RW_SLOT(lds, 0) + row * RS + seg * 8) = *(const u32x4*)((const bf16*)(ro + RO_Q) + (size_t)uo * 4096 + row * 64 + seg * 8);
        *(LAS u32x4*)(RW_SLOT(lds, 1) + row * RS + seg * 8) = *(const u32x4*)((const bf16*)(a.ws + WS_RS) + (size_t)uo * 4096 + row * 64 + seg * 8);
        for (int ck = tid; ck < 64 * 20; ck += 512) { const int rr = ck / 20, c8 = ck % 20, t = t0 + rr; const f16* cur = z + (size_t)t * NZ + ZGD + 8 * c8;
            const f16x8 cv = *(const f16x8*)cur; const f16x8 zero8 = {0, 0, 0, 0, 0, 0, 0, 0}; const f16x8 pv = t > 0 ? *(const f16x8*)(cur - NZ) : zero8; bf16x8 o;
#pragma unroll
            for (int e = 0; e < 8; ++e) o[e] = (bf16)sigmoidf_((float)cv[e] + ((float)pv[e] - (float)cv[e]) * mu[3200 + 8 * c8 + e]);
            *(LAS bf16x8*)(SG + rr * RG_S + 8 * c8) = o;
            *(LAS u32x4*)(GU + rr * RG_S + 8 * c8) = *(const u32x4*)((const bf16*)(a.ws + WS_GUPT) + (size_t)(h * 64 + rr) * 160 + 8 * c8); }
        __syncthreads();
        f32x4 y[2], g[2];
        { const f16x4* Yg = (const f16x4*)(ro + RO_Y) + (size_t)uo * 1024; const f16x4 y0 = Yg[(w * 2) * 64 + lane], y1 = Yg[(w * 2 + 1) * 64 + lane];
          y[0] = (f32x4){(float)y0[0], (float)y0[1], (float)y0[2], (float)y0[3]}; y[1] = (f32x4){(float)y1[0], (float)y1[1], (float)y1[2], (float)y1[3]}; }
        mm_acc<2>(y, RW_SLOT(lds, 0), RS, RW_SLOT(lds, 1), RS, w, lane);
        acc_zero(g); mm_acc<5>(g, SG, RG_S, GU, RG_S, w, lane);
        float s1[4], s2[4];
#pragma unroll
        for (int r = 0; r < 4; ++r) { s1[r] = y[0][r] + y[1][r]; s2[r] = y[0][r] * y[0][r] + y[1][r] * y[1][r];
#pragma unroll
            for (int o = 1; o < 16; o <<= 1) { s1[r] += __shfl_xor(s1[r], o); s2[r] += __shfl_xor(s2[r], o); }
            if ((lane & 15) == 0) { RED[((m0 + r) * 2 + (w & 1)) * 2] = s1[r]; RED[((m0 + r) * 2 + (w & 1)) * 2 + 1] = s2[r]; } }
        __syncthreads();
#pragma unroll
        for (int r = 0; r < 4; ++r) { const int tt = m0 + r, t = t0 + tt;
            const float sum = RED[(tt * 2) * 2] + RED[(tt * 2 + 1) * 2], sq = RED[(tt * 2) * 2 + 1] + RED[(tt * 2 + 1) * 2 + 1];
            const float mean = sum * (1.f / 64.f), var = fmaxf(sq * (1.f / 64.f) - mean * mean, 0.f), rstd = rsqrtf(var + 64e-5f);
            const float sbn = ((const float*)(a.ws + WS_SBON))[(size_t)t * 16 + h];
#pragma unroll
            for (int tn = 0; tn < 2; ++tn) { const int ch = h * 64 + n0 + 16 * tn; const f16* cur = z + (size_t)t * NZ + ZV + ch;
                const float cv = (float)cur[0], pv = t > 0 ? (float)cur[-NZ] : 0.f; const float vv = cv + (pv - cv) * mu[2048 + ch];
                const float yn = (y[tn][r] - mean) * rstd * a.in[I_LNXG][ch] + a.in[I_LNXB][ch];
                mix[(size_t)t * D + 1024 + ch] = (f16)((yn + sbn * vv) * g[tn][r]); } }
    }
}

__device__ __forceinline__ void p_rwkv_naive(const Args& a, LAS unsigned char* lds, int h) {
    const int tid = threadIdx.x; if (tid >= 64) return; const int i = tid;
    LAS float* Wl = (LAS float*)lds;
    LAS float* vin = Wl + 288 * 64;
    LAS float* vw = vin + 288; LAS float* vkk = vw + 64; LAS float* vb = vkk + 64; LAS float* vkp = vb + 64; LAS float* vr = vkp + 64;
    const int ch = h * 64 + i;
    for (int j = 0; j < 64; ++j) { Wl[j * 64 + i] = a.in[I_WUP][j * 1024 + ch]; Wl[(64 + j) * 64 + i] = a.in[I_AUP][j * 1024 + ch]; }
    for (int j = 0; j < 160; ++j) Wl[(128 + j) * 64 + i] = a.in[I_GUP][j * 1024 + ch];
    const float* mu = a.in[I_MU];
    const float mu_r = mu[ch], mu_k = mu[1024 + ch], mu_v = mu[2048 + ch], mu_wd = mu[3072 + i], mu_ad = mu[3136 + i], mu_g0 = mu[3200 + i], mu_g1 = mu[3264 + i], mu_g2 = (i < 32) ? mu[3328 + i] : 0.f;
    const float w0 = a.in[I_W0][ch], a0 = a.in[I_A0][ch], k_k = a.in[I_KK][ch], k_a = a.in[I_KA][ch], r_k = a.in[I_RK][ch], lg = a.in[I_LNXG][ch], lb = a.in[I_LNXB][ch];
    const f16* z = (const f16*)(a.ws + WS_Z); f16* mix = (f16*)(a.ws + WS_MIX);
    float S[64];
#pragma unroll
    for (int j = 0; j < 64; ++j) S[j] = 0.f;
    float pr = 0.f, pk = 0.f, pv = 0.f, pwd = 0.f, pad = 0.f, pg0 = 0.f, pg1 = 0.f, pg2 = 0.f;
    const f16* zr = z;
    float cr = (float)zr[ZR + ch], ck = (float)zr[ZK + ch], cv = (float)zr[ZV + ch], cwd = (float)zr[ZWD + i], cad = (float)zr[ZAD + i], cg0 = (float)zr[ZGD + i], cg1 = (float)zr[ZGD + 64 + i], cg2 = (i < 32) ? (float)zr[ZGD + 128 + i] : 0.f;
    LDS_WAIT();
    for (int t = 0; t < T; ++t) {
        float nr = 0.f, nk = 0.f, nv = 0.f, nwd = 0.f, nad = 0.f, ng0 = 0.f, ng1 = 0.f, ng2 = 0.f;
        if (t + 1 < T) { const f16* zn = z + (size_t)(t + 1) * NZ; nr = (float)zn[ZR + ch]; nk = (float)zn[ZK + ch]; nv = (float)zn[ZV + ch]; nwd = (float)zn[ZWD + i]; nad = (float)zn[ZAD + i];
            ng0 = (float)zn[ZGD + i]; ng1 = (float)zn[ZGD + 64 + i]; ng2 = (i < 32) ? (float)zn[ZGD + 128 + i] : 0.f; }
        const float r = cr + (pr - cr) * mu_r, k = ck + (pk - ck) * mu_k, v = cv + (pv - cv) * mu_v;
        const float wd = cwd + (pwd - cwd) * mu_wd, ad = cad + (pad - cad) * mu_ad, g0 = cg0 + (pg0 - cg0) * mu_g0, g1 = cg1 + (pg1 - cg1) * mu_g1, g2 = cg2 + (pg2 - cg2) * mu_g2;
        vin[i] = tanhf(wd); vin[64 + i] = ad; vin[128 + i] = sigmoidf_(g0); vin[192 + i] = sigmoidf_(g1); if (i < 32) vin[256 + i] = sigmoidf_(g2);
        LDS_WAIT();
        float wpre = w0, apre = a0, gg = 0.f;
#pragma unroll 8
        for (int j = 0; j < 64; ++j) { wpre += vin[j] * Wl[j * 64 + i]; apre += vin[64 + j] * Wl[(64 + j) * 64 + i]; }
#pragma unroll 8
        for (int j = 0; j < 160; ++j) gg += vin[128 + j] * Wl[(128 + j) * 64 + i];
        const float y0 = -wpre; const float sp = fmaxf(y0, 0.f) + log1pf(__expf(-fabsf(y0)));
        const float wlog = -sp - 0.5f; const float dec = __expf(-__expf(wlog));
        const float av = sigmoidf_(apre);
        const float kkr = k * k_k; const float ss = wave_sum(kkr * kkr); const float kk = kkr * rsqrtf(fmaxf(ss, 1e-24f));
        const float kp = k * (1.f + (av - 1.f) * k_a);
        vw[i] = dec; vkk[i] = kk; vb[i] = kk * av; vkp[i] = kp; vr[i] = r;
        LDS_WAIT();
        float sa = 0.f;
#pragma unroll
        for (int j = 0; j < 64; j += 4) { const f32x4 k4 = *(const LAS f32x4*)(vkk + j); sa -= S[j] * k4.x + S[j + 1] * k4.y + S[j + 2] * k4.z + S[j + 3] * k4.w; }
        float y = 0.f;
#pragma unroll
        for (int j = 0; j < 64; j += 4) { const f32x4 w4 = *(const LAS f32x4*)(vw + j), b4 = *(const LAS f32x4*)(vb + j), p4 = *(const LAS f32x4*)(vkp + j), r4 = *(const LAS f32x4*)(vr + j);
            S[j] = S[j] * w4.x + sa * b4.x + v * p4.x; S[j + 1] = S[j + 1] * w4.y + sa * b4.y + v * p4.y; S[j + 2] = S[j + 2] * w4.z + sa * b4.z + v * p4.z; S[j + 3] = S[j + 3] * w4.w + sa * b4.w + v * p4.w;
            y += S[j] * r4.x + S[j + 1] * r4.y + S[j + 2] * r4.z + S[j + 3] * r4.w; }
        const float mean = wave_sum(y) * (1.f / 64.f); const float dv = y - mean; const float var = wave_sum(dv * dv) * (1.f / 64.f);
        const float yn = dv * rsqrtf(var + 64e-5f) * lg + lb;
        const float bonus = wave_sum(r * kp * r_k) * v;
        mix[(size_t)t * D + 1024 + ch] = (f16)((yn + bonus) * gg);
        pr = cr; pk = ck; pv = cv; pwd = cwd; pad = cad; pg0 = cg0; pg1 = cg1; pg2 = cg2;
        cr = nr; ck = nk; cv = nv; cwd = nwd; cad = nad; cg0 = ng0; cg1 = ng1; cg2 = ng2;
        LDS_WAIT();
    }
}

__device__ __forceinline__ void p_router(const Args& a, LAS unsigned char* lds) {
    const int tid = threadIdx.x, lane = tid & 63, wave = tid >> 6, gw = blockIdx.x * 8 + wave, NGW = gridDim.x * 8;
    const float* x2 = (const float*)(a.ws + WS_X1); f16* h3 = (f16*)a.out;
    unsigned* ctl = (unsigned*)(a.ws + WS_CTL);
    int* tke = (int*)(a.ws + WS_TOK + TK_E); float* tkw = (float*)(a.ws + WS_TOK + TK_W);
    const float* Wg = a.in[I_RGW]; const float* We = a.in[I_REW];
    for (int m = gw; m < T; m += NGW) {
        const f32x4* xr = (const f32x4*)(x2 + (size_t)m * D) + lane; f32x4 v[8]; float s = 0.f;
#pragma unroll
        for (int j = 0; j < 8; ++j) { v[j] = xr[64 * j]; s += v[j].x * v[j].x + v[j].y * v[j].y + v[j].z * v[j].z + v[j].w * v[j].w; }
        const float rstd = rsqrtf(wave_sum(s) * (1.f / D) + EPS);
        const f32x4* gr = (const f32x4*)a.in[I_LN3] + lane; u32x2* o8 = (u32x2*)(h3 + (size_t)m * D) + lane;
#pragma unroll
        for (int j = 0; j < 8; ++j) { const f32x4 gg = gr[64 * j]; v[j].x *= rstd * gg.x; v[j].y *= rstd * gg.y; v[j].z *= rstd * gg.z; v[j].w *= rstd * gg.w;
            u32x2 w; w.x = pkh(v[j].x, v[j].y); w.y = pkh(v[j].z, v[j].w); o8[64 * j] = w; }
        LAS float* xs = (LAS float*)(lds + wave * 8192);
#pragma unroll
        for (int j = 0; j < 8; ++j) *(LAS f32x4*)(xs + j * 256 + lane * 4) = v[j];
        LDS_WAIT();
        float lg[4] = {0.f, 0.f, 0.f, 0.f};
#pragma unroll 2
        for (int k = 0; k < 32; ++k) { const int i = k * 64 + lane; const float xv = xs[i]; const f32x4 w4 = *(const f32x4*)(Wg + (size_t)i * 4);
            lg[0] += xv * w4.x; lg[1] += xv * w4.y; lg[2] += xv * w4.z; lg[3] += xv * w4.w; }
#pragma unroll
        for (int c = 0; c < 4; ++c) lg[c] = wave_sum(lg[c]) + a.in[I_RGB][c];
        int gi = 0; float gm = lg[0];
#pragma unroll
        for (int c = 1; c < 4; ++c) if (lg[c] > gm) { gm = lg[c]; gi = c; }
        float gs = 0.f;
#pragma unroll
        for (int c = 0; c < 4; ++c) gs += __expf(lg[c] - gm);
        const float pg = 1.f / gs;
        float le[8] = {0.f, 0.f, 0.f, 0.f, 0.f, 0.f, 0.f, 0.f};
#pragma unroll 2
        for (int k = 0; k < 32; ++k) { const int i = k * 64 + lane; const float xv = xs[i]; const f32x4* wp = (const f32x4*)(We + (size_t)i * 32 + gi * 8); const f32x4 wa = wp[0], wb = wp[1];
            le[0] += xv * wa.x; le[1] += xv * wa.y; le[2] += xv * wa.z; le[3] += xv * wa.w; le[4] += xv * wb.x; le[5] += xv * wb.y; le[6] += xv * wb.z; le[7] += xv * wb.w; }
#pragma unroll
        for (int c = 0; c < 8; ++c) le[c] = wave_sum(le[c]) + a.in[I_REB][gi * 8 + c];
        LDS_WAIT();
        int e1 = 0; float m1 = le[0];
#pragma unroll
        for (int c = 1; c < 8; ++c) if (le[c] > m1) { m1 = le[c]; e1 = c; }
        int e2 = -1; float m2 = -INFINITY;
#pragma unroll
        for (int c = 0; c < 8; ++c) if (c != e1 && le[c] > m2) { m2 = le[c]; e2 = c; }
        const float p1 = 1.f, p2 = __expf(m2 - m1);
        const float w1 = pg * p1 / (p1 + p2), w2 = pg * p2 / (p1 + p2);
        if (lane == 0) { const int E1 = gi * 8 + e1, E2 = gi * 8 + e2; tke[m * 2] = E1; tke[m * 2 + 1] = E2; tkw[m * 2] = w1; tkw[m * 2 + 1] = w2;
            atomicAdd(&ctl[CW_CNT + E1], 1u); atomicAdd(&ctl[CW_CNT + E2], 1u); }
    }
}
__device__ __forceinline__ void p_offsets(const Args& a) {
    if (blockIdx.x != 0) return;
    unsigned* ctl = (unsigned*)(a.ws + WS_CTL); int* stok = (int*)(a.ws + WS_TOK + TK_STOK); float* sw = (float*)(a.ws + WS_TOK + TK_SW);
    const int tid = threadIdx.x;
    if (tid == 0) {
        int off = 0, ngu = 0, ndn = 0; int2* ugu = (int2*)(ctl + CW_UGU); int2* udn = (int2*)(ctl + CW_UDN);
        for (int e = 0; e < NEXP; ++e) { const int n = (int)ctl[CW_CNT + e]; ctl[CW_OFF + e] = (unsigned)off; const int nt = (n + 255) / 256;
            for (int rt = 0; rt < nt; ++rt) { const int pm = off / 256 + rt; for (int jt = 0; jt < 2; ++jt) ugu[ngu++] = make_int2(pm, e * 2 + jt); for (int jt = 0; jt < 8; ++jt) udn[ndn++] = make_int2(pm, e * 8 + jt); }
            off += nt * 256; }
        ctl[CW_OFF + NEXP] = (unsigned)off; ctl[CW_NT] = (unsigned)(off / 256); ctl[CW_NGU] = (unsigned)ngu; ctl[CW_NDN] = (unsigned)ndn;
    }
    __syncthreads();
    for (int e = 0; e < NEXP; ++e) { const int n = (int)ctl[CW_CNT + e], off = (int)ctl[CW_OFF + e], end = (int)ctl[CW_OFF + e + 1];
        for (int s = off + n + tid; s < end; s += 512) { stok[s] = 0; sw[s] = 0.f; } }
}
__device__ __forceinline__ void p_slots(const Args& a) {
    unsigned* ctl = (unsigned*)(a.ws + WS_CTL);
    const int* tke = (const int*)(a.ws + WS_TOK + TK_E); const float* tkw = (const float*)(a.ws + WS_TOK + TK_W); int* tks = (int*)(a.ws + WS_TOK + TK_SLOT);
    int* stok = (int*)(a.ws + WS_TOK + TK_STOK); float* sw = (float*)(a.ws + WS_TOK + TK_SW);
    for (int i = blockIdx.x * 512 + threadIdx.x; i < T * 2; i += gridDim.x * 512) { const int e = tke[i]; const int slot = (int)ctl[CW_OFF + e] + (int)atomicAdd(&ctl[CW_CUR + e], 1u);
        stok[slot] = i >> 1; sw[slot] = tkw[i]; tks[i] = slot; }
}

constexpr int NPH = 17;
__global__ void __launch_bounds__(512, 2) mega(Args args) {
    extern __shared__ __attribute__((aligned(16))) unsigned char lds_raw[];
    LAS unsigned char* lds = (LAS unsigned char*)lds_raw;
    volatile LAS unsigned* MISC = (volatile LAS unsigned*)(lds + MISC_OFF);
    const int tid = threadIdx.x, lane = tid & 63, wave = tid >> 6;
    const int gw = blockIdx.x * 8 + wave, NGW = gridDim.x * 8, G = gridDim.x;
    unsigned char* ws = args.ws;
    unsigned* ctl = (unsigned*)(ws + WS_CTL);
    for (int u = tid; u < 512 / 4; u += 512) ((LAS unsigned*)(lds + MISC_OFF))[u] = 0u;
    __syncthreads();
    XcdBarrier bar; bar.bar = ctl + CW_BAR; bar.x = 0; bar.st = nullptr;
    const int lo = args.ph_lo, hi = args.ph_hi;
    if (hi - lo > 1) bar = xcd_barrier_post(ctl + CW_BAR, MISC + 8);
#ifndef PHMASK
#define PHMASK 0xFFFFFFFFu
#endif
#define IN(k) (((PHMASK >> (k)) & 1u) && lo <= (k) && (k) < hi)
#define BOTH(k) (IN(k) && IN((k) + 1))
#define GRID_BAR() xcd_barrier(bar)

    if (IN(0)) { p0_prologue(args, lds); if (BOTH(0)) GRID_BAR(); }
    if (IN(1)) {
        { pg8::Gemm g{(const f16*)(ws + WS_H), (const f16*)(ws + WS_WIN), D, D, D, nullptr}; pg8::StaticOrder S; S.init(T, NZ, G, (int)blockIdx.x);
          pg8::EpiF16 E{(f16*)(ws + WS_Z), NZ, 1.f}; pg8::gemm_phase<pg8::EpiF16, pg8::StaticOrder, true>(lds, g, S, E); }
        { const int b = blockIdx.x; const int which = b / 8;
          pg8::Gemm g{(const f16*)(ws + WS_MEMN), (const f16*)(ws + (which == 0 ? WS_WKT : WS_WVT)), D, D, D, nullptr}; pg8::StaticOrder S; S.init(256, D, 8, b < 16 ? b % 8 : 1 << 20);
          pg8::EpiF16 E{(f16*)(ws + (which == 0 ? WS_KM : WS_VM)), D, 1.f}; pg8::gemm_phase<pg8::EpiF16, pg8::StaticOrder, true>(lds, g, S, E); }
        if (BOTH(1)) GRID_BAR();
    }
    if (IN(2)) {
        p_compress(args, lds);
        __syncthreads();
        p_rwkv_local(args, lds);
        __syncthreads();
        { const int b = blockIdx.x; const int grp = b / 8, c = b % 8;
          if (grp < 4) { const int h = grp;
              pg8::Gemm g{(const f16*)(ws + WS_KM) + h * 512, (const f16*)(ws + WS_WQ16) + h * 512, D, D, 512, nullptr}; pg8::StaticOrder S; S.init(256, D, 8, c);
              pg8::EpiF16 E{(f16*)(ws + WS_WQK) + (size_t)h * 256 * D, D, 0.04419417382415922f}; pg8::gemm_phase<pg8::EpiF16, pg8::StaticOrder, true>(lds, g, S, E); }
          else if (grp < 8) { const int h = grp - 4;
              pg8::Gemm g{(const f16*)(ws + WS_WOT) + h * 512, (const f16*)(ws + WS_VM) + h * 512, D, D, 512, nullptr}; pg8::StaticOrder S; S.init(D, 256, 8, c);
              pg8::EpiF16 E{(f16*)(ws + WS_VOT) + h * 256, 1024, 1.f}; pg8::gemm_phase<pg8::EpiF16, pg8::StaticOrder, true>(lds, g, S, E); } }
        if (BOTH(2)) GRID_BAR();
    }
    if (IN(3)) {
        if (blockIdx.x < 16) p_rwkv_scan(args, lds, blockIdx.x);
        __syncthreads();
        p_nsa(args, lds);
        if (BOTH(3)) GRID_BAR();
    }
    if (IN(4)) { p_rwkv_out(args, lds); if (BOTH(4)) GRID_BAR(); }
    if (IN(5)) {
        const float* onsa = (const float*)(ws + WS_ONSA); f16* mix = (f16*)(ws + WS_MIX);
        for (int m = gw; m < T; m += NGW) { const f32x4* xr = (const f32x4*)(onsa + (size_t)m * 1024) + lane; f32x4 v[4]; float s = 0.f;
#pragma unroll
            for (int j = 0; j < 4; ++j) { v[j] = xr[64 * j]; s += v[j].x * v[j].x + v[j].y * v[j].y + v[j].z * v[j].z + v[j].w * v[j].w; }
            const float rstd = rsqrtf(wave_sum(s) * (1.f / 1024.f) + EPS); const f32x4* gr = (const f32x4*)args.in[I_NSAG] + lane; u32x2* o8 = (u32x2*)(mix + (size_t)m * D) + lane;
#pragma unroll
            for (int j = 0; j < 4; ++j) { const f32x4 gg = gr[64 * j]; u32x2 w; w.x = pkh(v[j].x * rstd * gg.x, v[j].y * rstd * gg.y); w.y = pkh(v[j].z * rstd * gg.z, v[j].w * rstd * gg.w); o8[64 * j] = w; } }
        if (BOTH(5)) GRID_BAR();
    }
    if (IN(6)) {
        pg8::Gemm g{(const f16*)(ws + WS_MIX), (const f16*)(ws + WS_WOUT), D, D, D, nullptr}; pg8::StaticOrder S; S.init(T, D, G, (int)blockIdx.x);
        pg8::EpiF32 E{(float*)(ws + WS_X1), args.in[I_X], D}; pg8::gemm_phase<pg8::EpiF32, pg8::StaticOrder, true>(lds, g, S, E);
        if (BOTH(6)) GRID_BAR();
    }
    if (IN(7)) {
        for (int m = gw; m < T; m += NGW) rms_row((const float*)(ws + WS_X1) + (size_t)m * D, args.in[I_LN2], (f16*)(ws + WS_H2) + (size_t)m * D, lane);
        p_moe_weights(args, lds);
        if (BOTH(7)) GRID_BAR();
    }
    if (IN(8)) {
        pg8::Gemm g{(const f16*)(ws + WS_H2), (const f16*)(ws + WS_WQK), D, D, D, nullptr}; pg8::StaticOrder S; S.init(T, 1024, G, (int)blockIdx.x);
        pg8::EpiF32 E{(float*)(ws + WS_S), nullptr, 1024}; pg8::gemm_phase<pg8::EpiF32, pg8::StaticOrder, true>(lds, g, S, E);
        if (BOTH(8)) GRID_BAR();
    }
    if (IN(9)) {
        const float* Sm = (const float*)(ws + WS_S); f16* P = (f16*)(ws + WS_P);
        for (int it = gw; it < T * 4; it += NGW) { const f32x4 v = *((const f32x4*)(Sm + (size_t)it * 256) + lane);
            const float mx = wave_max(fmaxf(fmaxf(v.x, v.y), fmaxf(v.z, v.w)));
            const float e0 = __expf(v.x - mx), e1 = __expf(v.y - mx), e2 = __expf(v.z - mx), e3 = __expf(v.w - mx);
            const float inv = 1.f / wave_sum(e0 + e1 + e2 + e3);
            u32x2 w; w.x = pkh(e0 * inv, e1 * inv); w.y = pkh(e2 * inv, e3 * inv); *((u32x2*)(P + (size_t)it * 256) + lane) = w; }
        if (BOTH(9)) GRID_BAR();
    }
    if (IN(10)) {
        pg8::Gemm g{(const f16*)(ws + WS_P), (const f16*)(ws + WS_VOT), 1024, 1024, 1024, nullptr}; pg8::StaticOrder S; S.init(T, D, G, (int)blockIdx.x);
        pg8::EpiF32 E{(float*)(ws + WS_X1), (const float*)(ws + WS_X1), D}; pg8::gemm_phase<pg8::EpiF32, pg8::StaticOrder, true>(lds, g, S, E);
        if (BOTH(10)) GRID_BAR();
    }
    if (IN(11)) { p_router(args, lds); if (BOTH(11)) GRID_BAR(); }
    if (IN(12)) { p_offsets(args); if (BOTH(12)) GRID_BAR(); }
    if (IN(13)) { p_slots(args); if (BOTH(13)) GRID_BAR(); }
    if (IN(14)) {
        pg8::Gemm g{(const f16*)args.out, (const f16*)(ws + WS_WGU), D, D, D, (const int*)(ws + WS_TOK + TK_STOK)};
        pg8::TableOrder S{(const int2*)(ctl + CW_UGU), (int)ctl[CW_NGU], G, (int)blockIdx.x};
        pg8::EpiSilu E{(f16*)(ws + WS_HID)}; pg8::gemm_phase<pg8::EpiSilu, pg8::TableOrder, true>(lds, g, S, E);
        if (BOTH(14)) GRID_BAR();
    }
    if (IN(15)) {
        pg8::Gemm g{(const f16*)(ws + WS_HID), (const f16*)(ws + WS_WD), EFF, EFF, EFF, nullptr};
        pg8::TableOrder S{(const int2*)(ctl + CW_UDN), (int)ctl[CW_NDN], G, (int)blockIdx.x};
        pg8::EpiDown E{ws}; pg8::gemm_phase<pg8::EpiDown, pg8::TableOrder, true>(lds, g, S, E);
        if (BOTH(15)) GRID_BAR();
    }
    if (IN(16)) {
        const float* x2 = (const float*)(ws + WS_X1); const int* tks = (const int*)(ws + WS_TOK + TK_SLOT);
        const float* tkw = (const float*)(ws + WS_TOK + TK_W);
        for (int m = gw; m < T; m += NGW) { const int s1 = tks[m * 2], s2 = tks[m * 2 + 1]; const float w1 = tkw[m * 2], w2 = tkw[m * 2 + 1];
            const f16* y1 = (const f16*)(ws + ((s1 >> 8) < 128 ? WS_Y0 + (size_t)(s1 >> 8) * MiB : WS_Y1 + (size_t)((s1 >> 8) - 128) * MiB)) + (size_t)(s1 & 255) * D;
            const f16* y2 = (const f16*)(ws + ((s2 >> 8) < 128 ? WS_Y0 + (size_t)(s2 >> 8) * MiB : WS_Y1 + (size_t)((s2 >> 8) - 128) * MiB)) + (size_t)(s2 & 255) * D;
            const f32x4* xr = (const f32x4*)(x2 + (size_t)m * D) + lane; f32x4 v[8]; float s = 0.f;
#pragma unroll
            for (int j = 0; j < 8; ++j) { v[j] = xr[64 * j]; const f16x4 a1 = *((const f16x4*)y1 + lane + 64 * j), a2 = *((const f16x4*)y2 + lane + 64 * j);
                v[j].x += w1 * (float)a1.x + w2 * (float)a2.x; v[j].y += w1 * (float)a1.y + w2 * (float)a2.y; v[j].z += w1 * (float)a1.z + w2 * (float)a2.z; v[j].w += w1 * (float)a1.w + w2 * (float)a2.w;
                s += v[j].x * v[j].x + v[j].y * v[j].y + v[j].z * v[j].z + v[j].w * v[j].w; }
            const float rstd = rsqrtf(wave_sum(s) * (1.f / D) + EPS); const f32x4* gr = (const f32x4*)args.in[I_LNF] + lane; f32x4* o = (f32x4*)(args.out + (size_t)m * D) + lane;
#pragma unroll
            for (int j = 0; j < 8; ++j) { const f32x4 gg = gr[64 * j]; o[64 * j] = (f32x4){v[j].x * rstd * gg.x, v[j].y * rstd * gg.y, v[j].z * rstd * gg.z, v[j].w * rstd * gg.w}; } }
    }
#undef IN
#undef BOTH
#undef GRID_BAR
}

extern "C" void kernel_launch(void* const* d_in, const int* in_sizes, int n_in, void* d_out, int out_size, void* d_ws, size_t ws_size, hipStream_t stream) {
    static int grid = 0;
    if (grid == 0) {
        if (n_in != 38 || out_size != T * D || ws_size < WS_END) { fprintf(stderr, "kernel_launch: unexpected shapes (n_in %d out %d ws %zu)\n", n_in, out_size, ws_size); grid = -1; return; }
        int dev = 0, cus = 0;
        if (hipGetDevice(&dev) != hipSuccess || hipDeviceGetAttribute(&cus, hipDeviceAttributeMultiprocessorCount, dev) != hipSuccess) { grid = -1; return; }
        if (hipFuncSetAttribute((const void*)mega, hipFuncAttributeMaxDynamicSharedMemorySize, LDS_BYTES) != hipSuccess) { grid = -1; return; }
        int per_cu = 0; (void)hipOccupancyMaxActiveBlocksPerMultiprocessor(&per_cu, (const void*)mega, 512, LDS_BYTES); (void)hipGetLastError();
        grid = cus;
    }
    if (grid < 0) return;
    (void)hipMemsetAsync((char*)d_ws + WS_CTL, 0, CTL_ZERO_BYTES, stream);
    Args a{};
    for (int i = 0; i < 38; ++i) a.in[i] = (const float*)d_in[i];
    a.out = (float*)d_out; a.ws = (unsigned char*)d_ws;
#if MK_ONE_LAUNCH
    a.ph_lo = 0; a.ph_hi = NPH;
    hipLaunchKernelGGL(mega, dim3(grid), dim3(512), LDS_BYTES, stream, a);
#else
    for (int p = 0; p < NPH; ++p) { a.ph_lo = p; a.ph_hi = p + 1; hipLaunchKernelGGL(mega, dim3(grid), dim3(512), LDS_BYTES, stream, a); }
#endif
}
```

```cpp
#include <hip/hip_runtime.h>
#include <cstdio>
#include <cstdint>

#ifndef DUPMASK
#define DUPMASK 0u
#endif
#ifndef MK_ONE_LAUNCH
#define MK_ONE_LAUNCH 1
#endif

#define LAS __attribute__((address_space(3)))
#define GAS __attribute__((address_space(1)))
typedef _Float16 f16;
typedef _Float16 f16x8 __attribute__((ext_vector_type(8)));
typedef _Float16 f16x4 __attribute__((ext_vector_type(4)));
typedef _Float16 f16x2 __attribute__((ext_vector_type(2)));
typedef float f32x4 __attribute__((ext_vector_type(4)));
typedef float f32x2 __attribute__((ext_vector_type(2)));
typedef unsigned u32x4 __attribute__((ext_vector_type(4)));
typedef unsigned u32x2 __attribute__((ext_vector_type(2)));
typedef __bf16 bf16;
typedef __bf16 bf16x8 __attribute__((ext_vector_type(8)));
typedef __bf16 bf16x4 __attribute__((ext_vector_type(4)));

constexpr int T = 16384, D = 2048, NZ = 6144;
constexpr int ZQ = 0, ZKC = 1024, ZVC = 1280, ZKS = 1536, ZVS = 1792, ZKW = 2048, ZVW = 2304, ZR = 2560, ZK = 3584, ZV = 4608, ZWD = 5632, ZAD = 5696, ZGD = 5760, ZGL = 5920;
constexpr int NCMP = 1023;
constexpr int NEXP = 32, EFF = 256, MAXSLOT = 40960, MAXTILES = 160;
constexpr float EPS = 1e-6f;

constexpr size_t MiB = 1u << 20;
constexpr size_t WS_CTL = 0, CTL_ZERO_BYTES = 64 * 1024;
constexpr size_t WS_MEMN = 1 * MiB, WS_KM = 2 * MiB, WS_VM = 3 * MiB, WS_KCMP = 4 * MiB, WS_VCMP = 5 * MiB, WS_TOK = 6 * MiB, WS_CMPB = 7 * MiB;
constexpr size_t WS_WQK = 8 * MiB, WS_VOT = 12 * MiB, WS_WIN = 16 * MiB, WS_WOUT = 40 * MiB, WS_WQ16 = 48 * MiB, WS_WKT = 56 * MiB, WS_WVT = 64 * MiB, WS_WOT = 72 * MiB;
constexpr size_t WS_WGU = 80 * MiB, WS_WD = 144 * MiB, WS_H = 176 * MiB, WS_Z = 240 * MiB, WS_ONSA = 432 * MiB, WS_END = 512 * MiB;
constexpr size_t WS_MIX = 112 * MiB, WS_P = WS_H, WS_H2 = WS_Z, WS_X1 = 304 * MiB, WS_S = WS_ONSA, WS_HID = 16 * MiB;
constexpr size_t WS_Y0 = 176 * MiB, WS_Y1 = 432 * MiB;
constexpr size_t WS_RS = 200 * MiB, WS_SBON = 232 * MiB;
constexpr size_t WS_WUPT = WS_CMPB + 64 * 1024, WS_AUPT = WS_WUPT + 128 * 1024, WS_GUPT = WS_AUPT + 128 * 1024;
constexpr size_t WS_W1T = 496 * MiB, WS_W2T = 498 * MiB, WS_CBIAS = 498 * MiB + 65536;
constexpr size_t WS_WRH = 499 * MiB, WS_WRL = 499 * MiB + 256 * 1024;
constexpr size_t RO_M = 0, RO_N = 32 * MiB, RO_Q = 64 * MiB, RO_Y = 96 * MiB;
constexpr size_t TK_E = 0, TK_W = 128 * 1024, TK_SLOT = 256 * 1024, TK_STOK = 384 * 1024, TK_SW = 576 * 1024;
constexpr int CW_BAR = 0;
constexpr int CW_Q = 3584;
constexpr int CW_CNT = 4096, CW_CUR = 4160, CW_OFF = 4224, CW_NT = 4288  , CW_NGU = 4289, CW_NDN = 4290;
constexpr int CW_UGU = 6144  , CW_UDN = 8192  ;
static_assert((CW_UDN + MAXTILES * 8 * 2) * 4 <= (int)CTL_ZERO_BYTES, "ctl");

constexpr int RING_BYTES = 131072, LDS_BYTES = 163840, MISC_OFF = LDS_BYTES - 512;

__device__ __forceinline__ unsigned pkh(float a, float b) { f16x2 v = {(f16)a, (f16)b}; return __builtin_bit_cast(unsigned, v); }
__device__ __forceinline__ float wave_sum(float v) {
#pragma unroll
    for (int o = 1; o < 64; o <<= 1) v += __shfl_xor(v, o);
    return v;
}
__device__ __forceinline__ float wave_max(float v) {
#pragma unroll
    for (int o = 1; o < 64; o <<= 1) v = fmaxf(v, __shfl_xor(v, o));
    return v;
}
__device__ __forceinline__ int opaque_tid() { int t = threadIdx.x; asm volatile("" : "+v"(t)); return t; }
#define LDS_WAIT() asm volatile("s_waitcnt lgkmcnt(0)" ::: "memory")
#define VM_WAIT() asm volatile("s_waitcnt vmcnt(0)" ::: "memory")
__device__ __forceinline__ float sigmoidf_(float x) { return 1.f / (1.f + __expf(-x)); }

namespace pg8 {
constexpr int BM = 256, BK = 64, HALF = 128, HTB = HALF * BK * 2, STAGE_BYTES = 8 * HTB, NXCD = 8, WGM = 8;
__host__ __device__ __forceinline__ int lds_byte(int r, int c) { const int st = (r >> 4) * 2 + (c >> 5), rr = r & 15, cc = c & 31, ob = rr * 64 + cc * 2; return st * 1024 + (ob ^ (((ob >> 9) & 1) << 5)); }
__host__ __device__ __forceinline__ void stage_rc(int b, int& R, int& C) { const int st = b / 1024, sb = b % 1024, swz = sb ^ (((sb >> 9) & 1) << 5); R = (st >> 1) * 16 + swz / 64; C = (st & 1) * 32 + (swz % 64) / 2; }
__host__ __device__ __forceinline__ int perm32(int rho) { const int n = rho >> 4, i = rho & 15; return 8 * (i >> 2) + 4 * n + (i & 3); }

struct Unit { int pm, pn; };
struct Gemm { const f16* A; const f16* Bt; int lda, ldb, K; const int* gather; };

struct StaticOrder {
    int nM, nN, nwg, G, c;
    __host__ __device__ void init(int M, int N, int G_, int c_) { nM = M / BM; nN = N / BM; nwg = nM * nN; G = G_; c = c_; }
    __host__ __device__ bool next(int i, Unit& u) const {
        const long L = (long)i * G + c; if (L >= nwg) return false;
        int wgid = (int)L; { const int q = nwg / NXCD, r = nwg % NXCD, xcd = wgid % NXCD, off = wgid / NXCD; wgid = (xcd < r ? xcd * (q + 1) : r * (q + 1) + (xcd - r) * q) + off; }
        const int nig = WGM * nN, gid = wgid / nig, fm = gid * WGM, gsz = (nM - fm) < WGM ? (nM - fm) : WGM;
        u.pm = fm + ((wgid % nig) % gsz); u.pn = (wgid % nig) / gsz; return true;
    }
};
struct TableOrder {
    const int2* tab; int n, G, c;
    __device__ bool next(int i, Unit& u) const { const int L = i * G + c; if (L >= n) return false; const int2 v = tab[L]; u.pm = v.x; u.pn = v.y; return true; }
};

struct EpiF16 {
    static constexpr bool PERM = true;
    f16* O; int ldc; float scale;
    __device__ __forceinline__ void operator()(const f32x4 (&acc)[2][2][4][2], const Unit& u, int wr, int wc, int fr, int fq) const {
        const int row0 = u.pm * BM + wr * 64 + fr, col0 = u.pn * BM + wc * 32 + 8 * fq;
#pragma unroll
        for (int ai = 0; ai < 2; ++ai)
#pragma unroll
            for (int m = 0; m < 4; ++m) { f16* rowp = O + (size_t)(row0 + ai * HALF + m * 16) * ldc + col0;
#pragma unroll
                for (int bj = 0; bj < 2; ++bj) { const f32x4 v0 = acc[ai][bj][m][0] * scale, v1 = acc[ai][bj][m][1] * scale;
                    u32x4 w; w.x = pkh(v0[0], v0[1]); w.y = pkh(v0[2], v0[3]); w.z = pkh(v1[0], v1[1]); w.w = pkh(v1[2], v1[3]);
                    *(u32x4*)(rowp + bj * HALF) = w; } }
    }
};
struct EpiF32 {
    static constexpr bool PERM = false;
    float* C; const float* R; int ldc;
    __device__ __forceinline__ void operator()(const f32x4 (&acc)[2][2][4][2], const Unit& u, int wr, int wc, int fr, int fq) const {
        const int row0 = u.pm * BM + wr * 64 + fr, col0 = u.pn * BM + wc * 32 + 4 * fq;
#pragma unroll
        for (int ai = 0; ai < 2; ++ai)
#pragma unroll
            for (int m = 0; m < 4; ++m) { const size_t ro = (size_t)(row0 + ai * HALF + m * 16) * ldc + col0;
#pragma unroll
                for (int bj = 0; bj < 2; ++bj)
#pragma unroll
                    for (int n = 0; n < 2; ++n) { f32x4 v = acc[ai][bj][m][n]; if (R) v = v + *(const f32x4*)(R + ro + bj * HALF + n * 16); *(f32x4*)(C + ro + bj * HALF + n * 16) = v; } }
    }
};
struct EpiSilu {
    static constexpr bool PERM = true;
    f16* O;
    __device__ __forceinline__ void operator()(const f32x4 (&acc)[2][2][4][2], const Unit& u, int wr, int wc, int fr, int fq) const {
        const int row0 = u.pm * BM + wr * 64 + fr, col0 = (u.pn & 1) * 128 + wc * 32 + 8 * fq;
#pragma unroll
        for (int ai = 0; ai < 2; ++ai)
#pragma unroll
            for (int m = 0; m < 4; ++m) { f16* rowp = O + (size_t)(row0 + ai * HALF + m * 16) * EFF + col0;
                float h[8];
#pragma unroll
                for (int n = 0; n < 2; ++n)
#pragma unroll
                    for (int e = 0; e < 4; ++e) { const float gt = acc[ai][0][m][n][e], up = acc[ai][1][m][n][e]; h[n * 4 + e] = gt / (1.f + __expf(-gt)) * up; }
                u32x4 w; w.x = pkh(h[0], h[1]); w.y = pkh(h[2], h[3]); w.z = pkh(h[4], h[5]); w.w = pkh(h[6], h[7]);
                *(u32x4*)rowp = w; }
    }
};
struct EpiDown {
    static constexpr bool PERM = true;
    unsigned char* ws;
    __device__ __forceinline__ void operator()(const f32x4 (&acc)[2][2][4][2], const Unit& u, int wr, int wc, int fr, int fq) const {
        f16* tile = (f16*)(ws + (u.pm < 128 ? WS_Y0 + (size_t)u.pm * MiB : WS_Y1 + (size_t)(u.pm - 128) * MiB));
        const int r0 = wr * 64 + fr, col0 = (u.pn & 7) * BM + wc * 32 + 8 * fq;
#pragma unroll
        for (int ai = 0; ai < 2; ++ai)
#pragma unroll
            for (int m = 0; m < 4; ++m) { f16* rowp = tile + (size_t)(r0 + ai * HALF + m * 16) * D + col0;
#pragma unroll
                for (int bj = 0; bj < 2; ++bj) { const f32x4 v0 = acc[ai][bj][m][0], v1 = acc[ai][bj][m][1];
                    u32x4 w; w.x = pkh(v0[0], v0[1]); w.y = pkh(v0[2], v0[3]); w.z = pkh(v1[0], v1[1]); w.w = pkh(v1[2], v1[3]);
                    *(u32x4*)(rowp + bj * HALF) = w; } }
    }
};

template <class Epi, class Sched, bool ALIGN_EPI, bool GATHER = false>
__device__ __forceinline__ void gemm_phase(LAS unsigned char* lds, const Gemm g, const Sched& S, const Epi& E) {
    const int tid = opaque_tid(), wid = __builtin_amdgcn_readfirstlane(tid >> 6), lane = tid & 63, wr = wid >> 2, wc = wid & 3, fr = lane & 15, fq = lane >> 4;
    const int K = g.K, nt = K / BK;
    int RA[2], CA[2]; unsigned voffA[2], voffB[2];
#pragma unroll
    for (int i = 0; i < 2; ++i) { int R, C; stage_rc(tid * 16 + i * 8192, R, C); const int Rb = Epi::PERM ? ((R & ~31) + perm32(R & 31)) : R;
        RA[i] = R; CA[i] = C; voffA[i] = (unsigned)(R * g.lda + C) * 2u; voffB[i] = (unsigned)(Rb * g.ldb + C) * 2u; }
    const size_t kstep = (size_t)(BK * 2);
    const size_t hstepA = (size_t)HALF * g.lda * 2, tstepA = 2 * hstepA;
    const size_t hstepB = (size_t)HALF * g.ldb * 2, tstepB = 2 * hstepB;
    const unsigned ldsw = (unsigned)wid * 1024u;
    const int aoff = lds_byte(wr * 64 + fr, fq * 8), boff = lds_byte(wc * 32 + fr, fq * 8);
    const char* Ab = (const char*)g.A;
#define PG8_SA(b, h) (((b) * 2 + (h)) * HTB)
#define PG8_SB(b, h) ((4 + (b) * 2 + (h)) * HTB)
#define PG8_STAGE(bufoff, gbase, voff) do { _Pragma("unroll") for (int _i = 0; _i < 2; ++_i) \
        __builtin_amdgcn_global_load_lds((const unsigned*)((const char*)(gbase) + (voff)[_i]), (LAS unsigned*)(lds + (bufoff) + ldsw + _i * 8192), 16, 0, 0); } while (0)
#define PG8_STA_CUR(bufoff, h, kb) do { if constexpr (GATHER) { PG8_STAGE(bufoff, Ab + (kb), offC[h]); } else { PG8_STAGE(bufoff, cA + (h) * hstepA + (kb), voffA); } } while (0)
#define PG8_STA_SEL(bufoff, h, kb) do { if constexpr (GATHER) { PG8_STAGE(bufoff, Ab + (kb), o2[h]); } else { PG8_STAGE(bufoff, a2p + (h) * hstepA + (kb), voffA); } } while (0)
#define PG8_LDA(dst, b, h) do { _Pragma("unroll") for (int m = 0; m < 4; ++m) _Pragma("unroll") for (int k = 0; k < 2; ++k) dst[m][k] = *(const LAS f16x8*)(lds + PG8_SA(b, h) + aoff + m * 2048 + k * 1024); } while (0)
#define PG8_LDB(dst, b, h) do { _Pragma("unroll") for (int n = 0; n < 2; ++n) _Pragma("unroll") for (int k = 0; k < 2; ++k) dst[n][k] = *(const LAS f16x8*)(lds + PG8_SB(b, h) + boff + n * 2048 + k * 1024); } while (0)
#define PG8_MMA(ai, bj, At, Bt) do { __builtin_amdgcn_s_setprio(1); _Pragma("unroll") for (int m = 0; m < 4; ++m) _Pragma("unroll") for (int n = 0; n < 2; ++n) _Pragma("unroll") for (int k = 0; k < 2; ++k) \
        acc[ai][bj][m][n] = __builtin_amdgcn_mfma_f32_16x16x32_f16(Bt[n][k], At[m][k], acc[ai][bj][m][n], 0, 0, 0); __builtin_amdgcn_s_setprio(0); } while (0)
#define PG8_WAIT_V(n) asm volatile("s_waitcnt vmcnt(" #n ")" ::: "memory")
#define PG8_WAIT_L(n) asm volatile("s_waitcnt lgkmcnt(" #n ")" ::: "memory")
#define PG8_BAR __builtin_amdgcn_s_barrier()
#define PG8_SCHED __builtin_amdgcn_sched_barrier(0)
#define PG8_OFFS(dst, U) do { _Pragma("unroll") for (int _h = 0; _h < 2; ++_h) _Pragma("unroll") for (int _i = 0; _i < 2; ++_i) { \
        const int _r = (U).pm * BM + _h * HALF + RA[_i]; dst[_h][_i] = ((unsigned)g.gather[_r] * (unsigned)g.lda + (unsigned)CA[_i]) * 2u; } } while (0)
    Unit cur, nxt; int ui = 0;
    if (!S.next(0, cur)) return;
    f32x4 acc[2][2][4][2];
#pragma unroll
    for (int a = 0; a < 2; ++a)
#pragma unroll
        for (int b = 0; b < 2; ++b)
#pragma unroll
            for (int m = 0; m < 4; ++m)
#pragma unroll
                for (int n = 0; n < 2; ++n) acc[a][b][m][n] = (f32x4){0.f, 0.f, 0.f, 0.f};
    f16x8 At[4][2], B0[2][2], B1[2][2];
    unsigned offC[2][2], offN[2][2];
    if constexpr (GATHER) { PG8_OFFS(offC, cur); }
    const char* cA = Ab + (size_t)cur.pm * tstepA;
    const char* cB = (const char*)g.Bt + (size_t)cur.pn * tstepB;
    PG8_STAGE(PG8_SB(0, 0), cB, voffB); PG8_STAGE(PG8_SB(0, 1), cB + hstepB, voffB); PG8_STA_CUR(PG8_SA(0, 0), 0, 0); PG8_STA_CUR(PG8_SA(0, 1), 1, 0);
    if (wr == 1) PG8_BAR;
    PG8_WAIT_V(2); PG8_BAR;
    PG8_STAGE(PG8_SB(1, 0), cB + kstep, voffB); PG8_STA_CUR(PG8_SA(1, 0), 0, kstep); PG8_STAGE(PG8_SB(1, 1), cB + hstepB + kstep, voffB);
    PG8_WAIT_V(6); PG8_BAR;
    for (;;) {
        const bool has_next = S.next(ui + 1, nxt);
        if constexpr (GATHER) {
            if (has_next) { PG8_OFFS(offN, nxt); } else {
#pragma unroll
                for (int _h = 0; _h < 2; ++_h)
#pragma unroll
                    for (int _i = 0; _i < 2; ++_i) offN[_h][_i] = offC[_h][_i]; } }
        const char* nA = has_next ? Ab + (size_t)nxt.pm * tstepA : cA;
        const char* nB = has_next ? (const char*)g.Bt + (size_t)nxt.pn * tstepB : cB;
#pragma nounroll
        for (int t = 0; t < nt; t += 2) {
            const bool last = (t == nt - 2);
            const size_t kb1 = (size_t)(t + 1) * kstep;
            const size_t kb2 = last ? 0 : (size_t)(t + 2) * kstep, kb3 = kb2 + kstep;
            unsigned o2[2][2];
            if constexpr (GATHER) {
#pragma unroll
                for (int _h = 0; _h < 2; ++_h)
#pragma unroll
                    for (int _i = 0; _i < 2; ++_i) o2[_h][_i] = last ? offN[_h][_i] : offC[_h][_i]; }
            const char* a2p = last ? nA : cA;
            const char* b2 = last ? nB : cB + (size_t)(t + 2) * kstep; const char* b3 = b2 + kstep;
            PG8_LDB(B0, 0, 0); PG8_LDB(B1, 0, 1); PG8_SCHED; PG8_LDA(At, 0, 0); PG8_STA_CUR(PG8_SA(1, 1), 1, kb1);
            PG8_WAIT_V(8); PG8_WAIT_L(0); PG8_BAR; PG8_MMA(0, 0, At, B0); PG8_MMA(0, 1, At, B1); PG8_BAR; PG8_SCHED;
            PG8_LDA(At, 0, 1); PG8_STAGE(PG8_SB(0, 0), b2, voffB); PG8_STAGE(PG8_SB(0, 1), b2 + hstepB, voffB); PG8_STA_SEL(PG8_SA(0, 0), 0, kb2);
            PG8_WAIT_V(8); PG8_WAIT_L(0); PG8_BAR; PG8_MMA(1, 0, At, B0); PG8_MMA(1, 1, At, B1); PG8_BAR; PG8_SCHED;
            PG8_LDB(B0, 1, 0); PG8_LDB(B1, 1, 1); PG8_SCHED; PG8_LDA(At, 1, 0); PG8_STA_SEL(PG8_SA(0, 1), 1, kb2);
            PG8_WAIT_V(8); PG8_WAIT_L(0); PG8_BAR; PG8_MMA(0, 0, At, B0); PG8_MMA(0, 1, At, B1); PG8_BAR; PG8_SCHED;
            PG8_LDA(At, 1, 1); PG8_STAGE(PG8_SB(1, 0), b3, voffB); PG8_STAGE(PG8_SB(1, 1), b3 + hstepB, voffB); PG8_STA_SEL(PG8_SA(1, 0), 0, kb3);
            PG8_WAIT_V(8); PG8_WAIT_L(0); PG8_BAR; PG8_MMA(1, 0, At, B0); PG8_MMA(1, 1, At, B1); PG8_BAR; PG8_SCHED;
        }
        if constexpr (ALIGN_EPI) { if (wr == 0) PG8_BAR; }
        E(acc, cur, wr, wc, fr, fq);
        if (!has_next) break;
#pragma unroll
        for (int a = 0; a < 2; ++a)
#pragma unroll
            for (int b = 0; b < 2; ++b)
#pragma unroll
                for (int m = 0; m < 4; ++m)
#pragma unroll
                    for (int n = 0; n < 2; ++n) acc[a][b][m][n] = (f32x4){0.f, 0.f, 0.f, 0.f};
        cur = nxt; cA = nA; cB = nB; ++ui;
        if constexpr (GATHER) {
#pragma unroll
            for (int _h = 0; _h < 2; ++_h)
#pragma unroll
                for (int _i = 0; _i < 2; ++_i) offC[_h][_i] = offN[_h][_i]; }
        if constexpr (ALIGN_EPI) { if (wr == 1) PG8_BAR; }
    }
    PG8_WAIT_V(0);
    if constexpr (!ALIGN_EPI) { if (wr == 0) PG8_BAR; }
    PG8_BAR;
#undef PG8_SA
#undef PG8_SB
#undef PG8_STAGE
#undef PG8_STA_CUR
#undef PG8_STA_SEL
#undef PG8_LDA
#undef PG8_LDB
#undef PG8_MMA
#undef PG8_WAIT_V
#undef PG8_WAIT_L
#undef PG8_BAR
#undef PG8_SCHED
#undef PG8_OFFS
}
}

#define XB_TMO      128
#define XB_XCNT(j)  (256  + 64 * (j))
#define XB_XSUB(j)  (1280 + 64 * (j))
#define XB_XGEN(j)  (2304 + 64 * (j))
#define XB_TOP      3328
#define XB_TOPGEN   3392
#define XCD_BAR_WORDS 3456
#define XB_SPIN_CAP (1u << 22)
__device__ __forceinline__ unsigned xb_ld(unsigned* p)              { return __hip_atomic_load(p, __ATOMIC_RELAXED, __HIP_MEMORY_SCOPE_AGENT); }
__device__ __forceinline__ unsigned xb_add(unsigned* p, unsigned v) { return __hip_atomic_fetch_add(p, v, __ATOMIC_RELAXED, __HIP_MEMORY_SCOPE_AGENT); }
__device__ __forceinline__ unsigned xb_xcc_id() { return (unsigned)__builtin_amdgcn_s_getreg((3 << 11) | 20) & 0xFu; }
#define XB_SPIN(cond, bar) do { unsigned _sp = 0; while (cond) { __builtin_amdgcn_s_sleep(1); \
    if ((++_sp & 255u) == 0u) { if (xb_ld(&(bar)[XB_TMO])) break; if (_sp > XB_SPIN_CAP) { atomicAdd(&(bar)[XB_TMO], 1u); break; } } } } while (0)
struct XcdBarrier { unsigned* bar; unsigned x; volatile LAS unsigned* st; };
__device__ __forceinline__ XcdBarrier xcd_barrier_post(unsigned* bar, volatile LAS unsigned* st) {
    XcdBarrier b; b.bar = bar; b.x = xb_xcc_id(); b.st = st;
    if (threadIdx.x == 0) (void)xb_add(&bar[XB_XCNT(b.x)], 1u);
    return b;
}
__device__ __forceinline__ void xcd_barrier_complete(unsigned* bar, unsigned x, unsigned& nloc, unsigned& nx) {
    const unsigned G = gridDim.x * gridDim.y * gridDim.z;
    unsigned sum, cnt, mine, sp = 0u;
    for (;;) {
        sum = 0u; cnt = 0u; mine = 0u;
#pragma unroll
        for (unsigned j = 0; j < 16; ++j) { const unsigned c = xb_ld(&bar[XB_XCNT(j)]); sum += c; cnt += (c > 0u) ? 1u : 0u; mine = (j == x) ? c : mine; }
        if (sum == G) break;
        __builtin_amdgcn_s_sleep(1);
        if ((++sp & 255u) == 0u) { if (xb_ld(&bar[XB_TMO])) break; if (sp > XB_SPIN_CAP) { atomicAdd(&bar[XB_TMO], 1u); break; } }
    }
    nloc = mine > 0u ? mine : 1u; nx = cnt > 0u ? cnt : 1u;
}
__device__ __forceinline__ void xcd_barrier(const XcdBarrier& b) {
    asm volatile("s_waitcnt vmcnt(0)" ::: "memory");
    __syncthreads();
    if (threadIdx.x == 0) {
        unsigned* bar = b.bar;
        __builtin_amdgcn_s_waitcnt(0);
        unsigned nloc = b.st[0], nx = b.st[1];
        if (nloc == 0u) { xcd_barrier_complete(bar, b.x, nloc, nx); b.st[0] = nloc; b.st[1] = nx; }
        const unsigned old = xb_add(&bar[XB_XSUB(b.x)], 1u);
        const unsigned gen = old / nloc;
        if (old + 1u == (gen + 1u) * nloc) {
            __builtin_amdgcn_fence(__ATOMIC_RELEASE, "agent");
            asm volatile("s_waitcnt vmcnt(0)" ::: "memory");
            const unsigned og = xb_add(&bar[XB_TOP], 1u);
            const unsigned tg = og / nx;
            if (og + 1u == (tg + 1u) * nx) xb_add(&bar[XB_TOPGEN], 1u);
            else XB_SPIN(xb_ld(&bar[XB_TOPGEN]) == tg, bar);
            __builtin_amdgcn_fence(__ATOMIC_ACQUIRE, "agent");
            xb_add(&bar[XB_XGEN(b.x)], 1u);
            asm volatile("s_waitcnt vmcnt(0)" ::: "memory");
        } else {
            XB_SPIN(xb_ld(&bar[XB_XGEN(b.x)]) == gen, bar);
            __builtin_amdgcn_fence(__ATOMIC_ACQUIRE, "agent");
            asm volatile("s_waitcnt vmcnt(0)" ::: "memory");
        }
    }
    __syncthreads();
}

struct Args { const float* in[38]; float* out; unsigned char* ws; int ph_lo, ph_hi; };
enum { I_X = 0, I_MEM, I_LN1, I_WIN, I_PK, I_W1K, I_W2K, I_PV, I_W1V, I_W2V, I_NSAG, I_MU, I_W0, I_WUP, I_A0, I_AUP, I_GUP, I_KK, I_KA, I_RK, I_LNXG, I_LNXB,
       I_WOUT, I_LNMEM, I_LN2, I_WQ, I_WK, I_WV, I_WO, I_LN3, I_RGW, I_RGB, I_REW, I_REB, I_MG, I_MU2, I_MD, I_LNF };

__device__ __forceinline__ void tr_item(const float* src, int sld, int k0, int scol0, int nvalid, f16* dst, size_t drow0, int dld, LAS float* scr, int lane) {
    const int nl = lane & 31;
#pragma unroll 8
    for (int i = 0; i < 32; ++i) { const int kk = 2 * i + (lane >> 5); scr[kk * 33 + nl] = (nl < nvalid) ? src[(size_t)(k0 + kk) * sld + scol0 + nl] : 0.f; }
    LDS_WAIT(); asm volatile("" ::: "memory");
    const int c = lane & 7;
#pragma unroll
    for (int j = 0; j < 4; ++j) { const int n = (lane >> 3) + 8 * j; const LAS float* s = scr + (8 * c) * 33 + n;
        u32x4 o; o.x = pkh(s[0 * 33], s[1 * 33]); o.y = pkh(s[2 * 33], s[3 * 33]); o.z = pkh(s[4 * 33], s[5 * 33]); o.w = pkh(s[6 * 33], s[7 * 33]);
        *(u32x4*)(dst + (drow0 + n) * (size_t)dld + k0 + 8 * c) = o; }
    LDS_WAIT(); asm volatile("" ::: "memory");
}
__device__ __forceinline__ void tr_matrix(const float* src, int K, int N, f16* dst, LAS float* scr, int gw, int NGW, int lane) {
    const int nblk = N / 32, items = (K / 64) * nblk;
    for (int it = gw; it < items; it += NGW) { const int kb = it / nblk, nb = it % nblk; tr_item(src, N, kb * 64, nb * 32, 32, dst, (size_t)nb * 32, K, scr, lane); }
}
__device__ __forceinline__ void rms_row(const float* xrow, const float* gain, f16* o16, int lane) {
    const f32x4* xr = (const f32x4*)xrow + lane; f32x4 v[8]; float s = 0.f;
#pragma unroll
    for (int j = 0; j < 8; ++j) { v[j] = xr[64 * j]; s += v[j].x * v[j].x + v[j].y * v[j].y + v[j].z * v[j].z + v[j].w * v[j].w; }
    const float rstd = rsqrtf(wave_sum(s) * (1.f / D) + EPS);
    const f32x4* gr = (const f32x4*)gain + lane;
    u32x2* o8 = (u32x2*)o16 + lane;
#pragma unroll
    for (int j = 0; j < 8; ++j) { const f32x4 gg = gr[64 * j]; u32x2 w; w.x = pkh(v[j].x * rstd * gg.x, v[j].y * rstd * gg.y); w.y = pkh(v[j].z * rstd * gg.z, v[j].w * rstd * gg.w); o8[64 * j] = w; }
}

__device__ __forceinline__ void p0_prologue(const Args& a, LAS unsigned char* lds) {
    const int tid = opaque_tid(), lane = tid & 63, wave = tid >> 6;
    const int gw = blockIdx.x * 8 + wave, NGW = gridDim.x * 8;
    LAS float* scr = (LAS float*)(lds + wave * 16384);
    unsigned char* ws = a.ws;
    { f16* dst = (f16*)(ws + WS_WIN); const float* src = a.in[I_WIN];
      const int nblk = NZ / 32, items = (D / 64) * nblk;
      for (int it = gw; it < items; it += NGW) { const int kb = it / nblk, nb = it % nblk, n0 = nb * 32;
          int sc = 0, nv = 32; if (n0 < 2560) sc = n0; else if (n0 < 5920) sc = n0 + 24; else if (n0 == 5920) { sc = 2560; nv = 24; } else { sc = 0; nv = 0; }
          tr_item(src, 5944, kb * 64, sc, nv, dst, (size_t)n0, D, scr, lane); } }
    tr_matrix(a.in[I_WOUT], D, D, (f16*)(ws + WS_WOUT), scr, gw, NGW, lane);
    tr_matrix(a.in[I_WK], D, D, (f16*)(ws + WS_WKT), scr, gw, NGW, lane);
    tr_matrix(a.in[I_WV], D, D, (f16*)(ws + WS_WVT), scr, gw, NGW, lane);
    tr_matrix(a.in[I_WO], D, D, (f16*)(ws + WS_WOT), scr, gw, NGW, lane);
    { const f32x4* s = (const f32x4*)a.in[I_WQ]; u32x2* d = (u32x2*)(ws + WS_WQ16);
      for (size_t i = (size_t)blockIdx.x * 512 + tid; i < (size_t)D * D / 4; i += (size_t)gridDim.x * 512) { const f32x4 v = s[i]; u32x2 w; w.x = pkh(v.x, v.y); w.y = pkh(v.z, v.w); d[i] = w; } }
    tr_matrix(a.in[I_W1K], 4096, 128, (f16*)(ws + WS_W1T), scr, gw, NGW, lane);
    tr_matrix(a.in[I_W1V], 4096, 128, (f16*)(ws + WS_W1T) + 128 * 4096, scr, gw, NGW, lane);
    tr_matrix(a.in[I_W2K], 128, 128, (f16*)(ws + WS_W2T), scr, gw, NGW, lane);
    tr_matrix(a.in[I_W2V], 128, 128, (f16*)(ws + WS_W2T) + 128 * 128, scr, gw, NGW, lane);
    for (int o = gw; o < 256; o += NGW) { const int kv = o >> 7, n = o & 127; const float* pos = a.in[kv ? I_PV : I_PK]; const float* w1 = a.in[kv ? I_W1V : I_W1K]; float acc = 0.f;
        for (int k = lane; k < 4096; k += 64) acc += pos[k] * w1[(size_t)k * 128 + n];
        acc = wave_sum(acc); if (lane == 0) ((float*)(ws + WS_CBIAS))[o] = acc; }
    for (int i = blockIdx.x * 512 + tid; i < 48 * D; i += gridDim.x * 512) { const int c = i / D, k = i % D; float v = 0.f;
        if (c < 4) v = a.in[I_RGW][k * 4 + c]; else if (c < 36) v = a.in[I_REW][k * 32 + (c - 4)];
        v *= a.in[I_LN3][k]; const f16 hi = (f16)v; ((f16*)(ws + WS_WRH))[i] = hi; ((f16*)(ws + WS_WRL))[i] = (f16)(v - (float)hi); }
    { bf16* wu = (bf16*)(ws + WS_WUPT); bf16* au = (bf16*)(ws + WS_AUPT); bf16* gu = (bf16*)(ws + WS_GUPT);
      for (int i = blockIdx.x * 512 + tid; i < 1024 * 64; i += gridDim.x * 512) { const int ch = i >> 6, j = i & 63; wu[i] = (bf16)a.in[I_WUP][j * 1024 + ch]; au[i] = (bf16)a.in[I_AUP][j * 1024 + ch]; }
      for (int i = blockIdx.x * 512 + tid; i < 1024 * 160; i += gridDim.x * 512) { const int ch = i / 160, j = i % 160; gu[i] = (bf16)a.in[I_GUP][j * 1024 + ch]; } }
    for (int m = gw; m < T; m += NGW) rms_row(a.in[I_X] + (size_t)m * D, a.in[I_LN1], (f16*)(ws + WS_H) + (size_t)m * D, lane);
    for (int m = gw; m < 256; m += NGW) rms_row(a.in[I_MEM] + (size_t)m * D, a.in[I_LNMEM], (f16*)(ws + WS_MEMN) + (size_t)m * D, lane);
}

__device__ __forceinline__ void p_moe_weights(const Args& a, LAS unsigned char* lds) {
    const int tid = opaque_tid(), lane = tid & 63, wave = tid >> 6;
    const int gw = blockIdx.x * 8 + wave, NGW = gridDim.x * 8;
    LAS float* scr = (LAS float*)(lds + wave * 16384);
    unsigned char* ws = a.ws;
    { f16* dst = (f16*)(ws + WS_WGU); const int items = NEXP * (D / 64) * 16;
      for (int it = gw; it < items; it += NGW) { const int e = it / ((D / 64) * 16), r = it % ((D / 64) * 16), kb = r / 16, nb = r % 16, j0 = nb * 32, jt = j0 / 256, jj = j0 % 256;
          const float* src = (jj < 128 ? a.in[I_MG] : a.in[I_MU2]) + (size_t)e * D * EFF; const int sc = jt * 128 + (jj & 127);
          tr_item(src, EFF, kb * 64, sc, 32, dst, (size_t)e * 512 + j0, D, scr, lane); } }
    { f16* dst = (f16*)(ws + WS_WD); const int items = NEXP * (EFF / 64) * (D / 32);
      for (int it = gw; it < items; it += NGW) { const int e = it / ((EFF / 64) * (D / 32)), r = it % ((EFF / 64) * (D / 32)), kb = r / (D / 32), nb = r % (D / 32);
          tr_item(a.in[I_MD] + (size_t)e * EFF * D, D, kb * 64, nb * 32, 32, dst, (size_t)e * D + nb * 32, EFF, scr, lane); } }
}

__device__ __forceinline__ float gelu_tanh(float x) { const float u = 0.7978845608028654f * (x + 0.044715f * x * x * x); const float e = __expf(2.f * u); return 0.5f * x * (2.f - 2.f / (e + 1.f)); }
constexpr int CP_RS = 272, CP_HS = 136, CP_HID = 272 * CP_RS;
__device__ __forceinline__ void p_compress(const Args& a, LAS unsigned char* lds) {
    const int tid = opaque_tid(), lane = tid & 63, w = __builtin_amdgcn_readfirstlane(tid >> 6);
    const f16* z = (const f16*)(a.ws + WS_Z);
    LAS f16* HID = (LAS f16*)(lds + CP_HID);
    for (int it = blockIdx.x; it < 256; it += gridDim.x) {
        const int kv = it >> 7, g = (it >> 6) & 1, c0 = (it & 63) * 16, tok0 = 16 * c0;
        const int zc = (kv ? ZVC : ZKC) + g * 128;
        __syncthreads();
        for (int ck = tid; ck < 272 * 16; ck += 512) { const int tl = ck >> 4, c16 = ck & 15, tok = tok0 + tl; const int rp = (tl & 15) * 17 + (tl >> 4);
            u32x4 v = {0u, 0u, 0u, 0u}; if (tok < T) v = *(const u32x4*)(z + (size_t)tok * NZ + zc + c16 * 8);
            *(LAS u32x4*)(lds + rp * CP_RS + c16 * 16) = v; }
        __syncthreads();
        f32x4 acc = {0.f, 0.f, 0.f, 0.f};
        const f16* wp = (const f16*)(a.ws + WS_W1T) + ((size_t)kv * 128 + 16 * w + (lane & 15)) * 4096 + 8 * (lane >> 4);
        const LAS unsigned char* ap = lds + (lane & 15) * CP_RS + 16 * (lane >> 4);
#pragma unroll 8
        for (int ks = 0; ks < 128; ++ks) { const int l = ks >> 2;
            const f16x8 av = *(const LAS f16x8*)(ap + ((l & 15) * 17 + (l >> 4)) * CP_RS + (ks & 3) * 64);
            const f16x8 bv = *(const f16x8*)(wp + 32 * ks);
            acc = __builtin_amdgcn_mfma_f32_16x16x32_f16(av, bv, acc, 0, 0, 0); }
        { const int n = 16 * w + (lane & 15); const float bs = ((const float*)(a.ws + WS_CBIAS))[kv * 128 + n];
#pragma unroll
          for (int r = 0; r < 4; ++r) HID[(4 * (lane >> 4) + r) * CP_HS + n] = (f16)gelu_tanh(acc[r] + bs); }
        __syncthreads();
        f32x4 o = {0.f, 0.f, 0.f, 0.f};
        const f16* w2p = (const f16*)(a.ws + WS_W2T) + ((size_t)kv * 128 + 16 * w + (lane & 15)) * 128 + 8 * (lane >> 4);
#pragma unroll
        for (int ks = 0; ks < 4; ++ks) { const f16x8 av = *(const LAS f16x8*)(HID + (lane & 15) * CP_HS + 32 * ks + 8 * (lane >> 4)); const f16x8 bv = *(const f16x8*)(w2p + 32 * ks);
            o = __builtin_amdgcn_mfma_f32_16x16x32_f16(av, bv, o, 0, 0, 0); }
        f16* dst = (f16*)(a.ws + (kv ? WS_VCMP : WS_KCMP));
#pragma unroll
        for (int r = 0; r < 4; ++r) { const int c = c0 + 4 * (lane >> 4) + r; dst[((size_t)c * 2 + g) * 128 + 16 * w + (lane & 15)] = c < NCMP ? (f16)o[r] : (f16)0.f; }
    }
}

typedef float f32x16 __attribute__((ext_vector_type(16)));
typedef short v4i16_t __attribute__((ext_vector_type(4)));
constexpr int NS_KB = 0, NS_VB = 32768, NS_PSEL = 65536, NS_PSTR = 257, NS_SELB = NS_PSEL + 64 * NS_PSTR * 4, NS_WANY = NS_SELB + 2048, NS_LIST = NS_WANY + 256, NS_CNT = NS_LIST + 512, NS_UNIT = NS_CNT + 64;
static_assert(NS_UNIT + 64 <= MISC_OFF, "nsa lds");
__device__ __forceinline__ unsigned offb(unsigned row, unsigned ch) { return 256u * row + 16u * (ch ^ (((row & 3u) << 2) | ((row >> 2) & 3u))); }
__device__ __forceinline__ void ns_dma(const f16* g0, size_t gstride, LAS unsigned char* buf, int wv, int lane) {
#pragma unroll
    for (int i = 0; i < 2; ++i) { const int piece = wv * 2 + i, row = 4 * piece + (lane >> 4), slot = lane & 15, ch = slot ^ (((row & 3) << 2) | ((row >> 2) & 3));
        __builtin_amdgcn_global_load_lds((const unsigned*)(g0 + (size_t)row * gstride + ch * 8), (LAS unsigned*)(buf + piece * 1024), 16, 0, 0); }
}
__device__ __forceinline__ void ns_qk(f32x16& s0, f32x16& s1, const LAS unsigned char* kb, const f16x8 (&qf)[8], int rho_, int hh_) {
    unsigned rho = (unsigned)rho_, hh = (unsigned)hh_;
    asm volatile("" : "+v"(rho), "+v"(hh));
    const unsigned xr = ((rho & 3u) << 2) | ((rho >> 2) & 3u);
    const LAS unsigned char* kbase = kb + 256u * rho + 16u * ((hh ^ xr) & 1u); const unsigned xs = xr >> 1;
#pragma unroll
    for (int i = 0; i < 16; ++i) { s0[i] = 0.f; s1[i] = 0.f; }
#pragma unroll
    for (int s = 0; s < 8; ++s) { const LAS unsigned char* ad = kbase + 32u * ((unsigned)s ^ xs);
        const f16x8 a0 = *(const LAS f16x8*)(ad), a1 = *(const LAS f16x8*)(ad + 8192);
        s0 = __builtin_amdgcn_mfma_f32_32x32x16_f16(a0, qf[s], s0, 0, 0, 0); s1 = __builtin_amdgcn_mfma_f32_32x32x16_f16(a1, qf[s], s1, 0, 0, 0); }
}
__device__ __forceinline__ void ns_pv(f32x16 (&O)[4], const LAS unsigned char* vb, const f32x16& p0, const f32x16& p1, int lane_) {
    unsigned lane = (unsigned)lane_;
    asm volatile("" : "+v"(lane));
    const unsigned hh = lane >> 5, blk = (lane >> 4) & 1, q = (lane & 15) >> 2, pp = lane & 3;
    const unsigned x = 2 * blk + (pp >> 1);
    const LAS unsigned char* vbase[2];
#pragma unroll
    for (int t = 0; t < 2; ++t) { const unsigned w = (hh + 2 * t) & 3u; vbase[t] = vb + 256u * (4 * hh + 8 * t + q) + 16u * (x ^ w) + 8u * (pp & 1); }
#pragma unroll
    for (int c = 0; c < 4; ++c) { const unsigned cq = 64u * ((unsigned)c ^ q);
        const LAS unsigned char* b0 = vbase[0] + cq; const LAS unsigned char* b1 = vbase[1] + cq;
#pragma unroll
        for (int kh = 0; kh < 2; ++kh)
#pragma unroll
            for (int sp = 0; sp < 2; ++sp) {
                f16x8 pf;
#pragma unroll
                for (int j = 0; j < 8; ++j) pf[j] = (f16)(kh ? p1[8 * sp + j] : p0[8 * sp + j]);
                const v4i16_t lo = __builtin_amdgcn_ds_read_tr16_b64_v4i16((LAS v4i16_t*)(b0 + 256 * (32 * kh + 16 * sp)));
                const v4i16_t hi = __builtin_amdgcn_ds_read_tr16_b64_v4i16((LAS v4i16_t*)(b1 + 256 * (32 * kh + 16 * sp)));
                typedef short s16x8 __attribute__((ext_vector_type(8)));
                const s16x8 v8 = {lo[0], lo[1], lo[2], lo[3], hi[0], hi[1], hi[2], hi[3]};
                O[c] = __builtin_amdgcn_mfma_f32_32x32x16_f16(__builtin_bit_cast(f16x8, v8), pf, O[c], 0, 0, 0); }
    }
}
#define NS_KIDX(r, hh) ((int)(((r) & 3) + 8 * ((r) >> 2) + 4 * (hh)))
__device__ __forceinline__ void ns_online(f32x16& x0, f32x16& x1, float& m, float& l, f32x16 (&O)[4]) {
    float mx = x0[0];
#pragma unroll
    for (int i = 1; i < 16; ++i) mx = fmaxf(mx, x0[i]);
#pragma unroll
    for (int i = 0; i < 16; ++i) mx = fmaxf(mx, x1[i]);
    mx = fmaxf(mx, __shfl_xor(mx, 32));
    const float mn = fmaxf(m, mx), alpha = __builtin_amdgcn_exp2f(m - mn);
    m = mn; float ls = 0.f;
#pragma unroll
    for (int i = 0; i < 16; ++i) { x0[i] = __builtin_amdgcn_exp2f(x0[i] - mn); x1[i] = __builtin_amdgcn_exp2f(x1[i] - mn); ls += x0[i] + x1[i]; }
    l = l * alpha + ls;
#pragma unroll
    for (int c = 0; c < 4; ++c) O[c] = O[c] * alpha;
}
__device__ __forceinline__ void p_nsa(const Args& a, LAS unsigned char* lds, int rep) {
    const int tid = opaque_tid(), lane = tid & 63, w = __builtin_amdgcn_readfirstlane(tid >> 6), rho = lane & 31, hh = lane >> 5, ql = rho >> 2, p = rho & 3;
    const f16* z = (const f16*)(a.ws + WS_Z); const f16* kcmp = (const f16*)(a.ws + WS_KCMP); const f16* vcmp = (const f16*)(a.ws + WS_VCMP);
    float* onsa = (float*)(a.ws + WS_ONSA); unsigned* ctl = (unsigned*)(a.ws + WS_CTL);
    LAS float* psel = (LAS float*)(lds + NS_PSEL); LAS unsigned* selb = (LAS unsigned*)(lds + NS_SELB); LAS unsigned* wany = (LAS unsigned*)(lds + NS_WANY);
    LAS unsigned char* list = lds + NS_LIST; LAS int* cnt = (LAS int*)(lds + NS_CNT); LAS int* unit_s = (LAS int*)(lds + NS_UNIT);
    const float c2 = 0.08838834764831845f * 1.4426950408889634f;
    for (;;) {
        __syncthreads();
        if (tid == 0) unit_s[0] = (int)atomicAdd(&ctl[CW_Q + rep], 1u);
        __syncthreads();
        const int u = unit_s[0]; if (u >= 512) break;
        const int blk = 255 - (u >> 1), g = u & 1, t0 = blk * 64, tq = t0 + 8 * w + ql, hq = g * 4 + p;
        f16x8 qf[8];
        { const f16* qrow = z + (size_t)tq * NZ + ZQ + hq * 128 + 8 * hh;
#pragma unroll
          for (int s = 0; s < 8; ++s) qf[s] = *(const f16x8*)(qrow + 16 * s); }
        const f16* zrow = z + (size_t)tq * NZ;
        const float gate_c = sigmoidf_((float)zrow[ZGL + hq]), gate_s = sigmoidf_((float)zrow[ZGL + 8 + hq]), gate_w = sigmoidf_((float)zrow[ZGL + 16 + hq]);
        f32x16 O[4];
        float* orow = onsa + (size_t)tq * 1024 + hq * 128 + 4 * hh;
#pragma unroll
        for (int c = 0; c < 4; ++c)
#pragma unroll
            for (int i = 0; i < 16; ++i) O[c][i] = 0.f;
        for (int i = lane; i < 8 * NS_PSTR; i += 64) psel[(8 * w) * NS_PSTR + i] = 0.f;
        const int cmax = tq >= 31 ? (tq - 31) >> 4 : -1;
        const int ntc = (4 * blk + 3 + 63) >> 6;
        float m = -1e30f, l = 0.f;
        ns_dma(kcmp + (size_t)g * 128, 256, lds + NS_KB, w, lane);
        VM_WAIT(); __syncthreads();
        for (int i = 0; i < ntc; ++i) {
            if (i + 1 < ntc) ns_dma(kcmp + ((size_t)(64 * (i + 1)) * 2 + g) * 128, 256, lds + NS_KB + ((i + 1) & 1) * 16384, w, lane);
            f32x16 x0, x1; ns_qk(x0, x1, lds + NS_KB + (i & 1) * 16384, qf, rho, hh);
#pragma unroll
            for (int r = 0; r < 16; ++r) { const int c0 = 64 * i + NS_KIDX(r, hh); x0[r] = (c0 <= cmax) ? x0[r] * c2 : -INFINITY; x1[r] = (c0 + 32 <= cmax) ? x1[r] * c2 : -INFINITY; }
            float mx = x0[0];
#pragma unroll
            for (int r = 1; r < 16; ++r) mx = fmaxf(mx, x0[r]);
#pragma unroll
            for (int r = 0; r < 16; ++r) mx = fmaxf(mx, x1[r]);
            mx = fmaxf(mx, __shfl_xor(mx, 32));
            const float mn = fmaxf(m, mx); float ls = 0.f;
#pragma unroll
            for (int r = 0; r < 16; ++r) ls += __builtin_amdgcn_exp2f(x0[r] - mn) + __builtin_amdgcn_exp2f(x1[r] - mn);
            l = l * __builtin_amdgcn_exp2f(m - mn) + ls; m = mn;
            VM_WAIT(); __syncthreads();
        }
        l += __shfl_xor(l, 32);
        const float invl = 1.f / fmaxf(l, 1e-30f);
        ns_dma(kcmp + (size_t)g * 128, 256, lds + NS_KB, w, lane); ns_dma(vcmp + (size_t)g * 128, 256, lds + NS_VB, w, lane);
        VM_WAIT(); __syncthreads();
        for (int i = 0; i < ntc; ++i) {
            if (i + 1 < ntc) { ns_dma(kcmp + ((size_t)(64 * (i + 1)) * 2 + g) * 128, 256, lds + NS_KB + ((i + 1) & 1) * 16384, w, lane); ns_dma(vcmp + ((size_t)(64 * (i + 1)) * 2 + g) * 128, 256, lds + NS_VB + ((i + 1) & 1) * 16384, w, lane); }
            f32x16 x0, x1; ns_qk(x0, x1, lds + NS_KB + (i & 1) * 16384, qf, rho, hh);
#pragma unroll
            for (int r = 0; r < 16; ++r) { const int c0 = 64 * i + NS_KIDX(r, hh);
                x0[r] = (c0 <= cmax) ? __builtin_amdgcn_exp2f(x0[r] * c2 - m) * invl : 0.f; x1[r] = (c0 + 32 <= cmax) ? __builtin_amdgcn_exp2f(x1[r] * c2 - m) * invl : 0.f; }
#pragma unroll
            for (int kh = 0; kh < 2; ++kh)
#pragma unroll
                for (int r4 = 0; r4 < 4; ++r4) {
                    const float pa = kh ? x1[4 * r4] : x0[4 * r4], pb = kh ? x1[4 * r4 + 1] : x0[4 * r4 + 1], pc_ = kh ? x1[4 * r4 + 2] : x0[4 * r4 + 2], pd = kh ? x1[4 * r4 + 3] : x0[4 * r4 + 3];
                    float mainv = pa + pb + pc_ + 0.5f * pd, carry = 0.5f * pd;
                    mainv += __shfl_xor(mainv, 1); mainv += __shfl_xor(mainv, 2); carry += __shfl_xor(carry, 1); carry += __shfl_xor(carry, 2);
                    if (p == 0) { const int sb = 16 * i + 8 * kh + 2 * r4 + hh; float* pr = (float*)(psel + (8 * w + ql) * NS_PSTR + sb); __hip_atomic_fetch_add(pr, mainv, __ATOMIC_RELAXED, __HIP_MEMORY_SCOPE_WORKGROUP); __hip_atomic_fetch_add(pr + 1, carry, __ATOMIC_RELAXED, __HIP_MEMORY_SCOPE_WORKGROUP); }
                }
            ns_pv(O, lds + NS_VB + (i & 1) * 16384, x0, x1, lane);
            VM_WAIT(); __syncthreads();
        }
#pragma unroll
        for (int c = 0; c < 4; ++c) {
#pragma unroll
            for (int r4 = 0; r4 < 4; ++r4) *(f32x4*)(orow + 32 * c + 8 * r4) = (f32x4){O[c][4 * r4] * gate_c, O[c][4 * r4 + 1] * gate_c, O[c][4 * r4 + 2] * gate_c, O[c][4 * r4 + 3] * gate_c};
#pragma unroll
            for (int i = 0; i < 16; ++i) O[c][i] = 0.f; }
        {
            unsigned anyw = 0u;
            for (int qq = 0; qq < 8; ++qq) {
                const LAS float* pr = psel + (8 * w + qq) * NS_PSTR;
                unsigned myw = 0u;
                if (lane == 0) myw |= 1u;
                if (lane == (blk >> 5)) myw |= 1u << (blk & 31);
                if (blk >= 1 && lane == ((blk - 1) >> 5)) myw |= 1u << ((blk - 1) & 31);
                const int ncand = blk >= 3 ? blk - 2 : 0;
                if (ncand <= 13) { if (ncand > 0 && lane == 0) myw |= ((blk - 2 >= 31) ? 0xFFFFFFFFu : ((2u << (blk - 2)) - 1u)) & ~1u; }
                else {
                    float v[4];
#pragma unroll
                    for (int jj = 0; jj < 4; ++jj) { const int s = 1 + lane + 64 * jj; v[jj] = (s <= blk - 2) ? pr[s] : -1.f; }
                    for (int it = 0; it < 13; ++it) {
                        float bv = v[0]; int bi = 1 + lane;
#pragma unroll
                        for (int jj = 1; jj < 4; ++jj) { if (v[jj] > bv) { bv = v[jj]; bi = 1 + lane + 64 * jj; } }
#pragma unroll
                        for (int o = 1; o < 64; o <<= 1) { const float ov = __shfl_xor(bv, o); const int oi = __shfl_xor(bi, o); if (ov > bv || (ov == bv && oi < bi)) { bv = ov; bi = oi; } }
                        if (lane == (bi >> 5)) myw |= 1u << (bi & 31);
#pragma unroll
                        for (int jj = 0; jj < 4; ++jj) if (bi == 1 + lane + 64 * jj) v[jj] = -1.f;
                    }
                }
                if (lane < 8) selb[(8 * w + qq) * 8 + lane] = myw;
                anyw |= myw;
            }
            if (lane < 8) wany[w * 8 + lane] = anyw;
        }
        __syncthreads();
        {
            int need = 0;
            if (w < 4) { const int sblk = 64 * w + lane; unsigned un = 0u;
#pragma unroll
                for (int ww = 0; ww < 8; ++ww) un |= wany[ww * 8 + (sblk >> 5)];
                need = (un >> (sblk & 31)) & 1; }
            const unsigned long long bal = __ballot(need);
            if (w < 4 && lane == 0) cnt[w] = __popcll(bal);
            __syncthreads();
            if (w < 4) { int base = 0;
                for (int ww = 0; ww < w; ++ww) base += cnt[ww];
                if (need) list[base + __popcll(bal & ((1ull << lane) - 1ull))] = (unsigned char)(64 * w + lane); }
            __syncthreads();
        }
        const int nlist = cnt[0] + cnt[1] + cnt[2] + cnt[3];
        m = -1e30f; l = 0.f;
        { const int s0 = list[0]; ns_dma(z + (size_t)(s0 * 64) * NZ + ZKS + g * 128, NZ, lds + NS_KB, w, lane); ns_dma(z + (size_t)(s0 * 64) * NZ + ZVS + g * 128, NZ, lds + NS_VB, w, lane); }
        VM_WAIT(); __syncthreads();
        for (int i = 0; i < nlist; ++i) {
            const int sb = list[i];
            if (i + 1 < nlist) { const int sn = list[i + 1]; ns_dma(z + (size_t)(sn * 64) * NZ + ZKS + g * 128, NZ, lds + NS_KB + ((i + 1) & 1) * 16384, w, lane); ns_dma(z + (size_t)(sn * 64) * NZ + ZVS + g * 128, NZ, lds + NS_VB + ((i + 1) & 1) * 16384, w, lane); }
            const unsigned wneed = (wany[w * 8 + (sb >> 5)] >> (sb & 31)) & 1u;
            if (wneed) {
                const bool rsel = (selb[(8 * w + ql) * 8 + (sb >> 5)] >> (sb & 31)) & 1u;
                f32x16 x0, x1; ns_qk(x0, x1, lds + NS_KB + (i & 1) * 16384, qf, rho, hh);
                const int kp0 = sb * 64;
#pragma unroll
                for (int r = 0; r < 16; ++r) { const int kp = kp0 + NS_KIDX(r, hh); x0[r] = (rsel && kp <= tq) ? x0[r] * c2 : -INFINITY; x1[r] = (rsel && kp + 32 <= tq) ? x1[r] * c2 : -INFINITY; }
                ns_online(x0, x1, m, l, O);
                ns_pv(O, lds + NS_VB + (i & 1) * 16384, x0, x1, lane);
            }
            VM_WAIT(); __syncthreads();
        }
        l += __shfl_xor(l, 32);
        { const float sc = gate_s / fmaxf(l, 1e-30f);
#pragma unroll
          for (int c = 0; c < 4; ++c) {
#pragma unroll
              for (int r4 = 0; r4 < 4; ++r4) { f32x4* op = (f32x4*)(orow + 32 * c + 8 * r4); const f32x4 e = *op; *op = (f32x4){e.x + O[c][4 * r4] * sc, e.y + O[c][4 * r4 + 1] * sc, e.z + O[c][4 * r4 + 2] * sc, e.w + O[c][4 * r4 + 3] * sc}; }
#pragma unroll
              for (int i = 0; i < 16; ++i) O[c][i] = 0.f; } }
        m = -1e30f; l = 0.f;
        const int wb0 = blk >= 8 ? blk - 8 : 0, nwt = blk - wb0 + 1;
        ns_dma(z + (size_t)(wb0 * 64) * NZ + ZKW + g * 128, NZ, lds + NS_KB, w, lane); ns_dma(z + (size_t)(wb0 * 64) * NZ + ZVW + g * 128, NZ, lds + NS_VB, w, lane);
        VM_WAIT(); __syncthreads();
        for (int i = 0; i < nwt; ++i) {
            const int kb = wb0 + i;
            if (i + 1 < nwt) { ns_dma(z + (size_t)((kb + 1) * 64) * NZ + ZKW + g * 128, NZ, lds + NS_KB + ((i + 1) & 1) * 16384, w, lane); ns_dma(z + (size_t)((kb + 1) * 64) * NZ + ZVW + g * 128, NZ, lds + NS_VB + ((i + 1) & 1) * 16384, w, lane); }
            f32x16 x0, x1; ns_qk(x0, x1, lds + NS_KB + (i & 1) * 16384, qf, rho, hh);
            const int kp0 = kb * 64;
#pragma unroll
            for (int r = 0; r < 16; ++r) { const int kp = kp0 + NS_KIDX(r, hh);
                x0[r] = (kp <= tq && kp + 511 >= tq) ? x0[r] * c2 : -INFINITY; x1[r] = (kp + 32 <= tq && kp + 32 + 511 >= tq) ? x1[r] * c2 : -INFINITY; }
            ns_online(x0, x1, m, l, O);
            ns_pv(O, lds + NS_VB + (i & 1) * 16384, x0, x1, lane);
            VM_WAIT(); __syncthreads();
        }
        l += __shfl_xor(l, 32);
        { const float sc = gate_w / fmaxf(l, 1e-30f);
#pragma unroll
          for (int c = 0; c < 4; ++c)
#pragma unroll
              for (int r4 = 0; r4 < 4; ++r4) { f32x4* op = (f32x4*)(orow + 32 * c + 8 * r4); const f32x4 e = *op; *op = (f32x4){e.x + O[c][4 * r4] * sc, e.y + O[c][4 * r4 + 1] * sc, e.z + O[c][4 * r4 + 2] * sc, e.w + O[c][4 * r4 + 3] * sc}; } }
    }
}


constexpr int RS = 72, SLOT = 64 * RS * 2, RW_FS = 68, RW_GCL = 14 * SLOT;
#define RW_SLOT(lds, i) ((LAS bf16*)((lds) + (i) * SLOT))
template <int KS> __device__ __forceinline__ void mm_acc(f32x4 (&acc)[2], const LAS bf16* X, int xs, const LAS bf16* Y, int ys, int w, int lane) {
    const LAS bf16* xp = X + (16 * (w >> 1) + (lane & 15)) * xs + 8 * (lane >> 4);
    const LAS bf16* yp = Y + (32 * (w & 1) + (lane & 15)) * ys + 8 * (lane >> 4);
#pragma unroll
    for (int ks = 0; ks < KS; ++ks) { const bf16x8 av = *(const LAS bf16x8*)(xp + 32 * ks), b0 = *(const LAS bf16x8*)(yp + 32 * ks), b1 = *(const LAS bf16x8*)(yp + 16 * ys + 32 * ks);
        acc[0] = __builtin_amdgcn_mfma_f32_16x16x32_bf16(av, b0, acc[0], 0, 0, 0); acc[1] = __builtin_amdgcn_mfma_f32_16x16x32_bf16(av, b1, acc[1], 0, 0, 0); }
}
__device__ __forceinline__ void acc_zero(f32x4 (&acc)[2]) { acc[0] = (f32x4){0.f, 0.f, 0.f, 0.f}; acc[1] = (f32x4){0.f, 0.f, 0.f, 0.f}; }
__device__ __forceinline__ void st_n(const f32x4 (&acc)[2], LAS bf16* dst, int m0, int n0) {
#pragma unroll
    for (int tn = 0; tn < 2; ++tn)
#pragma unroll
        for (int r = 0; r < 4; ++r) dst[(m0 + r) * RS + n0 + 16 * tn] = (bf16)acc[tn][r];
}
__device__ __forceinline__ void st_t(const f32x4 (&acc)[2], LAS bf16* dst, int m0, int n0) {
#pragma unroll
    for (int tn = 0; tn < 2; ++tn) { const bf16x4 v = {(bf16)acc[tn][0], (bf16)acc[tn][1], (bf16)acc[tn][2], (bf16)acc[tn][3]}; *(LAS bf16x4*)(dst + (n0 + 16 * tn) * RS + m0) = v; }
}
__device__ __forceinline__ void ld_n(f32x4 (&acc)[2], const LAS bf16* src, int m0, int n0) {
#pragma unroll
    for (int tn = 0; tn < 2; ++tn)
#pragma unroll
        for (int r = 0; r < 4; ++r) acc[tn][r] = (float)src[(m0 + r) * RS + n0 + 16 * tn];
}
template <bool INCL> __device__ __forceinline__ void tri_mask(f32x4 (&acc)[2], int m0, int n0) {
#pragma unroll
    for (int tn = 0; tn < 2; ++tn)
#pragma unroll
        for (int r = 0; r < 4; ++r) { const int m = m0 + r, n = n0 + 16 * tn; if (INCL ? (n > m) : (n >= m)) acc[tn][r] = 0.f; }
}
__device__ __forceinline__ void st_acc_g(const f32x4 (&acc)[2], f16* base, int u, int w, int lane) {
#pragma unroll
    for (int tn = 0; tn < 2; ++tn) { const f16x4 v = {(f16)acc[tn][0], (f16)acc[tn][1], (f16)acc[tn][2], (f16)acc[tn][3]}; ((f16x4*)base)[((size_t)u * 16 + w * 2 + tn) * 64 + lane] = v; }
}
__device__ __forceinline__ float fast_tanh(float x) { const float e = __expf(2.f * x); return 1.f - 2.f / (e + 1.f); }

__device__ __forceinline__ void p_rwkv_local(const Args& a, LAS unsigned char* lds) {
    const int tid = opaque_tid(), lane = tid & 63, w = __builtin_amdgcn_readfirstlane(tid >> 6);
    const int m0 = 16 * (w >> 1) + 4 * (lane >> 4), n0 = 32 * (w & 1) + (lane & 15);
    const int et = tid >> 3, cg = tid & 7;
    const f16* z = (const f16*)(a.ws + WS_Z);
    unsigned char* ro = (unsigned char*)a.out;
    LAS float* FW = (LAS float*)(lds + 8 * SLOT); LAS float* FA = FW + 64 * RW_FS; LAS float* TOT = FA + 64 * RW_FS; LAS float* GCL = (LAS float*)(lds + RW_GCL);
    const float* mu = a.in[I_MU];
    for (int u = blockIdx.x; u < 4096; u += gridDim.x) {
        const int c = u >> 4, h = u & 15, t0 = c * 64, ch0 = h * 64 + 8 * cg, uo = h * 256 + c;
        float r_[8], k_[8], v_[8];
        { const int t = t0 + et; const f16* cur = z + (size_t)t * NZ; const f16* prv = cur - NZ; const bool hp = t > 0;
          f16x8 c8, p8; const f16x8 zero8 = {0, 0, 0, 0, 0, 0, 0, 0};
          c8 = *(const f16x8*)(cur + ZR + ch0); p8 = hp ? *(const f16x8*)(prv + ZR + ch0) : zero8;
#pragma unroll
          for (int e = 0; e < 8; ++e) r_[e] = (float)c8[e] + ((float)p8[e] - (float)c8[e]) * mu[ch0 + e];
          c8 = *(const f16x8*)(cur + ZK + ch0); p8 = hp ? *(const f16x8*)(prv + ZK + ch0) : zero8;
#pragma unroll
          for (int e = 0; e < 8; ++e) k_[e] = (float)c8[e] + ((float)p8[e] - (float)c8[e]) * mu[1024 + ch0 + e];
          c8 = *(const f16x8*)(cur + ZV + ch0); p8 = hp ? *(const f16x8*)(prv + ZV + ch0) : zero8;
#pragma unroll
          for (int e = 0; e < 8; ++e) v_[e] = (float)c8[e] + ((float)p8[e] - (float)c8[e]) * mu[2048 + ch0 + e];
          bf16x8 x1, x2;
          c8 = *(const f16x8*)(cur + ZWD + 8 * cg); p8 = hp ? *(const f16x8*)(prv + ZWD + 8 * cg) : zero8;
#pragma unroll
          for (int e = 0; e < 8; ++e) x1[e] = (bf16)fast_tanh((float)c8[e] + ((float)p8[e] - (float)c8[e]) * mu[3072 + 8 * cg + e]);
          c8 = *(const f16x8*)(cur + ZAD + 8 * cg); p8 = hp ? *(const f16x8*)(prv + ZAD + 8 * cg) : zero8;
#pragma unroll
          for (int e = 0; e < 8; ++e) x2[e] = (bf16)((float)c8[e] + ((float)p8[e] - (float)c8[e]) * mu[3136 + 8 * cg + e]);
          *(LAS bf16x8*)(RW_SLOT(lds, 0) + et * RS + 8 * cg) = x1; *(LAS bf16x8*)(RW_SLOT(lds, 1) + et * RS + 8 * cg) = x2;
          *(LAS u32x4*)(RW_SLOT(lds, 2) + et * RS + 8 * cg) = *(const u32x4*)((const bf16*)(a.ws + WS_WUPT) + (size_t)(h * 64 + et) * 64 + 8 * cg);
          *(LAS u32x4*)(RW_SLOT(lds, 3) + et * RS + 8 * cg) = *(const u32x4*)((const bf16*)(a.ws + WS_AUPT) + (size_t)(h * 64 + et) * 64 + 8 * cg); }
        __syncthreads();
        { f32x4 acc[2]; acc_zero(acc); mm_acc<2>(acc, RW_SLOT(lds, 0), RS, RW_SLOT(lds, 2), RS, w, lane);
#pragma unroll
          for (int tn = 0; tn < 2; ++tn)
#pragma unroll
              for (int r = 0; r < 4; ++r) FW[(m0 + r) * RW_FS + n0 + 16 * tn] = acc[tn][r];
          acc_zero(acc); mm_acc<2>(acc, RW_SLOT(lds, 1), RS, RW_SLOT(lds, 3), RS, w, lane);
#pragma unroll
          for (int tn = 0; tn < 2; ++tn)
#pragma unroll
              for (int r = 0; r < 4; ++r) FA[(m0 + r) * RW_FS + n0 + 16 * tn] = acc[tn][r]; }
        __syncthreads();
        float lw_[8], kk_[8], b_[8];
        { float ss = 0.f, sb = 0.f;
#pragma unroll
          for (int e = 0; e < 8; ++e) { const int ch = ch0 + e;
              const float wpre = a.in[I_W0][ch] + FW[et * RW_FS + 8 * cg + e]; const float y0 = -wpre; const float sp = fmaxf(y0, 0.f) + __logf(1.f + __expf(-fabsf(y0)));
              lw_[e] = -__expf(-sp - 0.5f);
              const float av = sigmoidf_(a.in[I_A0][ch] + FA[et * RW_FS + 8 * cg + e]);
              const float kkr = k_[e] * a.in[I_KK][ch]; ss += kkr * kkr; kk_[e] = kkr;
              k_[e] = k_[e] * (1.f + (av - 1.f) * a.in[I_KA][ch]); b_[e] = av;
              sb += r_[e] * k_[e] * a.in[I_RK][ch]; }
          ss += __shfl_xor(ss, 1); ss += __shfl_xor(ss, 2); ss += __shfl_xor(ss, 4);
          sb += __shfl_xor(sb, 1); sb += __shfl_xor(sb, 2); sb += __shfl_xor(sb, 4);
          const float rn = rsqrtf(fmaxf(ss, 1e-24f));
#pragma unroll
          for (int e = 0; e < 8; ++e) { kk_[e] *= rn; b_[e] *= kk_[e]; FW[et * RW_FS + 8 * cg + e] = lw_[e]; }
          if (cg == 0) ((float*)(a.ws + WS_SBON))[(size_t)(t0 + et) * 16 + h] = sb; }
        __syncthreads();
        { const int j = tid & 63, rg = tid >> 6; float run = 0.f;
#pragma unroll
          for (int i = 0; i < 8; ++i) { run += FW[(8 * rg + i) * RW_FS + j]; FW[(8 * rg + i) * RW_FS + j] = run; }
          TOT[rg * 64 + j] = run;
          __syncthreads();
          float off = 0.f;
          for (int q = 0; q < rg; ++q) off += TOT[q * 64 + j];
#pragma unroll
          for (int i = 0; i < 8; ++i) FW[(8 * rg + i) * RW_FS + j] += off; }
        __syncthreads();
        { bf16x8 at, bt, kt, rt;
#pragma unroll
          for (int e = 0; e < 8; ++e) { const int jj = 8 * cg + e; const float cum = FW[et * RW_FS + jj], cl = FW[63 * RW_FS + jj];
              const float eA = __expf(cum - lw_[e]), eN = __expf(-cum), eP = __expf(cum), eH = __expf(cl - cum);
              const float A_ = -kk_[e] * eA;
              at[e] = (bf16)A_; bt[e] = (bf16)(b_[e] * eN); kt[e] = (bf16)(k_[e] * eN); rt[e] = (bf16)(r_[e] * eP);
              RW_SLOT(lds, 1)[jj * RS + et] = (bf16)A_; RW_SLOT(lds, 5)[jj * RS + et] = (bf16)(b_[e] * eH); RW_SLOT(lds, 6)[jj * RS + et] = (bf16)(k_[e] * eH); RW_SLOT(lds, 7)[jj * RS + et] = (bf16)v_[e];
              if (et == 63) GCL[jj] = __expf(cl); }
          *(LAS bf16x8*)(RW_SLOT(lds, 0) + et * RS + 8 * cg) = at; *(LAS bf16x8*)(RW_SLOT(lds, 2) + et * RS + 8 * cg) = bt;
          *(LAS bf16x8*)(RW_SLOT(lds, 3) + et * RS + 8 * cg) = kt; *(LAS bf16x8*)(RW_SLOT(lds, 4) + et * RS + 8 * cg) = rt; }
        __syncthreads();
        { f32x4 acc[2];
          acc_zero(acc); mm_acc<2>(acc, RW_SLOT(lds, 0), RS, RW_SLOT(lds, 2), RS, w, lane); tri_mask<false>(acc, m0, n0);
          st_n(acc, RW_SLOT(lds, 8), m0, n0); st_t(acc, RW_SLOT(lds, 9), m0, n0);
#pragma unroll
          for (int tn = 0; tn < 2; ++tn)
#pragma unroll
              for (int r = 0; r < 4; ++r) if (m0 + r == n0 + 16 * tn) acc[tn][r] += 1.f;
          st_n(acc, RW_SLOT(lds, 13), m0, n0);
          acc_zero(acc); mm_acc<2>(acc, RW_SLOT(lds, 0), RS, RW_SLOT(lds, 3), RS, w, lane); tri_mask<false>(acc, m0, n0); st_t(acc, RW_SLOT(lds, 10), m0, n0);
          acc_zero(acc); mm_acc<2>(acc, RW_SLOT(lds, 4), RS, RW_SLOT(lds, 2), RS, w, lane); tri_mask<true>(acc, m0, n0); st_n(acc, RW_SLOT(lds, 11), m0, n0);
          acc_zero(acc); mm_acc<2>(acc, RW_SLOT(lds, 4), RS, RW_SLOT(lds, 3), RS, w, lane); tri_mask<true>(acc, m0, n0); st_n(acc, RW_SLOT(lds, 12), m0, n0); }
        __syncthreads();
        { f32x4 acc[2];
          acc_zero(acc); mm_acc<2>(acc, RW_SLOT(lds, 8), RS, RW_SLOT(lds, 9), RS, w, lane); st_n(acc, RW_SLOT(lds, 0), m0, n0); st_t(acc, RW_SLOT(lds, 2), m0, n0);
          __syncthreads();
          ld_n(acc, RW_SLOT(lds, 13), m0, n0); mm_acc<2>(acc, RW_SLOT(lds, 13), RS, RW_SLOT(lds, 2), RS, w, lane); st_n(acc, RW_SLOT(lds, 3), m0, n0);
          acc_zero(acc); mm_acc<2>(acc, RW_SLOT(lds, 0), RS, RW_SLOT(lds, 2), RS, w, lane); st_n(acc, RW_SLOT(lds, 8), m0, n0); st_t(acc, RW_SLOT(lds, 9), m0, n0);
          __syncthreads();
          ld_n(acc, RW_SLOT(lds, 3), m0, n0); mm_acc<2>(acc, RW_SLOT(lds, 3), RS, RW_SLOT(lds, 9), RS, w, lane); st_n(acc, RW_SLOT(lds, 13), m0, n0);
          acc_zero(acc); mm_acc<2>(acc, RW_SLOT(lds, 8), RS, RW_SLOT(lds, 9), RS, w, lane); st_n(acc, RW_SLOT(lds, 0), m0, n0); st_t(acc, RW_SLOT(lds, 2), m0, n0);
          __syncthreads();
          ld_n(acc, RW_SLOT(lds, 13), m0, n0); mm_acc<2>(acc, RW_SLOT(lds, 13), RS, RW_SLOT(lds, 2), RS, w, lane); st_n(acc, RW_SLOT(lds, 3), m0, n0);
          acc_zero(acc); mm_acc<2>(acc, RW_SLOT(lds, 0), RS, RW_SLOT(lds, 2), RS, w, lane); st_n(acc, RW_SLOT(lds, 8), m0, n0); st_t(acc, RW_SLOT(lds, 9), m0, n0);
          __syncthreads();
          ld_n(acc, RW_SLOT(lds, 3), m0, n0); mm_acc<2>(acc, RW_SLOT(lds, 3), RS, RW_SLOT(lds, 9), RS, w, lane); st_n(acc, RW_SLOT(lds, 13), m0, n0);
          acc_zero(acc); mm_acc<2>(acc, RW_SLOT(lds, 8), RS, RW_SLOT(lds, 9), RS, w, lane); st_t(acc, RW_SLOT(lds, 2), m0, n0);
          __syncthreads();
          ld_n(acc, RW_SLOT(lds, 13), m0, n0); mm_acc<2>(acc, RW_SLOT(lds, 13), RS, RW_SLOT(lds, 2), RS, w, lane); st_n(acc, RW_SLOT(lds, 3), m0, n0);
          __syncthreads();
          acc_zero(acc); mm_acc<2>(acc, RW_SLOT(lds, 1), RS, RW_SLOT(lds, 3), RS, w, lane); st_n(acc, RW_SLOT(lds, 0), m0, n0);
          acc_zero(acc); mm_acc<2>(acc, RW_SLOT(lds, 3), RS, RW_SLOT(lds, 10), RS, w, lane); st_n(acc, RW_SLOT(lds, 8), m0, n0);
          __syncthreads();
          acc_zero(acc); mm_acc<2>(acc, RW_SLOT(lds, 7), RS, RW_SLOT(lds, 8), RS, w, lane); st_n(acc, RW_SLOT(lds, 9), m0, n0);
          acc_zero(acc); mm_acc<2>(acc, RW_SLOT(lds, 0), RS, RW_SLOT(lds, 11), RS, w, lane);
#pragma unroll
          for (int tn = 0; tn < 2; ++tn) { const int tt = n0 + 16 * tn; const bf16x4 rr = *(const LAS bf16x4*)(RW_SLOT(lds, 4) + tt * RS + m0);
              const bf16x4 o = {(bf16)(acc[tn][0] + (float)rr[0]), (bf16)(acc[tn][1] + (float)rr[1]), (bf16)(acc[tn][2] + (float)rr[2]), (bf16)(acc[tn][3] + (float)rr[3])};
              *(bf16x4*)((bf16*)(ro + RO_Q) + (size_t)uo * 4096 + tt * 64 + m0) = o; }
          acc_zero(acc); mm_acc<2>(acc, RW_SLOT(lds, 0), RS, RW_SLOT(lds, 5), RS, w, lane);
#pragma unroll
          for (int tn = 0; tn < 2; ++tn) { const int jj = n0 + 16 * tn; const float gc = GCL[jj];
              const bf16x4 o = {(bf16)(acc[tn][0] + (m0 == jj ? gc : 0.f)), (bf16)(acc[tn][1] + (m0 + 1 == jj ? gc : 0.f)), (bf16)(acc[tn][2] + (m0 + 2 == jj ? gc : 0.f)), (bf16)(acc[tn][3] + (m0 + 3 == jj ? gc : 0.f))};
              *(bf16x4*)((bf16*)(ro + RO_M) + (size_t)uo * 4096 + jj * 64 + m0) = o; }
          __syncthreads();
          acc_zero(acc); mm_acc<2>(acc, RW_SLOT(lds, 11), RS, RW_SLOT(lds, 9), RS, w, lane); mm_acc<2>(acc, RW_SLOT(lds, 12), RS, RW_SLOT(lds, 7), RS, w, lane); st_acc_g(acc, (f16*)(ro + RO_Y), uo, w, lane);
          acc_zero(acc); mm_acc<2>(acc, RW_SLOT(lds, 9), RS, RW_SLOT(lds, 5), RS, w, lane); mm_acc<2>(acc, RW_SLOT(lds, 7), RS, RW_SLOT(lds, 6), RS, w, lane); st_acc_g(acc, (f16*)(ro + RO_N), uo, w, lane);
        }
    }
}
__device__ __forceinline__ void p_rwkv_scan(const Args& a, LAS unsigned char* lds, int h) {
    const int tid = opaque_tid(), lane = tid & 63, w = __builtin_amdgcn_readfirstlane(tid >> 6);
    const int m0 = 16 * (w >> 1) + 4 * (lane >> 4), n0 = 32 * (w & 1) + (lane & 15), row = tid >> 3, seg = tid & 7;
    const unsigned char* ro = (const unsigned char*)a.out;
    const bf16* Mg = (const bf16*)(ro + RO_M) + (size_t)h * 256 * 4096; const f16x4* Ng = (const f16x4*)(ro + RO_N) + (size_t)h * 256 * 1024; bf16* Sg = (bf16*)(a.ws + WS_RS) + (size_t)h * 256 * 4096;
    f32x4 acc[2]; acc_zero(acc);
    u32x4 mreg = *(const u32x4*)(Mg + row * 64 + seg * 8); f16x4 nreg[2] = {Ng[(w * 2) * 64 + lane], Ng[(w * 2 + 1) * 64 + lane]};
    for (int c = 0; c < 256; ++c) {
        LAS bf16* Sb = RW_SLOT(lds, c & 1); LAS bf16* Mb = RW_SLOT(lds, 2 + (c & 1));
        st_n(acc, Sb, m0, n0);
        *(LAS u32x4*)(Mb + row * RS + seg * 8) = mreg;
        const f16x4 nc0 = nreg[0], nc1 = nreg[1];
        if (c + 1 < 256) { mreg = *(const u32x4*)(Mg + (size_t)(c + 1) * 4096 + row * 64 + seg * 8); nreg[0] = Ng[(size_t)(c + 1) * 1024 + (w * 2) * 64 + lane]; nreg[1] = Ng[(size_t)(c + 1) * 1024 + (w * 2 + 1) * 64 + lane]; }
        __syncthreads();
        *(u32x4*)(Sg + (size_t)c * 4096 + row * 64 + seg * 8) = *(const LAS u32x4*)(Sb + row * RS + seg * 8);
        acc[0] = (f32x4){(float)nc0[0], (float)nc0[1], (float)nc0[2], (float)nc0[3]}; acc[1] = (f32x4){(float)nc1[0], (float)nc1[1], (float)nc1[2], (float)nc1[3]};
        mm_acc<2>(acc, Sb, RS, Mb, RS, w, lane);
    }
}
constexpr int RG_S = 168;
__device__ __forceinline__ void p_rwkv_out(const Args& a, LAS unsigned char* lds) {
    const int tid = opaque_tid(), lane = tid & 63, w = __builtin_amdgcn_readfirstlane(tid >> 6);
    const int m0 = 16 * (w >> 1) + 4 * (lane >> 4), n0 = 32 * (w & 1) + (lane & 15), row = tid >> 3, seg = tid & 7;
    const f16* z = (const f16*)(a.ws + WS_Z); const unsigned char* ro = (const unsigned char*)a.out; f16* mix = (f16*)(a.ws + WS_MIX);
    const float* mu = a.in[I_MU];
    LAS bf16* SG = (LAS bf16*)(lds + 2 * SLOT); LAS bf16* GU = SG + 64 * RG_S; LAS float* RED = (LAS float*)(GU + 64 * RG_S);
    for (int u = blockIdx.x; u < 4096; u += gridDim.x) {
        const int c = u >> 4, h = u & 15, t0 = c * 64, uo = h * 256 + c;
        __syncthreads();
        *(LAS u32x4*)(RW_SLOT(lds, 0) + row * RS + seg * 8) = *(const u32x4*)((const bf16*)(ro + RO_Q) + (size_t)uo * 4096 + row * 64 + seg * 8);
        *(LAS u32x4*)(RW_SLOT(lds, 1) + row * RS + seg * 8) = *(const u32x4*)((const bf16*)(a.ws + WS_RS) + (size_t)uo * 4096 + row * 64 + seg * 8);
        for (int ck = tid; ck < 64 * 20; ck += 512) { const int rr = ck / 20, c8 = ck % 20, t = t0 + rr; const f16* cur = z + (size_t)t * NZ + ZGD + 8 * c8;
            const f16x8 cv = *(const f16x8*)cur; const f16x8 zero8 = {0, 0, 0, 0, 0, 0, 0, 0}; const f16x8 pv = t > 0 ? *(const f16x8*)(cur - NZ) : zero8; bf16x8 o;
#pragma unroll
            for (int e = 0; e < 8; ++e) o[e] = (bf16)sigmoidf_((float)cv[e] + ((float)pv[e] - (float)cv[e]) * mu[3200 + 8 * c8 + e]);
            *(LAS bf16x8*)(SG + rr * RG_S + 8 * c8) = o;
            *(LAS u32x4*)(GU + rr * RG_S + 8 * c8) = *(const u32x4*)((const bf16*)(a.ws + WS_GUPT) + (size_t)(h * 64 + rr) * 160 + 8 * c8); }
        __syncthreads();
        f32x4 y[2], g[2];
        { const f16x4* Yg = (const f16x4*)(ro + RO_Y) + (size_t)uo * 1024; const f16x4 y0 = Yg[(w * 2) * 64 + lane], y1 = Yg[(w * 2 + 1) * 64 + lane];
          y[0] = (f32x4){(float)y0[0], (float)y0[1], (float)y0[2], (float)y0[3]}; y[1] = (f32x4){(float)y1[0], (float)y1[1], (float)y1[2], (float)y1[3]}; }
        mm_acc<2>(y, RW_SLOT(lds, 0), RS, RW_SLOT(lds, 1), RS, w, lane);
        acc_zero(g); mm_acc<5>(g, SG, RG_S, GU, RG_S, w, lane);
        float s1[4], s2[4];
#pragma unroll
        for (int r = 0; r < 4; ++r) { s1[r] = y[0][r] + y[1][r]; s2[r] = y[0][r] * y[0][r] + y[1][r] * y[1][r];
#pragma unroll
            for (int o = 1; o < 16; o <<= 1) { s1[r] += __shfl_xor(s1[r], o); s2[r] += __shfl_xor(s2[r], o); }
            if ((lane & 15) == 0) { RED[((m0 + r) * 2 + (w & 1)) * 2] = s1[r]; RED[((m0 + r) * 2 + (w & 1)) * 2 + 1] = s2[r]; } }
        __syncthreads();
#pragma unroll
        for (int r = 0; r < 4; ++r) { const int tt = m0 + r, t = t0 + tt;
            const float sum = RED[(tt * 2) * 2] + RED[(tt * 2 + 1) * 2], sq = RED[(tt * 2) * 2 + 1] + RED[(tt * 2 + 1) * 2 + 1];
            const float mean = sum * (1.f / 64.f), var = fmaxf(sq * (1.f / 64.f) - mean * mean, 0.f), rstd = rsqrtf(var + 64e-5f);
            const float sbn = ((const float*)(a.ws + WS_SBON))[(size_t)t * 16 + h];
#pragma unroll
            for (int tn = 0; tn < 2; ++tn) { const int ch = h * 64 + n0 + 16 * tn; const f16* cur = z + (size_t)t * NZ + ZV + ch;
                const float cv = (float)cur[0], pv = t > 0 ? (float)cur[-NZ] : 0.f; const float vv = cv + (pv - cv) * mu[2048 + ch];
                const float yn = (y[tn][r] - mean) * rstd * a.in[I_LNXG][ch] + a.in[I_LNXB][ch];
                mix[(size_t)t * D + 1024 + ch] = (f16)((yn + sbn * vv) * g[tn][r]); } }
    }
}

__device__ __forceinline__ void p_router(const Args& a, LAS unsigned char* lds, int rep) {
    const int tid = opaque_tid(), lane = tid & 63, wave = tid >> 6, gw = blockIdx.x * 8 + wave, NGW = gridDim.x * 8;
    const float* x2 = (const float*)(a.ws + WS_X1); f16* h3 = (f16*)a.out;
    unsigned* ctl = (unsigned*)(a.ws + WS_CTL);
    int* tke = (int*)(a.ws + WS_TOK + TK_E); float* tkw = (float*)(a.ws + WS_TOK + TK_W);
    const f16* WH = (const f16*)(a.ws + WS_WRH); const f16* WL = (const f16*)(a.ws + WS_WRL);
    LAS float* LG = (LAS float*)(lds + wave * 4096); LAS float* RSTD = LG + 16 * 48;
    const int row = lane & 15, kq = lane >> 4;
    for (int tile = gw; tile < T / 16; tile += NGW) {
        const int r0 = tile * 16;
        f32x4 acc[3]; acc[0] = (f32x4){0.f, 0.f, 0.f, 0.f}; acc[1] = acc[0]; acc[2] = acc[0];
        float ss = 0.f;
        const float* xp = x2 + (size_t)(r0 + row) * D + 8 * kq;
        const f16* whp = WH + (size_t)row * D + 8 * kq; const f16* wlp = WL + (size_t)row * D + 8 * kq;
#pragma unroll 2
        for (int ks = 0; ks < 64; ++ks) {
            const f32x4 xa = *(const f32x4*)(xp + 32 * ks), xb = *(const f32x4*)(xp + 32 * ks + 4);
            ss += xa.x * xa.x + xa.y * xa.y + xa.z * xa.z + xa.w * xa.w + xb.x * xb.x + xb.y * xb.y + xb.z * xb.z + xb.w * xb.w;
            f16x8 hi, lo;
#pragma unroll
            for (int j = 0; j < 4; ++j) { hi[j] = (f16)xa[j]; lo[j] = (f16)(xa[j] - (float)hi[j]); hi[4 + j] = (f16)xb[j]; lo[4 + j] = (f16)(xb[j] - (float)hi[4 + j]); }
#pragma unroll
            for (int nt = 0; nt < 3; ++nt) { const f16x8 bh = *(const f16x8*)(whp + (size_t)nt * 16 * D + 32 * ks), bl = *(const f16x8*)(wlp + (size_t)nt * 16 * D + 32 * ks);
                acc[nt] = __builtin_amdgcn_mfma_f32_16x16x32_f16(hi, bh, acc[nt], 0, 0, 0); acc[nt] = __builtin_amdgcn_mfma_f32_16x16x32_f16(lo, bh, acc[nt], 0, 0, 0); acc[nt] = __builtin_amdgcn_mfma_f32_16x16x32_f16(hi, bl, acc[nt], 0, 0, 0); }
        }
        ss += __shfl_xor(ss, 16); ss += __shfl_xor(ss, 32);
        const float rstd = rsqrtf(ss * (1.f / D) + EPS);
        if (kq == 0) RSTD[row] = rstd;
#pragma unroll
        for (int nt = 0; nt < 3; ++nt)
#pragma unroll
            for (int r = 0; r < 4; ++r) LG[(4 * kq + r) * 48 + 16 * nt + row] = acc[nt][r];
        LDS_WAIT();
        if (lane < 16) {
            const float rs = RSTD[lane]; const LAS float* L = LG + lane * 48;
            float lg[4];
#pragma unroll
            for (int c = 0; c < 4; ++c) lg[c] = L[c] * rs + a.in[I_RGB][c];
            int gi = 0; float gm = lg[0];
#pragma unroll
            for (int c = 1; c < 4; ++c) if (lg[c] > gm) { gm = lg[c]; gi = c; }
            float gs = 0.f;
#pragma unroll
            for (int c = 0; c < 4; ++c) gs += __expf(lg[c] - gm);
            const float pg = 1.f / gs;
            float le[8];
#pragma unroll
            for (int c = 0; c < 8; ++c) le[c] = L[4 + gi * 8 + c] * rs + a.in[I_REB][gi * 8 + c];
            int e1 = 0; float m1 = le[0];
#pragma unroll
            for (int c = 1; c < 8; ++c) if (le[c] > m1) { m1 = le[c]; e1 = c; }
            int e2 = -1; float m2 = -INFINITY;
#pragma unroll
            for (int c = 0; c < 8; ++c) if (c != e1 && le[c] > m2) { m2 = le[c]; e2 = c; }
            const float p2 = __expf(m2 - m1);
            const float w1 = pg / (1.f + p2), w2 = pg * p2 / (1.f + p2);
            const int m = r0 + lane, E1 = gi * 8 + e1, E2 = gi * 8 + e2; tke[m * 2] = E1; tke[m * 2 + 1] = E2; tkw[m * 2] = w1; tkw[m * 2 + 1] = w2;
            atomicAdd(&ctl[CW_CNT + rep * 8000 + E1], 1u); atomicAdd(&ctl[CW_CNT + rep * 8000 + E2], 1u);
        }
        for (int rr = 0; rr < 16; ++rr) { const float rs = RSTD[rr]; const f32x4* xr = (const f32x4*)(x2 + (size_t)(r0 + rr) * D) + lane; const f32x4* gr = (const f32x4*)a.in[I_LN3] + lane; u32x2* o8 = (u32x2*)(h3 + (size_t)(r0 + rr) * D) + lane;
#pragma unroll
            for (int j = 0; j < 8; ++j) { const f32x4 v = xr[64 * j], gg = gr[64 * j]; u32x2 wv; wv.x = pkh(v.x * rs * gg.x, v.y * rs * gg.y); wv.y = pkh(v.z * rs * gg.z, v.w * rs * gg.w); o8[64 * j] = wv; } }
        LDS_WAIT();
    }
}
__device__ __forceinline__ void p_offsets(const Args& a) {
    if (blockIdx.x != 0) return;
    unsigned* ctl = (unsigned*)(a.ws + WS_CTL); int* stok = (int*)(a.ws + WS_TOK + TK_STOK); float* sw = (float*)(a.ws + WS_TOK + TK_SW);
    const int tid = opaque_tid();
    if (tid == 0) {
        int off = 0, ngu = 0, ndn = 0; int2* ugu = (int2*)(ctl + CW_UGU); int2* udn = (int2*)(ctl + CW_UDN);
        for (int e = 0; e < NEXP; ++e) { const int n = (int)ctl[CW_CNT + e]; ctl[CW_OFF + e] = (unsigned)off; const int nt = (n + 255) / 256;
            for (int rt = 0; rt < nt; ++rt) { const int pm = off / 256 + rt; for (int jt = 0; jt < 2; ++jt) ugu[ngu++] = make_int2(pm, e * 2 + jt); for (int jt = 0; jt < 8; ++jt) udn[ndn++] = make_int2(pm, e * 8 + jt); }
            off += nt * 256; }
        ctl[CW_OFF + NEXP] = (unsigned)off; ctl[CW_NT] = (unsigned)(off / 256); ctl[CW_NGU] = (unsigned)ngu; ctl[CW_NDN] = (unsigned)ndn;
    }
    __syncthreads();
    for (int e = 0; e < NEXP; ++e) { const int n = (int)ctl[CW_CNT + e], off = (int)ctl[CW_OFF + e], end = (int)ctl[CW_OFF + e + 1];
        for (int s = off + n + tid; s < end; s += 512) { stok[s] = 0; sw[s] = 0.f; } }
}
__device__ __forceinline__ void p_slots(const Args& a, int rep) {
    unsigned* ctl = (unsigned*)(a.ws + WS_CTL);
    const int* tke = (const int*)(a.ws + WS_TOK + TK_E); const float* tkw = (const float*)(a.ws + WS_TOK + TK_W); int* tks = (int*)(a.ws + WS_TOK + TK_SLOT);
    int* stok = (int*)(a.ws + WS_TOK + TK_STOK); float* sw = (float*)(a.ws + WS_TOK + TK_SW);
    const int tid_ = opaque_tid();
    for (int i = blockIdx.x * 512 + tid_; i < T * 2; i += gridDim.x * 512) { const int e = tke[i]; const int slot = (int)ctl[CW_OFF + e] + (int)atomicAdd(&ctl[CW_CUR + rep * 8000 + e], 1u);
        stok[slot] = i >> 1; sw[slot] = tkw[i]; tks[i] = slot; }
}

constexpr int NPH = 17;
__global__ void __launch_bounds__(512, 2) mega(Args args) {
    extern __shared__ __attribute__((aligned(16))) unsigned char lds_raw[];
    LAS unsigned char* lds = (LAS unsigned char*)lds_raw;
    volatile LAS unsigned* MISC = (volatile LAS unsigned*)(lds + MISC_OFF);
    const int G = gridDim.x;
#define PH_IDS const int tid = opaque_tid(), lane = tid & 63, wave = tid >> 6, gw = blockIdx.x * 8 + wave, NGW = gridDim.x * 8; (void)tid; (void)lane; (void)gw; (void)NGW
    unsigned char* ws = args.ws;
    unsigned* ctl = (unsigned*)(ws + WS_CTL);
    if (threadIdx.x < 128) ((LAS unsigned*)(lds + MISC_OFF))[threadIdx.x] = 0u;
    __syncthreads();
    XcdBarrier bar; bar.bar = ctl + CW_BAR; bar.x = 0; bar.st = nullptr;
    const int lo = args.ph_lo, hi = args.ph_hi;
    if (hi - lo > 1 || DUPMASK != 0u) bar = xcd_barrier_post(ctl + CW_BAR, MISC + 8);
#ifndef PHMASK
#define PHMASK 0xFFFFFFFFu
#endif
#define IN(k) (((PHMASK >> (k)) & 1u) && lo <= (k) && (k) < hi)
#define BOTH(k) (IN(k) && IN((k) + 1))
#define GRID_BAR() xcd_barrier(bar)
#define NREP(k) ((((DUPMASK) >> (k)) & 1u) ? 2 : 1)

    for (int rep_ = 0; rep_ < NREP(0); ++rep_) if (IN(0)) { p0_prologue(args, lds); if (BOTH(0) || rep_ + 1 < NREP(0)) GRID_BAR(); }
    for (int rep_ = 0; rep_ < NREP(1); ++rep_) if (IN(1)) {
        { pg8::Gemm g{(const f16*)(ws + WS_H), (const f16*)(ws + WS_WIN), D, D, D, nullptr}; pg8::StaticOrder S; S.init(T, NZ, G, (int)blockIdx.x);
          pg8::EpiF16 E{(f16*)(ws + WS_Z), NZ, 1.f}; pg8::gemm_phase<pg8::EpiF16, pg8::StaticOrder, true>(lds, g, S, E); }
        { const int b = blockIdx.x; const int which = b / 8;
          pg8::Gemm g{(const f16*)(ws + WS_MEMN), (const f16*)(ws + (which == 0 ? WS_WKT : WS_WVT)), D, D, D, nullptr}; pg8::StaticOrder S; S.init(256, D, 8, b < 16 ? b % 8 : 1 << 20);
          pg8::EpiF16 E{(f16*)(ws + (which == 0 ? WS_KM : WS_VM)), D, 1.f}; pg8::gemm_phase<pg8::EpiF16, pg8::StaticOrder, true>(lds, g, S, E); }
        if (BOTH(1) || rep_ + 1 < NREP(1)) GRID_BAR();
    }
    for (int rep_ = 0; rep_ < NREP(2); ++rep_) if (IN(2)) {
        p_compress(args, lds);
        __syncthreads();
        p_rwkv_local(args, lds);
        __syncthreads();
        { const int b = blockIdx.x; const int grp = b / 8, c = b % 8;
          if (grp < 4) { const int h = grp;
              pg8::Gemm g{(const f16*)(ws + WS_KM) + h * 512, (const f16*)(ws + WS_WQ16) + h * 512, D, D, 512, nullptr}; pg8::StaticOrder S; S.init(256, D, 8, c);
              pg8::EpiF16 E{(f16*)(ws + WS_WQK) + (size_t)h * 256 * D, D, 0.04419417382415922f}; pg8::gemm_phase<pg8::EpiF16, pg8::StaticOrder, true>(lds, g, S, E); }
          else if (grp < 8) { const int h = grp - 4;
              pg8::Gemm g{(const f16*)(ws + WS_WOT) + h * 512, (const f16*)(ws + WS_VM) + h * 512, D, D, 512, nullptr}; pg8::StaticOrder S; S.init(D, 256, 8, c);
              pg8::EpiF16 E{(f16*)(ws + WS_VOT) + h * 256, 1024, 1.f}; pg8::gemm_phase<pg8::EpiF16, pg8::StaticOrder, true>(lds, g, S, E); } }
        if (BOTH(2) || rep_ + 1 < NREP(2)) GRID_BAR();
    }
    for (int rep_ = 0; rep_ < NREP(3); ++rep_) if (IN(3)) {
        if (blockIdx.x < 16) p_rwkv_scan(args, lds, blockIdx.x);
        __syncthreads();
        p_nsa(args, lds, rep_);
        if (BOTH(3) || rep_ + 1 < NREP(3)) GRID_BAR();
    }
    for (int rep_ = 0; rep_ < NREP(4); ++rep_) if (IN(4)) { p_rwkv_out(args, lds); if (BOTH(4) || rep_ + 1 < NREP(4)) GRID_BAR(); }
    for (int rep_ = 0; rep_ < NREP(5); ++rep_) if (IN(5)) {
        PH_IDS;
        const float* onsa = (const float*)(ws + WS_ONSA); f16* mix = (f16*)(ws + WS_MIX);
        for (int m = gw; m < T; m += NGW) { const f32x4* xr = (const f32x4*)(onsa + (size_t)m * 1024) + lane; f32x4 v[4]; float s = 0.f;
#pragma unroll
            for (int j = 0; j < 4; ++j) { v[j] = xr[64 * j]; s += v[j].x * v[j].x + v[j].y * v[j].y + v[j].z * v[j].z + v[j].w * v[j].w; }
            const float rstd = rsqrtf(wave_sum(s) * (1.f / 1024.f) + EPS); const f32x4* gr = (const f32x4*)args.in[I_NSAG] + lane; u32x2* o8 = (u32x2*)(mix + (size_t)m * D) + lane;
#pragma unroll
            for (int j = 0; j < 4; ++j) { const f32x4 gg = gr[64 * j]; u32x2 w; w.x = pkh(v[j].x * rstd * gg.x, v[j].y * rstd * gg.y); w.y = pkh(v[j].z * rstd * gg.z, v[j].w * rstd * gg.w); o8[64 * j] = w; } }
        if (BOTH(5) || rep_ + 1 < NREP(5)) GRID_BAR();
    }
    for (int rep_ = 0; rep_ < NREP(6); ++rep_) if (IN(6)) {
        pg8::Gemm g{(const f16*)(ws + WS_MIX), (const f16*)(ws + WS_WOUT), D, D, D, nullptr}; pg8::StaticOrder S; S.init(T, D, G, (int)blockIdx.x);
        pg8::EpiF32 E{(float*)(ws + WS_X1), args.in[I_X], D}; pg8::gemm_phase<pg8::EpiF32, pg8::StaticOrder, true>(lds, g, S, E);
        if (BOTH(6) || rep_ + 1 < NREP(6)) GRID_BAR();
    }
    for (int rep_ = 0; rep_ < NREP(7); ++rep_) if (IN(7)) {
        PH_IDS;
        for (int m = gw; m < T; m += NGW) rms_row((const float*)(ws + WS_X1) + (size_t)m * D, args.in[I_LN2], (f16*)(ws + WS_H2) + (size_t)m * D, lane);
        p_moe_weights(args, lds);
        if (BOTH(7) || rep_ + 1 < NREP(7)) GRID_BAR();
    }
    for (int rep_ = 0; rep_ < NREP(8); ++rep_) if (IN(8)) {
        pg8::Gemm g{(const f16*)(ws + WS_H2), (const f16*)(ws + WS_WQK), D, D, D, nullptr}; pg8::StaticOrder S; S.init(T, 1024, G, (int)blockIdx.x);
        pg8::EpiF32 E{(float*)(ws + WS_S), nullptr, 1024}; pg8::gemm_phase<pg8::EpiF32, pg8::StaticOrder, true>(lds, g, S, E);
        if (BOTH(8) || rep_ + 1 < NREP(8)) GRID_BAR();
    }
    for (int rep_ = 0; rep_ < NREP(9); ++rep_) if (IN(9)) {
        PH_IDS;
        const float* Sm = (const float*)(ws + WS_S); f16* P = (f16*)(ws + WS_P);
        for (int it = gw; it < T * 4; it += NGW) { const f32x4 v = *((const f32x4*)(Sm + (size_t)it * 256) + lane);
            const float mx = wave_max(fmaxf(fmaxf(v.x, v.y), fmaxf(v.z, v.w)));
            const float e0 = __expf(v.x - mx), e1 = __expf(v.y - mx), e2 = __expf(v.z - mx), e3 = __expf(v.w - mx);
            const float inv = 1.f / wave_sum(e0 + e1 + e2 + e3);
            u32x2 w; w.x = pkh(e0 * inv, e1 * inv); w.y = pkh(e2 * inv, e3 * inv); *((u32x2*)(P + (size_t)it * 256) + lane) = w; }
        if (BOTH(9) || rep_ + 1 < NREP(9)) GRID_BAR();
    }
    for (int rep_ = 0; rep_ < NREP(10); ++rep_) if (IN(10)) {
        pg8::Gemm g{(const f16*)(ws + WS_P), (const f16*)(ws + WS_VOT), 1024, 1024, 1024, nullptr}; pg8::StaticOrder S; S.init(T, D, G, (int)blockIdx.x);
        pg8::EpiF32 E{(float*)(ws + WS_X1), (const float*)(ws + WS_X1), D}; pg8::gemm_phase<pg8::EpiF32, pg8::StaticOrder, true>(lds, g, S, E);
        if (BOTH(10) || rep_ + 1 < NREP(10)) GRID_BAR();
    }
    for (int rep_ = 0; rep_ < NREP(11); ++rep_) if (IN(11)) { p_router(args, lds, rep_); if (BOTH(11) || rep_ + 1 < NREP(11)) GRID_BAR(); }
    for (int rep_ = 0; rep_ < NREP(12); ++rep_) if (IN(12)) { p_offsets(args); if (BOTH(12) || rep_ + 1 < NREP(12)) GRID_BAR(); }
    for (int rep_ = 0; rep_ < NREP(13); ++rep_) if (IN(13)) { p_slots(args, rep_); if (BOTH(13) || rep_ + 1 < NREP(13)) GRID_BAR(); }
    for (int rep_ = 0; rep_ < NREP(14); ++rep_) if (IN(14)) {
        pg8::Gemm g{(const f16*)args.out, (const f16*)(ws + WS_WGU), D, D, D, (const int*)(ws + WS_TOK + TK_STOK)};
        pg8::TableOrder S{(const int2*)(ctl + CW_UGU), (int)ctl[CW_NGU], G, (int)blockIdx.x};
        pg8::EpiSilu E{(f16*)(ws + WS_HID)}; pg8::gemm_phase<pg8::EpiSilu, pg8::TableOrder, true, true>(lds, g, S, E);
        if (BOTH(14) || rep_ + 1 < NREP(14)) GRID_BAR();
    }
    for (int rep_ = 0; rep_ < NREP(15); ++rep_) if (IN(15)) {
        pg8::Gemm g{(const f16*)(ws + WS_HID), (const f16*)(ws + WS_WD), EFF, EFF, EFF, nullptr};
        pg8::TableOrder S{(const int2*)(ctl + CW_UDN), (int)ctl[CW_NDN], G, (int)blockIdx.x};
        pg8::EpiDown E{ws}; pg8::gemm_phase<pg8::EpiDown, pg8::TableOrder, true>(lds, g, S, E);
        if (BOTH(15) || rep_ + 1 < NREP(15)) GRID_BAR();
    }
    for (int rep_ = 0; rep_ < NREP(16); ++rep_) if (IN(16)) {
        PH_IDS;
        const float* x2 = (const float*)(ws + WS_X1); const int* tks = (const int*)(ws + WS_TOK + TK_SLOT);
        const float* tkw = (const float*)(ws + WS_TOK + TK_W);
        for (int m = gw; m < T; m += NGW) { const int s1 = tks[m * 2], s2 = tks[m * 2 + 1]; const float w1 = tkw[m * 2], w2 = tkw[m * 2 + 1];
            const f16* y1 = (const f16*)(ws + ((s1 >> 8) < 128 ? WS_Y0 + (size_t)(s1 >> 8) * MiB : WS_Y1 + (size_t)((s1 >> 8) - 128) * MiB)) + (size_t)(s1 & 255) * D;
            const f16* y2 = (const f16*)(ws + ((s2 >> 8) < 128 ? WS_Y0 + (size_t)(s2 >> 8) * MiB : WS_Y1 + (size_t)((s2 >> 8) - 128) * MiB)) + (size_t)(s2 & 255) * D;
            const f32x4* xr = (const f32x4*)(x2 + (size_t)m * D) + lane; f32x4 v[8]; float s = 0.f;
#pragma unroll
            for (int j = 0; j < 8; ++j) { v[j] = xr[64 * j]; const f16x4 a1 = *((const f16x4*)y1 + lane + 64 * j), a2 = *((const f16x4*)y2 + lane + 64 * j);
                v[j].x += w1 * (float)a1.x + w2 * (float)a2.x; v[j].y += w1 * (float)a1.y + w2 * (float)a2.y; v[j].z += w1 * (float)a1.z + w2 * (float)a2.z; v[j].w += w1 * (float)a1.w + w2 * (float)a2.w;
                s += v[j].x * v[j].x + v[j].y * v[j].y + v[j].z * v[j].z + v[j].w * v[j].w; }
            const float rstd = rsqrtf(wave_sum(s) * (1.f / D) + EPS); const f32x4* gr = (const f32x4*)args.in[I_LNF] + lane; f32x4* o = (f32x4*)(args.out + (size_t)m * D) + lane;
#pragma unroll
            for (int j = 0; j < 8; ++j) { const f32x4 gg = gr[64 * j]; o[64 * j] = (f32x4){v[j].x * rstd * gg.x, v[j].y * rstd * gg.y, v[j].z * rstd * gg.z, v[j].w * rstd * gg.w}; } }
    }
#undef IN
#undef BOTH
#undef GRID_BAR
}

extern "C" void kernel_launch(void* const* d_in, const int* in_sizes, int n_in, void* d_out, int out_size, void* d_ws, size_t ws_size, hipStream_t stream) {
    static int grid = 0;
    if (grid == 0) {
        if (n_in != 38 || out_size != T * D || ws_size < WS_END) { fprintf(stderr, "kernel_launch: unexpected shapes (n_in %d out %d ws %zu)\n", n_in, out_size, ws_size); grid = -1; return; }
        int dev = 0, cus = 0;
        if (hipGetDevice(&dev) != hipSuccess || hipDeviceGetAttribute(&cus, hipDeviceAttributeMultiprocessorCount, dev) != hipSuccess) { grid = -1; return; }
        if (hipFuncSetAttribute((const void*)mega, hipFuncAttributeMaxDynamicSharedMemorySize, LDS_BYTES) != hipSuccess) { grid = -1; return; }
        int per_cu = 0; (void)hipOccupancyMaxActiveBlocksPerMultiprocessor(&per_cu, (const void*)mega, 512, LDS_BYTES); (void)hipGetLastError();
        grid = cus;
    }
    if (grid < 0) return;
    (void)hipMemsetAsync((char*)d_ws + WS_CTL, 0, CTL_ZERO_BYTES, stream);
    Args a{};
    for (int i = 0; i < 38; ++i) a.in[i] = (const float*)d_in[i];
    a.out = (float*)d_out; a.ws = (unsigned char*)d_ws;
#if MK_ONE_LAUNCH
    a.ph_lo = 0; a.ph_hi = NPH;
    hipLaunchKernelGGL(mega, dim3(grid), dim3(512), LDS_BYTES, stream, a);
#else
    for (int p = 0; p < NPH; ++p) { a.ph_lo = p; a.ph_hi = p + 1; hipLaunchKernelGGL(mega, dim3(grid), dim3(512), LDS_BYTES, stream, a); }
#endif
}
```

```cpp
#include <hip/hip_runtime.h>
#include <cstdio>
#include <cstdint>

#ifndef DUPMASK
#define DUPMASK 0u
#endif
#ifndef NSA_SELREP
#define NSA_SELREP 1
#endif
#ifndef NSA_CMPREP
#define NSA_CMPREP 1
#endif
#ifndef NSA_WINREP
#define NSA_WINREP 1
#endif
#ifndef MK_ONE_LAUNCH
#define MK_ONE_LAUNCH 1
#endif

#define LAS __attribute__((address_space(3)))
#define GAS __attribute__((address_space(1)))
typedef _Float16 f16;
typedef _Float16 f16x8 __attribute__((ext_vector_type(8)));
typedef _Float16 f16x4 __attribute__((ext_vector_type(4)));
typedef _Float16 f16x2 __attribute__((ext_vector_type(2)));
typedef float f32x4 __attribute__((ext_vector_type(4)));
typedef float f32x2 __attribute__((ext_vector_type(2)));
typedef unsigned u32x4 __attribute__((ext_vector_type(4)));
typedef unsigned u32x2 __attribute__((ext_vector_type(2)));
typedef __bf16 bf16;
typedef __bf16 bf16x8 __attribute__((ext_vector_type(8)));
typedef __bf16 bf16x4 __attribute__((ext_vector_type(4)));

constexpr int T = 16384, D = 2048, NZ = 6144;
constexpr int ZQ = 0, ZKC = 1024, ZVC = 1280, ZKS = 1536, ZVS = 1792, ZKW = 2048, ZVW = 2304, ZR = 2560, ZK = 3584, ZV = 4608, ZWD = 5632, ZAD = 5696, ZGD = 5760, ZGL = 5920;
constexpr int NCMP = 1023;
constexpr int NEXP = 32, EFF = 256, MAXSLOT = 40960, MAXTILES = 160;
constexpr float EPS = 1e-6f;

constexpr size_t MiB = 1u << 20;
constexpr size_t WS_CTL = 0, CTL_ZERO_BYTES = 64 * 1024;
constexpr size_t WS_MEMN = 1 * MiB, WS_KM = 2 * MiB, WS_VM = 3 * MiB, WS_KCMP = 4 * MiB, WS_VCMP = 5 * MiB, WS_TOK = 6 * MiB, WS_CMPB = 7 * MiB;
constexpr size_t WS_WQK = 8 * MiB, WS_VOT = 12 * MiB, WS_WIN = 16 * MiB, WS_WOUT = 40 * MiB, WS_WQ16 = 48 * MiB, WS_WKT = 56 * MiB, WS_WVT = 64 * MiB, WS_WOT = 72 * MiB;
constexpr size_t WS_WGU = 80 * MiB, WS_WD = 144 * MiB, WS_H = 176 * MiB, WS_Z = 240 * MiB, WS_ONSA = 432 * MiB, WS_END = 512 * MiB;
constexpr size_t WS_MIX = 112 * MiB, WS_P = WS_H, WS_H2 = WS_Z, WS_X1 = 304 * MiB, WS_S = WS_ONSA, WS_HID = 16 * MiB;
constexpr size_t WS_Y0 = 176 * MiB, WS_Y1 = 432 * MiB;
constexpr size_t WS_RS = 200 * MiB, WS_SBON = 232 * MiB;
constexpr size_t WS_WUPT = WS_CMPB + 64 * 1024, WS_AUPT = WS_WUPT + 128 * 1024, WS_GUPT = WS_AUPT + 128 * 1024;
constexpr size_t WS_W1T = 496 * MiB, WS_W2T = 498 * MiB, WS_CBIAS = 498 * MiB + 65536;
constexpr size_t WS_WRH = 499 * MiB, WS_WRL = 499 * MiB + 256 * 1024;
constexpr size_t RO_M = 0, RO_N = 32 * MiB, RO_Q = 64 * MiB, RO_Y = 96 * MiB;
constexpr size_t TK_E = 0, TK_W = 128 * 1024, TK_SLOT = 256 * 1024, TK_STOK = 384 * 1024, TK_SW = 576 * 1024;
constexpr int CW_BAR = 0;
constexpr int CW_Q = 3584;
constexpr int CW_CNT = 4096, CW_CUR = 4160, CW_OFF = 4224, CW_NT = 4288  , CW_NGU = 4289, CW_NDN = 4290;
constexpr int CW_UGU = 6144  , CW_UDN = 8192  ;
static_assert((CW_UDN + MAXTILES * 8 * 2) * 4 <= (int)CTL_ZERO_BYTES, "ctl");

constexpr int RING_BYTES = 131072, LDS_BYTES = 163840, MISC_OFF = LDS_BYTES - 512;

__device__ __forceinline__ unsigned pkh(float a, float b) { f16x2 v = {(f16)a, (f16)b}; return __builtin_bit_cast(unsigned, v); }
__device__ __forceinline__ float wave_sum(float v) {
#pragma unroll
    for (int o = 1; o < 64; o <<= 1) v += __shfl_xor(v, o);
    return v;
}
__device__ __forceinline__ float wave_max(float v) {
#pragma unroll
    for (int o = 1; o < 64; o <<= 1) v = fmaxf(v, __shfl_xor(v, o));
    return v;
}
__device__ __forceinline__ int opaque_tid() { int t = threadIdx.x; asm volatile("" : "+v"(t)); return t; }
#define LDS_WAIT() asm volatile("s_waitcnt lgkmcnt(0)" ::: "memory")
#define VM_WAIT() asm volatile("s_waitcnt vmcnt(0)" ::: "memory")
__device__ __forceinline__ float sigmoidf_(float x) { return 1.f / (1.f + __expf(-x)); }

namespace pg8 {
constexpr int BM = 256, BK = 64, HALF = 128, HTB = HALF * BK * 2, STAGE_BYTES = 8 * HTB, NXCD = 8, WGM = 8;
__host__ __device__ __forceinline__ int lds_byte(int r, int c) { const int st = (r >> 4) * 2 + (c >> 5), rr = r & 15, cc = c & 31, ob = rr * 64 + cc * 2; return st * 1024 + (ob ^ (((ob >> 9) & 1) << 5)); }
__host__ __device__ __forceinline__ void stage_rc(int b, int& R, int& C) { const int st = b / 1024, sb = b % 1024, swz = sb ^ (((sb >> 9) & 1) << 5); R = (st >> 1) * 16 + swz / 64; C = (st & 1) * 32 + (swz % 64) / 2; }
__host__ __device__ __forceinline__ int perm32(int rho) { const int n = rho >> 4, i = rho & 15; return 8 * (i >> 2) + 4 * n + (i & 3); }

struct Unit { int pm, pn; };
struct Gemm { const f16* A; const f16* Bt; int lda, ldb, K; const int* gather; };

struct StaticOrder {
    int nM, nN, nwg, G, c;
    __host__ __device__ void init(int M, int N, int G_, int c_) { nM = M / BM; nN = N / BM; nwg = nM * nN; G = G_; c = c_; }
    __host__ __device__ bool next(int i, Unit& u) const {
        const long L = (long)i * G + c; if (L >= nwg) return false;
        int wgid = (int)L; { const int q = nwg / NXCD, r = nwg % NXCD, xcd = wgid % NXCD, off = wgid / NXCD; wgid = (xcd < r ? xcd * (q + 1) : r * (q + 1) + (xcd - r) * q) + off; }
        const int nig = WGM * nN, gid = wgid / nig, fm = gid * WGM, gsz = (nM - fm) < WGM ? (nM - fm) : WGM;
        u.pm = fm + ((wgid % nig) % gsz); u.pn = (wgid % nig) / gsz; return true;
    }
};
struct TableOrder {
    const int2* tab; int n, G, c;
    __device__ bool next(int i, Unit& u) const { const int L = i * G + c; if (L >= n) return false; const int2 v = tab[L]; u.pm = v.x; u.pn = v.y; return true; }
};

struct EpiF16 {
    static constexpr bool PERM = true;
    f16* O; int ldc; float scale;
    __device__ __forceinline__ void operator()(const f32x4 (&acc)[2][2][4][2], const Unit& u, int wr, int wc, int fr, int fq) const {
        const int row0 = u.pm * BM + wr * 64 + fr, col0 = u.pn * BM + wc * 32 + 8 * fq;
#pragma unroll
        for (int ai = 0; ai < 2; ++ai)
#pragma unroll
            for (int m = 0; m < 4; ++m) { f16* rowp = O + (size_t)(row0 + ai * HALF + m * 16) * ldc + col0;
#pragma unroll
                for (int bj = 0; bj < 2; ++bj) { const f32x4 v0 = acc[ai][bj][m][0] * scale, v1 = acc[ai][bj][m][1] * scale;
                    u32x4 w; w.x = pkh(v0[0], v0[1]); w.y = pkh(v0[2], v0[3]); w.z = pkh(v1[0], v1[1]); w.w = pkh(v1[2], v1[3]);
                    *(u32x4*)(rowp + bj * HALF) = w; } }
    }
};
struct EpiF32 {
    static constexpr bool PERM = false;
    float* C; const float* R; int ldc;
    __device__ __forceinline__ void operator()(const f32x4 (&acc)[2][2][4][2], const Unit& u, int wr, int wc, int fr, int fq) const {
        const int row0 = u.pm * BM + wr * 64 + fr, col0 = u.pn * BM + wc * 32 + 4 * fq;
#pragma unroll
        for (int ai = 0; ai < 2; ++ai)
#pragma unroll
            for (int m = 0; m < 4; ++m) { const size_t ro = (size_t)(row0 + ai * HALF + m * 16) * ldc + col0;
#pragma unroll
                for (int bj = 0; bj < 2; ++bj)
#pragma unroll
                    for (int n = 0; n < 2; ++n) { f32x4 v = acc[ai][bj][m][n]; if (R) v = v + *(const f32x4*)(R + ro + bj * HALF + n * 16); *(f32x4*)(C + ro + bj * HALF + n * 16) = v; } }
    }
};
struct EpiSilu {
    static constexpr bool PERM = true;
    f16* O;
    __device__ __forceinline__ void operator()(const f32x4 (&acc)[2][2][4][2], const Unit& u, int wr, int wc, int fr, int fq) const {
        const int row0 = u.pm * BM + wr * 64 + fr, col0 = (u.pn & 1) * 128 + wc * 32 + 8 * fq;
#pragma unroll
        for (int ai = 0; ai < 2; ++ai)
#pragma unroll
            for (int m = 0; m < 4; ++m) { f16* rowp = O + (size_t)(row0 + ai * HALF + m * 16) * EFF + col0;
                float h[8];
#pragma unroll
                for (int n = 0; n < 2; ++n)
#pragma unroll
                    for (int e = 0; e < 4; ++e) { const float gt = acc[ai][0][m][n][e], up = acc[ai][1][m][n][e]; h[n * 4 + e] = gt / (1.f + __expf(-gt)) * up; }
                u32x4 w; w.x = pkh(h[0], h[1]); w.y = pkh(h[2], h[3]); w.z = pkh(h[4], h[5]); w.w = pkh(h[6], h[7]);
                *(u32x4*)rowp = w; }
    }
};
struct EpiDown {
    static constexpr bool PERM = true;
    unsigned char* ws;
    __device__ __forceinline__ void operator()(const f32x4 (&acc)[2][2][4][2], const Unit& u, int wr, int wc, int fr, int fq) const {
        f16* tile = (f16*)(ws + (u.pm < 128 ? WS_Y0 + (size_t)u.pm * MiB : WS_Y1 + (size_t)(u.pm - 128) * MiB));
        const int r0 = wr * 64 + fr, col0 = (u.pn & 7) * BM + wc * 32 + 8 * fq;
#pragma unroll
        for (int ai = 0; ai < 2; ++ai)
#pragma unroll
            for (int m = 0; m < 4; ++m) { f16* rowp = tile + (size_t)(r0 + ai * HALF + m * 16) * D + col0;
#pragma unroll
                for (int bj = 0; bj < 2; ++bj) { const f32x4 v0 = acc[ai][bj][m][0], v1 = acc[ai][bj][m][1];
                    u32x4 w; w.x = pkh(v0[0], v0[1]); w.y = pkh(v0[2], v0[3]); w.z = pkh(v1[0], v1[1]); w.w = pkh(v1[2], v1[3]);
                    *(u32x4*)(rowp + bj * HALF) = w; } }
    }
};

template <class Epi, class Sched, bool ALIGN_EPI, bool GATHER = false>
__device__ __forceinline__ void gemm_phase(LAS unsigned char* lds, const Gemm g, const Sched& S, const Epi& E) {
    const int tid = opaque_tid(), wid = __builtin_amdgcn_readfirstlane(tid >> 6), lane = tid & 63, wr = wid >> 2, wc = wid & 3, fr = lane & 15, fq = lane >> 4;
    const int K = g.K, nt = K / BK;
    int RA[2], CA[2]; unsigned voffA[2], voffB[2];
#pragma unroll
    for (int i = 0; i < 2; ++i) { int R, C; stage_rc(tid * 16 + i * 8192, R, C); const int Rb = Epi::PERM ? ((R & ~31) + perm32(R & 31)) : R;
        RA[i] = R; CA[i] = C; voffA[i] = (unsigned)(R * g.lda + C) * 2u; voffB[i] = (unsigned)(Rb * g.ldb + C) * 2u; }
    const size_t kstep = (size_t)(BK * 2);
    const size_t hstepA = (size_t)HALF * g.lda * 2, tstepA = 2 * hstepA;
    const size_t hstepB = (size_t)HALF * g.ldb * 2, tstepB = 2 * hstepB;
    const unsigned ldsw = (unsigned)wid * 1024u;
    const int aoff = lds_byte(wr * 64 + fr, fq * 8), boff = lds_byte(wc * 32 + fr, fq * 8);
    const char* Ab = (const char*)g.A;
#define PG8_SA(b, h) (((b) * 2 + (h)) * HTB)
#define PG8_SB(b, h) ((4 + (b) * 2 + (h)) * HTB)
#define PG8_STAGE(bufoff, gbase, voff) do { _Pragma("unroll") for (int _i = 0; _i < 2; ++_i) \
        __builtin_amdgcn_global_load_lds((const unsigned*)((const char*)(gbase) + (voff)[_i]), (LAS unsigned*)(lds + (bufoff) + ldsw + _i * 8192), 16, 0, 0); } while (0)
#define PG8_STA_CUR(bufoff, h, kb) do { if constexpr (GATHER) { PG8_STAGE(bufoff, Ab + (kb), offC[h]); } else { PG8_STAGE(bufoff, cA + (h) * hstepA + (kb), voffA); } } while (0)
#define PG8_STA_SEL(bufoff, h, kb) do { if constexpr (GATHER) { PG8_STAGE(bufoff, Ab + (kb), o2[h]); } else { PG8_STAGE(bufoff, a2p + (h) * hstepA + (kb), voffA); } } while (0)
#define PG8_LDA(dst, b, h) do { _Pragma("unroll") for (int m = 0; m < 4; ++m) _Pragma("unroll") for (int k = 0; k < 2; ++k) dst[m][k] = *(const LAS f16x8*)(lds + PG8_SA(b, h) + aoff + m * 2048 + k * 1024); } while (0)
#define PG8_LDB(dst, b, h) do { _Pragma("unroll") for (int n = 0; n < 2; ++n) _Pragma("unroll") for (int k = 0; k < 2; ++k) dst[n][k] = *(const LAS f16x8*)(lds + PG8_SB(b, h) + boff + n * 2048 + k * 1024); } while (0)
#define PG8_MMA(ai, bj, At, Bt) do { __builtin_amdgcn_s_setprio(1); _Pragma("unroll") for (int m = 0; m < 4; ++m) _Pragma("unroll") for (int n = 0; n < 2; ++n) _Pragma("unroll") for (int k = 0; k < 2; ++k) \
        acc[ai][bj][m][n] = __builtin_amdgcn_mfma_f32_16x16x32_f16(Bt[n][k], At[m][k], acc[ai][bj][m][n], 0, 0, 0); __builtin_amdgcn_s_setprio(0); } while (0)
#define PG8_WAIT_V(n) asm volatile("s_waitcnt vmcnt(" #n ")" ::: "memory")
#define PG8_WAIT_L(n) asm volatile("s_waitcnt lgkmcnt(" #n ")" ::: "memory")
#define PG8_BAR __builtin_amdgcn_s_barrier()
#define PG8_SCHED __builtin_amdgcn_sched_barrier(0)
#define PG8_OFFS(dst, U) do { _Pragma("unroll") for (int _h = 0; _h < 2; ++_h) _Pragma("unroll") for (int _i = 0; _i < 2; ++_i) { \
        const int _r = (U).pm * BM + _h * HALF + RA[_i]; dst[_h][_i] = ((unsigned)g.gather[_r] * (unsigned)g.lda + (unsigned)CA[_i]) * 2u; } } while (0)
    Unit cur, nxt; int ui = 0;
    if (!S.next(0, cur)) return;
    f32x4 acc[2][2][4][2];
#pragma unroll
    for (int a = 0; a < 2; ++a)
#pragma unroll
        for (int b = 0; b < 2; ++b)
#pragma unroll
            for (int m = 0; m < 4; ++m)
#pragma unroll
                for (int n = 0; n < 2; ++n) acc[a][b][m][n] = (f32x4){0.f, 0.f, 0.f, 0.f};
    f16x8 At[4][2], B0[2][2], B1[2][2];
    unsigned offC[2][2], offN[2][2];
    if constexpr (GATHER) { PG8_OFFS(offC, cur); }
    const char* cA = Ab + (size_t)cur.pm * tstepA;
    const char* cB = (const char*)g.Bt + (size_t)cur.pn * tstepB;
    PG8_STAGE(PG8_SB(0, 0), cB, voffB); PG8_STAGE(PG8_SB(0, 1), cB + hstepB, voffB); PG8_STA_CUR(PG8_SA(0, 0), 0, 0); PG8_STA_CUR(PG8_SA(0, 1), 1, 0);
    if (wr == 1) PG8_BAR;
    PG8_WAIT_V(2); PG8_BAR;
    PG8_STAGE(PG8_SB(1, 0), cB + kstep, voffB); PG8_STA_CUR(PG8_SA(1, 0), 0, kstep); PG8_STAGE(PG8_SB(1, 1), cB + hstepB + kstep, voffB);
    PG8_WAIT_V(6); PG8_BAR;
    for (;;) {
        const bool has_next = S.next(ui + 1, nxt);
        if constexpr (GATHER) {
            if (has_next) { PG8_OFFS(offN, nxt); } else {
#pragma unroll
                for (int _h = 0; _h < 2; ++_h)
#pragma unroll
                    for (int _i = 0; _i < 2; ++_i) offN[_h][_i] = offC[_h][_i]; } }
        const char* nA = has_next ? Ab + (size_t)nxt.pm * tstepA : cA;
        const char* nB = has_next ? (const char*)g.Bt + (size_t)nxt.pn * tstepB : cB;
#pragma nounroll
        for (int t = 0; t < nt; t += 2) {
            const bool last = (t == nt - 2);
            const size_t kb1 = (size_t)(t + 1) * kstep;
            const size_t kb2 = last ? 0 : (size_t)(t + 2) * kstep, kb3 = kb2 + kstep;
            unsigned o2[2][2];
            if constexpr (GATHER) {
#pragma unroll
                for (int _h = 0; _h < 2; ++_h)
#pragma unroll
                    for (int _i = 0; _i < 2; ++_i) o2[_h][_i] = last ? offN[_h][_i] : offC[_h][_i]; }
            const char* a2p = last ? nA : cA;
            const char* b2 = last ? nB : cB + (size_t)(t + 2) * kstep; const char* b3 = b2 + kstep;
            PG8_LDB(B0, 0, 0); PG8_LDB(B1, 0, 1); PG8_SCHED; PG8_LDA(At, 0, 0); PG8_STA_CUR(PG8_SA(1, 1), 1, kb1);
            PG8_WAIT_V(8); PG8_WAIT_L(0); PG8_BAR; PG8_MMA(0, 0, At, B0); PG8_MMA(0, 1, At, B1); PG8_BAR; PG8_SCHED;
            PG8_LDA(At, 0, 1); PG8_STAGE(PG8_SB(0, 0), b2, voffB); PG8_STAGE(PG8_SB(0, 1), b2 + hstepB, voffB); PG8_STA_SEL(PG8_SA(0, 0), 0, kb2);
            PG8_WAIT_V(8); PG8_WAIT_L(0); PG8_BAR; PG8_MMA(1, 0, At, B0); PG8_MMA(1, 1, At, B1); PG8_BAR; PG8_SCHED;
            PG8_LDB(B0, 1, 0); PG8_LDB(B1, 1, 1); PG8_SCHED; PG8_LDA(At, 1, 0); PG8_STA_SEL(PG8_SA(0, 1), 1, kb2);
            PG8_WAIT_V(8); PG8_WAIT_L(0); PG8_BAR; PG8_MMA(0, 0, At, B0); PG8_MMA(0, 1, At, B1); PG8_BAR; PG8_SCHED;
            PG8_LDA(At, 1, 1); PG8_STAGE(PG8_SB(1, 0), b3, voffB); PG8_STAGE(PG8_SB(1, 1), b3 + hstepB, voffB); PG8_STA_SEL(PG8_SA(1, 0), 0, kb3);
            PG8_WAIT_V(8); PG8_WAIT_L(0); PG8_BAR; PG8_MMA(1, 0, At, B0); PG8_MMA(1, 1, At, B1); PG8_BAR; PG8_SCHED;
        }
        if constexpr (ALIGN_EPI) { if (wr == 0) PG8_BAR; }
        E(acc, cur, wr, wc, fr, fq);
        if (!has_next) break;
#pragma unroll
        for (int a = 0; a < 2; ++a)
#pragma unroll
            for (int b = 0; b < 2; ++b)
#pragma unroll
                for (int m = 0; m < 4; ++m)
#pragma unroll
                    for (int n = 0; n < 2; ++n) acc[a][b][m][n] = (f32x4){0.f, 0.f, 0.f, 0.f};
        cur = nxt; cA = nA; cB = nB; ++ui;
        if constexpr (GATHER) {
#pragma unroll
            for (int _h = 0; _h < 2; ++_h)
#pragma unroll
                for (int _i = 0; _i < 2; ++_i) offC[_h][_i] = offN[_h][_i]; }
        if constexpr (ALIGN_EPI) { if (wr == 1) PG8_BAR; }
    }
    PG8_WAIT_V(0);
    if constexpr (!ALIGN_EPI) { if (wr == 0) PG8_BAR; }
    PG8_BAR;
#undef PG8_SA
#undef PG8_SB
#undef PG8_STAGE
#undef PG8_STA_CUR
#undef PG8_STA_SEL
#undef PG8_LDA
#undef PG8_LDB
#undef PG8_MMA
#undef PG8_WAIT_V
#undef PG8_WAIT_L
#undef PG8_BAR
#undef PG8_SCHED
#undef PG8_OFFS
}
}

#define XB_TMO      128
#define XB_XCNT(j)  (256  + 64 * (j))
#define XB_XSUB(j)  (1280 + 64 * (j))
#define XB_XGEN(j)  (2304 + 64 * (j))
#define XB_TOP      3328
#define XB_TOPGEN   3392
#define XCD_BAR_WORDS 3456
#define XB_SPIN_CAP (1u << 22)
__device__ __forceinline__ unsigned xb_ld(unsigned* p)              { return __hip_atomic_load(p, __ATOMIC_RELAXED, __HIP_MEMORY_SCOPE_AGENT); }
__device__ __forceinline__ unsigned xb_add(unsigned* p, unsigned v) { return __hip_atomic_fetch_add(p, v, __ATOMIC_RELAXED, __HIP_MEMORY_SCOPE_AGENT); }
__device__ __forceinline__ unsigned xb_xcc_id() { return (unsigned)__builtin_amdgcn_s_getreg((3 << 11) | 20) & 0xFu; }
#define XB_SPIN(cond, bar) do { unsigned _sp = 0; while (cond) { __builtin_amdgcn_s_sleep(1); \
    if ((++_sp & 255u) == 0u) { if (xb_ld(&(bar)[XB_TMO])) break; if (_sp > XB_SPIN_CAP) { atomicAdd(&(bar)[XB_TMO], 1u); break; } } } } while (0)
struct XcdBarrier { unsigned* bar; unsigned x; volatile LAS unsigned* st; };
__device__ __forceinline__ XcdBarrier xcd_barrier_post(unsigned* bar, volatile LAS unsigned* st) {
    XcdBarrier b; b.bar = bar; b.x = xb_xcc_id(); b.st = st;
    if (threadIdx.x == 0) (void)xb_add(&bar[XB_XCNT(b.x)], 1u);
    return b;
}
__device__ __forceinline__ void xcd_barrier_complete(unsigned* bar, unsigned x, unsigned& nloc, unsigned& nx) {
    const unsigned G = gridDim.x * gridDim.y * gridDim.z;
    unsigned sum, cnt, mine, sp = 0u;
    for (;;) {
        sum = 0u; cnt = 0u; mine = 0u;
#pragma unroll
        for (unsigned j = 0; j < 16; ++j) { const unsigned c = xb_ld(&bar[XB_XCNT(j)]); sum += c; cnt += (c > 0u) ? 1u : 0u; mine = (j == x) ? c : mine; }
        if (sum == G) break;
        __builtin_amdgcn_s_sleep(1);
        if ((++sp & 255u) == 0u) { if (xb_ld(&bar[XB_TMO])) break; if (sp > XB_SPIN_CAP) { atomicAdd(&bar[XB_TMO], 1u); break; } }
    }
    nloc = mine > 0u ? mine : 1u; nx = cnt > 0u ? cnt : 1u;
}
__device__ __forceinline__ void xcd_barrier(const XcdBarrier& b) {
    asm volatile("s_waitcnt vmcnt(0)" ::: "memory");
    __syncthreads();
    if (threadIdx.x == 0) {
        unsigned* bar = b.bar;
        __builtin_amdgcn_s_waitcnt(0);
        unsigned nloc = b.st[0], nx = b.st[1];
        if (nloc == 0u) { xcd_barrier_complete(bar, b.x, nloc, nx); b.st[0] = nloc; b.st[1] = nx; }
        const unsigned old = xb_add(&bar[XB_XSUB(b.x)], 1u);
        const unsigned gen = old / nloc;
        if (old + 1u == (gen + 1u) * nloc) {
            __builtin_amdgcn_fence(__ATOMIC_RELEASE, "agent");
            asm volatile("s_waitcnt vmcnt(0)" ::: "memory");
            const unsigned og = xb_add(&bar[XB_TOP], 1u);
            const unsigned tg = og / nx;
            if (og + 1u == (tg + 1u) * nx) xb_add(&bar[XB_TOPGEN], 1u);
            else XB_SPIN(xb_ld(&bar[XB_TOPGEN]) == tg, bar);
            __builtin_amdgcn_fence(__ATOMIC_ACQUIRE, "agent");
            xb_add(&bar[XB_XGEN(b.x)], 1u);
            asm volatile("s_waitcnt vmcnt(0)" ::: "memory");
        } else {
            XB_SPIN(xb_ld(&bar[XB_XGEN(b.x)]) == gen, bar);
            __builtin_amdgcn_fence(__ATOMIC_ACQUIRE, "agent");
            asm volatile("s_waitcnt vmcnt(0)" ::: "memory");
        }
    }
    __syncthreads();
}

struct Args { const float* in[38]; float* out; unsigned char* ws; int ph_lo, ph_hi; };
enum { I_X = 0, I_MEM, I_LN1, I_WIN, I_PK, I_W1K, I_W2K, I_PV, I_W1V, I_W2V, I_NSAG, I_MU, I_W0, I_WUP, I_A0, I_AUP, I_GUP, I_KK, I_KA, I_RK, I_LNXG, I_LNXB,
       I_WOUT, I_LNMEM, I_LN2, I_WQ, I_WK, I_WV, I_WO, I_LN3, I_RGW, I_RGB, I_REW, I_REB, I_MG, I_MU2, I_MD, I_LNF };

__device__ __forceinline__ void tr_item(const float* src, int sld, int k0, int scol0, int nvalid, f16* dst, size_t drow0, int dld, LAS float* scr, int lane) {
    const int nl = lane & 31;
    float tv[32];
#pragma unroll
    for (int i = 0; i < 32; ++i) { const int kk = 2 * i + (lane >> 5); tv[i] = (nl < nvalid) ? src[(size_t)(k0 + kk) * sld + scol0 + nl] : 0.f; }
#pragma unroll
    for (int i = 0; i < 32; ++i) { const int kk = 2 * i + (lane >> 5); scr[kk * 33 + nl] = tv[i]; }
    LDS_WAIT(); asm volatile("" ::: "memory");
    const int c = lane & 7;
#pragma unroll
    for (int j = 0; j < 4; ++j) { const int n = (lane >> 3) + 8 * j; const LAS float* s = scr + (8 * c) * 33 + n;
        u32x4 o; o.x = pkh(s[0 * 33], s[1 * 33]); o.y = pkh(s[2 * 33], s[3 * 33]); o.z = pkh(s[4 * 33], s[5 * 33]); o.w = pkh(s[6 * 33], s[7 * 33]);
        *(u32x4*)(dst + (drow0 + n) * (size_t)dld + k0 + 8 * c) = o; }
    LDS_WAIT(); asm volatile("" ::: "memory");
}
__device__ __forceinline__ void tr_matrix(const float* src, int K, int N, f16* dst, LAS float* scr, int gw, int NGW, int lane) {
    const int nblk = N / 32, items = (K / 64) * nblk;
    for (int it = gw; it < items; it += NGW) { const int kb = it / nblk, nb = it % nblk; tr_item(src, N, kb * 64, nb * 32, 32, dst, (size_t)nb * 32, K, scr, lane); }
}
__device__ __forceinline__ void rms_row(const float* xrow, const float* gain, f16* o16, int lane) {
    const f32x4* xr = (const f32x4*)xrow + lane; f32x4 v[8]; float s = 0.f;
#pragma unroll
    for (int j = 0; j < 8; ++j) { v[j] = xr[64 * j]; s += v[j].x * v[j].x + v[j].y * v[j].y + v[j].z * v[j].z + v[j].w * v[j].w; }
    const float rstd = rsqrtf(wave_sum(s) * (1.f / D) + EPS);
    const f32x4* gr = (const f32x4*)gain + lane;
    u32x2* o8 = (u32x2*)o16 + lane;
#pragma unroll
    for (int j = 0; j < 8; ++j) { const f32x4 gg = gr[64 * j]; u32x2 w; w.x = pkh(v[j].x * rstd * gg.x, v[j].y * rstd * gg.y); w.y = pkh(v[j].z * rstd * gg.z, v[j].w * rstd * gg.w); o8[64 * j] = w; }
}

__device__ __forceinline__ void p0_prologue(const Args& a, LAS unsigned char* lds) {
    const int tid = opaque_tid(), lane = tid & 63, wave = tid >> 6;
    const int gw = blockIdx.x * 8 + wave, NGW = gridDim.x * 8;
    LAS float* scr = (LAS float*)(lds + wave * 16384);
    unsigned char* ws = a.ws;
    { f16* dst = (f16*)(ws + WS_WIN); const float* src = a.in[I_WIN];
      const int nblk = NZ / 32, items = (D / 64) * nblk;
      for (int it = gw; it < items; it += NGW) { const int kb = it / nblk, nb = it % nblk, n0 = nb * 32;
          int sc = 0, nv = 32; if (n0 < 2560) sc = n0; else if (n0 < 5920) sc = n0 + 24; else if (n0 == 5920) { sc = 2560; nv = 24; } else { sc = 0; nv = 0; }
          tr_item(src, 5944, kb * 64, sc, nv, dst, (size_t)n0, D, scr, lane); } }
    tr_matrix(a.in[I_WOUT], D, D, (f16*)(ws + WS_WOUT), scr, gw, NGW, lane);
    tr_matrix(a.in[I_WK], D, D, (f16*)(ws + WS_WKT), scr, gw, NGW, lane);
    tr_matrix(a.in[I_WV], D, D, (f16*)(ws + WS_WVT), scr, gw, NGW, lane);
    tr_matrix(a.in[I_WO], D, D, (f16*)(ws + WS_WOT), scr, gw, NGW, lane);
    { const f32x4* s = (const f32x4*)a.in[I_WQ]; u32x2* d = (u32x2*)(ws + WS_WQ16);
      for (size_t i = (size_t)blockIdx.x * 512 + tid; i < (size_t)D * D / 4; i += (size_t)gridDim.x * 512) { const f32x4 v = s[i]; u32x2 w; w.x = pkh(v.x, v.y); w.y = pkh(v.z, v.w); d[i] = w; } }
    tr_matrix(a.in[I_W1K], 4096, 128, (f16*)(ws + WS_W1T), scr, gw, NGW, lane);
    tr_matrix(a.in[I_W1V], 4096, 128, (f16*)(ws + WS_W1T) + 128 * 4096, scr, gw, NGW, lane);
    tr_matrix(a.in[I_W2K], 128, 128, (f16*)(ws + WS_W2T), scr, gw, NGW, lane);
    tr_matrix(a.in[I_W2V], 128, 128, (f16*)(ws + WS_W2T) + 128 * 128, scr, gw, NGW, lane);
    for (int o = gw; o < 256; o += NGW) { const int kv = o >> 7, n = o & 127; const float* pos = a.in[kv ? I_PV : I_PK]; const float* w1 = a.in[kv ? I_W1V : I_W1K]; float acc = 0.f;
        for (int k = lane; k < 4096; k += 64) acc += pos[k] * w1[(size_t)k * 128 + n];
        acc = wave_sum(acc); if (lane == 0) ((float*)(ws + WS_CBIAS))[o] = acc; }
    for (int i = blockIdx.x * 512 + tid; i < 48 * D; i += gridDim.x * 512) { const int c = i / D, k = i % D; float v = 0.f;
        if (c < 4) v = a.in[I_RGW][k * 4 + c]; else if (c < 36) v = a.in[I_REW][k * 32 + (c - 4)];
        v *= a.in[I_LN3][k]; const f16 hi = (f16)v; ((f16*)(ws + WS_WRH))[i] = hi; ((f16*)(ws + WS_WRL))[i] = (f16)(v - (float)hi); }
    { bf16* wu = (bf16*)(ws + WS_WUPT); bf16* au = (bf16*)(ws + WS_AUPT); bf16* gu = (bf16*)(ws + WS_GUPT);
      for (int i = blockIdx.x * 512 + tid; i < 1024 * 64; i += gridDim.x * 512) { const int ch = i >> 6, j = i & 63; wu[i] = (bf16)a.in[I_WUP][j * 1024 + ch]; au[i] = (bf16)a.in[I_AUP][j * 1024 + ch]; }
      for (int i = blockIdx.x * 512 + tid; i < 1024 * 160; i += gridDim.x * 512) { const int ch = i / 160, j = i % 160; gu[i] = (bf16)a.in[I_GUP][j * 1024 + ch]; } }
    for (int m = gw; m < T; m += NGW) rms_row(a.in[I_X] + (size_t)m * D, a.in[I_LN1], (f16*)(ws + WS_H) + (size_t)m * D, lane);
    for (int m = gw; m < 256; m += NGW) rms_row(a.in[I_MEM] + (size_t)m * D, a.in[I_LNMEM], (f16*)(ws + WS_MEMN) + (size_t)m * D, lane);
}

__device__ __forceinline__ void p_moe_weights(const Args& a, LAS unsigned char* lds) {
    const int tid = opaque_tid(), lane = tid & 63, wave = tid >> 6;
    const int gw = blockIdx.x * 8 + wave, NGW = gridDim.x * 8;
    LAS float* scr = (LAS float*)(lds + wave * 16384);
    unsigned char* ws = a.ws;
    { f16* dst = (f16*)(ws + WS_WGU); const int items = NEXP * (D / 64) * 16;
      for (int it = gw; it < items; it += NGW) { const int e = it / ((D / 64) * 16), r = it % ((D / 64) * 16), kb = r / 16, nb = r % 16, j0 = nb * 32, jt = j0 / 256, jj = j0 % 256;
          const float* src = (jj < 128 ? a.in[I_MG] : a.in[I_MU2]) + (size_t)e * D * EFF; const int sc = jt * 128 + (jj & 127);
          tr_item(src, EFF, kb * 64, sc, 32, dst, (size_t)e * 512 + j0, D, scr, lane); } }
    { f16* dst = (f16*)(ws + WS_WD); const int items = NEXP * (EFF / 64) * (D / 32);
      for (int it = gw; it < items; it += NGW) { const int e = it / ((EFF / 64) * (D / 32)), r = it % ((EFF / 64) * (D / 32)), kb = r / (D / 32), nb = r % (D / 32);
          tr_item(a.in[I_MD] + (size_t)e * EFF * D, D, kb * 64, nb * 32, 32, dst, (size_t)e * D + nb * 32, EFF, scr, lane); } }
}

__device__ __forceinline__ float gelu_tanh(float x) { const float u = 0.7978845608028654f * (x + 0.044715f * x * x * x); const float e = __expf(2.f * u); return 0.5f * x * (2.f - 2.f / (e + 1.f)); }
constexpr int CP_RS = 272, CP_HS = 136, CP_HID = 272 * CP_RS;
__device__ __forceinline__ void p_compress(const Args& a, LAS unsigned char* lds) {
    const int tid = opaque_tid(), lane = tid & 63, w = __builtin_amdgcn_readfirstlane(tid >> 6);
    const f16* z = (const f16*)(a.ws + WS_Z);
    LAS f16* HID = (LAS f16*)(lds + CP_HID);
    for (int it = blockIdx.x; it < 256; it += gridDim.x) {
        const int kv = it >> 7, g = (it >> 6) & 1, c0 = (it & 63) * 16, tok0 = 16 * c0;
        const int zc = (kv ? ZVC : ZKC) + g * 128;
        __syncthreads();
        for (int ck = tid; ck < 272 * 16; ck += 512) { const int tl = ck >> 4, c16 = ck & 15, tok = tok0 + tl; const int rp = (tl & 15) * 17 + (tl >> 4);
            u32x4 v = {0u, 0u, 0u, 0u}; if (tok < T) v = *(const u32x4*)(z + (size_t)tok * NZ + zc + c16 * 8);
            *(LAS u32x4*)(lds + rp * CP_RS + c16 * 16) = v; }
        __syncthreads();
        f32x4 acc = {0.f, 0.f, 0.f, 0.f};
        const f16* wp = (const f16*)(a.ws + WS_W1T) + ((size_t)kv * 128 + 16 * w + (lane & 15)) * 4096 + 8 * (lane >> 4);
        const LAS unsigned char* ap = lds + (lane & 15) * CP_RS + 16 * (lane >> 4);
#pragma unroll 8
        for (int ks = 0; ks < 128; ++ks) { const int l = ks >> 2;
            const f16x8 av = *(const LAS f16x8*)(ap + ((l & 15) * 17 + (l >> 4)) * CP_RS + (ks & 3) * 64);
            const f16x8 bv = *(const f16x8*)(wp + 32 * ks);
            acc = __builtin_amdgcn_mfma_f32_16x16x32_f16(av, bv, acc, 0, 0, 0); }
        { const int n = 16 * w + (lane & 15); const float bs = ((const float*)(a.ws + WS_CBIAS))[kv * 128 + n];
#pragma unroll
          for (int r = 0; r < 4; ++r) HID[(4 * (lane >> 4) + r) * CP_HS + n] = (f16)gelu_tanh(acc[r] + bs); }
        __syncthreads();
        f32x4 o = {0.f, 0.f, 0.f, 0.f};
        const f16* w2p = (const f16*)(a.ws + WS_W2T) + ((size_t)kv * 128 + 16 * w + (lane & 15)) * 128 + 8 * (lane >> 4);
#pragma unroll
        for (int ks = 0; ks < 4; ++ks) { const f16x8 av = *(const LAS f16x8*)(HID + (lane & 15) * CP_HS + 32 * ks + 8 * (lane >> 4)); const f16x8 bv = *(const f16x8*)(w2p + 32 * ks);
            o = __builtin_amdgcn_mfma_f32_16x16x32_f16(av, bv, o, 0, 0, 0); }
        f16* dst = (f16*)(a.ws + (kv ? WS_VCMP : WS_KCMP));
#pragma unroll
        for (int r = 0; r < 4; ++r) { const int c = c0 + 4 * (lane >> 4) + r; dst[((size_t)c * 2 + g) * 128 + 16 * w + (lane & 15)] = c < NCMP ? (f16)o[r] : (f16)0.f; }
    }
}

typedef float f32x16 __attribute__((ext_vector_type(16)));
typedef short v4i16_t __attribute__((ext_vector_type(4)));
constexpr int NS_PSEL = 65536, NS_PSTR = 257, NS_SELB = NS_PSEL + 64 * NS_PSTR * 4, NS_WANY = NS_SELB + 2048, NS_LIST = NS_WANY + 256, NS_CNT = NS_LIST + 512, NS_UNIT = NS_CNT + 64;
static_assert(NS_UNIT + 64 <= MISC_OFF, "nsa lds");
__device__ __forceinline__ unsigned offb(unsigned row, unsigned ch) { return 256u * row + 16u * (ch ^ (((row & 3u) << 2) | ((row >> 2) & 3u))); }
__device__ __forceinline__ void glds16(const void* gsrc, unsigned lds_dst) { unsigned keep;
    asm volatile("s_mov_b32 %0, m0\n\ts_mov_b32 m0, %2\n\ts_nop 0\n\tglobal_load_lds_dwordx4 %1, off\n\ts_mov_b32 m0, %0" : "=&s"(keep) : "v"(gsrc), "s"(lds_dst) : "memory"); }
__device__ __forceinline__ void ns_dma(const f16* g0, size_t gstride, unsigned lds_addr, int wv, int lane) {
#pragma unroll
    for (int i = 0; i < 2; ++i) { const int piece = wv * 2 + i, row = 4 * piece + (lane >> 4), slot = lane & 15, ch = slot ^ (((row & 3) << 2) | ((row >> 2) & 3));
        glds16(g0 + (size_t)row * gstride + ch * 8, lds_addr + piece * 1024); }
}
#define NS_VMW(n) asm volatile("s_waitcnt vmcnt(" #n ")" ::: "memory")
__device__ __forceinline__ void ns_qk(f32x16& s0, f32x16& s1, const LAS unsigned char* kb, const f16x8 (&qf)[8], int rho_, int hh_, float init) {
    unsigned rho = (unsigned)rho_, hh = (unsigned)hh_;
    asm volatile("" : "+v"(rho), "+v"(hh));
    const unsigned xr = ((rho & 3u) << 2) | ((rho >> 2) & 3u);
    const LAS unsigned char* kbase = kb + 256u * rho + 16u * ((hh ^ xr) & 1u); const unsigned xs = xr >> 1;
#pragma unroll
    for (int i = 0; i < 16; ++i) { s0[i] = init; s1[i] = init; }
    f16x8 af[8];
#pragma unroll
    for (int s = 0; s < 8; ++s) af[s] = *(const LAS f16x8*)(kbase + 32u * ((unsigned)s ^ xs));
#pragma unroll
    for (int s = 0; s < 8; ++s) s0 = __builtin_amdgcn_mfma_f32_32x32x16_f16(af[s], qf[s], s0, 0, 0, 0);
#pragma unroll
    for (int s = 0; s < 8; ++s) af[s] = *(const LAS f16x8*)(kbase + 32u * ((unsigned)s ^ xs) + 8192);
#pragma unroll
    for (int s = 0; s < 8; ++s) s1 = __builtin_amdgcn_mfma_f32_32x32x16_f16(af[s], qf[s], s1, 0, 0, 0);
}
__device__ __forceinline__ void ns_pv(f32x16 (&O)[4], const LAS unsigned char* vb, const f32x16& p0, const f32x16& p1, int lane_) {
    unsigned lane = (unsigned)lane_;
    asm volatile("" : "+v"(lane));
    const unsigned hh = lane >> 5, blk = (lane >> 4) & 1, q = (lane & 15) >> 2, pp = lane & 3;
    const unsigned x = 2 * blk + (pp >> 1);
    const LAS unsigned char* vbase[2];
#pragma unroll
    for (int t = 0; t < 2; ++t) { const unsigned w = (hh + 2 * t) & 3u; vbase[t] = vb + 256u * (4 * hh + 8 * t + q) + 16u * (x ^ w) + 8u * (pp & 1); }
    f16x8 pf[4];
#pragma unroll
    for (int kh = 0; kh < 2; ++kh)
#pragma unroll
        for (int sp = 0; sp < 2; ++sp)
#pragma unroll
            for (int j = 0; j < 8; ++j) pf[kh * 2 + sp][j] = (f16)(kh ? p1[8 * sp + j] : p0[8 * sp + j]);
#pragma unroll
    for (int c = 0; c < 4; ++c) { const unsigned cq = 64u * ((unsigned)c ^ q);
        const LAS unsigned char* b0 = vbase[0] + cq; const LAS unsigned char* b1 = vbase[1] + cq;
#pragma unroll
        for (int kh = 0; kh < 2; ++kh)
#pragma unroll
            for (int sp = 0; sp < 2; ++sp) {
                const v4i16_t lo = __builtin_amdgcn_ds_read_tr16_b64_v4i16((LAS v4i16_t*)(b0 + 256 * (32 * kh + 16 * sp)));
                const v4i16_t hi = __builtin_amdgcn_ds_read_tr16_b64_v4i16((LAS v4i16_t*)(b1 + 256 * (32 * kh + 16 * sp)));
                typedef short s16x8 __attribute__((ext_vector_type(8)));
                const s16x8 v8 = {lo[0], lo[1], lo[2], lo[3], hi[0], hi[1], hi[2], hi[3]};
                O[c] = __builtin_amdgcn_mfma_f32_32x32x16_f16(__builtin_bit_cast(f16x8, v8), pf[kh * 2 + sp], O[c], 0, 0, 0); }
    }
}
#define NS_KIDX(r, hh) ((int)(((r) & 3) + 8 * ((r) >> 2) + 4 * (hh)))
constexpr float NS_THR = 6.f;
template <bool WITH_O> __device__ __forceinline__ void ns_online(f32x16& y0, f32x16& y1, float& m, float& l, bool& seen, f32x16 (&O)[4]) {
    float mx = fmaxf(y0[0], y1[0]);
#pragma unroll
    for (int i = 1; i < 16; ++i) mx = fmaxf(mx, fmaxf(y0[i], y1[i]));
    mx = fmaxf(mx, __shfl_xor(mx, 32));
    const bool fin = mx > -INFINITY, first = !seen && fin;
    if (__any(first || mx > NS_THR)) {
        const float d = first ? mx : (mx > NS_THR ? mx : 0.f), alpha = __builtin_amdgcn_exp2f(-d);
        seen = seen || fin; m += d; l *= alpha;
        if (WITH_O) {
#pragma unroll
            for (int c = 0; c < 4; ++c) O[c] = O[c] * alpha; }
#pragma unroll
        for (int i = 0; i < 16; ++i) { y0[i] -= d; y1[i] -= d; }
    }
    float ls = 0.f;
#pragma unroll
    for (int i = 0; i < 16; ++i) { y0[i] = __builtin_amdgcn_exp2f(y0[i]); y1[i] = __builtin_amdgcn_exp2f(y1[i]); ls += y0[i] + y1[i]; }
    l += ls;
}
#define NS_ISSUE(j, NSL, HASV) do { const unsigned sa_ = lds_a + (unsigned)(((j) & ((NSL) - 1)) * 32768); ns_dma(NS_KPTR(j), NS_STRIDE, sa_, w, lane); if (HASV) ns_dma(NS_VPTR(j), NS_STRIDE, sa_ + 16384u, w, lane); } while (0)
#define NS_WAIT(nb, HASV) do { if (HASV) { if ((nb) >= 2) NS_VMW(8); else if ((nb) == 1) NS_VMW(4); else NS_VMW(0); } else { if ((nb) >= 2) NS_VMW(4); else if ((nb) == 1) NS_VMW(2); else NS_VMW(0); } } while (0)
#define NS_PROLOGUE(n, NSL, HASV) do { const int q_ = (n) < (NSL) - 1 ? (n) : (NSL) - 1; for (int j_ = 0; j_ < q_; ++j_) NS_ISSUE(j_, NSL, HASV); NS_WAIT(q_ - 1, HASV); __syncthreads(); } while (0)
#define NS_STEP_BEGIN(i, n, NSL, HASV) do { if ((i) + (NSL) - 1 < (n)) NS_ISSUE((i) + (NSL) - 1, NSL, HASV); } while (0)
#define NS_STEP_END(i, n, NSL, HASV) do { int nb_ = ((n) - 1 < (i) + (NSL) - 1 ? (n) - 1 : (i) + (NSL) - 1) - ((i) + 1); NS_WAIT(nb_, HASV); __syncthreads(); } while (0)
#define NS_KB(i, NSL) (lds + (((i) & ((NSL) - 1)) * 32768))
#define NS_VB(i, NSL) (lds + (((i) & ((NSL) - 1)) * 32768) + 16384)
__device__ __forceinline__ void p_nsa(const Args& a, LAS unsigned char* lds, int rep) {
    const int tid = opaque_tid(), lane = tid & 63, w = __builtin_amdgcn_readfirstlane(tid >> 6), rho = lane & 31, hh = lane >> 5, ql = rho >> 2, p = rho & 3;
    const unsigned lds_a = (unsigned)__builtin_amdgcn_readfirstlane((int)(unsigned)(size_t)lds);
    const f16* z = (const f16*)(a.ws + WS_Z); const f16* kcmp = (const f16*)(a.ws + WS_KCMP); const f16* vcmp = (const f16*)(a.ws + WS_VCMP);
    float* onsa = (float*)(a.ws + WS_ONSA); unsigned* ctl = (unsigned*)(a.ws + WS_CTL);
    LAS float* psel = (LAS float*)(lds + NS_PSEL); LAS unsigned* selb = (LAS unsigned*)(lds + NS_SELB); LAS unsigned* wany = (LAS unsigned*)(lds + NS_WANY);
    LAS unsigned char* list = lds + NS_LIST; LAS int* cnt = (LAS int*)(lds + NS_CNT); LAS int* unit_s = (LAS int*)(lds + NS_UNIT);
    const float c2 = 0.08838834764831845f * 1.4426950408889634f;
    for (;;) {
        __syncthreads();
        if (tid == 0) unit_s[0] = (int)atomicAdd(&ctl[CW_Q + rep], 1u);
        __syncthreads();
        const int u = unit_s[0]; if (u >= 512) break;
        const int blk = 255 - (u >> 1), g = u & 1, t0 = blk * 64, tq = t0 + 8 * w + ql, hq = g * 4 + p;
        f16x8 qf[8];
        { const f16* qrow = z + (size_t)tq * NZ + ZQ + hq * 128 + 8 * hh;
#pragma unroll
          for (int s = 0; s < 8; ++s) { const f16x8 q8 = *(const f16x8*)(qrow + 16 * s);
#pragma unroll
              for (int j = 0; j < 8; ++j) qf[s][j] = (f16)((float)q8[j] * c2); } }
        const f16* zrow = z + (size_t)tq * NZ;
        const float gate_c = sigmoidf_((float)zrow[ZGL + hq]), gate_s = sigmoidf_((float)zrow[ZGL + 8 + hq]), gate_w = sigmoidf_((float)zrow[ZGL + 16 + hq]);
        f32x16 O[4];
        float* orow = onsa + (size_t)tq * 1024 + hq * 128 + 4 * hh;
#pragma unroll
        for (int c = 0; c < 4; ++c)
#pragma unroll
            for (int i = 0; i < 16; ++i) O[c][i] = 0.f;
        const int cmax = tq >= 31 ? (tq - 31) >> 4 : -1;
        const int ntc = (4 * blk + 3 + 63) >> 6;
        float m = 0.f, l = 0.f; bool seen = false;
        const int cmin_w = (t0 + 8 * w) >= 31 ? (t0 + 8 * w - 31) >> 4 : -1;
#define NS_KPTR(j) (kcmp + ((size_t)(64 * (j)) * 2 + g) * 128)
#define NS_VPTR(j) (vcmp + ((size_t)(64 * (j)) * 2 + g) * 128)
#define NS_STRIDE 256
        NS_PROLOGUE(ntc, 4, false);
        for (int i = 0; i < ntc; ++i) {
            NS_STEP_BEGIN(i, ntc, 4, false);
            f32x16 x0, x1; ns_qk(x0, x1, NS_KB(i, 4), qf, rho, hh, -m);
            if (64 * i + 63 > cmin_w) {
#pragma unroll
                for (int r = 0; r < 16; ++r) { const int c0 = 64 * i + NS_KIDX(r, hh); x0[r] = (c0 <= cmax) ? x0[r] : -INFINITY; x1[r] = (c0 + 32 <= cmax) ? x1[r] : -INFINITY; } }
            ns_online<false>(x0, x1, m, l, seen, O);
            NS_STEP_END(i, ntc, 4, false);
        }
        l += __shfl_xor(l, 32);
        const float invl = 1.f / fmaxf(l, 1e-30f);
        for (int i = lane; i < 8 * NS_PSTR; i += 64) psel[(8 * w) * NS_PSTR + i] = 0.f;
        NS_PROLOGUE(ntc, 2, true);
        for (int i = 0; i < ntc; ++i) {
            NS_STEP_BEGIN(i, ntc, 2, true);
            f32x16 x0, x1; ns_qk(x0, x1, NS_KB(i, 2), qf, rho, hh, -m);
#pragma unroll
            for (int r = 0; r < 16; ++r) { x0[r] = __builtin_amdgcn_exp2f(x0[r]) * invl; x1[r] = __builtin_amdgcn_exp2f(x1[r]) * invl; }
            if (64 * i + 63 > cmin_w) {
#pragma unroll
                for (int r = 0; r < 16; ++r) { const int c0 = 64 * i + NS_KIDX(r, hh); x0[r] = (c0 <= cmax) ? x0[r] : 0.f; x1[r] = (c0 + 32 <= cmax) ? x1[r] : 0.f; } }
#pragma unroll
            for (int kh = 0; kh < 2; ++kh)
#pragma unroll
                for (int r4 = 0; r4 < 4; ++r4) {
                    const float pa = kh ? x1[4 * r4] : x0[4 * r4], pb = kh ? x1[4 * r4 + 1] : x0[4 * r4 + 1], pc_ = kh ? x1[4 * r4 + 2] : x0[4 * r4 + 2], pd = kh ? x1[4 * r4 + 3] : x0[4 * r4 + 3];
                    float mainv = pa + pb + pc_ + 0.5f * pd, carry = 0.5f * pd;
                    mainv += __shfl_xor(mainv, 1); mainv += __shfl_xor(mainv, 2); carry += __shfl_xor(carry, 1); carry += __shfl_xor(carry, 2);
                    if (p == 0) { const int sb = 16 * i + 8 * kh + 2 * r4 + hh; float* pr = (float*)(psel + (8 * w + ql) * NS_PSTR + sb); __hip_atomic_fetch_add(pr, mainv, __ATOMIC_RELAXED, __HIP_MEMORY_SCOPE_WORKGROUP); __hip_atomic_fetch_add(pr + 1, carry, __ATOMIC_RELAXED, __HIP_MEMORY_SCOPE_WORKGROUP); }
                }
            ns_pv(O, NS_VB(i, 2), x0, x1, lane);
            NS_STEP_END(i, ntc, 2, true);
        }
#undef NS_KPTR
#undef NS_VPTR
#undef NS_STRIDE
#pragma unroll
        for (int c = 0; c < 4; ++c) {
#pragma unroll
            for (int r4 = 0; r4 < 4; ++r4) *(f32x4*)(orow + 32 * c + 8 * r4) = (f32x4){O[c][4 * r4] * gate_c, O[c][4 * r4 + 1] * gate_c, O[c][4 * r4 + 2] * gate_c, O[c][4 * r4 + 3] * gate_c};
#pragma unroll
            for (int i = 0; i < 16; ++i) O[c][i] = 0.f; }
        {
            unsigned anyw = 0u;
            for (int qq = 0; qq < 8; ++qq) {
                const LAS float* pr = psel + (8 * w + qq) * NS_PSTR;
                unsigned myw = 0u;
                if (lane == 0) myw |= 1u;
                if (lane == (blk >> 5)) myw |= 1u << (blk & 31);
                if (blk >= 1 && lane == ((blk - 1) >> 5)) myw |= 1u << ((blk - 1) & 31);
                const int ncand = blk >= 3 ? blk - 2 : 0;
                if (ncand <= 13) { if (ncand > 0 && lane == 0) myw |= ((2u << (blk - 2)) - 1u) & ~1u; }
                else {
                    unsigned key[4];
#pragma unroll
                    for (int jj = 0; jj < 4; ++jj) { const int s = 1 + lane + 64 * jj; key[jj] = (s <= blk - 2) ? __float_as_uint(fmaxf(pr[s], 0.f)) + 1u : 0u; }
                    unsigned thr = 0u;
                    for (int bit = 31; bit >= 0; --bit) { const unsigned cand = thr | (1u << bit); int cn = 0;
#pragma unroll
                        for (int jj = 0; jj < 4; ++jj) cn += __popcll(__ballot(key[jj] >= cand));
                        if (cn >= 13) thr = cand; }
                    int cgt = 0;
#pragma unroll
                    for (int jj = 0; jj < 4; ++jj) cgt += __popcll(__ballot(key[jj] > thr));
                    int remaining = 13 - cgt;
                    unsigned long long M[4];
#pragma unroll
                    for (int jj = 0; jj < 4; ++jj) { const bool eq = key[jj] == thr; const unsigned long long em = __ballot(eq); const int c = __popcll(em);
                        const bool take_eq = eq && (__popcll(em & ((1ull << lane) - 1ull)) < remaining);
                        remaining = remaining > c ? remaining - c : 0;
                        M[jj] = __ballot(key[jj] > thr || take_eq); }
#pragma unroll
                    for (int j = 0; j < 8; ++j) { const int k = j >> 1; const unsigned long long sh = (M[k] << 1) | (k > 0 ? (M[k - 1] >> 63) : 0ull);
                        const unsigned wj = (unsigned)(sh >> (32 * (j & 1))); if (lane == j) myw |= wj; }
                }
                if (lane < 8) selb[(8 * w + qq) * 8 + lane] = myw;
                anyw |= myw;
            }
            if (lane < 8) wany[w * 8 + lane] = anyw;
        }
        __syncthreads();
        {
            int need = 0;
            if (w < 4) { const int sblk = 64 * w + lane; unsigned un = 0u;
#pragma unroll
                for (int ww = 0; ww < 8; ++ww) un |= wany[ww * 8 + (sblk >> 5)];
                need = (un >> (sblk & 31)) & 1; }
            const unsigned long long bal = __ballot(need);
            if (w < 4 && lane == 0) cnt[w] = __popcll(bal);
            __syncthreads();
            if (w < 4) { int base = 0;
                for (int ww = 0; ww < w; ++ww) base += cnt[ww];
                if (need) list[base + __popcll(bal & ((1ull << lane) - 1ull))] = (unsigned char)(64 * w + lane); }
            __syncthreads();
        }
        const int nlist = cnt[0] + cnt[1] + cnt[2] + cnt[3];
        for (int rp_ = 0; rp_ < NSA_SELREP; ++rp_) {
        if (rp_) { asm volatile("" :: "v"(O[0][0]), "v"(O[1][0]), "v"(O[2][0]), "v"(O[3][0]), "v"(l));
#pragma unroll
            for (int c = 0; c < 4; ++c)
#pragma unroll
                for (int i = 0; i < 16; ++i) O[c][i] = 0.f; }
        m = 0.f; l = 0.f; seen = false;
#define NS_KPTR(j) (z + (size_t)((int)list[j] * 64) * NZ + ZKS + g * 128)
#define NS_VPTR(j) (z + (size_t)((int)list[j] * 64) * NZ + ZVS + g * 128)
#define NS_STRIDE NZ
        NS_PROLOGUE(nlist, 4, true);
        for (int i = 0; i < nlist; ++i) {
            NS_STEP_BEGIN(i, nlist, 4, true);
            const int sb = list[i];
            const unsigned wneed = (wany[w * 8 + (sb >> 5)] >> (sb & 31)) & 1u;
            if (wneed) {
                const bool rsel = (selb[(8 * w + ql) * 8 + (sb >> 5)] >> (sb & 31)) & 1u;
                f32x16 x0, x1; ns_qk(x0, x1, NS_KB(i, 4), qf, rho, hh, rsel ? -m : -INFINITY);
                if (sb == blk) { const int kp0 = sb * 64;
#pragma unroll
                    for (int r = 0; r < 16; ++r) { const int kp = kp0 + NS_KIDX(r, hh); x0[r] = (kp <= tq) ? x0[r] : -INFINITY; x1[r] = (kp + 32 <= tq) ? x1[r] : -INFINITY; } }
                ns_online<true>(x0, x1, m, l, seen, O);
                ns_pv(O, NS_VB(i, 4), x0, x1, lane);
            }
            NS_STEP_END(i, nlist, 4, true);
        }
        }
#undef NS_KPTR
#undef NS_VPTR
        l += __shfl_xor(l, 32);
        { const float sc = gate_s / fmaxf(l, 1e-30f);
#pragma unroll
          for (int c = 0; c < 4; ++c) {
#pragma unroll
              for (int r4 = 0; r4 < 4; ++r4) { f32x4* op = (f32x4*)(orow + 32 * c + 8 * r4); const f32x4 e = *op; *op = (f32x4){e.x + O[c][4 * r4] * sc, e.y + O[c][4 * r4 + 1] * sc, e.z + O[c][4 * r4 + 2] * sc, e.w + O[c][4 * r4 + 3] * sc}; }
#pragma unroll
              for (int i = 0; i < 16; ++i) O[c][i] = 0.f; } }
        const int wb0 = blk >= 8 ? blk - 8 : 0, nwt = blk - wb0 + 1;
        for (int rp_ = 0; rp_ < NSA_WINREP; ++rp_) {
        if (rp_) { asm volatile("" :: "v"(O[0][0]), "v"(O[1][0]), "v"(O[2][0]), "v"(O[3][0]), "v"(l));
#pragma unroll
            for (int c = 0; c < 4; ++c)
#pragma unroll
                for (int i = 0; i < 16; ++i) O[c][i] = 0.f; }
        m = 0.f; l = 0.f; seen = false;
#define NS_KPTR(j) (z + (size_t)((wb0 + (j)) * 64) * NZ + ZKW + g * 128)
#define NS_VPTR(j) (z + (size_t)((wb0 + (j)) * 64) * NZ + ZVW + g * 128)
        NS_PROLOGUE(nwt, 4, true);
        for (int i = 0; i < nwt; ++i) {
            NS_STEP_BEGIN(i, nwt, 4, true);
            const int kb = wb0 + i;
            f32x16 x0, x1; ns_qk(x0, x1, NS_KB(i, 4), qf, rho, hh, -m);
            if (i == 0 || i == nwt - 1) { const int kp0 = kb * 64;
#pragma unroll
                for (int r = 0; r < 16; ++r) { const int kp = kp0 + NS_KIDX(r, hh);
                    x0[r] = (kp <= tq && kp + 511 >= tq) ? x0[r] : -INFINITY; x1[r] = (kp + 32 <= tq && kp + 32 + 511 >= tq) ? x1[r] : -INFINITY; } }
            ns_online<true>(x0, x1, m, l, seen, O);
            ns_pv(O, NS_VB(i, 4), x0, x1, lane);
            NS_STEP_END(i, nwt, 4, true);
        }
        }
#undef NS_KPTR
#undef NS_VPTR
#undef NS_STRIDE
        l += __shfl_xor(l, 32);
        { const float sc = gate_w / fmaxf(l, 1e-30f);
#pragma unroll
          for (int c = 0; c < 4; ++c)
#pragma unroll
              for (int r4 = 0; r4 < 4; ++r4) { f32x4* op = (f32x4*)(orow + 32 * c + 8 * r4); const f32x4 e = *op; *op = (f32x4){e.x + O[c][4 * r4] * sc, e.y + O[c][4 * r4 + 1] * sc, e.z + O[c][4 * r4 + 2] * sc, e.w + O[c][4 * r4 + 3] * sc}; } }
    }
}

constexpr int RS = 72, SLOT = 64 * RS * 2, RW_FS = 68, RW_GCL = 14 * SLOT;
#define RW_SLOT(lds, i) ((LAS bf16*)((lds) + (i) * SLOT))
template <int KS> __device__ __forceinline__ void mm_acc(f32x4 (&acc)[2], const LAS bf16* X, int xs, const LAS bf16* Y, int ys, int w, int lane) {
    const LAS bf16* xp = X + (16 * (w >> 1) + (lane & 15)) * xs + 8 * (lane >> 4);
    const LAS bf16* yp = Y + (32 * (w & 1) + (lane & 15)) * ys + 8 * (lane >> 4);
#pragma unroll
    for (int ks = 0; ks < KS; ++ks) { const bf16x8 av = *(const LAS bf16x8*)(xp + 32 * ks), b0 = *(const LAS bf16x8*)(yp + 32 * ks), b1 = *(const LAS bf16x8*)(yp + 16 * ys + 32 * ks);
        acc[0] = __builtin_amdgcn_mfma_f32_16x16x32_bf16(av, b0, acc[0], 0, 0, 0); acc[1] = __builtin_amdgcn_mfma_f32_16x16x32_bf16(av, b1, acc[1], 0, 0, 0); }
}
__device__ __forceinline__ void acc_zero(f32x4 (&acc)[2]) { acc[0] = (f32x4){0.f, 0.f, 0.f, 0.f}; acc[1] = (f32x4){0.f, 0.f, 0.f, 0.f}; }
__device__ __forceinline__ void st_n(const f32x4 (&acc)[2], LAS bf16* dst, int m0, int n0) {
#pragma unroll
    for (int tn = 0; tn < 2; ++tn)
#pragma unroll
        for (int r = 0; r < 4; ++r) dst[(m0 + r) * RS + n0 + 16 * tn] = (bf16)acc[tn][r];
}
__device__ __forceinline__ void st_t(const f32x4 (&acc)[2], LAS bf16* dst, int m0, int n0) {
#pragma unroll
    for (int tn = 0; tn < 2; ++tn) { const bf16x4 v = {(bf16)acc[tn][0], (bf16)acc[tn][1], (bf16)acc[tn][2], (bf16)acc[tn][3]}; *(LAS bf16x4*)(dst + (n0 + 16 * tn) * RS + m0) = v; }
}
__device__ __forceinline__ void ld_n(f32x4 (&acc)[2], const LAS bf16* src, int m0, int n0) {
#pragma unroll
    for (int tn = 0; tn < 2; ++tn)
#pragma unroll
        for (int r = 0; r < 4; ++r) acc[tn][r] = (float)src[(m0 + r) * RS + n0 + 16 * tn];
}
template <bool INCL> __device__ __forceinline__ void tri_mask(f32x4 (&acc)[2], int m0, int n0) {
#pragma unroll
    for (int tn = 0; tn < 2; ++tn)
#pragma unroll
        for (int r = 0; r < 4; ++r) { const int m = m0 + r, n = n0 + 16 * tn; if (INCL ? (n > m) : (n >= m)) acc[tn][r] = 0.f; }
}
__device__ __forceinline__ void st_acc_g(const f32x4 (&acc)[2], f16* base, int u, int w, int lane) {
#pragma unroll
    for (int tn = 0; tn < 2; ++tn) { const f16x4 v = {(f16)acc[tn][0], (f16)acc[tn][1], (f16)acc[tn][2], (f16)acc[tn][3]}; ((f16x4*)base)[((size_t)u * 16 + w * 2 + tn) * 64 + lane] = v; }
}
__device__ __forceinline__ float fast_tanh(float x) { const float e = __expf(2.f * x); return 1.f - 2.f / (e + 1.f); }

__device__ __forceinline__ void p_rwkv_local(const Args& a, LAS unsigned char* lds) {
    const int tid = opaque_tid(), lane = tid & 63, w = __builtin_amdgcn_readfirstlane(tid >> 6);
    const int m0 = 16 * (w >> 1) + 4 * (lane >> 4), n0 = 32 * (w & 1) + (lane & 15);
    const int et = tid >> 3, cg = tid & 7;
    const f16* z = (const f16*)(a.ws + WS_Z);
    unsigned char* ro = (unsigned char*)a.out;
    LAS float* FW = (LAS float*)(lds + 8 * SLOT); LAS float* FA = FW + 64 * RW_FS; LAS float* TOT = FA + 64 * RW_FS; LAS float* GCL = (LAS float*)(lds + RW_GCL);
    const float* mu = a.in[I_MU];
    for (int u = blockIdx.x; u < 4096; u += gridDim.x) {
        const int c = u >> 4, h = u & 15, t0 = c * 64, ch0 = h * 64 + 8 * cg, uo = h * 256 + c;
        float r_[8], k_[8], v_[8];
        { const int t = t0 + et; const f16* cur = z + (size_t)t * NZ; const f16* prv = cur - NZ; const bool hp = t > 0;
          f16x8 c8, p8; const f16x8 zero8 = {0, 0, 0, 0, 0, 0, 0, 0};
          c8 = *(const f16x8*)(cur + ZR + ch0); p8 = hp ? *(const f16x8*)(prv + ZR + ch0) : zero8;
#pragma unroll
          for (int e = 0; e < 8; ++e) r_[e] = (float)c8[e] + ((float)p8[e] - (float)c8[e]) * mu[ch0 + e];
          c8 = *(const f16x8*)(cur + ZK + ch0); p8 = hp ? *(const f16x8*)(prv + ZK + ch0) : zero8;
#pragma unroll
          for (int e = 0; e < 8; ++e) k_[e] = (float)c8[e] + ((float)p8[e] - (float)c8[e]) * mu[1024 + ch0 + e];
          c8 = *(const f16x8*)(cur + ZV + ch0); p8 = hp ? *(const f16x8*)(prv + ZV + ch0) : zero8;
#pragma unroll
          for (int e = 0; e < 8; ++e) v_[e] = (float)c8[e] + ((float)p8[e] - (float)c8[e]) * mu[2048 + ch0 + e];
          bf16x8 x1, x2;
          c8 = *(const f16x8*)(cur + ZWD + 8 * cg); p8 = hp ? *(const f16x8*)(prv + ZWD + 8 * cg) : zero8;
#pragma unroll
          for (int e = 0; e < 8; ++e) x1[e] = (bf16)fast_tanh((float)c8[e] + ((float)p8[e] - (float)c8[e]) * mu[3072 + 8 * cg + e]);
          c8 = *(const f16x8*)(cur + ZAD + 8 * cg); p8 = hp ? *(const f16x8*)(prv + ZAD + 8 * cg) : zero8;
#pragma unroll
          for (int e = 0; e < 8; ++e) x2[e] = (bf16)((float)c8[e] + ((float)p8[e] - (float)c8[e]) * mu[3136 + 8 * cg + e]);
          *(LAS bf16x8*)(RW_SLOT(lds, 0) + et * RS + 8 * cg) = x1; *(LAS bf16x8*)(RW_SLOT(lds, 1) + et * RS + 8 * cg) = x2;
          *(LAS u32x4*)(RW_SLOT(lds, 2) + et * RS + 8 * cg) = *(const u32x4*)((const bf16*)(a.ws + WS_WUPT) + (size_t)(h * 64 + et) * 64 + 8 * cg);
          *(LAS u32x4*)(RW_SLOT(lds, 3) + et * RS + 8 * cg) = *(const u32x4*)((const bf16*)(a.ws + WS_AUPT) + (size_t)(h * 64 + et) * 64 + 8 * cg); }
        __syncthreads();
        { f32x4 acc[2]; acc_zero(acc); mm_acc<2>(acc, RW_SLOT(lds, 0), RS, RW_SLOT(lds, 2), RS, w, lane);
#pragma unroll
          for (int tn = 0; tn < 2; ++tn)
#pragma unroll
              for (int r = 0; r < 4; ++r) FW[(m0 + r) * RW_FS + n0 + 16 * tn] = acc[tn][r];
          acc_zero(acc); mm_acc<2>(acc, RW_SLOT(lds, 1), RS, RW_SLOT(lds, 3), RS, w, lane);
#pragma unroll
          for (int tn = 0; tn < 2; ++tn)
#pragma unroll
              for (int r = 0; r < 4; ++r) FA[(m0 + r) * RW_FS + n0 + 16 * tn] = acc[tn][r]; }
        __syncthreads();
        float lw_[8], kk_[8], b_[8];
        { float ss = 0.f, sb = 0.f;
#pragma unroll
          for (int e = 0; e < 8; ++e) { const int ch = ch0 + e;
              const float wpre = a.in[I_W0][ch] + FW[et * RW_FS + 8 * cg + e]; const float y0 = -wpre; const float sp = fmaxf(y0, 0.f) + __logf(1.f + __expf(-fabsf(y0)));
              lw_[e] = -__expf(-sp - 0.5f);
              const float av = sigmoidf_(a.in[I_A0][ch] + FA[et * RW_FS + 8 * cg + e]);
              const float kkr = k_[e] * a.in[I_KK][ch]; ss += kkr * kkr; kk_[e] = kkr;
              k_[e] = k_[e] * (1.f + (av - 1.f) * a.in[I_KA][ch]); b_[e] = av;
              sb += r_[e] * k_[e] * a.in[I_RK][ch]; }
          ss += __shfl_xor(ss, 1); ss += __shfl_xor(ss, 2); ss += __shfl_xor(ss, 4);
          sb += __shfl_xor(sb, 1); sb += __shfl_xor(sb, 2); sb += __shfl_xor(sb, 4);
          const float rn = rsqrtf(fmaxf(ss, 1e-24f));
#pragma unroll
          for (int e = 0; e < 8; ++e) { kk_[e] *= rn; b_[e] *= kk_[e]; FW[et * RW_FS + 8 * cg + e] = lw_[e]; }
          if (cg == 0) ((float*)(a.ws + WS_SBON))[(size_t)(t0 + et) * 16 + h] = sb; }
        __syncthreads();
        { const int j = tid & 63, rg = tid >> 6; float run = 0.f;
#pragma unroll
          for (int i = 0; i < 8; ++i) { run += FW[(8 * rg + i) * RW_FS + j]; FW[(8 * rg + i) * RW_FS + j] = run; }
          TOT[rg * 64 + j] = run;
          __syncthreads();
          float off = 0.f;
          for (int q = 0; q < rg; ++q) off += TOT[q * 64 + j];
#pragma unroll
          for (int i = 0; i < 8; ++i) FW[(8 * rg + i) * RW_FS + j] += off; }
        __syncthreads();
        { bf16x8 at, bt, kt, rt;
#pragma unroll
          for (int e = 0; e < 8; ++e) { const int jj = 8 * cg + e; const float cum = FW[et * RW_FS + jj], cl = FW[63 * RW_FS + jj];
              const float eA = __expf(cum - lw_[e]), eN = __expf(-cum), eP = __expf(cum), eH = __expf(cl - cum);
              const float A_ = -kk_[e] * eA;
              at[e] = (bf16)A_; bt[e] = (bf16)(b_[e] * eN); kt[e] = (bf16)(k_[e] * eN); rt[e] = (bf16)(r_[e] * eP);
              RW_SLOT(lds, 1)[jj * RS + et] = (bf16)A_; RW_SLOT(lds, 5)[jj * RS + et] = (bf16)(b_[e] * eH); RW_SLOT(lds, 6)[jj * RS + et] = (bf16)(k_[e] * eH); RW_SLOT(lds, 7)[jj * RS + et] = (bf16)v_[e];
              if (et == 63) GCL[jj] = __expf(cl); }
          *(LAS bf16x8*)(RW_SLOT(lds, 0) + et * RS + 8 * cg) = at; *(LAS bf16x8*)(RW_SLOT(lds, 2) + et * RS + 8 * cg) = bt;
          *(LAS bf16x8*)(RW_SLOT(lds, 3) + et * RS + 8 * cg) = kt; *(LAS bf16x8*)(RW_SLOT(lds, 4) + et * RS + 8 * cg) = rt; }
        __syncthreads();
        { f32x4 acc[2];
          acc_zero(acc); mm_acc<2>(acc, RW_SLOT(lds, 0), RS, RW_SLOT(lds, 2), RS, w, lane); tri_mask<false>(acc, m0, n0);
          st_n(acc, RW_SLOT(lds, 8), m0, n0); st_t(acc, RW_SLOT(lds, 9), m0, n0);
#pragma unroll
          for (int tn = 0; tn < 2; ++tn)
#pragma unroll
              for (int r = 0; r < 4; ++r) if (m0 + r == n0 + 16 * tn) acc[tn][r] += 1.f;
          st_n(acc, RW_SLOT(lds, 13), m0, n0);
          acc_zero(acc); mm_acc<2>(acc, RW_SLOT(lds, 0), RS, RW_SLOT(lds, 3), RS, w, lane); tri_mask<false>(acc, m0, n0); st_t(acc, RW_SLOT(lds, 10), m0, n0);
          acc_zero(acc); mm_acc<2>(acc, RW_SLOT(lds, 4), RS, RW_SLOT(lds, 2), RS, w, lane); tri_mask<true>(acc, m0, n0); st_n(acc, RW_SLOT(lds, 11), m0, n0);
          acc_zero(acc); mm_acc<2>(acc, RW_SLOT(lds, 4), RS, RW_SLOT(lds, 3), RS, w, lane); tri_mask<true>(acc, m0, n0); st_n(acc, RW_SLOT(lds, 12), m0, n0); }
        __syncthreads();
        { f32x4 acc[2];
          acc_zero(acc); mm_acc<2>(acc, RW_SLOT(lds, 8), RS, RW_SLOT(lds, 9), RS, w, lane); st_n(acc, RW_SLOT(lds, 0), m0, n0); st_t(acc, RW_SLOT(lds, 2), m0, n0);
          __syncthreads();
          ld_n(acc, RW_SLOT(lds, 13), m0, n0); mm_acc<2>(acc, RW_SLOT(lds, 13), RS, RW_SLOT(lds, 2), RS, w, lane); st_n(acc, RW_SLOT(lds, 3), m0, n0);
          acc_zero(acc); mm_acc<2>(acc, RW_SLOT(lds, 0), RS, RW_SLOT(lds, 2), RS, w, lane); st_n(acc, RW_SLOT(lds, 8), m0, n0); st_t(acc, RW_SLOT(lds, 9), m0, n0);
          __syncthreads();
          ld_n(acc, RW_SLOT(lds, 3), m0, n0); mm_acc<2>(acc, RW_SLOT(lds, 3), RS, RW_SLOT(lds, 9), RS, w, lane); st_n(acc, RW_SLOT(lds, 13), m0, n0);
          acc_zero(acc); mm_acc<2>(acc, RW_SLOT(lds, 8), RS, RW_SLOT(lds, 9), RS, w, lane); st_n(acc, RW_SLOT(lds, 0), m0, n0); st_t(acc, RW_SLOT(lds, 2), m0, n0);
          __syncthreads();
          ld_n(acc, RW_SLOT(lds, 13), m0, n0); mm_acc<2>(acc, RW_SLOT(lds, 13), RS, RW_SLOT(lds, 2), RS, w, lane); st_n(acc, RW_SLOT(lds, 3), m0, n0);
          acc_zero(acc); mm_acc<2>(acc, RW_SLOT(lds, 0), RS, RW_SLOT(lds, 2), RS, w, lane); st_n(acc, RW_SLOT(lds, 8), m0, n0); st_t(acc, RW_SLOT(lds, 9), m0, n0);
          __syncthreads();
          ld_n(acc, RW_SLOT(lds, 3), m0, n0); mm_acc<2>(acc, RW_SLOT(lds, 3), RS, RW_SLOT(lds, 9), RS, w, lane); st_n(acc, RW_SLOT(lds, 13), m0, n0);
          acc_zero(acc); mm_acc<2>(acc, RW_SLOT(lds, 8), RS, RW_SLOT(lds, 9), RS, w, lane); st_t(acc, RW_SLOT(lds, 2), m0, n0);
          __syncthreads();
          ld_n(acc, RW_SLOT(lds, 13), m0, n0); mm_acc<2>(acc, RW_SLOT(lds, 13), RS, RW_SLOT(lds, 2), RS, w, lane); st_n(acc, RW_SLOT(lds, 3), m0, n0);
          __syncthreads();
          acc_zero(acc); mm_acc<2>(acc, RW_SLOT(lds, 1), RS, RW_SLOT(lds, 3), RS, w, lane); st_n(acc, RW_SLOT(lds, 0), m0, n0);
          acc_zero(acc); mm_acc<2>(acc, RW_SLOT(lds, 3), RS, RW_SLOT(lds, 10), RS, w, lane); st_n(acc, RW_SLOT(lds, 8), m0, n0);
          __syncthreads();
          acc_zero(acc); mm_acc<2>(acc, RW_SLOT(lds, 7), RS, RW_SLOT(lds, 8), RS, w, lane); st_n(acc, RW_SLOT(lds, 9), m0, n0);
          acc_zero(acc); mm_acc<2>(acc, RW_SLOT(lds, 0), RS, RW_SLOT(lds, 11), RS, w, lane);
#pragma unroll
          for (int tn = 0; tn < 2; ++tn) { const int tt = n0 + 16 * tn; const bf16x4 rr = *(const LAS bf16x4*)(RW_SLOT(lds, 4) + tt * RS + m0);
              const bf16x4 o = {(bf16)(acc[tn][0] + (float)rr[0]), (bf16)(acc[tn][1] + (float)rr[1]), (bf16)(acc[tn][2] + (float)rr[2]), (bf16)(acc[tn][3] + (float)rr[3])};
              *(bf16x4*)((bf16*)(ro + RO_Q) + (size_t)uo * 4096 + tt * 64 + m0) = o; }
          acc_zero(acc); mm_acc<2>(acc, RW_SLOT(lds, 0), RS, RW_SLOT(lds, 5), RS, w, lane);
#pragma unroll
          for (int tn = 0; tn < 2; ++tn) { const int jj = n0 + 16 * tn; const float gc = GCL[jj];
              const bf16x4 o = {(bf16)(acc[tn][0] + (m0 == jj ? gc : 0.f)), (bf16)(acc[tn][1] + (m0 + 1 == jj ? gc : 0.f)), (bf16)(acc[tn][2] + (m0 + 2 == jj ? gc : 0.f)), (bf16)(acc[tn][3] + (m0 + 3 == jj ? gc : 0.f))};
              *(bf16x4*)((bf16*)(ro + RO_M) + (size_t)uo * 4096 + jj * 64 + m0) = o; }
          __syncthreads();
          acc_zero(acc); mm_acc<2>(acc, RW_SLOT(lds, 11), RS, RW_SLOT(lds, 9), RS, w, lane); mm_acc<2>(acc, RW_SLOT(lds, 12), RS, RW_SLOT(lds, 7), RS, w, lane); st_acc_g(acc, (f16*)(ro + RO_Y), uo, w, lane);
          acc_zero(acc); mm_acc<2>(acc, RW_SLOT(lds, 9), RS, RW_SLOT(lds, 5), RS, w, lane); mm_acc<2>(acc, RW_SLOT(lds, 7), RS, RW_SLOT(lds, 6), RS, w, lane); st_acc_g(acc, (f16*)(ro + RO_N), uo, w, lane);
        }
    }
}
__device__ __forceinline__ void p_rwkv_scan(const Args& a, LAS unsigned char* lds, int h) {
    const int tid = opaque_tid(), lane = tid & 63, w = __builtin_amdgcn_readfirstlane(tid >> 6);
    const int m0 = 16 * (w >> 1) + 4 * (lane >> 4), n0 = 32 * (w & 1) + (lane & 15), row = tid >> 3, seg = tid & 7;
    const unsigned char* ro = (const unsigned char*)a.out;
    const bf16* Mg = (const bf16*)(ro + RO_M) + (size_t)h * 256 * 4096; const f16x4* Ng = (const f16x4*)(ro + RO_N) + (size_t)h * 256 * 1024; bf16* Sg = (bf16*)(a.ws + WS_RS) + (size_t)h * 256 * 4096;
    f32x4 acc[2]; acc_zero(acc);
    u32x4 mreg = *(const u32x4*)(Mg + row * 64 + seg * 8); f16x4 nreg[2] = {Ng[(w * 2) * 64 + lane], Ng[(w * 2 + 1) * 64 + lane]};
    for (int c = 0; c < 256; ++c) {
        LAS bf16* Sb = RW_SLOT(lds, c & 1); LAS bf16* Mb = RW_SLOT(lds, 2 + (c & 1));
        st_n(acc, Sb, m0, n0);
        *(LAS u32x4*)(Mb + row * RS + seg * 8) = mreg;
        const f16x4 nc0 = nreg[0], nc1 = nreg[1];
        if (c + 1 < 256) { mreg = *(const u32x4*)(Mg + (size_t)(c + 1) * 4096 + row * 64 + seg * 8); nreg[0] = Ng[(size_t)(c + 1) * 1024 + (w * 2) * 64 + lane]; nreg[1] = Ng[(size_t)(c + 1) * 1024 + (w * 2 + 1) * 64 + lane]; }
        __syncthreads();
        *(u32x4*)(Sg + (size_t)c * 4096 + row * 64 + seg * 8) = *(const LAS u32x4*)(Sb + row * RS + seg * 8);
        acc[0] = (f32x4){(float)nc0[0], (float)nc0[1], (float)nc0[2], (float)nc0[3]}; acc[1] = (f32x4){(float)nc1[0], (float)nc1[1], (float)nc1[2], (float)nc1[3]};
        mm_acc<2>(acc, Sb, RS, Mb, RS, w, lane);
    }
}
constexpr int RG_S = 168;
__device__ __forceinline__ void p_rwkv_out(const Args& a, LAS unsigned char* lds) {
    const int tid = opaque_tid(), lane = tid & 63, w = __builtin_amdgcn_readfirstlane(tid >> 6);
    const int m0 = 16 * (w >> 1) + 4 * (lane >> 4), n0 = 32 * (w & 1) + (lane & 15), row = tid >> 3, seg = tid & 7;
    const f16* z = (const f16*)(a.ws + WS_Z); const unsigned char* ro = (const unsigned char*)a.out; f16* mix = (f16*)(a.ws + WS_MIX);
    const float* mu = a.in[I_MU];
    LAS bf16* SG = (LAS bf16*)(lds + 2 * SLOT); LAS bf16* GU = SG + 64 * RG_S; LAS float* YL = (LAS float*)(GU + 64 * RG_S); LAS float* GL = YL + 64 * RW_FS;
    for (int u = blockIdx.x; u < 4096; u += gridDim.x) {
        const int c = u >> 4, h = u & 15, t0 = c * 64, uo = h * 256 + c;
        __syncthreads();
        *(LAS u32x4*)(RW_SLOT(lds, 0) + row * RS + seg * 8) = *(const u32x4*)((const bf16*)(ro + RO_Q) + (size_t)uo * 4096 + row * 64 + seg * 8);
        *(LAS u32x4*)(RW_SLOT(lds, 1) + row * RS + seg * 8) = *(const u32x4*)((const bf16*)(a.ws + WS_RS) + (size_t)uo * 4096 + row * 64 + seg * 8);
        for (int ck = tid; ck < 64 * 20; ck += 512) { const int rr = ck / 20, c8 = ck % 20, t = t0 + rr; const f16* cur = z + (size_t)t * NZ + ZGD + 8 * c8;
            const f16x8 cv = *(const f16x8*)cur; const f16x8 zero8 = {0, 0, 0, 0, 0, 0, 0, 0}; const f16x8 pv = t > 0 ? *(const f16x8*)(cur - NZ) : zero8; bf16x8 o;
#pragma unroll
            for (int e = 0; e < 8; ++e) o[e] = (bf16)sigmoidf_((float)cv[e] + ((float)pv[e] - (float)cv[e]) * mu[3200 + 8 * c8 + e]);
            *(LAS bf16x8*)(SG + rr * RG_S + 8 * c8) = o;
            *(LAS u32x4*)(GU + rr * RG_S + 8 * c8) = *(const u32x4*)((const bf16*)(a.ws + WS_GUPT) + (size_t)(h * 64 + rr) * 160 + 8 * c8); }
        __syncthreads();
        f32x4 y[2], g[2];
        { const f16x4* Yg = (const f16x4*)(ro + RO_Y) + (size_t)uo * 1024; const f16x4 y0 = Yg[(w * 2) * 64 + lane], y1 = Yg[(w * 2 + 1) * 64 + lane];
          y[0] = (f32x4){(float)y0[0], (float)y0[1], (float)y0[2], (float)y0[3]}; y[1] = (f32x4){(float)y1[0], (float)y1[1], (float)y1[2], (float)y1[3]}; }
        mm_acc<2>(y, RW_SLOT(lds, 0), RS, RW_SLOT(lds, 1), RS, w, lane);
        acc_zero(g); mm_acc<5>(g, SG, RG_S, GU, RG_S, w, lane);
#pragma unroll
        for (int tn = 0; tn < 2; ++tn)
#pragma unroll
            for (int r = 0; r < 4; ++r) { YL[(m0 + r) * RW_FS + n0 + 16 * tn] = y[tn][r]; GL[(m0 + r) * RW_FS + n0 + 16 * tn] = g[tn][r]; }
        __syncthreads();
        { const int et = tid >> 3, cg = tid & 7, t = t0 + et, ch0 = h * 64 + 8 * cg;
          float yv[8], gv[8]; float s1 = 0.f, s2 = 0.f;
#pragma unroll
          for (int e = 0; e < 8; ++e) { yv[e] = YL[et * RW_FS + 8 * cg + e]; gv[e] = GL[et * RW_FS + 8 * cg + e]; s1 += yv[e]; s2 += yv[e] * yv[e]; }
          s1 += __shfl_xor(s1, 1); s1 += __shfl_xor(s1, 2); s1 += __shfl_xor(s1, 4);
          s2 += __shfl_xor(s2, 1); s2 += __shfl_xor(s2, 2); s2 += __shfl_xor(s2, 4);
          const float mean = s1 * (1.f / 64.f), var = fmaxf(s2 * (1.f / 64.f) - mean * mean, 0.f), rstd = rsqrtf(var + 64e-5f);
          const float sbn = ((const float*)(a.ws + WS_SBON))[(size_t)t * 16 + h];
          const f16* cur = z + (size_t)t * NZ + ZV + ch0; const f16x8 zero8 = {0, 0, 0, 0, 0, 0, 0, 0};
          const f16x8 c8 = *(const f16x8*)cur, p8 = t > 0 ? *(const f16x8*)(cur - NZ) : zero8;
          f16x8 o;
#pragma unroll
          for (int e = 0; e < 8; ++e) { const int ch = ch0 + e; const float vv = (float)c8[e] + ((float)p8[e] - (float)c8[e]) * mu[2048 + ch];
              const float yn = (yv[e] - mean) * rstd * a.in[I_LNXG][ch] + a.in[I_LNXB][ch]; o[e] = (f16)((yn + sbn * vv) * gv[e]); }
          *(f16x8*)(mix + (size_t)t * D + 1024 + ch0) = o; }
    }
}

__device__ __forceinline__ void p_router(const Args& a, LAS unsigned char* lds, int rep) {
    const int tid = opaque_tid(), lane = tid & 63, wave = __builtin_amdgcn_readfirstlane(tid >> 6);
    const float* x2 = (const float*)(a.ws + WS_X1); f16* h3 = (f16*)a.out;
    unsigned* ctl = (unsigned*)(a.ws + WS_CTL);
    int* tke = (int*)(a.ws + WS_TOK + TK_E); float* tkw = (float*)(a.ws + WS_TOK + TK_W);
    const f16* WH = (const f16*)(a.ws + WS_WRH); const f16* WL = (const f16*)(a.ws + WS_WRL);
    LAS float* PART = (LAS float*)lds;
    LAS float* SSP = PART + 8 * 16 * 48;
    LAS float* LG = SSP + 128;
    LAS float* RSTD = LG + 16 * 48;
    const int row = lane & 15, kq = lane >> 4;
    for (int tile = blockIdx.x; tile < T / 16; tile += gridDim.x) {
        const int r0 = tile * 16;
        f32x4 acc[3]; acc[0] = (f32x4){0.f, 0.f, 0.f, 0.f}; acc[1] = acc[0]; acc[2] = acc[0];
        float ss = 0.f;
        const float* xp = x2 + (size_t)(r0 + row) * D + 256 * wave + 8 * kq;
        const f16* whp = WH + (size_t)row * D + 256 * wave + 8 * kq; const f16* wlp = WL + (size_t)row * D + 256 * wave + 8 * kq;
#pragma unroll 4
        for (int ks = 0; ks < 8; ++ks) {
            const f32x4 xa = *(const f32x4*)(xp + 32 * ks), xb = *(const f32x4*)(xp + 32 * ks + 4);
            ss += xa.x * xa.x + xa.y * xa.y + xa.z * xa.z + xa.w * xa.w + xb.x * xb.x + xb.y * xb.y + xb.z * xb.z + xb.w * xb.w;
            f16x8 hi, lo;
#pragma unroll
            for (int j = 0; j < 4; ++j) { hi[j] = (f16)xa[j]; lo[j] = (f16)(xa[j] - (float)hi[j]); hi[4 + j] = (f16)xb[j]; lo[4 + j] = (f16)(xb[j] - (float)hi[4 + j]); }
#pragma unroll
            for (int nt = 0; nt < 3; ++nt) { const f16x8 bh = *(const f16x8*)(whp + (size_t)nt * 16 * D + 32 * ks), bl = *(const f16x8*)(wlp + (size_t)nt * 16 * D + 32 * ks);
                acc[nt] = __builtin_amdgcn_mfma_f32_16x16x32_f16(hi, bh, acc[nt], 0, 0, 0); acc[nt] = __builtin_amdgcn_mfma_f32_16x16x32_f16(lo, bh, acc[nt], 0, 0, 0); acc[nt] = __builtin_amdgcn_mfma_f32_16x16x32_f16(hi, bl, acc[nt], 0, 0, 0); }
        }
        ss += __shfl_xor(ss, 16); ss += __shfl_xor(ss, 32);
        __syncthreads();
        if (kq == 0) SSP[wave * 16 + row] = ss;
#pragma unroll
        for (int nt = 0; nt < 3; ++nt)
#pragma unroll
            for (int r = 0; r < 4; ++r) PART[(wave * 16 + 4 * kq + r) * 48 + 16 * nt + row] = acc[nt][r];
        __syncthreads();
        for (int i = tid; i < 16 * 48; i += 512) { float v = 0.f;
#pragma unroll
            for (int ww = 0; ww < 8; ++ww) v += PART[ww * 768 + i];
            LG[i] = v; }
        if (tid < 16) { float v = 0.f;
#pragma unroll
            for (int ww = 0; ww < 8; ++ww) v += SSP[ww * 16 + tid];
            RSTD[tid] = rsqrtf(v * (1.f / D) + EPS); }
        __syncthreads();
        if (tid < 16) {
            const float rs = RSTD[tid]; const LAS float* L = LG + tid * 48;
            float lg[4];
#pragma unroll
            for (int c = 0; c < 4; ++c) lg[c] = L[c] * rs + a.in[I_RGB][c];
            int gi = 0; float gm = lg[0];
#pragma unroll
            for (int c = 1; c < 4; ++c) if (lg[c] > gm) { gm = lg[c]; gi = c; }
            float gs = 0.f;
#pragma unroll
            for (int c = 0; c < 4; ++c) gs += __expf(lg[c] - gm);
            const float pg = 1.f / gs;
            float le[8];
#pragma unroll
            for (int c = 0; c < 8; ++c) le[c] = L[4 + gi * 8 + c] * rs + a.in[I_REB][gi * 8 + c];
            int e1 = 0; float m1 = le[0];
#pragma unroll
            for (int c = 1; c < 8; ++c) if (le[c] > m1) { m1 = le[c]; e1 = c; }
            int e2 = -1; float m2 = -INFINITY;
#pragma unroll
            for (int c = 0; c < 8; ++c) if (c != e1 && le[c] > m2) { m2 = le[c]; e2 = c; }
            const float p2 = __expf(m2 - m1);
            const float w1 = pg / (1.f + p2), w2 = pg * p2 / (1.f + p2);
            const int m = r0 + tid, E1 = gi * 8 + e1, E2 = gi * 8 + e2; tke[m * 2] = E1; tke[m * 2 + 1] = E2; tkw[m * 2] = w1; tkw[m * 2 + 1] = w2;
            atomicAdd(&ctl[CW_CNT + rep * 8000 + E1], 1u); atomicAdd(&ctl[CW_CNT + rep * 8000 + E2], 1u);
        }
#pragma unroll
        for (int rr2 = 0; rr2 < 2; ++rr2) { const int rr = wave * 2 + rr2; const float rs = RSTD[rr]; const f32x4* xr = (const f32x4*)(x2 + (size_t)(r0 + rr) * D) + lane; const f32x4* gr = (const f32x4*)a.in[I_LN3] + lane; u32x2* o8 = (u32x2*)(h3 + (size_t)(r0 + rr) * D) + lane;
#pragma unroll
            for (int j = 0; j < 8; ++j) { const f32x4 v = xr[64 * j], gg = gr[64 * j]; u32x2 wv; wv.x = pkh(v.x * rs * gg.x, v.y * rs * gg.y); wv.y = pkh(v.z * rs * gg.z, v.w * rs * gg.w); o8[64 * j] = wv; } }
    }
}
__device__ __forceinline__ void p_slots(const Args& a, LAS unsigned char* lds, int rep) {
    unsigned* ctl = (unsigned*)(a.ws + WS_CTL);
    const int* tke = (const int*)(a.ws + WS_TOK + TK_E); const float* tkw = (const float*)(a.ws + WS_TOK + TK_W); int* tks = (int*)(a.ws + WS_TOK + TK_SLOT);
    int* stok = (int*)(a.ws + WS_TOK + TK_STOK); float* sw = (float*)(a.ws + WS_TOK + TK_SW);
    const int tid = opaque_tid(), lane = tid & 63;
    LAS int* offl = (LAS int*)lds; LAS int* cntl = offl + 64;
    __syncthreads();
    if (tid < 64) {
        const int n = lane < NEXP ? (int)ctl[CW_CNT + lane] : 0, nt = (n + 255) >> 8;
        int pre = nt;
#pragma unroll
        for (int o = 1; o < 32; o <<= 1) { const int v = __shfl_up(pre, o); if ((lane & 31) >= o) pre += v; }
        const int tb = pre - nt;
        if (lane < NEXP) { offl[lane] = tb * 256; cntl[lane] = n; }
        if (lane == NEXP - 1) offl[NEXP] = pre * 256;
        if (blockIdx.x == 0 && lane < NEXP) {
            int2* ugu = (int2*)(ctl + CW_UGU); int2* udn = (int2*)(ctl + CW_UDN);
            for (int rt = 0; rt < nt; ++rt) { const int pm = tb + rt;
#pragma unroll
                for (int jt = 0; jt < 2; ++jt) ugu[pm * 2 + jt] = make_int2(pm, lane * 2 + jt);
#pragma unroll
                for (int jt = 0; jt < 8; ++jt) udn[pm * 8 + jt] = make_int2(pm, lane * 8 + jt); }
            if (lane == NEXP - 1) { ctl[CW_NT] = (unsigned)pre; ctl[CW_NGU] = (unsigned)(pre * 2); ctl[CW_NDN] = (unsigned)(pre * 8); }
        }
    }
    __syncthreads();
    if (blockIdx.x == 0 && rep == 0) {
        for (int e = 0; e < NEXP; ++e) { const int end = offl[e + 1];
            for (int sl = offl[e] + cntl[e] + tid; sl < end; sl += 512) { stok[sl] = 0; sw[sl] = 0.f; } } }
    for (int i = blockIdx.x * 512 + tid; i < T * 2; i += gridDim.x * 512) { const int e = tke[i]; const int slot = offl[e] + (int)atomicAdd(&ctl[CW_CUR + rep * 8000 + e], 1u);
        stok[slot] = i >> 1; sw[slot] = tkw[i]; tks[i] = slot; }
}

constexpr int NPH = 17;
__global__ void __launch_bounds__(512, 2) mega(Args args) {
    extern __shared__ __attribute__((aligned(16))) unsigned char lds_raw[];
    LAS unsigned char* lds = (LAS unsigned char*)lds_raw;
    volatile LAS unsigned* MISC = (volatile LAS unsigned*)(lds + MISC_OFF);
    const int G = gridDim.x;
#define PH_IDS const int tid = opaque_tid(), lane = tid & 63, wave = tid >> 6, gw = blockIdx.x * 8 + wave, NGW = gridDim.x * 8; (void)tid; (void)lane; (void)gw; (void)NGW
    unsigned char* ws = args.ws;
    unsigned* ctl = (unsigned*)(ws + WS_CTL);
    if (threadIdx.x < 128) ((LAS unsigned*)(lds + MISC_OFF))[threadIdx.x] = 0u;
    __syncthreads();
    XcdBarrier bar; bar.bar = ctl + CW_BAR; bar.x = 0; bar.st = nullptr;
    const int lo = args.ph_lo, hi = args.ph_hi;
    if (hi - lo > 1 || DUPMASK != 0u) bar = xcd_barrier_post(ctl + CW_BAR, MISC + 8);
#ifndef PHMASK
#define PHMASK 0xFFFFFFFFu
#endif
#define IN(k) (((PHMASK >> (k)) & 1u) && lo <= (k) && (k) < hi)
#define BOTH(k) (IN(k) && IN((k) + 1))
#define GRID_BAR() xcd_barrier(bar)
#define NREP(k) ((((DUPMASK) >> (k)) & 1u) ? 2 : 1)

    for (int rep_ = 0; rep_ < NREP(0); ++rep_) if (IN(0)) { p0_prologue(args, lds); if (BOTH(0) || rep_ + 1 < NREP(0)) GRID_BAR(); }
    for (int rep_ = 0; rep_ < NREP(1); ++rep_) if (IN(1)) {
        { pg8::Gemm g{(const f16*)(ws + WS_H), (const f16*)(ws + WS_WIN), D, D, D, nullptr}; pg8::StaticOrder S; S.init(T, NZ, G, (int)blockIdx.x);
          pg8::EpiF16 E{(f16*)(ws + WS_Z), NZ, 1.f}; pg8::gemm_phase<pg8::EpiF16, pg8::StaticOrder, true>(lds, g, S, E); }
        if (BOTH(1) || rep_ + 1 < NREP(1)) GRID_BAR();
    }
    for (int rep_ = 0; rep_ < NREP(2); ++rep_) if (IN(2)) {
        p_compress(args, lds);
        __syncthreads();
        p_rwkv_local(args, lds);
        if (BOTH(2) || rep_ + 1 < NREP(2)) GRID_BAR();
    }
    for (int rep_ = 0; rep_ < NREP(3); ++rep_) if (IN(3)) {
        if (blockIdx.x < 16) p_rwkv_scan(args, lds, blockIdx.x);
        else if (blockIdx.x < 32 && rep_ == 0) { const int b = blockIdx.x - 16; const int which = b / 8;
            pg8::Gemm g{(const f16*)(ws + WS_MEMN), (const f16*)(ws + (which == 0 ? WS_WKT : WS_WVT)), D, D, D, nullptr}; pg8::StaticOrder S; S.init(256, D, 8, b % 8);
            pg8::EpiF16 E{(f16*)(ws + (which == 0 ? WS_KM : WS_VM)), D, 1.f}; pg8::gemm_phase<pg8::EpiF16, pg8::StaticOrder, true>(lds, g, S, E); }
        __syncthreads();
        p_nsa(args, lds, rep_);
        if (BOTH(3) || rep_ + 1 < NREP(3)) GRID_BAR();
    }
    for (int rep_ = 0; rep_ < NREP(4); ++rep_) if (IN(4)) { p_rwkv_out(args, lds); if (BOTH(4) || rep_ + 1 < NREP(4)) GRID_BAR(); }
    for (int rep_ = 0; rep_ < NREP(5); ++rep_) if (IN(5)) {
        PH_IDS;
        if (blockIdx.x < 64) { const int b = blockIdx.x; const int grp = b / 8, c = b % 8;
          if (grp < 4) { const int h = grp;
              pg8::Gemm g{(const f16*)(ws + WS_KM) + h * 512, (const f16*)(ws + WS_WQ16) + h * 512, D, D, 512, nullptr}; pg8::StaticOrder S; S.init(256, D, 8, c);
              pg8::EpiF16 E{(f16*)(ws + WS_WQK) + (size_t)h * 256 * D, D, 0.04419417382415922f}; pg8::gemm_phase<pg8::EpiF16, pg8::StaticOrder, true>(lds, g, S, E); }
          else { const int h = grp - 4;
              pg8::Gemm g{(const f16*)(ws + WS_WOT) + h * 512, (const f16*)(ws + WS_VM) + h * 512, D, D, 512, nullptr}; pg8::StaticOrder S; S.init(D, 256, 8, c);
              pg8::EpiF16 E{(f16*)(ws + WS_VOT) + h * 256, 1024, 1.f}; pg8::gemm_phase<pg8::EpiF16, pg8::StaticOrder, true>(lds, g, S, E); } }
        else {
        const float* onsa = (const float*)(ws + WS_ONSA); f16* mix = (f16*)(ws + WS_MIX);
        for (int m = gw - 64 * 8; m < T; m += NGW - 64 * 8) { const f32x4* xr = (const f32x4*)(onsa + (size_t)m * 1024) + lane; f32x4 v[4]; float s = 0.f;
#pragma unroll
            for (int j = 0; j < 4; ++j) { v[j] = xr[64 * j]; s += v[j].x * v[j].x + v[j].y * v[j].y + v[j].z * v[j].z + v[j].w * v[j].w; }
            const float rstd = rsqrtf(wave_sum(s) * (1.f / 1024.f) + EPS); const f32x4* gr = (const f32x4*)args.in[I_NSAG] + lane; u32x2* o8 = (u32x2*)(mix + (size_t)m * D) + lane;
#pragma unroll
            for (int j = 0; j < 4; ++j) { const f32x4 gg = gr[64 * j]; u32x2 w; w.x = pkh(v[j].x * rstd * gg.x, v[j].y * rstd * gg.y); w.y = pkh(v[j].z * rstd * gg.z, v[j].w * rstd * gg.w); o8[64 * j] = w; } }
        }
        if (BOTH(5) || rep_ + 1 < NREP(5)) GRID_BAR();
    }
    for (int rep_ = 0; rep_ < NREP(6); ++rep_) if (IN(6)) {
        pg8::Gemm g{(const f16*)(ws + WS_MIX), (const f16*)(ws + WS_WOUT), D, D, D, nullptr}; pg8::StaticOrder S; S.init(T, D, G, (int)blockIdx.x);
        pg8::EpiF32 E{(float*)(ws + WS_X1), args.in[I_X], D}; pg8::gemm_phase<pg8::EpiF32, pg8::StaticOrder, true>(lds, g, S, E);
        if (BOTH(6) || rep_ + 1 < NREP(6)) GRID_BAR();
    }
    for (int rep_ = 0; rep_ < NREP(7); ++rep_) if (IN(7)) {
        PH_IDS;
        for (int m = gw; m < T; m += NGW) rms_row((const float*)(ws + WS_X1) + (size_t)m * D, args.in[I_LN2], (f16*)(ws + WS_H2) + (size_t)m * D, lane);
        p_moe_weights(args, lds);
        if (BOTH(7) || rep_ + 1 < NREP(7)) GRID_BAR();
    }
    for (int rep_ = 0; rep_ < NREP(8); ++rep_) if (IN(8)) {
        pg8::Gemm g{(const f16*)(ws + WS_H2), (const f16*)(ws + WS_WQK), D, D, D, nullptr}; pg8::StaticOrder S; S.init(T, 1024, G, (int)blockIdx.x);
        pg8::EpiF32 E{(float*)(ws + WS_S), nullptr, 1024}; pg8::gemm_phase<pg8::EpiF32, pg8::StaticOrder, true>(lds, g, S, E);
        if (BOTH(8) || rep_ + 1 < NREP(8)) GRID_BAR();
    }
    for (int rep_ = 0; rep_ < NREP(9); ++rep_) if (IN(9)) {
        PH_IDS;
        const float* Sm = (const float*)(ws + WS_S); f16* P = (f16*)(ws + WS_P);
        for (int it = gw; it < T * 4; it += NGW) { const f32x4 v = *((const f32x4*)(Sm + (size_t)it * 256) + lane);
            const float mx = wave_max(fmaxf(fmaxf(v.x, v.y), fmaxf(v.z, v.w)));
            const float e0 = __expf(v.x - mx), e1 = __expf(v.y - mx), e2 = __expf(v.z - mx), e3 = __expf(v.w - mx);
            const float inv = 1.f / wave_sum(e0 + e1 + e2 + e3);
            u32x2 w; w.x = pkh(e0 * inv, e1 * inv); w.y = pkh(e2 * inv, e3 * inv); *((u32x2*)(P + (size_t)it * 256) + lane) = w; }
        if (BOTH(9) || rep_ + 1 < NREP(9)) GRID_BAR();
    }
    for (int rep_ = 0; rep_ < NREP(10); ++rep_) if (IN(10)) {
        pg8::Gemm g{(const f16*)(ws + WS_P), (const f16*)(ws + WS_VOT), 1024, 1024, 1024, nullptr}; pg8::StaticOrder S; S.init(T, D, G, (int)blockIdx.x);
        pg8::EpiF32 E{(float*)(ws + WS_X1), (const float*)(ws + WS_X1), D}; pg8::gemm_phase<pg8::EpiF32, pg8::StaticOrder, true>(lds, g, S, E);
        if (BOTH(10) || rep_ + 1 < NREP(10)) GRID_BAR();
    }
    for (int rep_ = 0; rep_ < NREP(11); ++rep_) if (IN(11)) { p_router(args, lds, rep_); if (BOTH(11) || rep_ + 1 < NREP(11)) GRID_BAR(); }
    for (int rep_ = 0; rep_ < NREP(13); ++rep_) if (IN(13)) { p_slots(args, lds, rep_); if (BOTH(13) || rep_ + 1 < NREP(13)) GRID_BAR(); }
    for (int rep_ = 0; rep_ < NREP(14); ++rep_) if (IN(14)) {
        pg8::Gemm g{(const f16*)args.out, (const f16*)(ws + WS_WGU), D, D, D, (const int*)(ws + WS_TOK + TK_STOK)};
        pg8::TableOrder S{(const int2*)(ctl + CW_UGU), (int)ctl[CW_NGU], G, (int)blockIdx.x};
        pg8::EpiSilu E{(f16*)(ws + WS_HID)}; pg8::gemm_phase<pg8::EpiSilu, pg8::TableOrder, true, true>(lds, g, S, E);
        if (BOTH(14) || rep_ + 1 < NREP(14)) GRID_BAR();
    }
    for (int rep_ = 0; rep_ < NREP(15); ++rep_) if (IN(15)) {
        pg8::Gemm g{(const f16*)(ws + WS_HID), (const f16*)(ws + WS_WD), EFF, EFF, EFF, nullptr};
        pg8::TableOrder S{(const int2*)(ctl + CW_UDN), (int)ctl[CW_NDN], G, (int)blockIdx.x};
        pg8::EpiDown E{ws}; pg8::gemm_phase<pg8::EpiDown, pg8::TableOrder, true>(lds, g, S, E);
        if (BOTH(15) || rep_ + 1 < NREP(15)) GRID_BAR();
    }
    for (int rep_ = 0; rep_ < NREP(16); ++rep_) if (IN(16)) {
        PH_IDS;
        const float* x2 = (const float*)(ws + WS_X1); const int* tks = (const int*)(ws + WS_TOK + TK_SLOT);
        const float* tkw = (const float*)(ws + WS_TOK + TK_W);
        for (int m = gw; m < T; m += NGW) { const int s1 = tks[m * 2], s2 = tks[m * 2 + 1]; const float w1 = tkw[m * 2], w2 = tkw[m * 2 + 1];
            const f16* y1 = (const f16*)(ws + ((s1 >> 8) < 128 ? WS_Y0 + (size_t)(s1 >> 8) * MiB : WS_Y1 + (size_t)((s1 >> 8) - 128) * MiB)) + (size_t)(s1 & 255) * D;
            const f16* y2 = (const f16*)(ws + ((s2 >> 8) < 128 ? WS_Y0 + (size_t)(s2 >> 8) * MiB : WS_Y1 + (size_t)((s2 >> 8) - 128) * MiB)) + (size_t)(s2 & 255) * D;
            const f32x4* xr = (const f32x4*)(x2 + (size_t)m * D) + lane; f32x4 v[8]; float s = 0.f;
#pragma unroll
            for (int j = 0; j < 8; ++j) { v[j] = xr[64 * j]; const f16x4 a1 = *((const f16x4*)y1 + lane + 64 * j), a2 = *((const f16x4*)y2 + lane + 64 * j);
                v[j].x += w1 * (float)a1.x + w2 * (float)a2.x; v[j].y += w1 * (float)a1.y + w2 * (float)a2.y; v[j].z += w1 * (float)a1.z + w2 * (float)a2.z; v[j].w += w1 * (float)a1.w + w2 * (float)a2.w;
                s += v[j].x * v[j].x + v[j].y * v[j].y + v[j].z * v[j].z + v[j].w * v[j].w; }
            const float rstd = rsqrtf(wave_sum(s) * (1.f / D) + EPS); const f32x4* gr = (const f32x4*)args.in[I_LNF] + lane; f32x4* o = (f32x4*)(args.out + (size_t)m * D) + lane;
#pragma unroll
            for (int j = 0; j < 8; ++j) { const f32x4 gg = gr[64 * j]; o[64 * j] = (f32x4){v[j].x * rstd * gg.x, v[j].y * rstd * gg.y, v[j].z * rstd * gg.z, v[j].w * rstd * gg.w}; } }
    }
#undef IN
#undef BOTH
#undef GRID_BAR
}

extern "C" void kernel_launch(void* const* d_in, const int* in_sizes, int n_in, void* d_out, int out_size, void* d_ws, size_t ws_size, hipStream_t stream) {
    static int grid = 0;
    if (grid == 0) {
        if (n_in != 38 || out_size != T * D || ws_size < WS_END) { fprintf(stderr, "kernel_launch: unexpected shapes (n_in %d out %d ws %zu)\n", n_in, out_size, ws_size); grid = -1; return; }
        int dev = 0, cus = 0;
        if (hipGetDevice(&dev) != hipSuccess || hipDeviceGetAttribute(&cus, hipDeviceAttributeMultiprocessorCount, dev) != hipSuccess) { grid = -1; return; }
        if (hipFuncSetAttribute((const void*)mega, hipFuncAttributeMaxDynamicSharedMemorySize, LDS_BYTES) != hipSuccess) { grid = -1; return; }
        int per_cu = 0; (void)hipOccupancyMaxActiveBlocksPerMultiprocessor(&per_cu, (const void*)mega, 512, LDS_BYTES); (void)hipGetLastError();
        grid = cus;
    }
    if (grid < 0) return;
    (void)hipMemsetAsync((char*)d_ws + WS_CTL, 0, CTL_ZERO_BYTES, stream);
    Args a{};
    for (int i = 0; i < 38; ++i) a.in[i] = (const float*)d_in[i];
    a.out = (float*)d_out; a.ws = (unsigned char*)d_ws;
#if MK_ONE_LAUNCH
    a.ph_lo = 0; a.ph_hi = NPH;
    hipLaunchKernelGGL(mega, dim3(grid), dim3(512), LDS_BYTES, stream, a);
#else
    for (int p = 0; p < NPH; ++p) { a.ph_lo = p; a.ph_hi = p + 1; hipLaunchKernelGGL(mega, dim3(grid), dim3(512), LDS_BYTES, stream, a); }
#endif
}
```

```cpp
#include <hip/hip_runtime.h>
#include <cstdio>
#include <cstdint>

#ifndef DUPMASK
#define DUPMASK 0u
#endif
#ifndef NSA_SELREP
#define NSA_SELREP 1
#endif
#ifndef NSA_CMPREP
#define NSA_CMPREP 1
#endif
#ifndef NSA_WINREP
#define NSA_WINREP 1
#endif
#ifndef DUPX
#define DUPX 0
#endif
#ifndef MK_ONE_LAUNCH
#define MK_ONE_LAUNCH 1
#endif

#define LAS __attribute__((address_space(3)))
#define GAS __attribute__((address_space(1)))
typedef _Float16 f16;
typedef _Float16 f16x8 __attribute__((ext_vector_type(8)));
typedef _Float16 f16x4 __attribute__((ext_vector_type(4)));
typedef _Float16 f16x2 __attribute__((ext_vector_type(2)));
typedef float f32x4 __attribute__((ext_vector_type(4)));
typedef float f32x2 __attribute__((ext_vector_type(2)));
typedef unsigned u32x4 __attribute__((ext_vector_type(4)));
typedef unsigned u32x2 __attribute__((ext_vector_type(2)));
typedef __bf16 bf16;
typedef __bf16 bf16x8 __attribute__((ext_vector_type(8)));
typedef __bf16 bf16x4 __attribute__((ext_vector_type(4)));

constexpr int T = 16384, D = 2048, NZ = 6144;
constexpr int ZQ = 0, ZKC = 1024, ZVC = 1280, ZKS = 1536, ZVS = 1792, ZKW = 2048, ZVW = 2304, ZR = 2560, ZK = 3584, ZV = 4608, ZWD = 5632, ZAD = 5696, ZGD = 5760, ZGL = 5920;
constexpr int NCMP = 1023;
constexpr int NEXP = 32, EFF = 256, MAXSLOT = 40960, MAXTILES = 160;
constexpr float EPS = 1e-6f;

constexpr size_t MiB = 1u << 20;
constexpr size_t WS_CTL = 0, CTL_ZERO_BYTES = 64 * 1024;
constexpr size_t WS_MEMN = 1 * MiB, WS_KM = 2 * MiB, WS_VM = 3 * MiB, WS_KCMP = 4 * MiB, WS_VCMP = 5 * MiB, WS_TOK = 6 * MiB, WS_CMPB = 7 * MiB;
constexpr size_t WS_WQK = 8 * MiB, WS_VOT = 12 * MiB, WS_WIN = 16 * MiB, WS_WOUT = 40 * MiB, WS_WQ16 = 48 * MiB, WS_WKT = 56 * MiB, WS_WVT = 64 * MiB, WS_WOT = 72 * MiB;
constexpr size_t WS_WGU = 80 * MiB, WS_WD = 144 * MiB, WS_H = 176 * MiB, WS_Z = 240 * MiB, WS_ONSA = 432 * MiB, WS_END = 512 * MiB;
constexpr size_t WS_MIX = 112 * MiB, WS_P = WS_H, WS_H2 = WS_Z, WS_X1 = 304 * MiB, WS_S = WS_ONSA, WS_HID = 16 * MiB;
constexpr size_t WS_Y0 = 176 * MiB, WS_Y1 = 432 * MiB;
constexpr size_t WS_RS = 200 * MiB, WS_SBON = 232 * MiB;
constexpr size_t WS_WUPT = WS_CMPB + 64 * 1024, WS_AUPT = WS_WUPT + 128 * 1024, WS_GUPT = WS_AUPT + 128 * 1024;
constexpr size_t WS_W1T = 496 * MiB, WS_W2T = 498 * MiB, WS_CBIAS = 498 * MiB + 65536;
constexpr size_t WS_WRH = 499 * MiB, WS_WRL = 499 * MiB + 256 * 1024;
constexpr size_t RO_M = 0, RO_N = 32 * MiB, RO_Q = 64 * MiB, RO_Y = 96 * MiB;
constexpr size_t TK_E = 0, TK_W = 128 * 1024, TK_SLOT = 256 * 1024, TK_STOK = 384 * 1024, TK_SW = 576 * 1024;
constexpr int CW_BAR = 0;
constexpr int CW_Q = 3584;
constexpr int CW_CNT = 4096, CW_CUR = 4160, CW_OFF = 4224, CW_NT = 4288  , CW_NGU = 4289, CW_NDN = 4290;
constexpr int CW_UGU = 6144  , CW_UDN = 8192  ;
static_assert((CW_UDN + MAXTILES * 8 * 2) * 4 <= (int)CTL_ZERO_BYTES, "ctl");

constexpr int RING_BYTES = 131072, LDS_BYTES = 163840, MISC_OFF = LDS_BYTES - 512;

__device__ __forceinline__ unsigned pkh(float a, float b) { f16x2 v = {(f16)a, (f16)b}; return __builtin_bit_cast(unsigned, v); }
__device__ __forceinline__ float wave_sum(float v) {
#pragma unroll
    for (int o = 1; o < 64; o <<= 1) v += __shfl_xor(v, o);
    return v;
}
__device__ __forceinline__ float wave_max(float v) {
#pragma unroll
    for (int o = 1; o < 64; o <<= 1) v = fmaxf(v, __shfl_xor(v, o));
    return v;
}
__device__ __forceinline__ int opaque_tid() { int t = threadIdx.x; asm volatile("" : "+v"(t)); return t; }
#define LDS_WAIT() asm volatile("s_waitcnt lgkmcnt(0)" ::: "memory")
#define VM_WAIT() asm volatile("s_waitcnt vmcnt(0)" ::: "memory")
__device__ __forceinline__ float sigmoidf_(float x) { return 1.f / (1.f + __expf(-x)); }

namespace pg8 {
constexpr int BM = 256, BK = 64, HALF = 128, HTB = HALF * BK * 2, STAGE_BYTES = 8 * HTB, NXCD = 8, WGM = 8;
__host__ __device__ __forceinline__ int lds_byte(int r, int c) { const int st = (r >> 4) * 2 + (c >> 5), rr = r & 15, cc = c & 31, ob = rr * 64 + cc * 2; return st * 1024 + (ob ^ (((ob >> 9) & 1) << 5)); }
__host__ __device__ __forceinline__ void stage_rc(int b, int& R, int& C) { const int st = b / 1024, sb = b % 1024, swz = sb ^ (((sb >> 9) & 1) << 5); R = (st >> 1) * 16 + swz / 64; C = (st & 1) * 32 + (swz % 64) / 2; }
__host__ __device__ __forceinline__ int perm32(int rho) { const int n = rho >> 4, i = rho & 15; return 8 * (i >> 2) + 4 * n + (i & 3); }

struct Unit { int pm, pn; };
struct Gemm { const f16* A; const f16* Bt; int lda, ldb, K; const int* gather; };

struct StaticOrder {
    int nM, nN, nwg, G, c;
    __host__ __device__ void init(int M, int N, int G_, int c_) { nM = M / BM; nN = N / BM; nwg = nM * nN; G = G_; c = c_; }
    __host__ __device__ bool next(int i, Unit& u) const {
        const long L = (long)i * G + c; if (L >= nwg) return false;
        int wgid = (int)L; { const int q = nwg / NXCD, r = nwg % NXCD, xcd = wgid % NXCD, off = wgid / NXCD; wgid = (xcd < r ? xcd * (q + 1) : r * (q + 1) + (xcd - r) * q) + off; }
        const int nig = WGM * nN, gid = wgid / nig, fm = gid * WGM, gsz = (nM - fm) < WGM ? (nM - fm) : WGM;
        u.pm = fm + ((wgid % nig) % gsz); u.pn = (wgid % nig) / gsz; return true;
    }
};
struct TableOrder {
    const int2* tab; int n, G, c;
    __device__ bool next(int i, Unit& u) const { const int L = i * G + c; if (L >= n) return false; const int2 v = tab[L]; u.pm = v.x; u.pn = v.y; return true; }
};

struct EpiF16 {
    static constexpr bool PERM = true;
    f16* O; int ldc; float scale;
    __device__ __forceinline__ void operator()(const f32x4 (&acc)[2][2][4][2], const Unit& u, int wr, int wc, int fr, int fq) const {
        const int row0 = u.pm * BM + wr * 64 + fr, col0 = u.pn * BM + wc * 32 + 8 * fq;
#pragma unroll
        for (int ai = 0; ai < 2; ++ai)
#pragma unroll
            for (int m = 0; m < 4; ++m) { f16* rowp = O + (size_t)(row0 + ai * HALF + m * 16) * ldc + col0;
#pragma unroll
                for (int bj = 0; bj < 2; ++bj) { const f32x4 v0 = acc[ai][bj][m][0] * scale, v1 = acc[ai][bj][m][1] * scale;
                    u32x4 w; w.x = pkh(v0[0], v0[1]); w.y = pkh(v0[2], v0[3]); w.z = pkh(v1[0], v1[1]); w.w = pkh(v1[2], v1[3]);
                    *(u32x4*)(rowp + bj * HALF) = w; } }
    }
};
struct EpiF32 {
    static constexpr bool PERM = false;
    float* C; const float* R; int ldc;
    __device__ __forceinline__ void operator()(const f32x4 (&acc)[2][2][4][2], const Unit& u, int wr, int wc, int fr, int fq) const {
        const int row0 = u.pm * BM + wr * 64 + fr, col0 = u.pn * BM + wc * 32 + 4 * fq;
#pragma unroll
        for (int ai = 0; ai < 2; ++ai)
#pragma unroll
            for (int m = 0; m < 4; ++m) { const size_t ro = (size_t)(row0 + ai * HALF + m * 16) * ldc + col0;
#pragma unroll
                for (int bj = 0; bj < 2; ++bj)
#pragma unroll
                    for (int n = 0; n < 2; ++n) { f32x4 v = acc[ai][bj][m][n]; if (R) v = v + *(const f32x4*)(R + ro + bj * HALF + n * 16); *(f32x4*)(C + ro + bj * HALF + n * 16) = v; } }
    }
};
struct EpiSilu {
    static constexpr bool PERM = true;
    f16* O;
    __device__ __forceinline__ void operator()(const f32x4 (&acc)[2][2][4][2], const Unit& u, int wr, int wc, int fr, int fq) const {
        const int row0 = u.pm * BM + wr * 64 + fr, col0 = (u.pn & 1) * 128 + wc * 32 + 8 * fq;
#pragma unroll
        for (int ai = 0; ai < 2; ++ai)
#pragma unroll
            for (int m = 0; m < 4; ++m) { f16* rowp = O + (size_t)(row0 + ai * HALF + m * 16) * EFF + col0;
                float h[8];
#pragma unroll
                for (int n = 0; n < 2; ++n)
#pragma unroll
                    for (int e = 0; e < 4; ++e) { const float gt = acc[ai][0][m][n][e], up = acc[ai][1][m][n][e]; h[n * 4 + e] = gt / (1.f + __expf(-gt)) * up; }
                u32x4 w; w.x = pkh(h[0], h[1]); w.y = pkh(h[2], h[3]); w.z = pkh(h[4], h[5]); w.w = pkh(h[6], h[7]);
                *(u32x4*)rowp = w; }
    }
};
struct EpiDown {
    static constexpr bool PERM = true;
    unsigned char* ws;
    __device__ __forceinline__ void operator()(const f32x4 (&acc)[2][2][4][2], const Unit& u, int wr, int wc, int fr, int fq) const {
        f16* tile = (f16*)(ws + (u.pm < 128 ? WS_Y0 + (size_t)u.pm * MiB : WS_Y1 + (size_t)(u.pm - 128) * MiB));
        const int r0 = wr * 64 + fr, col0 = (u.pn & 7) * BM + wc * 32 + 8 * fq;
#pragma unroll
        for (int ai = 0; ai < 2; ++ai)
#pragma unroll
            for (int m = 0; m < 4; ++m) { f16* rowp = tile + (size_t)(r0 + ai * HALF + m * 16) * D + col0;
#pragma unroll
                for (int bj = 0; bj < 2; ++bj) { const f32x4 v0 = acc[ai][bj][m][0], v1 = acc[ai][bj][m][1];
                    u32x4 w; w.x = pkh(v0[0], v0[1]); w.y = pkh(v0[2], v0[3]); w.z = pkh(v1[0], v1[1]); w.w = pkh(v1[2], v1[3]);
                    *(u32x4*)(rowp + bj * HALF) = w; } }
    }
};

template <class Epi, class Sched, bool ALIGN_EPI, bool GATHER = false>
__device__ __forceinline__ void gemm_phase(LAS unsigned char* lds, const Gemm g, const Sched& S, const Epi& E) {
    const int tid = opaque_tid(), wid = __builtin_amdgcn_readfirstlane(tid >> 6), lane = tid & 63, wr = wid >> 2, wc = wid & 3, fr = lane & 15, fq = lane >> 4;
    const int K = g.K, nt = K / BK;
    int RA[2], CA[2]; unsigned voffA[2], voffB[2];
#pragma unroll
    for (int i = 0; i < 2; ++i) { int R, C; stage_rc(tid * 16 + i * 8192, R, C); const int Rb = Epi::PERM ? ((R & ~31) + perm32(R & 31)) : R;
        RA[i] = R; CA[i] = C; voffA[i] = (unsigned)(R * g.lda + C) * 2u; voffB[i] = (unsigned)(Rb * g.ldb + C) * 2u; }
    const size_t kstep = (size_t)(BK * 2);
    const size_t hstepA = (size_t)HALF * g.lda * 2, tstepA = 2 * hstepA;
    const size_t hstepB = (size_t)HALF * g.ldb * 2, tstepB = 2 * hstepB;
    const unsigned ldsw = (unsigned)wid * 1024u;
    const int aoff = lds_byte(wr * 64 + fr, fq * 8), boff = lds_byte(wc * 32 + fr, fq * 8);
    const char* Ab = (const char*)g.A;
#define PG8_SA(b, h) (((b) * 2 + (h)) * HTB)
#define PG8_SB(b, h) ((4 + (b) * 2 + (h)) * HTB)
#define PG8_STAGE(bufoff, gbase, voff) do { _Pragma("unroll") for (int _i = 0; _i < 2; ++_i) \
        __builtin_amdgcn_global_load_lds((const unsigned*)((const char*)(gbase) + (voff)[_i]), (LAS unsigned*)(lds + (bufoff) + ldsw + _i * 8192), 16, 0, 0); } while (0)
#define PG8_STA_CUR(bufoff, h, kb) do { if constexpr (GATHER) { PG8_STAGE(bufoff, Ab + (kb), offC[h]); } else { PG8_STAGE(bufoff, cA + (h) * hstepA + (kb), voffA); } } while (0)
#define PG8_STA_SEL(bufoff, h, kb) do { if constexpr (GATHER) { PG8_STAGE(bufoff, Ab + (kb), o2[h]); } else { PG8_STAGE(bufoff, a2p + (h) * hstepA + (kb), voffA); } } while (0)
#define PG8_LDA(dst, b, h) do { _Pragma("unroll") for (int m = 0; m < 4; ++m) _Pragma("unroll") for (int k = 0; k < 2; ++k) dst[m][k] = *(const LAS f16x8*)(lds + PG8_SA(b, h) + aoff + m * 2048 + k * 1024); } while (0)
#define PG8_LDB(dst, b, h) do { _Pragma("unroll") for (int n = 0; n < 2; ++n) _Pragma("unroll") for (int k = 0; k < 2; ++k) dst[n][k] = *(const LAS f16x8*)(lds + PG8_SB(b, h) + boff + n * 2048 + k * 1024); } while (0)
#define PG8_MMA(ai, bj, At, Bt) do { __builtin_amdgcn_s_setprio(1); _Pragma("unroll") for (int m = 0; m < 4; ++m) _Pragma("unroll") for (int n = 0; n < 2; ++n) _Pragma("unroll") for (int k = 0; k < 2; ++k) \
        acc[ai][bj][m][n] = __builtin_amdgcn_mfma_f32_16x16x32_f16(Bt[n][k], At[m][k], acc[ai][bj][m][n], 0, 0, 0); __builtin_amdgcn_s_setprio(0); } while (0)
#define PG8_WAIT_V(n) asm volatile("s_waitcnt vmcnt(" #n ")" ::: "memory")
#define PG8_WAIT_L(n) asm volatile("s_waitcnt lgkmcnt(" #n ")" ::: "memory")
#define PG8_BAR __builtin_amdgcn_s_barrier()
#define PG8_SCHED __builtin_amdgcn_sched_barrier(0)
#define PG8_OFFS(dst, U) do { _Pragma("unroll") for (int _h = 0; _h < 2; ++_h) _Pragma("unroll") for (int _i = 0; _i < 2; ++_i) { \
        const int _r = (U).pm * BM + _h * HALF + RA[_i]; dst[_h][_i] = ((unsigned)g.gather[_r] * (unsigned)g.lda + (unsigned)CA[_i]) * 2u; } } while (0)
    Unit cur, nxt; int ui = 0;
    if (!S.next(0, cur)) return;
    f32x4 acc[2][2][4][2];
#pragma unroll
    for (int a = 0; a < 2; ++a)
#pragma unroll
        for (int b = 0; b < 2; ++b)
#pragma unroll
            for (int m = 0; m < 4; ++m)
#pragma unroll
                for (int n = 0; n < 2; ++n) acc[a][b][m][n] = (f32x4){0.f, 0.f, 0.f, 0.f};
    f16x8 At[4][2], B0[2][2], B1[2][2];
    unsigned offC[2][2], offN[2][2];
    if constexpr (GATHER) { PG8_OFFS(offC, cur); }
    const char* cA = Ab + (size_t)cur.pm * tstepA;
    const char* cB = (const char*)g.Bt + (size_t)cur.pn * tstepB;
    PG8_STAGE(PG8_SB(0, 0), cB, voffB); PG8_STAGE(PG8_SB(0, 1), cB + hstepB, voffB); PG8_STA_CUR(PG8_SA(0, 0), 0, 0); PG8_STA_CUR(PG8_SA(0, 1), 1, 0);
    if (wr == 1) PG8_BAR;
    PG8_WAIT_V(2); PG8_BAR;
    PG8_STAGE(PG8_SB(1, 0), cB + kstep, voffB); PG8_STA_CUR(PG8_SA(1, 0), 0, kstep); PG8_STAGE(PG8_SB(1, 1), cB + hstepB + kstep, voffB);
    PG8_WAIT_V(6); PG8_BAR;
    for (;;) {
        const bool has_next = S.next(ui + 1, nxt);
        if constexpr (GATHER) {
            if (has_next) { PG8_OFFS(offN, nxt); } else {
#pragma unroll
                for (int _h = 0; _h < 2; ++_h)
#pragma unroll
                    for (int _i = 0; _i < 2; ++_i) offN[_h][_i] = offC[_h][_i]; } }
        const char* nA = has_next ? Ab + (size_t)nxt.pm * tstepA : cA;
        const char* nB = has_next ? (const char*)g.Bt + (size_t)nxt.pn * tstepB : cB;
#pragma nounroll
        for (int t = 0; t < nt; t += 2) {
            const bool last = (t == nt - 2);
            const size_t kb1 = (size_t)(t + 1) * kstep;
            const size_t kb2 = last ? 0 : (size_t)(t + 2) * kstep, kb3 = kb2 + kstep;
            unsigned o2[2][2];
            if constexpr (GATHER) {
#pragma unroll
                for (int _h = 0; _h < 2; ++_h)
#pragma unroll
                    for (int _i = 0; _i < 2; ++_i) o2[_h][_i] = last ? offN[_h][_i] : offC[_h][_i]; }
            const char* a2p = last ? nA : cA;
            const char* b2 = last ? nB : cB + (size_t)(t + 2) * kstep; const char* b3 = b2 + kstep;
            PG8_LDB(B0, 0, 0); PG8_LDB(B1, 0, 1); PG8_SCHED; PG8_LDA(At, 0, 0); PG8_STA_CUR(PG8_SA(1, 1), 1, kb1);
            PG8_WAIT_V(8); PG8_WAIT_L(0); PG8_BAR; PG8_MMA(0, 0, At, B0); PG8_MMA(0, 1, At, B1); PG8_BAR; PG8_SCHED;
            PG8_LDA(At, 0, 1); PG8_STAGE(PG8_SB(0, 0), b2, voffB); PG8_STAGE(PG8_SB(0, 1), b2 + hstepB, voffB); PG8_STA_SEL(PG8_SA(0, 0), 0, kb2);
            PG8_WAIT_V(8); PG8_WAIT_L(0); PG8_BAR; PG8_MMA(1, 0, At, B0); PG8_MMA(1, 1, At, B1); PG8_BAR; PG8_SCHED;
            PG8_LDB(B0, 1, 0); PG8_LDB(B1, 1, 1); PG8_SCHED; PG8_LDA(At, 1, 0); PG8_STA_SEL(PG8_SA(0, 1), 1, kb2);
            PG8_WAIT_V(8); PG8_WAIT_L(0); PG8_BAR; PG8_MMA(0, 0, At, B0); PG8_MMA(0, 1, At, B1); PG8_BAR; PG8_SCHED;
            PG8_LDA(At, 1, 1); PG8_STAGE(PG8_SB(1, 0), b3, voffB); PG8_STAGE(PG8_SB(1, 1), b3 + hstepB, voffB); PG8_STA_SEL(PG8_SA(1, 0), 0, kb3);
            PG8_WAIT_V(8); PG8_WAIT_L(0); PG8_BAR; PG8_MMA(1, 0, At, B0); PG8_MMA(1, 1, At, B1); PG8_BAR; PG8_SCHED;
        }
        if constexpr (ALIGN_EPI) { if (wr == 0) PG8_BAR; }
        E(acc, cur, wr, wc, fr, fq);
        if (!has_next) break;
#pragma unroll
        for (int a = 0; a < 2; ++a)
#pragma unroll
            for (int b = 0; b < 2; ++b)
#pragma unroll
                for (int m = 0; m < 4; ++m)
#pragma unroll
                    for (int n = 0; n < 2; ++n) acc[a][b][m][n] = (f32x4){0.f, 0.f, 0.f, 0.f};
        cur = nxt; cA = nA; cB = nB; ++ui;
        if constexpr (GATHER) {
#pragma unroll
            for (int _h = 0; _h < 2; ++_h)
#pragma unroll
                for (int _i = 0; _i < 2; ++_i) offC[_h][_i] = offN[_h][_i]; }
        if constexpr (ALIGN_EPI) { if (wr == 1) PG8_BAR; }
    }
    PG8_WAIT_V(0);
    if constexpr (!ALIGN_EPI) { if (wr == 0) PG8_BAR; }
    PG8_BAR;
#undef PG8_SA
#undef PG8_SB
#undef PG8_STAGE
#undef PG8_STA_CUR
#undef PG8_STA_SEL
#undef PG8_LDA
#undef PG8_LDB
#undef PG8_MMA
#undef PG8_WAIT_V
#undef PG8_WAIT_L
#undef PG8_BAR
#undef PG8_SCHED
#undef PG8_OFFS
}
}

#define XB_TMO      128
#define XB_XCNT(j)  (256  + 64 * (j))
#define XB_XSUB(j)  (1280 + 64 * (j))
#define XB_XGEN(j)  (2304 + 64 * (j))
#define XB_TOP      3328
#define XB_TOPGEN   3392
#define XCD_BAR_WORDS 3456
#define XB_SPIN_CAP (1u << 22)
__device__ __forceinline__ unsigned xb_ld(unsigned* p)              { return __hip_atomic_load(p, __ATOMIC_RELAXED, __HIP_MEMORY_SCOPE_AGENT); }
__device__ __forceinline__ unsigned xb_add(unsigned* p, unsigned v) { return __hip_atomic_fetch_add(p, v, __ATOMIC_RELAXED, __HIP_MEMORY_SCOPE_AGENT); }
__device__ __forceinline__ unsigned xb_xcc_id() { return (unsigned)__builtin_amdgcn_s_getreg((3 << 11) | 20) & 0xFu; }
#define XB_SPIN(cond, bar) do { unsigned _sp = 0; while (cond) { __builtin_amdgcn_s_sleep(1); \
    if ((++_sp & 255u) == 0u) { if (xb_ld(&(bar)[XB_TMO])) break; if (_sp > XB_SPIN_CAP) { atomicAdd(&(bar)[XB_TMO], 1u); break; } } } } while (0)
struct XcdBarrier { unsigned* bar; unsigned x; volatile LAS unsigned* st; };
__device__ __forceinline__ XcdBarrier xcd_barrier_post(unsigned* bar, volatile LAS unsigned* st) {
    XcdBarrier b; b.bar = bar; b.x = xb_xcc_id(); b.st = st;
    if (threadIdx.x == 0) (void)xb_add(&bar[XB_XCNT(b.x)], 1u);
    return b;
}
__device__ __forceinline__ void xcd_barrier_complete(unsigned* bar, unsigned x, unsigned& nloc, unsigned& nx) {
    const unsigned G = gridDim.x * gridDim.y * gridDim.z;
    unsigned sum, cnt, mine, sp = 0u;
    for (;;) {
        sum = 0u; cnt = 0u; mine = 0u;
#pragma unroll
        for (unsigned j = 0; j < 16; ++j) { const unsigned c = xb_ld(&bar[XB_XCNT(j)]); sum += c; cnt += (c > 0u) ? 1u : 0u; mine = (j == x) ? c : mine; }
        if (sum == G) break;
        __builtin_amdgcn_s_sleep(1);
        if ((++sp & 255u) == 0u) { if (xb_ld(&bar[XB_TMO])) break; if (sp > XB_SPIN_CAP) { atomicAdd(&bar[XB_TMO], 1u); break; } }
    }
    nloc = mine > 0u ? mine : 1u; nx = cnt > 0u ? cnt : 1u;
}
__device__ __forceinline__ void xcd_barrier(const XcdBarrier& b) {
    asm volatile("s_waitcnt vmcnt(0)" ::: "memory");
    __syncthreads();
    if (threadIdx.x == 0) {
        unsigned* bar = b.bar;
        __builtin_amdgcn_s_waitcnt(0);
        unsigned nloc = b.st[0], nx = b.st[1];
        if (nloc == 0u) { xcd_barrier_complete(bar, b.x, nloc, nx); b.st[0] = nloc; b.st[1] = nx; }
        const unsigned old = xb_add(&bar[XB_XSUB(b.x)], 1u);
        const unsigned gen = old / nloc;
        if (old + 1u == (gen + 1u) * nloc) {
            __builtin_amdgcn_fence(__ATOMIC_RELEASE, "agent");
            asm volatile("s_waitcnt vmcnt(0)" ::: "memory");
            const unsigned og = xb_add(&bar[XB_TOP], 1u);
            const unsigned tg = og / nx;
            if (og + 1u == (tg + 1u) * nx) xb_add(&bar[XB_TOPGEN], 1u);
            else XB_SPIN(xb_ld(&bar[XB_TOPGEN]) == tg, bar);
            __builtin_amdgcn_fence(__ATOMIC_ACQUIRE, "agent");
            xb_add(&bar[XB_XGEN(b.x)], 1u);
            asm volatile("s_waitcnt vmcnt(0)" ::: "memory");
        } else {
            XB_SPIN(xb_ld(&bar[XB_XGEN(b.x)]) == gen, bar);
            __builtin_amdgcn_fence(__ATOMIC_ACQUIRE, "agent");
            asm volatile("s_waitcnt vmcnt(0)" ::: "memory");
        }
    }
    __syncthreads();
}

struct Args { const float* in[38]; float* out; unsigned char* ws; int ph_lo, ph_hi; };
enum { I_X = 0, I_MEM, I_LN1, I_WIN, I_PK, I_W1K, I_W2K, I_PV, I_W1V, I_W2V, I_NSAG, I_MU, I_W0, I_WUP, I_A0, I_AUP, I_GUP, I_KK, I_KA, I_RK, I_LNXG, I_LNXB,
       I_WOUT, I_LNMEM, I_LN2, I_WQ, I_WK, I_WV, I_WO, I_LN3, I_RGW, I_RGB, I_REW, I_REB, I_MG, I_MU2, I_MD, I_LNF };

__device__ __forceinline__ void tr_item(const float* src, int sld, int k0, int scol0, int nvalid, f16* dst, size_t drow0, int dld, LAS float* scr, int lane) {
    const int nl = lane & 31;
    float tv[32];
#pragma unroll
    for (int i = 0; i < 32; ++i) { const int kk = 2 * i + (lane >> 5); tv[i] = (nl < nvalid) ? src[(size_t)(k0 + kk) * sld + scol0 + nl] : 0.f; }
#pragma unroll
    for (int i = 0; i < 32; ++i) { const int kk = 2 * i + (lane >> 5); scr[kk * 33 + nl] = tv[i]; }
    LDS_WAIT(); asm volatile("" ::: "memory");
    const int c = lane & 7;
#pragma unroll
    for (int j = 0; j < 4; ++j) { const int n = (lane >> 3) + 8 * j; const LAS float* s = scr + (8 * c) * 33 + n;
        u32x4 o; o.x = pkh(s[0 * 33], s[1 * 33]); o.y = pkh(s[2 * 33], s[3 * 33]); o.z = pkh(s[4 * 33], s[5 * 33]); o.w = pkh(s[6 * 33], s[7 * 33]);
        *(u32x4*)(dst + (drow0 + n) * (size_t)dld + k0 + 8 * c) = o; }
    LDS_WAIT(); asm volatile("" ::: "memory");
}
__device__ __forceinline__ void tr_matrix(const float* src, int K, int N, f16* dst, LAS float* scr, int gw, int NGW, int lane) {
    const int nblk = N / 32, items = (K / 64) * nblk;
    for (int it = gw; it < items; it += NGW) { const int kb = it / nblk, nb = it % nblk; tr_item(src, N, kb * 64, nb * 32, 32, dst, (size_t)nb * 32, K, scr, lane); }
}
__device__ __forceinline__ void rms_row(const float* xrow, const float* gain, f16* o16, int lane) {
    const f32x4* xr = (const f32x4*)xrow + lane; f32x4 v[8]; float s = 0.f;
#pragma unroll
    for (int j = 0; j < 8; ++j) { v[j] = xr[64 * j]; s += v[j].x * v[j].x + v[j].y * v[j].y + v[j].z * v[j].z + v[j].w * v[j].w; }
    const f32x4* gr = (const f32x4*)gain + lane; f32x4 gg[8];
#pragma unroll
    for (int j = 0; j < 8; ++j) gg[j] = gr[64 * j];
    const float rstd = rsqrtf(wave_sum(s) * (1.f / D) + EPS);
    u32x2* o8 = (u32x2*)o16 + lane;
#pragma unroll
    for (int j = 0; j < 8; ++j) { u32x2 w; w.x = pkh(v[j].x * rstd * gg[j].x, v[j].y * rstd * gg[j].y); w.y = pkh(v[j].z * rstd * gg[j].z, v[j].w * rstd * gg[j].w); o8[64 * j] = w; }
}

__device__ __forceinline__ void p0_prologue(const Args& a, LAS unsigned char* lds) {
    const int tid = opaque_tid(), lane = tid & 63, wave = tid >> 6;
    const int gw = blockIdx.x * 8 + wave, NGW = gridDim.x * 8;
    LAS float* scr = (LAS float*)(lds + wave * 16384);
    unsigned char* ws = a.ws;
    { f16* dst = (f16*)(ws + WS_WIN); const float* src = a.in[I_WIN];
      const int nblk = NZ / 32, items = (D / 64) * nblk;
      for (int it = gw; it < items; it += NGW) { const int kb = it / nblk, nb = it % nblk, n0 = nb * 32;
          int sc = 0, nv = 32; if (n0 < 2560) sc = n0; else if (n0 < 5920) sc = n0 + 24; else if (n0 == 5920) { sc = 2560; nv = 24; } else { sc = 0; nv = 0; }
          tr_item(src, 5944, kb * 64, sc, nv, dst, (size_t)n0, D, scr, lane); } }
    tr_matrix(a.in[I_WOUT], D, D, (f16*)(ws + WS_WOUT), scr, gw, NGW, lane);
    tr_matrix(a.in[I_WK], D, D, (f16*)(ws + WS_WKT), scr, gw, NGW, lane);
    tr_matrix(a.in[I_WV], D, D, (f16*)(ws + WS_WVT), scr, gw, NGW, lane);
    tr_matrix(a.in[I_WO], D, D, (f16*)(ws + WS_WOT), scr, gw, NGW, lane);
    { const f32x4* s = (const f32x4*)a.in[I_WQ]; u32x2* d = (u32x2*)(ws + WS_WQ16);
      for (size_t i = (size_t)blockIdx.x * 512 + tid; i < (size_t)D * D / 4; i += (size_t)gridDim.x * 512) { const f32x4 v = s[i]; u32x2 w; w.x = pkh(v.x, v.y); w.y = pkh(v.z, v.w); d[i] = w; } }
    tr_matrix(a.in[I_W1K], 4096, 128, (f16*)(ws + WS_W1T), scr, gw, NGW, lane);
    tr_matrix(a.in[I_W1V], 4096, 128, (f16*)(ws + WS_W1T) + 128 * 4096, scr, gw, NGW, lane);
    tr_matrix(a.in[I_W2K], 128, 128, (f16*)(ws + WS_W2T), scr, gw, NGW, lane);
    tr_matrix(a.in[I_W2V], 128, 128, (f16*)(ws + WS_W2T) + 128 * 128, scr, gw, NGW, lane);
    for (int o = gw; o < 256; o += NGW) { const int kv = o >> 7, n = o & 127; const float* pos = a.in[kv ? I_PV : I_PK]; const float* w1 = a.in[kv ? I_W1V : I_W1K]; float acc = 0.f;
        for (int k = lane; k < 4096; k += 64) acc += pos[k] * w1[(size_t)k * 128 + n];
        acc = wave_sum(acc); if (lane == 0) ((float*)(ws + WS_CBIAS))[o] = acc; }
    for (int i = blockIdx.x * 512 + tid; i < 48 * D; i += gridDim.x * 512) { const int c = i / D, k = i % D; float v = 0.f;
        if (c < 4) v = a.in[I_RGW][k * 4 + c]; else if (c < 36) v = a.in[I_REW][k * 32 + (c - 4)];
        v *= a.in[I_LN3][k]; const f16 hi = (f16)v; ((f16*)(ws + WS_WRH))[i] = hi; ((f16*)(ws + WS_WRL))[i] = (f16)(v - (float)hi); }
    { bf16* wu = (bf16*)(ws + WS_WUPT); bf16* au = (bf16*)(ws + WS_AUPT); bf16* gu = (bf16*)(ws + WS_GUPT);
      for (int i = blockIdx.x * 512 + tid; i < 1024 * 64; i += gridDim.x * 512) { const int ch = i >> 6, j = i & 63; wu[i] = (bf16)a.in[I_WUP][j * 1024 + ch]; au[i] = (bf16)a.in[I_AUP][j * 1024 + ch]; }
      for (int i = blockIdx.x * 512 + tid; i < 1024 * 160; i += gridDim.x * 512) { const int ch = i / 160, j = i % 160; gu[i] = (bf16)a.in[I_GUP][j * 1024 + ch]; } }
    for (int m = gw; m < T; m += NGW) rms_row(a.in[I_X] + (size_t)m * D, a.in[I_LN1], (f16*)(ws + WS_H) + (size_t)m * D, lane);
    for (int m = gw; m < 256; m += NGW) rms_row(a.in[I_MEM] + (size_t)m * D, a.in[I_LNMEM], (f16*)(ws + WS_MEMN) + (size_t)m * D, lane);
}

__device__ __forceinline__ void p_moe_weights(const Args& a, LAS unsigned char* lds) {
    const int tid = opaque_tid(), lane = tid & 63, wave = tid >> 6;
    const int gw = blockIdx.x * 8 + wave, NGW = gridDim.x * 8;
    LAS float* scr = (LAS float*)(lds + wave * 16384);
    unsigned char* ws = a.ws;
    { f16* dst = (f16*)(ws + WS_WGU); const int items = NEXP * (D / 64) * 16;
      for (int it = gw; it < items; it += NGW) { const int e = it / ((D / 64) * 16), r = it % ((D / 64) * 16), kb = r / 16, nb = r % 16, j0 = nb * 32, jt = j0 / 256, jj = j0 % 256;
          const float* src = (jj < 128 ? a.in[I_MG] : a.in[I_MU2]) + (size_t)e * D * EFF; const int sc = jt * 128 + (jj & 127);
          tr_item(src, EFF, kb * 64, sc, 32, dst, (size_t)e * 512 + j0, D, scr, lane); } }
    { f16* dst = (f16*)(ws + WS_WD); const int items = NEXP * (EFF / 64) * (D / 32);
      for (int it = gw; it < items; it += NGW) { const int e = it / ((EFF / 64) * (D / 32)), r = it % ((EFF / 64) * (D / 32)), kb = r / (D / 32), nb = r % (D / 32);
          tr_item(a.in[I_MD] + (size_t)e * EFF * D, D, kb * 64, nb * 32, 32, dst, (size_t)e * D + nb * 32, EFF, scr, lane); } }
}

__device__ __forceinline__ float gelu_tanh(float x) { const float u = 0.7978845608028654f * (x + 0.044715f * x * x * x); const float e = __expf(2.f * u); return 0.5f * x * (2.f - 2.f / (e + 1.f)); }
constexpr int CP_RS = 272, CP_HS = 136, CP_HID = 272 * CP_RS;
__device__ __forceinline__ void p_compress(const Args& a, LAS unsigned char* lds) {
    const int tid = opaque_tid(), lane = tid & 63, w = __builtin_amdgcn_readfirstlane(tid >> 6);
    const f16* z = (const f16*)(a.ws + WS_Z);
    LAS f16* HID = (LAS f16*)(lds + CP_HID);
    for (int it = blockIdx.x; it < 256; it += gridDim.x) {
        const int kv = it >> 7, g = (it >> 6) & 1, c0 = (it & 63) * 16, tok0 = 16 * c0;
        const int zc = (kv ? ZVC : ZKC) + g * 128;
        __syncthreads();
        for (int ck = tid; ck < 272 * 16; ck += 512) { const int tl = ck >> 4, c16 = ck & 15, tok = tok0 + tl; const int rp = (tl & 15) * 17 + (tl >> 4);
            u32x4 v = {0u, 0u, 0u, 0u}; if (tok < T) v = *(const u32x4*)(z + (size_t)tok * NZ + zc + c16 * 8);
            *(LAS u32x4*)(lds + rp * CP_RS + c16 * 16) = v; }
        __syncthreads();
        f32x4 acc = {0.f, 0.f, 0.f, 0.f};
        const f16* wp = (const f16*)(a.ws + WS_W1T) + ((size_t)kv * 128 + 16 * w + (lane & 15)) * 4096 + 8 * (lane >> 4);
        const LAS unsigned char* ap = lds + (lane & 15) * CP_RS + 16 * (lane >> 4);
#pragma unroll 8
        for (int ks = 0; ks < 128; ++ks) { const int l = ks >> 2;
            const f16x8 av = *(const LAS f16x8*)(ap + ((l & 15) * 17 + (l >> 4)) * CP_RS + (ks & 3) * 64);
            const f16x8 bv = *(const f16x8*)(wp + 32 * ks);
            acc = __builtin_amdgcn_mfma_f32_16x16x32_f16(av, bv, acc, 0, 0, 0); }
        { const int n = 16 * w + (lane & 15); const float bs = ((const float*)(a.ws + WS_CBIAS))[kv * 128 + n];
#pragma unroll
          for (int r = 0; r < 4; ++r) HID[(4 * (lane >> 4) + r) * CP_HS + n] = (f16)gelu_tanh(acc[r] + bs); }
        __syncthreads();
        f32x4 o = {0.f, 0.f, 0.f, 0.f};
        const f16* w2p = (const f16*)(a.ws + WS_W2T) + ((size_t)kv * 128 + 16 * w + (lane & 15)) * 128 + 8 * (lane >> 4);
#pragma unroll
        for (int ks = 0; ks < 4; ++ks) { const f16x8 av = *(const LAS f16x8*)(HID + (lane & 15) * CP_HS + 32 * ks + 8 * (lane >> 4)); const f16x8 bv = *(const f16x8*)(w2p + 32 * ks);
            o = __builtin_amdgcn_mfma_f32_16x16x32_f16(av, bv, o, 0, 0, 0); }
        f16* dst = (f16*)(a.ws + (kv ? WS_VCMP : WS_KCMP));
#pragma unroll
        for (int r = 0; r < 4; ++r) { const int c = c0 + 4 * (lane >> 4) + r; dst[((size_t)c * 2 + g) * 128 + 16 * w + (lane & 15)] = c < NCMP ? (f16)o[r] : (f16)0.f; }
    }
}

typedef float f32x16 __attribute__((ext_vector_type(16)));
typedef short v4i16_t __attribute__((ext_vector_type(4)));
constexpr int NS_PSEL = 65536, NS_PSTR = 257, NS_SELB = NS_PSEL + 64 * NS_PSTR * 4, NS_WANY = NS_SELB + 2048, NS_LIST = NS_WANY + 256, NS_CNT = NS_LIST + 512, NS_UNIT = NS_CNT + 64;
static_assert(NS_UNIT + 64 <= MISC_OFF, "nsa lds");
__device__ __forceinline__ unsigned offb(unsigned row, unsigned ch) { return 256u * row + 16u * (ch ^ (((row & 3u) << 2) | ((row >> 2) & 3u))); }
__device__ __forceinline__ void glds16(const void* gsrc, unsigned lds_dst) { unsigned keep;
    asm volatile("s_mov_b32 %0, m0\n\ts_mov_b32 m0, %2\n\ts_nop 0\n\tglobal_load_lds_dwordx4 %1, off\n\ts_mov_b32 m0, %0" : "=&s"(keep) : "v"(gsrc), "s"(lds_dst) : "memory"); }
__device__ __forceinline__ void ns_dma(const f16* g0, size_t gstride, unsigned lds_addr, int wv, int lane) {
#pragma unroll
    for (int i = 0; i < 2; ++i) { const int piece = wv * 2 + i, row = 4 * piece + (lane >> 4), slot = lane & 15, ch = slot ^ (((row & 3) << 2) | ((row >> 2) & 3));
        glds16(g0 + (size_t)row * gstride + ch * 8, lds_addr + piece * 1024); }
}
#define NS_VMW(n) asm volatile("s_waitcnt vmcnt(" #n ")" ::: "memory")
__device__ __forceinline__ void ns_qk(f32x16& s0, f32x16& s1, const LAS unsigned char* kb, const f16x8 (&qf)[8], int rho_, int hh_, float init) {
    unsigned rho = (unsigned)rho_, hh = (unsigned)hh_;
    asm volatile("" : "+v"(rho), "+v"(hh));
    const unsigned xr = ((rho & 3u) << 2) | ((rho >> 2) & 3u);
    const LAS unsigned char* kbase = kb + 256u * rho + 16u * ((hh ^ xr) & 1u); const unsigned xs = xr >> 1;
#pragma unroll
    for (int i = 0; i < 16; ++i) { s0[i] = init; s1[i] = init; }
    f16x8 af[8];
#pragma unroll
    for (int s = 0; s < 8; ++s) af[s] = *(const LAS f16x8*)(kbase + 32u * ((unsigned)s ^ xs));
#pragma unroll
    for (int s = 0; s < 8; ++s) s0 = __builtin_amdgcn_mfma_f32_32x32x16_f16(af[s], qf[s], s0, 0, 0, 0);
#pragma unroll
    for (int s = 0; s < 8; ++s) af[s] = *(const LAS f16x8*)(kbase + 32u * ((unsigned)s ^ xs) + 8192);
#pragma unroll
    for (int s = 0; s < 8; ++s) s1 = __builtin_amdgcn_mfma_f32_32x32x16_f16(af[s], qf[s], s1, 0, 0, 0);
}
__device__ __forceinline__ void ns_pv(f32x16 (&O)[4], const LAS unsigned char* vb, const f32x16& p0, const f32x16& p1, int lane_) {
    unsigned lane = (unsigned)lane_;
    asm volatile("" : "+v"(lane));
    const unsigned hh = lane >> 5, blk = (lane >> 4) & 1, q = (lane & 15) >> 2, pp = lane & 3;
    const unsigned x = 2 * blk + (pp >> 1);
    const LAS unsigned char* vbase[2];
#pragma unroll
    for (int t = 0; t < 2; ++t) { const unsigned w = (hh + 2 * t) & 3u; vbase[t] = vb + 256u * (4 * hh + 8 * t + q) + 16u * (x ^ w) + 8u * (pp & 1); }
    f16x8 pf[4];
#pragma unroll
    for (int kh = 0; kh < 2; ++kh)
#pragma unroll
        for (int sp = 0; sp < 2; ++sp)
#pragma unroll
            for (int j = 0; j < 8; ++j) pf[kh * 2 + sp][j] = (f16)(kh ? p1[8 * sp + j] : p0[8 * sp + j]);
#pragma unroll
    for (int c = 0; c < 4; ++c) { const unsigned cq = 64u * ((unsigned)c ^ q);
        const LAS unsigned char* b0 = vbase[0] + cq; const LAS unsigned char* b1 = vbase[1] + cq;
#pragma unroll
        for (int kh = 0; kh < 2; ++kh)
#pragma unroll
            for (int sp = 0; sp < 2; ++sp) {
                const v4i16_t lo = __builtin_amdgcn_ds_read_tr16_b64_v4i16((LAS v4i16_t*)(b0 + 256 * (32 * kh + 16 * sp)));
                const v4i16_t hi = __builtin_amdgcn_ds_read_tr16_b64_v4i16((LAS v4i16_t*)(b1 + 256 * (32 * kh + 16 * sp)));
                typedef short s16x8 __attribute__((ext_vector_type(8)));
                const s16x8 v8 = {lo[0], lo[1], lo[2], lo[3], hi[0], hi[1], hi[2], hi[3]};
                O[c] = __builtin_amdgcn_mfma_f32_32x32x16_f16(__builtin_bit_cast(f16x8, v8), pf[kh * 2 + sp], O[c], 0, 0, 0); }
    }
}
#define NS_KIDX(r, hh) ((int)(((r) & 3) + 8 * ((r) >> 2) + 4 * (hh)))
constexpr float NS_THR = 6.f;
template <bool WITH_O> __device__ __forceinline__ void ns_online(f32x16& y0, f32x16& y1, float& m, float& l, bool& seen, f32x16 (&O)[4]) {
    float mx = fmaxf(y0[0], y1[0]);
#pragma unroll
    for (int i = 1; i < 16; ++i) mx = fmaxf(mx, fmaxf(y0[i], y1[i]));
    mx = fmaxf(mx, __shfl_xor(mx, 32));
    const bool fin = mx > -INFINITY, first = !seen && fin;
    if (__any(first || mx > NS_THR)) {
        const float d = first ? mx : (mx > NS_THR ? mx : 0.f), alpha = __builtin_amdgcn_exp2f(-d);
        seen = seen || fin; m += d; l *= alpha;
        if (WITH_O) {
#pragma unroll
            for (int c = 0; c < 4; ++c) O[c] = O[c] * alpha; }
#pragma unroll
        for (int i = 0; i < 16; ++i) { y0[i] -= d; y1[i] -= d; }
    }
    float ls = 0.f;
#pragma unroll
    for (int i = 0; i < 16; ++i) { y0[i] = __builtin_amdgcn_exp2f(y0[i]); y1[i] = __builtin_amdgcn_exp2f(y1[i]); ls += y0[i] + y1[i]; }
    l += ls;
}
#define NS_ISSUE(j, NSL, HASV) do { const unsigned sa_ = lds_a + (unsigned)(((j) & ((NSL) - 1)) * 32768); ns_dma(NS_KPTR(j), NS_STRIDE, sa_, w, lane); if (HASV) ns_dma(NS_VPTR(j), NS_STRIDE, sa_ + 16384u, w, lane); } while (0)
#define NS_WAIT(nb, HASV) do { if (HASV) { if ((nb) >= 2) NS_VMW(8); else if ((nb) == 1) NS_VMW(4); else NS_VMW(0); } else { if ((nb) >= 2) NS_VMW(4); else if ((nb) == 1) NS_VMW(2); else NS_VMW(0); } } while (0)
#define NS_PROLOGUE(n, NSL, HASV) do { const int q_ = (n) < (NSL) - 1 ? (n) : (NSL) - 1; for (int j_ = 0; j_ < q_; ++j_) NS_ISSUE(j_, NSL, HASV); NS_WAIT(q_ - 1, HASV); __syncthreads(); } while (0)
#define NS_STEP_BEGIN(i, n, NSL, HASV) do { if ((i) + (NSL) - 1 < (n)) NS_ISSUE((i) + (NSL) - 1, NSL, HASV); } while (0)
#define NS_STEP_END(i, n, NSL, HASV) do { int nb_ = ((n) - 1 < (i) + (NSL) - 1 ? (n) - 1 : (i) + (NSL) - 1) - ((i) + 1); NS_WAIT(nb_, HASV); __syncthreads(); } while (0)
#define NS_KB(i, NSL) (lds + (((i) & ((NSL) - 1)) * 32768))
#define NS_VB(i, NSL) (lds + (((i) & ((NSL) - 1)) * 32768) + 16384)
__device__ __forceinline__ void p_nsa(const Args& a, LAS unsigned char* lds, int rep) {
    const int tid = opaque_tid(), lane = tid & 63, w = __builtin_amdgcn_readfirstlane(tid >> 6), rho = lane & 31, hh = lane >> 5, ql = rho >> 2, p = rho & 3;
    const unsigned lds_a = (unsigned)__builtin_amdgcn_readfirstlane((int)(unsigned)(size_t)lds);
    const f16* z = (const f16*)(a.ws + WS_Z); const f16* kcmp = (const f16*)(a.ws + WS_KCMP); const f16* vcmp = (const f16*)(a.ws + WS_VCMP);
    float* onsa = (float*)(a.ws + WS_ONSA); unsigned* ctl = (unsigned*)(a.ws + WS_CTL);
    LAS float* psel = (LAS float*)(lds + NS_PSEL); LAS unsigned* selb = (LAS unsigned*)(lds + NS_SELB); LAS unsigned* wany = (LAS unsigned*)(lds + NS_WANY);
    LAS unsigned char* list = lds + NS_LIST; LAS int* cnt = (LAS int*)(lds + NS_CNT); LAS int* unit_s = (LAS int*)(lds + NS_UNIT);
    const float c2 = 0.08838834764831845f * 1.4426950408889634f;
    for (;;) {
        __syncthreads();
        if (tid == 0) unit_s[0] = (int)atomicAdd(&ctl[CW_Q + rep], 1u);
        __syncthreads();
        const int u = unit_s[0]; if (u >= 512) break;
        const int blk = 255 - (u >> 1), g = u & 1, t0 = blk * 64, tq = t0 + 8 * w + ql, hq = g * 4 + p;
        f16x8 qf[8];
        { const f16* qrow = z + (size_t)tq * NZ + ZQ + hq * 128 + 8 * hh;
#pragma unroll
          for (int s = 0; s < 8; ++s) { const f16x8 q8 = *(const f16x8*)(qrow + 16 * s);
#pragma unroll
              for (int j = 0; j < 8; ++j) qf[s][j] = (f16)((float)q8[j] * c2); } }
        const f16* zrow = z + (size_t)tq * NZ;
        const float gate_c = sigmoidf_((float)zrow[ZGL + hq]), gate_s = sigmoidf_((float)zrow[ZGL + 8 + hq]), gate_w = sigmoidf_((float)zrow[ZGL + 16 + hq]);
        f32x16 O[4];
        float* orow = onsa + (size_t)tq * 1024 + hq * 128 + 4 * hh;
#pragma unroll
        for (int c = 0; c < 4; ++c)
#pragma unroll
            for (int i = 0; i < 16; ++i) O[c][i] = 0.f;
        const int cmax = tq >= 31 ? (tq - 31) >> 4 : -1;
        const int ntc = (4 * blk + 3 + 63) >> 6;
        float m = 0.f, l = 0.f; bool seen = false;
        const int cmin_w = (t0 + 8 * w) >= 31 ? (t0 + 8 * w - 31) >> 4 : -1;
#define NS_KPTR(j) (kcmp + ((size_t)(64 * (j)) * 2 + g) * 128)
#define NS_VPTR(j) (vcmp + ((size_t)(64 * (j)) * 2 + g) * 128)
#define NS_STRIDE 256
        NS_PROLOGUE(ntc, 4, false);
        for (int i = 0; i < ntc; ++i) {
            NS_STEP_BEGIN(i, ntc, 4, false);
            f32x16 x0, x1; ns_qk(x0, x1, NS_KB(i, 4), qf, rho, hh, -m);
            if (64 * i + 63 > cmin_w) {
#pragma unroll
                for (int r = 0; r < 16; ++r) { const int c0 = 64 * i + NS_KIDX(r, hh); x0[r] = (c0 <= cmax) ? x0[r] : -INFINITY; x1[r] = (c0 + 32 <= cmax) ? x1[r] : -INFINITY; } }
            ns_online<false>(x0, x1, m, l, seen, O);
            NS_STEP_END(i, ntc, 4, false);
        }
        l += __shfl_xor(l, 32);
        const float invl = 1.f / fmaxf(l, 1e-30f);
        for (int i = lane; i < 8 * NS_PSTR; i += 64) psel[(8 * w) * NS_PSTR + i] = 0.f;
        NS_PROLOGUE(ntc, 2, true);
        for (int i = 0; i < ntc; ++i) {
            NS_STEP_BEGIN(i, ntc, 2, true);
            f32x16 x0, x1; ns_qk(x0, x1, NS_KB(i, 2), qf, rho, hh, -m);
#pragma unroll
            for (int r = 0; r < 16; ++r) { x0[r] = __builtin_amdgcn_exp2f(x0[r]) * invl; x1[r] = __builtin_amdgcn_exp2f(x1[r]) * invl; }
            if (64 * i + 63 > cmin_w) {
#pragma unroll
                for (int r = 0; r < 16; ++r) { const int c0 = 64 * i + NS_KIDX(r, hh); x0[r] = (c0 <= cmax) ? x0[r] : 0.f; x1[r] = (c0 + 32 <= cmax) ? x1[r] : 0.f; } }
#pragma unroll
            for (int kh = 0; kh < 2; ++kh)
#pragma unroll
                for (int r4 = 0; r4 < 4; ++r4) {
                    const float pa = kh ? x1[4 * r4] : x0[4 * r4], pb = kh ? x1[4 * r4 + 1] : x0[4 * r4 + 1], pc_ = kh ? x1[4 * r4 + 2] : x0[4 * r4 + 2], pd = kh ? x1[4 * r4 + 3] : x0[4 * r4 + 3];
                    float mainv = pa + pb + pc_ + 0.5f * pd, carry = 0.5f * pd;
                    mainv += __shfl_xor(mainv, 1); mainv += __shfl_xor(mainv, 2); carry += __shfl_xor(carry, 1); carry += __shfl_xor(carry, 2);
                    if (p == 0) { const int sb = 16 * i + 8 * kh + 2 * r4 + hh; float* pr = (float*)(psel + (8 * w + ql) * NS_PSTR + sb); __hip_atomic_fetch_add(pr, mainv, __ATOMIC_RELAXED, __HIP_MEMORY_SCOPE_WORKGROUP); __hip_atomic_fetch_add(pr + 1, carry, __ATOMIC_RELAXED, __HIP_MEMORY_SCOPE_WORKGROUP); }
                }
            ns_pv(O, NS_VB(i, 2), x0, x1, lane);
            NS_STEP_END(i, ntc, 2, true);
        }
#undef NS_KPTR
#undef NS_VPTR
#undef NS_STRIDE
#pragma unroll
        for (int c = 0; c < 4; ++c) {
#pragma unroll
            for (int r4 = 0; r4 < 4; ++r4) *(f32x4*)(orow + 32 * c + 8 * r4) = (f32x4){O[c][4 * r4] * gate_c, O[c][4 * r4 + 1] * gate_c, O[c][4 * r4 + 2] * gate_c, O[c][4 * r4 + 3] * gate_c};
#pragma unroll
            for (int i = 0; i < 16; ++i) O[c][i] = 0.f; }
        {
            unsigned anyw = 0u;
            for (int qq = 0; qq < 8; ++qq) {
                const LAS float* pr = psel + (8 * w + qq) * NS_PSTR;
                unsigned myw = 0u;
                if (lane == 0) myw |= 1u;
                if (lane == (blk >> 5)) myw |= 1u << (blk & 31);
                if (blk >= 1 && lane == ((blk - 1) >> 5)) myw |= 1u << ((blk - 1) & 31);
                const int ncand = blk >= 3 ? blk - 2 : 0;
                if (ncand <= 13) { if (ncand > 0 && lane == 0) myw |= ((2u << (blk - 2)) - 1u) & ~1u; }
                else {
                    unsigned key[4];
#pragma unroll
                    for (int jj = 0; jj < 4; ++jj) { const int s = 1 + lane + 64 * jj; key[jj] = (s <= blk - 2) ? __float_as_uint(fmaxf(pr[s], 0.f)) + 1u : 0u; }
                    unsigned thr = 0u;
                    for (int bit = 31; bit >= 0; --bit) { const unsigned cand = thr | (1u << bit); int cn = 0;
#pragma unroll
                        for (int jj = 0; jj < 4; ++jj) cn += __popcll(__ballot(key[jj] >= cand));
                        if (cn >= 13) thr = cand; }
                    int cgt = 0;
#pragma unroll
                    for (int jj = 0; jj < 4; ++jj) cgt += __popcll(__ballot(key[jj] > thr));
                    int remaining = 13 - cgt;
                    unsigned long long M[4];
#pragma unroll
                    for (int jj = 0; jj < 4; ++jj) { const bool eq = key[jj] == thr; const unsigned long long em = __ballot(eq); const int c = __popcll(em);
                        const bool take_eq = eq && (__popcll(em & ((1ull << lane) - 1ull)) < remaining);
                        remaining = remaining > c ? remaining - c : 0;
                        M[jj] = __ballot(key[jj] > thr || take_eq); }
#pragma unroll
                    for (int j = 0; j < 8; ++j) { const int k = j >> 1; const unsigned long long sh = (M[k] << 1) | (k > 0 ? (M[k - 1] >> 63) : 0ull);
                        const unsigned wj = (unsigned)(sh >> (32 * (j & 1))); if (lane == j) myw |= wj; }
                }
                if (lane < 8) selb[(8 * w + qq) * 8 + lane] = myw;
                anyw |= myw;
            }
            if (lane < 8) wany[w * 8 + lane] = anyw;
        }
        __syncthreads();
        {
            int need = 0;
            if (w < 4) { const int sblk = 64 * w + lane; unsigned un = 0u;
#pragma unroll
                for (int ww = 0; ww < 8; ++ww) un |= wany[ww * 8 + (sblk >> 5)];
                need = (un >> (sblk & 31)) & 1; }
            const unsigned long long bal = __ballot(need);
            if (w < 4 && lane == 0) cnt[w] = __popcll(bal);
            __syncthreads();
            if (w < 4) { int base = 0;
                for (int ww = 0; ww < w; ++ww) base += cnt[ww];
                if (need) list[base + __popcll(bal & ((1ull << lane) - 1ull))] = (unsigned char)(64 * w + lane); }
            __syncthreads();
        }
        const int nlist = cnt[0] + cnt[1] + cnt[2] + cnt[3];
        for (int rp_ = 0; rp_ < NSA_SELREP; ++rp_) {
        if (rp_) { asm volatile("" :: "v"(O[0][0]), "v"(O[1][0]), "v"(O[2][0]), "v"(O[3][0]), "v"(l));
#pragma unroll
            for (int c = 0; c < 4; ++c)
#pragma unroll
                for (int i = 0; i < 16; ++i) O[c][i] = 0.f; }
        m = 0.f; l = 0.f; seen = false;
#define NS_KPTR(j) (z + (size_t)((int)list[j] * 64) * NZ + ZKS + g * 128)
#define NS_VPTR(j) (z + (size_t)((int)list[j] * 64) * NZ + ZVS + g * 128)
#define NS_STRIDE NZ
        NS_PROLOGUE(nlist, 4, true);
        for (int i = 0; i < nlist; ++i) {
            NS_STEP_BEGIN(i, nlist, 4, true);
            const int sb = list[i];
            const unsigned wneed = (wany[w * 8 + (sb >> 5)] >> (sb & 31)) & 1u;
            if (wneed) {
                const bool rsel = (selb[(8 * w + ql) * 8 + (sb >> 5)] >> (sb & 31)) & 1u;
                f32x16 x0, x1; ns_qk(x0, x1, NS_KB(i, 4), qf, rho, hh, rsel ? -m : -INFINITY);
                if (sb == blk) { const int kp0 = sb * 64;
#pragma unroll
                    for (int r = 0; r < 16; ++r) { const int kp = kp0 + NS_KIDX(r, hh); x0[r] = (kp <= tq) ? x0[r] : -INFINITY; x1[r] = (kp + 32 <= tq) ? x1[r] : -INFINITY; } }
                ns_online<true>(x0, x1, m, l, seen, O);
                ns_pv(O, NS_VB(i, 4), x0, x1, lane);
            }
            NS_STEP_END(i, nlist, 4, true);
        }
        }
#undef NS_KPTR
#undef NS_VPTR
        l += __shfl_xor(l, 32);
        { const float sc = gate_s / fmaxf(l, 1e-30f); f32x4 ev[4][4];
#pragma unroll
          for (int c = 0; c < 4; ++c)
#pragma unroll
              for (int r4 = 0; r4 < 4; ++r4) ev[c][r4] = *(const f32x4*)(orow + 32 * c + 8 * r4);
#pragma unroll
          for (int c = 0; c < 4; ++c) {
#pragma unroll
              for (int r4 = 0; r4 < 4; ++r4) { const f32x4 e = ev[c][r4]; *(f32x4*)(orow + 32 * c + 8 * r4) = (f32x4){e.x + O[c][4 * r4] * sc, e.y + O[c][4 * r4 + 1] * sc, e.z + O[c][4 * r4 + 2] * sc, e.w + O[c][4 * r4 + 3] * sc}; }
#pragma unroll
              for (int i = 0; i < 16; ++i) O[c][i] = 0.f; } }
        const int wb0 = blk >= 8 ? blk - 8 : 0, nwt = blk - wb0 + 1;
        for (int rp_ = 0; rp_ < NSA_WINREP; ++rp_) {
        if (rp_) { asm volatile("" :: "v"(O[0][0]), "v"(O[1][0]), "v"(O[2][0]), "v"(O[3][0]), "v"(l));
#pragma unroll
            for (int c = 0; c < 4; ++c)
#pragma unroll
                for (int i = 0; i < 16; ++i) O[c][i] = 0.f; }
        m = 0.f; l = 0.f; seen = false;
#define NS_KPTR(j) (z + (size_t)((wb0 + (j)) * 64) * NZ + ZKW + g * 128)
#define NS_VPTR(j) (z + (size_t)((wb0 + (j)) * 64) * NZ + ZVW + g * 128)
        NS_PROLOGUE(nwt, 4, true);
        for (int i = 0; i < nwt; ++i) {
            NS_STEP_BEGIN(i, nwt, 4, true);
            const int kb = wb0 + i;
            f32x16 x0, x1; ns_qk(x0, x1, NS_KB(i, 4), qf, rho, hh, -m);
            if (i == 0 || i == nwt - 1) { const int kp0 = kb * 64;
#pragma unroll
                for (int r = 0; r < 16; ++r) { const int kp = kp0 + NS_KIDX(r, hh);
                    x0[r] = (kp <= tq && kp + 511 >= tq) ? x0[r] : -INFINITY; x1[r] = (kp + 32 <= tq && kp + 32 + 511 >= tq) ? x1[r] : -INFINITY; } }
            ns_online<true>(x0, x1, m, l, seen, O);
            ns_pv(O, NS_VB(i, 4), x0, x1, lane);
            NS_STEP_END(i, nwt, 4, true);
        }
        }
#undef NS_KPTR
#undef NS_VPTR
#undef NS_STRIDE
        l += __shfl_xor(l, 32);
        { const float sc = gate_w / fmaxf(l, 1e-30f); f32x4 ev[4][4];
#pragma unroll
          for (int c = 0; c < 4; ++c)
#pragma unroll
              for (int r4 = 0; r4 < 4; ++r4) ev[c][r4] = *(const f32x4*)(orow + 32 * c + 8 * r4);
#pragma unroll
          for (int c = 0; c < 4; ++c)
#pragma unroll
              for (int r4 = 0; r4 < 4; ++r4) { const f32x4 e = ev[c][r4]; *(f32x4*)(orow + 32 * c + 8 * r4) = (f32x4){e.x + O[c][4 * r4] * sc, e.y + O[c][4 * r4 + 1] * sc, e.z + O[c][4 * r4 + 2] * sc, e.w + O[c][4 * r4 + 3] * sc}; } }
    }
}

constexpr int RS = 72, SLOT = 64 * RS * 2, RW_FS = 68, RW_GCL = 16 * SLOT;
#define RW_SLOT(lds, i) ((LAS bf16*)((lds) + (i) * SLOT))
template <int KS> __device__ __forceinline__ void mm_acc(f32x4 (&acc)[2], const LAS bf16* X, int xs, const LAS bf16* Y, int ys, int w, int lane) {
    const LAS bf16* xp = X + (16 * (w >> 1) + (lane & 15)) * xs + 8 * (lane >> 4);
    const LAS bf16* yp = Y + (32 * (w & 1) + (lane & 15)) * ys + 8 * (lane >> 4);
#pragma unroll
    for (int ks = 0; ks < KS; ++ks) { const bf16x8 av = *(const LAS bf16x8*)(xp + 32 * ks), b0 = *(const LAS bf16x8*)(yp + 32 * ks), b1 = *(const LAS bf16x8*)(yp + 16 * ys + 32 * ks);
        acc[0] = __builtin_amdgcn_mfma_f32_16x16x32_bf16(av, b0, acc[0], 0, 0, 0); acc[1] = __builtin_amdgcn_mfma_f32_16x16x32_bf16(av, b1, acc[1], 0, 0, 0); }
}
__device__ __forceinline__ void acc_zero(f32x4 (&acc)[2]) { acc[0] = (f32x4){0.f, 0.f, 0.f, 0.f}; acc[1] = (f32x4){0.f, 0.f, 0.f, 0.f}; }
__device__ __forceinline__ void st_n(const f32x4 (&acc)[2], LAS bf16* dst, int m0, int n0) {
#pragma unroll
    for (int tn = 0; tn < 2; ++tn)
#pragma unroll
        for (int r = 0; r < 4; ++r) dst[(m0 + r) * RS + n0 + 16 * tn] = (bf16)acc[tn][r];
}
__device__ __forceinline__ void st_t(const f32x4 (&acc)[2], LAS bf16* dst, int m0, int n0) {
#pragma unroll
    for (int tn = 0; tn < 2; ++tn) { const bf16x4 v = {(bf16)acc[tn][0], (bf16)acc[tn][1], (bf16)acc[tn][2], (bf16)acc[tn][3]}; *(LAS bf16x4*)(dst + (n0 + 16 * tn) * RS + m0) = v; }
}
__device__ __forceinline__ void ld_n(f32x4 (&acc)[2], const LAS bf16* src, int m0, int n0) {
#pragma unroll
    for (int tn = 0; tn < 2; ++tn)
#pragma unroll
        for (int r = 0; r < 4; ++r) acc[tn][r] = (float)src[(m0 + r) * RS + n0 + 16 * tn];
}
template <bool INCL> __device__ __forceinline__ void tri_mask(f32x4 (&acc)[2], int m0, int n0) {
#pragma unroll
    for (int tn = 0; tn < 2; ++tn)
#pragma unroll
        for (int r = 0; r < 4; ++r) { const int m = m0 + r, n = n0 + 16 * tn; if (INCL ? (n > m) : (n >= m)) acc[tn][r] = 0.f; }
}
__device__ __forceinline__ void st_acc_g(const f32x4 (&acc)[2], f16* base, int u, int w, int lane) {
#pragma unroll
    for (int tn = 0; tn < 2; ++tn) { const f16x4 v = {(f16)acc[tn][0], (f16)acc[tn][1], (f16)acc[tn][2], (f16)acc[tn][3]}; ((f16x4*)base)[((size_t)u * 16 + w * 2 + tn) * 64 + lane] = v; }
}
__device__ __forceinline__ float fast_tanh(float x) { const float e = __expf(2.f * x); return 1.f - 2.f / (e + 1.f); }

__device__ __forceinline__ void p_rwkv_local(const Args& a, LAS unsigned char* lds) {
    const int tid = opaque_tid(), lane = tid & 63, w = __builtin_amdgcn_readfirstlane(tid >> 6);
    const int m0 = 16 * (w >> 1) + 4 * (lane >> 4), n0 = 32 * (w & 1) + (lane & 15);
    const int et = tid >> 3, cg = tid & 7;
    const f16* z = (const f16*)(a.ws + WS_Z);
    unsigned char* ro = (unsigned char*)a.out;
    LAS float* FW = (LAS float*)(lds + 8 * SLOT); LAS float* FA = FW + 64 * RW_FS; LAS float* TOT = FA + 64 * RW_FS; LAS float* GCL = (LAS float*)(lds + RW_GCL); LAS float* PRM = GCL + 64;
    const int h = blockIdx.x & 15, cstep = gridDim.x >> 4, ch0 = h * 64 + 8 * cg;
    __syncthreads();
    if (tid < 64) { const int ch = h * 64 + tid; const float* mu = a.in[I_MU];
        PRM[tid] = mu[ch]; PRM[64 + tid] = mu[1024 + ch]; PRM[128 + tid] = mu[2048 + ch]; PRM[192 + tid] = mu[3072 + tid]; PRM[256 + tid] = mu[3136 + tid];
        PRM[320 + tid] = a.in[I_W0][ch]; PRM[384 + tid] = a.in[I_A0][ch]; PRM[448 + tid] = a.in[I_KK][ch]; PRM[512 + tid] = a.in[I_KA][ch]; PRM[576 + tid] = a.in[I_RK][ch]; }
    *(LAS u32x4*)(RW_SLOT(lds, 14) + et * RS + 8 * cg) = *(const u32x4*)((const bf16*)(a.ws + WS_WUPT) + (size_t)(h * 64 + et) * 64 + 8 * cg);
    *(LAS u32x4*)(RW_SLOT(lds, 15) + et * RS + 8 * cg) = *(const u32x4*)((const bf16*)(a.ws + WS_AUPT) + (size_t)(h * 64 + et) * 64 + 8 * cg);
    f16x8 zc[5], zp[5];
    const f16x8 zero8 = {0, 0, 0, 0, 0, 0, 0, 0};
#define RW_LOADZ(cc) do { const int t_ = (cc) * 64 + et; const f16* cur_ = z + (size_t)t_ * NZ; const bool hp_ = t_ > 0; \
        zc[0] = *(const f16x8*)(cur_ + ZR + ch0); zc[1] = *(const f16x8*)(cur_ + ZK + ch0); zc[2] = *(const f16x8*)(cur_ + ZV + ch0); zc[3] = *(const f16x8*)(cur_ + ZWD + 8 * cg); zc[4] = *(const f16x8*)(cur_ + ZAD + 8 * cg); \
        zp[0] = hp_ ? *(const f16x8*)(cur_ - NZ + ZR + ch0) : zero8; zp[1] = hp_ ? *(const f16x8*)(cur_ - NZ + ZK + ch0) : zero8; zp[2] = hp_ ? *(const f16x8*)(cur_ - NZ + ZV + ch0) : zero8; \
        zp[3] = hp_ ? *(const f16x8*)(cur_ - NZ + ZWD + 8 * cg) : zero8; zp[4] = hp_ ? *(const f16x8*)(cur_ - NZ + ZAD + 8 * cg) : zero8; } while (0)
    __syncthreads();
    if ((blockIdx.x >> 4) < 256) RW_LOADZ(blockIdx.x >> 4);
    for (int c = blockIdx.x >> 4; c < 256; c += cstep) {
        const int t0 = c * 64, uo = h * 256 + c;
        float r_[8], k_[8], v_[8];
        { bf16x8 x1, x2;
#pragma unroll
          for (int e = 0; e < 8; ++e) { const int jj = 8 * cg + e;
              r_[e] = (float)zc[0][e] + ((float)zp[0][e] - (float)zc[0][e]) * PRM[jj]; k_[e] = (float)zc[1][e] + ((float)zp[1][e] - (float)zc[1][e]) * PRM[64 + jj]; v_[e] = (float)zc[2][e] + ((float)zp[2][e] - (float)zc[2][e]) * PRM[128 + jj];
              x1[e] = (bf16)fast_tanh((float)zc[3][e] + ((float)zp[3][e] - (float)zc[3][e]) * PRM[192 + jj]); x2[e] = (bf16)((float)zc[4][e] + ((float)zp[4][e] - (float)zc[4][e]) * PRM[256 + jj]); }
          *(LAS bf16x8*)(RW_SLOT(lds, 0) + et * RS + 8 * cg) = x1; *(LAS bf16x8*)(RW_SLOT(lds, 1) + et * RS + 8 * cg) = x2; }
        if (c + cstep < 256) RW_LOADZ(c + cstep);
        __syncthreads();
        { f32x4 acc[2]; acc_zero(acc); mm_acc<2>(acc, RW_SLOT(lds, 0), RS, RW_SLOT(lds, 14), RS, w, lane);
#pragma unroll
          for (int tn = 0; tn < 2; ++tn)
#pragma unroll
              for (int r = 0; r < 4; ++r) FW[(m0 + r) * RW_FS + n0 + 16 * tn] = acc[tn][r];
          acc_zero(acc); mm_acc<2>(acc, RW_SLOT(lds, 1), RS, RW_SLOT(lds, 15), RS, w, lane);
#pragma unroll
          for (int tn = 0; tn < 2; ++tn)
#pragma unroll
              for (int r = 0; r < 4; ++r) FA[(m0 + r) * RW_FS + n0 + 16 * tn] = acc[tn][r]; }
        __syncthreads();
        float lw_[8], kk_[8], b_[8];
        { float ss = 0.f, sb = 0.f;
#pragma unroll
          for (int e = 0; e < 8; ++e) {
              const float wpre = PRM[320 + 8 * cg + e] + FW[et * RW_FS + 8 * cg + e]; const float y0 = -wpre; const float sp = fmaxf(y0, 0.f) + __logf(1.f + __expf(-fabsf(y0)));
              lw_[e] = -__expf(-sp - 0.5f);
              const float av = sigmoidf_(PRM[384 + 8 * cg + e] + FA[et * RW_FS + 8 * cg + e]);
              const float kkr = k_[e] * PRM[448 + 8 * cg + e]; ss += kkr * kkr; kk_[e] = kkr;
              k_[e] = k_[e] * (1.f + (av - 1.f) * PRM[512 + 8 * cg + e]); b_[e] = av;
              sb += r_[e] * k_[e] * PRM[576 + 8 * cg + e]; }
          ss += __shfl_xor(ss, 1); ss += __shfl_xor(ss, 2); ss += __shfl_xor(ss, 4);
          sb += __shfl_xor(sb, 1); sb += __shfl_xor(sb, 2); sb += __shfl_xor(sb, 4);
          const float rn = rsqrtf(fmaxf(ss, 1e-24f));
#pragma unroll
          for (int e = 0; e < 8; ++e) { kk_[e] *= rn; b_[e] *= kk_[e]; FW[et * RW_FS + 8 * cg + e] = lw_[e]; }
          if (cg == 0) ((float*)(a.ws + WS_SBON))[(size_t)(t0 + et) * 16 + h] = sb; }
        __syncthreads();
        { const int j = tid & 63, rg = tid >> 6; float run = 0.f;
#pragma unroll
          for (int i = 0; i < 8; ++i) { run += FW[(8 * rg + i) * RW_FS + j]; FW[(8 * rg + i) * RW_FS + j] = run; }
          TOT[rg * 64 + j] = run;
          __syncthreads();
          float off = 0.f;
          for (int q = 0; q < rg; ++q) off += TOT[q * 64 + j];
#pragma unroll
          for (int i = 0; i < 8; ++i) FW[(8 * rg + i) * RW_FS + j] += off; }
        __syncthreads();
        { bf16x8 at, bt, kt, rt;
#pragma unroll
          for (int e = 0; e < 8; ++e) { const int jj = 8 * cg + e; const float cum = FW[et * RW_FS + jj], cl = FW[63 * RW_FS + jj];
              const float eA = __expf(cum - lw_[e]), eN = __expf(-cum), eP = __expf(cum), eH = __expf(cl - cum);
              const float A_ = -kk_[e] * eA;
              at[e] = (bf16)A_; bt[e] = (bf16)(b_[e] * eN); kt[e] = (bf16)(k_[e] * eN); rt[e] = (bf16)(r_[e] * eP);
              RW_SLOT(lds, 1)[jj * RS + et] = (bf16)A_; RW_SLOT(lds, 5)[jj * RS + et] = (bf16)(b_[e] * eH); RW_SLOT(lds, 6)[jj * RS + et] = (bf16)(k_[e] * eH); RW_SLOT(lds, 7)[jj * RS + et] = (bf16)v_[e];
              if (et == 63) GCL[jj] = __expf(cl); }
          *(LAS bf16x8*)(RW_SLOT(lds, 0) + et * RS + 8 * cg) = at; *(LAS bf16x8*)(RW_SLOT(lds, 2) + et * RS + 8 * cg) = bt;
          *(LAS bf16x8*)(RW_SLOT(lds, 3) + et * RS + 8 * cg) = kt; *(LAS bf16x8*)(RW_SLOT(lds, 4) + et * RS + 8 * cg) = rt; }
        __syncthreads();
        { f32x4 acc[2];
          acc_zero(acc); mm_acc<2>(acc, RW_SLOT(lds, 0), RS, RW_SLOT(lds, 2), RS, w, lane); tri_mask<false>(acc, m0, n0);
          st_n(acc, RW_SLOT(lds, 8), m0, n0); st_t(acc, RW_SLOT(lds, 9), m0, n0);
#pragma unroll
          for (int tn = 0; tn < 2; ++tn)
#pragma unroll
              for (int r = 0; r < 4; ++r) if (m0 + r == n0 + 16 * tn) acc[tn][r] += 1.f;
          st_n(acc, RW_SLOT(lds, 13), m0, n0);
          acc_zero(acc); mm_acc<2>(acc, RW_SLOT(lds, 0), RS, RW_SLOT(lds, 3), RS, w, lane); tri_mask<false>(acc, m0, n0); st_t(acc, RW_SLOT(lds, 10), m0, n0);
          acc_zero(acc); mm_acc<2>(acc, RW_SLOT(lds, 4), RS, RW_SLOT(lds, 2), RS, w, lane); tri_mask<true>(acc, m0, n0); st_n(acc, RW_SLOT(lds, 11), m0, n0);
          acc_zero(acc); mm_acc<2>(acc, RW_SLOT(lds, 4), RS, RW_SLOT(lds, 3), RS, w, lane); tri_mask<true>(acc, m0, n0); st_n(acc, RW_SLOT(lds, 12), m0, n0); }
        __syncthreads();
        { f32x4 acc[2];
          acc_zero(acc); mm_acc<2>(acc, RW_SLOT(lds, 8), RS, RW_SLOT(lds, 9), RS, w, lane); st_n(acc, RW_SLOT(lds, 0), m0, n0); st_t(acc, RW_SLOT(lds, 2), m0, n0);
          __syncthreads();
          ld_n(acc, RW_SLOT(lds, 13), m0, n0); mm_acc<2>(acc, RW_SLOT(lds, 13), RS, RW_SLOT(lds, 2), RS, w, lane); st_n(acc, RW_SLOT(lds, 3), m0, n0);
          acc_zero(acc); mm_acc<2>(acc, RW_SLOT(lds, 0), RS, RW_SLOT(lds, 2), RS, w, lane); st_n(acc, RW_SLOT(lds, 8), m0, n0); st_t(acc, RW_SLOT(lds, 9), m0, n0);
          __syncthreads();
          ld_n(acc, RW_SLOT(lds, 3), m0, n0); mm_acc<2>(acc, RW_SLOT(lds, 3), RS, RW_SLOT(lds, 9), RS, w, lane); st_n(acc, RW_SLOT(lds, 13), m0, n0);
          acc_zero(acc); mm_acc<2>(acc, RW_SLOT(lds, 8), RS, RW_SLOT(lds, 9), RS, w, lane); st_n(acc, RW_SLOT(lds, 0), m0, n0); st_t(acc, RW_SLOT(lds, 2), m0, n0);
          __syncthreads();
          ld_n(acc, RW_SLOT(lds, 13), m0, n0); mm_acc<2>(acc, RW_SLOT(lds, 13), RS, RW_SLOT(lds, 2), RS, w, lane); st_n(acc, RW_SLOT(lds, 3), m0, n0);
          acc_zero(acc); mm_acc<2>(acc, RW_SLOT(lds, 0), RS, RW_SLOT(lds, 2), RS, w, lane); st_n(acc, RW_SLOT(lds, 8), m0, n0); st_t(acc, RW_SLOT(lds, 9), m0, n0);
          __syncthreads();
          ld_n(acc, RW_SLOT(lds, 3), m0, n0); mm_acc<2>(acc, RW_SLOT(lds, 3), RS, RW_SLOT(lds, 9), RS, w, lane); st_n(acc, RW_SLOT(lds, 13), m0, n0);
          acc_zero(acc); mm_acc<2>(acc, RW_SLOT(lds, 8), RS, RW_SLOT(lds, 9), RS, w, lane); st_t(acc, RW_SLOT(lds, 2), m0, n0);
          __syncthreads();
          ld_n(acc, RW_SLOT(lds, 13), m0, n0); mm_acc<2>(acc, RW_SLOT(lds, 13), RS, RW_SLOT(lds, 2), RS, w, lane); st_n(acc, RW_SLOT(lds, 3), m0, n0);
          __syncthreads();
          acc_zero(acc); mm_acc<2>(acc, RW_SLOT(lds, 1), RS, RW_SLOT(lds, 3), RS, w, lane); st_n(acc, RW_SLOT(lds, 0), m0, n0);
          acc_zero(acc); mm_acc<2>(acc, RW_SLOT(lds, 3), RS, RW_SLOT(lds, 10), RS, w, lane); st_n(acc, RW_SLOT(lds, 8), m0, n0);
          __syncthreads();
          acc_zero(acc); mm_acc<2>(acc, RW_SLOT(lds, 7), RS, RW_SLOT(lds, 8), RS, w, lane); st_n(acc, RW_SLOT(lds, 9), m0, n0);
          acc_zero(acc); mm_acc<2>(acc, RW_SLOT(lds, 0), RS, RW_SLOT(lds, 11), RS, w, lane);
#pragma unroll
          for (int tn = 0; tn < 2; ++tn) { const int tt = n0 + 16 * tn; const bf16x4 rr = *(const LAS bf16x4*)(RW_SLOT(lds, 4) + tt * RS + m0);
              const bf16x4 o = {(bf16)(acc[tn][0] + (float)rr[0]), (bf16)(acc[tn][1] + (float)rr[1]), (bf16)(acc[tn][2] + (float)rr[2]), (bf16)(acc[tn][3] + (float)rr[3])};
              *(bf16x4*)((bf16*)(ro + RO_Q) + (size_t)uo * 4096 + tt * 64 + m0) = o; }
          acc_zero(acc); mm_acc<2>(acc, RW_SLOT(lds, 0), RS, RW_SLOT(lds, 5), RS, w, lane);
#pragma unroll
          for (int tn = 0; tn < 2; ++tn) { const int jj = n0 + 16 * tn; const float gc = GCL[jj];
              const bf16x4 o = {(bf16)(acc[tn][0] + (m0 == jj ? gc : 0.f)), (bf16)(acc[tn][1] + (m0 + 1 == jj ? gc : 0.f)), (bf16)(acc[tn][2] + (m0 + 2 == jj ? gc : 0.f)), (bf16)(acc[tn][3] + (m0 + 3 == jj ? gc : 0.f))};
              *(bf16x4*)((bf16*)(ro + RO_M) + (size_t)uo * 4096 + jj * 64 + m0) = o; }
          __syncthreads();
          acc_zero(acc); mm_acc<2>(acc, RW_SLOT(lds, 11), RS, RW_SLOT(lds, 9), RS, w, lane); mm_acc<2>(acc, RW_SLOT(lds, 12), RS, RW_SLOT(lds, 7), RS, w, lane); st_acc_g(acc, (f16*)(ro + RO_Y), uo, w, lane);
          acc_zero(acc); mm_acc<2>(acc, RW_SLOT(lds, 9), RS, RW_SLOT(lds, 5), RS, w, lane); mm_acc<2>(acc, RW_SLOT(lds, 7), RS, RW_SLOT(lds, 6), RS, w, lane); st_acc_g(acc, (f16*)(ro + RO_N), uo, w, lane);
        }
    }
}
__device__ __forceinline__ void p_rwkv_scan(const Args& a, LAS unsigned char* lds, int h) {
    const int tid = opaque_tid(), lane = tid & 63, w = __builtin_amdgcn_readfirstlane(tid >> 6);
    const int m0 = 16 * (w >> 1) + 4 * (lane >> 4), n0 = 32 * (w & 1) + (lane & 15), row = tid >> 3, seg = tid & 7;
    const unsigned char* ro = (const unsigned char*)a.out;
    const bf16* Mg = (const bf16*)(ro + RO_M) + (size_t)h * 256 * 4096; const f16x4* Ng = (const f16x4*)(ro + RO_N) + (size_t)h * 256 * 1024; bf16* Sg = (bf16*)(a.ws + WS_RS) + (size_t)h * 256 * 4096;
    f32x4 acc[2]; acc_zero(acc);
    u32x4 mreg = *(const u32x4*)(Mg + row * 64 + seg * 8); f16x4 nreg[2] = {Ng[(w * 2) * 64 + lane], Ng[(w * 2 + 1) * 64 + lane]};
    for (int c = 0; c < 256; ++c) {
        LAS bf16* Sb = RW_SLOT(lds, c & 1); LAS bf16* Mb = RW_SLOT(lds, 2 + (c & 1));
        st_n(acc, Sb, m0, n0);
        *(LAS u32x4*)(Mb + row * RS + seg * 8) = mreg;
        const f16x4 nc0 = nreg[0], nc1 = nreg[1];
        if (c + 1 < 256) { mreg = *(const u32x4*)(Mg + (size_t)(c + 1) * 4096 + row * 64 + seg * 8); nreg[0] = Ng[(size_t)(c + 1) * 1024 + (w * 2) * 64 + lane]; nreg[1] = Ng[(size_t)(c + 1) * 1024 + (w * 2 + 1) * 64 + lane]; }
        __syncthreads();
        *(u32x4*)(Sg + (size_t)c * 4096 + row * 64 + seg * 8) = *(const LAS u32x4*)(Sb + row * RS + seg * 8);
        acc[0] = (f32x4){(float)nc0[0], (float)nc0[1], (float)nc0[2], (float)nc0[3]}; acc[1] = (f32x4){(float)nc1[0], (float)nc1[1], (float)nc1[2], (float)nc1[3]};
        mm_acc<2>(acc, Sb, RS, Mb, RS, w, lane);
    }
}
constexpr int RG_S = 168;
__device__ __forceinline__ void p_rwkv_out(const Args& a, LAS unsigned char* lds) {
    const int tid = opaque_tid(), lane = tid & 63, w = __builtin_amdgcn_readfirstlane(tid >> 6);
    const int m0 = 16 * (w >> 1) + 4 * (lane >> 4), n0 = 32 * (w & 1) + (lane & 15), row = tid >> 3, seg = tid & 7;
    const f16* z = (const f16*)(a.ws + WS_Z); const unsigned char* ro = (const unsigned char*)a.out; f16* mix = (f16*)(a.ws + WS_MIX);
    LAS bf16* SG = (LAS bf16*)(lds + 2 * SLOT); LAS bf16* GU = SG + 64 * RG_S; LAS float* YL = (LAS float*)(GU + 64 * RG_S); LAS float* GL = YL + 64 * RW_FS; LAS float* PRM = GL + 64 * RW_FS;
    const int h = blockIdx.x & 15, cstep = gridDim.x >> 4, et = row, cg = seg, ch0 = h * 64 + 8 * cg;
    __syncthreads();
    for (int ck = tid; ck < 64 * 20; ck += 512) { const int rr = ck / 20, c8 = ck % 20; *(LAS u32x4*)(GU + rr * RG_S + 8 * c8) = *(const u32x4*)((const bf16*)(a.ws + WS_GUPT) + (size_t)(h * 64 + rr) * 160 + 8 * c8); }
    if (tid < 160) PRM[tid] = a.in[I_MU][3200 + tid];
    if (tid < 64) { PRM[160 + tid] = a.in[I_MU][2048 + h * 64 + tid]; PRM[224 + tid] = a.in[I_LNXG][h * 64 + tid]; PRM[288 + tid] = a.in[I_LNXB][h * 64 + tid]; }
    const f16x8 zero8 = {0, 0, 0, 0, 0, 0, 0, 0};
    u32x4 qreg, sreg; f16x4 yreg[2]; f16x8 gc[3], gp[3], vc, vp; float sbn;
#define RO_LOAD(cc) do { const int uo_ = h * 256 + (cc), t0_ = (cc) * 64; \
        qreg = *(const u32x4*)((const bf16*)(ro + RO_Q) + (size_t)uo_ * 4096 + row * 64 + seg * 8); sreg = *(const u32x4*)((const bf16*)(a.ws + WS_RS) + (size_t)uo_ * 4096 + row * 64 + seg * 8); \
        { const f16x4* Yg_ = (const f16x4*)(ro + RO_Y) + (size_t)uo_ * 1024; yreg[0] = Yg_[(w * 2) * 64 + lane]; yreg[1] = Yg_[(w * 2 + 1) * 64 + lane]; } \
        _Pragma("unroll") for (int i_ = 0; i_ < 3; ++i_) { const int ck_ = tid + 512 * i_; if (ck_ < 64 * 20) { const int t_ = t0_ + ck_ / 20; const f16* cur_ = z + (size_t)t_ * NZ + ZGD + 8 * (ck_ % 20); gc[i_] = *(const f16x8*)cur_; gp[i_] = t_ > 0 ? *(const f16x8*)(cur_ - NZ) : zero8; } } \
        { const int t_ = t0_ + et; const f16* cur_ = z + (size_t)t_ * NZ + ZV + ch0; vc = *(const f16x8*)cur_; vp = t_ > 0 ? *(const f16x8*)(cur_ - NZ) : zero8; sbn = ((const float*)(a.ws + WS_SBON))[(size_t)t_ * 16 + h]; } } while (0)
    RO_LOAD(blockIdx.x >> 4);
    for (int c = blockIdx.x >> 4; c < 256; c += cstep) {
        const int t0 = c * 64;
        __syncthreads();
        *(LAS u32x4*)(RW_SLOT(lds, 0) + row * RS + seg * 8) = qreg; *(LAS u32x4*)(RW_SLOT(lds, 1) + row * RS + seg * 8) = sreg;
#pragma unroll
        for (int i = 0; i < 3; ++i) { const int ck = tid + 512 * i; if (ck < 64 * 20) { const int rr = ck / 20, c8 = ck % 20; bf16x8 o;
#pragma unroll
            for (int e = 0; e < 8; ++e) o[e] = (bf16)sigmoidf_((float)gc[i][e] + ((float)gp[i][e] - (float)gc[i][e]) * PRM[8 * c8 + e]);
            *(LAS bf16x8*)(SG + rr * RG_S + 8 * c8) = o; } }
        f32x4 y[2], g[2];
        y[0] = (f32x4){(float)yreg[0][0], (float)yreg[0][1], (float)yreg[0][2], (float)yreg[0][3]}; y[1] = (f32x4){(float)yreg[1][0], (float)yreg[1][1], (float)yreg[1][2], (float)yreg[1][3]};
        const f16x8 vcc = vc, vpp = vp; const float sbc = sbn;
        if (c + cstep < 256) RO_LOAD(c + cstep);
        __syncthreads();
        mm_acc<2>(y, RW_SLOT(lds, 0), RS, RW_SLOT(lds, 1), RS, w, lane);
        acc_zero(g); mm_acc<5>(g, SG, RG_S, GU, RG_S, w, lane);
#pragma unroll
        for (int tn = 0; tn < 2; ++tn)
#pragma unroll
            for (int r = 0; r < 4; ++r) { YL[(m0 + r) * RW_FS + n0 + 16 * tn] = y[tn][r]; GL[(m0 + r) * RW_FS + n0 + 16 * tn] = g[tn][r]; }
        __syncthreads();
        { const int t = t0 + et;
          float yv[8], gv[8]; float s1 = 0.f, s2 = 0.f;
#pragma unroll
          for (int e = 0; e < 8; ++e) { yv[e] = YL[et * RW_FS + 8 * cg + e]; gv[e] = GL[et * RW_FS + 8 * cg + e]; s1 += yv[e]; s2 += yv[e] * yv[e]; }
          s1 += __shfl_xor(s1, 1); s1 += __shfl_xor(s1, 2); s1 += __shfl_xor(s1, 4);
          s2 += __shfl_xor(s2, 1); s2 += __shfl_xor(s2, 2); s2 += __shfl_xor(s2, 4);
          const float mean = s1 * (1.f / 64.f), var = fmaxf(s2 * (1.f / 64.f) - mean * mean, 0.f), rstd = rsqrtf(var + 64e-5f);
          f16x8 o;
#pragma unroll
          for (int e = 0; e < 8; ++e) { const int jj = 8 * cg + e; const float vv = (float)vcc[e] + ((float)vpp[e] - (float)vcc[e]) * PRM[160 + jj];
              const float yn = (yv[e] - mean) * rstd * PRM[224 + jj] + PRM[288 + jj]; o[e] = (f16)((yn + sbc * vv) * gv[e]); }
          *(f16x8*)(mix + (size_t)t * D + 1024 + ch0) = o; }
    }
}

__device__ __forceinline__ void p_router(const Args& a, LAS unsigned char* lds, int rep) {
    const int tid = opaque_tid(), lane = tid & 63, wave = __builtin_amdgcn_readfirstlane(tid >> 6);
    const float* x2 = (const float*)(a.ws + WS_X1); f16* h3 = (f16*)a.out;
    unsigned* ctl = (unsigned*)(a.ws + WS_CTL);
    int* tke = (int*)(a.ws + WS_TOK + TK_E); float* tkw = (float*)(a.ws + WS_TOK + TK_W);
    const f16* WH = (const f16*)(a.ws + WS_WRH); const f16* WL = (const f16*)(a.ws + WS_WRL);
    LAS float* PART = (LAS float*)lds;
    LAS float* SSP = PART + 8 * 16 * 48;
    LAS float* LG = SSP + 128;
    LAS float* RSTD = LG + 16 * 48;
    const int row = lane & 15, kq = lane >> 4;
    for (int tile = blockIdx.x; tile < T / 16; tile += gridDim.x) {
        const int r0 = tile * 16;
        f32x4 acc[3]; acc[0] = (f32x4){0.f, 0.f, 0.f, 0.f}; acc[1] = acc[0]; acc[2] = acc[0];
        float ss = 0.f;
        const float* xp = x2 + (size_t)(r0 + row) * D + 256 * wave + 8 * kq;
        const f16* whp = WH + (size_t)row * D + 256 * wave + 8 * kq; const f16* wlp = WL + (size_t)row * D + 256 * wave + 8 * kq;
#pragma unroll 4
        for (int ks = 0; ks < 8; ++ks) {
            const f32x4 xa = *(const f32x4*)(xp + 32 * ks), xb = *(const f32x4*)(xp + 32 * ks + 4);
            ss += xa.x * xa.x + xa.y * xa.y + xa.z * xa.z + xa.w * xa.w + xb.x * xb.x + xb.y * xb.y + xb.z * xb.z + xb.w * xb.w;
            f16x8 hi, lo;
#pragma unroll
            for (int j = 0; j < 4; ++j) { hi[j] = (f16)xa[j]; lo[j] = (f16)(xa[j] - (float)hi[j]); hi[4 + j] = (f16)xb[j]; lo[4 + j] = (f16)(xb[j] - (float)hi[4 + j]); }
#pragma unroll
            for (int nt = 0; nt < 3; ++nt) { const f16x8 bh = *(const f16x8*)(whp + (size_t)nt * 16 * D + 32 * ks), bl = *(const f16x8*)(wlp + (size_t)nt * 16 * D + 32 * ks);
                acc[nt] = __builtin_amdgcn_mfma_f32_16x16x32_f16(hi, bh, acc[nt], 0, 0, 0); acc[nt] = __builtin_amdgcn_mfma_f32_16x16x32_f16(lo, bh, acc[nt], 0, 0, 0); acc[nt] = __builtin_amdgcn_mfma_f32_16x16x32_f16(hi, bl, acc[nt], 0, 0, 0); }
        }
        ss += __shfl_xor(ss, 16); ss += __shfl_xor(ss, 32);
        __syncthreads();
        if (kq == 0) SSP[wave * 16 + row] = ss;
#pragma unroll
        for (int nt = 0; nt < 3; ++nt)
#pragma unroll
            for (int r = 0; r < 4; ++r) PART[(wave * 16 + 4 * kq + r) * 48 + 16 * nt + row] = acc[nt][r];
        __syncthreads();
        for (int i = tid; i < 16 * 48; i += 512) { float v = 0.f;
#pragma unroll
            for (int ww = 0; ww < 8; ++ww) v += PART[ww * 768 + i];
            LG[i] = v; }
        if (tid < 16) { float v = 0.f;
#pragma unroll
            for (int ww = 0; ww < 8; ++ww) v += SSP[ww * 16 + tid];
            RSTD[tid] = rsqrtf(v * (1.f / D) + EPS); }
        __syncthreads();
        if (tid < 16) {
            const float rs = RSTD[tid]; const LAS float* L = LG + tid * 48;
            float lg[4];
#pragma unroll
            for (int c = 0; c < 4; ++c) lg[c] = L[c] * rs + a.in[I_RGB][c];
            int gi = 0; float gm = lg[0];
#pragma unroll
            for (int c = 1; c < 4; ++c) if (lg[c] > gm) { gm = lg[c]; gi = c; }
            float gs = 0.f;
#pragma unroll
            for (int c = 0; c < 4; ++c) gs += __expf(lg[c] - gm);
            const float pg = 1.f / gs;
            float le[8];
#pragma unroll
            for (int c = 0; c < 8; ++c) le[c] = L[4 + gi * 8 + c] * rs + a.in[I_REB][gi * 8 + c];
            int e1 = 0; float m1 = le[0];
#pragma unroll
            for (int c = 1; c < 8; ++c) if (le[c] > m1) { m1 = le[c]; e1 = c; }
            int e2 = -1; float m2 = -INFINITY;
#pragma unroll
            for (int c = 0; c < 8; ++c) if (c != e1 && le[c] > m2) { m2 = le[c]; e2 = c; }
            const float p2 = __expf(m2 - m1);
            const float w1 = pg / (1.f + p2), w2 = pg * p2 / (1.f + p2);
            const int m = r0 + tid, E1 = gi * 8 + e1, E2 = gi * 8 + e2; tke[m * 2] = E1; tke[m * 2 + 1] = E2; tkw[m * 2] = w1; tkw[m * 2 + 1] = w2;
            atomicAdd(&ctl[CW_CNT + rep * 8000 + E1], 1u); atomicAdd(&ctl[CW_CNT + rep * 8000 + E2], 1u);
        }
        { f32x4 xv[2][8];
#pragma unroll
          for (int rr2 = 0; rr2 < 2; ++rr2) { const f32x4* xr = (const f32x4*)(x2 + (size_t)(r0 + wave * 2 + rr2) * D) + lane;
#pragma unroll
              for (int j = 0; j < 8; ++j) xv[rr2][j] = xr[64 * j]; }
#pragma unroll
          for (int rr2 = 0; rr2 < 2; ++rr2) { const int rr = wave * 2 + rr2; const float rs = RSTD[rr]; const f32x4* gr = (const f32x4*)a.in[I_LN3] + lane; u32x2* o8 = (u32x2*)(h3 + (size_t)(r0 + rr) * D) + lane;
#pragma unroll
              for (int j = 0; j < 8; ++j) { const f32x4 v = xv[rr2][j], gg = gr[64 * j]; u32x2 wv; wv.x = pkh(v.x * rs * gg.x, v.y * rs * gg.y); wv.y = pkh(v.z * rs * gg.z, v.w * rs * gg.w); o8[64 * j] = wv; } } }
    }
}
__device__ __forceinline__ void p_slots(const Args& a, LAS unsigned char* lds, int rep) {
    unsigned* ctl = (unsigned*)(a.ws + WS_CTL);
    const int* tke = (const int*)(a.ws + WS_TOK + TK_E); const float* tkw = (const float*)(a.ws + WS_TOK + TK_W); int* tks = (int*)(a.ws + WS_TOK + TK_SLOT);
    int* stok = (int*)(a.ws + WS_TOK + TK_STOK); float* sw = (float*)(a.ws + WS_TOK + TK_SW);
    const int tid = opaque_tid(), lane = tid & 63;
    LAS int* offl = (LAS int*)lds; LAS int* cntl = offl + 64;
    __syncthreads();
    if (tid < 64) {
        const int n = lane < NEXP ? (int)ctl[CW_CNT + lane] : 0, nt = (n + 255) >> 8;
        int pre = nt;
#pragma unroll
        for (int o = 1; o < 32; o <<= 1) { const int v = __shfl_up(pre, o); if ((lane & 31) >= o) pre += v; }
        const int tb = pre - nt;
        if (lane < NEXP) { offl[lane] = tb * 256; cntl[lane] = n; }
        if (lane == NEXP - 1) offl[NEXP] = pre * 256;
        if (blockIdx.x == 0 && lane < NEXP) {
            int2* ugu = (int2*)(ctl + CW_UGU); int2* udn = (int2*)(ctl + CW_UDN);
            for (int rt = 0; rt < nt; ++rt) { const int pm = tb + rt;
#pragma unroll
                for (int jt = 0; jt < 2; ++jt) ugu[pm * 2 + jt] = make_int2(pm, lane * 2 + jt);
#pragma unroll
                for (int jt = 0; jt < 8; ++jt) udn[pm * 8 + jt] = make_int2(pm, lane * 8 + jt); }
            if (lane == NEXP - 1) { ctl[CW_NT] = (unsigned)pre; ctl[CW_NGU] = (unsigned)(pre * 2); ctl[CW_NDN] = (unsigned)(pre * 8); }
        }
    }
    __syncthreads();
    if (blockIdx.x == 0 && rep == 0) {
        for (int e = 0; e < NEXP; ++e) { const int end = offl[e + 1];
            for (int sl = offl[e] + cntl[e] + tid; sl < end; sl += 512) { stok[sl] = 0; sw[sl] = 0.f; } } }
    for (int i = blockIdx.x * 512 + tid; i < T * 2; i += gridDim.x * 512) { const int e = tke[i]; const int slot = offl[e] + (int)atomicAdd(&ctl[CW_CUR + rep * 8000 + e], 1u);
        stok[slot] = i >> 1; sw[slot] = tkw[i]; tks[i] = slot; }
}

constexpr int NPH = 17;
__global__ void __launch_bounds__(512, 2) mega(Args args) {
    extern __shared__ __attribute__((aligned(16))) unsigned char lds_raw[];
    LAS unsigned char* lds = (LAS unsigned char*)lds_raw;
    volatile LAS unsigned* MISC = (volatile LAS unsigned*)(lds + MISC_OFF);
    const int G = gridDim.x;
#define PH_IDS const int tid = opaque_tid(), lane = tid & 63, wave = tid >> 6, gw = blockIdx.x * 8 + wave, NGW = gridDim.x * 8; (void)tid; (void)lane; (void)gw; (void)NGW
    unsigned char* ws = args.ws;
    unsigned* ctl = (unsigned*)(ws + WS_CTL);
    if (threadIdx.x < 128) ((LAS unsigned*)(lds + MISC_OFF))[threadIdx.x] = 0u;
    __syncthreads();
    XcdBarrier bar; bar.bar = ctl + CW_BAR; bar.x = 0; bar.st = nullptr;
    const int lo = args.ph_lo, hi = args.ph_hi;
    if (hi - lo > 1 || DUPMASK != 0u) bar = xcd_barrier_post(ctl + CW_BAR, MISC + 8);
#ifndef PHMASK
#define PHMASK 0xFFFFFFFFu
#endif
#define IN(k) (((PHMASK >> (k)) & 1u) && lo <= (k) && (k) < hi)
#define BOTH(k) (IN(k) && IN((k) + 1))
#define GRID_BAR() xcd_barrier(bar)
#define NREP(k) ((((DUPMASK) >> (k)) & 1u) ? 2 : 1)

    for (int rep_ = 0; rep_ < NREP(0); ++rep_) if (IN(0)) { p0_prologue(args, lds); if (BOTH(0) || rep_ + 1 < NREP(0)) GRID_BAR(); }
    for (int rep_ = 0; rep_ < NREP(1); ++rep_) if (IN(1)) {
        { pg8::Gemm g{(const f16*)(ws + WS_H), (const f16*)(ws + WS_WIN), D, D, D, nullptr}; pg8::StaticOrder S; S.init(T, NZ, G, (int)blockIdx.x);
          pg8::EpiF16 E{(f16*)(ws + WS_Z), NZ, 1.f}; pg8::gemm_phase<pg8::EpiF16, pg8::StaticOrder, true>(lds, g, S, E); }
        if (BOTH(1) || rep_ + 1 < NREP(1)) GRID_BAR();
    }
    for (int rep_ = 0; rep_ < NREP(2); ++rep_) if (IN(2)) {
        for (int r2_ = 0; r2_ < ((DUPX & 1) ? 2 : 1); ++r2_) { p_compress(args, lds); __syncthreads(); }
        for (int r2_ = 0; r2_ < ((DUPX & 2) ? 2 : 1); ++r2_) { p_rwkv_local(args, lds); __syncthreads(); }
        if (BOTH(2) || rep_ + 1 < NREP(2)) GRID_BAR();
    }
    for (int rep_ = 0; rep_ < NREP(3); ++rep_) if (IN(3)) {
        if (blockIdx.x < 16) p_rwkv_scan(args, lds, blockIdx.x);
        else if (blockIdx.x < 32 && rep_ == 0) { const int b = blockIdx.x - 16; const int which = b / 8;
            pg8::Gemm g{(const f16*)(ws + WS_MEMN), (const f16*)(ws + (which == 0 ? WS_WKT : WS_WVT)), D, D, D, nullptr}; pg8::StaticOrder S; S.init(256, D, 8, b % 8);
            pg8::EpiF16 E{(f16*)(ws + (which == 0 ? WS_KM : WS_VM)), D, 1.f}; pg8::gemm_phase<pg8::EpiF16, pg8::StaticOrder, true>(lds, g, S, E); }
        __syncthreads();
        p_nsa(args, lds, rep_);
        if (BOTH(3) || rep_ + 1 < NREP(3)) GRID_BAR();
    }
    for (int rep_ = 0; rep_ < NREP(4); ++rep_) if (IN(4)) { p_rwkv_out(args, lds); if (BOTH(4) || rep_ + 1 < NREP(4)) GRID_BAR(); }
    for (int rep_ = 0; rep_ < NREP(5); ++rep_) if (IN(5)) {
        PH_IDS;
        if (blockIdx.x < 64) { const int b = blockIdx.x; const int grp = b / 8, c = b % 8;
          if (grp < 4) { const int h = grp;
              pg8::Gemm g{(const f16*)(ws + WS_KM) + h * 512, (const f16*)(ws + WS_WQ16) + h * 512, D, D, 512, nullptr}; pg8::StaticOrder S; S.init(256, D, 8, c);
              pg8::EpiF16 E{(f16*)(ws + WS_WQK) + (size_t)h * 256 * D, D, 0.04419417382415922f}; pg8::gemm_phase<pg8::EpiF16, pg8::StaticOrder, true>(lds, g, S, E); }
          else { const int h = grp - 4;
              pg8::Gemm g{(const f16*)(ws + WS_WOT) + h * 512, (const f16*)(ws + WS_VM) + h * 512, D, D, 512, nullptr}; pg8::StaticOrder S; S.init(D, 256, 8, c);
              pg8::EpiF16 E{(f16*)(ws + WS_VOT) + h * 256, 1024, 1.f}; pg8::gemm_phase<pg8::EpiF16, pg8::StaticOrder, true>(lds, g, S, E); } }
        else {
        const float* onsa = (const float*)(ws + WS_ONSA); f16* mix = (f16*)(ws + WS_MIX);
        for (int m = gw - 64 * 8; m < T; m += NGW - 64 * 8) { const f32x4* xr = (const f32x4*)(onsa + (size_t)m * 1024) + lane; f32x4 v[4]; float s = 0.f;
#pragma unroll
            for (int j = 0; j < 4; ++j) { v[j] = xr[64 * j]; s += v[j].x * v[j].x + v[j].y * v[j].y + v[j].z * v[j].z + v[j].w * v[j].w; }
            const f32x4* gr = (const f32x4*)args.in[I_NSAG] + lane; f32x4 gg[4];
#pragma unroll
            for (int j = 0; j < 4; ++j) gg[j] = gr[64 * j];
            const float rstd = rsqrtf(wave_sum(s) * (1.f / 1024.f) + EPS); u32x2* o8 = (u32x2*)(mix + (size_t)m * D) + lane;
#pragma unroll
            for (int j = 0; j < 4; ++j) { u32x2 w; w.x = pkh(v[j].x * rstd * gg[j].x, v[j].y * rstd * gg[j].y); w.y = pkh(v[j].z * rstd * gg[j].z, v[j].w * rstd * gg[j].w); o8[64 * j] = w; } }
        }
        if (BOTH(5) || rep_ + 1 < NREP(5)) GRID_BAR();
    }
    for (int rep_ = 0; rep_ < NREP(6); ++rep_) if (IN(6)) {
        pg8::Gemm g{(const f16*)(ws + WS_MIX), (const f16*)(ws + WS_WOUT), D, D, D, nullptr}; pg8::StaticOrder S; S.init(T, D, G, (int)blockIdx.x);
        pg8::EpiF32 E{(float*)(ws + WS_X1), args.in[I_X], D}; pg8::gemm_phase<pg8::EpiF32, pg8::StaticOrder, true>(lds, g, S, E);
        if (BOTH(6) || rep_ + 1 < NREP(6)) GRID_BAR();
    }
    for (int rep_ = 0; rep_ < NREP(7); ++rep_) if (IN(7)) {
        PH_IDS;
        for (int m = gw; m < T; m += NGW) rms_row((const float*)(ws + WS_X1) + (size_t)m * D, args.in[I_LN2], (f16*)(ws + WS_H2) + (size_t)m * D, lane);
        p_moe_weights(args, lds);
        if (BOTH(7) || rep_ + 1 < NREP(7)) GRID_BAR();
    }
    for (int rep_ = 0; rep_ < NREP(8); ++rep_) if (IN(8)) {
        pg8::Gemm g{(const f16*)(ws + WS_H2), (const f16*)(ws + WS_WQK), D, D, D, nullptr}; pg8::StaticOrder S; S.init(T, 1024, G, (int)blockIdx.x);
        pg8::EpiF32 E{(float*)(ws + WS_S), nullptr, 1024}; pg8::gemm_phase<pg8::EpiF32, pg8::StaticOrder, true>(lds, g, S, E);
        if (BOTH(8) || rep_ + 1 < NREP(8)) GRID_BAR();
    }
    for (int rep_ = 0; rep_ < NREP(9); ++rep_) if (IN(9)) {
        PH_IDS;
        const float* Sm = (const float*)(ws + WS_S); f16* P = (f16*)(ws + WS_P);
        for (int it = gw; it < T * 4; it += NGW) { const f32x4 v = *((const f32x4*)(Sm + (size_t)it * 256) + lane);
            const float mx = wave_max(fmaxf(fmaxf(v.x, v.y), fmaxf(v.z, v.w)));
            const float e0 = __expf(v.x - mx), e1 = __expf(v.y - mx), e2 = __expf(v.z - mx), e3 = __expf(v.w - mx);
            const float inv = 1.f / wave_sum(e0 + e1 + e2 + e3);
            u32x2 w; w.x = pkh(e0 * inv, e1 * inv); w.y = pkh(e2 * inv, e3 * inv); *((u32x2*)(P + (size_t)it * 256) + lane) = w; }
        if (BOTH(9) || rep_ + 1 < NREP(9)) GRID_BAR();
    }
    for (int rep_ = 0; rep_ < NREP(10); ++rep_) if (IN(10)) {
        pg8::Gemm g{(const f16*)(ws + WS_P), (const f16*)(ws + WS_VOT), 1024, 1024, 1024, nullptr}; pg8::StaticOrder S; S.init(T, D, G, (int)blockIdx.x);
        pg8::EpiF32 E{(float*)(ws + WS_X1), (const float*)(ws + WS_X1), D}; pg8::gemm_phase<pg8::EpiF32, pg8::StaticOrder, true>(lds, g, S, E);
        if (BOTH(10) || rep_ + 1 < NREP(10)) GRID_BAR();
    }
    for (int rep_ = 0; rep_ < NREP(11); ++rep_) if (IN(11)) { p_router(args, lds, rep_); if (BOTH(11) || rep_ + 1 < NREP(11)) GRID_BAR(); }
    for (int rep_ = 0; rep_ < NREP(13); ++rep_) if (IN(13)) { p_slots(args, lds, rep_); if (BOTH(13) || rep_ + 1 < NREP(13)) GRID_BAR(); }
    for (int rep_ = 0; rep_ < NREP(14); ++rep_) if (IN(14)) {
        pg8::Gemm g{(const f16*)args.out, (const f16*)(ws + WS_WGU), D, D, D, (const int*)(ws + WS_TOK + TK_STOK)};
        pg8::TableOrder S{(const int2*)(ctl + CW_UGU), (int)ctl[CW_NGU], G, (int)blockIdx.x};
        pg8::EpiSilu E{(f16*)(ws + WS_HID)}; pg8::gemm_phase<pg8::EpiSilu, pg8::TableOrder, true, true>(lds, g, S, E);
        if (BOTH(14) || rep_ + 1 < NREP(14)) GRID_BAR();
    }
    for (int rep_ = 0; rep_ < NREP(15); ++rep_) if (IN(15)) {
        pg8::Gemm g{(const f16*)(ws + WS_HID), (const f16*)(ws + WS_WD), EFF, EFF, EFF, nullptr};
        pg8::TableOrder S{(const int2*)(ctl + CW_UDN), (int)ctl[CW_NDN], G, (int)blockIdx.x};
        pg8::EpiDown E{ws}; pg8::gemm_phase<pg8::EpiDown, pg8::TableOrder, true>(lds, g, S, E);
        if (BOTH(15) || rep_ + 1 < NREP(15)) GRID_BAR();
    }
    for (int rep_ = 0; rep_ < NREP(16); ++rep_) if (IN(16)) {
        PH_IDS;
        const float* x2 = (const float*)(ws + WS_X1); const int* tks = (const int*)(ws + WS_TOK + TK_SLOT);
        const float* tkw = (const float*)(ws + WS_TOK + TK_W);
        for (int m = gw; m < T; m += NGW) { const int s1 = tks[m * 2], s2 = tks[m * 2 + 1]; const float w1 = tkw[m * 2], w2 = tkw[m * 2 + 1];
            const f16* y1 = (const f16*)(ws + ((s1 >> 8) < 128 ? WS_Y0 + (size_t)(s1 >> 8) * MiB : WS_Y1 + (size_t)((s1 >> 8) - 128) * MiB)) + (size_t)(s1 & 255) * D;
            const f16* y2 = (const f16*)(ws + ((s2 >> 8) < 128 ? WS_Y0 + (size_t)(s2 >> 8) * MiB : WS_Y1 + (size_t)((s2 >> 8) - 128) * MiB)) + (size_t)(s2 & 255) * D;
            const f32x4* xr = (const f32x4*)(x2 + (size_t)m * D) + lane; f32x4 v[8]; float s = 0.f;
#pragma unroll
            for (int j = 0; j < 8; ++j) { v[j] = xr[64 * j]; const f16x4 a1 = *((const f16x4*)y1 + lane + 64 * j), a2 = *((const f16x4*)y2 + lane + 64 * j);
                v[j].x += w1 * (float)a1.x + w2 * (float)a2.x; v[j].y += w1 * (float)a1.y + w2 * (float)a2.y; v[j].z += w1 * (float)a1.z + w2 * (float)a2.z; v[j].w += w1 * (float)a1.w + w2 * (float)a2.w;
                s += v[j].x * v[j].x + v[j].y * v[j].y + v[j].z * v[j].z + v[j].w * v[j].w; }
            const f32x4* gr = (const f32x4*)args.in[I_LNF] + lane; f32x4 gg[8];
#pragma unroll
            for (int j = 0; j < 8; ++j) gg[j] = gr[64 * j];
            const float rstd = rsqrtf(wave_sum(s) * (1.f / D) + EPS); f32x4* o = (f32x4*)(args.out + (size_t)m * D) + lane;
#pragma unroll
            for (int j = 0; j < 8; ++j) o[64 * j] = (f32x4){v[j].x * rstd * gg[j].x, v[j].y * rstd * gg[j].y, v[j].z * rstd * gg[j].z, v[j].w * rstd * gg[j].w}; }
    }
#undef IN
#undef BOTH
#undef GRID_BAR
}

extern "C" void kernel_launch(void* const* d_in, const int* in_sizes, int n_in, void* d_out, int out_size, void* d_ws, size_t ws_size, hipStream_t stream) {
    static int grid = 0;
    if (grid == 0) {
        if (n_in != 38 || out_size != T * D || ws_size < WS_END) { fprintf(stderr, "kernel_launch: unexpected shapes (n_in %d out %d ws %zu)\n", n_in, out_size, ws_size); grid = -1; return; }
        int dev = 0, cus = 0;
        if (hipGetDevice(&dev) != hipSuccess || hipDeviceGetAttribute(&cus, hipDeviceAttributeMultiprocessorCount, dev) != hipSuccess) { grid = -1; return; }
        if (hipFuncSetAttribute((const void*)mega, hipFuncAttributeMaxDynamicSharedMemorySize, LDS_BYTES) != hipSuccess) { grid = -1; return; }
        int per_cu = 0; (void)hipOccupancyMaxActiveBlocksPerMultiprocessor(&per_cu, (const void*)mega, 512, LDS_BYTES); (void)hipGetLastError();
        grid = cus;
    }
    if (grid < 0) return;
    (void)hipMemsetAsync((char*)d_ws + WS_CTL, 0, CTL_ZERO_BYTES, stream);
    Args a{};
    for (int i = 0; i < 38; ++i) a.in[i] = (const float*)d_in[i];
    a.out = (float*)d_out; a.ws = (unsigned char*)d_ws;
#if MK_ONE_LAUNCH
    a.ph_lo = 0; a.ph_hi = NPH;
    hipLaunchKernelGGL(mega, dim3(grid), dim3(512), LDS_BYTES, stream, a);
#else
    for (int p = 0; p < NPH; ++p) { a.ph_lo = p; a.ph_hi = p + 1; hipLaunchKernelGGL(mega, dim3(grid), dim3(512), LDS_BYTES, stream, a); }
#endif
}
```

```cpp
#include <hip/hip_runtime.h>
#include <cstdio>
#include <cstdint>

#ifndef DUPMASK
#define DUPMASK 0u
#endif
#ifndef NSA_SELREP
#define NSA_SELREP 1
#endif
#ifndef NSA_CMPREP
#define NSA_CMPREP 1
#endif
#ifndef NSA_WINREP
#define NSA_WINREP 1
#endif
#ifndef DUPX
#define DUPX 0
#endif
#ifndef MK_ONE_LAUNCH
#define MK_ONE_LAUNCH 1
#endif

#define LAS __attribute__((address_space(3)))
#define GAS __attribute__((address_space(1)))
typedef _Float16 f16;
typedef _Float16 f16x8 __attribute__((ext_vector_type(8)));
typedef _Float16 f16x4 __attribute__((ext_vector_type(4)));
typedef _Float16 f16x2 __attribute__((ext_vector_type(2)));
typedef float f32x4 __attribute__((ext_vector_type(4)));
typedef float f32x2 __attribute__((ext_vector_type(2)));
typedef unsigned u32x4 __attribute__((ext_vector_type(4)));
typedef unsigned u32x2 __attribute__((ext_vector_type(2)));
typedef __bf16 bf16;
typedef __bf16 bf16x8 __attribute__((ext_vector_type(8)));
typedef __bf16 bf16x4 __attribute__((ext_vector_type(4)));

constexpr int T = 16384, D = 2048, NZ = 6144;
constexpr int ZQ = 0, ZKC = 1024, ZVC = 1280, ZKS = 1536, ZVS = 1792, ZKW = 2048, ZVW = 2304, ZR = 2560, ZK = 3584, ZV = 4608, ZWD = 5632, ZAD = 5696, ZGD = 5760, ZGL = 5920;
constexpr int NCMP = 1023;
constexpr int NEXP = 32, EFF = 256, MAXSLOT = 40960, MAXTILES = 160;
constexpr float EPS = 1e-6f;

constexpr size_t MiB = 1u << 20;
constexpr size_t WS_CTL = 0, CTL_ZERO_BYTES = 64 * 1024;
constexpr size_t WS_MEMN = 1 * MiB, WS_KM = 2 * MiB, WS_VM = 3 * MiB, WS_KCMP = 4 * MiB, WS_VCMP = 5 * MiB, WS_TOK = 6 * MiB, WS_CMPB = 7 * MiB;
constexpr size_t WS_WQK = 8 * MiB, WS_VOT = 12 * MiB, WS_WIN = 16 * MiB, WS_WOUT = 40 * MiB, WS_WQ16 = 48 * MiB, WS_WKT = 56 * MiB, WS_WVT = 64 * MiB, WS_WOT = 72 * MiB;
constexpr size_t WS_WGU = 80 * MiB, WS_WD = 144 * MiB, WS_H = 176 * MiB, WS_Z = 240 * MiB, WS_ONSA = 432 * MiB, WS_END = 512 * MiB;
constexpr size_t WS_MIX = 112 * MiB, WS_P = WS_H, WS_H2 = WS_Z, WS_X1 = 304 * MiB, WS_S = WS_ONSA, WS_HID = 16 * MiB;
constexpr size_t WS_Y0 = 176 * MiB, WS_Y1 = 432 * MiB;
constexpr size_t WS_RS = 200 * MiB, WS_SBON = 232 * MiB;
constexpr size_t WS_WUPT = WS_CMPB + 64 * 1024, WS_AUPT = WS_WUPT + 128 * 1024, WS_GUPT = WS_AUPT + 128 * 1024;
constexpr size_t WS_W1T = 496 * MiB, WS_W2T = 498 * MiB, WS_CBIAS = 498 * MiB + 65536;
constexpr size_t WS_WRH = 499 * MiB, WS_WRL = 499 * MiB + 256 * 1024;
constexpr size_t RO_M = 0, RO_N = 32 * MiB, RO_Q = 64 * MiB, RO_Y = 96 * MiB;
constexpr size_t TK_E = 0, TK_W = 128 * 1024, TK_SLOT = 256 * 1024, TK_STOK = 384 * 1024, TK_SW = 576 * 1024;
constexpr int CW_BAR = 0;
constexpr int CW_Q = 3584;
constexpr int CW_CNT = 4096, CW_CUR = 4160, CW_OFF = 4224, CW_NT = 4288  , CW_NGU = 4289, CW_NDN = 4290;
constexpr int CW_UGU = 6144  , CW_UDN = 8192  ;
static_assert((CW_UDN + MAXTILES * 8 * 2) * 4 <= (int)CTL_ZERO_BYTES, "ctl");

constexpr int RING_BYTES = 131072, LDS_BYTES = 163840, MISC_OFF = LDS_BYTES - 512;

__device__ __forceinline__ unsigned pkh(float a, float b) { f16x2 v = {(f16)a, (f16)b}; return __builtin_bit_cast(unsigned, v); }
__device__ __forceinline__ float wave_sum(float v) {
#pragma unroll
    for (int o = 1; o < 64; o <<= 1) v += __shfl_xor(v, o);
    return v;
}
__device__ __forceinline__ float wave_max(float v) {
#pragma unroll
    for (int o = 1; o < 64; o <<= 1) v = fmaxf(v, __shfl_xor(v, o));
    return v;
}
__device__ __forceinline__ int opaque_tid() { int t = threadIdx.x; asm volatile("" : "+v"(t)); return t; }
#define LDS_WAIT() asm volatile("s_waitcnt lgkmcnt(0)" ::: "memory")
#define VM_WAIT() asm volatile("s_waitcnt vmcnt(0)" ::: "memory")
__device__ __forceinline__ float sigmoidf_(float x) { return 1.f / (1.f + __expf(-x)); }

namespace pg8 {
constexpr int BM = 256, BK = 64, HALF = 128, HTB = HALF * BK * 2, STAGE_BYTES = 8 * HTB, NXCD = 8, WGM = 8;
__host__ __device__ __forceinline__ int lds_byte(int r, int c) { const int st = (r >> 4) * 2 + (c >> 5), rr = r & 15, cc = c & 31, ob = rr * 64 + cc * 2; return st * 1024 + (ob ^ (((ob >> 9) & 1) << 5)); }
__host__ __device__ __forceinline__ void stage_rc(int b, int& R, int& C) { const int st = b / 1024, sb = b % 1024, swz = sb ^ (((sb >> 9) & 1) << 5); R = (st >> 1) * 16 + swz / 64; C = (st & 1) * 32 + (swz % 64) / 2; }
__host__ __device__ __forceinline__ int perm32(int rho) { const int n = rho >> 4, i = rho & 15; return 8 * (i >> 2) + 4 * n + (i & 3); }

struct Unit { int pm, pn; };
struct Gemm { const f16* A; const f16* Bt; int lda, ldb, K; const int* gather; };

struct StaticOrder {
    int nM, nN, nwg, G, c;
    __host__ __device__ void init(int M, int N, int G_, int c_) { nM = M / BM; nN = N / BM; nwg = nM * nN; G = G_; c = c_; }
    __host__ __device__ bool next(int i, Unit& u) const {
        const long L = (long)i * G + c; if (L >= nwg) return false;
        int wgid = (int)L; { const int q = nwg / NXCD, r = nwg % NXCD, xcd = wgid % NXCD, off = wgid / NXCD; wgid = (xcd < r ? xcd * (q + 1) : r * (q + 1) + (xcd - r) * q) + off; }
        const int nig = WGM * nN, gid = wgid / nig, fm = gid * WGM, gsz = (nM - fm) < WGM ? (nM - fm) : WGM;
        u.pm = fm + ((wgid % nig) % gsz); u.pn = (wgid % nig) / gsz; return true;
    }
};
struct TableOrder {
    const int2* tab; int n, G, c;
    __device__ bool next(int i, Unit& u) const { const int L = i * G + c; if (L >= n) return false; const int2 v = tab[L]; u.pm = v.x; u.pn = v.y; return true; }
};

struct EpiF16 {
    static constexpr bool PERM = true;
    f16* O; int ldc; float scale;
    __device__ __forceinline__ void operator()(const f32x4 (&acc)[2][2][4][2], const Unit& u, int wr, int wc, int fr, int fq) const {
        const int row0 = u.pm * BM + wr * 64 + fr, col0 = u.pn * BM + wc * 32 + 8 * fq;
#pragma unroll
        for (int ai = 0; ai < 2; ++ai)
#pragma unroll
            for (int m = 0; m < 4; ++m) { f16* rowp = O + (size_t)(row0 + ai * HALF + m * 16) * ldc + col0;
#pragma unroll
                for (int bj = 0; bj < 2; ++bj) { const f32x4 v0 = acc[ai][bj][m][0] * scale, v1 = acc[ai][bj][m][1] * scale;
                    u32x4 w; w.x = pkh(v0[0], v0[1]); w.y = pkh(v0[2], v0[3]); w.z = pkh(v1[0], v1[1]); w.w = pkh(v1[2], v1[3]);
                    *(u32x4*)(rowp + bj * HALF) = w; } }
    }
};
struct EpiF32 {
    static constexpr bool PERM = false;
    float* C; const float* R; int ldc;
    __device__ __forceinline__ void operator()(const f32x4 (&acc)[2][2][4][2], const Unit& u, int wr, int wc, int fr, int fq) const {
        const int row0 = u.pm * BM + wr * 64 + fr, col0 = u.pn * BM + wc * 32 + 4 * fq;
#pragma unroll
        for (int ai = 0; ai < 2; ++ai)
#pragma unroll
            for (int m = 0; m < 4; ++m) { const size_t ro = (size_t)(row0 + ai * HALF + m * 16) * ldc + col0;
#pragma unroll
                for (int bj = 0; bj < 2; ++bj)
#pragma unroll
                    for (int n = 0; n < 2; ++n) { f32x4 v = acc[ai][bj][m][n]; if (R) v = v + *(const f32x4*)(R + ro + bj * HALF + n * 16); *(f32x4*)(C + ro + bj * HALF + n * 16) = v; } }
    }
};
struct EpiSilu {
    static constexpr bool PERM = true;
    f16* O;
    __device__ __forceinline__ void operator()(const f32x4 (&acc)[2][2][4][2], const Unit& u, int wr, int wc, int fr, int fq) const {
        const int row0 = u.pm * BM + wr * 64 + fr, col0 = (u.pn & 1) * 128 + wc * 32 + 8 * fq;
#pragma unroll
        for (int ai = 0; ai < 2; ++ai)
#pragma unroll
            for (int m = 0; m < 4; ++m) { f16* rowp = O + (size_t)(row0 + ai * HALF + m * 16) * EFF + col0;
                float h[8];
#pragma unroll
                for (int n = 0; n < 2; ++n)
#pragma unroll
                    for (int e = 0; e < 4; ++e) { const float gt = acc[ai][0][m][n][e], up = acc[ai][1][m][n][e]; h[n * 4 + e] = gt / (1.f + __expf(-gt)) * up; }
                u32x4 w; w.x = pkh(h[0], h[1]); w.y = pkh(h[2], h[3]); w.z = pkh(h[4], h[5]); w.w = pkh(h[6], h[7]);
                *(u32x4*)rowp = w; }
    }
};
struct EpiDown {
    static constexpr bool PERM = true;
    unsigned char* ws;
    __device__ __forceinline__ void operator()(const f32x4 (&acc)[2][2][4][2], const Unit& u, int wr, int wc, int fr, int fq) const {
        f16* tile = (f16*)(ws + (u.pm < 128 ? WS_Y0 + (size_t)u.pm * MiB : WS_Y1 + (size_t)(u.pm - 128) * MiB));
        const int r0 = wr * 64 + fr, col0 = (u.pn & 7) * BM + wc * 32 + 8 * fq;
#pragma unroll
        for (int ai = 0; ai < 2; ++ai)
#pragma unroll
            for (int m = 0; m < 4; ++m) { f16* rowp = tile + (size_t)(r0 + ai * HALF + m * 16) * D + col0;
#pragma unroll
                for (int bj = 0; bj < 2; ++bj) { const f32x4 v0 = acc[ai][bj][m][0], v1 = acc[ai][bj][m][1];
                    u32x4 w; w.x = pkh(v0[0], v0[1]); w.y = pkh(v0[2], v0[3]); w.z = pkh(v1[0], v1[1]); w.w = pkh(v1[2], v1[3]);
                    *(u32x4*)(rowp + bj * HALF) = w; } }
    }
};

template <class Epi, class Sched, bool ALIGN_EPI, bool GATHER = false>
__device__ __forceinline__ void gemm_phase(LAS unsigned char* lds, const Gemm g, const Sched& S, const Epi& E) {
    const int tid = opaque_tid(), wid = __builtin_amdgcn_readfirstlane(tid >> 6), lane = tid & 63, wr = wid >> 2, wc = wid & 3, fr = lane & 15, fq = lane >> 4;
    const int K = g.K, nt = K / BK;
    int RA[2], CA[2]; unsigned voffA[2], voffB[2];
#pragma unroll
    for (int i = 0; i < 2; ++i) { int R, C; stage_rc(tid * 16 + i * 8192, R, C); const int Rb = Epi::PERM ? ((R & ~31) + perm32(R & 31)) : R;
        RA[i] = R; CA[i] = C; voffA[i] = (unsigned)(R * g.lda + C) * 2u; voffB[i] = (unsigned)(Rb * g.ldb + C) * 2u; }
    const size_t kstep = (size_t)(BK * 2);
    const size_t hstepA = (size_t)HALF * g.lda * 2, tstepA = 2 * hstepA;
    const size_t hstepB = (size_t)HALF * g.ldb * 2, tstepB = 2 * hstepB;
    const unsigned ldsw = (unsigned)wid * 1024u;
    const int aoff = lds_byte(wr * 64 + fr, fq * 8), boff = lds_byte(wc * 32 + fr, fq * 8);
    const char* Ab = (const char*)g.A;
#define PG8_SA(b, h) (((b) * 2 + (h)) * HTB)
#define PG8_SB(b, h) ((4 + (b) * 2 + (h)) * HTB)
#define PG8_STAGE(bufoff, gbase, voff) do { _Pragma("unroll") for (int _i = 0; _i < 2; ++_i) \
        __builtin_amdgcn_global_load_lds((const unsigned*)((const char*)(gbase) + (voff)[_i]), (LAS unsigned*)(lds + (bufoff) + ldsw + _i * 8192), 16, 0, 0); } while (0)
#define PG8_STA_CUR(bufoff, h, kb) do { if constexpr (GATHER) { PG8_STAGE(bufoff, Ab + (kb), offC[h]); } else { PG8_STAGE(bufoff, cA + (h) * hstepA + (kb), voffA); } } while (0)
#define PG8_STA_SEL(bufoff, h, kb) do { if constexpr (GATHER) { PG8_STAGE(bufoff, Ab + (kb), o2[h]); } else { PG8_STAGE(bufoff, a2p + (h) * hstepA + (kb), voffA); } } while (0)
#define PG8_LDA(dst, b, h) do { _Pragma("unroll") for (int m = 0; m < 4; ++m) _Pragma("unroll") for (int k = 0; k < 2; ++k) dst[m][k] = *(const LAS f16x8*)(lds + PG8_SA(b, h) + aoff + m * 2048 + k * 1024); } while (0)
#define PG8_LDB(dst, b, h) do { _Pragma("unroll") for (int n = 0; n < 2; ++n) _Pragma("unroll") for (int k = 0; k < 2; ++k) dst[n][k] = *(const LAS f16x8*)(lds + PG8_SB(b, h) + boff + n * 2048 + k * 1024); } while (0)
#define PG8_MMA(ai, bj, At, Bt) do { __builtin_amdgcn_s_setprio(1); _Pragma("unroll") for (int m = 0; m < 4; ++m) _Pragma("unroll") for (int n = 0; n < 2; ++n) _Pragma("unroll") for (int k = 0; k < 2; ++k) \
        acc[ai][bj][m][n] = __builtin_amdgcn_mfma_f32_16x16x32_f16(Bt[n][k], At[m][k], acc[ai][bj][m][n], 0, 0, 0); __builtin_amdgcn_s_setprio(0); } while (0)
#define PG8_WAIT_V(n) asm volatile("s_waitcnt vmcnt(" #n ")" ::: "memory")
#define PG8_WAIT_L(n) asm volatile("s_waitcnt lgkmcnt(" #n ")" ::: "memory")
#define PG8_BAR __builtin_amdgcn_s_barrier()
#define PG8_SCHED __builtin_amdgcn_sched_barrier(0)
#define PG8_OFFS(dst, U) do { _Pragma("unroll") for (int _h = 0; _h < 2; ++_h) _Pragma("unroll") for (int _i = 0; _i < 2; ++_i) { \
        const int _r = (U).pm * BM + _h * HALF + RA[_i]; dst[_h][_i] = ((unsigned)g.gather[_r] * (unsigned)g.lda + (unsigned)CA[_i]) * 2u; } } while (0)
    Unit cur, nxt; int ui = 0;
    if (!S.next(0, cur)) return;
    f32x4 acc[2][2][4][2];
#pragma unroll
    for (int a = 0; a < 2; ++a)
#pragma unroll
        for (int b = 0; b < 2; ++b)
#pragma unroll
            for (int m = 0; m < 4; ++m)
#pragma unroll
                for (int n = 0; n < 2; ++n) acc[a][b][m][n] = (f32x4){0.f, 0.f, 0.f, 0.f};
    f16x8 At[4][2], B0[2][2], B1[2][2];
    unsigned offC[2][2], offN[2][2];
    if constexpr (GATHER) { PG8_OFFS(offC, cur); }
    const char* cA = Ab + (size_t)cur.pm * tstepA;
    const char* cB = (const char*)g.Bt + (size_t)cur.pn * tstepB;
    PG8_STAGE(PG8_SB(0, 0), cB, voffB); PG8_STAGE(PG8_SB(0, 1), cB + hstepB, voffB); PG8_STA_CUR(PG8_SA(0, 0), 0, 0); PG8_STA_CUR(PG8_SA(0, 1), 1, 0);
    if (wr == 1) PG8_BAR;
    PG8_WAIT_V(2); PG8_BAR;
    PG8_STAGE(PG8_SB(1, 0), cB + kstep, voffB); PG8_STA_CUR(PG8_SA(1, 0), 0, kstep); PG8_STAGE(PG8_SB(1, 1), cB + hstepB + kstep, voffB);
    PG8_WAIT_V(6); PG8_BAR;
    for (;;) {
        const bool has_next = S.next(ui + 1, nxt);
        if constexpr (GATHER) {
            if (has_next) { PG8_OFFS(offN, nxt); } else {
#pragma unroll
                for (int _h = 0; _h < 2; ++_h)
#pragma unroll
                    for (int _i = 0; _i < 2; ++_i) offN[_h][_i] = offC[_h][_i]; } }
        const char* nA = has_next ? Ab + (size_t)nxt.pm * tstepA : cA;
        const char* nB = has_next ? (const char*)g.Bt + (size_t)nxt.pn * tstepB : cB;
#pragma nounroll
        for (int t = 0; t < nt; t += 2) {
            const bool last = (t == nt - 2);
            const size_t kb1 = (size_t)(t + 1) * kstep;
            const size_t kb2 = last ? 0 : (size_t)(t + 2) * kstep, kb3 = kb2 + kstep;
            unsigned o2[2][2];
            if constexpr (GATHER) {
#pragma unroll
                for (int _h = 0; _h < 2; ++_h)
#pragma unroll
                    for (int _i = 0; _i < 2; ++_i) o2[_h][_i] = last ? offN[_h][_i] : offC[_h][_i]; }
            const char* a2p = last ? nA : cA;
            const char* b2 = last ? nB : cB + (size_t)(t + 2) * kstep; const char* b3 = b2 + kstep;
            PG8_LDB(B0, 0, 0); PG8_LDB(B1, 0, 1); PG8_SCHED; PG8_LDA(At, 0, 0); PG8_STA_CUR(PG8_SA(1, 1), 1, kb1);
            PG8_WAIT_V(8); PG8_WAIT_L(0); PG8_BAR; PG8_MMA(0, 0, At, B0); PG8_MMA(0, 1, At, B1); PG8_BAR; PG8_SCHED;
            PG8_LDA(At, 0, 1); PG8_STAGE(PG8_SB(0, 0), b2, voffB); PG8_STAGE(PG8_SB(0, 1), b2 + hstepB, voffB); PG8_STA_SEL(PG8_SA(0, 0), 0, kb2);
            PG8_WAIT_V(8); PG8_WAIT_L(0); PG8_BAR; PG8_MMA(1, 0, At, B0); PG8_MMA(1, 1, At, B1); PG8_BAR; PG8_SCHED;
            PG8_LDB(B0, 1, 0); PG8_LDB(B1, 1, 1); PG8_SCHED; PG8_LDA(At, 1, 0); PG8_STA_SEL(PG8_SA(0, 1), 1, kb2);
            PG8_WAIT_V(8); PG8_WAIT_L(0); PG8_BAR; PG8_MMA(0, 0, At, B0); PG8_MMA(0, 1, At, B1); PG8_BAR; PG8_SCHED;
            PG8_LDA(At, 1, 1); PG8_STAGE(PG8_SB(1, 0), b3, voffB); PG8_STAGE(PG8_SB(1, 1), b3 + hstepB, voffB); PG8_STA_SEL(PG8_SA(1, 0), 0, kb3);
            PG8_WAIT_V(8); PG8_WAIT_L(0); PG8_BAR; PG8_MMA(1, 0, At, B0); PG8_MMA(1, 1, At, B1); PG8_BAR; PG8_SCHED;
        }
        if constexpr (ALIGN_EPI) { if (wr == 0) PG8_BAR; }
        E(acc, cur, wr, wc, fr, fq);
        if (!has_next) break;
#pragma unroll
        for (int a = 0; a < 2; ++a)
#pragma unroll
            for (int b = 0; b < 2; ++b)
#pragma unroll
                for (int m = 0; m < 4; ++m)
#pragma unroll
                    for (int n = 0; n < 2; ++n) acc[a][b][m][n] = (f32x4){0.f, 0.f, 0.f, 0.f};
        cur = nxt; cA = nA; cB = nB; ++ui;
        if constexpr (GATHER) {
#pragma unroll
            for (int _h = 0; _h < 2; ++_h)
#pragma unroll
                for (int _i = 0; _i < 2; ++_i) offC[_h][_i] = offN[_h][_i]; }
        if constexpr (ALIGN_EPI) { if (wr == 1) PG8_BAR; }
    }
    PG8_WAIT_V(0);
    if constexpr (!ALIGN_EPI) { if (wr == 0) PG8_BAR; }
    PG8_BAR;
#undef PG8_SA
#undef PG8_SB
#undef PG8_STAGE
#undef PG8_STA_CUR
#undef PG8_STA_SEL
#undef PG8_LDA
#undef PG8_LDB
#undef PG8_MMA
#undef PG8_WAIT_V
#undef PG8_WAIT_L
#undef PG8_BAR
#undef PG8_SCHED
#undef PG8_OFFS
}
}

#define XB_TMO      128
#define XB_XCNT(j)  (256  + 64 * (j))
#define XB_XSUB(j)  (1280 + 64 * (j))
#define XB_XGEN(j)  (2304 + 64 * (j))
#define XB_TOP      3328
#define XB_TOPGEN   3392
#define XCD_BAR_WORDS 3456
#define XB_SPIN_CAP (1u << 22)
__device__ __forceinline__ unsigned xb_ld(unsigned* p)              { return __hip_atomic_load(p, __ATOMIC_RELAXED, __HIP_MEMORY_SCOPE_AGENT); }
__device__ __forceinline__ unsigned xb_add(unsigned* p, unsigned v) { return __hip_atomic_fetch_add(p, v, __ATOMIC_RELAXED, __HIP_MEMORY_SCOPE_AGENT); }
__device__ __forceinline__ unsigned xb_xcc_id() { return (unsigned)__builtin_amdgcn_s_getreg((3 << 11) | 20) & 0xFu; }
#define XB_SPIN(cond, bar) do { unsigned _sp = 0; while (cond) { __builtin_amdgcn_s_sleep(1); \
    if ((++_sp & 255u) == 0u) { if (xb_ld(&(bar)[XB_TMO])) break; if (_sp > XB_SPIN_CAP) { atomicAdd(&(bar)[XB_TMO], 1u); break; } } } } while (0)
struct XcdBarrier { unsigned* bar; unsigned x; volatile LAS unsigned* st; };
__device__ __forceinline__ XcdBarrier xcd_barrier_post(unsigned* bar, volatile LAS unsigned* st) {
    XcdBarrier b; b.bar = bar; b.x = xb_xcc_id(); b.st = st;
    if (threadIdx.x == 0) (void)xb_add(&bar[XB_XCNT(b.x)], 1u);
    return b;
}
__device__ __forceinline__ void xcd_barrier_complete(unsigned* bar, unsigned x, unsigned& nloc, unsigned& nx) {
    const unsigned G = gridDim.x * gridDim.y * gridDim.z;
    unsigned sum, cnt, mine, sp = 0u;
    for (;;) {
        sum = 0u; cnt = 0u; mine = 0u;
#pragma unroll
        for (unsigned j = 0; j < 16; ++j) { const unsigned c = xb_ld(&bar[XB_XCNT(j)]); sum += c; cnt += (c > 0u) ? 1u : 0u; mine = (j == x) ? c : mine; }
        if (sum == G) break;
        __builtin_amdgcn_s_sleep(1);
        if ((++sp & 255u) == 0u) { if (xb_ld(&bar[XB_TMO])) break; if (sp > XB_SPIN_CAP) { atomicAdd(&bar[XB_TMO], 1u); break; } }
    }
    nloc = mine > 0u ? mine : 1u; nx = cnt > 0u ? cnt : 1u;
}
__device__ __forceinline__ void xcd_barrier(const XcdBarrier& b) {
    asm volatile("s_waitcnt vmcnt(0)" ::: "memory");
    __syncthreads();
    if (threadIdx.x == 0) {
        unsigned* bar = b.bar;
        __builtin_amdgcn_s_waitcnt(0);
        unsigned nloc = b.st[0], nx = b.st[1];
        if (nloc == 0u) { xcd_barrier_complete(bar, b.x, nloc, nx); b.st[0] = nloc; b.st[1] = nx; }
        const unsigned old = xb_add(&bar[XB_XSUB(b.x)], 1u);
        const unsigned gen = old / nloc;
        if (old + 1u == (gen + 1u) * nloc) {
            __builtin_amdgcn_fence(__ATOMIC_RELEASE, "agent");
            asm volatile("s_waitcnt vmcnt(0)" ::: "memory");
            const unsigned og = xb_add(&bar[XB_TOP], 1u);
            const unsigned tg = og / nx;
            if (og + 1u == (tg + 1u) * nx) xb_add(&bar[XB_TOPGEN], 1u);
            else XB_SPIN(xb_ld(&bar[XB_TOPGEN]) == tg, bar);
            __builtin_amdgcn_fence(__ATOMIC_ACQUIRE, "agent");
            xb_add(&bar[XB_XGEN(b.x)], 1u);
            asm volatile("s_waitcnt vmcnt(0)" ::: "memory");
        } else {
            XB_SPIN(xb_ld(&bar[XB_XGEN(b.x)]) == gen, bar);
            __builtin_amdgcn_fence(__ATOMIC_ACQUIRE, "agent");
            asm volatile("s_waitcnt vmcnt(0)" ::: "memory");
        }
    }
    __syncthreads();
}

struct Args { const float* in[38]; float* out; unsigned char* ws; int ph_lo, ph_hi; };
enum { I_X = 0, I_MEM, I_LN1, I_WIN, I_PK, I_W1K, I_W2K, I_PV, I_W1V, I_W2V, I_NSAG, I_MU, I_W0, I_WUP, I_A0, I_AUP, I_GUP, I_KK, I_KA, I_RK, I_LNXG, I_LNXB,
       I_WOUT, I_LNMEM, I_LN2, I_WQ, I_WK, I_WV, I_WO, I_LN3, I_RGW, I_RGB, I_REW, I_REB, I_MG, I_MU2, I_MD, I_LNF };

__device__ __forceinline__ void tr_item(const float* src, int sld, int k0, int scol0, int nvalid, f16* dst, size_t drow0, int dld, LAS float* scr, int lane) {
    const int nl = lane & 31;
    float tv[32];
#pragma unroll
    for (int i = 0; i < 32; ++i) { const int kk = 2 * i + (lane >> 5); tv[i] = (nl < nvalid) ? src[(size_t)(k0 + kk) * sld + scol0 + nl] : 0.f; }
#pragma unroll
    for (int i = 0; i < 32; ++i) { const int kk = 2 * i + (lane >> 5); scr[kk * 33 + nl] = tv[i]; }
    LDS_WAIT(); asm volatile("" ::: "memory");
    const int c = lane & 7;
#pragma unroll
    for (int j = 0; j < 4; ++j) { const int n = (lane >> 3) + 8 * j; const LAS float* s = scr + (8 * c) * 33 + n;
        u32x4 o; o.x = pkh(s[0 * 33], s[1 * 33]); o.y = pkh(s[2 * 33], s[3 * 33]); o.z = pkh(s[4 * 33], s[5 * 33]); o.w = pkh(s[6 * 33], s[7 * 33]);
        *(u32x4*)(dst + (drow0 + n) * (size_t)dld + k0 + 8 * c) = o; }
    LDS_WAIT(); asm volatile("" ::: "memory");
}
__device__ __forceinline__ void tr_matrix(const float* src, int K, int N, f16* dst, LAS float* scr, int gw, int NGW, int lane) {
    const int nblk = N / 32, items = (K / 64) * nblk;
    for (int it = gw; it < items; it += NGW) { const int kb = it / nblk, nb = it % nblk; tr_item(src, N, kb * 64, nb * 32, 32, dst, (size_t)nb * 32, K, scr, lane); }
}
__device__ __forceinline__ void rms_row(const float* xrow, const float* gain, f16* o16, int lane) {
    const f32x4* xr = (const f32x4*)xrow + lane; f32x4 v[8]; float s = 0.f;
#pragma unroll
    for (int j = 0; j < 8; ++j) { v[j] = xr[64 * j]; s += v[j].x * v[j].x + v[j].y * v[j].y + v[j].z * v[j].z + v[j].w * v[j].w; }
    const f32x4* gr = (const f32x4*)gain + lane; f32x4 gg[8];
#pragma unroll
    for (int j = 0; j < 8; ++j) gg[j] = gr[64 * j];
    const float rstd = rsqrtf(wave_sum(s) * (1.f / D) + EPS);
    u32x2* o8 = (u32x2*)o16 + lane;
#pragma unroll
    for (int j = 0; j < 8; ++j) { u32x2 w; w.x = pkh(v[j].x * rstd * gg[j].x, v[j].y * rstd * gg[j].y); w.y = pkh(v[j].z * rstd * gg[j].z, v[j].w * rstd * gg[j].w); o8[64 * j] = w; }
}

__device__ __forceinline__ void p0_prologue(const Args& a, LAS unsigned char* lds) {
    const int tid = opaque_tid(), lane = tid & 63, wave = tid >> 6;
    const int gw = blockIdx.x * 8 + wave, NGW = gridDim.x * 8;
    LAS float* scr = (LAS float*)(lds + wave * 16384);
    unsigned char* ws = a.ws;
    { f16* dst = (f16*)(ws + WS_WIN); const float* src = a.in[I_WIN];
      const int nblk = NZ / 32, items = (D / 64) * nblk;
      for (int it = gw; it < items; it += NGW) { const int kb = it / nblk, nb = it % nblk, n0 = nb * 32;
          int sc = 0, nv = 32; if (n0 < 2560) sc = n0; else if (n0 < 5920) sc = n0 + 24; else if (n0 == 5920) { sc = 2560; nv = 24; } else { sc = 0; nv = 0; }
          tr_item(src, 5944, kb * 64, sc, nv, dst, (size_t)n0, D, scr, lane); } }
    tr_matrix(a.in[I_WOUT], D, D, (f16*)(ws + WS_WOUT), scr, gw, NGW, lane);
    tr_matrix(a.in[I_WK], D, D, (f16*)(ws + WS_WKT), scr, gw, NGW, lane);
    tr_matrix(a.in[I_WV], D, D, (f16*)(ws + WS_WVT), scr, gw, NGW, lane);
    tr_matrix(a.in[I_WO], D, D, (f16*)(ws + WS_WOT), scr, gw, NGW, lane);
    { const f32x4* s = (const f32x4*)a.in[I_WQ]; u32x2* d = (u32x2*)(ws + WS_WQ16);
      for (size_t i = (size_t)blockIdx.x * 512 + tid; i < (size_t)D * D / 4; i += (size_t)gridDim.x * 512) { const f32x4 v = s[i]; u32x2 w; w.x = pkh(v.x, v.y); w.y = pkh(v.z, v.w); d[i] = w; } }
    tr_matrix(a.in[I_W1K], 4096, 128, (f16*)(ws + WS_W1T), scr, gw, NGW, lane);
    tr_matrix(a.in[I_W1V], 4096, 128, (f16*)(ws + WS_W1T) + 128 * 4096, scr, gw, NGW, lane);
    tr_matrix(a.in[I_W2K], 128, 128, (f16*)(ws + WS_W2T), scr, gw, NGW, lane);
    tr_matrix(a.in[I_W2V], 128, 128, (f16*)(ws + WS_W2T) + 128 * 128, scr, gw, NGW, lane);
    for (int o = gw; o < 256; o += NGW) { const int kv = o >> 7, n = o & 127; const float* pos = a.in[kv ? I_PV : I_PK]; const float* w1 = a.in[kv ? I_W1V : I_W1K]; float acc = 0.f;
        for (int k = lane; k < 4096; k += 64) acc += pos[k] * w1[(size_t)k * 128 + n];
        acc = wave_sum(acc); if (lane == 0) ((float*)(ws + WS_CBIAS))[o] = acc; }
    for (int i = blockIdx.x * 512 + tid; i < 48 * D; i += gridDim.x * 512) { const int c = i / D, k = i % D; float v = 0.f;
        if (c < 4) v = a.in[I_RGW][k * 4 + c]; else if (c < 36) v = a.in[I_REW][k * 32 + (c - 4)];
        v *= a.in[I_LN3][k]; const f16 hi = (f16)v; ((f16*)(ws + WS_WRH))[i] = hi; ((f16*)(ws + WS_WRL))[i] = (f16)(v - (float)hi); }
    { bf16* wu = (bf16*)(ws + WS_WUPT); bf16* au = (bf16*)(ws + WS_AUPT); bf16* gu = (bf16*)(ws + WS_GUPT);
      for (int i = blockIdx.x * 512 + tid; i < 1024 * 64; i += gridDim.x * 512) { const int ch = i >> 6, j = i & 63; wu[i] = (bf16)a.in[I_WUP][j * 1024 + ch]; au[i] = (bf16)a.in[I_AUP][j * 1024 + ch]; }
      for (int i = blockIdx.x * 512 + tid; i < 1024 * 160; i += gridDim.x * 512) { const int ch = i / 160, j = i % 160; gu[i] = (bf16)a.in[I_GUP][j * 1024 + ch]; } }
    for (int m = gw; m < T; m += NGW) rms_row(a.in[I_X] + (size_t)m * D, a.in[I_LN1], (f16*)(ws + WS_H) + (size_t)m * D, lane);
    for (int m = gw; m < 256; m += NGW) rms_row(a.in[I_MEM] + (size_t)m * D, a.in[I_LNMEM], (f16*)(ws + WS_MEMN) + (size_t)m * D, lane);
}

__device__ __forceinline__ void p_moe_weights(const Args& a, LAS unsigned char* lds) {
    const int tid = opaque_tid(), lane = tid & 63, wave = tid >> 6;
    const int gw = blockIdx.x * 8 + wave, NGW = gridDim.x * 8;
    LAS float* scr = (LAS float*)(lds + wave * 16384);
    unsigned char* ws = a.ws;
    { f16* dst = (f16*)(ws + WS_WGU); const int items = NEXP * (D / 64) * 16;
      for (int it = gw; it < items; it += NGW) { const int e = it / ((D / 64) * 16), r = it % ((D / 64) * 16), kb = r / 16, nb = r % 16, j0 = nb * 32, jt = j0 / 256, jj = j0 % 256;
          const float* src = (jj < 128 ? a.in[I_MG] : a.in[I_MU2]) + (size_t)e * D * EFF; const int sc = jt * 128 + (jj & 127);
          tr_item(src, EFF, kb * 64, sc, 32, dst, (size_t)e * 512 + j0, D, scr, lane); } }
    { f16* dst = (f16*)(ws + WS_WD); const int items = NEXP * (EFF / 64) * (D / 32);
      for (int it = gw; it < items; it += NGW) { const int e = it / ((EFF / 64) * (D / 32)), r = it % ((EFF / 64) * (D / 32)), kb = r / (D / 32), nb = r % (D / 32);
          tr_item(a.in[I_MD] + (size_t)e * EFF * D, D, kb * 64, nb * 32, 32, dst, (size_t)e * D + nb * 32, EFF, scr, lane); } }
}

__device__ __forceinline__ float gelu_tanh(float x) { const float u = 0.7978845608028654f * (x + 0.044715f * x * x * x); const float e = __expf(2.f * u); return 0.5f * x * (2.f - 2.f / (e + 1.f)); }
constexpr int CP_RS = 272, CP_HS = 136, CP_HID = 272 * CP_RS;
__device__ __forceinline__ void p_compress(const Args& a, LAS unsigned char* lds) {
    const int tid = opaque_tid(), lane = tid & 63, w = __builtin_amdgcn_readfirstlane(tid >> 6);
    const f16* z = (const f16*)(a.ws + WS_Z);
    LAS f16* HID = (LAS f16*)(lds + CP_HID);
    for (int it = blockIdx.x; it < 256; it += gridDim.x) {
        const int kv = it >> 7, g = (it >> 6) & 1, c0 = (it & 63) * 16, tok0 = 16 * c0;
        const int zc = (kv ? ZVC : ZKC) + g * 128;
        __syncthreads();
        for (int ck = tid; ck < 272 * 16; ck += 512) { const int tl = ck >> 4, c16 = ck & 15, tok = tok0 + tl; const int rp = (tl & 15) * 17 + (tl >> 4);
            u32x4 v = {0u, 0u, 0u, 0u}; if (tok < T) v = *(const u32x4*)(z + (size_t)tok * NZ + zc + c16 * 8);
            *(LAS u32x4*)(lds + rp * CP_RS + c16 * 16) = v; }
        __syncthreads();
        f32x4 acc = {0.f, 0.f, 0.f, 0.f};
        const f16* wp = (const f16*)(a.ws + WS_W1T) + ((size_t)kv * 128 + 16 * w + (lane & 15)) * 4096 + 8 * (lane >> 4);
        const LAS unsigned char* ap = lds + (lane & 15) * CP_RS + 16 * (lane >> 4);
#pragma unroll 8
        for (int ks = 0; ks < 128; ++ks) { const int l = ks >> 2;
            const f16x8 av = *(const LAS f16x8*)(ap + ((l & 15) * 17 + (l >> 4)) * CP_RS + (ks & 3) * 64);
            const f16x8 bv = *(const f16x8*)(wp + 32 * ks);
            acc = __builtin_amdgcn_mfma_f32_16x16x32_f16(av, bv, acc, 0, 0, 0); }
        { const int n = 16 * w + (lane & 15); const float bs = ((const float*)(a.ws + WS_CBIAS))[kv * 128 + n];
#pragma unroll
          for (int r = 0; r < 4; ++r) HID[(4 * (lane >> 4) + r) * CP_HS + n] = (f16)gelu_tanh(acc[r] + bs); }
        __syncthreads();
        f32x4 o = {0.f, 0.f, 0.f, 0.f};
        const f16* w2p = (const f16*)(a.ws + WS_W2T) + ((size_t)kv * 128 + 16 * w + (lane & 15)) * 128 + 8 * (lane >> 4);
#pragma unroll
        for (int ks = 0; ks < 4; ++ks) { const f16x8 av = *(const LAS f16x8*)(HID + (lane & 15) * CP_HS + 32 * ks + 8 * (lane >> 4)); const f16x8 bv = *(const f16x8*)(w2p + 32 * ks);
            o = __builtin_amdgcn_mfma_f32_16x16x32_f16(av, bv, o, 0, 0, 0); }
        f16* dst = (f16*)(a.ws + (kv ? WS_VCMP : WS_KCMP));
#pragma unroll
        for (int r = 0; r < 4; ++r) { const int c = c0 + 4 * (lane >> 4) + r; dst[((size_t)c * 2 + g) * 128 + 16 * w + (lane & 15)] = c < NCMP ? (f16)o[r] : (f16)0.f; }
    }
}

typedef float f32x16 __attribute__((ext_vector_type(16)));
typedef short v4i16_t __attribute__((ext_vector_type(4)));
constexpr int NS_PSEL = 65536, NS_PSTR = 257, NS_SELB = NS_PSEL + 64 * NS_PSTR * 4, NS_WANY = NS_SELB + 2048, NS_LIST = NS_WANY + 256, NS_CNT = NS_LIST + 512, NS_UNIT = NS_CNT + 64;
static_assert(NS_UNIT + 64 <= MISC_OFF, "nsa lds");
__device__ __forceinline__ unsigned offb(unsigned row, unsigned ch) { return 256u * row + 16u * (ch ^ (((row & 3u) << 2) | ((row >> 2) & 3u))); }
__device__ __forceinline__ void glds16(const void* gsrc, unsigned lds_dst) { unsigned keep;
    asm volatile("s_mov_b32 %0, m0\n\ts_mov_b32 m0, %2\n\ts_nop 0\n\tglobal_load_lds_dwordx4 %1, off\n\ts_mov_b32 m0, %0" : "=&s"(keep) : "v"(gsrc), "s"(lds_dst) : "memory"); }
__device__ __forceinline__ void ns_dma(const f16* g0, size_t gstride, unsigned lds_addr, int wv, int lane) {
#pragma unroll
    for (int i = 0; i < 2; ++i) { const int piece = wv * 2 + i, row = 4 * piece + (lane >> 4), slot = lane & 15, ch = slot ^ (((row & 3) << 2) | ((row >> 2) & 3));
        glds16(g0 + (size_t)row * gstride + ch * 8, lds_addr + piece * 1024); }
}
#define NS_VMW(n) asm volatile("s_waitcnt vmcnt(" #n ")" ::: "memory")
__device__ __forceinline__ void ns_qk(f32x16& s0, f32x16& s1, const LAS unsigned char* kb, const f16x8 (&qf)[8], int rho_, int hh_, float init) {
    unsigned rho = (unsigned)rho_, hh = (unsigned)hh_;
    asm volatile("" : "+v"(rho), "+v"(hh));
    const unsigned xr = ((rho & 3u) << 2) | ((rho >> 2) & 3u);
    const LAS unsigned char* kbase = kb + 256u * rho + 16u * ((hh ^ xr) & 1u); const unsigned xs = xr >> 1;
#pragma unroll
    for (int i = 0; i < 16; ++i) { s0[i] = init; s1[i] = init; }
    f16x8 af[8];
#pragma unroll
    for (int s = 0; s < 8; ++s) af[s] = *(const LAS f16x8*)(kbase + 32u * ((unsigned)s ^ xs));
#pragma unroll
    for (int s = 0; s < 8; ++s) s0 = __builtin_amdgcn_mfma_f32_32x32x16_f16(af[s], qf[s], s0, 0, 0, 0);
#pragma unroll
    for (int s = 0; s < 8; ++s) af[s] = *(const LAS f16x8*)(kbase + 32u * ((unsigned)s ^ xs) + 8192);
#pragma unroll
    for (int s = 0; s < 8; ++s) s1 = __builtin_amdgcn_mfma_f32_32x32x16_f16(af[s], qf[s], s1, 0, 0, 0);
}
__device__ __forceinline__ void ns_pv(f32x16 (&O)[4], const LAS unsigned char* vb, const f32x16& p0, const f32x16& p1, int lane_) {
    unsigned lane = (unsigned)lane_;
    asm volatile("" : "+v"(lane));
    const unsigned hh = lane >> 5, blk = (lane >> 4) & 1, q = (lane & 15) >> 2, pp = lane & 3;
    const unsigned x = 2 * blk + (pp >> 1);
    const LAS unsigned char* vbase[2];
#pragma unroll
    for (int t = 0; t < 2; ++t) { const unsigned w = (hh + 2 * t) & 3u; vbase[t] = vb + 256u * (4 * hh + 8 * t + q) + 16u * (x ^ w) + 8u * (pp & 1); }
    f16x8 pf[4];
#pragma unroll
    for (int kh = 0; kh < 2; ++kh)
#pragma unroll
        for (int sp = 0; sp < 2; ++sp)
#pragma unroll
            for (int j = 0; j < 8; ++j) pf[kh * 2 + sp][j] = (f16)(kh ? p1[8 * sp + j] : p0[8 * sp + j]);
#pragma unroll
    for (int c = 0; c < 4; ++c) { const unsigned cq = 64u * ((unsigned)c ^ q);
        const LAS unsigned char* b0 = vbase[0] + cq; const LAS unsigned char* b1 = vbase[1] + cq;
#pragma unroll
        for (int kh = 0; kh < 2; ++kh)
#pragma unroll
            for (int sp = 0; sp < 2; ++sp) {
                const v4i16_t lo = __builtin_amdgcn_ds_read_tr16_b64_v4i16((LAS v4i16_t*)(b0 + 256 * (32 * kh + 16 * sp)));
                const v4i16_t hi = __builtin_amdgcn_ds_read_tr16_b64_v4i16((LAS v4i16_t*)(b1 + 256 * (32 * kh + 16 * sp)));
                typedef short s16x8 __attribute__((ext_vector_type(8)));
                const s16x8 v8 = {lo[0], lo[1], lo[2], lo[3], hi[0], hi[1], hi[2], hi[3]};
                O[c] = __builtin_amdgcn_mfma_f32_32x32x16_f16(__builtin_bit_cast(f16x8, v8), pf[kh * 2 + sp], O[c], 0, 0, 0); }
    }
}
#define NS_KIDX(r, hh) ((int)(((r) & 3) + 8 * ((r) >> 2) + 4 * (hh)))
constexpr float NS_THR = 6.f;
template <bool WITH_O> __device__ __forceinline__ void ns_online(f32x16& y0, f32x16& y1, float& m, float& l, bool& seen, f32x16 (&O)[4]) {
    float mx = fmaxf(y0[0], y1[0]);
#pragma unroll
    for (int i = 1; i < 16; ++i) mx = fmaxf(mx, fmaxf(y0[i], y1[i]));
    mx = fmaxf(mx, __shfl_xor(mx, 32));
    const bool fin = mx > -INFINITY, first = !seen && fin;
    if (__any(first || mx > NS_THR)) {
        const float d = first ? mx : (mx > NS_THR ? mx : 0.f), alpha = __builtin_amdgcn_exp2f(-d);
        seen = seen || fin; m += d; l *= alpha;
        if (WITH_O) {
#pragma unroll
            for (int c = 0; c < 4; ++c) O[c] = O[c] * alpha; }
#pragma unroll
        for (int i = 0; i < 16; ++i) { y0[i] -= d; y1[i] -= d; }
    }
    float ls = 0.f;
#pragma unroll
    for (int i = 0; i < 16; ++i) { y0[i] = __builtin_amdgcn_exp2f(y0[i]); y1[i] = __builtin_amdgcn_exp2f(y1[i]); ls += y0[i] + y1[i]; }
    l += ls;
}
#define NS_ISSUE(j, NSL, HASV) do { const unsigned sa_ = lds_a + (unsigned)(((j) & ((NSL) - 1)) * 32768); ns_dma(NS_KPTR(j), NS_STRIDE, sa_, w, lane); if (HASV) ns_dma(NS_VPTR(j), NS_STRIDE, sa_ + 16384u, w, lane); } while (0)
#define NS_WAIT(nb, HASV) do { if (HASV) { if ((nb) >= 2) NS_VMW(8); else if ((nb) == 1) NS_VMW(4); else NS_VMW(0); } else { if ((nb) >= 2) NS_VMW(4); else if ((nb) == 1) NS_VMW(2); else NS_VMW(0); } } while (0)
#define NS_PROLOGUE(n, NSL, HASV) do { const int q_ = (n) < (NSL) - 1 ? (n) : (NSL) - 1; for (int j_ = 0; j_ < q_; ++j_) NS_ISSUE(j_, NSL, HASV); NS_WAIT(q_ - 1, HASV); __syncthreads(); } while (0)
#define NS_STEP_BEGIN(i, n, NSL, HASV) do { if ((i) + (NSL) - 1 < (n)) NS_ISSUE((i) + (NSL) - 1, NSL, HASV); } while (0)
#define NS_STEP_END(i, n, NSL, HASV) do { int nb_ = ((n) - 1 < (i) + (NSL) - 1 ? (n) - 1 : (i) + (NSL) - 1) - ((i) + 1); NS_WAIT(nb_, HASV); __syncthreads(); } while (0)
#define NS_KB(i, NSL) (lds + (((i) & ((NSL) - 1)) * 32768))
#define NS_VB(i, NSL) (lds + (((i) & ((NSL) - 1)) * 32768) + 16384)
__device__ __forceinline__ void p_nsa(const Args& a, LAS unsigned char* lds, int rep) {
    const int tid = opaque_tid(), lane = tid & 63, w = __builtin_amdgcn_readfirstlane(tid >> 6), rho = lane & 31, hh = lane >> 5, ql = rho >> 2, p = rho & 3;
    const unsigned lds_a = (unsigned)__builtin_amdgcn_readfirstlane((int)(unsigned)(size_t)lds);
    const f16* z = (const f16*)(a.ws + WS_Z); const f16* kcmp = (const f16*)(a.ws + WS_KCMP); const f16* vcmp = (const f16*)(a.ws + WS_VCMP);
    float* onsa = (float*)(a.ws + WS_ONSA); unsigned* ctl = (unsigned*)(a.ws + WS_CTL);
    LAS float* psel = (LAS float*)(lds + NS_PSEL); LAS unsigned* selb = (LAS unsigned*)(lds + NS_SELB); LAS unsigned* wany = (LAS unsigned*)(lds + NS_WANY);
    LAS unsigned char* list = lds + NS_LIST; LAS int* cnt = (LAS int*)(lds + NS_CNT); LAS int* unit_s = (LAS int*)(lds + NS_UNIT);
    const float c2 = 0.08838834764831845f * 1.4426950408889634f;
    for (;;) {
        __syncthreads();
        if (tid == 0) unit_s[0] = (int)atomicAdd(&ctl[CW_Q + rep], 1u);
        __syncthreads();
        const int u = unit_s[0]; if (u >= 512) break;
        const int blk = 255 - (u >> 1), g = u & 1, t0 = blk * 64, tq = t0 + 8 * w + ql, hq = g * 4 + p;
        f16x8 qf[8];
        { const f16* qrow = z + (size_t)tq * NZ + ZQ + hq * 128 + 8 * hh;
#pragma unroll
          for (int s = 0; s < 8; ++s) { const f16x8 q8 = *(const f16x8*)(qrow + 16 * s);
#pragma unroll
              for (int j = 0; j < 8; ++j) qf[s][j] = (f16)((float)q8[j] * c2); } }
        const f16* zrow = z + (size_t)tq * NZ;
        const float gate_c = sigmoidf_((float)zrow[ZGL + hq]), gate_s = sigmoidf_((float)zrow[ZGL + 8 + hq]), gate_w = sigmoidf_((float)zrow[ZGL + 16 + hq]);
        f32x16 O[4];
        float* orow = onsa + (size_t)tq * 1024 + hq * 128 + 4 * hh;
#pragma unroll
        for (int c = 0; c < 4; ++c)
#pragma unroll
            for (int i = 0; i < 16; ++i) O[c][i] = 0.f;
        const int cmax = tq >= 31 ? (tq - 31) >> 4 : -1;
        const int ntc = (4 * blk + 3 + 63) >> 6;
        float m = 0.f, l = 0.f; bool seen = false;
        const int cmin_w = (t0 + 8 * w) >= 31 ? (t0 + 8 * w - 31) >> 4 : -1;
#define NS_KPTR(j) (kcmp + ((size_t)(64 * (j)) * 2 + g) * 128)
#define NS_VPTR(j) (vcmp + ((size_t)(64 * (j)) * 2 + g) * 128)
#define NS_STRIDE 256
        NS_PROLOGUE(ntc, 4, false);
        for (int i = 0; i < ntc; ++i) {
            NS_STEP_BEGIN(i, ntc, 4, false);
            f32x16 x0, x1; ns_qk(x0, x1, NS_KB(i, 4), qf, rho, hh, -m);
            if (64 * i + 63 > cmin_w) {
#pragma unroll
                for (int r = 0; r < 16; ++r) { const int c0 = 64 * i + NS_KIDX(r, hh); x0[r] = (c0 <= cmax) ? x0[r] : -INFINITY; x1[r] = (c0 + 32 <= cmax) ? x1[r] : -INFINITY; } }
            ns_online<false>(x0, x1, m, l, seen, O);
            NS_STEP_END(i, ntc, 4, false);
        }
        l += __shfl_xor(l, 32);
        const float invl = 1.f / fmaxf(l, 1e-30f);
        for (int i = lane; i < 8 * NS_PSTR; i += 64) psel[(8 * w) * NS_PSTR + i] = 0.f;
        NS_PROLOGUE(ntc, 2, true);
        for (int i = 0; i < ntc; ++i) {
            NS_STEP_BEGIN(i, ntc, 2, true);
            f32x16 x0, x1; ns_qk(x0, x1, NS_KB(i, 2), qf, rho, hh, -m);
#pragma unroll
            for (int r = 0; r < 16; ++r) { x0[r] = __builtin_amdgcn_exp2f(x0[r]) * invl; x1[r] = __builtin_amdgcn_exp2f(x1[r]) * invl; }
            if (64 * i + 63 > cmin_w) {
#pragma unroll
                for (int r = 0; r < 16; ++r) { const int c0 = 64 * i + NS_KIDX(r, hh); x0[r] = (c0 <= cmax) ? x0[r] : 0.f; x1[r] = (c0 + 32 <= cmax) ? x1[r] : 0.f; } }
#pragma unroll
            for (int kh = 0; kh < 2; ++kh)
#pragma unroll
                for (int r4 = 0; r4 < 4; ++r4) {
                    const float pa = kh ? x1[4 * r4] : x0[4 * r4], pb = kh ? x1[4 * r4 + 1] : x0[4 * r4 + 1], pc_ = kh ? x1[4 * r4 + 2] : x0[4 * r4 + 2], pd = kh ? x1[4 * r4 + 3] : x0[4 * r4 + 3];
                    float mainv = pa + pb + pc_ + 0.5f * pd, carry = 0.5f * pd;
                    mainv += __shfl_xor(mainv, 1); mainv += __shfl_xor(mainv, 2); carry += __shfl_xor(carry, 1); carry += __shfl_xor(carry, 2);
                    if (p == 0) { const int sb = 16 * i + 8 * kh + 2 * r4 + hh; float* pr = (float*)(psel + (8 * w + ql) * NS_PSTR + sb); __hip_atomic_fetch_add(pr, mainv, __ATOMIC_RELAXED, __HIP_MEMORY_SCOPE_WORKGROUP); __hip_atomic_fetch_add(pr + 1, carry, __ATOMIC_RELAXED, __HIP_MEMORY_SCOPE_WORKGROUP); }
                }
            ns_pv(O, NS_VB(i, 2), x0, x1, lane);
            NS_STEP_END(i, ntc, 2, true);
        }
#undef NS_KPTR
#undef NS_VPTR
#undef NS_STRIDE
#pragma unroll
        for (int c = 0; c < 4; ++c) {
#pragma unroll
            for (int r4 = 0; r4 < 4; ++r4) *(f32x4*)(orow + 32 * c + 8 * r4) = (f32x4){O[c][4 * r4] * gate_c, O[c][4 * r4 + 1] * gate_c, O[c][4 * r4 + 2] * gate_c, O[c][4 * r4 + 3] * gate_c};
#pragma unroll
            for (int i = 0; i < 16; ++i) O[c][i] = 0.f; }
        {
            unsigned anyw = 0u;
            for (int qq = 0; qq < 8; ++qq) {
                const LAS float* pr = psel + (8 * w + qq) * NS_PSTR;
                unsigned myw = 0u;
                if (lane == 0) myw |= 1u;
                if (lane == (blk >> 5)) myw |= 1u << (blk & 31);
                if (blk >= 1 && lane == ((blk - 1) >> 5)) myw |= 1u << ((blk - 1) & 31);
                const int ncand = blk >= 3 ? blk - 2 : 0;
                if (ncand <= 13) { if (ncand > 0 && lane == 0) myw |= ((2u << (blk - 2)) - 1u) & ~1u; }
                else {
                    unsigned key[4];
#pragma unroll
                    for (int jj = 0; jj < 4; ++jj) { const int s = 1 + lane + 64 * jj; key[jj] = (s <= blk - 2) ? __float_as_uint(fmaxf(pr[s], 0.f)) + 1u : 0u; }
                    unsigned thr = 0u;
                    for (int bit = 31; bit >= 0; --bit) { const unsigned cand = thr | (1u << bit); int cn = 0;
#pragma unroll
                        for (int jj = 0; jj < 4; ++jj) cn += __popcll(__ballot(key[jj] >= cand));
                        if (cn >= 13) thr = cand; }
                    int cgt = 0;
#pragma unroll
                    for (int jj = 0; jj < 4; ++jj) cgt += __popcll(__ballot(key[jj] > thr));
                    int remaining = 13 - cgt;
                    unsigned long long M[4];
#pragma unroll
                    for (int jj = 0; jj < 4; ++jj) { const bool eq = key[jj] == thr; const unsigned long long em = __ballot(eq); const int c = __popcll(em);
                        const bool take_eq = eq && (__popcll(em & ((1ull << lane) - 1ull)) < remaining);
                        remaining = remaining > c ? remaining - c : 0;
                        M[jj] = __ballot(key[jj] > thr || take_eq); }
#pragma unroll
                    for (int j = 0; j < 8; ++j) { const int k = j >> 1; const unsigned long long sh = (M[k] << 1) | (k > 0 ? (M[k - 1] >> 63) : 0ull);
                        const unsigned wj = (unsigned)(sh >> (32 * (j & 1))); if (lane == j) myw |= wj; }
                }
                if (lane < 8) selb[(8 * w + qq) * 8 + lane] = myw;
                anyw |= myw;
            }
            if (lane < 8) wany[w * 8 + lane] = anyw;
        }
        __syncthreads();
        {
            int need = 0;
            if (w < 4) { const int sblk = 64 * w + lane; unsigned un = 0u;
#pragma unroll
                for (int ww = 0; ww < 8; ++ww) un |= wany[ww * 8 + (sblk >> 5)];
                need = (un >> (sblk & 31)) & 1; }
            const unsigned long long bal = __ballot(need);
            if (w < 4 && lane == 0) cnt[w] = __popcll(bal);
            __syncthreads();
            if (w < 4) { int base = 0;
                for (int ww = 0; ww < w; ++ww) base += cnt[ww];
                if (need) list[base + __popcll(bal & ((1ull << lane) - 1ull))] = (unsigned char)(64 * w + lane); }
            __syncthreads();
        }
        const int nlist = cnt[0] + cnt[1] + cnt[2] + cnt[3];
        for (int rp_ = 0; rp_ < NSA_SELREP; ++rp_) {
        if (rp_) { asm volatile("" :: "v"(O[0][0]), "v"(O[1][0]), "v"(O[2][0]), "v"(O[3][0]), "v"(l));
#pragma unroll
            for (int c = 0; c < 4; ++c)
#pragma unroll
                for (int i = 0; i < 16; ++i) O[c][i] = 0.f; }
        m = 0.f; l = 0.f; seen = false;
#define NS_KPTR(j) (z + (size_t)((int)list[j] * 64) * NZ + ZKS + g * 128)
#define NS_VPTR(j) (z + (size_t)((int)list[j] * 64) * NZ + ZVS + g * 128)
#define NS_STRIDE NZ
        NS_PROLOGUE(nlist, 4, true);
        for (int i = 0; i < nlist; ++i) {
            NS_STEP_BEGIN(i, nlist, 4, true);
            const int sb = list[i];
            const unsigned wneed = (wany[w * 8 + (sb >> 5)] >> (sb & 31)) & 1u;
            if (wneed) {
                const bool rsel = (selb[(8 * w + ql) * 8 + (sb >> 5)] >> (sb & 31)) & 1u;
                f32x16 x0, x1; ns_qk(x0, x1, NS_KB(i, 4), qf, rho, hh, rsel ? -m : -INFINITY);
                if (sb == blk) { const int kp0 = sb * 64;
#pragma unroll
                    for (int r = 0; r < 16; ++r) { const int kp = kp0 + NS_KIDX(r, hh); x0[r] = (kp <= tq) ? x0[r] : -INFINITY; x1[r] = (kp + 32 <= tq) ? x1[r] : -INFINITY; } }
                ns_online<true>(x0, x1, m, l, seen, O);
                ns_pv(O, NS_VB(i, 4), x0, x1, lane);
            }
            NS_STEP_END(i, nlist, 4, true);
        }
        }
#undef NS_KPTR
#undef NS_VPTR
        l += __shfl_xor(l, 32);
        { const float sc = gate_s / fmaxf(l, 1e-30f); f32x4 ev[4][4];
#pragma unroll
          for (int c = 0; c < 4; ++c)
#pragma unroll
              for (int r4 = 0; r4 < 4; ++r4) ev[c][r4] = *(const f32x4*)(orow + 32 * c + 8 * r4);
#pragma unroll
          for (int c = 0; c < 4; ++c) {
#pragma unroll
              for (int r4 = 0; r4 < 4; ++r4) { const f32x4 e = ev[c][r4]; *(f32x4*)(orow + 32 * c + 8 * r4) = (f32x4){e.x + O[c][4 * r4] * sc, e.y + O[c][4 * r4 + 1] * sc, e.z + O[c][4 * r4 + 2] * sc, e.w + O[c][4 * r4 + 3] * sc}; }
#pragma unroll
              for (int i = 0; i < 16; ++i) O[c][i] = 0.f; } }
        const int wb0 = blk >= 8 ? blk - 8 : 0, nwt = blk - wb0 + 1;
        for (int rp_ = 0; rp_ < NSA_WINREP; ++rp_) {
        if (rp_) { asm volatile("" :: "v"(O[0][0]), "v"(O[1][0]), "v"(O[2][0]), "v"(O[3][0]), "v"(l));
#pragma unroll
            for (int c = 0; c < 4; ++c)
#pragma unroll
                for (int i = 0; i < 16; ++i) O[c][i] = 0.f; }
        m = 0.f; l = 0.f; seen = false;
#define NS_KPTR(j) (z + (size_t)((wb0 + (j)) * 64) * NZ + ZKW + g * 128)
#define NS_VPTR(j) (z + (size_t)((wb0 + (j)) * 64) * NZ + ZVW + g * 128)
        NS_PROLOGUE(nwt, 4, true);
        for (int i = 0; i < nwt; ++i) {
            NS_STEP_BEGIN(i, nwt, 4, true);
            const int kb = wb0 + i;
            f32x16 x0, x1; ns_qk(x0, x1, NS_KB(i, 4), qf, rho, hh, -m);
            if (i == 0 || i == nwt - 1) { const int kp0 = kb * 64;
#pragma unroll
                for (int r = 0; r < 16; ++r) { const int kp = kp0 + NS_KIDX(r, hh);
                    x0[r] = (kp <= tq && kp + 511 >= tq) ? x0[r] : -INFINITY; x1[r] = (kp + 32 <= tq && kp + 32 + 511 >= tq) ? x1[r] : -INFINITY; } }
            ns_online<true>(x0, x1, m, l, seen, O);
            ns_pv(O, NS_VB(i, 4), x0, x1, lane);
            NS_STEP_END(i, nwt, 4, true);
        }
        }
#undef NS_KPTR
#undef NS_VPTR
#undef NS_STRIDE
        l += __shfl_xor(l, 32);
        { const float sc = gate_w / fmaxf(l, 1e-30f); f32x4 ev[4][4];
#pragma unroll
          for (int c = 0; c < 4; ++c)
#pragma unroll
              for (int r4 = 0; r4 < 4; ++r4) ev[c][r4] = *(const f32x4*)(orow + 32 * c + 8 * r4);
#pragma unroll
          for (int c = 0; c < 4; ++c)
#pragma unroll
              for (int r4 = 0; r4 < 4; ++r4) { const f32x4 e = ev[c][r4]; *(f32x4*)(orow + 32 * c + 8 * r4) = (f32x4){e.x + O[c][4 * r4] * sc, e.y + O[c][4 * r4 + 1] * sc, e.z + O[c][4 * r4 + 2] * sc, e.w + O[c][4 * r4 + 3] * sc}; } }
    }
}

constexpr int RS = 72, SLOT = 64 * RS * 2, RW_FS = 68, RW_GCL = 17 * SLOT;
#define RW_SLOT(lds, i) ((LAS bf16*)((lds) + (i) * SLOT))
template <int KS> __device__ __forceinline__ void mm_acc(f32x4 (&acc)[2], const LAS bf16* X, int xs, const LAS bf16* Y, int ys, int w, int lane) {
    const LAS bf16* xp = X + (16 * (w >> 1) + (lane & 15)) * xs + 8 * (lane >> 4);
    const LAS bf16* yp = Y + (32 * (w & 1) + (lane & 15)) * ys + 8 * (lane >> 4);
#pragma unroll
    for (int ks = 0; ks < KS; ++ks) { const bf16x8 av = *(const LAS bf16x8*)(xp + 32 * ks), b0 = *(const LAS bf16x8*)(yp + 32 * ks), b1 = *(const LAS bf16x8*)(yp + 16 * ys + 32 * ks);
        acc[0] = __builtin_amdgcn_mfma_f32_16x16x32_bf16(av, b0, acc[0], 0, 0, 0); acc[1] = __builtin_amdgcn_mfma_f32_16x16x32_bf16(av, b1, acc[1], 0, 0, 0); }
}
__device__ __forceinline__ void acc_zero(f32x4 (&acc)[2]) { acc[0] = (f32x4){0.f, 0.f, 0.f, 0.f}; acc[1] = (f32x4){0.f, 0.f, 0.f, 0.f}; }
__device__ __forceinline__ void st_n(const f32x4 (&acc)[2], LAS bf16* dst, int m0, int n0) {
#pragma unroll
    for (int tn = 0; tn < 2; ++tn)
#pragma unroll
        for (int r = 0; r < 4; ++r) dst[(m0 + r) * RS + n0 + 16 * tn] = (bf16)acc[tn][r];
}
__device__ __forceinline__ void st_t(const f32x4 (&acc)[2], LAS bf16* dst, int m0, int n0) {
#pragma unroll
    for (int tn = 0; tn < 2; ++tn) { const bf16x4 v = {(bf16)acc[tn][0], (bf16)acc[tn][1], (bf16)acc[tn][2], (bf16)acc[tn][3]}; *(LAS bf16x4*)(dst + (n0 + 16 * tn) * RS + m0) = v; }
}
__device__ __forceinline__ void ld_n(f32x4 (&acc)[2], const LAS bf16* src, int m0, int n0) {
#pragma unroll
    for (int tn = 0; tn < 2; ++tn)
#pragma unroll
        for (int r = 0; r < 4; ++r) acc[tn][r] = (float)src[(m0 + r) * RS + n0 + 16 * tn];
}
template <bool INCL> __device__ __forceinline__ void tri_mask(f32x4 (&acc)[2], int m0, int n0) {
#pragma unroll
    for (int tn = 0; tn < 2; ++tn)
#pragma unroll
        for (int r = 0; r < 4; ++r) { const int m = m0 + r, n = n0 + 16 * tn; if (INCL ? (n > m) : (n >= m)) acc[tn][r] = 0.f; }
}
__device__ __forceinline__ void st_acc_g(const f32x4 (&acc)[2], f16* base, int u, int w, int lane) {
#pragma unroll
    for (int tn = 0; tn < 2; ++tn) { const f16x4 v = {(f16)acc[tn][0], (f16)acc[tn][1], (f16)acc[tn][2], (f16)acc[tn][3]}; ((f16x4*)base)[((size_t)u * 16 + w * 2 + tn) * 64 + lane] = v; }
}
__device__ __forceinline__ float fast_tanh(float x) { const float e = __expf(2.f * x); return 1.f - 2.f / (e + 1.f); }

__device__ __forceinline__ void p_rwkv_local(const Args& a, LAS unsigned char* lds) {
    const int tid = opaque_tid(), lane = tid & 63, w = __builtin_amdgcn_readfirstlane(tid >> 6);
    const int m0 = 16 * (w >> 1) + 4 * (lane >> 4), n0 = 32 * (w & 1) + (lane & 15);
    const int et = tid >> 3, cg = tid & 7;
    const f16* z = (const f16*)(a.ws + WS_Z);
    unsigned char* ro = (unsigned char*)a.out;
    LAS float* FW = (LAS float*)(lds + 8 * SLOT); LAS float* FA = FW + 64 * RW_FS; LAS float* TOT = FA + 64 * RW_FS; LAS float* GCL = (LAS float*)(lds + RW_GCL); LAS float* PRM = GCL + 64;
    const int h = blockIdx.x & 15, cstep = gridDim.x >> 4, ch0 = h * 64 + 8 * cg;
    __syncthreads();
    if (tid < 64) { const int ch = h * 64 + tid; const float* mu = a.in[I_MU];
        PRM[tid] = mu[ch]; PRM[64 + tid] = mu[1024 + ch]; PRM[128 + tid] = mu[2048 + ch]; PRM[192 + tid] = mu[3072 + tid]; PRM[256 + tid] = mu[3136 + tid];
        PRM[320 + tid] = a.in[I_W0][ch]; PRM[384 + tid] = a.in[I_A0][ch]; PRM[448 + tid] = a.in[I_KK][ch]; PRM[512 + tid] = a.in[I_KA][ch]; PRM[576 + tid] = a.in[I_RK][ch]; }
    { bf16x8 id8;
#pragma unroll
      for (int e = 0; e < 8; ++e) id8[e] = (bf16)((8 * cg + e == et) ? 1.f : 0.f);
      *(LAS bf16x8*)(RW_SLOT(lds, 16) + et * RS + 8 * cg) = id8; }
    *(LAS u32x4*)(RW_SLOT(lds, 14) + et * RS + 8 * cg) = *(const u32x4*)((const bf16*)(a.ws + WS_WUPT) + (size_t)(h * 64 + et) * 64 + 8 * cg);
    *(LAS u32x4*)(RW_SLOT(lds, 15) + et * RS + 8 * cg) = *(const u32x4*)((const bf16*)(a.ws + WS_AUPT) + (size_t)(h * 64 + et) * 64 + 8 * cg);
    f16x8 zc[5], zp[5];
    const f16x8 zero8 = {0, 0, 0, 0, 0, 0, 0, 0};
#define RW_LOADZ(cc) do { const int t_ = (cc) * 64 + et; const f16* cur_ = z + (size_t)t_ * NZ; const bool hp_ = t_ > 0; \
        zc[0] = *(const f16x8*)(cur_ + ZR + ch0); zc[1] = *(const f16x8*)(cur_ + ZK + ch0); zc[2] = *(const f16x8*)(cur_ + ZV + ch0); zc[3] = *(const f16x8*)(cur_ + ZWD + 8 * cg); zc[4] = *(const f16x8*)(cur_ + ZAD + 8 * cg); \
        zp[0] = hp_ ? *(const f16x8*)(cur_ - NZ + ZR + ch0) : zero8; zp[1] = hp_ ? *(const f16x8*)(cur_ - NZ + ZK + ch0) : zero8; zp[2] = hp_ ? *(const f16x8*)(cur_ - NZ + ZV + ch0) : zero8; \
        zp[3] = hp_ ? *(const f16x8*)(cur_ - NZ + ZWD + 8 * cg) : zero8; zp[4] = hp_ ? *(const f16x8*)(cur_ - NZ + ZAD + 8 * cg) : zero8; } while (0)
    __syncthreads();
    if ((blockIdx.x >> 4) < 256) RW_LOADZ(blockIdx.x >> 4);
    for (int c = blockIdx.x >> 4; c < 256; c += cstep) {
        const int t0 = c * 64, uo = h * 256 + c;
        float r_[8], k_[8], v_[8];
        { bf16x8 x1, x2;
#pragma unroll
          for (int e = 0; e < 8; ++e) { const int jj = 8 * cg + e;
              r_[e] = (float)zc[0][e] + ((float)zp[0][e] - (float)zc[0][e]) * PRM[jj]; k_[e] = (float)zc[1][e] + ((float)zp[1][e] - (float)zc[1][e]) * PRM[64 + jj]; v_[e] = (float)zc[2][e] + ((float)zp[2][e] - (float)zc[2][e]) * PRM[128 + jj];
              x1[e] = (bf16)fast_tanh((float)zc[3][e] + ((float)zp[3][e] - (float)zc[3][e]) * PRM[192 + jj]); x2[e] = (bf16)((float)zc[4][e] + ((float)zp[4][e] - (float)zc[4][e]) * PRM[256 + jj]); }
          *(LAS bf16x8*)(RW_SLOT(lds, 0) + et * RS + 8 * cg) = x1; *(LAS bf16x8*)(RW_SLOT(lds, 1) + et * RS + 8 * cg) = x2; }
        if (c + cstep < 256) RW_LOADZ(c + cstep);
        __syncthreads();
        { f32x4 acc[2]; acc_zero(acc); mm_acc<2>(acc, RW_SLOT(lds, 0), RS, RW_SLOT(lds, 14), RS, w, lane);
#pragma unroll
          for (int tn = 0; tn < 2; ++tn)
#pragma unroll
              for (int r = 0; r < 4; ++r) FW[(m0 + r) * RW_FS + n0 + 16 * tn] = acc[tn][r];
          acc_zero(acc); mm_acc<2>(acc, RW_SLOT(lds, 1), RS, RW_SLOT(lds, 15), RS, w, lane);
#pragma unroll
          for (int tn = 0; tn < 2; ++tn)
#pragma unroll
              for (int r = 0; r < 4; ++r) FA[(m0 + r) * RW_FS + n0 + 16 * tn] = acc[tn][r]; }
        __syncthreads();
        float lw_[8], kk_[8], b_[8];
        { float ss = 0.f, sb = 0.f;
#pragma unroll
          for (int e = 0; e < 8; ++e) {
              const float wpre = PRM[320 + 8 * cg + e] + FW[et * RW_FS + 8 * cg + e]; const float y0 = -wpre; const float sp = fmaxf(y0, 0.f) + __logf(1.f + __expf(-fabsf(y0)));
              lw_[e] = -__expf(-sp - 0.5f);
              const float av = sigmoidf_(PRM[384 + 8 * cg + e] + FA[et * RW_FS + 8 * cg + e]);
              const float kkr = k_[e] * PRM[448 + 8 * cg + e]; ss += kkr * kkr; kk_[e] = kkr;
              k_[e] = k_[e] * (1.f + (av - 1.f) * PRM[512 + 8 * cg + e]); b_[e] = av;
              sb += r_[e] * k_[e] * PRM[576 + 8 * cg + e]; }
          ss += __shfl_xor(ss, 1); ss += __shfl_xor(ss, 2); ss += __shfl_xor(ss, 4);
          sb += __shfl_xor(sb, 1); sb += __shfl_xor(sb, 2); sb += __shfl_xor(sb, 4);
          const float rn = rsqrtf(fmaxf(ss, 1e-24f));
#pragma unroll
          for (int e = 0; e < 8; ++e) { kk_[e] *= rn; b_[e] *= kk_[e]; FW[et * RW_FS + 8 * cg + e] = lw_[e]; }
          if (cg == 0) ((float*)(a.ws + WS_SBON))[(size_t)(t0 + et) * 16 + h] = sb; }
        __syncthreads();
        { const int j = tid & 63, rg = tid >> 6; float run = 0.f;
#pragma unroll
          for (int i = 0; i < 8; ++i) { run += FW[(8 * rg + i) * RW_FS + j]; FW[(8 * rg + i) * RW_FS + j] = run; }
          TOT[rg * 64 + j] = run;
          __syncthreads();
          float off = 0.f;
          for (int q = 0; q < rg; ++q) off += TOT[q * 64 + j];
#pragma unroll
          for (int i = 0; i < 8; ++i) FW[(8 * rg + i) * RW_FS + j] += off; }
        __syncthreads();
        { bf16x8 at, bt, kt, rt, bh, kh, vv;
#pragma unroll
          for (int e = 0; e < 8; ++e) { const int jj = 8 * cg + e; const float cum = FW[et * RW_FS + jj], cl = FW[63 * RW_FS + jj];
              const float eA = __expf(cum - lw_[e]), eN = __expf(-cum), eP = __expf(cum), eH = __expf(cl - cum);
              at[e] = (bf16)(-kk_[e] * eA); bt[e] = (bf16)(b_[e] * eN); kt[e] = (bf16)(k_[e] * eN); rt[e] = (bf16)(r_[e] * eP);
              bh[e] = (bf16)(b_[e] * eH); kh[e] = (bf16)(k_[e] * eH); vv[e] = (bf16)v_[e];
              if (et == 63) GCL[jj] = __expf(cl); }
          *(LAS bf16x8*)(RW_SLOT(lds, 0) + et * RS + 8 * cg) = at; *(LAS bf16x8*)(RW_SLOT(lds, 2) + et * RS + 8 * cg) = bt;
          *(LAS bf16x8*)(RW_SLOT(lds, 3) + et * RS + 8 * cg) = kt; *(LAS bf16x8*)(RW_SLOT(lds, 4) + et * RS + 8 * cg) = rt;
          *(LAS bf16x8*)(RW_SLOT(lds, 5) + et * RS + 8 * cg) = bh; *(LAS bf16x8*)(RW_SLOT(lds, 6) + et * RS + 8 * cg) = kh; *(LAS bf16x8*)(RW_SLOT(lds, 7) + et * RS + 8 * cg) = vv; }
        __syncthreads();
#define RW_MM(acc, XS, YS) mm_acc<2>(acc, RW_SLOT(lds, XS), RS, RW_SLOT(lds, YS), RS, w, lane)
#define RW_ST(acc, DS) st_t(acc, RW_SLOT(lds, DS), m0, n0)
        { f32x4 acc[2];
          acc_zero(acc); RW_MM(acc, 0, 16); RW_ST(acc, 1);
          acc_zero(acc); RW_MM(acc, 5, 16); RW_ST(acc, 8);
          acc_zero(acc); RW_MM(acc, 6, 16); RW_ST(acc, 9);
          acc_zero(acc); RW_MM(acc, 7, 16); RW_ST(acc, 10);
          __syncthreads();
          acc_zero(acc); RW_MM(acc, 2, 0);
#pragma unroll
          for (int tn = 0; tn < 2; ++tn)
#pragma unroll
              for (int r = 0; r < 4; ++r) if (m0 + r >= n0 + 16 * tn) acc[tn][r] = 0.f;
          RW_ST(acc, 5);
#pragma unroll
          for (int tn = 0; tn < 2; ++tn)
#pragma unroll
              for (int r = 0; r < 4; ++r) if (m0 + r == n0 + 16 * tn) acc[tn][r] = 1.f;
          RW_ST(acc, 13);
          acc_zero(acc); RW_MM(acc, 0, 2); tri_mask<false>(acc, m0, n0); RW_ST(acc, 6);
          acc_zero(acc); RW_MM(acc, 0, 3); tri_mask<false>(acc, m0, n0); RW_ST(acc, 7);
          acc_zero(acc); RW_MM(acc, 2, 4);
#pragma unroll
          for (int tn = 0; tn < 2; ++tn)
#pragma unroll
              for (int r = 0; r < 4; ++r) if (m0 + r > n0 + 16 * tn) acc[tn][r] = 0.f;
          RW_ST(acc, 11);
          acc_zero(acc); RW_MM(acc, 3, 4);
#pragma unroll
          for (int tn = 0; tn < 2; ++tn)
#pragma unroll
              for (int r = 0; r < 4; ++r) if (m0 + r > n0 + 16 * tn) acc[tn][r] = 0.f;
          RW_ST(acc, 12);
          __syncthreads();
#define RW_LDT(acc, TS) do { _Pragma("unroll") for (int tn_ = 0; tn_ < 2; ++tn_) { const bf16x4 v_ = *(const LAS bf16x4*)(RW_SLOT(lds, TS) + (n0 + 16 * tn_) * RS + m0); acc[tn_] = (f32x4){(float)v_[0], (float)v_[1], (float)v_[2], (float)v_[3]}; } } while (0)
          acc_zero(acc); RW_MM(acc, 6, 5); RW_ST(acc, 0); acc_zero(acc); RW_MM(acc, 5, 6); RW_ST(acc, 2);
          __syncthreads();
          RW_LDT(acc, 13); RW_MM(acc, 2, 13); RW_ST(acc, 3);
          acc_zero(acc); RW_MM(acc, 2, 0); RW_ST(acc, 5); acc_zero(acc); RW_MM(acc, 0, 2); RW_ST(acc, 6);
          __syncthreads();
          RW_LDT(acc, 3); RW_MM(acc, 6, 3); RW_ST(acc, 13);
          acc_zero(acc); RW_MM(acc, 6, 5); RW_ST(acc, 0); acc_zero(acc); RW_MM(acc, 5, 6); RW_ST(acc, 2);
          __syncthreads();
          RW_LDT(acc, 13); RW_MM(acc, 2, 13); RW_ST(acc, 3);
          acc_zero(acc); RW_MM(acc, 2, 0); RW_ST(acc, 5); acc_zero(acc); RW_MM(acc, 0, 2); RW_ST(acc, 6);
          __syncthreads();
          RW_LDT(acc, 3); RW_MM(acc, 6, 3); RW_ST(acc, 13);
          acc_zero(acc); RW_MM(acc, 5, 6); RW_ST(acc, 2);
          __syncthreads();
          RW_LDT(acc, 13); RW_MM(acc, 2, 13); RW_ST(acc, 3);
          __syncthreads();
          acc_zero(acc); RW_MM(acc, 3, 1); RW_ST(acc, 0);
          acc_zero(acc); RW_MM(acc, 7, 3); RW_ST(acc, 5);
          __syncthreads();
          acc_zero(acc); RW_MM(acc, 5, 10); RW_ST(acc, 6);
          acc_zero(acc); RW_MM(acc, 0, 11);
#pragma unroll
          for (int tn = 0; tn < 2; ++tn) { const int tt = n0 + 16 * tn; const bf16x4 rr = *(const LAS bf16x4*)(RW_SLOT(lds, 4) + tt * RS + m0);
              const bf16x4 o = {(bf16)(acc[tn][0] + (float)rr[0]), (bf16)(acc[tn][1] + (float)rr[1]), (bf16)(acc[tn][2] + (float)rr[2]), (bf16)(acc[tn][3] + (float)rr[3])};
              *(bf16x4*)((bf16*)(ro + RO_Q) + (size_t)uo * 4096 + tt * 64 + m0) = o; }
          acc_zero(acc); RW_MM(acc, 0, 8);
#pragma unroll
          for (int tn = 0; tn < 2; ++tn) { const int jj = n0 + 16 * tn; const float gc = GCL[jj];
              const bf16x4 o = {(bf16)(acc[tn][0] + (m0 == jj ? gc : 0.f)), (bf16)(acc[tn][1] + (m0 + 1 == jj ? gc : 0.f)), (bf16)(acc[tn][2] + (m0 + 2 == jj ? gc : 0.f)), (bf16)(acc[tn][3] + (m0 + 3 == jj ? gc : 0.f))};
              *(bf16x4*)((bf16*)(ro + RO_M) + (size_t)uo * 4096 + jj * 64 + m0) = o; }
          __syncthreads();
          acc_zero(acc); RW_MM(acc, 11, 6); RW_MM(acc, 12, 10); st_acc_g(acc, (f16*)(ro + RO_Y), uo, w, lane);
          acc_zero(acc); RW_MM(acc, 6, 8); RW_MM(acc, 10, 9); st_acc_g(acc, (f16*)(ro + RO_N), uo, w, lane);
        }
#undef RW_MM
#undef RW_ST
#undef RW_LDT
    }
}
__device__ __forceinline__ void p_rwkv_scan(const Args& a, LAS unsigned char* lds, int h) {
    const int tid = opaque_tid(), lane = tid & 63, w = __builtin_amdgcn_readfirstlane(tid >> 6);
    const int m0 = 16 * (w >> 1) + 4 * (lane >> 4), n0 = 32 * (w & 1) + (lane & 15), row = tid >> 3, seg = tid & 7;
    const unsigned char* ro = (const unsigned char*)a.out;
    const bf16* Mg = (const bf16*)(ro + RO_M) + (size_t)h * 256 * 4096; const f16x4* Ng = (const f16x4*)(ro + RO_N) + (size_t)h * 256 * 1024; bf16* Sg = (bf16*)(a.ws + WS_RS) + (size_t)h * 256 * 4096;
    f32x4 acc[2]; acc_zero(acc);
    u32x4 mreg = *(const u32x4*)(Mg + row * 64 + seg * 8); f16x4 nreg[2] = {Ng[(w * 2) * 64 + lane], Ng[(w * 2 + 1) * 64 + lane]};
    for (int c = 0; c < 256; ++c) {
        LAS bf16* Sb = RW_SLOT(lds, c & 1); LAS bf16* Mb = RW_SLOT(lds, 2 + (c & 1));
        st_n(acc, Sb, m0, n0);
        *(LAS u32x4*)(Mb + row * RS + seg * 8) = mreg;
        const f16x4 nc0 = nreg[0], nc1 = nreg[1];
        if (c + 1 < 256) { mreg = *(const u32x4*)(Mg + (size_t)(c + 1) * 4096 + row * 64 + seg * 8); nreg[0] = Ng[(size_t)(c + 1) * 1024 + (w * 2) * 64 + lane]; nreg[1] = Ng[(size_t)(c + 1) * 1024 + (w * 2 + 1) * 64 + lane]; }
        __syncthreads();
        *(u32x4*)(Sg + (size_t)c * 4096 + row * 64 + seg * 8) = *(const LAS u32x4*)(Sb + row * RS + seg * 8);
        acc[0] = (f32x4){(float)nc0[0], (float)nc0[1], (float)nc0[2], (float)nc0[3]}; acc[1] = (f32x4){(float)nc1[0], (float)nc1[1], (float)nc1[2], (float)nc1[3]};
        mm_acc<2>(acc, Sb, RS, Mb, RS, w, lane);
    }
}
constexpr int RG_S = 168;
__device__ __forceinline__ void p_rwkv_out(const Args& a, LAS unsigned char* lds) {
    const int tid = opaque_tid(), lane = tid & 63, w = __builtin_amdgcn_readfirstlane(tid >> 6);
    const int m0 = 16 * (w >> 1) + 4 * (lane >> 4), n0 = 32 * (w & 1) + (lane & 15), row = tid >> 3, seg = tid & 7;
    const f16* z = (const f16*)(a.ws + WS_Z); const unsigned char* ro = (const unsigned char*)a.out; f16* mix = (f16*)(a.ws + WS_MIX);
    LAS bf16* SG = (LAS bf16*)(lds + 2 * SLOT); LAS bf16* GU = SG + 64 * RG_S; LAS float* YL = (LAS float*)(GU + 64 * RG_S); LAS float* GL = YL + 64 * RW_FS; LAS float* PRM = GL + 64 * RW_FS;
    const int h = blockIdx.x & 15, cstep = gridDim.x >> 4, et = row, cg = seg, ch0 = h * 64 + 8 * cg;
    __syncthreads();
    for (int ck = tid; ck < 64 * 20; ck += 512) { const int rr = ck / 20, c8 = ck % 20; *(LAS u32x4*)(GU + rr * RG_S + 8 * c8) = *(const u32x4*)((const bf16*)(a.ws + WS_GUPT) + (size_t)(h * 64 + rr) * 160 + 8 * c8); }
    if (tid < 160) PRM[tid] = a.in[I_MU][3200 + tid];
    if (tid < 64) { PRM[160 + tid] = a.in[I_MU][2048 + h * 64 + tid]; PRM[224 + tid] = a.in[I_LNXG][h * 64 + tid]; PRM[288 + tid] = a.in[I_LNXB][h * 64 + tid]; }
    const f16x8 zero8 = {0, 0, 0, 0, 0, 0, 0, 0};
    u32x4 qreg, sreg; f16x4 yreg[2]; f16x8 gc[3], gp[3], vc, vp; float sbn;
#define RO_LOAD(cc) do { const int uo_ = h * 256 + (cc), t0_ = (cc) * 64; \
        qreg = *(const u32x4*)((const bf16*)(ro + RO_Q) + (size_t)uo_ * 4096 + row * 64 + seg * 8); sreg = *(const u32x4*)((const bf16*)(a.ws + WS_RS) + (size_t)uo_ * 4096 + row * 64 + seg * 8); \
        { const f16x4* Yg_ = (const f16x4*)(ro + RO_Y) + (size_t)uo_ * 1024; yreg[0] = Yg_[(w * 2) * 64 + lane]; yreg[1] = Yg_[(w * 2 + 1) * 64 + lane]; } \
        _Pragma("unroll") for (int i_ = 0; i_ < 3; ++i_) { const int ck_ = tid + 512 * i_; if (ck_ < 64 * 20) { const int t_ = t0_ + ck_ / 20; const f16* cur_ = z + (size_t)t_ * NZ + ZGD + 8 * (ck_ % 20); gc[i_] = *(const f16x8*)cur_; gp[i_] = t_ > 0 ? *(const f16x8*)(cur_ - NZ) : zero8; } } \
        { const int t_ = t0_ + et; const f16* cur_ = z + (size_t)t_ * NZ + ZV + ch0; vc = *(const f16x8*)cur_; vp = t_ > 0 ? *(const f16x8*)(cur_ - NZ) : zero8; sbn = ((const float*)(a.ws + WS_SBON))[(size_t)t_ * 16 + h]; } } while (0)
    RO_LOAD(blockIdx.x >> 4);
    for (int c = blockIdx.x >> 4; c < 256; c += cstep) {
        const int t0 = c * 64;
        __syncthreads();
        *(LAS u32x4*)(RW_SLOT(lds, 0) + row * RS + seg * 8) = qreg; *(LAS u32x4*)(RW_SLOT(lds, 1) + row * RS + seg * 8) = sreg;
#pragma unroll
        for (int i = 0; i < 3; ++i) { const int ck = tid + 512 * i; if (ck < 64 * 20) { const int rr = ck / 20, c8 = ck % 20; bf16x8 o;
#pragma unroll
            for (int e = 0; e < 8; ++e) o[e] = (bf16)sigmoidf_((float)gc[i][e] + ((float)gp[i][e] - (float)gc[i][e]) * PRM[8 * c8 + e]);
            *(LAS bf16x8*)(SG + rr * RG_S + 8 * c8) = o; } }
        f32x4 y[2], g[2];
        y[0] = (f32x4){(float)yreg[0][0], (float)yreg[0][1], (float)yreg[0][2], (float)yreg[0][3]}; y[1] = (f32x4){(float)yreg[1][0], (float)yreg[1][1], (float)yreg[1][2], (float)yreg[1][3]};
        const f16x8 vcc = vc, vpp = vp; const float sbc = sbn;
        if (c + cstep < 256) RO_LOAD(c + cstep);
        __syncthreads();
        mm_acc<2>(y, RW_SLOT(lds, 0), RS, RW_SLOT(lds, 1), RS, w, lane);
        acc_zero(g); mm_acc<5>(g, SG, RG_S, GU, RG_S, w, lane);
#pragma unroll
        for (int tn = 0; tn < 2; ++tn)
#pragma unroll
            for (int r = 0; r < 4; ++r) { YL[(m0 + r) * RW_FS + n0 + 16 * tn] = y[tn][r]; GL[(m0 + r) * RW_FS + n0 + 16 * tn] = g[tn][r]; }
        __syncthreads();
        { const int t = t0 + et;
          float yv[8], gv[8]; float s1 = 0.f, s2 = 0.f;
#pragma unroll
          for (int e = 0; e < 8; ++e) { yv[e] = YL[et * RW_FS + 8 * cg + e]; gv[e] = GL[et * RW_FS + 8 * cg + e]; s1 += yv[e]; s2 += yv[e] * yv[e]; }
          s1 += __shfl_xor(s1, 1); s1 += __shfl_xor(s1, 2); s1 += __shfl_xor(s1, 4);
          s2 += __shfl_xor(s2, 1); s2 += __shfl_xor(s2, 2); s2 += __shfl_xor(s2, 4);
          const float mean = s1 * (1.f / 64.f), var = fmaxf(s2 * (1.f / 64.f) - mean * mean, 0.f), rstd = rsqrtf(var + 64e-5f);
          f16x8 o;
#pragma unroll
          for (int e = 0; e < 8; ++e) { const int jj = 8 * cg + e; const float vv = (float)vcc[e] + ((float)vpp[e] - (float)vcc[e]) * PRM[160 + jj];
              const float yn = (yv[e] - mean) * rstd * PRM[224 + jj] + PRM[288 + jj]; o[e] = (f16)((yn + sbc * vv) * gv[e]); }
          *(f16x8*)(mix + (size_t)t * D + 1024 + ch0) = o; }
    }
}

constexpr int RT_XS = 2048 + 8;
__device__ __forceinline__ void p_router(const Args& a, LAS unsigned char* lds, int rep) {
    const int tid = opaque_tid(), lane = tid & 63, wave = __builtin_amdgcn_readfirstlane(tid >> 6);
    const float* x2 = (const float*)(a.ws + WS_X1); f16* h3 = (f16*)a.out;
    unsigned* ctl = (unsigned*)(a.ws + WS_CTL);
    int* tke = (int*)(a.ws + WS_TOK + TK_E); float* tkw = (float*)(a.ws + WS_TOK + TK_W);
    const f16* WH = (const f16*)(a.ws + WS_WRH); const f16* WL = (const f16*)(a.ws + WS_WRL);
    LAS float* PART = (LAS float*)lds;
    LAS float* SSP = PART + 8 * 16 * 48;
    LAS float* LG = SSP + 128;
    LAS float* RSTD = LG + 16 * 48;
    LAS float* XT = RSTD + 16;
    const int row = lane & 15, kq = lane >> 4;
    for (int tile = blockIdx.x; tile < T / 16; tile += gridDim.x) {
        const int r0 = tile * 16;
        f32x4 acc[3]; acc[0] = (f32x4){0.f, 0.f, 0.f, 0.f}; acc[1] = acc[0]; acc[2] = acc[0];
        float ss = 0.f;
        const float* xp = x2 + (size_t)(r0 + row) * D + 256 * wave + 8 * kq;
        const f16* whp = WH + (size_t)row * D + 256 * wave + 8 * kq; const f16* wlp = WL + (size_t)row * D + 256 * wave + 8 * kq;
#pragma unroll 1
        for (int kb = 0; kb < 2; ++kb) {
            f32x4 xa[4], xb[4]; f16x8 bh[4][3], bl[4][3];
#pragma unroll
            for (int k4 = 0; k4 < 4; ++k4) { const int ks = kb * 4 + k4; xa[k4] = *(const f32x4*)(xp + 32 * ks); xb[k4] = *(const f32x4*)(xp + 32 * ks + 4);
#pragma unroll
                for (int nt = 0; nt < 3; ++nt) { bh[k4][nt] = *(const f16x8*)(whp + (size_t)nt * 16 * D + 32 * ks); bl[k4][nt] = *(const f16x8*)(wlp + (size_t)nt * 16 * D + 32 * ks); } }
            asm volatile("s_waitcnt vmcnt(0)" ::: "memory");
#pragma unroll
            for (int k4 = 0; k4 < 4; ++k4) {
                { LAS float* xd = XT + row * RT_XS + 256 * wave + 32 * (kb * 4 + k4) + 8 * kq; *(LAS f32x4*)xd = xa[k4]; *(LAS f32x4*)(xd + 4) = xb[k4]; }
                ss += xa[k4].x * xa[k4].x + xa[k4].y * xa[k4].y + xa[k4].z * xa[k4].z + xa[k4].w * xa[k4].w + xb[k4].x * xb[k4].x + xb[k4].y * xb[k4].y + xb[k4].z * xb[k4].z + xb[k4].w * xb[k4].w;
                f16x8 hi, lo;
#pragma unroll
                for (int j = 0; j < 4; ++j) { hi[j] = (f16)xa[k4][j]; lo[j] = (f16)(xa[k4][j] - (float)hi[j]); hi[4 + j] = (f16)xb[k4][j]; lo[4 + j] = (f16)(xb[k4][j] - (float)hi[4 + j]); }
#pragma unroll
                for (int nt = 0; nt < 3; ++nt) {
                    acc[nt] = __builtin_amdgcn_mfma_f32_16x16x32_f16(hi, bh[k4][nt], acc[nt], 0, 0, 0); acc[nt] = __builtin_amdgcn_mfma_f32_16x16x32_f16(lo, bh[k4][nt], acc[nt], 0, 0, 0); acc[nt] = __builtin_amdgcn_mfma_f32_16x16x32_f16(hi, bl[k4][nt], acc[nt], 0, 0, 0); }
            }
        }
        ss += __shfl_xor(ss, 16); ss += __shfl_xor(ss, 32);
        __syncthreads();
        if (kq == 0) SSP[wave * 16 + row] = ss;
#pragma unroll
        for (int nt = 0; nt < 3; ++nt)
#pragma unroll
            for (int r = 0; r < 4; ++r) PART[(wave * 16 + 4 * kq + r) * 48 + 16 * nt + row] = acc[nt][r];
        __syncthreads();
        for (int i = tid; i < 16 * 48; i += 512) { float v = 0.f;
#pragma unroll
            for (int ww = 0; ww < 8; ++ww) v += PART[ww * 768 + i];
            LG[i] = v; }
        if (tid < 16) { float v = 0.f;
#pragma unroll
            for (int ww = 0; ww < 8; ++ww) v += SSP[ww * 16 + tid];
            RSTD[tid] = rsqrtf(v * (1.f / D) + EPS); }
        __syncthreads();
        if (tid < 16) {
            const float rs = RSTD[tid]; const LAS float* L = LG + tid * 48;
            float lg[4];
#pragma unroll
            for (int c = 0; c < 4; ++c) lg[c] = L[c] * rs + a.in[I_RGB][c];
            int gi = 0; float gm = lg[0];
#pragma unroll
            for (int c = 1; c < 4; ++c) if (lg[c] > gm) { gm = lg[c]; gi = c; }
            float gs = 0.f;
#pragma unroll
            for (int c = 0; c < 4; ++c) gs += __expf(lg[c] - gm);
            const float pg = 1.f / gs;
            float le[8];
#pragma unroll
            for (int c = 0; c < 8; ++c) le[c] = L[4 + gi * 8 + c] * rs + a.in[I_REB][gi * 8 + c];
            int e1 = 0; float m1 = le[0];
#pragma unroll
            for (int c = 1; c < 8; ++c) if (le[c] > m1) { m1 = le[c]; e1 = c; }
            int e2 = -1; float m2 = -INFINITY;
#pragma unroll
            for (int c = 0; c < 8; ++c) if (c != e1 && le[c] > m2) { m2 = le[c]; e2 = c; }
            const float p2 = __expf(m2 - m1);
            const float w1 = pg / (1.f + p2), w2 = pg * p2 / (1.f + p2);
            const int m = r0 + tid, E1 = gi * 8 + e1, E2 = gi * 8 + e2; tke[m * 2] = E1; tke[m * 2 + 1] = E2; tkw[m * 2] = w1; tkw[m * 2 + 1] = w2;
            atomicAdd(&ctl[CW_CNT + rep * 8000 + E1], 1u); atomicAdd(&ctl[CW_CNT + rep * 8000 + E2], 1u);
        }
        { f32x4 xv[2][8], gg[8]; const f32x4* gr = (const f32x4*)a.in[I_LN3] + lane;
#pragma unroll
          for (int j = 0; j < 8; ++j) gg[j] = gr[64 * j];
#pragma unroll
          for (int rr2 = 0; rr2 < 2; ++rr2) { const LAS f32x4* xr = (const LAS f32x4*)(XT + (wave * 2 + rr2) * RT_XS) + lane;
#pragma unroll
              for (int j = 0; j < 8; ++j) xv[rr2][j] = xr[64 * j]; }
#pragma unroll
          for (int rr2 = 0; rr2 < 2; ++rr2) { const int rr = wave * 2 + rr2; const float rs = RSTD[rr]; u32x2* o8 = (u32x2*)(h3 + (size_t)(r0 + rr) * D) + lane;
#pragma unroll
              for (int j = 0; j < 8; ++j) { const f32x4 v = xv[rr2][j]; u32x2 wv; wv.x = pkh(v.x * rs * gg[j].x, v.y * rs * gg[j].y); wv.y = pkh(v.z * rs * gg[j].z, v.w * rs * gg[j].w); o8[64 * j] = wv; } } }
        __syncthreads();
    }
}
__device__ __forceinline__ void p_slots(const Args& a, LAS unsigned char* lds, int rep) {
    unsigned* ctl = (unsigned*)(a.ws + WS_CTL);
    const int* tke = (const int*)(a.ws + WS_TOK + TK_E); const float* tkw = (const float*)(a.ws + WS_TOK + TK_W); int* tks = (int*)(a.ws + WS_TOK + TK_SLOT);
    int* stok = (int*)(a.ws + WS_TOK + TK_STOK); float* sw = (float*)(a.ws + WS_TOK + TK_SW);
    const int tid = opaque_tid(), lane = tid & 63;
    LAS int* offl = (LAS int*)lds; LAS int* cntl = offl + 64;
    __syncthreads();
    if (tid < 64) {
        const int n = lane < NEXP ? (int)ctl[CW_CNT + lane] : 0, nt = (n + 255) >> 8;
        int pre = nt;
#pragma unroll
        for (int o = 1; o < 32; o <<= 1) { const int v = __shfl_up(pre, o); if ((lane & 31) >= o) pre += v; }
        const int tb = pre - nt;
        if (lane < NEXP) { offl[lane] = tb * 256; cntl[lane] = n; }
        if (lane == NEXP - 1) offl[NEXP] = pre * 256;
        if (blockIdx.x == 0 && lane < NEXP) {
            int2* ugu = (int2*)(ctl + CW_UGU); int2* udn = (int2*)(ctl + CW_UDN);
            for (int rt = 0; rt < nt; ++rt) { const int pm = tb + rt;
#pragma unroll
                for (int jt = 0; jt < 2; ++jt) ugu[pm * 2 + jt] = make_int2(pm, lane * 2 + jt);
#pragma unroll
                for (int jt = 0; jt < 8; ++jt) udn[pm * 8 + jt] = make_int2(pm, lane * 8 + jt); }
            if (lane == NEXP - 1) { ctl[CW_NT] = (unsigned)pre; ctl[CW_NGU] = (unsigned)(pre * 2); ctl[CW_NDN] = (unsigned)(pre * 8); }
        }
    }
    __syncthreads();
    if (blockIdx.x == 0 && rep == 0) {
        for (int e = 0; e < NEXP; ++e) { const int end = offl[e + 1];
            for (int sl = offl[e] + cntl[e] + tid; sl < end; sl += 512) { stok[sl] = 0; sw[sl] = 0.f; } } }
    for (int i = blockIdx.x * 512 + tid; i < T * 2; i += gridDim.x * 512) { const int e = tke[i]; const int slot = offl[e] + (int)atomicAdd(&ctl[CW_CUR + rep * 8000 + e], 1u);
        stok[slot] = i >> 1; sw[slot] = tkw[i]; tks[i] = slot; }
}

constexpr int NPH = 17;
__global__ void __launch_bounds__(512, 2) mega(Args args) {
    extern __shared__ __attribute__((aligned(16))) unsigned char lds_raw[];
    LAS unsigned char* lds = (LAS unsigned char*)lds_raw;
    volatile LAS unsigned* MISC = (volatile LAS unsigned*)(lds + MISC_OFF);
    const int G = gridDim.x;
#define PH_IDS const int tid = opaque_tid(), lane = tid & 63, wave = tid >> 6, gw = blockIdx.x * 8 + wave, NGW = gridDim.x * 8; (void)tid; (void)lane; (void)gw; (void)NGW
    unsigned char* ws = args.ws;
    unsigned* ctl = (unsigned*)(ws + WS_CTL);
    if (threadIdx.x < 128) ((LAS unsigned*)(lds + MISC_OFF))[threadIdx.x] = 0u;
    __syncthreads();
    XcdBarrier bar; bar.bar = ctl + CW_BAR; bar.x = 0; bar.st = nullptr;
    const int lo = args.ph_lo, hi = args.ph_hi;
    if (hi - lo > 1 || DUPMASK != 0u) bar = xcd_barrier_post(ctl + CW_BAR, MISC + 8);
#ifndef PHMASK
#define PHMASK 0xFFFFFFFFu
#endif
#define IN(k) (((PHMASK >> (k)) & 1u) && lo <= (k) && (k) < hi)
#define BOTH(k) (IN(k) && IN((k) + 1))
#define GRID_BAR() xcd_barrier(bar)
#define NREP(k) ((((DUPMASK) >> (k)) & 1u) ? 2 : 1)

    for (int rep_ = 0; rep_ < NREP(0); ++rep_) if (IN(0)) { p0_prologue(args, lds); if (BOTH(0) || rep_ + 1 < NREP(0)) GRID_BAR(); }
    for (int rep_ = 0; rep_ < NREP(1); ++rep_) if (IN(1)) {
        { pg8::Gemm g{(const f16*)(ws + WS_H), (const f16*)(ws + WS_WIN), D, D, D, nullptr}; pg8::StaticOrder S; S.init(T, NZ, G, (int)blockIdx.x);
          pg8::EpiF16 E{(f16*)(ws + WS_Z), NZ, 1.f}; pg8::gemm_phase<pg8::EpiF16, pg8::StaticOrder, true>(lds, g, S, E); }
        if (BOTH(1) || rep_ + 1 < NREP(1)) GRID_BAR();
    }
    for (int rep_ = 0; rep_ < NREP(2); ++rep_) if (IN(2)) {
        for (int r2_ = 0; r2_ < ((DUPX & 1) ? 2 : 1); ++r2_) { p_compress(args, lds); __syncthreads(); }
        for (int r2_ = 0; r2_ < ((DUPX & 2) ? 2 : 1); ++r2_) { p_rwkv_local(args, lds); __syncthreads(); }
        if (BOTH(2) || rep_ + 1 < NREP(2)) GRID_BAR();
    }
    for (int rep_ = 0; rep_ < NREP(3); ++rep_) if (IN(3)) {
        if (blockIdx.x < 16) p_rwkv_scan(args, lds, blockIdx.x);
        else if (blockIdx.x < 32 && rep_ == 0) { const int b = blockIdx.x - 16; const int which = b / 8;
            pg8::Gemm g{(const f16*)(ws + WS_MEMN), (const f16*)(ws + (which == 0 ? WS_WKT : WS_WVT)), D, D, D, nullptr}; pg8::StaticOrder S; S.init(256, D, 8, b % 8);
            pg8::EpiF16 E{(f16*)(ws + (which == 0 ? WS_KM : WS_VM)), D, 1.f}; pg8::gemm_phase<pg8::EpiF16, pg8::StaticOrder, true>(lds, g, S, E); }
        __syncthreads();
        p_nsa(args, lds, rep_);
        if (BOTH(3) || rep_ + 1 < NREP(3)) GRID_BAR();
    }
    for (int rep_ = 0; rep_ < NREP(5); ++rep_) if (IN(5)) {
        p_rwkv_out(args, lds);
        __syncthreads();
        PH_IDS;
        if (blockIdx.x < 64) { const int b = blockIdx.x; const int grp = b / 8, c = b % 8;
          if (grp < 4) { const int h = grp;
              pg8::Gemm g{(const f16*)(ws + WS_KM) + h * 512, (const f16*)(ws + WS_WQ16) + h * 512, D, D, 512, nullptr}; pg8::StaticOrder S; S.init(256, D, 8, c);
              pg8::EpiF16 E{(f16*)(ws + WS_WQK) + (size_t)h * 256 * D, D, 0.04419417382415922f}; pg8::gemm_phase<pg8::EpiF16, pg8::StaticOrder, true>(lds, g, S, E); }
          else { const int h = grp - 4;
              pg8::Gemm g{(const f16*)(ws + WS_WOT) + h * 512, (const f16*)(ws + WS_VM) + h * 512, D, D, 512, nullptr}; pg8::StaticOrder S; S.init(D, 256, 8, c);
              pg8::EpiF16 E{(f16*)(ws + WS_VOT) + h * 256, 1024, 1.f}; pg8::gemm_phase<pg8::EpiF16, pg8::StaticOrder, true>(lds, g, S, E); } }
        else {
        const float* onsa = (const float*)(ws + WS_ONSA); f16* mix = (f16*)(ws + WS_MIX);
        for (int m = gw - 64 * 8; m < T; m += NGW - 64 * 8) { const f32x4* xr = (const f32x4*)(onsa + (size_t)m * 1024) + lane; f32x4 v[4]; float s = 0.f;
#pragma unroll
            for (int j = 0; j < 4; ++j) { v[j] = xr[64 * j]; s += v[j].x * v[j].x + v[j].y * v[j].y + v[j].z * v[j].z + v[j].w * v[j].w; }
            const f32x4* gr = (const f32x4*)args.in[I_NSAG] + lane; f32x4 gg[4];
#pragma unroll
            for (int j = 0; j < 4; ++j) gg[j] = gr[64 * j];
            const float rstd = rsqrtf(wave_sum(s) * (1.f / 1024.f) + EPS); u32x2* o8 = (u32x2*)(mix + (size_t)m * D) + lane;
#pragma unroll
            for (int j = 0; j < 4; ++j) { u32x2 w; w.x = pkh(v[j].x * rstd * gg[j].x, v[j].y * rstd * gg[j].y); w.y = pkh(v[j].z * rstd * gg[j].z, v[j].w * rstd * gg[j].w); o8[64 * j] = w; } }
        }
        if (BOTH(5) || rep_ + 1 < NREP(5)) GRID_BAR();
    }
    for (int rep_ = 0; rep_ < NREP(6); ++rep_) if (IN(6)) {
        pg8::Gemm g{(const f16*)(ws + WS_MIX), (const f16*)(ws + WS_WOUT), D, D, D, nullptr}; pg8::StaticOrder S; S.init(T, D, G, (int)blockIdx.x);
        pg8::EpiF32 E{(float*)(ws + WS_X1), args.in[I_X], D}; pg8::gemm_phase<pg8::EpiF32, pg8::StaticOrder, true>(lds, g, S, E);
        if (BOTH(6) || rep_ + 1 < NREP(6)) GRID_BAR();
    }
    for (int rep_ = 0; rep_ < NREP(7); ++rep_) if (IN(7)) {
        PH_IDS;
        for (int m = gw; m < T; m += NGW) rms_row((const float*)(ws + WS_X1) + (size_t)m * D, args.in[I_LN2], (f16*)(ws + WS_H2) + (size_t)m * D, lane);
        p_moe_weights(args, lds);
        if (BOTH(7) || rep_ + 1 < NREP(7)) GRID_BAR();
    }
    for (int rep_ = 0; rep_ < NREP(8); ++rep_) if (IN(8)) {
        pg8::Gemm g{(const f16*)(ws + WS_H2), (const f16*)(ws + WS_WQK), D, D, D, nullptr}; pg8::StaticOrder S; S.init(T, 1024, G, (int)blockIdx.x);
        pg8::EpiF32 E{(float*)(ws + WS_S), nullptr, 1024}; pg8::gemm_phase<pg8::EpiF32, pg8::StaticOrder, true>(lds, g, S, E);
        if (BOTH(8) || rep_ + 1 < NREP(8)) GRID_BAR();
    }
    for (int rep_ = 0; rep_ < NREP(9); ++rep_) if (IN(9)) {
        PH_IDS;
        const float* Sm = (const float*)(ws + WS_S); f16* P = (f16*)(ws + WS_P);
        for (int it = gw; it < T * 4; it += NGW) { const f32x4 v = *((const f32x4*)(Sm + (size_t)it * 256) + lane);
            const float mx = wave_max(fmaxf(fmaxf(v.x, v.y), fmaxf(v.z, v.w)));
            const float e0 = __expf(v.x - mx), e1 = __expf(v.y - mx), e2 = __expf(v.z - mx), e3 = __expf(v.w - mx);
            const float inv = 1.f / wave_sum(e0 + e1 + e2 + e3);
            u32x2 w; w.x = pkh(e0 * inv, e1 * inv); w.y = pkh(e2 * inv, e3 * inv); *((u32x2*)(P + (size_t)it * 256) + lane) = w; }
        if (BOTH(9) || rep_ + 1 < NREP(9)) GRID_BAR();
    }
    for (int rep_ = 0; rep_ < NREP(10); ++rep_) if (IN(10)) {
        pg8::Gemm g{(const f16*)(ws + WS_P), (const f16*)(ws + WS_VOT), 1024, 1024, 1024, nullptr}; pg8::StaticOrder S; S.init(T, D, G, (int)blockIdx.x);
        pg8::EpiF32 E{(float*)(ws + WS_X1), (const float*)(ws + WS_X1), D}; pg8::gemm_phase<pg8::EpiF32, pg8::StaticOrder, true>(lds, g, S, E);
        if (BOTH(10) || rep_ + 1 < NREP(10)) GRID_BAR();
    }
    for (int rep_ = 0; rep_ < NREP(11); ++rep_) if (IN(11)) { p_router(args, lds, rep_); if (BOTH(11) || rep_ + 1 < NREP(11)) GRID_BAR(); }
    for (int rep_ = 0; rep_ < NREP(13); ++rep_) if (IN(13)) { p_slots(args, lds, rep_); if (BOTH(13) || rep_ + 1 < NREP(13)) GRID_BAR(); }
    for (int rep_ = 0; rep_ < NREP(14); ++rep_) if (IN(14)) {
        pg8::Gemm g{(const f16*)args.out, (const f16*)(ws + WS_WGU), D, D, D, (const int*)(ws + WS_TOK + TK_STOK)};
        pg8::TableOrder S{(const int2*)(ctl + CW_UGU), (int)ctl[CW_NGU], G, (int)blockIdx.x};
        pg8::EpiSilu E{(f16*)(ws + WS_HID)}; pg8::gemm_phase<pg8::EpiSilu, pg8::TableOrder, true, true>(lds, g, S, E);
        if (BOTH(14) || rep_ + 1 < NREP(14)) GRID_BAR();
    }
    for (int rep_ = 0; rep_ < NREP(15); ++rep_) if (IN(15)) {
        pg8::Gemm g{(const f16*)(ws + WS_HID), (const f16*)(ws + WS_WD), EFF, EFF, EFF, nullptr};
        pg8::TableOrder S{(const int2*)(ctl + CW_UDN), (int)ctl[CW_NDN], G, (int)blockIdx.x};
        pg8::EpiDown E{ws}; pg8::gemm_phase<pg8::EpiDown, pg8::TableOrder, true>(lds, g, S, E);
        if (BOTH(15) || rep_ + 1 < NREP(15)) GRID_BAR();
    }
    for (int rep_ = 0; rep_ < NREP(16); ++rep_) if (IN(16)) {
        PH_IDS;
        const float* x2 = (const float*)(ws + WS_X1); const int* tks = (const int*)(ws + WS_TOK + TK_SLOT);
        const float* tkw = (const float*)(ws + WS_TOK + TK_W);
        for (int m = gw; m < T; m += NGW) { const int s1 = tks[m * 2], s2 = tks[m * 2 + 1]; const float w1 = tkw[m * 2], w2 = tkw[m * 2 + 1];
            const f16* y1 = (const f16*)(ws + ((s1 >> 8) < 128 ? WS_Y0 + (size_t)(s1 >> 8) * MiB : WS_Y1 + (size_t)((s1 >> 8) - 128) * MiB)) + (size_t)(s1 & 255) * D;
            const f16* y2 = (const f16*)(ws + ((s2 >> 8) < 128 ? WS_Y0 + (size_t)(s2 >> 8) * MiB : WS_Y1 + (size_t)((s2 >> 8) - 128) * MiB)) + (size_t)(s2 & 255) * D;
            const f32x4* xr = (const f32x4*)(x2 + (size_t)m * D) + lane; f32x4 v[8]; float s = 0.f;
#pragma unroll
            for (int j = 0; j < 8; ++j) { v[j] = xr[64 * j]; const f16x4 a1 = *((const f16x4*)y1 + lane + 64 * j), a2 = *((const f16x4*)y2 + lane + 64 * j);
                v[j].x += w1 * (float)a1.x + w2 * (float)a2.x; v[j].y += w1 * (float)a1.y + w2 * (float)a2.y; v[j].z += w1 * (float)a1.z + w2 * (float)a2.z; v[j].w += w1 * (float)a1.w + w2 * (float)a2.w;
                s += v[j].x * v[j].x + v[j].y * v[j].y + v[j].z * v[j].z + v[j].w * v[j].w; }
            const f32x4* gr = (const f32x4*)args.in[I_LNF] + lane; f32x4 gg[8];
#pragma unroll
            for (int j = 0; j < 8; ++j) gg[j] = gr[64 * j];
            const float rstd = rsqrtf(wave_sum(s) * (1.f / D) + EPS); f32x4* o = (f32x4*)(args.out + (size_t)m * D) + lane;
#pragma unroll
            for (int j = 0; j < 8; ++j) o[64 * j] = (f32x4){v[j].x * rstd * gg[j].x, v[j].y * rstd * gg[j].y, v[j].z * rstd * gg[j].z, v[j].w * rstd * gg[j].w}; }
    }
#undef IN
#undef BOTH
#undef GRID_BAR
}

extern "C" void kernel_launch(void* const* d_in, const int* in_sizes, int n_in, void* d_out, int out_size, void* d_ws, size_t ws_size, hipStream_t stream) {
    static int grid = 0;
    if (grid == 0) {
        if (n_in != 38 || out_size != T * D || ws_size < WS_END) { fprintf(stderr, "kernel_launch: unexpected shapes (n_in %d out %d ws %zu)\n", n_in, out_size, ws_size); grid = -1; return; }
        int dev = 0, cus = 0;
        if (hipGetDevice(&dev) != hipSuccess || hipDeviceGetAttribute(&cus, hipDeviceAttributeMultiprocessorCount, dev) != hipSuccess) { grid = -1; return; }
        if (hipFuncSetAttribute((const void*)mega, hipFuncAttributeMaxDynamicSharedMemorySize, LDS_BYTES) != hipSuccess) { grid = -1; return; }
        int per_cu = 0; (void)hipOccupancyMaxActiveBlocksPerMultiprocessor(&per_cu, (const void*)mega, 512, LDS_BYTES); (void)hipGetLastError();
        grid = cus;
    }
    if (grid < 0) return;
    (void)hipMemsetAsync((char*)d_ws + WS_CTL, 0, CTL_ZERO_BYTES, stream);
    Args a{};
    for (int i = 0; i < 38; ++i) a.in[i] = (const float*)d_in[i];
    a.out = (float*)d_out; a.ws = (unsigned char*)d_ws;
#if MK_ONE_LAUNCH
    a.ph_lo = 0; a.ph_hi = NPH;
    hipLaunchKernelGGL(mega, dim3(grid), dim3(512), LDS_BYTES, stream, a);
#else
    for (int p = 0; p < NPH; ++p) { a.ph_lo = p; a.ph_hi = p + 1; hipLaunchKernelGGL(mega, dim3(grid), dim3(512), LDS_BYTES, stream, a); }
#endif
}
```

```cpp
#include <hip/hip_runtime.h>
#include <cstdio>
#include <cstdint>

#ifndef DUPMASK
#define DUPMASK 0u
#endif
#ifndef NSA_SELREP
#define NSA_SELREP 1
#endif
#ifndef NSA_CMPREP
#define NSA_CMPREP 1
#endif
#ifndef NSA_WINREP
#define NSA_WINREP 1
#endif
#ifndef DUPX
#define DUPX 0
#endif
#ifndef MK_ONE_LAUNCH
#define MK_ONE_LAUNCH 1
#endif

#define LAS __attribute__((address_space(3)))
#define GAS __attribute__((address_space(1)))
typedef _Float16 f16;
typedef _Float16 f16x8 __attribute__((ext_vector_type(8)));
typedef _Float16 f16x4 __attribute__((ext_vector_type(4)));
typedef _Float16 f16x2 __attribute__((ext_vector_type(2)));
typedef float f32x4 __attribute__((ext_vector_type(4)));
typedef float f32x2 __attribute__((ext_vector_type(2)));
typedef unsigned u32x4 __attribute__((ext_vector_type(4)));
typedef unsigned u32x2 __attribute__((ext_vector_type(2)));
typedef __bf16 bf16;
typedef __bf16 bf16x8 __attribute__((ext_vector_type(8)));
typedef __bf16 bf16x4 __attribute__((ext_vector_type(4)));

constexpr int T = 16384, D = 2048, NZ = 6144;
constexpr int ZQ = 0, ZKC = 1024, ZVC = 1280, ZKS = 1536, ZVS = 1792, ZKW = 2048, ZVW = 2304, ZR = 2560, ZK = 3584, ZV = 4608, ZWD = 5632, ZAD = 5696, ZGD = 5760, ZGL = 5920;
constexpr int NCMP = 1023;
constexpr int NEXP = 32, EFF = 256, MAXSLOT = 40960, MAXTILES = 160;
constexpr float EPS = 1e-6f;

constexpr size_t MiB = 1u << 20;
constexpr size_t WS_CTL = 0, CTL_ZERO_BYTES = 192 * 1024, WS_ROWSS = 128 * 1024;
constexpr size_t WS_MEMN = 1 * MiB, WS_KM = 2 * MiB, WS_VM = 3 * MiB, WS_KCMP = 4 * MiB, WS_VCMP = 5 * MiB, WS_TOK = 6 * MiB, WS_CMPB = 7 * MiB;
constexpr size_t WS_WQK = 8 * MiB, WS_VOT = 12 * MiB, WS_WIN = 16 * MiB, WS_WOUT = 40 * MiB, WS_WQ16 = 48 * MiB, WS_WKT = 56 * MiB, WS_WVT = 64 * MiB, WS_WOT = 72 * MiB;
constexpr size_t WS_WGU = 80 * MiB, WS_WD = 144 * MiB, WS_H = 176 * MiB, WS_Z = 240 * MiB, WS_ONSA = 432 * MiB, WS_END = 512 * MiB;
constexpr size_t WS_MIX = 112 * MiB, WS_P = WS_H, WS_H2 = WS_Z, WS_X1 = 304 * MiB, WS_S = WS_ONSA, WS_HID = 16 * MiB;
constexpr size_t WS_Y0 = 176 * MiB, WS_Y1 = 432 * MiB;
constexpr size_t WS_RS = 200 * MiB, WS_SBON = 232 * MiB;
constexpr size_t WS_WUPT = WS_CMPB + 64 * 1024, WS_AUPT = WS_WUPT + 128 * 1024, WS_GUPT = WS_AUPT + 128 * 1024;
constexpr size_t WS_W1T = 496 * MiB, WS_W2T = 498 * MiB, WS_CBIAS = 498 * MiB + 65536;
constexpr size_t WS_WRH = 499 * MiB, WS_WRL = 499 * MiB + 256 * 1024;
constexpr size_t RO_M = 0, RO_N = 32 * MiB, RO_Q = 64 * MiB, RO_Y = 96 * MiB;
constexpr size_t TK_E = 0, TK_W = 128 * 1024, TK_SLOT = 256 * 1024, TK_STOK = 384 * 1024, TK_SW = 576 * 1024;
constexpr int CW_BAR = 0;
constexpr int CW_Q = 3584;
constexpr int CW_CNT = 4096, CW_CUR = 4160, CW_OFF = 4224, CW_NT = 4288  , CW_NGU = 4289, CW_NDN = 4290;
constexpr int CW_UGU = 6144  , CW_UDN = 8192  ;
static_assert((CW_UDN + MAXTILES * 8 * 2) * 4 <= (int)CTL_ZERO_BYTES, "ctl");

constexpr int RING_BYTES = 131072, LDS_BYTES = 163840, MISC_OFF = LDS_BYTES - 512;

__device__ __forceinline__ unsigned pkh(float a, float b) { f16x2 v = {(f16)a, (f16)b}; return __builtin_bit_cast(unsigned, v); }
__device__ __forceinline__ float wave_sum(float v) {
#pragma unroll
    for (int o = 1; o < 64; o <<= 1) v += __shfl_xor(v, o);
    return v;
}
__device__ __forceinline__ float wave_max(float v) {
#pragma unroll
    for (int o = 1; o < 64; o <<= 1) v = fmaxf(v, __shfl_xor(v, o));
    return v;
}
__device__ __forceinline__ int opaque_tid() { int t = threadIdx.x; asm volatile("" : "+v"(t)); return t; }
#define LDS_WAIT() asm volatile("s_waitcnt lgkmcnt(0)" ::: "memory")
#define VM_WAIT() asm volatile("s_waitcnt vmcnt(0)" ::: "memory")
__device__ __forceinline__ float sigmoidf_(float x) { return 1.f / (1.f + __expf(-x)); }

namespace pg8 {
constexpr int BM = 256, BK = 64, HALF = 128, HTB = HALF * BK * 2, STAGE_BYTES = 8 * HTB, NXCD = 8, WGM = 8;
__host__ __device__ __forceinline__ int lds_byte(int r, int c) { const int st = (r >> 4) * 2 + (c >> 5), rr = r & 15, cc = c & 31, ob = rr * 64 + cc * 2; return st * 1024 + (ob ^ (((ob >> 9) & 1) << 5)); }
__host__ __device__ __forceinline__ void stage_rc(int b, int& R, int& C) { const int st = b / 1024, sb = b % 1024, swz = sb ^ (((sb >> 9) & 1) << 5); R = (st >> 1) * 16 + swz / 64; C = (st & 1) * 32 + (swz % 64) / 2; }
__host__ __device__ __forceinline__ int perm32(int rho) { const int n = rho >> 4, i = rho & 15; return 8 * (i >> 2) + 4 * n + (i & 3); }

struct Unit { int pm, pn; };
struct Gemm { const f16* A; const f16* Bt; int lda, ldb, K; const int* gather; };

struct StaticOrder {
    int nM, nN, nwg, G, c;
    __host__ __device__ void init(int M, int N, int G_, int c_) { nM = M / BM; nN = N / BM; nwg = nM * nN; G = G_; c = c_; }
    __host__ __device__ bool next(int i, Unit& u) const {
        const long L = (long)i * G + c; if (L >= nwg) return false;
        int wgid = (int)L; { const int q = nwg / NXCD, r = nwg % NXCD, xcd = wgid % NXCD, off = wgid / NXCD; wgid = (xcd < r ? xcd * (q + 1) : r * (q + 1) + (xcd - r) * q) + off; }
        const int nig = WGM * nN, gid = wgid / nig, fm = gid * WGM, gsz = (nM - fm) < WGM ? (nM - fm) : WGM;
        u.pm = fm + ((wgid % nig) % gsz); u.pn = (wgid % nig) / gsz; return true;
    }
};
struct TableOrder {
    const int2* tab; int n, G, c;
    __device__ bool next(int i, Unit& u) const { const int L = i * G + c; if (L >= n) return false; const int2 v = tab[L]; u.pm = v.x; u.pn = v.y; return true; }
};

struct EpiF16 {
    static constexpr bool PERM = true;
    f16* O; int ldc; float scale;
    __device__ __forceinline__ void operator()(const f32x4 (&acc)[2][2][4][2], const Unit& u, int wr, int wc, int fr, int fq) const {
        const int row0 = u.pm * BM + wr * 64 + fr, col0 = u.pn * BM + wc * 32 + 8 * fq;
#pragma unroll
        for (int ai = 0; ai < 2; ++ai)
#pragma unroll
            for (int m = 0; m < 4; ++m) { f16* rowp = O + (size_t)(row0 + ai * HALF + m * 16) * ldc + col0;
#pragma unroll
                for (int bj = 0; bj < 2; ++bj) { const f32x4 v0 = acc[ai][bj][m][0] * scale, v1 = acc[ai][bj][m][1] * scale;
                    u32x4 w; w.x = pkh(v0[0], v0[1]); w.y = pkh(v0[2], v0[3]); w.z = pkh(v1[0], v1[1]); w.w = pkh(v1[2], v1[3]);
                    *(u32x4*)(rowp + bj * HALF) = w; } }
    }
};
struct EpiF32 {
    static constexpr bool PERM = false;
    float* C; const float* R; int ldc;
    __device__ __forceinline__ void operator()(const f32x4 (&acc)[2][2][4][2], const Unit& u, int wr, int wc, int fr, int fq) const {
        const int row0 = u.pm * BM + wr * 64 + fr, col0 = u.pn * BM + wc * 32 + 4 * fq;
#pragma unroll
        for (int ai = 0; ai < 2; ++ai)
#pragma unroll
            for (int m = 0; m < 4; ++m) { const size_t ro = (size_t)(row0 + ai * HALF + m * 16) * ldc + col0;
#pragma unroll
                for (int bj = 0; bj < 2; ++bj)
#pragma unroll
                    for (int n = 0; n < 2; ++n) { f32x4 v = acc[ai][bj][m][n]; if (R) v = v + *(const f32x4*)(R + ro + bj * HALF + n * 16); *(f32x4*)(C + ro + bj * HALF + n * 16) = v; } }
    }
};
struct EpiRes16 {
    static constexpr bool PERM = false;
    float* C; const float* R; f16* H; float* rowss; int ldc;
    __device__ __forceinline__ void operator()(const f32x4 (&acc)[2][2][4][2], const Unit& u, int wr, int wc, int fr, int fq) const {
        const int row0 = u.pm * BM + wr * 64 + fr, col0 = u.pn * BM + wc * 32 + 4 * fq;
#pragma unroll
        for (int ai = 0; ai < 2; ++ai)
#pragma unroll
            for (int m = 0; m < 4; ++m) { const int row = row0 + ai * HALF + m * 16; const size_t ro = (size_t)row * ldc + col0; float ss = 0.f;
                f32x4 v[2][2];
#pragma unroll
                for (int bj = 0; bj < 2; ++bj)
#pragma unroll
                    for (int n = 0; n < 2; ++n) v[bj][n] = acc[ai][bj][m][n] + *(const f32x4*)(R + ro + bj * HALF + n * 16);
#pragma unroll
                for (int bj = 0; bj < 2; ++bj)
#pragma unroll
                    for (int n = 0; n < 2; ++n) { const f32x4 x = v[bj][n]; *(f32x4*)(C + ro + bj * HALF + n * 16) = x; ss += x.x * x.x + x.y * x.y + x.z * x.z + x.w * x.w;
                        u32x2 hw; hw.x = pkh(x.x, x.y); hw.y = pkh(x.z, x.w); *(u32x2*)(H + ro + bj * HALF + n * 16) = hw; }
                ss += __shfl_xor(ss, 16); ss += __shfl_xor(ss, 32);
                if (fq == 0) atomicAdd(rowss + row, ss); }
    }
};
struct EpiSoftmax {
    static constexpr bool PERM = true;
    f16* O; int ldc; const float* rowss; LAS float* xm; LAS float* xs;
    __device__ __forceinline__ void operator()(const f32x4 (&acc)[2][2][4][2], const Unit& u, int wr, int wc, int fr, int fq) const {
        const int row0 = u.pm * BM + wr * 64 + fr, col0 = u.pn * BM + wc * 32 + 8 * fq;
        float rs[2][4], mx[2][4];
#pragma unroll
        for (int ai = 0; ai < 2; ++ai)
#pragma unroll
            for (int m = 0; m < 4; ++m) { rs[ai][m] = rsqrtf(rowss[row0 + ai * HALF + m * 16] * (1.f / D) + EPS); float v = -INFINITY;
#pragma unroll
                for (int bj = 0; bj < 2; ++bj)
#pragma unroll
                    for (int n = 0; n < 2; ++n)
#pragma unroll
                        for (int e = 0; e < 4; ++e) v = fmaxf(v, acc[ai][bj][m][n][e]);
                v *= rs[ai][m]; v = fmaxf(v, __shfl_xor(v, 16)); v = fmaxf(v, __shfl_xor(v, 32));
                if (fq == 0) xm[(ai * HALF + wr * 64 + m * 16 + fr) * 4 + wc] = v; }
        asm volatile("s_waitcnt lgkmcnt(0)" ::: "memory"); __builtin_amdgcn_s_barrier(); asm volatile("" ::: "memory");
        float e_[2][4][16]; float inv[2][4];
#pragma unroll
        for (int ai = 0; ai < 2; ++ai)
#pragma unroll
            for (int m = 0; m < 4; ++m) { const LAS f32x4* q = (const LAS f32x4*)(xm + (ai * HALF + wr * 64 + m * 16 + fr) * 4); const f32x4 mm = *q; mx[ai][m] = fmaxf(fmaxf(mm.x, mm.y), fmaxf(mm.z, mm.w)); float sm = 0.f;
#pragma unroll
                for (int bj = 0; bj < 2; ++bj)
#pragma unroll
                    for (int n = 0; n < 2; ++n)
#pragma unroll
                        for (int e = 0; e < 4; ++e) { const float ev = __expf(acc[ai][bj][m][n][e] * rs[ai][m] - mx[ai][m]); e_[ai][m][bj * 8 + n * 4 + e] = ev; sm += ev; }
                sm += __shfl_xor(sm, 16); sm += __shfl_xor(sm, 32);
                if (fq == 0) xs[(ai * HALF + wr * 64 + m * 16 + fr) * 4 + wc] = sm; }
        asm volatile("s_waitcnt lgkmcnt(0)" ::: "memory"); __builtin_amdgcn_s_barrier(); asm volatile("" ::: "memory");
#pragma unroll
        for (int ai = 0; ai < 2; ++ai)
#pragma unroll
            for (int m = 0; m < 4; ++m) { const f32x4 ssum = *(const LAS f32x4*)(xs + (ai * HALF + wr * 64 + m * 16 + fr) * 4); inv[ai][m] = 1.f / ((ssum.x + ssum.y) + (ssum.z + ssum.w));
                f16* rowp = O + (size_t)(row0 + ai * HALF + m * 16) * ldc + col0;
#pragma unroll
                for (int bj = 0; bj < 2; ++bj) { const float* ee = &e_[ai][m][bj * 8]; const float iv = inv[ai][m];
                    u32x4 w; w.x = pkh(ee[0] * iv, ee[1] * iv); w.y = pkh(ee[2] * iv, ee[3] * iv); w.z = pkh(ee[4] * iv, ee[5] * iv); w.w = pkh(ee[6] * iv, ee[7] * iv);
                    *(u32x4*)(rowp + bj * HALF) = w; } }
    }
};
struct EpiSilu {
    static constexpr bool PERM = true;
    f16* O;
    __device__ __forceinline__ void operator()(const f32x4 (&acc)[2][2][4][2], const Unit& u, int wr, int wc, int fr, int fq) const {
        const int row0 = u.pm * BM + wr * 64 + fr, col0 = (u.pn & 1) * 128 + wc * 32 + 8 * fq;
#pragma unroll
        for (int ai = 0; ai < 2; ++ai)
#pragma unroll
            for (int m = 0; m < 4; ++m) { f16* rowp = O + (size_t)(row0 + ai * HALF + m * 16) * EFF + col0;
                float h[8];
#pragma unroll
                for (int n = 0; n < 2; ++n)
#pragma unroll
                    for (int e = 0; e < 4; ++e) { const float gt = acc[ai][0][m][n][e], up = acc[ai][1][m][n][e]; h[n * 4 + e] = gt / (1.f + __expf(-gt)) * up; }
                u32x4 w; w.x = pkh(h[0], h[1]); w.y = pkh(h[2], h[3]); w.z = pkh(h[4], h[5]); w.w = pkh(h[6], h[7]);
                *(u32x4*)rowp = w; }
    }
};
struct EpiDown {
    static constexpr bool PERM = true;
    unsigned char* ws;
    __device__ __forceinline__ void operator()(const f32x4 (&acc)[2][2][4][2], const Unit& u, int wr, int wc, int fr, int fq) const {
        f16* tile = (f16*)(ws + (u.pm < 128 ? WS_Y0 + (size_t)u.pm * MiB : WS_Y1 + (size_t)(u.pm - 128) * MiB));
        const int r0 = wr * 64 + fr, col0 = (u.pn & 7) * BM + wc * 32 + 8 * fq;
#pragma unroll
        for (int ai = 0; ai < 2; ++ai)
#pragma unroll
            for (int m = 0; m < 4; ++m) { f16* rowp = tile + (size_t)(r0 + ai * HALF + m * 16) * D + col0;
#pragma unroll
                for (int bj = 0; bj < 2; ++bj) { const f32x4 v0 = acc[ai][bj][m][0], v1 = acc[ai][bj][m][1];
                    u32x4 w; w.x = pkh(v0[0], v0[1]); w.y = pkh(v0[2], v0[3]); w.z = pkh(v1[0], v1[1]); w.w = pkh(v1[2], v1[3]);
                    *(u32x4*)(rowp + bj * HALF) = w; } }
    }
};

template <class Epi, class Sched, bool ALIGN_EPI, bool GATHER = false>
__device__ __forceinline__ void gemm_phase(LAS unsigned char* lds, const Gemm g, const Sched& S, const Epi& E) {
    const int tid = opaque_tid(), wid = __builtin_amdgcn_readfirstlane(tid >> 6), lane = tid & 63, wr = wid >> 2, wc = wid & 3, fr = lane & 15, fq = lane >> 4;
    const int K = g.K, nt = K / BK;
    int RA[2], CA[2]; unsigned voffA[2], voffB[2];
#pragma unroll
    for (int i = 0; i < 2; ++i) { int R, C; stage_rc(tid * 16 + i * 8192, R, C); const int Rb = Epi::PERM ? ((R & ~31) + perm32(R & 31)) : R;
        RA[i] = R; CA[i] = C; voffA[i] = (unsigned)(R * g.lda + C) * 2u; voffB[i] = (unsigned)(Rb * g.ldb + C) * 2u; }
    const size_t kstep = (size_t)(BK * 2);
    const size_t hstepA = (size_t)HALF * g.lda * 2, tstepA = 2 * hstepA;
    const size_t hstepB = (size_t)HALF * g.ldb * 2, tstepB = 2 * hstepB;
    const unsigned ldsw = (unsigned)wid * 1024u;
    const int aoff = lds_byte(wr * 64 + fr, fq * 8), boff = lds_byte(wc * 32 + fr, fq * 8);
    const char* Ab = (const char*)g.A;
#define PG8_SA(b, h) (((b) * 2 + (h)) * HTB)
#define PG8_SB(b, h) ((4 + (b) * 2 + (h)) * HTB)
#define PG8_STAGE(bufoff, gbase, voff) do { _Pragma("unroll") for (int _i = 0; _i < 2; ++_i) \
        __builtin_amdgcn_global_load_lds((const unsigned*)((const char*)(gbase) + (voff)[_i]), (LAS unsigned*)(lds + (bufoff) + ldsw + _i * 8192), 16, 0, 0); } while (0)
#define PG8_STA_CUR(bufoff, h, kb) do { if constexpr (GATHER) { PG8_STAGE(bufoff, Ab + (kb), offC[h]); } else { PG8_STAGE(bufoff, cA + (h) * hstepA + (kb), voffA); } } while (0)
#define PG8_STA_SEL(bufoff, h, kb) do { if constexpr (GATHER) { PG8_STAGE(bufoff, Ab + (kb), o2[h]); } else { PG8_STAGE(bufoff, a2p + (h) * hstepA + (kb), voffA); } } while (0)
#define PG8_LDA(dst, b, h) do { _Pragma("unroll") for (int m = 0; m < 4; ++m) _Pragma("unroll") for (int k = 0; k < 2; ++k) dst[m][k] = *(const LAS f16x8*)(lds + PG8_SA(b, h) + aoff + m * 2048 + k * 1024); } while (0)
#define PG8_LDB(dst, b, h) do { _Pragma("unroll") for (int n = 0; n < 2; ++n) _Pragma("unroll") for (int k = 0; k < 2; ++k) dst[n][k] = *(const LAS f16x8*)(lds + PG8_SB(b, h) + boff + n * 2048 + k * 1024); } while (0)
#define PG8_MMA(ai, bj, At, Bt) do { __builtin_amdgcn_s_setprio(1); _Pragma("unroll") for (int m = 0; m < 4; ++m) _Pragma("unroll") for (int n = 0; n < 2; ++n) _Pragma("unroll") for (int k = 0; k < 2; ++k) \
        acc[ai][bj][m][n] = __builtin_amdgcn_mfma_f32_16x16x32_f16(Bt[n][k], At[m][k], acc[ai][bj][m][n], 0, 0, 0); __builtin_amdgcn_s_setprio(0); } while (0)
#define PG8_WAIT_V(n) asm volatile("s_waitcnt vmcnt(" #n ")" ::: "memory")
#define PG8_WAIT_L(n) asm volatile("s_waitcnt lgkmcnt(" #n ")" ::: "memory")
#define PG8_BAR __builtin_amdgcn_s_barrier()
#define PG8_SCHED __builtin_amdgcn_sched_barrier(0)
#define PG8_OFFS(dst, U) do { _Pragma("unroll") for (int _h = 0; _h < 2; ++_h) _Pragma("unroll") for (int _i = 0; _i < 2; ++_i) { \
        const int _r = (U).pm * BM + _h * HALF + RA[_i]; dst[_h][_i] = ((unsigned)g.gather[_r] * (unsigned)g.lda + (unsigned)CA[_i]) * 2u; } } while (0)
    Unit cur, nxt; int ui = 0;
    if (!S.next(0, cur)) return;
    f32x4 acc[2][2][4][2];
#pragma unroll
    for (int a = 0; a < 2; ++a)
#pragma unroll
        for (int b = 0; b < 2; ++b)
#pragma unroll
            for (int m = 0; m < 4; ++m)
#pragma unroll
                for (int n = 0; n < 2; ++n) acc[a][b][m][n] = (f32x4){0.f, 0.f, 0.f, 0.f};
    f16x8 At[4][2], B0[2][2], B1[2][2];
    unsigned offC[2][2], offN[2][2];
    if constexpr (GATHER) { PG8_OFFS(offC, cur); }
    const char* cA = Ab + (size_t)cur.pm * tstepA;
    const char* cB = (const char*)g.Bt + (size_t)cur.pn * tstepB;
    PG8_STAGE(PG8_SB(0, 0), cB, voffB); PG8_STAGE(PG8_SB(0, 1), cB + hstepB, voffB); PG8_STA_CUR(PG8_SA(0, 0), 0, 0); PG8_STA_CUR(PG8_SA(0, 1), 1, 0);
    if (wr == 1) PG8_BAR;
    PG8_WAIT_V(2); PG8_BAR;
    PG8_STAGE(PG8_SB(1, 0), cB + kstep, voffB); PG8_STA_CUR(PG8_SA(1, 0), 0, kstep); PG8_STAGE(PG8_SB(1, 1), cB + hstepB + kstep, voffB);
    PG8_WAIT_V(6); PG8_BAR;
    for (;;) {
        const bool has_next = S.next(ui + 1, nxt);
        if constexpr (GATHER) {
            if (has_next) { PG8_OFFS(offN, nxt); } else {
#pragma unroll
                for (int _h = 0; _h < 2; ++_h)
#pragma unroll
                    for (int _i = 0; _i < 2; ++_i) offN[_h][_i] = offC[_h][_i]; } }
        const char* nA = has_next ? Ab + (size_t)nxt.pm * tstepA : cA;
        const char* nB = has_next ? (const char*)g.Bt + (size_t)nxt.pn * tstepB : cB;
#pragma nounroll
        for (int t = 0; t < nt; t += 2) {
            const bool last = (t == nt - 2);
            const size_t kb1 = (size_t)(t + 1) * kstep;
            const size_t kb2 = last ? 0 : (size_t)(t + 2) * kstep, kb3 = kb2 + kstep;
            unsigned o2[2][2];
            if constexpr (GATHER) {
#pragma unroll
                for (int _h = 0; _h < 2; ++_h)
#pragma unroll
                    for (int _i = 0; _i < 2; ++_i) o2[_h][_i] = last ? offN[_h][_i] : offC[_h][_i]; }
            const char* a2p = last ? nA : cA;
            const char* b2 = last ? nB : cB + (size_t)(t + 2) * kstep; const char* b3 = b2 + kstep;
            PG8_LDB(B0, 0, 0); PG8_LDB(B1, 0, 1); PG8_SCHED; PG8_LDA(At, 0, 0); PG8_STA_CUR(PG8_SA(1, 1), 1, kb1);
            PG8_WAIT_V(8); PG8_WAIT_L(0); PG8_BAR; PG8_MMA(0, 0, At, B0); PG8_MMA(0, 1, At, B1); PG8_BAR; PG8_SCHED;
            PG8_LDA(At, 0, 1); PG8_STAGE(PG8_SB(0, 0), b2, voffB); PG8_STAGE(PG8_SB(0, 1), b2 + hstepB, voffB); PG8_STA_SEL(PG8_SA(0, 0), 0, kb2);
            PG8_WAIT_V(8); PG8_WAIT_L(0); PG8_BAR; PG8_MMA(1, 0, At, B0); PG8_MMA(1, 1, At, B1); PG8_BAR; PG8_SCHED;
            PG8_LDB(B0, 1, 0); PG8_LDB(B1, 1, 1); PG8_SCHED; PG8_LDA(At, 1, 0); PG8_STA_SEL(PG8_SA(0, 1), 1, kb2);
            PG8_WAIT_V(8); PG8_WAIT_L(0); PG8_BAR; PG8_MMA(0, 0, At, B0); PG8_MMA(0, 1, At, B1); PG8_BAR; PG8_SCHED;
            PG8_LDA(At, 1, 1); PG8_STAGE(PG8_SB(1, 0), b3, voffB); PG8_STAGE(PG8_SB(1, 1), b3 + hstepB, voffB); PG8_STA_SEL(PG8_SA(1, 0), 0, kb3);
            PG8_WAIT_V(8); PG8_WAIT_L(0); PG8_BAR; PG8_MMA(1, 0, At, B0); PG8_MMA(1, 1, At, B1); PG8_BAR; PG8_SCHED;
        }
        if constexpr (ALIGN_EPI) { if (wr == 0) PG8_BAR; }
        E(acc, cur, wr, wc, fr, fq);
        if (!has_next) break;
#pragma unroll
        for (int a = 0; a < 2; ++a)
#pragma unroll
            for (int b = 0; b < 2; ++b)
#pragma unroll
                for (int m = 0; m < 4; ++m)
#pragma unroll
                    for (int n = 0; n < 2; ++n) acc[a][b][m][n] = (f32x4){0.f, 0.f, 0.f, 0.f};
        cur = nxt; cA = nA; cB = nB; ++ui;
        if constexpr (GATHER) {
#pragma unroll
            for (int _h = 0; _h < 2; ++_h)
#pragma unroll
                for (int _i = 0; _i < 2; ++_i) offC[_h][_i] = offN[_h][_i]; }
        if constexpr (ALIGN_EPI) { if (wr == 1) PG8_BAR; }
    }
    PG8_WAIT_V(0);
    if constexpr (!ALIGN_EPI) { if (wr == 0) PG8_BAR; }
    PG8_BAR;
#undef PG8_SA
#undef PG8_SB
#undef PG8_STAGE
#undef PG8_STA_CUR
#undef PG8_STA_SEL
#undef PG8_LDA
#undef PG8_LDB
#undef PG8_MMA
#undef PG8_WAIT_V
#undef PG8_WAIT_L
#undef PG8_BAR
#undef PG8_SCHED
#undef PG8_OFFS
}
}

#define XB_TMO      128
#define XB_XCNT(j)  (256  + 64 * (j))
#define XB_XSUB(j)  (1280 + 64 * (j))
#define XB_XGEN(j)  (2304 + 64 * (j))
#define XB_TOP      3328
#define XB_TOPGEN   3392
#define XCD_BAR_WORDS 3456
#define XB_SPIN_CAP (1u << 22)
__device__ __forceinline__ unsigned xb_ld(unsigned* p)              { return __hip_atomic_load(p, __ATOMIC_RELAXED, __HIP_MEMORY_SCOPE_AGENT); }
__device__ __forceinline__ unsigned xb_add(unsigned* p, unsigned v) { return __hip_atomic_fetch_add(p, v, __ATOMIC_RELAXED, __HIP_MEMORY_SCOPE_AGENT); }
__device__ __forceinline__ unsigned xb_xcc_id() { return (unsigned)__builtin_amdgcn_s_getreg((3 << 11) | 20) & 0xFu; }
#define XB_SPIN(cond, bar) do { unsigned _sp = 0; while (cond) { __builtin_amdgcn_s_sleep(1); \
    if ((++_sp & 255u) == 0u) { if (xb_ld(&(bar)[XB_TMO])) break; if (_sp > XB_SPIN_CAP) { atomicAdd(&(bar)[XB_TMO], 1u); break; } } } } while (0)
struct XcdBarrier { unsigned* bar; unsigned x; volatile LAS unsigned* st; };
__device__ __forceinline__ XcdBarrier xcd_barrier_post(unsigned* bar, volatile LAS unsigned* st) {
    XcdBarrier b; b.bar = bar; b.x = xb_xcc_id(); b.st = st;
    if (threadIdx.x == 0) (void)xb_add(&bar[XB_XCNT(b.x)], 1u);
    return b;
}
__device__ __forceinline__ void xcd_barrier_complete(unsigned* bar, unsigned x, unsigned& nloc, unsigned& nx) {
    const unsigned G = gridDim.x * gridDim.y * gridDim.z;
    unsigned sum, cnt, mine, sp = 0u;
    for (;;) {
        sum = 0u; cnt = 0u; mine = 0u;
#pragma unroll
        for (unsigned j = 0; j < 16; ++j) { const unsigned c = xb_ld(&bar[XB_XCNT(j)]); sum += c; cnt += (c > 0u) ? 1u : 0u; mine = (j == x) ? c : mine; }
        if (sum == G) break;
        __builtin_amdgcn_s_sleep(1);
        if ((++sp & 255u) == 0u) { if (xb_ld(&bar[XB_TMO])) break; if (sp > XB_SPIN_CAP) { atomicAdd(&bar[XB_TMO], 1u); break; } }
    }
    nloc = mine > 0u ? mine : 1u; nx = cnt > 0u ? cnt : 1u;
}
__device__ __forceinline__ void xcd_barrier(const XcdBarrier& b) {
    asm volatile("s_waitcnt vmcnt(0)" ::: "memory");
    __syncthreads();
    if (threadIdx.x == 0) {
        unsigned* bar = b.bar;
        __builtin_amdgcn_s_waitcnt(0);
        unsigned nloc = b.st[0], nx = b.st[1];
        if (nloc == 0u) { xcd_barrier_complete(bar, b.x, nloc, nx); b.st[0] = nloc; b.st[1] = nx; }
        const unsigned old = xb_add(&bar[XB_XSUB(b.x)], 1u);
        const unsigned gen = old / nloc;
        if (old + 1u == (gen + 1u) * nloc) {
            __builtin_amdgcn_fence(__ATOMIC_RELEASE, "agent");
            asm volatile("s_waitcnt vmcnt(0)" ::: "memory");
            const unsigned og = xb_add(&bar[XB_TOP], 1u);
            const unsigned tg = og / nx;
            if (og + 1u == (tg + 1u) * nx) xb_add(&bar[XB_TOPGEN], 1u);
            else XB_SPIN(xb_ld(&bar[XB_TOPGEN]) == tg, bar);
            __builtin_amdgcn_fence(__ATOMIC_ACQUIRE, "agent");
            xb_add(&bar[XB_XGEN(b.x)], 1u);
            asm volatile("s_waitcnt vmcnt(0)" ::: "memory");
        } else {
            XB_SPIN(xb_ld(&bar[XB_XGEN(b.x)]) == gen, bar);
            __builtin_amdgcn_fence(__ATOMIC_ACQUIRE, "agent");
            asm volatile("s_waitcnt vmcnt(0)" ::: "memory");
        }
    }
    __syncthreads();
}

struct Args { const float* in[38]; float* out; unsigned char* ws; int ph_lo, ph_hi; };
enum { I_X = 0, I_MEM, I_LN1, I_WIN, I_PK, I_W1K, I_W2K, I_PV, I_W1V, I_W2V, I_NSAG, I_MU, I_W0, I_WUP, I_A0, I_AUP, I_GUP, I_KK, I_KA, I_RK, I_LNXG, I_LNXB,
       I_WOUT, I_LNMEM, I_LN2, I_WQ, I_WK, I_WV, I_WO, I_LN3, I_RGW, I_RGB, I_REW, I_REB, I_MG, I_MU2, I_MD, I_LNF };

__device__ __forceinline__ void tr_item(const float* src, int sld, int k0, int scol0, int nvalid, f16* dst, size_t drow0, int dld, LAS float* scr, int lane) {
    const int nl = lane & 31;
    float tv[32];
#pragma unroll
    for (int i = 0; i < 32; ++i) { const int kk = 2 * i + (lane >> 5); tv[i] = (nl < nvalid) ? src[(size_t)(k0 + kk) * sld + scol0 + nl] : 0.f; }
#pragma unroll
    for (int i = 0; i < 32; ++i) { const int kk = 2 * i + (lane >> 5); scr[kk * 33 + nl] = tv[i]; }
    LDS_WAIT(); asm volatile("" ::: "memory");
    const int c = lane & 7;
#pragma unroll
    for (int j = 0; j < 4; ++j) { const int n = (lane >> 3) + 8 * j; const LAS float* s = scr + (8 * c) * 33 + n;
        u32x4 o; o.x = pkh(s[0 * 33], s[1 * 33]); o.y = pkh(s[2 * 33], s[3 * 33]); o.z = pkh(s[4 * 33], s[5 * 33]); o.w = pkh(s[6 * 33], s[7 * 33]);
        *(u32x4*)(dst + (drow0 + n) * (size_t)dld + k0 + 8 * c) = o; }
    LDS_WAIT(); asm volatile("" ::: "memory");
}
__device__ __forceinline__ void tr_matrix(const float* src, int K, int N, f16* dst, LAS float* scr, int gw, int NGW, int lane) {
    const int nblk = N / 32, items = (K / 64) * nblk;
    for (int it = gw; it < items; it += NGW) { const int kb = it / nblk, nb = it % nblk; tr_item(src, N, kb * 64, nb * 32, 32, dst, (size_t)nb * 32, K, scr, lane); }
}
__device__ __forceinline__ void rms_row(const float* xrow, const float* gain, f16* o16, int lane) {
    const f32x4* xr = (const f32x4*)xrow + lane; f32x4 v[8]; float s = 0.f;
#pragma unroll
    for (int j = 0; j < 8; ++j) { v[j] = xr[64 * j]; s += v[j].x * v[j].x + v[j].y * v[j].y + v[j].z * v[j].z + v[j].w * v[j].w; }
    const f32x4* gr = (const f32x4*)gain + lane; f32x4 gg[8];
#pragma unroll
    for (int j = 0; j < 8; ++j) gg[j] = gr[64 * j];
    const float rstd = rsqrtf(wave_sum(s) * (1.f / D) + EPS);
    u32x2* o8 = (u32x2*)o16 + lane;
#pragma unroll
    for (int j = 0; j < 8; ++j) { u32x2 w; w.x = pkh(v[j].x * rstd * gg[j].x, v[j].y * rstd * gg[j].y); w.y = pkh(v[j].z * rstd * gg[j].z, v[j].w * rstd * gg[j].w); o8[64 * j] = w; }
}

__device__ __forceinline__ void p0_prologue(const Args& a, LAS unsigned char* lds) {
    const int tid = opaque_tid(), lane = tid & 63, wave = tid >> 6;
    const int gw = blockIdx.x * 8 + wave, NGW = gridDim.x * 8;
    LAS float* scr = (LAS float*)(lds + wave * 16384);
    unsigned char* ws = a.ws;
    { f16* dst = (f16*)(ws + WS_WIN); const float* src = a.in[I_WIN];
      const int nblk = NZ / 32, items = (D / 64) * nblk;
      for (int it = gw; it < items; it += NGW) { const int kb = it / nblk, nb = it % nblk, n0 = nb * 32;
          int sc = 0, nv = 32; if (n0 < 2560) sc = n0; else if (n0 < 5920) sc = n0 + 24; else if (n0 == 5920) { sc = 2560; nv = 24; } else { sc = 0; nv = 0; }
          tr_item(src, 5944, kb * 64, sc, nv, dst, (size_t)n0, D, scr, lane); } }
    tr_matrix(a.in[I_WOUT], D, D, (f16*)(ws + WS_WOUT), scr, gw, NGW, lane);
    tr_matrix(a.in[I_WK], D, D, (f16*)(ws + WS_WKT), scr, gw, NGW, lane);
    tr_matrix(a.in[I_WV], D, D, (f16*)(ws + WS_WVT), scr, gw, NGW, lane);
    tr_matrix(a.in[I_WO], D, D, (f16*)(ws + WS_WOT), scr, gw, NGW, lane);
    { const f32x4* s = (const f32x4*)a.in[I_WQ]; u32x2* d = (u32x2*)(ws + WS_WQ16);
      for (size_t i = (size_t)blockIdx.x * 512 + tid; i < (size_t)D * D / 4; i += (size_t)gridDim.x * 512) { const f32x4 v = s[i]; const float gsc = a.in[I_LN2][i / (D / 4)]; u32x2 w; w.x = pkh(v.x * gsc, v.y * gsc); w.y = pkh(v.z * gsc, v.w * gsc); d[i] = w; } }
    tr_matrix(a.in[I_W1K], 4096, 128, (f16*)(ws + WS_W1T), scr, gw, NGW, lane);
    tr_matrix(a.in[I_W1V], 4096, 128, (f16*)(ws + WS_W1T) + 128 * 4096, scr, gw, NGW, lane);
    tr_matrix(a.in[I_W2K], 128, 128, (f16*)(ws + WS_W2T), scr, gw, NGW, lane);
    tr_matrix(a.in[I_W2V], 128, 128, (f16*)(ws + WS_W2T) + 128 * 128, scr, gw, NGW, lane);
    for (int o = gw; o < 256; o += NGW) { const int kv = o >> 7, n = o & 127; const float* pos = a.in[kv ? I_PV : I_PK]; const float* w1 = a.in[kv ? I_W1V : I_W1K]; float acc = 0.f;
        for (int k = lane; k < 4096; k += 64) acc += pos[k] * w1[(size_t)k * 128 + n];
        acc = wave_sum(acc); if (lane == 0) ((float*)(ws + WS_CBIAS))[o] = acc; }
    for (int i = blockIdx.x * 512 + tid; i < 48 * D; i += gridDim.x * 512) { const int c = i / D, k = i % D; float v = 0.f;
        if (c < 4) v = a.in[I_RGW][k * 4 + c]; else if (c < 36) v = a.in[I_REW][k * 32 + (c - 4)];
        v *= a.in[I_LN3][k]; const f16 hi = (f16)v; ((f16*)(ws + WS_WRH))[i] = hi; ((f16*)(ws + WS_WRL))[i] = (f16)(v - (float)hi); }
    { bf16* wu = (bf16*)(ws + WS_WUPT); bf16* au = (bf16*)(ws + WS_AUPT); bf16* gu = (bf16*)(ws + WS_GUPT);
      for (int i = blockIdx.x * 512 + tid; i < 1024 * 64; i += gridDim.x * 512) { const int ch = i >> 6, j = i & 63; wu[i] = (bf16)a.in[I_WUP][j * 1024 + ch]; au[i] = (bf16)a.in[I_AUP][j * 1024 + ch]; }
      for (int i = blockIdx.x * 512 + tid; i < 1024 * 160; i += gridDim.x * 512) { const int ch = i / 160, j = i % 160; gu[i] = (bf16)a.in[I_GUP][j * 1024 + ch]; } }
    for (int m = gw; m < T; m += NGW) rms_row(a.in[I_X] + (size_t)m * D, a.in[I_LN1], (f16*)(ws + WS_H) + (size_t)m * D, lane);
    for (int m = gw; m < 256; m += NGW) rms_row(a.in[I_MEM] + (size_t)m * D, a.in[I_LNMEM], (f16*)(ws + WS_MEMN) + (size_t)m * D, lane);
}

__device__ __forceinline__ void p_moe_weights(const Args& a, LAS unsigned char* lds) {
    const int tid = opaque_tid(), lane = tid & 63, wave = tid >> 6;
    const int gw = blockIdx.x * 8 + wave, NGW = gridDim.x * 8;
    LAS float* scr = (LAS float*)(lds + wave * 16384);
    unsigned char* ws = a.ws;
    { f16* dst = (f16*)(ws + WS_WGU); const int items = NEXP * (D / 64) * 16;
      for (int it = gw; it < items; it += NGW) { const int e = it / ((D / 64) * 16), r = it % ((D / 64) * 16), kb = r / 16, nb = r % 16, j0 = nb * 32, jt = j0 / 256, jj = j0 % 256;
          const float* src = (jj < 128 ? a.in[I_MG] : a.in[I_MU2]) + (size_t)e * D * EFF; const int sc = jt * 128 + (jj & 127);
          tr_item(src, EFF, kb * 64, sc, 32, dst, (size_t)e * 512 + j0, D, scr, lane); } }
    { f16* dst = (f16*)(ws + WS_WD); const int items = NEXP * (EFF / 64) * (D / 32);
      for (int it = gw; it < items; it += NGW) { const int e = it / ((EFF / 64) * (D / 32)), r = it % ((EFF / 64) * (D / 32)), kb = r / (D / 32), nb = r % (D / 32);
          tr_item(a.in[I_MD] + (size_t)e * EFF * D, D, kb * 64, nb * 32, 32, dst, (size_t)e * D + nb * 32, EFF, scr, lane); } }
}

__device__ __forceinline__ float gelu_tanh(float x) { const float u = 0.7978845608028654f * (x + 0.044715f * x * x * x); const float e = __expf(2.f * u); return 0.5f * x * (2.f - 2.f / (e + 1.f)); }
constexpr int CP_RS = 272, CP_HS = 136, CP_HID = 272 * CP_RS;
__device__ __forceinline__ void p_compress(const Args& a, LAS unsigned char* lds) {
    const int tid = opaque_tid(), lane = tid & 63, w = __builtin_amdgcn_readfirstlane(tid >> 6);
    const f16* z = (const f16*)(a.ws + WS_Z);
    LAS f16* HID = (LAS f16*)(lds + CP_HID);
    for (int it = blockIdx.x; it < 256; it += gridDim.x) {
        const int kv = it >> 7, g = (it >> 6) & 1, c0 = (it & 63) * 16, tok0 = 16 * c0;
        const int zc = (kv ? ZVC : ZKC) + g * 128;
        __syncthreads();
        for (int ck = tid; ck < 272 * 16; ck += 512) { const int tl = ck >> 4, c16 = ck & 15, tok = tok0 + tl; const int rp = (tl & 15) * 17 + (tl >> 4);
            u32x4 v = {0u, 0u, 0u, 0u}; if (tok < T) v = *(const u32x4*)(z + (size_t)tok * NZ + zc + c16 * 8);
            *(LAS u32x4*)(lds + rp * CP_RS + c16 * 16) = v; }
        __syncthreads();
        f32x4 acc = {0.f, 0.f, 0.f, 0.f};
        const f16* wp = (const f16*)(a.ws + WS_W1T) + ((size_t)kv * 128 + 16 * w + (lane & 15)) * 4096 + 8 * (lane >> 4);
        const LAS unsigned char* ap = lds + (lane & 15) * CP_RS + 16 * (lane >> 4);
#pragma unroll 8
        for (int ks = 0; ks < 128; ++ks) { const int l = ks >> 2;
            const f16x8 av = *(const LAS f16x8*)(ap + ((l & 15) * 17 + (l >> 4)) * CP_RS + (ks & 3) * 64);
            const f16x8 bv = *(const f16x8*)(wp + 32 * ks);
            acc = __builtin_amdgcn_mfma_f32_16x16x32_f16(av, bv, acc, 0, 0, 0); }
        { const int n = 16 * w + (lane & 15); const float bs = ((const float*)(a.ws + WS_CBIAS))[kv * 128 + n];
#pragma unroll
          for (int r = 0; r < 4; ++r) HID[(4 * (lane >> 4) + r) * CP_HS + n] = (f16)gelu_tanh(acc[r] + bs); }
        __syncthreads();
        f32x4 o = {0.f, 0.f, 0.f, 0.f};
        const f16* w2p = (const f16*)(a.ws + WS_W2T) + ((size_t)kv * 128 + 16 * w + (lane & 15)) * 128 + 8 * (lane >> 4);
#pragma unroll
        for (int ks = 0; ks < 4; ++ks) { const f16x8 av = *(const LAS f16x8*)(HID + (lane & 15) * CP_HS + 32 * ks + 8 * (lane >> 4)); const f16x8 bv = *(const f16x8*)(w2p + 32 * ks);
            o = __builtin_amdgcn_mfma_f32_16x16x32_f16(av, bv, o, 0, 0, 0); }
        f16* dst = (f16*)(a.ws + (kv ? WS_VCMP : WS_KCMP));
#pragma unroll
        for (int r = 0; r < 4; ++r) { const int c = c0 + 4 * (lane >> 4) + r; dst[((size_t)c * 2 + g) * 128 + 16 * w + (lane & 15)] = c < NCMP ? (f16)o[r] : (f16)0.f; }
    }
}

typedef float f32x16 __attribute__((ext_vector_type(16)));
typedef short v4i16_t __attribute__((ext_vector_type(4)));
constexpr int NS_PSEL = 65536, NS_PSTR = 257, NS_SELB = NS_PSEL + 64 * NS_PSTR * 4, NS_WANY = NS_SELB + 2048, NS_LIST = NS_WANY + 256, NS_CNT = NS_LIST + 512, NS_UNIT = NS_CNT + 64;
static_assert(NS_UNIT + 64 <= MISC_OFF, "nsa lds");
__device__ __forceinline__ unsigned offb(unsigned row, unsigned ch) { return 256u * row + 16u * (ch ^ (((row & 3u) << 2) | ((row >> 2) & 3u))); }
__device__ __forceinline__ void glds16(const void* gsrc, unsigned lds_dst) { unsigned keep;
    asm volatile("s_mov_b32 %0, m0\n\ts_mov_b32 m0, %2\n\ts_nop 0\n\tglobal_load_lds_dwordx4 %1, off\n\ts_mov_b32 m0, %0" : "=&s"(keep) : "v"(gsrc), "s"(lds_dst) : "memory"); }
__device__ __forceinline__ void ns_dma(const f16* g0, const unsigned (&doff)[2], unsigned lds_addr, int wv) {
#pragma unroll
    for (int i = 0; i < 2; ++i) glds16(g0 + doff[i], lds_addr + (wv * 2 + i) * 1024);
}
#define NS_VMW(n) asm volatile("s_waitcnt vmcnt(" #n ")" ::: "memory")
__device__ __forceinline__ void ns_qk(f32x16& s0, f32x16& s1, const LAS unsigned char* kb, const f16x8 (&qf)[8], int rho_, int hh_, float init) {
    unsigned rho = (unsigned)rho_, hh = (unsigned)hh_;
    asm volatile("" : "+v"(rho), "+v"(hh));
    const unsigned xr = ((rho & 3u) << 2) | ((rho >> 2) & 3u);
    const LAS unsigned char* kbase = kb + 256u * rho + 16u * ((hh ^ xr) & 1u); const unsigned xs = xr >> 1;
#pragma unroll
    for (int i = 0; i < 16; ++i) { s0[i] = init; s1[i] = init; }
    f16x8 af[8];
#pragma unroll
    for (int s = 0; s < 8; ++s) af[s] = *(const LAS f16x8*)(kbase + 32u * ((unsigned)s ^ xs));
#pragma unroll
    for (int s = 0; s < 8; ++s) s0 = __builtin_amdgcn_mfma_f32_32x32x16_f16(af[s], qf[s], s0, 0, 0, 0);
#pragma unroll
    for (int s = 0; s < 8; ++s) af[s] = *(const LAS f16x8*)(kbase + 32u * ((unsigned)s ^ xs) + 8192);
#pragma unroll
    for (int s = 0; s < 8; ++s) s1 = __builtin_amdgcn_mfma_f32_32x32x16_f16(af[s], qf[s], s1, 0, 0, 0);
}
__device__ __forceinline__ void ns_pv(f32x16 (&O)[4], const LAS unsigned char* vb, const f32x16& p0, const f32x16& p1, int lane_) {
    unsigned lane = (unsigned)lane_;
    asm volatile("" : "+v"(lane));
    const unsigned hh = lane >> 5, blk = (lane >> 4) & 1, q = (lane & 15) >> 2, pp = lane & 3;
    const unsigned x = 2 * blk + (pp >> 1);
    const LAS unsigned char* vbase[2];
#pragma unroll
    for (int t = 0; t < 2; ++t) { const unsigned w = (hh + 2 * t) & 3u; vbase[t] = vb + 256u * (4 * hh + 8 * t + q) + 16u * (x ^ w) + 8u * (pp & 1); }
    f16x8 pf[4];
#pragma unroll
    for (int kh = 0; kh < 2; ++kh)
#pragma unroll
        for (int sp = 0; sp < 2; ++sp)
#pragma unroll
            for (int j = 0; j < 8; ++j) pf[kh * 2 + sp][j] = (f16)(kh ? p1[8 * sp + j] : p0[8 * sp + j]);
#pragma unroll
    for (int c = 0; c < 4; ++c) { const unsigned cq = 64u * ((unsigned)c ^ q);
        const LAS unsigned char* b0 = vbase[0] + cq; const LAS unsigned char* b1 = vbase[1] + cq;
#pragma unroll
        for (int kh = 0; kh < 2; ++kh)
#pragma unroll
            for (int sp = 0; sp < 2; ++sp) {
                const v4i16_t lo = __builtin_amdgcn_ds_read_tr16_b64_v4i16((LAS v4i16_t*)(b0 + 256 * (32 * kh + 16 * sp)));
                const v4i16_t hi = __builtin_amdgcn_ds_read_tr16_b64_v4i16((LAS v4i16_t*)(b1 + 256 * (32 * kh + 16 * sp)));
                typedef short s16x8 __attribute__((ext_vector_type(8)));
                const s16x8 v8 = {lo[0], lo[1], lo[2], lo[3], hi[0], hi[1], hi[2], hi[3]};
                O[c] = __builtin_amdgcn_mfma_f32_32x32x16_f16(__builtin_bit_cast(f16x8, v8), pf[kh * 2 + sp], O[c], 0, 0, 0); }
    }
}
#define NS_KIDX(r, hh) ((int)(((r) & 3) + 8 * ((r) >> 2) + 4 * (hh)))
constexpr float NS_THR = 6.f;
template <bool WITH_O> __device__ __forceinline__ void ns_online(f32x16& y0, f32x16& y1, float& m, float& l, bool& seen, f32x16 (&O)[4]) {
    float mx = fmaxf(y0[0], y1[0]);
#pragma unroll
    for (int i = 1; i < 16; ++i) mx = fmaxf(mx, fmaxf(y0[i], y1[i]));
    mx = fmaxf(mx, __shfl_xor(mx, 32));
    const bool fin = mx > -INFINITY, first = !seen && fin;
    if (__any(first || mx > NS_THR)) {
        const float d = first ? mx : (mx > NS_THR ? mx : 0.f), alpha = __builtin_amdgcn_exp2f(-d);
        seen = seen || fin; m += d; l *= alpha;
        if (WITH_O) {
#pragma unroll
            for (int c = 0; c < 4; ++c) O[c] = O[c] * alpha; }
#pragma unroll
        for (int i = 0; i < 16; ++i) { y0[i] -= d; y1[i] -= d; }
    }
    float ls = 0.f;
#pragma unroll
    for (int i = 0; i < 16; ++i) { y0[i] = __builtin_amdgcn_exp2f(y0[i]); y1[i] = __builtin_amdgcn_exp2f(y1[i]); ls += y0[i] + y1[i]; }
    l += ls;
}
#define NS_ISSUE(j, NSL, HASV) do { const unsigned sa_ = lds_a + (unsigned)(((j) & ((NSL) - 1)) * 32768); ns_dma(NS_KPTR(j), NS_DOFF, sa_, w); if (HASV) ns_dma(NS_VPTR(j), NS_DOFF, sa_ + 16384u, w); } while (0)
#define NS_WAIT(nb, HASV) do { if (HASV) { if ((nb) >= 2) NS_VMW(8); else if ((nb) == 1) NS_VMW(4); else NS_VMW(0); } else { if ((nb) >= 2) NS_VMW(4); else if ((nb) == 1) NS_VMW(2); else NS_VMW(0); } } while (0)
#define NS_PROLOGUE(n, NSL, HASV) do { const int q_ = (n) < (NSL) - 1 ? (n) : (NSL) - 1; for (int j_ = 0; j_ < q_; ++j_) NS_ISSUE(j_, NSL, HASV); NS_WAIT(q_ - 1, HASV); __syncthreads(); } while (0)
#define NS_STEP_BEGIN(i, n, NSL, HASV) do { if ((i) + (NSL) - 1 < (n)) NS_ISSUE((i) + (NSL) - 1, NSL, HASV); } while (0)
#define NS_STEP_END(i, n, NSL, HASV) do { int nb_ = ((n) - 1 < (i) + (NSL) - 1 ? (n) - 1 : (i) + (NSL) - 1) - ((i) + 1); NS_WAIT(nb_, HASV); __syncthreads(); } while (0)
#define NS_KB(i, NSL) (lds + (((i) & ((NSL) - 1)) * 32768))
#define NS_VB(i, NSL) (lds + (((i) & ((NSL) - 1)) * 32768) + 16384)
__device__ __forceinline__ void p_nsa(const Args& a, LAS unsigned char* lds, int rep) {
    const int tid = opaque_tid(), lane = tid & 63, w = __builtin_amdgcn_readfirstlane(tid >> 6), rho = lane & 31, hh = lane >> 5, ql = rho >> 2, p = rho & 3;
    const unsigned lds_a = (unsigned)__builtin_amdgcn_readfirstlane((int)(unsigned)(size_t)lds);
    const f16* z = (const f16*)(a.ws + WS_Z); const f16* kcmp = (const f16*)(a.ws + WS_KCMP); const f16* vcmp = (const f16*)(a.ws + WS_VCMP);
    float* onsa = (float*)(a.ws + WS_ONSA); unsigned* ctl = (unsigned*)(a.ws + WS_CTL);
    LAS float* psel = (LAS float*)(lds + NS_PSEL); LAS unsigned* selb = (LAS unsigned*)(lds + NS_SELB); LAS unsigned* wany = (LAS unsigned*)(lds + NS_WANY);
    LAS unsigned char* list = lds + NS_LIST; LAS int* cnt = (LAS int*)(lds + NS_CNT); LAS int* unit_s = (LAS int*)(lds + NS_UNIT);
    const float c2 = 0.08838834764831845f * 1.4426950408889634f;
    unsigned doff_c[2], doff_z[2];
#pragma unroll
    for (int i = 0; i < 2; ++i) { const int piece = w * 2 + i, row = 4 * piece + (lane >> 4), ch = (lane & 15) ^ (((row & 3) << 2) | ((row >> 2) & 3)); doff_c[i] = (unsigned)(row * 256 + ch * 8); doff_z[i] = (unsigned)(row * NZ + ch * 8); }
    for (;;) {
        __syncthreads();
        if (tid == 0) unit_s[0] = (int)atomicAdd(&ctl[CW_Q + rep], 1u);
        __syncthreads();
        const int u = unit_s[0]; if (u >= 512) break;
        const int blk = 255 - (u >> 1), g = u & 1, t0 = blk * 64, tq = t0 + 8 * w + ql, hq = g * 4 + p;
        f16x8 qf[8];
        { const f16* qrow = z + (size_t)tq * NZ + ZQ + hq * 128 + 8 * hh;
#pragma unroll
          for (int s = 0; s < 8; ++s) { const f16x8 q8 = *(const f16x8*)(qrow + 16 * s);
#pragma unroll
              for (int j = 0; j < 8; ++j) qf[s][j] = (f16)((float)q8[j] * c2); } }
        const f16* zrow = z + (size_t)tq * NZ;
        const float gate_c = sigmoidf_((float)zrow[ZGL + hq]), gate_s = sigmoidf_((float)zrow[ZGL + 8 + hq]), gate_w = sigmoidf_((float)zrow[ZGL + 16 + hq]);
        f32x16 O[4];
        float* orow = onsa + (size_t)tq * 1024 + hq * 128 + 4 * hh;
#pragma unroll
        for (int c = 0; c < 4; ++c)
#pragma unroll
            for (int i = 0; i < 16; ++i) O[c][i] = 0.f;
        const int cmax = tq >= 31 ? (tq - 31) >> 4 : -1;
        const int ntc = (4 * blk + 3 + 63) >> 6;
        float m = 0.f, l = 0.f; bool seen = false;
        const int cmin_w = (t0 + 8 * w) >= 31 ? (t0 + 8 * w - 31) >> 4 : -1;
#define NS_KPTR(j) (kcmp + ((size_t)(64 * (j)) * 2 + g) * 128)
#define NS_VPTR(j) (vcmp + ((size_t)(64 * (j)) * 2 + g) * 128)
#define NS_DOFF doff_c
        { const int npc = (ntc + 1) >> 1;
#define NS_ISSUE_KPAIR(ip) do { const unsigned sa_ = lds_a + (unsigned)(((ip) & 1) * 65536); const int j0_ = 2 * (ip); ns_dma(NS_KPTR(j0_), NS_DOFF, sa_, w); if (j0_ + 1 < ntc) ns_dma(NS_KPTR(j0_ + 1), NS_DOFF, sa_ + 32768u, w); } while (0)
          NS_ISSUE_KPAIR(0); NS_VMW(0); __syncthreads();
          for (int ip = 0; ip < npc; ++ip) {
              if (ip + 1 < npc) NS_ISSUE_KPAIR(ip + 1);
#pragma unroll
              for (int hb = 0; hb < 2; ++hb) { const int i = 2 * ip + hb;
                  if (i < ntc) {
                      f32x16 x0, x1; ns_qk(x0, x1, lds + (ip & 1) * 65536 + hb * 32768, qf, rho, hh, -m);
                      if (64 * i + 63 > cmin_w) {
#pragma unroll
                          for (int r = 0; r < 16; ++r) { const int c0 = 64 * i + NS_KIDX(r, hh); x0[r] = (c0 <= cmax) ? x0[r] : -INFINITY; x1[r] = (c0 + 32 <= cmax) ? x1[r] : -INFINITY; } }
                      ns_online<false>(x0, x1, m, l, seen, O); } }
              NS_VMW(0); __syncthreads();
          } }
        l += __shfl_xor(l, 32);
        const float invl = 1.f / fmaxf(l, 1e-30f);
        for (int i = lane; i < 8 * NS_PSTR; i += 64) psel[(8 * w) * NS_PSTR + i] = 0.f;
        NS_PROLOGUE(ntc, 2, true);
        for (int i = 0; i < ntc; ++i) {
            NS_STEP_BEGIN(i, ntc, 2, true);
            f32x16 x0, x1; ns_qk(x0, x1, NS_KB(i, 2), qf, rho, hh, -m);
#pragma unroll
            for (int r = 0; r < 16; ++r) { x0[r] = __builtin_amdgcn_exp2f(x0[r]) * invl; x1[r] = __builtin_amdgcn_exp2f(x1[r]) * invl; }
            if (64 * i + 63 > cmin_w) {
#pragma unroll
                for (int r = 0; r < 16; ++r) { const int c0 = 64 * i + NS_KIDX(r, hh); x0[r] = (c0 <= cmax) ? x0[r] : 0.f; x1[r] = (c0 + 32 <= cmax) ? x1[r] : 0.f; } }
#pragma unroll
            for (int kh = 0; kh < 2; ++kh)
#pragma unroll
                for (int r4 = 0; r4 < 4; ++r4) {
                    const float pa = kh ? x1[4 * r4] : x0[4 * r4], pb = kh ? x1[4 * r4 + 1] : x0[4 * r4 + 1], pc_ = kh ? x1[4 * r4 + 2] : x0[4 * r4 + 2], pd = kh ? x1[4 * r4 + 3] : x0[4 * r4 + 3];
                    float mainv = pa + pb + pc_ + 0.5f * pd, carry = 0.5f * pd;
                    mainv += __shfl_xor(mainv, 1); mainv += __shfl_xor(mainv, 2); carry += __shfl_xor(carry, 1); carry += __shfl_xor(carry, 2);
                    if (p == 0) { const int sb = 16 * i + 8 * kh + 2 * r4 + hh; float* pr = (float*)(psel + (8 * w + ql) * NS_PSTR + sb); __hip_atomic_fetch_add(pr, mainv, __ATOMIC_RELAXED, __HIP_MEMORY_SCOPE_WORKGROUP); __hip_atomic_fetch_add(pr + 1, carry, __ATOMIC_RELAXED, __HIP_MEMORY_SCOPE_WORKGROUP); }
                }
            ns_pv(O, NS_VB(i, 2), x0, x1, lane);
            NS_STEP_END(i, ntc, 2, true);
        }
#undef NS_KPTR
#undef NS_VPTR
#undef NS_DOFF
#pragma unroll
        for (int c = 0; c < 4; ++c) {
#pragma unroll
            for (int r4 = 0; r4 < 4; ++r4) *(f32x4*)(orow + 32 * c + 8 * r4) = (f32x4){O[c][4 * r4] * gate_c, O[c][4 * r4 + 1] * gate_c, O[c][4 * r4 + 2] * gate_c, O[c][4 * r4 + 3] * gate_c};
#pragma unroll
            for (int i = 0; i < 16; ++i) O[c][i] = 0.f; }
        {
            unsigned anyw = 0u;
            for (int qq = 0; qq < 8; ++qq) {
                const LAS float* pr = psel + (8 * w + qq) * NS_PSTR;
                unsigned myw = 0u;
                if (lane == 0) myw |= 1u;
                if (lane == (blk >> 5)) myw |= 1u << (blk & 31);
                if (blk >= 1 && lane == ((blk - 1) >> 5)) myw |= 1u << ((blk - 1) & 31);
                const int ncand = blk >= 3 ? blk - 2 : 0;
                if (ncand <= 13) { if (ncand > 0 && lane == 0) myw |= ((2u << (blk - 2)) - 1u) & ~1u; }
                else {
                    unsigned key[4];
#pragma unroll
                    for (int jj = 0; jj < 4; ++jj) { const int s = 1 + lane + 64 * jj; key[jj] = (s <= blk - 2) ? __float_as_uint(fmaxf(pr[s], 0.f)) + 1u : 0u; }
                    unsigned thr = 0u;
                    for (int bit = 31; bit >= 0; --bit) { const unsigned cand = thr | (1u << bit); int cn = 0;
#pragma unroll
                        for (int jj = 0; jj < 4; ++jj) cn += __popcll(__ballot(key[jj] >= cand));
                        if (cn >= 13) thr = cand; }
                    int cgt = 0;
#pragma unroll
                    for (int jj = 0; jj < 4; ++jj) cgt += __popcll(__ballot(key[jj] > thr));
                    int remaining = 13 - cgt;
                    unsigned long long M[4];
#pragma unroll
                    for (int jj = 0; jj < 4; ++jj) { const bool eq = key[jj] == thr; const unsigned long long em = __ballot(eq); const int c = __popcll(em);
                        const bool take_eq = eq && (__popcll(em & ((1ull << lane) - 1ull)) < remaining);
                        remaining = remaining > c ? remaining - c : 0;
                        M[jj] = __ballot(key[jj] > thr || take_eq); }
#pragma unroll
                    for (int j = 0; j < 8; ++j) { const int k = j >> 1; const unsigned long long sh = (M[k] << 1) | (k > 0 ? (M[k - 1] >> 63) : 0ull);
                        const unsigned wj = (unsigned)(sh >> (32 * (j & 1))); if (lane == j) myw |= wj; }
                }
                if (lane < 8) selb[(8 * w + qq) * 8 + lane] = myw;
                anyw |= myw;
            }
            if (lane < 8) wany[w * 8 + lane] = anyw;
        }
        __syncthreads();
        unsigned sw8[8], aw8[8], un8[8];
#pragma unroll
        for (int j = 0; j < 8; ++j) { sw8[j] = selb[(8 * w + ql) * 8 + j]; aw8[j] = (unsigned)__builtin_amdgcn_readfirstlane((int)wany[w * 8 + j]); unsigned un = 0u;
#pragma unroll
            for (int ww = 0; ww < 8; ++ww) un |= wany[ww * 8 + j];
            un8[j] = (unsigned)__builtin_amdgcn_readfirstlane((int)un); }
        const int nlist = blk + 1;
        for (int rp_ = 0; rp_ < NSA_SELREP; ++rp_) {
        if (rp_) { asm volatile("" :: "v"(O[0][0]), "v"(O[1][0]), "v"(O[2][0]), "v"(O[3][0]), "v"(l));
#pragma unroll
            for (int c = 0; c < 4; ++c)
#pragma unroll
                for (int i = 0; i < 16; ++i) O[c][i] = 0.f; }
        m = 0.f; l = 0.f; seen = false;
#define NS_KPTR(j) (z + (size_t)((j) * 64) * NZ + ZKS + g * 128)
#define NS_VPTR(j) (z + (size_t)((j) * 64) * NZ + ZVS + g * 128)
#define NS_DOFF doff_z
        const int npair = (nlist + 1) >> 1;
#define NS_ISSUE_PAIR(ip) do { const unsigned sa_ = lds_a + (unsigned)(((ip) & 1) * 65536); const int j0_ = 2 * (ip); \
            ns_dma(NS_KPTR(j0_), NS_DOFF, sa_, w); ns_dma(NS_VPTR(j0_), NS_DOFF, sa_ + 16384u, w); \
            if (j0_ + 1 < nlist) { ns_dma(NS_KPTR(j0_ + 1), NS_DOFF, sa_ + 32768u, w); ns_dma(NS_VPTR(j0_ + 1), NS_DOFF, sa_ + 49152u, w); } } while (0)
        NS_ISSUE_PAIR(0); NS_VMW(0); __syncthreads();
        unsigned cw_s = 0u, cw_a = 0u;
        for (int ip = 0; ip < npair; ++ip) {
            if (ip + 1 < npair) NS_ISSUE_PAIR(ip + 1);
#pragma unroll
            for (int hb = 0; hb < 2; ++hb) {
                const int sb = 2 * ip + hb, bit = sb & 31;
                if (sb < nlist) {
                    if (bit == 0) { const int wi = sb >> 5; cw_s = sw8[0]; cw_a = aw8[0];
#pragma unroll
                        for (int j = 1; j < 8; ++j) { if (wi == j) { cw_s = sw8[j]; cw_a = aw8[j]; } } }
                    if ((cw_a >> bit) & 1u) {
                        const bool rsel = (cw_s >> bit) & 1u;
                        const LAS unsigned char* kb = lds + (ip & 1) * 65536 + hb * 32768;
                        f32x16 x0, x1; ns_qk(x0, x1, kb, qf, rho, hh, rsel ? -m : -INFINITY);
                        if (sb == blk) { const int kp0 = sb * 64;
#pragma unroll
                            for (int r = 0; r < 16; ++r) { const int kp = kp0 + NS_KIDX(r, hh); x0[r] = (kp <= tq) ? x0[r] : -INFINITY; x1[r] = (kp + 32 <= tq) ? x1[r] : -INFINITY; } }
                        ns_online<true>(x0, x1, m, l, seen, O);
                        ns_pv(O, kb + 16384, x0, x1, lane);
                    }
                }
            }
            NS_VMW(0); __syncthreads();
        }
        }
#undef NS_KPTR
#undef NS_VPTR
        l += __shfl_xor(l, 32);
        { const float sc = gate_s / fmaxf(l, 1e-30f); f32x4 ev[4][4];
#pragma unroll
          for (int c = 0; c < 4; ++c)
#pragma unroll
              for (int r4 = 0; r4 < 4; ++r4) ev[c][r4] = *(const f32x4*)(orow + 32 * c + 8 * r4);
#pragma unroll
          for (int c = 0; c < 4; ++c) {
#pragma unroll
              for (int r4 = 0; r4 < 4; ++r4) { const f32x4 e = ev[c][r4]; *(f32x4*)(orow + 32 * c + 8 * r4) = (f32x4){e.x + O[c][4 * r4] * sc, e.y + O[c][4 * r4 + 1] * sc, e.z + O[c][4 * r4 + 2] * sc, e.w + O[c][4 * r4 + 3] * sc}; }
#pragma unroll
              for (int i = 0; i < 16; ++i) O[c][i] = 0.f; } }
        const int wb0 = blk >= 8 ? blk - 8 : 0, nwt = blk - wb0 + 1;
        for (int rp_ = 0; rp_ < NSA_WINREP; ++rp_) {
        if (rp_) { asm volatile("" :: "v"(O[0][0]), "v"(O[1][0]), "v"(O[2][0]), "v"(O[3][0]), "v"(l));
#pragma unroll
            for (int c = 0; c < 4; ++c)
#pragma unroll
                for (int i = 0; i < 16; ++i) O[c][i] = 0.f; }
        m = 0.f; l = 0.f; seen = false;
#define NS_KPTR(j) (z + (size_t)((wb0 + (j)) * 64) * NZ + ZKW + g * 128)
#define NS_VPTR(j) (z + (size_t)((wb0 + (j)) * 64) * NZ + ZVW + g * 128)
        { const int npw = (nwt + 1) >> 1;
#define NS_ISSUE_WPAIR(ip) do { const unsigned sa_ = lds_a + (unsigned)(((ip) & 1) * 65536); const int j0_ = 2 * (ip); \
              ns_dma(NS_KPTR(j0_), NS_DOFF, sa_, w); ns_dma(NS_VPTR(j0_), NS_DOFF, sa_ + 16384u, w); \
              if (j0_ + 1 < nwt) { ns_dma(NS_KPTR(j0_ + 1), NS_DOFF, sa_ + 32768u, w); ns_dma(NS_VPTR(j0_ + 1), NS_DOFF, sa_ + 49152u, w); } } while (0)
          NS_ISSUE_WPAIR(0); NS_VMW(0); __syncthreads();
          for (int ip = 0; ip < npw; ++ip) {
              if (ip + 1 < npw) NS_ISSUE_WPAIR(ip + 1);
#pragma unroll
              for (int hb = 0; hb < 2; ++hb) { const int i = 2 * ip + hb;
                  if (i < nwt) { const int kb = wb0 + i; const LAS unsigned char* kbp = lds + (ip & 1) * 65536 + hb * 32768;
                      f32x16 x0, x1; ns_qk(x0, x1, kbp, qf, rho, hh, -m);
                      if (i == 0 || i == nwt - 1) { const int kp0 = kb * 64;
#pragma unroll
                          for (int r = 0; r < 16; ++r) { const int kp = kp0 + NS_KIDX(r, hh);
                              x0[r] = (kp <= tq && kp + 511 >= tq) ? x0[r] : -INFINITY; x1[r] = (kp + 32 <= tq && kp + 32 + 511 >= tq) ? x1[r] : -INFINITY; } }
                      ns_online<true>(x0, x1, m, l, seen, O);
                      ns_pv(O, kbp + 16384, x0, x1, lane); } }
              NS_VMW(0); __syncthreads();
          } }
        }
#undef NS_KPTR
#undef NS_VPTR
#undef NS_DOFF
        l += __shfl_xor(l, 32);
        { const float sc = gate_w / fmaxf(l, 1e-30f); f32x4 ev[4][4];
#pragma unroll
          for (int c = 0; c < 4; ++c)
#pragma unroll
              for (int r4 = 0; r4 < 4; ++r4) ev[c][r4] = *(const f32x4*)(orow + 32 * c + 8 * r4);
#pragma unroll
          for (int c = 0; c < 4; ++c)
#pragma unroll
              for (int r4 = 0; r4 < 4; ++r4) { const f32x4 e = ev[c][r4]; *(f32x4*)(orow + 32 * c + 8 * r4) = (f32x4){e.x + O[c][4 * r4] * sc, e.y + O[c][4 * r4 + 1] * sc, e.z + O[c][4 * r4 + 2] * sc, e.w + O[c][4 * r4 + 3] * sc}; } }
    }
}

constexpr int RS = 72, SLOT = 64 * RS * 2, RW_FS = 68, RW_GCL = 17 * SLOT;
#define RW_SLOT(lds, i) ((LAS bf16*)((lds) + (i) * SLOT))
template <int KS> __device__ __forceinline__ void mm_acc(f32x4 (&acc)[2], const LAS bf16* X, int xs, const LAS bf16* Y, int ys, int w, int lane) {
    const LAS bf16* xp = X + (16 * (w >> 1) + (lane & 15)) * xs + 8 * (lane >> 4);
    const LAS bf16* yp = Y + (32 * (w & 1) + (lane & 15)) * ys + 8 * (lane >> 4);
#pragma unroll
    for (int ks = 0; ks < KS; ++ks) { const bf16x8 av = *(const LAS bf16x8*)(xp + 32 * ks), b0 = *(const LAS bf16x8*)(yp + 32 * ks), b1 = *(const LAS bf16x8*)(yp + 16 * ys + 32 * ks);
        acc[0] = __builtin_amdgcn_mfma_f32_16x16x32_bf16(av, b0, acc[0], 0, 0, 0); acc[1] = __builtin_amdgcn_mfma_f32_16x16x32_bf16(av, b1, acc[1], 0, 0, 0); }
}
__device__ __forceinline__ void acc_zero(f32x4 (&acc)[2]) { acc[0] = (f32x4){0.f, 0.f, 0.f, 0.f}; acc[1] = (f32x4){0.f, 0.f, 0.f, 0.f}; }
__device__ __forceinline__ void st_n(const f32x4 (&acc)[2], LAS bf16* dst, int m0, int n0) {
#pragma unroll
    for (int tn = 0; tn < 2; ++tn)
#pragma unroll
        for (int r = 0; r < 4; ++r) dst[(m0 + r) * RS + n0 + 16 * tn] = (bf16)acc[tn][r];
}
__device__ __forceinline__ void st_t(const f32x4 (&acc)[2], LAS bf16* dst, int m0, int n0) {
#pragma unroll
    for (int tn = 0; tn < 2; ++tn) { const bf16x4 v = {(bf16)acc[tn][0], (bf16)acc[tn][1], (bf16)acc[tn][2], (bf16)acc[tn][3]}; *(LAS bf16x4*)(dst + (n0 + 16 * tn) * RS + m0) = v; }
}
__device__ __forceinline__ void ld_n(f32x4 (&acc)[2], const LAS bf16* src, int m0, int n0) {
#pragma unroll
    for (int tn = 0; tn < 2; ++tn)
#pragma unroll
        for (int r = 0; r < 4; ++r) acc[tn][r] = (float)src[(m0 + r) * RS + n0 + 16 * tn];
}
template <bool INCL> __device__ __forceinline__ void tri_mask(f32x4 (&acc)[2], int m0, int n0) {
#pragma unroll
    for (int tn = 0; tn < 2; ++tn)
#pragma unroll
        for (int r = 0; r < 4; ++r) { const int m = m0 + r, n = n0 + 16 * tn; if (INCL ? (n > m) : (n >= m)) acc[tn][r] = 0.f; }
}
__device__ __forceinline__ void st_acc_g(const f32x4 (&acc)[2], f16* base, int u, int w, int lane) {
#pragma unroll
    for (int tn = 0; tn < 2; ++tn) { const f16x4 v = {(f16)acc[tn][0], (f16)acc[tn][1], (f16)acc[tn][2], (f16)acc[tn][3]}; ((f16x4*)base)[((size_t)u * 16 + w * 2 + tn) * 64 + lane] = v; }
}
__device__ __forceinline__ float fast_tanh(float x) { const float e = __expf(2.f * x); return 1.f - 2.f / (e + 1.f); }

__device__ __forceinline__ void p_rwkv_local(const Args& a, LAS unsigned char* lds) {
    const int tid = opaque_tid(), lane = tid & 63, w = __builtin_amdgcn_readfirstlane(tid >> 6);
    const int m0 = 16 * (w >> 1) + 4 * (lane >> 4), n0 = 32 * (w & 1) + (lane & 15);
    const int et = tid >> 3, cg = tid & 7;
    const f16* z = (const f16*)(a.ws + WS_Z);
    unsigned char* ro = (unsigned char*)a.out;
    LAS float* FW = (LAS float*)(lds + 8 * SLOT); LAS float* FA = FW + 64 * RW_FS; LAS float* TOT = FA + 64 * RW_FS; LAS float* GCL = (LAS float*)(lds + RW_GCL); LAS float* PRM = GCL + 64;
    const int h = blockIdx.x & 15, cstep = gridDim.x >> 4, ch0 = h * 64 + 8 * cg;
    __syncthreads();
    if (tid < 64) { const int ch = h * 64 + tid; const float* mu = a.in[I_MU];
        PRM[tid] = mu[ch]; PRM[64 + tid] = mu[1024 + ch]; PRM[128 + tid] = mu[2048 + ch]; PRM[192 + tid] = mu[3072 + tid]; PRM[256 + tid] = mu[3136 + tid];
        PRM[320 + tid] = a.in[I_W0][ch]; PRM[384 + tid] = a.in[I_A0][ch]; PRM[448 + tid] = a.in[I_KK][ch]; PRM[512 + tid] = a.in[I_KA][ch]; PRM[576 + tid] = a.in[I_RK][ch]; }
    { bf16x8 id8;
#pragma unroll
      for (int e = 0; e < 8; ++e) id8[e] = (bf16)((8 * cg + e == et) ? 1.f : 0.f);
      *(LAS bf16x8*)(RW_SLOT(lds, 16) + et * RS + 8 * cg) = id8; }
    *(LAS u32x4*)(RW_SLOT(lds, 14) + et * RS + 8 * cg) = *(const u32x4*)((const bf16*)(a.ws + WS_WUPT) + (size_t)(h * 64 + et) * 64 + 8 * cg);
    *(LAS u32x4*)(RW_SLOT(lds, 15) + et * RS + 8 * cg) = *(const u32x4*)((const bf16*)(a.ws + WS_AUPT) + (size_t)(h * 64 + et) * 64 + 8 * cg);
    f16x8 zc[5], zp[5];
    const f16x8 zero8 = {0, 0, 0, 0, 0, 0, 0, 0};
#define RW_LOADZ(cc) do { const int t_ = (cc) * 64 + et; const f16* cur_ = z + (size_t)t_ * NZ; const bool hp_ = t_ > 0; \
        zc[0] = *(const f16x8*)(cur_ + ZR + ch0); zc[1] = *(const f16x8*)(cur_ + ZK + ch0); zc[2] = *(const f16x8*)(cur_ + ZV + ch0); zc[3] = *(const f16x8*)(cur_ + ZWD + 8 * cg); zc[4] = *(const f16x8*)(cur_ + ZAD + 8 * cg); \
        zp[0] = hp_ ? *(const f16x8*)(cur_ - NZ + ZR + ch0) : zero8; zp[1] = hp_ ? *(const f16x8*)(cur_ - NZ + ZK + ch0) : zero8; zp[2] = hp_ ? *(const f16x8*)(cur_ - NZ + ZV + ch0) : zero8; \
        zp[3] = hp_ ? *(const f16x8*)(cur_ - NZ + ZWD + 8 * cg) : zero8; zp[4] = hp_ ? *(const f16x8*)(cur_ - NZ + ZAD + 8 * cg) : zero8; } while (0)
    __syncthreads();
    if ((blockIdx.x >> 4) < 256) RW_LOADZ(blockIdx.x >> 4);
    for (int c = blockIdx.x >> 4; c < 256; c += cstep) {
        const int t0 = c * 64, uo = h * 256 + c;
        float r_[8], k_[8], v_[8];
        { bf16x8 x1, x2;
#pragma unroll
          for (int e = 0; e < 8; ++e) { const int jj = 8 * cg + e;
              r_[e] = (float)zc[0][e] + ((float)zp[0][e] - (float)zc[0][e]) * PRM[jj]; k_[e] = (float)zc[1][e] + ((float)zp[1][e] - (float)zc[1][e]) * PRM[64 + jj]; v_[e] = (float)zc[2][e] + ((float)zp[2][e] - (float)zc[2][e]) * PRM[128 + jj];
              x1[e] = (bf16)fast_tanh((float)zc[3][e] + ((float)zp[3][e] - (float)zc[3][e]) * PRM[192 + jj]); x2[e] = (bf16)((float)zc[4][e] + ((float)zp[4][e] - (float)zc[4][e]) * PRM[256 + jj]); }
          *(LAS bf16x8*)(RW_SLOT(lds, 0) + et * RS + 8 * cg) = x1; *(LAS bf16x8*)(RW_SLOT(lds, 1) + et * RS + 8 * cg) = x2; }
        if (c + cstep < 256) RW_LOADZ(c + cstep);
        __syncthreads();
        { f32x4 acc[2]; acc_zero(acc); mm_acc<2>(acc, RW_SLOT(lds, 0), RS, RW_SLOT(lds, 14), RS, w, lane);
#pragma unroll
          for (int tn = 0; tn < 2; ++tn)
#pragma unroll
              for (int r = 0; r < 4; ++r) FW[(m0 + r) * RW_FS + n0 + 16 * tn] = acc[tn][r];
          acc_zero(acc); mm_acc<2>(acc, RW_SLOT(lds, 1), RS, RW_SLOT(lds, 15), RS, w, lane);
#pragma unroll
          for (int tn = 0; tn < 2; ++tn)
#pragma unroll
              for (int r = 0; r < 4; ++r) FA[(m0 + r) * RW_FS + n0 + 16 * tn] = acc[tn][r]; }
        __syncthreads();
        float lw_[8], kk_[8], b_[8];
        { float ss = 0.f, sb = 0.f;
#pragma unroll
          for (int e = 0; e < 8; ++e) {
              const float wpre = PRM[320 + 8 * cg + e] + FW[et * RW_FS + 8 * cg + e]; const float y0 = -wpre; const float sp = fmaxf(y0, 0.f) + __logf(1.f + __expf(-fabsf(y0)));
              lw_[e] = -__expf(-sp - 0.5f);
              const float av = sigmoidf_(PRM[384 + 8 * cg + e] + FA[et * RW_FS + 8 * cg + e]);
              const float kkr = k_[e] * PRM[448 + 8 * cg + e]; ss += kkr * kkr; kk_[e] = kkr;
              k_[e] = k_[e] * (1.f + (av - 1.f) * PRM[512 + 8 * cg + e]); b_[e] = av;
              sb += r_[e] * k_[e] * PRM[576 + 8 * cg + e]; }
          ss += __shfl_xor(ss, 1); ss += __shfl_xor(ss, 2); ss += __shfl_xor(ss, 4);
          sb += __shfl_xor(sb, 1); sb += __shfl_xor(sb, 2); sb += __shfl_xor(sb, 4);
          const float rn = rsqrtf(fmaxf(ss, 1e-24f));
#pragma unroll
          for (int e = 0; e < 8; ++e) { kk_[e] *= rn; b_[e] *= kk_[e]; FW[et * RW_FS + 8 * cg + e] = lw_[e]; }
          if (cg == 0) ((float*)(a.ws + WS_SBON))[(size_t)(t0 + et) * 16 + h] = sb; }
        __syncthreads();
        { const int j = tid & 63, rg = tid >> 6; float run = 0.f;
#pragma unroll
          for (int i = 0; i < 8; ++i) { run += FW[(8 * rg + i) * RW_FS + j]; FW[(8 * rg + i) * RW_FS + j] = run; }
          TOT[rg * 64 + j] = run;
          __syncthreads();
          float off = 0.f;
          for (int q = 0; q < rg; ++q) off += TOT[q * 64 + j];
#pragma unroll
          for (int i = 0; i < 8; ++i) FW[(8 * rg + i) * RW_FS + j] += off; }
        __syncthreads();
        { bf16x8 at, bt, kt, rt, bh, kh, vv;
#pragma unroll
          for (int e = 0; e < 8; ++e) { const int jj = 8 * cg + e; const float cum = FW[et * RW_FS + jj], cl = FW[63 * RW_FS + jj];
              const float eA = __expf(cum - lw_[e]), eN = __expf(-cum), eP = __expf(cum), eH = __expf(cl - cum);
              at[e] = (bf16)(-kk_[e] * eA); bt[e] = (bf16)(b_[e] * eN); kt[e] = (bf16)(k_[e] * eN); rt[e] = (bf16)(r_[e] * eP);
              bh[e] = (bf16)(b_[e] * eH); kh[e] = (bf16)(k_[e] * eH); vv[e] = (bf16)v_[e];
              if (et == 63) GCL[jj] = __expf(cl); }
          *(LAS bf16x8*)(RW_SLOT(lds, 0) + et * RS + 8 * cg) = at; *(LAS bf16x8*)(RW_SLOT(lds, 2) + et * RS + 8 * cg) = bt;
          *(LAS bf16x8*)(RW_SLOT(lds, 3) + et * RS + 8 * cg) = kt; *(LAS bf16x8*)(RW_SLOT(lds, 4) + et * RS + 8 * cg) = rt;
          *(LAS bf16x8*)(RW_SLOT(lds, 5) + et * RS + 8 * cg) = bh; *(LAS bf16x8*)(RW_SLOT(lds, 6) + et * RS + 8 * cg) = kh; *(LAS bf16x8*)(RW_SLOT(lds, 7) + et * RS + 8 * cg) = vv; }
        __syncthreads();
#define RW_MM(acc, XS, YS) mm_acc<2>(acc, RW_SLOT(lds, XS), RS, RW_SLOT(lds, YS), RS, w, lane)
#define RW_ST(acc, DS) st_t(acc, RW_SLOT(lds, DS), m0, n0)
        { f32x4 acc[2];
          acc_zero(acc); RW_MM(acc, 0, 16); RW_ST(acc, 1);
          acc_zero(acc); RW_MM(acc, 5, 16); RW_ST(acc, 8);
          acc_zero(acc); RW_MM(acc, 6, 16); RW_ST(acc, 9);
          acc_zero(acc); RW_MM(acc, 7, 16); RW_ST(acc, 10);
          __syncthreads();
          acc_zero(acc); RW_MM(acc, 2, 0);
#pragma unroll
          for (int tn = 0; tn < 2; ++tn)
#pragma unroll
              for (int r = 0; r < 4; ++r) if (m0 + r >= n0 + 16 * tn) acc[tn][r] = 0.f;
          RW_ST(acc, 5);
#pragma unroll
          for (int tn = 0; tn < 2; ++tn)
#pragma unroll
              for (int r = 0; r < 4; ++r) if (m0 + r == n0 + 16 * tn) acc[tn][r] = 1.f;
          RW_ST(acc, 13);
          acc_zero(acc); RW_MM(acc, 0, 2); tri_mask<false>(acc, m0, n0); RW_ST(acc, 6);
          acc_zero(acc); RW_MM(acc, 0, 3); tri_mask<false>(acc, m0, n0); RW_ST(acc, 7);
          acc_zero(acc); RW_MM(acc, 2, 4);
#pragma unroll
          for (int tn = 0; tn < 2; ++tn)
#pragma unroll
              for (int r = 0; r < 4; ++r) if (m0 + r > n0 + 16 * tn) acc[tn][r] = 0.f;
          RW_ST(acc, 11);
          acc_zero(acc); RW_MM(acc, 3, 4);
#pragma unroll
          for (int tn = 0; tn < 2; ++tn)
#pragma unroll
              for (int r = 0; r < 4; ++r) if (m0 + r > n0 + 16 * tn) acc[tn][r] = 0.f;
          RW_ST(acc, 12);
          __syncthreads();
#define RW_LDT(acc, TS) do { _Pragma("unroll") for (int tn_ = 0; tn_ < 2; ++tn_) { const bf16x4 v_ = *(const LAS bf16x4*)(RW_SLOT(lds, TS) + (n0 + 16 * tn_) * RS + m0); acc[tn_] = (f32x4){(float)v_[0], (float)v_[1], (float)v_[2], (float)v_[3]}; } } while (0)
          acc_zero(acc); RW_MM(acc, 6, 5); RW_ST(acc, 0); acc_zero(acc); RW_MM(acc, 5, 6); RW_ST(acc, 2);
          __syncthreads();
          RW_LDT(acc, 13); RW_MM(acc, 2, 13); RW_ST(acc, 3);
          acc_zero(acc); RW_MM(acc, 2, 0); RW_ST(acc, 5); acc_zero(acc); RW_MM(acc, 0, 2); RW_ST(acc, 6);
          __syncthreads();
          RW_LDT(acc, 3); RW_MM(acc, 6, 3); RW_ST(acc, 13);
          acc_zero(acc); RW_MM(acc, 6, 5); RW_ST(acc, 0); acc_zero(acc); RW_MM(acc, 5, 6); RW_ST(acc, 2);
          __syncthreads();
          RW_LDT(acc, 13); RW_MM(acc, 2, 13); RW_ST(acc, 3);
          acc_zero(acc); RW_MM(acc, 2, 0); RW_ST(acc, 5); acc_zero(acc); RW_MM(acc, 0, 2); RW_ST(acc, 6);
          __syncthreads();
          RW_LDT(acc, 3); RW_MM(acc, 6, 3); RW_ST(acc, 13);
          acc_zero(acc); RW_MM(acc, 5, 6); RW_ST(acc, 2);
          __syncthreads();
          RW_LDT(acc, 13); RW_MM(acc, 2, 13); RW_ST(acc, 3);
          __syncthreads();
          acc_zero(acc); RW_MM(acc, 3, 1); RW_ST(acc, 0);
          acc_zero(acc); RW_MM(acc, 7, 3); RW_ST(acc, 5);
          __syncthreads();
          acc_zero(acc); RW_MM(acc, 5, 10); RW_ST(acc, 6);
          acc_zero(acc); RW_MM(acc, 0, 11);
#pragma unroll
          for (int tn = 0; tn < 2; ++tn) { const int tt = n0 + 16 * tn; const bf16x4 rr = *(const LAS bf16x4*)(RW_SLOT(lds, 4) + tt * RS + m0);
              const bf16x4 o = {(bf16)(acc[tn][0] + (float)rr[0]), (bf16)(acc[tn][1] + (float)rr[1]), (bf16)(acc[tn][2] + (float)rr[2]), (bf16)(acc[tn][3] + (float)rr[3])};
              *(bf16x4*)((bf16*)(ro + RO_Q) + (size_t)uo * 4096 + tt * 64 + m0) = o; }
          acc_zero(acc); RW_MM(acc, 0, 8);
#pragma unroll
          for (int tn = 0; tn < 2; ++tn) { const int jj = n0 + 16 * tn; const float gc = GCL[jj];
              const bf16x4 o = {(bf16)(acc[tn][0] + (m0 == jj ? gc : 0.f)), (bf16)(acc[tn][1] + (m0 + 1 == jj ? gc : 0.f)), (bf16)(acc[tn][2] + (m0 + 2 == jj ? gc : 0.f)), (bf16)(acc[tn][3] + (m0 + 3 == jj ? gc : 0.f))};
              *(bf16x4*)((bf16*)(ro + RO_M) + (size_t)uo * 4096 + jj * 64 + m0) = o; }
          __syncthreads();
          acc_zero(acc); RW_MM(acc, 11, 6); RW_MM(acc, 12, 10); st_acc_g(acc, (f16*)(ro + RO_Y), uo, w, lane);
          acc_zero(acc); RW_MM(acc, 6, 8); RW_MM(acc, 10, 9); st_acc_g(acc, (f16*)(ro + RO_N), uo, w, lane);
        }
#undef RW_MM
#undef RW_ST
#undef RW_LDT
    }
}
__device__ __forceinline__ void p_rwkv_scan(const Args& a, LAS unsigned char* lds, int h) {
    const int tid = opaque_tid(), lane = tid & 63, w = __builtin_amdgcn_readfirstlane(tid >> 6);
    const int m0 = 16 * (w >> 1) + 4 * (lane >> 4), n0 = 32 * (w & 1) + (lane & 15), row = tid >> 3, seg = tid & 7;
    const unsigned char* ro = (const unsigned char*)a.out;
    const bf16* Mg = (const bf16*)(ro + RO_M) + (size_t)h * 256 * 4096; const f16x4* Ng = (const f16x4*)(ro + RO_N) + (size_t)h * 256 * 1024; bf16* Sg = (bf16*)(a.ws + WS_RS) + (size_t)h * 256 * 4096;
    f32x4 acc[2]; acc_zero(acc);
    u32x4 mreg = *(const u32x4*)(Mg + row * 64 + seg * 8); f16x4 nreg[2] = {Ng[(w * 2) * 64 + lane], Ng[(w * 2 + 1) * 64 + lane]};
    for (int c = 0; c < 256; ++c) {
        LAS bf16* Sb = RW_SLOT(lds, c & 1); LAS bf16* Mb = RW_SLOT(lds, 2 + (c & 1));
        st_n(acc, Sb, m0, n0);
        *(LAS u32x4*)(Mb + row * RS + seg * 8) = mreg;
        const f16x4 nc0 = nreg[0], nc1 = nreg[1];
        if (c + 1 < 256) { mreg = *(const u32x4*)(Mg + (size_t)(c + 1) * 4096 + row * 64 + seg * 8); nreg[0] = Ng[(size_t)(c + 1) * 1024 + (w * 2) * 64 + lane]; nreg[1] = Ng[(size_t)(c + 1) * 1024 + (w * 2 + 1) * 64 + lane]; }
        __syncthreads();
        *(u32x4*)(Sg + (size_t)c * 4096 + row * 64 + seg * 8) = *(const LAS u32x4*)(Sb + row * RS + seg * 8);
        acc[0] = (f32x4){(float)nc0[0], (float)nc0[1], (float)nc0[2], (float)nc0[3]}; acc[1] = (f32x4){(float)nc1[0], (float)nc1[1], (float)nc1[2], (float)nc1[3]};
        mm_acc<2>(acc, Sb, RS, Mb, RS, w, lane);
    }
}
constexpr int RG_S = 168;
__device__ __forceinline__ void p_rwkv_out(const Args& a, LAS unsigned char* lds) {
    const int tid = opaque_tid(), lane = tid & 63, w = __builtin_amdgcn_readfirstlane(tid >> 6);
    const int m0 = 16 * (w >> 1) + 4 * (lane >> 4), n0 = 32 * (w & 1) + (lane & 15), row = tid >> 3, seg = tid & 7;
    const f16* z = (const f16*)(a.ws + WS_Z); const unsigned char* ro = (const unsigned char*)a.out; f16* mix = (f16*)(a.ws + WS_MIX);
    LAS bf16* SG = (LAS bf16*)(lds + 2 * SLOT); LAS bf16* GU = SG + 64 * RG_S; LAS float* YL = (LAS float*)(GU + 64 * RG_S); LAS float* GL = YL + 64 * RW_FS; LAS float* PRM = GL + 64 * RW_FS;
    const int h = blockIdx.x & 15, cstep = gridDim.x >> 4, et = row, cg = seg, ch0 = h * 64 + 8 * cg;
    __syncthreads();
    for (int ck = tid; ck < 64 * 20; ck += 512) { const int rr = ck / 20, c8 = ck % 20; *(LAS u32x4*)(GU + rr * RG_S + 8 * c8) = *(const u32x4*)((const bf16*)(a.ws + WS_GUPT) + (size_t)(h * 64 + rr) * 160 + 8 * c8); }
    if (tid < 160) PRM[tid] = a.in[I_MU][3200 + tid];
    if (tid < 64) { PRM[160 + tid] = a.in[I_MU][2048 + h * 64 + tid]; PRM[224 + tid] = a.in[I_LNXG][h * 64 + tid]; PRM[288 + tid] = a.in[I_LNXB][h * 64 + tid]; }
    const f16x8 zero8 = {0, 0, 0, 0, 0, 0, 0, 0};
    u32x4 qreg, sreg; f16x4 yreg[2]; f16x8 gc[3], gp[3], vc, vp; float sbn;
#define RO_LOAD(cc) do { const int uo_ = h * 256 + (cc), t0_ = (cc) * 64; \
        qreg = *(const u32x4*)((const bf16*)(ro + RO_Q) + (size_t)uo_ * 4096 + row * 64 + seg * 8); sreg = *(const u32x4*)((const bf16*)(a.ws + WS_RS) + (size_t)uo_ * 4096 + row * 64 + seg * 8); \
        { const f16x4* Yg_ = (const f16x4*)(ro + RO_Y) + (size_t)uo_ * 1024; yreg[0] = Yg_[(w * 2) * 64 + lane]; yreg[1] = Yg_[(w * 2 + 1) * 64 + lane]; } \
        _Pragma("unroll") for (int i_ = 0; i_ < 3; ++i_) { const int ck_ = tid + 512 * i_; if (ck_ < 64 * 20) { const int t_ = t0_ + ck_ / 20; const f16* cur_ = z + (size_t)t_ * NZ + ZGD + 8 * (ck_ % 20); gc[i_] = *(const f16x8*)cur_; gp[i_] = t_ > 0 ? *(const f16x8*)(cur_ - NZ) : zero8; } } \
        { const int t_ = t0_ + et; const f16* cur_ = z + (size_t)t_ * NZ + ZV + ch0; vc = *(const f16x8*)cur_; vp = t_ > 0 ? *(const f16x8*)(cur_ - NZ) : zero8; sbn = ((const float*)(a.ws + WS_SBON))[(size_t)t_ * 16 + h]; } } while (0)
    RO_LOAD(blockIdx.x >> 4);
    for (int c = blockIdx.x >> 4; c < 256; c += cstep) {
        const int t0 = c * 64;
        __syncthreads();
        *(LAS u32x4*)(RW_SLOT(lds, 0) + row * RS + seg * 8) = qreg; *(LAS u32x4*)(RW_SLOT(lds, 1) + row * RS + seg * 8) = sreg;
#pragma unroll
        for (int i = 0; i < 3; ++i) { const int ck = tid + 512 * i; if (ck < 64 * 20) { const int rr = ck / 20, c8 = ck % 20; bf16x8 o;
#pragma unroll
            for (int e = 0; e < 8; ++e) o[e] = (bf16)sigmoidf_((float)gc[i][e] + ((float)gp[i][e] - (float)gc[i][e]) * PRM[8 * c8 + e]);
            *(LAS bf16x8*)(SG + rr * RG_S + 8 * c8) = o; } }
        f32x4 y[2], g[2];
        y[0] = (f32x4){(float)yreg[0][0], (float)yreg[0][1], (float)yreg[0][2], (float)yreg[0][3]}; y[1] = (f32x4){(float)yreg[1][0], (float)yreg[1][1], (float)yreg[1][2], (float)yreg[1][3]};
        const f16x8 vcc = vc, vpp = vp; const float sbc = sbn;
        if (c + cstep < 256) RO_LOAD(c + cstep);
        __syncthreads();
        mm_acc<2>(y, RW_SLOT(lds, 0), RS, RW_SLOT(lds, 1), RS, w, lane);
        acc_zero(g); mm_acc<5>(g, SG, RG_S, GU, RG_S, w, lane);
#pragma unroll
        for (int tn = 0; tn < 2; ++tn)
#pragma unroll
            for (int r = 0; r < 4; ++r) { YL[(m0 + r) * RW_FS + n0 + 16 * tn] = y[tn][r]; GL[(m0 + r) * RW_FS + n0 + 16 * tn] = g[tn][r]; }
        __syncthreads();
        { const int t = t0 + et;
          float yv[8], gv[8]; float s1 = 0.f, s2 = 0.f;
#pragma unroll
          for (int e = 0; e < 8; ++e) { yv[e] = YL[et * RW_FS + 8 * cg + e]; gv[e] = GL[et * RW_FS + 8 * cg + e]; s1 += yv[e]; s2 += yv[e] * yv[e]; }
          s1 += __shfl_xor(s1, 1); s1 += __shfl_xor(s1, 2); s1 += __shfl_xor(s1, 4);
          s2 += __shfl_xor(s2, 1); s2 += __shfl_xor(s2, 2); s2 += __shfl_xor(s2, 4);
          const float mean = s1 * (1.f / 64.f), var = fmaxf(s2 * (1.f / 64.f) - mean * mean, 0.f), rstd = rsqrtf(var + 64e-5f);
          f16x8 o;
#pragma unroll
          for (int e = 0; e < 8; ++e) { const int jj = 8 * cg + e; const float vv = (float)vcc[e] + ((float)vpp[e] - (float)vcc[e]) * PRM[160 + jj];
              const float yn = (yv[e] - mean) * rstd * PRM[224 + jj] + PRM[288 + jj]; o[e] = (f16)((yn + sbc * vv) * gv[e]); }
          *(f16x8*)(mix + (size_t)t * D + 1024 + ch0) = o; }
    }
}

constexpr int RT_XS = 2048 + 8;
__device__ __forceinline__ void p_router(const Args& a, LAS unsigned char* lds, int rep) {
    const int tid = opaque_tid(), lane = tid & 63, wave = __builtin_amdgcn_readfirstlane(tid >> 6);
    const float* x2 = (const float*)(a.ws + WS_X1); f16* h3 = (f16*)a.out;
    unsigned* ctl = (unsigned*)(a.ws + WS_CTL);
    int* tke = (int*)(a.ws + WS_TOK + TK_E); float* tkw = (float*)(a.ws + WS_TOK + TK_W);
    const f16* WH = (const f16*)(a.ws + WS_WRH); const f16* WL = (const f16*)(a.ws + WS_WRL);
    LAS float* PART = (LAS float*)lds;
    LAS float* SSP = PART + 8 * 16 * 48;
    LAS float* LG = SSP + 128;
    LAS float* RSTD = LG + 16 * 48;
    LAS float* XT = RSTD + 16;
    const int row = lane & 15, kq = lane >> 4;
    for (int tile = blockIdx.x; tile < T / 16; tile += gridDim.x) {
        const int r0 = tile * 16;
        f32x4 acc[3]; acc[0] = (f32x4){0.f, 0.f, 0.f, 0.f}; acc[1] = acc[0]; acc[2] = acc[0];
        float ss = 0.f;
        const float* xp = x2 + (size_t)(r0 + row) * D + 256 * wave + 8 * kq;
        const f16* whp = WH + (size_t)row * D + 256 * wave + 8 * kq; const f16* wlp = WL + (size_t)row * D + 256 * wave + 8 * kq;
#pragma unroll 1
        for (int kb = 0; kb < 2; ++kb) {
            f32x4 xa[4], xb[4]; f16x8 bh[4][3], bl[4][3];
#pragma unroll
            for (int k4 = 0; k4 < 4; ++k4) { const int ks = kb * 4 + k4; xa[k4] = *(const f32x4*)(xp + 32 * ks); xb[k4] = *(const f32x4*)(xp + 32 * ks + 4);
#pragma unroll
                for (int nt = 0; nt < 3; ++nt) { bh[k4][nt] = *(const f16x8*)(whp + (size_t)nt * 16 * D + 32 * ks); bl[k4][nt] = *(const f16x8*)(wlp + (size_t)nt * 16 * D + 32 * ks); } }
            asm volatile("s_waitcnt vmcnt(0)" ::: "memory");
#pragma unroll
            for (int k4 = 0; k4 < 4; ++k4) {
                { LAS float* xd = XT + row * RT_XS + 256 * wave + 32 * (kb * 4 + k4) + 8 * kq; *(LAS f32x4*)xd = xa[k4]; *(LAS f32x4*)(xd + 4) = xb[k4]; }
                ss += xa[k4].x * xa[k4].x + xa[k4].y * xa[k4].y + xa[k4].z * xa[k4].z + xa[k4].w * xa[k4].w + xb[k4].x * xb[k4].x + xb[k4].y * xb[k4].y + xb[k4].z * xb[k4].z + xb[k4].w * xb[k4].w;
                f16x8 hi, lo;
#pragma unroll
                for (int j = 0; j < 4; ++j) { hi[j] = (f16)xa[k4][j]; lo[j] = (f16)(xa[k4][j] - (float)hi[j]); hi[4 + j] = (f16)xb[k4][j]; lo[4 + j] = (f16)(xb[k4][j] - (float)hi[4 + j]); }
#pragma unroll
                for (int nt = 0; nt < 3; ++nt) {
                    acc[nt] = __builtin_amdgcn_mfma_f32_16x16x32_f16(hi, bh[k4][nt], acc[nt], 0, 0, 0); acc[nt] = __builtin_amdgcn_mfma_f32_16x16x32_f16(lo, bh[k4][nt], acc[nt], 0, 0, 0); acc[nt] = __builtin_amdgcn_mfma_f32_16x16x32_f16(hi, bl[k4][nt], acc[nt], 0, 0, 0); }
            }
        }
        ss += __shfl_xor(ss, 16); ss += __shfl_xor(ss, 32);
        __syncthreads();
        if (kq == 0) SSP[wave * 16 + row] = ss;
#pragma unroll
        for (int nt = 0; nt < 3; ++nt)
#pragma unroll
            for (int r = 0; r < 4; ++r) PART[(wave * 16 + 4 * kq + r) * 48 + 16 * nt + row] = acc[nt][r];
        __syncthreads();
        for (int i = tid; i < 16 * 48; i += 512) { float v = 0.f;
#pragma unroll
            for (int ww = 0; ww < 8; ++ww) v += PART[ww * 768 + i];
            LG[i] = v; }
        if (tid < 16) { float v = 0.f;
#pragma unroll
            for (int ww = 0; ww < 8; ++ww) v += SSP[ww * 16 + tid];
            RSTD[tid] = rsqrtf(v * (1.f / D) + EPS); }
        __syncthreads();
        if (tid < 16) {
            const float rs = RSTD[tid]; const LAS float* L = LG + tid * 48;
            float lg[4];
#pragma unroll
            for (int c = 0; c < 4; ++c) lg[c] = L[c] * rs + a.in[I_RGB][c];
            int gi = 0; float gm = lg[0];
#pragma unroll
            for (int c = 1; c < 4; ++c) if (lg[c] > gm) { gm = lg[c]; gi = c; }
            float gs = 0.f;
#pragma unroll
            for (int c = 0; c < 4; ++c) gs += __expf(lg[c] - gm);
            const float pg = 1.f / gs;
            float le[8];
#pragma unroll
            for (int c = 0; c < 8; ++c) le[c] = L[4 + gi * 8 + c] * rs + a.in[I_REB][gi * 8 + c];
            int e1 = 0; float m1 = le[0];
#pragma unroll
            for (int c = 1; c < 8; ++c) if (le[c] > m1) { m1 = le[c]; e1 = c; }
            int e2 = -1; float m2 = -INFINITY;
#pragma unroll
            for (int c = 0; c < 8; ++c) if (c != e1 && le[c] > m2) { m2 = le[c]; e2 = c; }
            const float p2 = __expf(m2 - m1);
            const float w1 = pg / (1.f + p2), w2 = pg * p2 / (1.f + p2);
            const int m = r0 + tid, E1 = gi * 8 + e1, E2 = gi * 8 + e2; tke[m * 2] = E1; tke[m * 2 + 1] = E2; tkw[m * 2] = w1; tkw[m * 2 + 1] = w2;
            atomicAdd(&ctl[CW_CNT + rep * 8000 + E1], 1u); atomicAdd(&ctl[CW_CNT + rep * 8000 + E2], 1u);
        }
        { f32x4 xv[2][8], gg[8]; const f32x4* gr = (const f32x4*)a.in[I_LN3] + lane;
#pragma unroll
          for (int j = 0; j < 8; ++j) gg[j] = gr[64 * j];
#pragma unroll
          for (int rr2 = 0; rr2 < 2; ++rr2) { const LAS f32x4* xr = (const LAS f32x4*)(XT + (wave * 2 + rr2) * RT_XS) + lane;
#pragma unroll
              for (int j = 0; j < 8; ++j) xv[rr2][j] = xr[64 * j]; }
#pragma unroll
          for (int rr2 = 0; rr2 < 2; ++rr2) { const int rr = wave * 2 + rr2; const float rs = RSTD[rr]; u32x2* o8 = (u32x2*)(h3 + (size_t)(r0 + rr) * D) + lane;
#pragma unroll
              for (int j = 0; j < 8; ++j) { const f32x4 v = xv[rr2][j]; u32x2 wv; wv.x = pkh(v.x * rs * gg[j].x, v.y * rs * gg[j].y); wv.y = pkh(v.z * rs * gg[j].z, v.w * rs * gg[j].w); o8[64 * j] = wv; } } }
        __syncthreads();
    }
}
__device__ __forceinline__ void p_slots(const Args& a, LAS unsigned char* lds, int rep) {
    unsigned* ctl = (unsigned*)(a.ws + WS_CTL);
    const int* tke = (const int*)(a.ws + WS_TOK + TK_E); const float* tkw = (const float*)(a.ws + WS_TOK + TK_W); int* tks = (int*)(a.ws + WS_TOK + TK_SLOT);
    int* stok = (int*)(a.ws + WS_TOK + TK_STOK); float* sw = (float*)(a.ws + WS_TOK + TK_SW);
    const int tid = opaque_tid(), lane = tid & 63;
    LAS int* offl = (LAS int*)lds; LAS int* cntl = offl + 64;
    __syncthreads();
    if (tid < 64) {
        const int n = lane < NEXP ? (int)ctl[CW_CNT + lane] : 0, nt = (n + 255) >> 8;
        int pre = nt;
#pragma unroll
        for (int o = 1; o < 32; o <<= 1) { const int v = __shfl_up(pre, o); if ((lane & 31) >= o) pre += v; }
        const int tb = pre - nt;
        if (lane < NEXP) { offl[lane] = tb * 256; cntl[lane] = n; }
        if (lane == NEXP - 1) offl[NEXP] = pre * 256;
        if (blockIdx.x == 0 && lane < NEXP) {
            int2* ugu = (int2*)(ctl + CW_UGU); int2* udn = (int2*)(ctl + CW_UDN);
            for (int rt = 0; rt < nt; ++rt) { const int pm = tb + rt;
#pragma unroll
                for (int jt = 0; jt < 2; ++jt) ugu[pm * 2 + jt] = make_int2(pm, lane * 2 + jt);
#pragma unroll
                for (int jt = 0; jt < 8; ++jt) udn[pm * 8 + jt] = make_int2(pm, lane * 8 + jt); }
            if (lane == NEXP - 1) { ctl[CW_NT] = (unsigned)pre; ctl[CW_NGU] = (unsigned)(pre * 2); ctl[CW_NDN] = (unsigned)(pre * 8); }
        }
    }
    __syncthreads();
    if (blockIdx.x == 0 && rep == 0) {
        for (int e = 0; e < NEXP; ++e) { const int end = offl[e + 1];
            for (int sl = offl[e] + cntl[e] + tid; sl < end; sl += 512) { stok[sl] = 0; sw[sl] = 0.f; } } }
    for (int i = blockIdx.x * 512 + tid; i < T * 2; i += gridDim.x * 512) { const int e = tke[i]; const int slot = offl[e] + (int)atomicAdd(&ctl[CW_CUR + rep * 8000 + e], 1u);
        stok[slot] = i >> 1; sw[slot] = tkw[i]; tks[i] = slot; }
}

constexpr int NPH = 17;
__global__ void __launch_bounds__(512, 2) mega(Args args) {
    extern __shared__ __attribute__((aligned(16))) unsigned char lds_raw[];
    LAS unsigned char* lds = (LAS unsigned char*)lds_raw;
    volatile LAS unsigned* MISC = (volatile LAS unsigned*)(lds + MISC_OFF);
    const int G = gridDim.x;
#define PH_IDS const int tid = opaque_tid(), lane = tid & 63, wave = tid >> 6, gw = blockIdx.x * 8 + wave, NGW = gridDim.x * 8; (void)tid; (void)lane; (void)gw; (void)NGW
    unsigned char* ws = args.ws;
    unsigned* ctl = (unsigned*)(ws + WS_CTL);
    if (threadIdx.x < 128) ((LAS unsigned*)(lds + MISC_OFF))[threadIdx.x] = 0u;
    __syncthreads();
    XcdBarrier bar; bar.bar = ctl + CW_BAR; bar.x = 0; bar.st = nullptr;
    const int lo = args.ph_lo, hi = args.ph_hi;
    if (hi - lo > 1 || DUPMASK != 0u) bar = xcd_barrier_post(ctl + CW_BAR, MISC + 8);
#ifndef PHMASK
#define PHMASK 0xFFFFFFFFu
#endif
#define IN(k) (((PHMASK >> (k)) & 1u) && lo <= (k) && (k) < hi)
#define BOTH(k) (IN(k) && IN((k) + 1))
#define GRID_BAR() xcd_barrier(bar)
#define NREP(k) ((((DUPMASK) >> (k)) & 1u) ? 2 : 1)

    for (int rep_ = 0; rep_ < NREP(0); ++rep_) if (IN(0)) { p0_prologue(args, lds); if (BOTH(0) || rep_ + 1 < NREP(0)) GRID_BAR(); }
    for (int rep_ = 0; rep_ < NREP(1); ++rep_) if (IN(1)) {
        { pg8::Gemm g{(const f16*)(ws + WS_H), (const f16*)(ws + WS_WIN), D, D, D, nullptr}; pg8::StaticOrder S; S.init(T, NZ, G, (int)blockIdx.x);
          pg8::EpiF16 E{(f16*)(ws + WS_Z), NZ, 1.f}; pg8::gemm_phase<pg8::EpiF16, pg8::StaticOrder, true>(lds, g, S, E); }
        if (BOTH(1) || rep_ + 1 < NREP(1)) GRID_BAR();
    }
    for (int rep_ = 0; rep_ < NREP(2); ++rep_) if (IN(2)) {
        for (int r2_ = 0; r2_ < ((DUPX & 1) ? 2 : 1); ++r2_) { p_compress(args, lds); __syncthreads(); }
        for (int r2_ = 0; r2_ < ((DUPX & 2) ? 2 : 1); ++r2_) { p_rwkv_local(args, lds); __syncthreads(); }
        if (BOTH(2) || rep_ + 1 < NREP(2)) GRID_BAR();
    }
    for (int rep_ = 0; rep_ < NREP(3); ++rep_) if (IN(3)) {
        if (blockIdx.x < 16) p_rwkv_scan(args, lds, blockIdx.x);
        else if (blockIdx.x < 32 && rep_ == 0) { const int b = blockIdx.x - 16; const int which = b / 8;
            pg8::Gemm g{(const f16*)(ws + WS_MEMN), (const f16*)(ws + (which == 0 ? WS_WKT : WS_WVT)), D, D, D, nullptr}; pg8::StaticOrder S; S.init(256, D, 8, b % 8);
            pg8::EpiF16 E{(f16*)(ws + (which == 0 ? WS_KM : WS_VM)), D, 1.f}; pg8::gemm_phase<pg8::EpiF16, pg8::StaticOrder, true>(lds, g, S, E); }
        __syncthreads();
        p_nsa(args, lds, rep_);
        if (BOTH(3) || rep_ + 1 < NREP(3)) GRID_BAR();
    }
    for (int rep_ = 0; rep_ < NREP(5); ++rep_) if (IN(5)) {
        p_rwkv_out(args, lds);
        __syncthreads();
        PH_IDS;
        if (blockIdx.x < 64) { const int b = blockIdx.x; const int grp = b / 8, c = b % 8;
          if (grp < 4) { const int h = grp;
              pg8::Gemm g{(const f16*)(ws + WS_KM) + h * 512, (const f16*)(ws + WS_WQ16) + h * 512, D, D, 512, nullptr}; pg8::StaticOrder S; S.init(256, D, 8, c);
              pg8::EpiF16 E{(f16*)(ws + WS_WQK) + (size_t)h * 256 * D, D, 0.04419417382415922f}; pg8::gemm_phase<pg8::EpiF16, pg8::StaticOrder, true>(lds, g, S, E); }
          else { const int h = grp - 4;
              pg8::Gemm g{(const f16*)(ws + WS_WOT) + h * 512, (const f16*)(ws + WS_VM) + h * 512, D, D, 512, nullptr}; pg8::StaticOrder S; S.init(D, 256, 8, c);
              pg8::EpiF16 E{(f16*)(ws + WS_VOT) + h * 256, 1024, 1.f}; pg8::gemm_phase<pg8::EpiF16, pg8::StaticOrder, true>(lds, g, S, E); } }
        else {
        const float* onsa = (const float*)(ws + WS_ONSA); f16* mix = (f16*)(ws + WS_MIX);
        for (int m = gw - 64 * 8; m < T; m += NGW - 64 * 8) { const f32x4* xr = (const f32x4*)(onsa + (size_t)m * 1024) + lane; f32x4 v[4]; float s = 0.f;
#pragma unroll
            for (int j = 0; j < 4; ++j) { v[j] = xr[64 * j]; s += v[j].x * v[j].x + v[j].y * v[j].y + v[j].z * v[j].z + v[j].w * v[j].w; }
            const f32x4* gr = (const f32x4*)args.in[I_NSAG] + lane; f32x4 gg[4];
#pragma unroll
            for (int j = 0; j < 4; ++j) gg[j] = gr[64 * j];
            const float rstd = rsqrtf(wave_sum(s) * (1.f / 1024.f) + EPS); u32x2* o8 = (u32x2*)(mix + (size_t)m * D) + lane;
#pragma unroll
            for (int j = 0; j < 4; ++j) { u32x2 w; w.x = pkh(v[j].x * rstd * gg[j].x, v[j].y * rstd * gg[j].y); w.y = pkh(v[j].z * rstd * gg[j].z, v[j].w * rstd * gg[j].w); o8[64 * j] = w; } }
        }
        if (BOTH(5) || rep_ + 1 < NREP(5)) GRID_BAR();
    }
    for (int rep_ = 0; rep_ < NREP(6); ++rep_) if (IN(6)) {
        pg8::Gemm g{(const f16*)(ws + WS_MIX), (const f16*)(ws + WS_WOUT), D, D, D, nullptr}; pg8::StaticOrder S; S.init(T, D, G, (int)blockIdx.x);
        pg8::EpiRes16 E{(float*)(ws + WS_X1), args.in[I_X], (f16*)(ws + WS_H2), (float*)(ws + WS_CTL + WS_ROWSS), D}; pg8::gemm_phase<pg8::EpiRes16, pg8::StaticOrder, true>(lds, g, S, E);
        if (BOTH(6) || rep_ + 1 < NREP(6)) GRID_BAR();
    }
    for (int rep_ = 0; rep_ < NREP(7); ++rep_) if (IN(7)) {
        PH_IDS;
        p_moe_weights(args, lds);
        if (BOTH(7) || rep_ + 1 < NREP(7)) GRID_BAR();
    }
    for (int rep_ = 0; rep_ < NREP(8); ++rep_) if (IN(8)) {
        pg8::Gemm g{(const f16*)(ws + WS_H2), (const f16*)(ws + WS_WQK), D, D, D, nullptr}; pg8::StaticOrder S; S.init(T, 1024, G, (int)blockIdx.x);
        pg8::EpiSoftmax E{(f16*)(ws + WS_P), 1024, (const float*)(ws + WS_CTL + WS_ROWSS), (LAS float*)(lds + RING_BYTES), (LAS float*)(lds + RING_BYTES + 4096)}; pg8::gemm_phase<pg8::EpiSoftmax, pg8::StaticOrder, true>(lds, g, S, E);
        if (BOTH(8) || rep_ + 1 < NREP(8)) GRID_BAR();
    }
    for (int rep_ = 0; rep_ < NREP(10); ++rep_) if (IN(10)) {
        pg8::Gemm g{(const f16*)(ws + WS_P), (const f16*)(ws + WS_VOT), 1024, 1024, 1024, nullptr}; pg8::StaticOrder S; S.init(T, D, G, (int)blockIdx.x);
        pg8::EpiF32 E{(float*)(ws + WS_X1), (const float*)(ws + WS_X1), D}; pg8::gemm_phase<pg8::EpiF32, pg8::StaticOrder, true>(lds, g, S, E);
        if (BOTH(10) || rep_ + 1 < NREP(10)) GRID_BAR();
    }
    for (int rep_ = 0; rep_ < NREP(11); ++rep_) if (IN(11)) { p_router(args, lds, rep_); if (BOTH(11) || rep_ + 1 < NREP(11)) GRID_BAR(); }
    for (int rep_ = 0; rep_ < NREP(13); ++rep_) if (IN(13)) { p_slots(args, lds, rep_); if (BOTH(13) || rep_ + 1 < NREP(13)) GRID_BAR(); }
    for (int rep_ = 0; rep_ < NREP(14); ++rep_) if (IN(14)) {
        pg8::Gemm g{(const f16*)args.out, (const f16*)(ws + WS_WGU), D, D, D, (const int*)(ws + WS_TOK + TK_STOK)};
        pg8::TableOrder S{(const int2*)(ctl + CW_UGU), (int)ctl[CW_NGU], G, (int)blockIdx.x};
        pg8::EpiSilu E{(f16*)(ws + WS_HID)}; pg8::gemm_phase<pg8::EpiSilu, pg8::TableOrder, true, true>(lds, g, S, E);
        if (BOTH(14) || rep_ + 1 < NREP(14)) GRID_BAR();
    }
    for (int rep_ = 0; rep_ < NREP(15); ++rep_) if (IN(15)) {
        pg8::Gemm g{(const f16*)(ws + WS_HID), (const f16*)(ws + WS_WD), EFF, EFF, EFF, nullptr};
        pg8::TableOrder S{(const int2*)(ctl + CW_UDN), (int)ctl[CW_NDN], G, (int)blockIdx.x};
        pg8::EpiDown E{ws}; pg8::gemm_phase<pg8::EpiDown, pg8::TableOrder, true>(lds, g, S, E);
        if (BOTH(15) || rep_ + 1 < NREP(15)) GRID_BAR();
    }
    for (int rep_ = 0; rep_ < NREP(16); ++rep_) if (IN(16)) {
        PH_IDS;
        const float* x2 = (const float*)(ws + WS_X1); const int* tks = (const int*)(ws + WS_TOK + TK_SLOT);
        const float* tkw = (const float*)(ws + WS_TOK + TK_W);
        for (int m = gw; m < T; m += NGW) { const int s1 = tks[m * 2], s2 = tks[m * 2 + 1]; const float w1 = tkw[m * 2], w2 = tkw[m * 2 + 1];
            const f16* y1 = (const f16*)(ws + ((s1 >> 8) < 128 ? WS_Y0 + (size_t)(s1 >> 8) * MiB : WS_Y1 + (size_t)((s1 >> 8) - 128) * MiB)) + (size_t)(s1 & 255) * D;
            const f16* y2 = (const f16*)(ws + ((s2 >> 8) < 128 ? WS_Y0 + (size_t)(s2 >> 8) * MiB : WS_Y1 + (size_t)((s2 >> 8) - 128) * MiB)) + (size_t)(s2 & 255) * D;
            const f32x4* xr = (const f32x4*)(x2 + (size_t)m * D) + lane; f32x4 v[8]; float s = 0.f;
#pragma unroll
            for (int j = 0; j < 8; ++j) { v[j] = xr[64 * j]; const f16x4 a1 = *((const f16x4*)y1 + lane + 64 * j), a2 = *((const f16x4*)y2 + lane + 64 * j);
                v[j].x += w1 * (float)a1.x + w2 * (float)a2.x; v[j].y += w1 * (float)a1.y + w2 * (float)a2.y; v[j].z += w1 * (float)a1.z + w2 * (float)a2.z; v[j].w += w1 * (float)a1.w + w2 * (float)a2.w;
                s += v[j].x * v[j].x + v[j].y * v[j].y + v[j].z * v[j].z + v[j].w * v[j].w; }
            const f32x4* gr = (const f32x4*)args.in[I_LNF] + lane; f32x4 gg[8];
#pragma unroll
            for (int j = 0; j < 8; ++j) gg[j] = gr[64 * j];
            const float rstd = rsqrtf(wave_sum(s) * (1.f / D) + EPS); f32x4* o = (f32x4*)(args.out + (size_t)m * D) + lane;
#pragma unroll
            for (int j = 0; j < 8; ++j) o[64 * j] = (f32x4){v[j].x * rstd * gg[j].x, v[j].y * rstd * gg[j].y, v[j].z * rstd * gg[j].z, v[j].w * rstd * gg[j].w}; }
    }
#undef IN
#undef BOTH
#undef GRID_BAR
}

extern "C" void kernel_launch(void* const* d_in, const int* in_sizes, int n_in, void* d_out, int out_size, void* d_ws, size_t ws_size, hipStream_t stream) {
    static int grid = 0;
    if (grid == 0) {
        if (n_in != 38 || out_size != T * D || ws_size < WS_END) { fprintf(stderr, "kernel_launch: unexpected shapes (n_in %d out %d ws %zu)\n", n_in, out_size, ws_size); grid = -1; return; }
        int dev = 0, cus = 0;
        if (hipGetDevice(&dev) != hipSuccess || hipDeviceGetAttribute(&cus, hipDeviceAttributeMultiprocessorCount, dev) != hipSuccess) { grid = -1; return; }
        if (hipFuncSetAttribute((const void*)mega, hipFuncAttributeMaxDynamicSharedMemorySize, LDS_BYTES) != hipSuccess) { grid = -1; return; }
        int per_cu = 0; (void)hipOccupancyMaxActiveBlocksPerMultiprocessor(&per_cu, (const void*)mega, 512, LDS_BYTES); (void)hipGetLastError();
        grid = cus;
    }
    if (grid < 0) return;
    (void)hipMemsetAsync((char*)d_ws + WS_CTL, 0, CTL_ZERO_BYTES, stream);
    Args a{};
    for (int i = 0; i < 38; ++i) a.in[i] = (const float*)d_in[i];
    a.out = (float*)d_out; a.ws = (unsigned char*)d_ws;
#if MK_ONE_LAUNCH
    a.ph_lo = 0; a.ph_hi = NPH;
    hipLaunchKernelGGL(mega, dim3(grid), dim3(512), LDS_BYTES, stream, a);
#else
    for (int p = 0; p < NPH; ++p) { a.ph_lo = p; a.ph_hi = p + 1; hipLaunchKernelGGL(mega, dim3(grid), dim3(512), LDS_BYTES, stream, a); }
#endif
}
```

```cpp
#include <hip/hip_runtime.h>
#include <cstdio>
#include <cstdint>

#ifndef DUPMASK
#define DUPMASK 0u
#endif
#ifndef NSA_SELREP
#define NSA_SELREP 1
#endif
#ifndef NSA_CMPREP
#define NSA_CMPREP 1
#endif
#ifndef NSA_WINREP
#define NSA_WINREP 1
#endif
#ifndef DUPX
#define DUPX 0
#endif
#ifndef MK_ONE_LAUNCH
#define MK_ONE_LAUNCH 1
#endif

#define LAS __attribute__((address_space(3)))
#define GAS __attribute__((address_space(1)))
typedef _Float16 f16;
typedef _Float16 f16x8 __attribute__((ext_vector_type(8)));
typedef _Float16 f16x4 __attribute__((ext_vector_type(4)));
typedef _Float16 f16x2 __attribute__((ext_vector_type(2)));
typedef float f32x4 __attribute__((ext_vector_type(4)));
typedef float f32x2 __attribute__((ext_vector_type(2)));
typedef unsigned u32x4 __attribute__((ext_vector_type(4)));
typedef unsigned u32x2 __attribute__((ext_vector_type(2)));
typedef __bf16 bf16;
typedef __bf16 bf16x8 __attribute__((ext_vector_type(8)));
typedef __bf16 bf16x4 __attribute__((ext_vector_type(4)));

constexpr int T = 16384, D = 2048, NZ = 6144;
constexpr int ZQ = 0, ZKC = 1024, ZVC = 1280, ZKS = 1536, ZVS = 1792, ZKW = 2048, ZVW = 2304, ZR = 2560, ZK = 3584, ZV = 4608, ZWD = 5632, ZAD = 5696, ZGD = 5760, ZGL = 5920;
constexpr int NCMP = 1023;
constexpr int NEXP = 32, EFF = 256, MAXSLOT = 40960, MAXTILES = 160;
constexpr float EPS = 1e-6f;

constexpr size_t MiB = 1u << 20;
constexpr size_t WS_CTL = 0, CTL_ZERO_BYTES = 192 * 1024, WS_ROWSS = 128 * 1024;
constexpr size_t WS_MEMN = 1 * MiB, WS_KM = 2 * MiB, WS_VM = 3 * MiB, WS_KCMP = 4 * MiB, WS_VCMP = 5 * MiB, WS_TOK = 6 * MiB, WS_CMPB = 7 * MiB;
constexpr size_t WS_WQK = 8 * MiB, WS_VOT = 12 * MiB, WS_WIN = 16 * MiB, WS_WOUT = 40 * MiB, WS_WQ16 = 48 * MiB, WS_WKT = 56 * MiB, WS_WVT = 64 * MiB, WS_WOT = 72 * MiB;
constexpr size_t WS_WGU = 80 * MiB, WS_WD = 144 * MiB, WS_H = 176 * MiB, WS_Z = 240 * MiB, WS_ONSA = 432 * MiB, WS_END = 512 * MiB;
constexpr size_t WS_MIX = 112 * MiB, WS_P = WS_H, WS_H2 = WS_Z, WS_X1 = 304 * MiB, WS_S = WS_ONSA, WS_HID = 16 * MiB;
constexpr size_t WS_Y0 = 176 * MiB, WS_Y1 = 432 * MiB;
constexpr size_t WS_RS = 200 * MiB, WS_SBON = 232 * MiB;
constexpr size_t WS_WUPT = WS_CMPB + 64 * 1024, WS_AUPT = WS_WUPT + 128 * 1024, WS_GUPT = WS_AUPT + 128 * 1024;
constexpr size_t WS_W1T = 496 * MiB, WS_W2T = 498 * MiB, WS_CBIAS = 498 * MiB + 65536;
constexpr size_t WS_WRH = 499 * MiB, WS_WRL = 499 * MiB + 256 * 1024;
constexpr size_t RO_M = 0, RO_N = 32 * MiB, RO_Q = 64 * MiB, RO_Y = 96 * MiB;
constexpr size_t TK_E = 0, TK_W = 128 * 1024, TK_SLOT = 256 * 1024, TK_STOK = 384 * 1024, TK_SW = 576 * 1024;
constexpr int CW_BAR = 0;
constexpr int CW_Q = 3584;
constexpr int CW_CNT = 4096, CW_CUR = 4160, CW_OFF = 4224, CW_NT = 4288  , CW_NGU = 4289, CW_NDN = 4290;
constexpr int CW_UGU = 6144  , CW_UDN = 8192  ;
static_assert((CW_UDN + MAXTILES * 8 * 2) * 4 <= (int)CTL_ZERO_BYTES, "ctl");

constexpr int RING_BYTES = 131072, LDS_BYTES = 163840, MISC_OFF = LDS_BYTES - 512;

__device__ __forceinline__ unsigned pkh(float a, float b) { f16x2 v = {(f16)a, (f16)b}; return __builtin_bit_cast(unsigned, v); }
__device__ __forceinline__ float wave_sum(float v) {
#pragma unroll
    for (int o = 1; o < 64; o <<= 1) v += __shfl_xor(v, o);
    return v;
}
__device__ __forceinline__ float wave_max(float v) {
#pragma unroll
    for (int o = 1; o < 64; o <<= 1) v = fmaxf(v, __shfl_xor(v, o));
    return v;
}
__device__ __forceinline__ int opaque_tid() { int t = threadIdx.x; asm volatile("" : "+v"(t)); return t; }
#define LDS_WAIT() asm volatile("s_waitcnt lgkmcnt(0)" ::: "memory")
#define VM_WAIT() asm volatile("s_waitcnt vmcnt(0)" ::: "memory")
__device__ __forceinline__ float sigmoidf_(float x) { return 1.f / (1.f + __expf(-x)); }

namespace pg8 {
constexpr int BM = 256, BK = 64, HALF = 128, HTB = HALF * BK * 2, STAGE_BYTES = 8 * HTB, NXCD = 8, WGM = 8;
__host__ __device__ __forceinline__ int lds_byte(int r, int c) { const int st = (r >> 4) * 2 + (c >> 5), rr = r & 15, cc = c & 31, ob = rr * 64 + cc * 2; return st * 1024 + (ob ^ (((ob >> 9) & 1) << 5)); }
__host__ __device__ __forceinline__ void stage_rc(int b, int& R, int& C) { const int st = b / 1024, sb = b % 1024, swz = sb ^ (((sb >> 9) & 1) << 5); R = (st >> 1) * 16 + swz / 64; C = (st & 1) * 32 + (swz % 64) / 2; }
__host__ __device__ __forceinline__ int perm32(int rho) { const int n = rho >> 4, i = rho & 15; return 8 * (i >> 2) + 4 * n + (i & 3); }

struct Unit { int pm, pn; };
struct Gemm { const f16* A; const f16* Bt; int lda, ldb, K; const int* gather; };

struct StaticOrder {
    int nM, nN, nwg, G, c;
    __host__ __device__ void init(int M, int N, int G_, int c_) { nM = M / BM; nN = N / BM; nwg = nM * nN; G = G_; c = c_; }
    __host__ __device__ bool next(int i, Unit& u) const {
        const long L = (long)i * G + c; if (L >= nwg) return false;
        int wgid = (int)L; { const int q = nwg / NXCD, r = nwg % NXCD, xcd = wgid % NXCD, off = wgid / NXCD; wgid = (xcd < r ? xcd * (q + 1) : r * (q + 1) + (xcd - r) * q) + off; }
        const int nig = WGM * nN, gid = wgid / nig, fm = gid * WGM, gsz = (nM - fm) < WGM ? (nM - fm) : WGM;
        u.pm = fm + ((wgid % nig) % gsz); u.pn = (wgid % nig) / gsz; return true;
    }
};
struct TableOrder {
    const int2* tab; int n, G, c;
    __device__ bool next(int i, Unit& u) const { const int L = i * G + c; if (L >= n) return false; const int2 v = tab[L]; u.pm = v.x; u.pn = v.y; return true; }
};

struct EpiF16 {
    static constexpr bool PERM = true;
    f16* O; int ldc; float scale;
    __device__ __forceinline__ void operator()(const f32x4 (&acc)[2][2][4][2], const Unit& u, int wr, int wc, int fr, int fq) const {
        const int row0 = u.pm * BM + wr * 64 + fr, col0 = u.pn * BM + wc * 32 + 8 * fq;
#pragma unroll
        for (int ai = 0; ai < 2; ++ai)
#pragma unroll
            for (int m = 0; m < 4; ++m) { f16* rowp = O + (size_t)(row0 + ai * HALF + m * 16) * ldc + col0;
#pragma unroll
                for (int bj = 0; bj < 2; ++bj) { const f32x4 v0 = acc[ai][bj][m][0] * scale, v1 = acc[ai][bj][m][1] * scale;
                    u32x4 w; w.x = pkh(v0[0], v0[1]); w.y = pkh(v0[2], v0[3]); w.z = pkh(v1[0], v1[1]); w.w = pkh(v1[2], v1[3]);
                    *(u32x4*)(rowp + bj * HALF) = w; } }
    }
};
struct EpiF32 {
    static constexpr bool PERM = false;
    float* C; const float* R; int ldc;
    __device__ __forceinline__ void operator()(const f32x4 (&acc)[2][2][4][2], const Unit& u, int wr, int wc, int fr, int fq) const {
        const int row0 = u.pm * BM + wr * 64 + fr, col0 = u.pn * BM + wc * 32 + 4 * fq;
#pragma unroll
        for (int ai = 0; ai < 2; ++ai)
#pragma unroll
            for (int m = 0; m < 4; ++m) { const size_t ro = (size_t)(row0 + ai * HALF + m * 16) * ldc + col0;
#pragma unroll
                for (int bj = 0; bj < 2; ++bj)
#pragma unroll
                    for (int n = 0; n < 2; ++n) { f32x4 v = acc[ai][bj][m][n]; if (R) v = v + *(const f32x4*)(R + ro + bj * HALF + n * 16); *(f32x4*)(C + ro + bj * HALF + n * 16) = v; } }
    }
};
struct EpiRes16 {
    static constexpr bool PERM = false;
    float* C; const float* R; f16* H; float* rowss; int ldc;
    __device__ __forceinline__ void operator()(const f32x4 (&acc)[2][2][4][2], const Unit& u, int wr, int wc, int fr, int fq) const {
        const int row0 = u.pm * BM + wr * 64 + fr, col0 = u.pn * BM + wc * 32 + 4 * fq;
#pragma unroll
        for (int ai = 0; ai < 2; ++ai)
#pragma unroll
            for (int m = 0; m < 4; ++m) { const int row = row0 + ai * HALF + m * 16; const size_t ro = (size_t)row * ldc + col0; float ss = 0.f;
                f32x4 v[2][2];
#pragma unroll
                for (int bj = 0; bj < 2; ++bj)
#pragma unroll
                    for (int n = 0; n < 2; ++n) v[bj][n] = acc[ai][bj][m][n] + *(const f32x4*)(R + ro + bj * HALF + n * 16);
#pragma unroll
                for (int bj = 0; bj < 2; ++bj)
#pragma unroll
                    for (int n = 0; n < 2; ++n) { const f32x4 x = v[bj][n]; *(f32x4*)(C + ro + bj * HALF + n * 16) = x; ss += x.x * x.x + x.y * x.y + x.z * x.z + x.w * x.w;
                        u32x2 hw; hw.x = pkh(x.x, x.y); hw.y = pkh(x.z, x.w); *(u32x2*)(H + ro + bj * HALF + n * 16) = hw; }
                ss += __shfl_xor(ss, 16); ss += __shfl_xor(ss, 32);
                if (fq == 0) atomicAdd(rowss + row, ss); }
    }
};
struct EpiSoftmax {
    static constexpr bool PERM = true;
    f16* O; int ldc; const float* rowss; LAS float* xm; LAS float* xs;
    __device__ __forceinline__ void operator()(const f32x4 (&acc)[2][2][4][2], const Unit& u, int wr, int wc, int fr, int fq) const {
        const int row0 = u.pm * BM + wr * 64 + fr, col0 = u.pn * BM + wc * 32 + 8 * fq;
        float rs[2][4], mx[2][4];
#pragma unroll
        for (int ai = 0; ai < 2; ++ai)
#pragma unroll
            for (int m = 0; m < 4; ++m) { rs[ai][m] = rsqrtf(rowss[row0 + ai * HALF + m * 16] * (1.f / D) + EPS); float v = -INFINITY;
#pragma unroll
                for (int bj = 0; bj < 2; ++bj)
#pragma unroll
                    for (int n = 0; n < 2; ++n)
#pragma unroll
                        for (int e = 0; e < 4; ++e) v = fmaxf(v, acc[ai][bj][m][n][e]);
                v *= rs[ai][m]; v = fmaxf(v, __shfl_xor(v, 16)); v = fmaxf(v, __shfl_xor(v, 32));
                if (fq == 0) xm[(ai * HALF + wr * 64 + m * 16 + fr) * 4 + wc] = v; }
        asm volatile("s_waitcnt lgkmcnt(0)" ::: "memory"); __builtin_amdgcn_s_barrier(); asm volatile("" ::: "memory");
        float e_[2][4][16]; float inv[2][4];
#pragma unroll
        for (int ai = 0; ai < 2; ++ai)
#pragma unroll
            for (int m = 0; m < 4; ++m) { const LAS f32x4* q = (const LAS f32x4*)(xm + (ai * HALF + wr * 64 + m * 16 + fr) * 4); const f32x4 mm = *q; mx[ai][m] = fmaxf(fmaxf(mm.x, mm.y), fmaxf(mm.z, mm.w)); float sm = 0.f;
#pragma unroll
                for (int bj = 0; bj < 2; ++bj)
#pragma unroll
                    for (int n = 0; n < 2; ++n)
#pragma unroll
                        for (int e = 0; e < 4; ++e) { const float ev = __expf(acc[ai][bj][m][n][e] * rs[ai][m] - mx[ai][m]); e_[ai][m][bj * 8 + n * 4 + e] = ev; sm += ev; }
                sm += __shfl_xor(sm, 16); sm += __shfl_xor(sm, 32);
                if (fq == 0) xs[(ai * HALF + wr * 64 + m * 16 + fr) * 4 + wc] = sm; }
        asm volatile("s_waitcnt lgkmcnt(0)" ::: "memory"); __builtin_amdgcn_s_barrier(); asm volatile("" ::: "memory");
#pragma unroll
        for (int ai = 0; ai < 2; ++ai)
#pragma unroll
            for (int m = 0; m < 4; ++m) { const f32x4 ssum = *(const LAS f32x4*)(xs + (ai * HALF + wr * 64 + m * 16 + fr) * 4); inv[ai][m] = 1.f / ((ssum.x + ssum.y) + (ssum.z + ssum.w));
                f16* rowp = O + (size_t)(row0 + ai * HALF + m * 16) * ldc + col0;
#pragma unroll
                for (int bj = 0; bj < 2; ++bj) { const float* ee = &e_[ai][m][bj * 8]; const float iv = inv[ai][m];
                    u32x4 w; w.x = pkh(ee[0] * iv, ee[1] * iv); w.y = pkh(ee[2] * iv, ee[3] * iv); w.z = pkh(ee[4] * iv, ee[5] * iv); w.w = pkh(ee[6] * iv, ee[7] * iv);
                    *(u32x4*)(rowp + bj * HALF) = w; } }
    }
};
struct EpiSilu {
    static constexpr bool PERM = true;
    f16* O;
    __device__ __forceinline__ void operator()(const f32x4 (&acc)[2][2][4][2], const Unit& u, int wr, int wc, int fr, int fq) const {
        const int row0 = u.pm * BM + wr * 64 + fr, col0 = (u.pn & 1) * 128 + wc * 32 + 8 * fq;
#pragma unroll
        for (int ai = 0; ai < 2; ++ai)
#pragma unroll
            for (int m = 0; m < 4; ++m) { f16* rowp = O + (size_t)(row0 + ai * HALF + m * 16) * EFF + col0;
                float h[8];
#pragma unroll
                for (int n = 0; n < 2; ++n)
#pragma unroll
                    for (int e = 0; e < 4; ++e) { const float gt = acc[ai][0][m][n][e], up = acc[ai][1][m][n][e]; h[n * 4 + e] = gt / (1.f + __expf(-gt)) * up; }
                u32x4 w; w.x = pkh(h[0], h[1]); w.y = pkh(h[2], h[3]); w.z = pkh(h[4], h[5]); w.w = pkh(h[6], h[7]);
                *(u32x4*)rowp = w; }
    }
};
struct EpiDown {
    static constexpr bool PERM = true;
    unsigned char* ws;
    __device__ __forceinline__ void operator()(const f32x4 (&acc)[2][2][4][2], const Unit& u, int wr, int wc, int fr, int fq) const {
        f16* tile = (f16*)(ws + (u.pm < 128 ? WS_Y0 + (size_t)u.pm * MiB : WS_Y1 + (size_t)(u.pm - 128) * MiB));
        const int r0 = wr * 64 + fr, col0 = (u.pn & 7) * BM + wc * 32 + 8 * fq;
#pragma unroll
        for (int ai = 0; ai < 2; ++ai)
#pragma unroll
            for (int m = 0; m < 4; ++m) { f16* rowp = tile + (size_t)(r0 + ai * HALF + m * 16) * D + col0;
#pragma unroll
                for (int bj = 0; bj < 2; ++bj) { const f32x4 v0 = acc[ai][bj][m][0], v1 = acc[ai][bj][m][1];
                    u32x4 w; w.x = pkh(v0[0], v0[1]); w.y = pkh(v0[2], v0[3]); w.z = pkh(v1[0], v1[1]); w.w = pkh(v1[2], v1[3]);
                    *(u32x4*)(rowp + bj * HALF) = w; } }
    }
};

template <class Epi, class Sched, bool ALIGN_EPI, bool GATHER = false>
__device__ __forceinline__ void gemm_phase(LAS unsigned char* lds, const Gemm g, const Sched& S, const Epi& E) {
    const int tid = opaque_tid(), wid = __builtin_amdgcn_readfirstlane(tid >> 6), lane = tid & 63, wr = wid >> 2, wc = wid & 3, fr = lane & 15, fq = lane >> 4;
    const int K = g.K, nt = K / BK;
    int RA[2], CA[2]; unsigned voffA[2], voffB[2];
#pragma unroll
    for (int i = 0; i < 2; ++i) { int R, C; stage_rc(tid * 16 + i * 8192, R, C); const int Rb = Epi::PERM ? ((R & ~31) + perm32(R & 31)) : R;
        RA[i] = R; CA[i] = C; voffA[i] = (unsigned)(R * g.lda + C) * 2u; voffB[i] = (unsigned)(Rb * g.ldb + C) * 2u; }
    const size_t kstep = (size_t)(BK * 2);
    const size_t hstepA = (size_t)HALF * g.lda * 2, tstepA = 2 * hstepA;
    const size_t hstepB = (size_t)HALF * g.ldb * 2, tstepB = 2 * hstepB;
    const unsigned ldsw = (unsigned)wid * 1024u;
    const int aoff = lds_byte(wr * 64 + fr, fq * 8), boff = lds_byte(wc * 32 + fr, fq * 8);
    const char* Ab = (const char*)g.A;
#define PG8_SA(b, h) (((b) * 2 + (h)) * HTB)
#define PG8_SB(b, h) ((4 + (b) * 2 + (h)) * HTB)
#define PG8_STAGE(bufoff, gbase, voff) do { _Pragma("unroll") for (int _i = 0; _i < 2; ++_i) \
        __builtin_amdgcn_global_load_lds((const unsigned*)((const char*)(gbase) + (voff)[_i]), (LAS unsigned*)(lds + (bufoff) + ldsw + _i * 8192), 16, 0, 0); } while (0)
#define PG8_STA_CUR(bufoff, h, kb) do { if constexpr (GATHER) { PG8_STAGE(bufoff, Ab + (kb), offC[h]); } else { PG8_STAGE(bufoff, cA + (h) * hstepA + (kb), voffA); } } while (0)
#define PG8_STA_SEL(bufoff, h, kb) do { if constexpr (GATHER) { PG8_STAGE(bufoff, Ab + (kb), o2[h]); } else { PG8_STAGE(bufoff, a2p + (h) * hstepA + (kb), voffA); } } while (0)
#define PG8_LDA(dst, b, h) do { _Pragma("unroll") for (int m = 0; m < 4; ++m) _Pragma("unroll") for (int k = 0; k < 2; ++k) dst[m][k] = *(const LAS f16x8*)(lds + PG8_SA(b, h) + aoff + m * 2048 + k * 1024); } while (0)
#define PG8_LDB(dst, b, h) do { _Pragma("unroll") for (int n = 0; n < 2; ++n) _Pragma("unroll") for (int k = 0; k < 2; ++k) dst[n][k] = *(const LAS f16x8*)(lds + PG8_SB(b, h) + boff + n * 2048 + k * 1024); } while (0)
#define PG8_MMA(ai, bj, At, Bt) do { __builtin_amdgcn_s_setprio(1); _Pragma("unroll") for (int m = 0; m < 4; ++m) _Pragma("unroll") for (int n = 0; n < 2; ++n) _Pragma("unroll") for (int k = 0; k < 2; ++k) \
        acc[ai][bj][m][n] = __builtin_amdgcn_mfma_f32_16x16x32_f16(Bt[n][k], At[m][k], acc[ai][bj][m][n], 0, 0, 0); __builtin_amdgcn_s_setprio(0); } while (0)
#define PG8_WAIT_V(n) asm volatile("s_waitcnt vmcnt(" #n ")" ::: "memory")
#define PG8_WAIT_L(n) asm volatile("s_waitcnt lgkmcnt(" #n ")" ::: "memory")
#define PG8_BAR __builtin_amdgcn_s_barrier()
#define PG8_SCHED __builtin_amdgcn_sched_barrier(0)
#define PG8_OFFS(dst, U) do { _Pragma("unroll") for (int _h = 0; _h < 2; ++_h) _Pragma("unroll") for (int _i = 0; _i < 2; ++_i) { \
        const int _r = (U).pm * BM + _h * HALF + RA[_i]; dst[_h][_i] = ((unsigned)g.gather[_r] * (unsigned)g.lda + (unsigned)CA[_i]) * 2u; } } while (0)
    Unit cur, nxt; int ui = 0;
    if (!S.next(0, cur)) return;
    f32x4 acc[2][2][4][2];
#pragma unroll
    for (int a = 0; a < 2; ++a)
#pragma unroll
        for (int b = 0; b < 2; ++b)
#pragma unroll
            for (int m = 0; m < 4; ++m)
#pragma unroll
                for (int n = 0; n < 2; ++n) acc[a][b][m][n] = (f32x4){0.f, 0.f, 0.f, 0.f};
    f16x8 At[4][2], B0[2][2], B1[2][2];
    unsigned offC[2][2], offN[2][2];
    if constexpr (GATHER) { PG8_OFFS(offC, cur); }
    const char* cA = Ab + (size_t)cur.pm * tstepA;
    const char* cB = (const char*)g.Bt + (size_t)cur.pn * tstepB;
    PG8_STAGE(PG8_SB(0, 0), cB, voffB); PG8_STAGE(PG8_SB(0, 1), cB + hstepB, voffB); PG8_STA_CUR(PG8_SA(0, 0), 0, 0); PG8_STA_CUR(PG8_SA(0, 1), 1, 0);
    if (wr == 1) PG8_BAR;
    PG8_WAIT_V(2); PG8_BAR;
    PG8_STAGE(PG8_SB(1, 0), cB + kstep, voffB); PG8_STA_CUR(PG8_SA(1, 0), 0, kstep); PG8_STAGE(PG8_SB(1, 1), cB + hstepB + kstep, voffB);
    PG8_WAIT_V(6); PG8_BAR;
    for (;;) {
        const bool has_next = S.next(ui + 1, nxt);
        if constexpr (GATHER) {
            if (has_next) { PG8_OFFS(offN, nxt); } else {
#pragma unroll
                for (int _h = 0; _h < 2; ++_h)
#pragma unroll
                    for (int _i = 0; _i < 2; ++_i) offN[_h][_i] = offC[_h][_i]; } }
        const char* nA = has_next ? Ab + (size_t)nxt.pm * tstepA : cA;
        const char* nB = has_next ? (const char*)g.Bt + (size_t)nxt.pn * tstepB : cB;
#pragma nounroll
        for (int t = 0; t < nt; t += 2) {
            const bool last = (t == nt - 2);
            const size_t kb1 = (size_t)(t + 1) * kstep;
            const size_t kb2 = last ? 0 : (size_t)(t + 2) * kstep, kb3 = kb2 + kstep;
            unsigned o2[2][2];
            if constexpr (GATHER) {
#pragma unroll
                for (int _h = 0; _h < 2; ++_h)
#pragma unroll
                    for (int _i = 0; _i < 2; ++_i) o2[_h][_i] = last ? offN[_h][_i] : offC[_h][_i]; }
            const char* a2p = last ? nA : cA;
            const char* b2 = last ? nB : cB + (size_t)(t + 2) * kstep; const char* b3 = b2 + kstep;
            PG8_LDB(B0, 0, 0); PG8_LDB(B1, 0, 1); PG8_SCHED; PG8_LDA(At, 0, 0); PG8_STA_CUR(PG8_SA(1, 1), 1, kb1);
            PG8_WAIT_V(8); PG8_WAIT_L(0); PG8_BAR; PG8_MMA(0, 0, At, B0); PG8_MMA(0, 1, At, B1); PG8_BAR; PG8_SCHED;
            PG8_LDA(At, 0, 1); PG8_STAGE(PG8_SB(0, 0), b2, voffB); PG8_STAGE(PG8_SB(0, 1), b2 + hstepB, voffB); PG8_STA_SEL(PG8_SA(0, 0), 0, kb2);
            PG8_WAIT_V(8); PG8_WAIT_L(0); PG8_BAR; PG8_MMA(1, 0, At, B0); PG8_MMA(1, 1, At, B1); PG8_BAR; PG8_SCHED;
            PG8_LDB(B0, 1, 0); PG8_LDB(B1, 1, 1); PG8_SCHED; PG8_LDA(At, 1, 0); PG8_STA_SEL(PG8_SA(0, 1), 1, kb2);
            PG8_WAIT_V(8); PG8_WAIT_L(0); PG8_BAR; PG8_MMA(0, 0, At, B0); PG8_MMA(0, 1, At, B1); PG8_BAR; PG8_SCHED;
            PG8_LDA(At, 1, 1); PG8_STAGE(PG8_SB(1, 0), b3, voffB); PG8_STAGE(PG8_SB(1, 1), b3 + hstepB, voffB); PG8_STA_SEL(PG8_SA(1, 0), 0, kb3);
            PG8_WAIT_V(8); PG8_WAIT_L(0); PG8_BAR; PG8_MMA(1, 0, At, B0); PG8_MMA(1, 1, At, B1); PG8_BAR; PG8_SCHED;
        }
        if constexpr (ALIGN_EPI) { if (wr == 0) PG8_BAR; }
        E(acc, cur, wr, wc, fr, fq);
        if (!has_next) break;
#pragma unroll
        for (int a = 0; a < 2; ++a)
#pragma unroll
            for (int b = 0; b < 2; ++b)
#pragma unroll
                for (int m = 0; m < 4; ++m)
#pragma unroll
                    for (int n = 0; n < 2; ++n) acc[a][b][m][n] = (f32x4){0.f, 0.f, 0.f, 0.f};
        cur = nxt; cA = nA; cB = nB; ++ui;
        if constexpr (GATHER) {
#pragma unroll
            for (int _h = 0; _h < 2; ++_h)
#pragma unroll
                for (int _i = 0; _i < 2; ++_i) offC[_h][_i] = offN[_h][_i]; }
        if constexpr (ALIGN_EPI) { if (wr == 1) PG8_BAR; }
    }
    PG8_WAIT_V(0);
    if constexpr (!ALIGN_EPI) { if (wr == 0) PG8_BAR; }
    PG8_BAR;
#undef PG8_SA
#undef PG8_SB
#undef PG8_STAGE
#undef PG8_STA_CUR
#undef PG8_STA_SEL
#undef PG8_LDA
#undef PG8_LDB
#undef PG8_MMA
#undef PG8_WAIT_V
#undef PG8_WAIT_L
#undef PG8_BAR
#undef PG8_SCHED
#undef PG8_OFFS
}
}

#define XB_TMO      128
#define XB_XCNT(j)  (256  + 64 * (j))
#define XB_XSUB(j)  (1280 + 64 * (j))
#define XB_XGEN(j)  (2304 + 64 * (j))
#define XB_TOP      3328
#define XB_TOPGEN   3392
#define XCD_BAR_WORDS 3456
#define XB_SPIN_CAP (1u << 22)
__device__ __forceinline__ unsigned xb_ld(unsigned* p)              { return __hip_atomic_load(p, __ATOMIC_RELAXED, __HIP_MEMORY_SCOPE_AGENT); }
__device__ __forceinline__ unsigned xb_add(unsigned* p, unsigned v) { return __hip_atomic_fetch_add(p, v, __ATOMIC_RELAXED, __HIP_MEMORY_SCOPE_AGENT); }
__device__ __forceinline__ unsigned xb_xcc_id() { return (unsigned)__builtin_amdgcn_s_getreg((3 << 11) | 20) & 0xFu; }
#define XB_SPIN(cond, bar) do { unsigned _sp = 0; while (cond) { __builtin_amdgcn_s_sleep(1); \
    if ((++_sp & 255u) == 0u) { if (xb_ld(&(bar)[XB_TMO])) break; if (_sp > XB_SPIN_CAP) { atomicAdd(&(bar)[XB_TMO], 1u); break; } } } } while (0)
struct XcdBarrier { unsigned* bar; unsigned x; volatile LAS unsigned* st; };
__device__ __forceinline__ XcdBarrier xcd_barrier_post(unsigned* bar, volatile LAS unsigned* st) {
    XcdBarrier b; b.bar = bar; b.x = xb_xcc_id(); b.st = st;
    if (threadIdx.x == 0) (void)xb_add(&bar[XB_XCNT(b.x)], 1u);
    return b;
}
__device__ __forceinline__ void xcd_barrier_complete(unsigned* bar, unsigned x, unsigned& nloc, unsigned& nx) {
    const unsigned G = gridDim.x * gridDim.y * gridDim.z;
    unsigned sum, cnt, mine, sp = 0u;
    for (;;) {
        sum = 0u; cnt = 0u; mine = 0u;
#pragma unroll
        for (unsigned j = 0; j < 16; ++j) { const unsigned c = xb_ld(&bar[XB_XCNT(j)]); sum += c; cnt += (c > 0u) ? 1u : 0u; mine = (j == x) ? c : mine; }
        if (sum == G) break;
        __builtin_amdgcn_s_sleep(1);
        if ((++sp & 255u) == 0u) { if (xb_ld(&bar[XB_TMO])) break; if (sp > XB_SPIN_CAP) { atomicAdd(&bar[XB_TMO], 1u); break; } }
    }
    nloc = mine > 0u ? mine : 1u; nx = cnt > 0u ? cnt : 1u;
}
__device__ __forceinline__ void xcd_barrier(const XcdBarrier& b) {
    asm volatile("s_waitcnt vmcnt(0)" ::: "memory");
    __syncthreads();
    if (threadIdx.x == 0) {
        unsigned* bar = b.bar;
        __builtin_amdgcn_s_waitcnt(0);
        unsigned nloc = b.st[0], nx = b.st[1];
        if (nloc == 0u) { xcd_barrier_complete(bar, b.x, nloc, nx); b.st[0] = nloc; b.st[1] = nx; }
        const unsigned old = xb_add(&bar[XB_XSUB(b.x)], 1u);
        const unsigned gen = old / nloc;
        if (old + 1u == (gen + 1u) * nloc) {
            __builtin_amdgcn_fence(__ATOMIC_RELEASE, "agent");
            asm volatile("s_waitcnt vmcnt(0)" ::: "memory");
            const unsigned og = xb_add(&bar[XB_TOP], 1u);
            const unsigned tg = og / nx;
            if (og + 1u == (tg + 1u) * nx) xb_add(&bar[XB_TOPGEN], 1u);
            else XB_SPIN(xb_ld(&bar[XB_TOPGEN]) == tg, bar);
            __builtin_amdgcn_fence(__ATOMIC_ACQUIRE, "agent");
            xb_add(&bar[XB_XGEN(b.x)], 1u);
            asm volatile("s_waitcnt vmcnt(0)" ::: "memory");
        } else {
            XB_SPIN(xb_ld(&bar[XB_XGEN(b.x)]) == gen, bar);
            __builtin_amdgcn_fence(__ATOMIC_ACQUIRE, "agent");
            asm volatile("s_waitcnt vmcnt(0)" ::: "memory");
        }
    }
    __syncthreads();
}

struct Args { const float* in[38]; float* out; unsigned char* ws; int ph_lo, ph_hi; };
enum { I_X = 0, I_MEM, I_LN1, I_WIN, I_PK, I_W1K, I_W2K, I_PV, I_W1V, I_W2V, I_NSAG, I_MU, I_W0, I_WUP, I_A0, I_AUP, I_GUP, I_KK, I_KA, I_RK, I_LNXG, I_LNXB,
       I_WOUT, I_LNMEM, I_LN2, I_WQ, I_WK, I_WV, I_WO, I_LN3, I_RGW, I_RGB, I_REW, I_REB, I_MG, I_MU2, I_MD, I_LNF };

struct TrItem { float tv[32]; f16* dst; size_t drow0; int dld, k0; };
__device__ __forceinline__ void tr_load(TrItem& it, const float* src, int sld, int k0, int scol0, int nvalid, f16* dst, size_t drow0, int dld, int lane) {
    const int nl = lane & 31; it.dst = dst; it.drow0 = drow0; it.dld = dld; it.k0 = k0;
#pragma unroll
    for (int i = 0; i < 32; ++i) { const int kk = 2 * i + (lane >> 5); it.tv[i] = (nl < nvalid) ? src[(size_t)(k0 + kk) * sld + scol0 + nl] : 0.f; }
}
__device__ __forceinline__ void tr_finish(const TrItem& it, LAS float* scr, int lane) {
    const int nl = lane & 31;
#pragma unroll
    for (int i = 0; i < 32; ++i) { const int kk = 2 * i + (lane >> 5); scr[kk * 33 + nl] = it.tv[i]; }
    LDS_WAIT(); asm volatile("" ::: "memory");
    const int c = lane & 7;
#pragma unroll
    for (int j = 0; j < 4; ++j) { const int n = (lane >> 3) + 8 * j; const LAS float* s = scr + (8 * c) * 33 + n;
        u32x4 o; o.x = pkh(s[0 * 33], s[1 * 33]); o.y = pkh(s[2 * 33], s[3 * 33]); o.z = pkh(s[4 * 33], s[5 * 33]); o.w = pkh(s[6 * 33], s[7 * 33]);
        *(u32x4*)(it.dst + (it.drow0 + n) * (size_t)it.dld + it.k0 + 8 * c) = o; }
    LDS_WAIT(); asm volatile("" ::: "memory");
}
__device__ __forceinline__ void tr_item(const float* src, int sld, int k0, int scol0, int nvalid, f16* dst, size_t drow0, int dld, LAS float* scr, int lane) {
    TrItem it; tr_load(it, src, sld, k0, scol0, nvalid, dst, drow0, dld, lane); tr_finish(it, scr, lane);
}
__device__ __forceinline__ void tr_matrix(const float* src, int K, int N, f16* dst, LAS float* scr, int gw, int NGW, int lane) {
    const int nblk = N / 32, items = (K / 64) * nblk;
    for (int it = gw; it < items; it += 2 * NGW) { TrItem a, b; const int it2 = it + NGW; const bool two = it2 < items;
        tr_load(a, src, N, (it / nblk) * 64, (it % nblk) * 32, 32, dst, (size_t)(it % nblk) * 32, K, lane);
        if (two) tr_load(b, src, N, (it2 / nblk) * 64, (it2 % nblk) * 32, 32, dst, (size_t)(it2 % nblk) * 32, K, lane);
        tr_finish(a, scr, lane); if (two) tr_finish(b, scr, lane); }
}
__device__ __forceinline__ void rms_row(const float* xrow, const float* gain, f16* o16, int lane) {
    const f32x4* xr = (const f32x4*)xrow + lane; f32x4 v[8]; float s = 0.f;
#pragma unroll
    for (int j = 0; j < 8; ++j) { v[j] = xr[64 * j]; s += v[j].x * v[j].x + v[j].y * v[j].y + v[j].z * v[j].z + v[j].w * v[j].w; }
    const f32x4* gr = (const f32x4*)gain + lane; f32x4 gg[8];
#pragma unroll
    for (int j = 0; j < 8; ++j) gg[j] = gr[64 * j];
    const float rstd = rsqrtf(wave_sum(s) * (1.f / D) + EPS);
    u32x2* o8 = (u32x2*)o16 + lane;
#pragma unroll
    for (int j = 0; j < 8; ++j) { u32x2 w; w.x = pkh(v[j].x * rstd * gg[j].x, v[j].y * rstd * gg[j].y); w.y = pkh(v[j].z * rstd * gg[j].z, v[j].w * rstd * gg[j].w); o8[64 * j] = w; }
}

__device__ __forceinline__ void p0_prologue(const Args& a, LAS unsigned char* lds) {
    const int tid = opaque_tid(), lane = tid & 63, wave = tid >> 6;
    const int gw = blockIdx.x * 8 + wave, NGW = gridDim.x * 8;
    LAS float* scr = (LAS float*)(lds + wave * 16384);
    unsigned char* ws = a.ws;
    { f16* dst = (f16*)(ws + WS_WIN); const float* src = a.in[I_WIN];
      const int nblk = NZ / 32, items = (D / 64) * nblk;
      for (int it0 = gw; it0 < items; it0 += 2 * NGW) { TrItem ta, tb; const bool two = it0 + NGW < items;
#pragma unroll
          for (int q = 0; q < 2; ++q) { if (q == 1 && !two) break; const int it = it0 + q * NGW; const int kb = it / nblk, nb = it % nblk, n0 = nb * 32;
              int sc = 0, nv = 32; if (n0 < 2560) sc = n0; else if (n0 < 5920) sc = n0 + 24; else if (n0 == 5920) { sc = 2560; nv = 24; } else { sc = 0; nv = 0; }
              tr_load(q ? tb : ta, src, 5944, kb * 64, sc, nv, dst, (size_t)n0, D, lane); }
          tr_finish(ta, scr, lane); if (two) tr_finish(tb, scr, lane); } }
    tr_matrix(a.in[I_WOUT], D, D, (f16*)(ws + WS_WOUT), scr, gw, NGW, lane);
    tr_matrix(a.in[I_WK], D, D, (f16*)(ws + WS_WKT), scr, gw, NGW, lane);
    tr_matrix(a.in[I_WV], D, D, (f16*)(ws + WS_WVT), scr, gw, NGW, lane);
    tr_matrix(a.in[I_WO], D, D, (f16*)(ws + WS_WOT), scr, gw, NGW, lane);
    { const f32x4* s = (const f32x4*)a.in[I_WQ]; u32x2* d = (u32x2*)(ws + WS_WQ16);
      for (size_t i = (size_t)blockIdx.x * 512 + tid; i < (size_t)D * D / 4; i += (size_t)gridDim.x * 512) { const f32x4 v = s[i]; const float gsc = a.in[I_LN2][i / (D / 4)]; u32x2 w; w.x = pkh(v.x * gsc, v.y * gsc); w.y = pkh(v.z * gsc, v.w * gsc); d[i] = w; } }
    tr_matrix(a.in[I_W1K], 4096, 128, (f16*)(ws + WS_W1T), scr, gw, NGW, lane);
    tr_matrix(a.in[I_W1V], 4096, 128, (f16*)(ws + WS_W1T) + 128 * 4096, scr, gw, NGW, lane);
    tr_matrix(a.in[I_W2K], 128, 128, (f16*)(ws + WS_W2T), scr, gw, NGW, lane);
    tr_matrix(a.in[I_W2V], 128, 128, (f16*)(ws + WS_W2T) + 128 * 128, scr, gw, NGW, lane);
    for (int o = gw; o < 256; o += NGW) { const int kv = o >> 7, n = o & 127; const float* pos = a.in[kv ? I_PV : I_PK]; const float* w1 = a.in[kv ? I_W1V : I_W1K]; float acc = 0.f;
        for (int k = lane; k < 4096; k += 64) acc += pos[k] * w1[(size_t)k * 128 + n];
        acc = wave_sum(acc); if (lane == 0) ((float*)(ws + WS_CBIAS))[o] = acc; }
    for (int i = blockIdx.x * 512 + tid; i < 48 * D; i += gridDim.x * 512) { const int c = i / D, k = i % D; float v = 0.f;
        if (c < 4) v = a.in[I_RGW][k * 4 + c]; else if (c < 36) v = a.in[I_REW][k * 32 + (c - 4)];
        v *= a.in[I_LN3][k]; const f16 hi = (f16)v; ((f16*)(ws + WS_WRH))[i] = hi; ((f16*)(ws + WS_WRL))[i] = (f16)(v - (float)hi); }
    { bf16* wu = (bf16*)(ws + WS_WUPT); bf16* au = (bf16*)(ws + WS_AUPT); bf16* gu = (bf16*)(ws + WS_GUPT);
      for (int i = blockIdx.x * 512 + tid; i < 1024 * 64; i += gridDim.x * 512) { const int ch = i >> 6, j = i & 63; wu[i] = (bf16)a.in[I_WUP][j * 1024 + ch]; au[i] = (bf16)a.in[I_AUP][j * 1024 + ch]; }
      for (int i = blockIdx.x * 512 + tid; i < 1024 * 160; i += gridDim.x * 512) { const int ch = i / 160, j = i % 160; gu[i] = (bf16)a.in[I_GUP][j * 1024 + ch]; } }
    for (int m = gw; m < T; m += NGW) rms_row(a.in[I_X] + (size_t)m * D, a.in[I_LN1], (f16*)(ws + WS_H) + (size_t)m * D, lane);
    for (int m = gw; m < 256; m += NGW) rms_row(a.in[I_MEM] + (size_t)m * D, a.in[I_LNMEM], (f16*)(ws + WS_MEMN) + (size_t)m * D, lane);
}

__device__ __forceinline__ void p_moe_weights(const Args& a, LAS unsigned char* lds) {
    const int tid = opaque_tid(), lane = tid & 63, wave = tid >> 6;
    const int gw = blockIdx.x * 8 + wave, NGW = gridDim.x * 8;
    LAS float* scr = (LAS float*)(lds + wave * 16384);
    unsigned char* ws = a.ws;
    { f16* dst = (f16*)(ws + WS_WGU); const int items = NEXP * (D / 64) * 16;
      for (int it = gw; it < items; it += NGW) { const int e = it / ((D / 64) * 16), r = it % ((D / 64) * 16), kb = r / 16, nb = r % 16, j0 = nb * 32, jt = j0 / 256, jj = j0 % 256;
          const float* src = (jj < 128 ? a.in[I_MG] : a.in[I_MU2]) + (size_t)e * D * EFF; const int sc = jt * 128 + (jj & 127);
          tr_item(src, EFF, kb * 64, sc, 32, dst, (size_t)e * 512 + j0, D, scr, lane); } }
    { f16* dst = (f16*)(ws + WS_WD); const int items = NEXP * (EFF / 64) * (D / 32);
      for (int it = gw; it < items; it += NGW) { const int e = it / ((EFF / 64) * (D / 32)), r = it % ((EFF / 64) * (D / 32)), kb = r / (D / 32), nb = r % (D / 32);
          tr_item(a.in[I_MD] + (size_t)e * EFF * D, D, kb * 64, nb * 32, 32, dst, (size_t)e * D + nb * 32, EFF, scr, lane); } }
}

__device__ __forceinline__ float gelu_tanh(float x) { const float u = 0.7978845608028654f * (x + 0.044715f * x * x * x); const float e = __expf(2.f * u); return 0.5f * x * (2.f - 2.f / (e + 1.f)); }
constexpr int CP_RS = 272, CP_HS = 136, CP_HID = 272 * CP_RS;
__device__ __forceinline__ void p_compress(const Args& a, LAS unsigned char* lds) {
    const int tid = opaque_tid(), lane = tid & 63, w = __builtin_amdgcn_readfirstlane(tid >> 6);
    const f16* z = (const f16*)(a.ws + WS_Z);
    LAS f16* HID = (LAS f16*)(lds + CP_HID);
    for (int it = blockIdx.x; it < 256; it += gridDim.x) {
        const int kv = it >> 7, g = (it >> 6) & 1, c0 = (it & 63) * 16, tok0 = 16 * c0;
        const int zc = (kv ? ZVC : ZKC) + g * 128;
        __syncthreads();
        for (int ck = tid; ck < 272 * 16; ck += 512) { const int tl = ck >> 4, c16 = ck & 15, tok = tok0 + tl; const int rp = (tl & 15) * 17 + (tl >> 4);
            u32x4 v = {0u, 0u, 0u, 0u}; if (tok < T) v = *(const u32x4*)(z + (size_t)tok * NZ + zc + c16 * 8);
            *(LAS u32x4*)(lds + rp * CP_RS + c16 * 16) = v; }
        __syncthreads();
        f32x4 acc = {0.f, 0.f, 0.f, 0.f};
        const f16* wp = (const f16*)(a.ws + WS_W1T) + ((size_t)kv * 128 + 16 * w + (lane & 15)) * 4096 + 8 * (lane >> 4);
        const LAS unsigned char* ap = lds + (lane & 15) * CP_RS + 16 * (lane >> 4);
#pragma unroll 8
        for (int ks = 0; ks < 128; ++ks) { const int l = ks >> 2;
            const f16x8 av = *(const LAS f16x8*)(ap + ((l & 15) * 17 + (l >> 4)) * CP_RS + (ks & 3) * 64);
            const f16x8 bv = *(const f16x8*)(wp + 32 * ks);
            acc = __builtin_amdgcn_mfma_f32_16x16x32_f16(av, bv, acc, 0, 0, 0); }
        { const int n = 16 * w + (lane & 15); const float bs = ((const float*)(a.ws + WS_CBIAS))[kv * 128 + n];
#pragma unroll
          for (int r = 0; r < 4; ++r) HID[(4 * (lane >> 4) + r) * CP_HS + n] = (f16)gelu_tanh(acc[r] + bs); }
        __syncthreads();
        f32x4 o = {0.f, 0.f, 0.f, 0.f};
        const f16* w2p = (const f16*)(a.ws + WS_W2T) + ((size_t)kv * 128 + 16 * w + (lane & 15)) * 128 + 8 * (lane >> 4);
#pragma unroll
        for (int ks = 0; ks < 4; ++ks) { const f16x8 av = *(const LAS f16x8*)(HID + (lane & 15) * CP_HS + 32 * ks + 8 * (lane >> 4)); const f16x8 bv = *(const f16x8*)(w2p + 32 * ks);
            o = __builtin_amdgcn_mfma_f32_16x16x32_f16(av, bv, o, 0, 0, 0); }
        f16* dst = (f16*)(a.ws + (kv ? WS_VCMP : WS_KCMP));
#pragma unroll
        for (int r = 0; r < 4; ++r) { const int c = c0 + 4 * (lane >> 4) + r; dst[((size_t)c * 2 + g) * 128 + 16 * w + (lane & 15)] = c < NCMP ? (f16)o[r] : (f16)0.f; }
    }
}

typedef float f32x16 __attribute__((ext_vector_type(16)));
typedef short v4i16_t __attribute__((ext_vector_type(4)));
constexpr int NS_PSEL = 65536, NS_PSTR = 257, NS_SELB = NS_PSEL + 64 * NS_PSTR * 4, NS_WANY = NS_SELB + 2048, NS_LIST = NS_WANY + 256, NS_CNT = NS_LIST + 512, NS_UNIT = NS_CNT + 64;
static_assert(NS_UNIT + 64 <= MISC_OFF, "nsa lds");
__device__ __forceinline__ unsigned offb(unsigned row, unsigned ch) { return 256u * row + 16u * (ch ^ (((row & 3u) << 2) | ((row >> 2) & 3u))); }
__device__ __forceinline__ void glds16(const void* gsrc, unsigned lds_dst) { unsigned keep;
    asm volatile("s_mov_b32 %0, m0\n\ts_mov_b32 m0, %2\n\ts_nop 0\n\tglobal_load_lds_dwordx4 %1, off\n\ts_mov_b32 m0, %0" : "=&s"(keep) : "v"(gsrc), "s"(lds_dst) : "memory"); }
__device__ __forceinline__ void ns_dma(const f16* g0, const unsigned (&doff)[2], unsigned lds_addr, int wv) {
#pragma unroll
    for (int i = 0; i < 2; ++i) glds16(g0 + doff[i], lds_addr + (wv * 2 + i) * 1024);
}
#define NS_VMW(n) asm volatile("s_waitcnt vmcnt(" #n ")" ::: "memory")
__device__ __forceinline__ void ns_qk(f32x16& s0, f32x16& s1, const LAS unsigned char* kb, const f16x8 (&qf)[8], int rho_, int hh_, float init) {
    unsigned rho = (unsigned)rho_, hh = (unsigned)hh_;
    asm volatile("" : "+v"(rho), "+v"(hh));
    const unsigned xr = ((rho & 3u) << 2) | ((rho >> 2) & 3u);
    const LAS unsigned char* kbase = kb + 256u * rho + 16u * ((hh ^ xr) & 1u); const unsigned xs = xr >> 1;
#pragma unroll
    for (int i = 0; i < 16; ++i) { s0[i] = init; s1[i] = init; }
    f16x8 af[8];
#pragma unroll
    for (int s = 0; s < 8; ++s) af[s] = *(const LAS f16x8*)(kbase + 32u * ((unsigned)s ^ xs));
#pragma unroll
    for (int s = 0; s < 8; ++s) s0 = __builtin_amdgcn_mfma_f32_32x32x16_f16(af[s], qf[s], s0, 0, 0, 0);
#pragma unroll
    for (int s = 0; s < 8; ++s) af[s] = *(const LAS f16x8*)(kbase + 32u * ((unsigned)s ^ xs) + 8192);
#pragma unroll
    for (int s = 0; s < 8; ++s) s1 = __builtin_amdgcn_mfma_f32_32x32x16_f16(af[s], qf[s], s1, 0, 0, 0);
}
__device__ __forceinline__ void ns_pv(f32x16 (&O)[4], const LAS unsigned char* vb, const f32x16& p0, const f32x16& p1, int lane_) {
    unsigned lane = (unsigned)lane_;
    asm volatile("" : "+v"(lane));
    const unsigned hh = lane >> 5, blk = (lane >> 4) & 1, q = (lane & 15) >> 2, pp = lane & 3;
    const unsigned x = 2 * blk + (pp >> 1);
    const LAS unsigned char* vbase[2];
#pragma unroll
    for (int t = 0; t < 2; ++t) { const unsigned w = (hh + 2 * t) & 3u; vbase[t] = vb + 256u * (4 * hh + 8 * t + q) + 16u * (x ^ w) + 8u * (pp & 1); }
    f16x8 pf[4];
#pragma unroll
    for (int kh = 0; kh < 2; ++kh)
#pragma unroll
        for (int sp = 0; sp < 2; ++sp)
#pragma unroll
            for (int j = 0; j < 8; ++j) pf[kh * 2 + sp][j] = (f16)(kh ? p1[8 * sp + j] : p0[8 * sp + j]);
#pragma unroll
    for (int c = 0; c < 4; ++c) { const unsigned cq = 64u * ((unsigned)c ^ q);
        const LAS unsigned char* b0 = vbase[0] + cq; const LAS unsigned char* b1 = vbase[1] + cq;
#pragma unroll
        for (int kh = 0; kh < 2; ++kh)
#pragma unroll
            for (int sp = 0; sp < 2; ++sp) {
                const v4i16_t lo = __builtin_amdgcn_ds_read_tr16_b64_v4i16((LAS v4i16_t*)(b0 + 256 * (32 * kh + 16 * sp)));
                const v4i16_t hi = __builtin_amdgcn_ds_read_tr16_b64_v4i16((LAS v4i16_t*)(b1 + 256 * (32 * kh + 16 * sp)));
                typedef short s16x8 __attribute__((ext_vector_type(8)));
                const s16x8 v8 = {lo[0], lo[1], lo[2], lo[3], hi[0], hi[1], hi[2], hi[3]};
                O[c] = __builtin_amdgcn_mfma_f32_32x32x16_f16(__builtin_bit_cast(f16x8, v8), pf[kh * 2 + sp], O[c], 0, 0, 0); }
    }
}
#define NS_KIDX(r, hh) ((int)(((r) & 3) + 8 * ((r) >> 2) + 4 * (hh)))
constexpr float NS_THR = 6.f;
template <bool WITH_O> __device__ __forceinline__ void ns_online(f32x16& y0, f32x16& y1, float& m, float& l, bool& seen, f32x16 (&O)[4]) {
    float mx = fmaxf(y0[0], y1[0]);
#pragma unroll
    for (int i = 1; i < 16; ++i) mx = fmaxf(mx, fmaxf(y0[i], y1[i]));
    mx = fmaxf(mx, __shfl_xor(mx, 32));
    const bool fin = mx > -INFINITY, first = !seen && fin;
    if (__any(first || mx > NS_THR)) {
        const float d = first ? mx : (mx > NS_THR ? mx : 0.f), alpha = __builtin_amdgcn_exp2f(-d);
        seen = seen || fin; m += d; l *= alpha;
        if (WITH_O) {
#pragma unroll
            for (int c = 0; c < 4; ++c) O[c] = O[c] * alpha; }
#pragma unroll
        for (int i = 0; i < 16; ++i) { y0[i] -= d; y1[i] -= d; }
    }
    float ls = 0.f;
#pragma unroll
    for (int i = 0; i < 16; ++i) { y0[i] = __builtin_amdgcn_exp2f(y0[i]); y1[i] = __builtin_amdgcn_exp2f(y1[i]); ls += y0[i] + y1[i]; }
    l += ls;
}
#define NS_ISSUE(j, NSL, HASV) do { const unsigned sa_ = lds_a + (unsigned)(((j) & ((NSL) - 1)) * 32768); ns_dma(NS_KPTR(j), NS_DOFF, sa_, w); if (HASV) ns_dma(NS_VPTR(j), NS_DOFF, sa_ + 16384u, w); } while (0)
#define NS_WAIT(nb, HASV) do { if (HASV) { if ((nb) >= 2) NS_VMW(8); else if ((nb) == 1) NS_VMW(4); else NS_VMW(0); } else { if ((nb) >= 2) NS_VMW(4); else if ((nb) == 1) NS_VMW(2); else NS_VMW(0); } } while (0)
#define NS_PROLOGUE(n, NSL, HASV) do { const int q_ = (n) < (NSL) - 1 ? (n) : (NSL) - 1; for (int j_ = 0; j_ < q_; ++j_) NS_ISSUE(j_, NSL, HASV); NS_WAIT(q_ - 1, HASV); __syncthreads(); } while (0)
#define NS_STEP_BEGIN(i, n, NSL, HASV) do { if ((i) + (NSL) - 1 < (n)) NS_ISSUE((i) + (NSL) - 1, NSL, HASV); } while (0)
#define NS_STEP_END(i, n, NSL, HASV) do { int nb_ = ((n) - 1 < (i) + (NSL) - 1 ? (n) - 1 : (i) + (NSL) - 1) - ((i) + 1); NS_WAIT(nb_, HASV); __syncthreads(); } while (0)
#define NS_KB(i, NSL) (lds + (((i) & ((NSL) - 1)) * 32768))
#define NS_VB(i, NSL) (lds + (((i) & ((NSL) - 1)) * 32768) + 16384)
__device__ __forceinline__ void p_nsa(const Args& a, LAS unsigned char* lds, int rep) {
    const int tid = opaque_tid(), lane = tid & 63, w = __builtin_amdgcn_readfirstlane(tid >> 6), rho = lane & 31, hh = lane >> 5, ql = rho >> 2, p = rho & 3;
    const unsigned lds_a = (unsigned)__builtin_amdgcn_readfirstlane((int)(unsigned)(size_t)lds);
    const f16* z = (const f16*)(a.ws + WS_Z); const f16* kcmp = (const f16*)(a.ws + WS_KCMP); const f16* vcmp = (const f16*)(a.ws + WS_VCMP);
    float* onsa = (float*)(a.ws + WS_ONSA); unsigned* ctl = (unsigned*)(a.ws + WS_CTL);
    LAS float* psel = (LAS float*)(lds + NS_PSEL); LAS unsigned* selb = (LAS unsigned*)(lds + NS_SELB); LAS unsigned* wany = (LAS unsigned*)(lds + NS_WANY);
    LAS unsigned char* list = lds + NS_LIST; LAS int* cnt = (LAS int*)(lds + NS_CNT); LAS int* unit_s = (LAS int*)(lds + NS_UNIT);
    const float c2 = 0.08838834764831845f * 1.4426950408889634f;
    unsigned doff_c[2], doff_z[2];
#pragma unroll
    for (int i = 0; i < 2; ++i) { const int piece = w * 2 + i, row = 4 * piece + (lane >> 4), ch = (lane & 15) ^ (((row & 3) << 2) | ((row >> 2) & 3)); doff_c[i] = (unsigned)(row * 256 + ch * 8); doff_z[i] = (unsigned)(row * NZ + ch * 8); }
    for (;;) {
        __syncthreads();
        if (tid == 0) unit_s[0] = (int)atomicAdd(&ctl[CW_Q + rep], 1u);
        __syncthreads();
        const int u = unit_s[0]; if (u >= 512) break;
        const int blk = 255 - (u >> 1), g = u & 1, t0 = blk * 64, tq = t0 + 8 * w + ql, hq = g * 4 + p;
        f16x8 qf[8];
        { const f16* qrow = z + (size_t)tq * NZ + ZQ + hq * 128 + 8 * hh;
#pragma unroll
          for (int s = 0; s < 8; ++s) { const f16x8 q8 = *(const f16x8*)(qrow + 16 * s);
#pragma unroll
              for (int j = 0; j < 8; ++j) qf[s][j] = (f16)((float)q8[j] * c2); } }
        const f16* zrow = z + (size_t)tq * NZ;
        const float gate_c = sigmoidf_((float)zrow[ZGL + hq]), gate_s = sigmoidf_((float)zrow[ZGL + 8 + hq]), gate_w = sigmoidf_((float)zrow[ZGL + 16 + hq]);
        f32x16 O[4];
        float* orow = onsa + (size_t)tq * 1024 + hq * 128 + 4 * hh;
#pragma unroll
        for (int c = 0; c < 4; ++c)
#pragma unroll
            for (int i = 0; i < 16; ++i) O[c][i] = 0.f;
        const int cmax = tq >= 31 ? (tq - 31) >> 4 : -1;
        const int ntc = (4 * blk + 3 + 63) >> 6;
        float m = 0.f, l = 0.f; bool seen = false;
        const int cmin_w = (t0 + 8 * w) >= 31 ? (t0 + 8 * w - 31) >> 4 : -1;
#define NS_KPTR(j) (kcmp + ((size_t)(64 * (j)) * 2 + g) * 128)
#define NS_VPTR(j) (vcmp + ((size_t)(64 * (j)) * 2 + g) * 128)
#define NS_DOFF doff_c
        { const int npc = (ntc + 1) >> 1;
#define NS_ISSUE_KPAIR(ip) do { const unsigned sa_ = lds_a + (unsigned)(((ip) & 1) * 65536); const int j0_ = 2 * (ip); ns_dma(NS_KPTR(j0_), NS_DOFF, sa_, w); if (j0_ + 1 < ntc) ns_dma(NS_KPTR(j0_ + 1), NS_DOFF, sa_ + 32768u, w); } while (0)
          NS_ISSUE_KPAIR(0); NS_VMW(0); __syncthreads();
          for (int ip = 0; ip < npc; ++ip) {
              if (ip + 1 < npc) NS_ISSUE_KPAIR(ip + 1);
#pragma unroll
              for (int hb = 0; hb < 2; ++hb) { const int i = 2 * ip + hb;
                  if (i < ntc) {
                      f32x16 x0, x1; ns_qk(x0, x1, lds + (ip & 1) * 65536 + hb * 32768, qf, rho, hh, -m);
                      if (64 * i + 63 > cmin_w) {
#pragma unroll
                          for (int r = 0; r < 16; ++r) { const int c0 = 64 * i + NS_KIDX(r, hh); x0[r] = (c0 <= cmax) ? x0[r] : -INFINITY; x1[r] = (c0 + 32 <= cmax) ? x1[r] : -INFINITY; } }
                      ns_online<false>(x0, x1, m, l, seen, O); } }
              NS_VMW(0); __syncthreads();
          } }
        l += __shfl_xor(l, 32);
        const float invl = 1.f / fmaxf(l, 1e-30f);
        for (int i = lane; i < 8 * NS_PSTR; i += 64) psel[(8 * w) * NS_PSTR + i] = 0.f;
        NS_PROLOGUE(ntc, 2, true);
        for (int i = 0; i < ntc; ++i) {
            NS_STEP_BEGIN(i, ntc, 2, true);
            f32x16 x0, x1; ns_qk(x0, x1, NS_KB(i, 2), qf, rho, hh, -m);
#pragma unroll
            for (int r = 0; r < 16; ++r) { x0[r] = __builtin_amdgcn_exp2f(x0[r]) * invl; x1[r] = __builtin_amdgcn_exp2f(x1[r]) * invl; }
            if (64 * i + 63 > cmin_w) {
#pragma unroll
                for (int r = 0; r < 16; ++r) { const int c0 = 64 * i + NS_KIDX(r, hh); x0[r] = (c0 <= cmax) ? x0[r] : 0.f; x1[r] = (c0 + 32 <= cmax) ? x1[r] : 0.f; } }
#pragma unroll
            for (int kh = 0; kh < 2; ++kh)
#pragma unroll
                for (int r4 = 0; r4 < 4; ++r4) {
                    const float pa = kh ? x1[4 * r4] : x0[4 * r4], pb = kh ? x1[4 * r4 + 1] : x0[4 * r4 + 1], pc_ = kh ? x1[4 * r4 + 2] : x0[4 * r4 + 2], pd = kh ? x1[4 * r4 + 3] : x0[4 * r4 + 3];
                    float mainv = pa + pb + pc_ + 0.5f * pd, carry = 0.5f * pd;
                    mainv += __shfl_xor(mainv, 1); mainv += __shfl_xor(mainv, 2); carry += __shfl_xor(carry, 1); carry += __shfl_xor(carry, 2);
                    if (p == 0) { const int sb = 16 * i + 8 * kh + 2 * r4 + hh; float* pr = (float*)(psel + (8 * w + ql) * NS_PSTR + sb); __hip_atomic_fetch_add(pr, mainv, __ATOMIC_RELAXED, __HIP_MEMORY_SCOPE_WORKGROUP); __hip_atomic_fetch_add(pr + 1, carry, __ATOMIC_RELAXED, __HIP_MEMORY_SCOPE_WORKGROUP); }
                }
            ns_pv(O, NS_VB(i, 2), x0, x1, lane);
            NS_STEP_END(i, ntc, 2, true);
        }
#undef NS_KPTR
#undef NS_VPTR
#undef NS_DOFF
#pragma unroll
        for (int c = 0; c < 4; ++c) {
#pragma unroll
            for (int r4 = 0; r4 < 4; ++r4) *(f32x4*)(orow + 32 * c + 8 * r4) = (f32x4){O[c][4 * r4] * gate_c, O[c][4 * r4 + 1] * gate_c, O[c][4 * r4 + 2] * gate_c, O[c][4 * r4 + 3] * gate_c};
#pragma unroll
            for (int i = 0; i < 16; ++i) O[c][i] = 0.f; }
        {
            unsigned anyw = 0u;
            for (int qq = 0; qq < 8; ++qq) {
                const LAS float* pr = psel + (8 * w + qq) * NS_PSTR;
                unsigned myw = 0u;
                if (lane == 0) myw |= 1u;
                if (lane == (blk >> 5)) myw |= 1u << (blk & 31);
                if (blk >= 1 && lane == ((blk - 1) >> 5)) myw |= 1u << ((blk - 1) & 31);
                const int ncand = blk >= 3 ? blk - 2 : 0;
                if (ncand <= 13) { if (ncand > 0 && lane == 0) myw |= ((2u << (blk - 2)) - 1u) & ~1u; }
                else {
                    unsigned key[4];
#pragma unroll
                    for (int jj = 0; jj < 4; ++jj) { const int s = 1 + lane + 64 * jj; key[jj] = (s <= blk - 2) ? __float_as_uint(fmaxf(pr[s], 0.f)) + 1u : 0u; }
                    unsigned thr = 0u;
                    for (int bit = 31; bit >= 0; --bit) { const unsigned cand = thr | (1u << bit); int cn = 0;
#pragma unroll
                        for (int jj = 0; jj < 4; ++jj) cn += __popcll(__ballot(key[jj] >= cand));
                        if (cn >= 13) thr = cand; }
                    int cgt = 0;
#pragma unroll
                    for (int jj = 0; jj < 4; ++jj) cgt += __popcll(__ballot(key[jj] > thr));
                    int remaining = 13 - cgt;
                    unsigned long long M[4];
#pragma unroll
                    for (int jj = 0; jj < 4; ++jj) { const bool eq = key[jj] == thr; const unsigned long long em = __ballot(eq); const int c = __popcll(em);
                        const bool take_eq = eq && (__popcll(em & ((1ull << lane) - 1ull)) < remaining);
                        remaining = remaining > c ? remaining - c : 0;
                        M[jj] = __ballot(key[jj] > thr || take_eq); }
#pragma unroll
                    for (int j = 0; j < 8; ++j) { const int k = j >> 1; const unsigned long long sh = (M[k] << 1) | (k > 0 ? (M[k - 1] >> 63) : 0ull);
                        const unsigned wj = (unsigned)(sh >> (32 * (j & 1))); if (lane == j) myw |= wj; }
                }
                if (lane < 8) selb[(8 * w + qq) * 8 + lane] = myw;
                anyw |= myw;
            }
            if (lane < 8) wany[w * 8 + lane] = anyw;
        }
        __syncthreads();
        unsigned sw8[8], aw8[8], un8[8];
#pragma unroll
        for (int j = 0; j < 8; ++j) { sw8[j] = selb[(8 * w + ql) * 8 + j]; aw8[j] = (unsigned)__builtin_amdgcn_readfirstlane((int)wany[w * 8 + j]); unsigned un = 0u;
#pragma unroll
            for (int ww = 0; ww < 8; ++ww) un |= wany[ww * 8 + j];
            un8[j] = (unsigned)__builtin_amdgcn_readfirstlane((int)un); }
        const int nlist = blk + 1;
        for (int rp_ = 0; rp_ < NSA_SELREP; ++rp_) {
        if (rp_) { asm volatile("" :: "v"(O[0][0]), "v"(O[1][0]), "v"(O[2][0]), "v"(O[3][0]), "v"(l));
#pragma unroll
            for (int c = 0; c < 4; ++c)
#pragma unroll
                for (int i = 0; i < 16; ++i) O[c][i] = 0.f; }
        m = 0.f; l = 0.f; seen = false;
#define NS_KPTR(j) (z + (size_t)((j) * 64) * NZ + ZKS + g * 128)
#define NS_VPTR(j) (z + (size_t)((j) * 64) * NZ + ZVS + g * 128)
#define NS_DOFF doff_z
        const int npair = (nlist + 1) >> 1;
#define NS_ISSUE_PAIR(ip) do { const unsigned sa_ = lds_a + (unsigned)(((ip) & 1) * 65536); const int j0_ = 2 * (ip); \
            ns_dma(NS_KPTR(j0_), NS_DOFF, sa_, w); ns_dma(NS_VPTR(j0_), NS_DOFF, sa_ + 16384u, w); \
            if (j0_ + 1 < nlist) { ns_dma(NS_KPTR(j0_ + 1), NS_DOFF, sa_ + 32768u, w); ns_dma(NS_VPTR(j0_ + 1), NS_DOFF, sa_ + 49152u, w); } } while (0)
        NS_ISSUE_PAIR(0); NS_VMW(0); __syncthreads();
        unsigned cw_s = 0u, cw_a = 0u;
        for (int ip = 0; ip < npair; ++ip) {
            if (ip + 1 < npair) NS_ISSUE_PAIR(ip + 1);
#pragma unroll
            for (int hb = 0; hb < 2; ++hb) {
                const int sb = 2 * ip + hb, bit = sb & 31;
                if (sb < nlist) {
                    if (bit == 0) { const int wi = sb >> 5; cw_s = sw8[0]; cw_a = aw8[0];
#pragma unroll
                        for (int j = 1; j < 8; ++j) { if (wi == j) { cw_s = sw8[j]; cw_a = aw8[j]; } } }
                    if ((cw_a >> bit) & 1u) {
                        const bool rsel = (cw_s >> bit) & 1u;
                        const LAS unsigned char* kb = lds + (ip & 1) * 65536 + hb * 32768;
                        f32x16 x0, x1; ns_qk(x0, x1, kb, qf, rho, hh, rsel ? -m : -INFINITY);
                        if (sb == blk) { const int kp0 = sb * 64;
#pragma unroll
                            for (int r = 0; r < 16; ++r) { const int kp = kp0 + NS_KIDX(r, hh); x0[r] = (kp <= tq) ? x0[r] : -INFINITY; x1[r] = (kp + 32 <= tq) ? x1[r] : -INFINITY; } }
                        ns_online<true>(x0, x1, m, l, seen, O);
                        ns_pv(O, kb + 16384, x0, x1, lane);
                    }
                }
            }
            NS_VMW(0); __syncthreads();
        }
        }
#undef NS_KPTR
#undef NS_VPTR
        l += __shfl_xor(l, 32);
        { const float sc = gate_s / fmaxf(l, 1e-30f); f32x4 ev[4][4];
#pragma unroll
          for (int c = 0; c < 4; ++c)
#pragma unroll
              for (int r4 = 0; r4 < 4; ++r4) ev[c][r4] = *(const f32x4*)(orow + 32 * c + 8 * r4);
#pragma unroll
          for (int c = 0; c < 4; ++c) {
#pragma unroll
              for (int r4 = 0; r4 < 4; ++r4) { const f32x4 e = ev[c][r4]; *(f32x4*)(orow + 32 * c + 8 * r4) = (f32x4){e.x + O[c][4 * r4] * sc, e.y + O[c][4 * r4 + 1] * sc, e.z + O[c][4 * r4 + 2] * sc, e.w + O[c][4 * r4 + 3] * sc}; }
#pragma unroll
              for (int i = 0; i < 16; ++i) O[c][i] = 0.f; } }
        const int wb0 = blk >= 8 ? blk - 8 : 0, nwt = blk - wb0 + 1;
        for (int rp_ = 0; rp_ < NSA_WINREP; ++rp_) {
        if (rp_) { asm volatile("" :: "v"(O[0][0]), "v"(O[1][0]), "v"(O[2][0]), "v"(O[3][0]), "v"(l));
#pragma unroll
            for (int c = 0; c < 4; ++c)
#pragma unroll
                for (int i = 0; i < 16; ++i) O[c][i] = 0.f; }
        m = 0.f; l = 0.f; seen = false;
#define NS_KPTR(j) (z + (size_t)((wb0 + (j)) * 64) * NZ + ZKW + g * 128)
#define NS_VPTR(j) (z + (size_t)((wb0 + (j)) * 64) * NZ + ZVW + g * 128)
        { const int npw = (nwt + 1) >> 1;
#define NS_ISSUE_WPAIR(ip) do { const unsigned sa_ = lds_a + (unsigned)(((ip) & 1) * 65536); const int j0_ = 2 * (ip); \
              ns_dma(NS_KPTR(j0_), NS_DOFF, sa_, w); ns_dma(NS_VPTR(j0_), NS_DOFF, sa_ + 16384u, w); \
              if (j0_ + 1 < nwt) { ns_dma(NS_KPTR(j0_ + 1), NS_DOFF, sa_ + 32768u, w); ns_dma(NS_VPTR(j0_ + 1), NS_DOFF, sa_ + 49152u, w); } } while (0)
          NS_ISSUE_WPAIR(0); NS_VMW(0); __syncthreads();
          for (int ip = 0; ip < npw; ++ip) {
              if (ip + 1 < npw) NS_ISSUE_WPAIR(ip + 1);
#pragma unroll
              for (int hb = 0; hb < 2; ++hb) { const int i = 2 * ip + hb;
                  if (i < nwt) { const int kb = wb0 + i; const LAS unsigned char* kbp = lds + (ip & 1) * 65536 + hb * 32768;
                      f32x16 x0, x1; ns_qk(x0, x1, kbp, qf, rho, hh, -m);
                      if (i == 0 || i == nwt - 1) { const int kp0 = kb * 64;
#pragma unroll
                          for (int r = 0; r < 16; ++r) { const int kp = kp0 + NS_KIDX(r, hh);
                              x0[r] = (kp <= tq && kp + 511 >= tq) ? x0[r] : -INFINITY; x1[r] = (kp + 32 <= tq && kp + 32 + 511 >= tq) ? x1[r] : -INFINITY; } }
                      ns_online<true>(x0, x1, m, l, seen, O);
                      ns_pv(O, kbp + 16384, x0, x1, lane); } }
              NS_VMW(0); __syncthreads();
          } }
        }
#undef NS_KPTR
#undef NS_VPTR
#undef NS_DOFF
        l += __shfl_xor(l, 32);
        { const float sc = gate_w / fmaxf(l, 1e-30f); f32x4 ev[4][4];
#pragma unroll
          for (int c = 0; c < 4; ++c)
#pragma unroll
              for (int r4 = 0; r4 < 4; ++r4) ev[c][r4] = *(const f32x4*)(orow + 32 * c + 8 * r4);
#pragma unroll
          for (int c = 0; c < 4; ++c)
#pragma unroll
              for (int r4 = 0; r4 < 4; ++r4) { const f32x4 e = ev[c][r4]; *(f32x4*)(orow + 32 * c + 8 * r4) = (f32x4){e.x + O[c][4 * r4] * sc, e.y + O[c][4 * r4 + 1] * sc, e.z + O[c][4 * r4 + 2] * sc, e.w + O[c][4 * r4 + 3] * sc}; } }
    }
}

constexpr int RS = 72, SLOT = 64 * RS * 2, RW_FS = 68, RW_GCL = 17 * SLOT;
#define RW_SLOT(lds, i) ((LAS bf16*)((lds) + (i) * SLOT))
template <int KS> __device__ __forceinline__ void mm_acc(f32x4 (&acc)[2], const LAS bf16* X, int xs, const LAS bf16* Y, int ys, int w, int lane) {
    const LAS bf16* xp = X + (16 * (w >> 1) + (lane & 15)) * xs + 8 * (lane >> 4);
    const LAS bf16* yp = Y + (32 * (w & 1) + (lane & 15)) * ys + 8 * (lane >> 4);
#pragma unroll
    for (int ks = 0; ks < KS; ++ks) { const bf16x8 av = *(const LAS bf16x8*)(xp + 32 * ks), b0 = *(const LAS bf16x8*)(yp + 32 * ks), b1 = *(const LAS bf16x8*)(yp + 16 * ys + 32 * ks);
        acc[0] = __builtin_amdgcn_mfma_f32_16x16x32_bf16(av, b0, acc[0], 0, 0, 0); acc[1] = __builtin_amdgcn_mfma_f32_16x16x32_bf16(av, b1, acc[1], 0, 0, 0); }
}
__device__ __forceinline__ void acc_zero(f32x4 (&acc)[2]) { acc[0] = (f32x4){0.f, 0.f, 0.f, 0.f}; acc[1] = (f32x4){0.f, 0.f, 0.f, 0.f}; }
__device__ __forceinline__ void st_n(const f32x4 (&acc)[2], LAS bf16* dst, int m0, int n0) {
#pragma unroll
    for (int tn = 0; tn < 2; ++tn)
#pragma unroll
        for (int r = 0; r < 4; ++r) dst[(m0 + r) * RS + n0 + 16 * tn] = (bf16)acc[tn][r];
}
__device__ __forceinline__ void st_t(const f32x4 (&acc)[2], LAS bf16* dst, int m0, int n0) {
#pragma unroll
    for (int tn = 0; tn < 2; ++tn) { const bf16x4 v = {(bf16)acc[tn][0], (bf16)acc[tn][1], (bf16)acc[tn][2], (bf16)acc[tn][3]}; *(LAS bf16x4*)(dst + (n0 + 16 * tn) * RS + m0) = v; }
}
__device__ __forceinline__ void ld_n(f32x4 (&acc)[2], const LAS bf16* src, int m0, int n0) {
#pragma unroll
    for (int tn = 0; tn < 2; ++tn)
#pragma unroll
        for (int r = 0; r < 4; ++r) acc[tn][r] = (float)src[(m0 + r) * RS + n0 + 16 * tn];
}
template <bool INCL> __device__ __forceinline__ void tri_mask(f32x4 (&acc)[2], int m0, int n0) {
#pragma unroll
    for (int tn = 0; tn < 2; ++tn)
#pragma unroll
        for (int r = 0; r < 4; ++r) { const int m = m0 + r, n = n0 + 16 * tn; if (INCL ? (n > m) : (n >= m)) acc[tn][r] = 0.f; }
}
__device__ __forceinline__ void st_acc_g(const f32x4 (&acc)[2], f16* base, int u, int w, int lane) {
#pragma unroll
    for (int tn = 0; tn < 2; ++tn) { const f16x4 v = {(f16)acc[tn][0], (f16)acc[tn][1], (f16)acc[tn][2], (f16)acc[tn][3]}; ((f16x4*)base)[((size_t)u * 16 + w * 2 + tn) * 64 + lane] = v; }
}
__device__ __forceinline__ float fast_tanh(float x) { const float e = __expf(2.f * x); return 1.f - 2.f / (e + 1.f); }

__device__ __forceinline__ void p_rwkv_local(const Args& a, LAS unsigned char* lds) {
    const int tid = opaque_tid(), lane = tid & 63, w = __builtin_amdgcn_readfirstlane(tid >> 6);
    const int m0 = 16 * (w >> 1) + 4 * (lane >> 4), n0 = 32 * (w & 1) + (lane & 15);
    const int et = tid >> 3, cg = tid & 7;
    const f16* z = (const f16*)(a.ws + WS_Z);
    unsigned char* ro = (unsigned char*)a.out;
    LAS float* FW = (LAS float*)(lds + 8 * SLOT); LAS float* FA = FW + 64 * RW_FS; LAS float* TOT = FA + 64 * RW_FS; LAS float* GCL = (LAS float*)(lds + RW_GCL); LAS float* PRM = GCL + 64;
    const int h = blockIdx.x & 15, cstep = gridDim.x >> 4, ch0 = h * 64 + 8 * cg;
    __syncthreads();
    if (tid < 64) { const int ch = h * 64 + tid; const float* mu = a.in[I_MU];
        PRM[tid] = mu[ch]; PRM[64 + tid] = mu[1024 + ch]; PRM[128 + tid] = mu[2048 + ch]; PRM[192 + tid] = mu[3072 + tid]; PRM[256 + tid] = mu[3136 + tid];
        PRM[320 + tid] = a.in[I_W0][ch]; PRM[384 + tid] = a.in[I_A0][ch]; PRM[448 + tid] = a.in[I_KK][ch]; PRM[512 + tid] = a.in[I_KA][ch]; PRM[576 + tid] = a.in[I_RK][ch]; }
    { bf16x8 id8;
#pragma unroll
      for (int e = 0; e < 8; ++e) id8[e] = (bf16)((8 * cg + e == et) ? 1.f : 0.f);
      *(LAS bf16x8*)(RW_SLOT(lds, 16) + et * RS + 8 * cg) = id8; }
    *(LAS u32x4*)(RW_SLOT(lds, 14) + et * RS + 8 * cg) = *(const u32x4*)((const bf16*)(a.ws + WS_WUPT) + (size_t)(h * 64 + et) * 64 + 8 * cg);
    *(LAS u32x4*)(RW_SLOT(lds, 15) + et * RS + 8 * cg) = *(const u32x4*)((const bf16*)(a.ws + WS_AUPT) + (size_t)(h * 64 + et) * 64 + 8 * cg);
    f16x8 zc[5], zp[5];
    const f16x8 zero8 = {0, 0, 0, 0, 0, 0, 0, 0};
#define RW_LOADZ(cc) do { const int t_ = (cc) * 64 + et; const f16* cur_ = z + (size_t)t_ * NZ; const bool hp_ = t_ > 0; \
        zc[0] = *(const f16x8*)(cur_ + ZR + ch0); zc[1] = *(const f16x8*)(cur_ + ZK + ch0); zc[2] = *(const f16x8*)(cur_ + ZV + ch0); zc[3] = *(const f16x8*)(cur_ + ZWD + 8 * cg); zc[4] = *(const f16x8*)(cur_ + ZAD + 8 * cg); \
        zp[0] = hp_ ? *(const f16x8*)(cur_ - NZ + ZR + ch0) : zero8; zp[1] = hp_ ? *(const f16x8*)(cur_ - NZ + ZK + ch0) : zero8; zp[2] = hp_ ? *(const f16x8*)(cur_ - NZ + ZV + ch0) : zero8; \
        zp[3] = hp_ ? *(const f16x8*)(cur_ - NZ + ZWD + 8 * cg) : zero8; zp[4] = hp_ ? *(const f16x8*)(cur_ - NZ + ZAD + 8 * cg) : zero8; } while (0)
    __syncthreads();
    if ((blockIdx.x >> 4) < 256) RW_LOADZ(blockIdx.x >> 4);
    for (int c = blockIdx.x >> 4; c < 256; c += cstep) {
        const int t0 = c * 64, uo = h * 256 + c;
        float r_[8], k_[8], v_[8];
        { bf16x8 x1, x2;
#pragma unroll
          for (int e = 0; e < 8; ++e) { const int jj = 8 * cg + e;
              r_[e] = (float)zc[0][e] + ((float)zp[0][e] - (float)zc[0][e]) * PRM[jj]; k_[e] = (float)zc[1][e] + ((float)zp[1][e] - (float)zc[1][e]) * PRM[64 + jj]; v_[e] = (float)zc[2][e] + ((float)zp[2][e] - (float)zc[2][e]) * PRM[128 + jj];
              x1[e] = (bf16)fast_tanh((float)zc[3][e] + ((float)zp[3][e] - (float)zc[3][e]) * PRM[192 + jj]); x2[e] = (bf16)((float)zc[4][e] + ((float)zp[4][e] - (float)zc[4][e]) * PRM[256 + jj]); }
          *(LAS bf16x8*)(RW_SLOT(lds, 0) + et * RS + 8 * cg) = x1; *(LAS bf16x8*)(RW_SLOT(lds, 1) + et * RS + 8 * cg) = x2; }
        if (c + cstep < 256) RW_LOADZ(c + cstep);
        __syncthreads();
        { f32x4 acc[2]; acc_zero(acc); mm_acc<2>(acc, RW_SLOT(lds, 0), RS, RW_SLOT(lds, 14), RS, w, lane);
#pragma unroll
          for (int tn = 0; tn < 2; ++tn)
#pragma unroll
              for (int r = 0; r < 4; ++r) FW[(m0 + r) * RW_FS + n0 + 16 * tn] = acc[tn][r];
          acc_zero(acc); mm_acc<2>(acc, RW_SLOT(lds, 1), RS, RW_SLOT(lds, 15), RS, w, lane);
#pragma unroll
          for (int tn = 0; tn < 2; ++tn)
#pragma unroll
              for (int r = 0; r < 4; ++r) FA[(m0 + r) * RW_FS + n0 + 16 * tn] = acc[tn][r]; }
        __syncthreads();
        float lw_[8], kk_[8], b_[8];
        { float ss = 0.f, sb = 0.f;
#pragma unroll
          for (int e = 0; e < 8; ++e) {
              const float wpre = PRM[320 + 8 * cg + e] + FW[et * RW_FS + 8 * cg + e]; const float y0 = -wpre; const float sp = fmaxf(y0, 0.f) + __logf(1.f + __expf(-fabsf(y0)));
              lw_[e] = -__expf(-sp - 0.5f);
              const float av = sigmoidf_(PRM[384 + 8 * cg + e] + FA[et * RW_FS + 8 * cg + e]);
              const float kkr = k_[e] * PRM[448 + 8 * cg + e]; ss += kkr * kkr; kk_[e] = kkr;
              k_[e] = k_[e] * (1.f + (av - 1.f) * PRM[512 + 8 * cg + e]); b_[e] = av;
              sb += r_[e] * k_[e] * PRM[576 + 8 * cg + e]; }
          ss += __shfl_xor(ss, 1); ss += __shfl_xor(ss, 2); ss += __shfl_xor(ss, 4);
          sb += __shfl_xor(sb, 1); sb += __shfl_xor(sb, 2); sb += __shfl_xor(sb, 4);
          const float rn = rsqrtf(fmaxf(ss, 1e-24f));
#pragma unroll
          for (int e = 0; e < 8; ++e) { kk_[e] *= rn; b_[e] *= kk_[e]; FW[et * RW_FS + 8 * cg + e] = lw_[e]; }
          if (cg == 0) ((float*)(a.ws + WS_SBON))[(size_t)(t0 + et) * 16 + h] = sb; }
        __syncthreads();
        { const int j = tid & 63, rg = tid >> 6; float run = 0.f;
#pragma unroll
          for (int i = 0; i < 8; ++i) { run += FW[(8 * rg + i) * RW_FS + j]; FW[(8 * rg + i) * RW_FS + j] = run; }
          TOT[rg * 64 + j] = run;
          __syncthreads();
          float off = 0.f;
          for (int q = 0; q < rg; ++q) off += TOT[q * 64 + j];
#pragma unroll
          for (int i = 0; i < 8; ++i) FW[(8 * rg + i) * RW_FS + j] += off; }
        __syncthreads();
        { bf16x8 at, bt, kt, rt, bh, kh, vv;
#pragma unroll
          for (int e = 0; e < 8; ++e) { const int jj = 8 * cg + e; const float cum = FW[et * RW_FS + jj], cl = FW[63 * RW_FS + jj];
              const float eA = __expf(cum - lw_[e]), eN = __expf(-cum), eP = __expf(cum), eH = __expf(cl - cum);
              at[e] = (bf16)(-kk_[e] * eA); bt[e] = (bf16)(b_[e] * eN); kt[e] = (bf16)(k_[e] * eN); rt[e] = (bf16)(r_[e] * eP);
              bh[e] = (bf16)(b_[e] * eH); kh[e] = (bf16)(k_[e] * eH); vv[e] = (bf16)v_[e];
              if (et == 63) GCL[jj] = __expf(cl); }
          *(LAS bf16x8*)(RW_SLOT(lds, 0) + et * RS + 8 * cg) = at; *(LAS bf16x8*)(RW_SLOT(lds, 2) + et * RS + 8 * cg) = bt;
          *(LAS bf16x8*)(RW_SLOT(lds, 3) + et * RS + 8 * cg) = kt; *(LAS bf16x8*)(RW_SLOT(lds, 4) + et * RS + 8 * cg) = rt;
          *(LAS bf16x8*)(RW_SLOT(lds, 5) + et * RS + 8 * cg) = bh; *(LAS bf16x8*)(RW_SLOT(lds, 6) + et * RS + 8 * cg) = kh; *(LAS bf16x8*)(RW_SLOT(lds, 7) + et * RS + 8 * cg) = vv; }
        __syncthreads();
#define RW_MM(acc, XS, YS) mm_acc<2>(acc, RW_SLOT(lds, XS), RS, RW_SLOT(lds, YS), RS, w, lane)
#define RW_ST(acc, DS) st_t(acc, RW_SLOT(lds, DS), m0, n0)
        { f32x4 acc[2];
          acc_zero(acc); RW_MM(acc, 0, 16); RW_ST(acc, 1);
          acc_zero(acc); RW_MM(acc, 5, 16); RW_ST(acc, 8);
          acc_zero(acc); RW_MM(acc, 6, 16); RW_ST(acc, 9);
          acc_zero(acc); RW_MM(acc, 7, 16); RW_ST(acc, 10);
          __syncthreads();
          acc_zero(acc); RW_MM(acc, 2, 0);
#pragma unroll
          for (int tn = 0; tn < 2; ++tn)
#pragma unroll
              for (int r = 0; r < 4; ++r) if (m0 + r >= n0 + 16 * tn) acc[tn][r] = 0.f;
          RW_ST(acc, 5);
#pragma unroll
          for (int tn = 0; tn < 2; ++tn)
#pragma unroll
              for (int r = 0; r < 4; ++r) if (m0 + r == n0 + 16 * tn) acc[tn][r] = 1.f;
          RW_ST(acc, 13);
          acc_zero(acc); RW_MM(acc, 0, 2); tri_mask<false>(acc, m0, n0); RW_ST(acc, 6);
          acc_zero(acc); RW_MM(acc, 0, 3); tri_mask<false>(acc, m0, n0); RW_ST(acc, 7);
          acc_zero(acc); RW_MM(acc, 2, 4);
#pragma unroll
          for (int tn = 0; tn < 2; ++tn)
#pragma unroll
              for (int r = 0; r < 4; ++r) if (m0 + r > n0 + 16 * tn) acc[tn][r] = 0.f;
          RW_ST(acc, 11);
          acc_zero(acc); RW_MM(acc, 3, 4);
#pragma unroll
          for (int tn = 0; tn < 2; ++tn)
#pragma unroll
              for (int r = 0; r < 4; ++r) if (m0 + r > n0 + 16 * tn) acc[tn][r] = 0.f;
          RW_ST(acc, 12);
          __syncthreads();
#define RW_LDT(acc, TS) do { _Pragma("unroll") for (int tn_ = 0; tn_ < 2; ++tn_) { const bf16x4 v_ = *(const LAS bf16x4*)(RW_SLOT(lds, TS) + (n0 + 16 * tn_) * RS + m0); acc[tn_] = (f32x4){(float)v_[0], (float)v_[1], (float)v_[2], (float)v_[3]}; } } while (0)
          acc_zero(acc); RW_MM(acc, 6, 5); RW_ST(acc, 0); acc_zero(acc); RW_MM(acc, 5, 6); RW_ST(acc, 2);
          __syncthreads();
          RW_LDT(acc, 13); RW_MM(acc, 2, 13); RW_ST(acc, 3);
          acc_zero(acc); RW_MM(acc, 2, 0); RW_ST(acc, 5); acc_zero(acc); RW_MM(acc, 0, 2); RW_ST(acc, 6);
          __syncthreads();
          RW_LDT(acc, 3); RW_MM(acc, 6, 3); RW_ST(acc, 13);
          acc_zero(acc); RW_MM(acc, 6, 5); RW_ST(acc, 0); acc_zero(acc); RW_MM(acc, 5, 6); RW_ST(acc, 2);
          __syncthreads();
          RW_LDT(acc, 13); RW_MM(acc, 2, 13); RW_ST(acc, 3);
          acc_zero(acc); RW_MM(acc, 2, 0); RW_ST(acc, 5); acc_zero(acc); RW_MM(acc, 0, 2); RW_ST(acc, 6);
          __syncthreads();
          RW_LDT(acc, 3); RW_MM(acc, 6, 3); RW_ST(acc, 13);
          acc_zero(acc); RW_MM(acc, 5, 6); RW_ST(acc, 2);
          __syncthreads();
          RW_LDT(acc, 13); RW_MM(acc, 2, 13); RW_ST(acc, 3);
          __syncthreads();
          acc_zero(acc); RW_MM(acc, 3, 1); RW_ST(acc, 0);
          acc_zero(acc); RW_MM(acc, 7, 3); RW_ST(acc, 5);
          __syncthreads();
          acc_zero(acc); RW_MM(acc, 5, 10); RW_ST(acc, 6);
          acc_zero(acc); RW_MM(acc, 0, 11);
#pragma unroll
          for (int tn = 0; tn < 2; ++tn) { const int tt = n0 + 16 * tn; const bf16x4 rr = *(const LAS bf16x4*)(RW_SLOT(lds, 4) + tt * RS + m0);
              const bf16x4 o = {(bf16)(acc[tn][0] + (float)rr[0]), (bf16)(acc[tn][1] + (float)rr[1]), (bf16)(acc[tn][2] + (float)rr[2]), (bf16)(acc[tn][3] + (float)rr[3])};
              *(bf16x4*)((bf16*)(ro + RO_Q) + (size_t)uo * 4096 + tt * 64 + m0) = o; }
          acc_zero(acc); RW_MM(acc, 0, 8);
#pragma unroll
          for (int tn = 0; tn < 2; ++tn) { const int jj = n0 + 16 * tn; const float gc = GCL[jj];
              const bf16x4 o = {(bf16)(acc[tn][0] + (m0 == jj ? gc : 0.f)), (bf16)(acc[tn][1] + (m0 + 1 == jj ? gc : 0.f)), (bf16)(acc[tn][2] + (m0 + 2 == jj ? gc : 0.f)), (bf16)(acc[tn][3] + (m0 + 3 == jj ? gc : 0.f))};
              *(bf16x4*)((bf16*)(ro + RO_M) + (size_t)uo * 4096 + jj * 64 + m0) = o; }
          __syncthreads();
          acc_zero(acc); RW_MM(acc, 11, 6); RW_MM(acc, 12, 10); st_acc_g(acc, (f16*)(ro + RO_Y), uo, w, lane);
          acc_zero(acc); RW_MM(acc, 6, 8); RW_MM(acc, 10, 9); st_acc_g(acc, (f16*)(ro + RO_N), uo, w, lane);
        }
#undef RW_MM
#undef RW_ST
#undef RW_LDT
    }
}
__device__ __forceinline__ void p_rwkv_scan(const Args& a, LAS unsigned char* lds, int h) {
    const int tid = opaque_tid(), lane = tid & 63, w = __builtin_amdgcn_readfirstlane(tid >> 6);
    const int m0 = 16 * (w >> 1) + 4 * (lane >> 4), n0 = 32 * (w & 1) + (lane & 15), row = tid >> 3, seg = tid & 7;
    const unsigned char* ro = (const unsigned char*)a.out;
    const bf16* Mg = (const bf16*)(ro + RO_M) + (size_t)h * 256 * 4096; const f16x4* Ng = (const f16x4*)(ro + RO_N) + (size_t)h * 256 * 1024; bf16* Sg = (bf16*)(a.ws + WS_RS) + (size_t)h * 256 * 4096;
    f32x4 acc[2]; acc_zero(acc);
    u32x4 mreg = *(const u32x4*)(Mg + row * 64 + seg * 8); f16x4 nreg[2] = {Ng[(w * 2) * 64 + lane], Ng[(w * 2 + 1) * 64 + lane]};
    for (int c = 0; c < 256; ++c) {
        LAS bf16* Sb = RW_SLOT(lds, c & 1); LAS bf16* Mb = RW_SLOT(lds, 2 + (c & 1));
        st_n(acc, Sb, m0, n0);
        *(LAS u32x4*)(Mb + row * RS + seg * 8) = mreg;
        const f16x4 nc0 = nreg[0], nc1 = nreg[1];
        if (c + 1 < 256) { mreg = *(const u32x4*)(Mg + (size_t)(c + 1) * 4096 + row * 64 + seg * 8); nreg[0] = Ng[(size_t)(c + 1) * 1024 + (w * 2) * 64 + lane]; nreg[1] = Ng[(size_t)(c + 1) * 1024 + (w * 2 + 1) * 64 + lane]; }
        __syncthreads();
        *(u32x4*)(Sg + (size_t)c * 4096 + row * 64 + seg * 8) = *(const LAS u32x4*)(Sb + row * RS + seg * 8);
        acc[0] = (f32x4){(float)nc0[0], (float)nc0[1], (float)nc0[2], (float)nc0[3]}; acc[1] = (f32x4){(float)nc1[0], (float)nc1[1], (float)nc1[2], (float)nc1[3]};
        mm_acc<2>(acc, Sb, RS, Mb, RS, w, lane);
    }
}
constexpr int RG_S = 168;
__device__ __forceinline__ void p_rwkv_out(const Args& a, LAS unsigned char* lds) {
    const int tid = opaque_tid(), lane = tid & 63, w = __builtin_amdgcn_readfirstlane(tid >> 6);
    const int m0 = 16 * (w >> 1) + 4 * (lane >> 4), n0 = 32 * (w & 1) + (lane & 15), row = tid >> 3, seg = tid & 7;
    const f16* z = (const f16*)(a.ws + WS_Z); const unsigned char* ro = (const unsigned char*)a.out; f16* mix = (f16*)(a.ws + WS_MIX);
    LAS bf16* SG = (LAS bf16*)(lds + 2 * SLOT); LAS bf16* GU = SG + 64 * RG_S; LAS float* YL = (LAS float*)(GU + 64 * RG_S); LAS float* GL = YL + 64 * RW_FS; LAS float* PRM = GL + 64 * RW_FS;
    const int h = blockIdx.x & 15, cstep = gridDim.x >> 4, et = row, cg = seg, ch0 = h * 64 + 8 * cg;
    __syncthreads();
    for (int ck = tid; ck < 64 * 20; ck += 512) { const int rr = ck / 20, c8 = ck % 20; *(LAS u32x4*)(GU + rr * RG_S + 8 * c8) = *(const u32x4*)((const bf16*)(a.ws + WS_GUPT) + (size_t)(h * 64 + rr) * 160 + 8 * c8); }
    if (tid < 160) PRM[tid] = a.in[I_MU][3200 + tid];
    if (tid < 64) { PRM[160 + tid] = a.in[I_MU][2048 + h * 64 + tid]; PRM[224 + tid] = a.in[I_LNXG][h * 64 + tid]; PRM[288 + tid] = a.in[I_LNXB][h * 64 + tid]; }
    const f16x8 zero8 = {0, 0, 0, 0, 0, 0, 0, 0};
    u32x4 qreg, sreg; f16x4 yreg[2]; f16x8 gc[3], gp[3], vc, vp; float sbn;
#define RO_LOAD(cc) do { const int uo_ = h * 256 + (cc), t0_ = (cc) * 64; \
        qreg = *(const u32x4*)((const bf16*)(ro + RO_Q) + (size_t)uo_ * 4096 + row * 64 + seg * 8); sreg = *(const u32x4*)((const bf16*)(a.ws + WS_RS) + (size_t)uo_ * 4096 + row * 64 + seg * 8); \
        { const f16x4* Yg_ = (const f16x4*)(ro + RO_Y) + (size_t)uo_ * 1024; yreg[0] = Yg_[(w * 2) * 64 + lane]; yreg[1] = Yg_[(w * 2 + 1) * 64 + lane]; } \
        _Pragma("unroll") for (int i_ = 0; i_ < 3; ++i_) { const int ck_ = tid + 512 * i_; if (ck_ < 64 * 20) { const int t_ = t0_ + ck_ / 20; const f16* cur_ = z + (size_t)t_ * NZ + ZGD + 8 * (ck_ % 20); gc[i_] = *(const f16x8*)cur_; gp[i_] = t_ > 0 ? *(const f16x8*)(cur_ - NZ) : zero8; } } \
        { const int t_ = t0_ + et; const f16* cur_ = z + (size_t)t_ * NZ + ZV + ch0; vc = *(const f16x8*)cur_; vp = t_ > 0 ? *(const f16x8*)(cur_ - NZ) : zero8; sbn = ((const float*)(a.ws + WS_SBON))[(size_t)t_ * 16 + h]; } } while (0)
    RO_LOAD(blockIdx.x >> 4);
    for (int c = blockIdx.x >> 4; c < 256; c += cstep) {
        const int t0 = c * 64;
        __syncthreads();
        *(LAS u32x4*)(RW_SLOT(lds, 0) + row * RS + seg * 8) = qreg; *(LAS u32x4*)(RW_SLOT(lds, 1) + row * RS + seg * 8) = sreg;
#pragma unroll
        for (int i = 0; i < 3; ++i) { const int ck = tid + 512 * i; if (ck < 64 * 20) { const int rr = ck / 20, c8 = ck % 20; bf16x8 o;
#pragma unroll
            for (int e = 0; e < 8; ++e) o[e] = (bf16)sigmoidf_((float)gc[i][e] + ((float)gp[i][e] - (float)gc[i][e]) * PRM[8 * c8 + e]);
            *(LAS bf16x8*)(SG + rr * RG_S + 8 * c8) = o; } }
        f32x4 y[2], g[2];
        y[0] = (f32x4){(float)yreg[0][0], (float)yreg[0][1], (float)yreg[0][2], (float)yreg[0][3]}; y[1] = (f32x4){(float)yreg[1][0], (float)yreg[1][1], (float)yreg[1][2], (float)yreg[1][3]};
        const f16x8 vcc = vc, vpp = vp; const float sbc = sbn;
        if (c + cstep < 256) RO_LOAD(c + cstep);
        __syncthreads();
        mm_acc<2>(y, RW_SLOT(lds, 0), RS, RW_SLOT(lds, 1), RS, w, lane);
        acc_zero(g); mm_acc<5>(g, SG, RG_S, GU, RG_S, w, lane);
#pragma unroll
        for (int tn = 0; tn < 2; ++tn)
#pragma unroll
            for (int r = 0; r < 4; ++r) { YL[(m0 + r) * RW_FS + n0 + 16 * tn] = y[tn][r]; GL[(m0 + r) * RW_FS + n0 + 16 * tn] = g[tn][r]; }
        __syncthreads();
        { const int t = t0 + et;
          float yv[8], gv[8]; float s1 = 0.f, s2 = 0.f;
#pragma unroll
          for (int e = 0; e < 8; ++e) { yv[e] = YL[et * RW_FS + 8 * cg + e]; gv[e] = GL[et * RW_FS + 8 * cg + e]; s1 += yv[e]; s2 += yv[e] * yv[e]; }
          s1 += __shfl_xor(s1, 1); s1 += __shfl_xor(s1, 2); s1 += __shfl_xor(s1, 4);
          s2 += __shfl_xor(s2, 1); s2 += __shfl_xor(s2, 2); s2 += __shfl_xor(s2, 4);
          const float mean = s1 * (1.f / 64.f), var = fmaxf(s2 * (1.f / 64.f) - mean * mean, 0.f), rstd = rsqrtf(var + 64e-5f);
          f16x8 o;
#pragma unroll
          for (int e = 0; e < 8; ++e) { const int jj = 8 * cg + e; const float vv = (float)vcc[e] + ((float)vpp[e] - (float)vcc[e]) * PRM[160 + jj];
              const float yn = (yv[e] - mean) * rstd * PRM[224 + jj] + PRM[288 + jj]; o[e] = (f16)((yn + sbc * vv) * gv[e]); }
          *(f16x8*)(mix + (size_t)t * D + 1024 + ch0) = o; }
    }
}

constexpr int RT_XS = 2048 + 8;
__device__ __forceinline__ void p_router(const Args& a, LAS unsigned char* lds, int rep) {
    const int tid = opaque_tid(), lane = tid & 63, wave = __builtin_amdgcn_readfirstlane(tid >> 6);
    const float* x2 = (const float*)(a.ws + WS_X1); f16* h3 = (f16*)a.out;
    unsigned* ctl = (unsigned*)(a.ws + WS_CTL);
    int* tke = (int*)(a.ws + WS_TOK + TK_E); float* tkw = (float*)(a.ws + WS_TOK + TK_W);
    const f16* WH = (const f16*)(a.ws + WS_WRH); const f16* WL = (const f16*)(a.ws + WS_WRL);
    LAS float* PART = (LAS float*)lds;
    LAS float* SSP = PART + 8 * 16 * 48;
    LAS float* LG = SSP + 128;
    LAS float* RSTD = LG + 16 * 48;
    LAS float* XT = RSTD + 16;
    const int row = lane & 15, kq = lane >> 4;
    for (int tile = blockIdx.x; tile < T / 16; tile += gridDim.x) {
        const int r0 = tile * 16;
        f32x4 acc[3]; acc[0] = (f32x4){0.f, 0.f, 0.f, 0.f}; acc[1] = acc[0]; acc[2] = acc[0];
        float ss = 0.f;
        const float* xp = x2 + (size_t)(r0 + row) * D + 256 * wave + 8 * kq;
        const f16* whp = WH + (size_t)row * D + 256 * wave + 8 * kq; const f16* wlp = WL + (size_t)row * D + 256 * wave + 8 * kq;
#pragma unroll 1
        for (int kb = 0; kb < 2; ++kb) {
            f32x4 xa[4], xb[4]; f16x8 bh[4][3], bl[4][3];
#pragma unroll
            for (int k4 = 0; k4 < 4; ++k4) { const int ks = kb * 4 + k4; xa[k4] = *(const f32x4*)(xp + 32 * ks); xb[k4] = *(const f32x4*)(xp + 32 * ks + 4);
#pragma unroll
                for (int nt = 0; nt < 3; ++nt) { bh[k4][nt] = *(const f16x8*)(whp + (size_t)nt * 16 * D + 32 * ks); bl[k4][nt] = *(const f16x8*)(wlp + (size_t)nt * 16 * D + 32 * ks); } }
            asm volatile("s_waitcnt vmcnt(0)" ::: "memory");
#pragma unroll
            for (int k4 = 0; k4 < 4; ++k4) {
                { LAS float* xd = XT + row * RT_XS + 256 * wave + 32 * (kb * 4 + k4) + 8 * kq; *(LAS f32x4*)xd = xa[k4]; *(LAS f32x4*)(xd + 4) = xb[k4]; }
                ss += xa[k4].x * xa[k4].x + xa[k4].y * xa[k4].y + xa[k4].z * xa[k4].z + xa[k4].w * xa[k4].w + xb[k4].x * xb[k4].x + xb[k4].y * xb[k4].y + xb[k4].z * xb[k4].z + xb[k4].w * xb[k4].w;
                f16x8 hi, lo;
#pragma unroll
                for (int j = 0; j < 4; ++j) { hi[j] = (f16)xa[k4][j]; lo[j] = (f16)(xa[k4][j] - (float)hi[j]); hi[4 + j] = (f16)xb[k4][j]; lo[4 + j] = (f16)(xb[k4][j] - (float)hi[4 + j]); }
#pragma unroll
                for (int nt = 0; nt < 3; ++nt) {
                    acc[nt] = __builtin_amdgcn_mfma_f32_16x16x32_f16(hi, bh[k4][nt], acc[nt], 0, 0, 0); acc[nt] = __builtin_amdgcn_mfma_f32_16x16x32_f16(lo, bh[k4][nt], acc[nt], 0, 0, 0); acc[nt] = __builtin_amdgcn_mfma_f32_16x16x32_f16(hi, bl[k4][nt], acc[nt], 0, 0, 0); }
            }
        }
        ss += __shfl_xor(ss, 16); ss += __shfl_xor(ss, 32);
        __syncthreads();
        if (kq == 0) SSP[wave * 16 + row] = ss;
#pragma unroll
        for (int nt = 0; nt < 3; ++nt)
#pragma unroll
            for (int r = 0; r < 4; ++r) PART[(wave * 16 + 4 * kq + r) * 48 + 16 * nt + row] = acc[nt][r];
        __syncthreads();
        for (int i = tid; i < 16 * 48; i += 512) { float v = 0.f;
#pragma unroll
            for (int ww = 0; ww < 8; ++ww) v += PART[ww * 768 + i];
            LG[i] = v; }
        if (tid < 16) { float v = 0.f;
#pragma unroll
            for (int ww = 0; ww < 8; ++ww) v += SSP[ww * 16 + tid];
            RSTD[tid] = rsqrtf(v * (1.f / D) + EPS); }
        __syncthreads();
        if (tid < 16) {
            const float rs = RSTD[tid]; const LAS float* L = LG + tid * 48;
            float lg[4];
#pragma unroll
            for (int c = 0; c < 4; ++c) lg[c] = L[c] * rs + a.in[I_RGB][c];
            int gi = 0; float gm = lg[0];
#pragma unroll
            for (int c = 1; c < 4; ++c) if (lg[c] > gm) { gm = lg[c]; gi = c; }
            float gs = 0.f;
#pragma unroll
            for (int c = 0; c < 4; ++c) gs += __expf(lg[c] - gm);
            const float pg = 1.f / gs;
            float le[8];
#pragma unroll
            for (int c = 0; c < 8; ++c) le[c] = L[4 + gi * 8 + c] * rs + a.in[I_REB][gi * 8 + c];
            int e1 = 0; float m1 = le[0];
#pragma unroll
            for (int c = 1; c < 8; ++c) if (le[c] > m1) { m1 = le[c]; e1 = c; }
            int e2 = -1; float m2 = -INFINITY;
#pragma unroll
            for (int c = 0; c < 8; ++c) if (c != e1 && le[c] > m2) { m2 = le[c]; e2 = c; }
            const float p2 = __expf(m2 - m1);
            const float w1 = pg / (1.f + p2), w2 = pg * p2 / (1.f + p2);
            const int m = r0 + tid, E1 = gi * 8 + e1, E2 = gi * 8 + e2; tke[m * 2] = E1; tke[m * 2 + 1] = E2; tkw[m * 2] = w1; tkw[m * 2 + 1] = w2;
            atomicAdd(&ctl[CW_CNT + rep * 8000 + E1], 1u); atomicAdd(&ctl[CW_CNT + rep * 8000 + E2], 1u);
        }
        { f32x4 xv[2][8], gg[8]; const f32x4* gr = (const f32x4*)a.in[I_LN3] + lane;
#pragma unroll
          for (int j = 0; j < 8; ++j) gg[j] = gr[64 * j];
#pragma unroll
          for (int rr2 = 0; rr2 < 2; ++rr2) { const LAS f32x4* xr = (const LAS f32x4*)(XT + (wave * 2 + rr2) * RT_XS) + lane;
#pragma unroll
              for (int j = 0; j < 8; ++j) xv[rr2][j] = xr[64 * j]; }
#pragma unroll
          for (int rr2 = 0; rr2 < 2; ++rr2) { const int rr = wave * 2 + rr2; const float rs = RSTD[rr]; u32x2* o8 = (u32x2*)(h3 + (size_t)(r0 + rr) * D) + lane;
#pragma unroll
              for (int j = 0; j < 8; ++j) { const f32x4 v = xv[rr2][j]; u32x2 wv; wv.x = pkh(v.x * rs * gg[j].x, v.y * rs * gg[j].y); wv.y = pkh(v.z * rs * gg[j].z, v.w * rs * gg[j].w); o8[64 * j] = wv; } } }
        __syncthreads();
    }
}
__device__ __forceinline__ void p_slots(const Args& a, LAS unsigned char* lds, int rep) {
    unsigned* ctl = (unsigned*)(a.ws + WS_CTL);
    const int* tke = (const int*)(a.ws + WS_TOK + TK_E); const float* tkw = (const float*)(a.ws + WS_TOK + TK_W); int* tks = (int*)(a.ws + WS_TOK + TK_SLOT);
    int* stok = (int*)(a.ws + WS_TOK + TK_STOK); float* sw = (float*)(a.ws + WS_TOK + TK_SW);
    const int tid = opaque_tid(), lane = tid & 63;
    LAS int* offl = (LAS int*)lds; LAS int* cntl = offl + 64;
    __syncthreads();
    if (tid < 64) {
        const int n = lane < NEXP ? (int)ctl[CW_CNT + lane] : 0, nt = (n + 255) >> 8;
        int pre = nt;
#pragma unroll
        for (int o = 1; o < 32; o <<= 1) { const int v = __shfl_up(pre, o); if ((lane & 31) >= o) pre += v; }
        const int tb = pre - nt;
        if (lane < NEXP) { offl[lane] = tb * 256; cntl[lane] = n; }
        if (lane == NEXP - 1) offl[NEXP] = pre * 256;
        if (blockIdx.x == 0 && lane < NEXP) {
            int2* ugu = (int2*)(ctl + CW_UGU); int2* udn = (int2*)(ctl + CW_UDN);
            for (int rt = 0; rt < nt; ++rt) { const int pm = tb + rt;
#pragma unroll
                for (int jt = 0; jt < 2; ++jt) ugu[pm * 2 + jt] = make_int2(pm, lane * 2 + jt);
#pragma unroll
                for (int jt = 0; jt < 8; ++jt) udn[pm * 8 + jt] = make_int2(pm, lane * 8 + jt); }
            if (lane == NEXP - 1) { ctl[CW_NT] = (unsigned)pre; ctl[CW_NGU] = (unsigned)(pre * 2); ctl[CW_NDN] = (unsigned)(pre * 8); }
        }
    }
    __syncthreads();
    if (blockIdx.x == 0 && rep == 0) {
        for (int e = 0; e < NEXP; ++e) { const int end = offl[e + 1];
            for (int sl = offl[e] + cntl[e] + tid; sl < end; sl += 512) { stok[sl] = 0; sw[sl] = 0.f; } } }
    LAS int* hist = cntl + 64; LAS int* gbase = hist + 64;
    for (int base = blockIdx.x * 512; base < T * 2; base += gridDim.x * 512) {
        __syncthreads();
        if (tid < 64) hist[tid] = 0;
        __syncthreads();
        const int i = base + tid; const bool ok = i < T * 2; const int e = ok ? tke[i] : 0;
        int rank = 0; if (ok) rank = __hip_atomic_fetch_add((int*)(hist + e), 1, __ATOMIC_RELAXED, __HIP_MEMORY_SCOPE_WORKGROUP);
        __syncthreads();
        if (tid < NEXP) { const int c = hist[tid]; gbase[tid] = c ? (int)atomicAdd(&ctl[CW_CUR + rep * 8000 + tid], (unsigned)c) : 0; }
        __syncthreads();
        if (ok) { const int slot = offl[e] + gbase[e] + rank; stok[slot] = i >> 1; sw[slot] = tkw[i]; tks[i] = slot; }
    }
}


constexpr int NPH = 17;
__global__ void __launch_bounds__(512, 2) mega(Args args) {
    extern __shared__ __attribute__((aligned(16))) unsigned char lds_raw[];
    LAS unsigned char* lds = (LAS unsigned char*)lds_raw;
    volatile LAS unsigned* MISC = (volatile LAS unsigned*)(lds + MISC_OFF);
    const int G = gridDim.x;
#define PH_IDS const int tid = opaque_tid(), lane = tid & 63, wave = tid >> 6, gw = blockIdx.x * 8 + wave, NGW = gridDim.x * 8; (void)tid; (void)lane; (void)gw; (void)NGW
    unsigned char* ws = args.ws;
    unsigned* ctl = (unsigned*)(ws + WS_CTL);
    if (threadIdx.x < 128) ((LAS unsigned*)(lds + MISC_OFF))[threadIdx.x] = 0u;
    __syncthreads();
    XcdBarrier bar; bar.bar = ctl + CW_BAR; bar.x = 0; bar.st = nullptr;
    const int lo = args.ph_lo, hi = args.ph_hi;
    if (hi - lo > 1 || DUPMASK != 0u) bar = xcd_barrier_post(ctl + CW_BAR, MISC + 8);
#ifndef PHMASK
#define PHMASK 0xFFFFFFFFu
#endif
#define IN(k) (((PHMASK >> (k)) & 1u) && lo <= (k) && (k) < hi)
#define BOTH(k) (IN(k) && IN((k) + 1))
#define GRID_BAR() xcd_barrier(bar)
#define NREP(k) ((((DUPMASK) >> (k)) & 1u) ? 2 : 1)

    for (int rep_ = 0; rep_ < NREP(0); ++rep_) if (IN(0)) { p0_prologue(args, lds); if (BOTH(0) || rep_ + 1 < NREP(0)) GRID_BAR(); }
    for (int rep_ = 0; rep_ < NREP(1); ++rep_) if (IN(1)) {
        { pg8::Gemm g{(const f16*)(ws + WS_H), (const f16*)(ws + WS_WIN), D, D, D, nullptr}; pg8::StaticOrder S; S.init(T, NZ, G, (int)blockIdx.x);
          pg8::EpiF16 E{(f16*)(ws + WS_Z), NZ, 1.f}; pg8::gemm_phase<pg8::EpiF16, pg8::StaticOrder, true>(lds, g, S, E); }
        if (BOTH(1) || rep_ + 1 < NREP(1)) GRID_BAR();
    }
    for (int rep_ = 0; rep_ < NREP(2); ++rep_) if (IN(2)) {
        for (int r2_ = 0; r2_ < ((DUPX & 1) ? 2 : 1); ++r2_) { p_compress(args, lds); __syncthreads(); }
        for (int r2_ = 0; r2_ < ((DUPX & 2) ? 2 : 1); ++r2_) { p_rwkv_local(args, lds); __syncthreads(); }
        if (BOTH(2) || rep_ + 1 < NREP(2)) GRID_BAR();
    }
    for (int rep_ = 0; rep_ < NREP(3); ++rep_) if (IN(3)) {
        if (blockIdx.x < 16) p_rwkv_scan(args, lds, blockIdx.x);
        else if (blockIdx.x < 32 && rep_ == 0) { const int b = blockIdx.x - 16; const int which = b / 8;
            pg8::Gemm g{(const f16*)(ws + WS_MEMN), (const f16*)(ws + (which == 0 ? WS_WKT : WS_WVT)), D, D, D, nullptr}; pg8::StaticOrder S; S.init(256, D, 8, b % 8);
            pg8::EpiF16 E{(f16*)(ws + (which == 0 ? WS_KM : WS_VM)), D, 1.f}; pg8::gemm_phase<pg8::EpiF16, pg8::StaticOrder, true>(lds, g, S, E); }
        __syncthreads();
        p_nsa(args, lds, rep_);
        if (BOTH(3) || rep_ + 1 < NREP(3)) GRID_BAR();
    }
    for (int rep_ = 0; rep_ < NREP(5); ++rep_) if (IN(5)) {
        p_rwkv_out(args, lds);
        __syncthreads();
        PH_IDS;
        if (blockIdx.x < 64) { const int b = blockIdx.x; const int grp = b / 8, c = b % 8;
          if (grp < 4) { const int h = grp;
              pg8::Gemm g{(const f16*)(ws + WS_KM) + h * 512, (const f16*)(ws + WS_WQ16) + h * 512, D, D, 512, nullptr}; pg8::StaticOrder S; S.init(256, D, 8, c);
              pg8::EpiF16 E{(f16*)(ws + WS_WQK) + (size_t)h * 256 * D, D, 0.04419417382415922f}; pg8::gemm_phase<pg8::EpiF16, pg8::StaticOrder, true>(lds, g, S, E); }
          else { const int h = grp - 4;
              pg8::Gemm g{(const f16*)(ws + WS_WOT) + h * 512, (const f16*)(ws + WS_VM) + h * 512, D, D, 512, nullptr}; pg8::StaticOrder S; S.init(D, 256, 8, c);
              pg8::EpiF16 E{(f16*)(ws + WS_VOT) + h * 256, 1024, 1.f}; pg8::gemm_phase<pg8::EpiF16, pg8::StaticOrder, true>(lds, g, S, E); } }
        else {
        const float* onsa = (const float*)(ws + WS_ONSA); f16* mix = (f16*)(ws + WS_MIX);
        for (int m = gw - 64 * 8; m < T; m += NGW - 64 * 8) { const f32x4* xr = (const f32x4*)(onsa + (size_t)m * 1024) + lane; f32x4 v[4]; float s = 0.f;
#pragma unroll
            for (int j = 0; j < 4; ++j) { v[j] = xr[64 * j]; s += v[j].x * v[j].x + v[j].y * v[j].y + v[j].z * v[j].z + v[j].w * v[j].w; }
            const f32x4* gr = (const f32x4*)args.in[I_NSAG] + lane; f32x4 gg[4];
#pragma unroll
            for (int j = 0; j < 4; ++j) gg[j] = gr[64 * j];
            const float rstd = rsqrtf(wave_sum(s) * (1.f / 1024.f) + EPS); u32x2* o8 = (u32x2*)(mix + (size_t)m * D) + lane;
#pragma unroll
            for (int j = 0; j < 4; ++j) { u32x2 w; w.x = pkh(v[j].x * rstd * gg[j].x, v[j].y * rstd * gg[j].y); w.y = pkh(v[j].z * rstd * gg[j].z, v[j].w * rstd * gg[j].w); o8[64 * j] = w; } }
        }
        if (BOTH(5) || rep_ + 1 < NREP(5)) GRID_BAR();
    }
    for (int rep_ = 0; rep_ < NREP(6); ++rep_) if (IN(6)) {
        pg8::Gemm g{(const f16*)(ws + WS_MIX), (const f16*)(ws + WS_WOUT), D, D, D, nullptr}; pg8::StaticOrder S; S.init(T, D, G, (int)blockIdx.x);
        pg8::EpiRes16 E{(float*)(ws + WS_X1), args.in[I_X], (f16*)(ws + WS_H2), (float*)(ws + WS_CTL + WS_ROWSS), D}; pg8::gemm_phase<pg8::EpiRes16, pg8::StaticOrder, true>(lds, g, S, E);
        if (BOTH(6) || rep_ + 1 < NREP(6)) GRID_BAR();
    }
    for (int rep_ = 0; rep_ < NREP(7); ++rep_) if (IN(7)) {
        PH_IDS;
        p_moe_weights(args, lds);
        if (BOTH(7) || rep_ + 1 < NREP(7)) GRID_BAR();
    }
    for (int rep_ = 0; rep_ < NREP(8); ++rep_) if (IN(8)) {
        pg8::Gemm g{(const f16*)(ws + WS_H2), (const f16*)(ws + WS_WQK), D, D, D, nullptr}; pg8::StaticOrder S; S.init(T, 1024, G, (int)blockIdx.x);
        pg8::EpiSoftmax E{(f16*)(ws + WS_P), 1024, (const float*)(ws + WS_CTL + WS_ROWSS), (LAS float*)(lds + RING_BYTES), (LAS float*)(lds + RING_BYTES + 4096)}; pg8::gemm_phase<pg8::EpiSoftmax, pg8::StaticOrder, true>(lds, g, S, E);
        if (BOTH(8) || rep_ + 1 < NREP(8)) GRID_BAR();
    }
    for (int rep_ = 0; rep_ < NREP(10); ++rep_) if (IN(10)) {
        pg8::Gemm g{(const f16*)(ws + WS_P), (const f16*)(ws + WS_VOT), 1024, 1024, 1024, nullptr}; pg8::StaticOrder S; S.init(T, D, G, (int)blockIdx.x);
        pg8::EpiF32 E{(float*)(ws + WS_X1), (const float*)(ws + WS_X1), D}; pg8::gemm_phase<pg8::EpiF32, pg8::StaticOrder, true>(lds, g, S, E);
        if (BOTH(10) || rep_ + 1 < NREP(10)) GRID_BAR();
    }
    for (int rep_ = 0; rep_ < NREP(11); ++rep_) if (IN(11)) { p_router(args, lds, rep_); if (BOTH(11) || rep_ + 1 < NREP(11)) GRID_BAR(); }
    for (int rep_ = 0; rep_ < NREP(13); ++rep_) if (IN(13)) { p_slots(args, lds, rep_); if (BOTH(13) || rep_ + 1 < NREP(13)) GRID_BAR(); }
    for (int rep_ = 0; rep_ < NREP(14); ++rep_) if (IN(14)) {
        pg8::Gemm g{(const f16*)args.out, (const f16*)(ws + WS_WGU), D, D, D, (const int*)(ws + WS_TOK + TK_STOK)};
        pg8::TableOrder S{(const int2*)(ctl + CW_UGU), (int)ctl[CW_NGU], G, (int)blockIdx.x};
        pg8::EpiSilu E{(f16*)(ws + WS_HID)}; pg8::gemm_phase<pg8::EpiSilu, pg8::TableOrder, true, true>(lds, g, S, E);
        if (BOTH(14) || rep_ + 1 < NREP(14)) GRID_BAR();
    }
    for (int rep_ = 0; rep_ < NREP(15); ++rep_) if (IN(15)) {
        pg8::Gemm g{(const f16*)(ws + WS_HID), (const f16*)(ws + WS_WD), EFF, EFF, EFF, nullptr};
        pg8::TableOrder S{(const int2*)(ctl + CW_UDN), (int)ctl[CW_NDN], G, (int)blockIdx.x};
        pg8::EpiDown E{ws}; pg8::gemm_phase<pg8::EpiDown, pg8::TableOrder, true>(lds, g, S, E);
        if (BOTH(15) || rep_ + 1 < NREP(15)) GRID_BAR();
    }
    for (int rep_ = 0; rep_ < NREP(16); ++rep_) if (IN(16)) {
        PH_IDS;
        const float* x2 = (const float*)(ws + WS_X1); const int* tks = (const int*)(ws + WS_TOK + TK_SLOT);
        const float* tkw = (const float*)(ws + WS_TOK + TK_W);
        for (int m0_ = gw; m0_ < T; m0_ += 2 * NGW) {
            const int mm[2] = {m0_, (m0_ + NGW < T) ? m0_ + NGW : m0_};
            int sa[2][2]; float wa[2][2];
#pragma unroll
            for (int q = 0; q < 2; ++q) { sa[q][0] = tks[mm[q] * 2]; sa[q][1] = tks[mm[q] * 2 + 1]; wa[q][0] = tkw[mm[q] * 2]; wa[q][1] = tkw[mm[q] * 2 + 1]; }
            f32x4 v[2][8]; f16x4 ya[2][2][8];
#pragma unroll
            for (int q = 0; q < 2; ++q) { const f32x4* xr = (const f32x4*)(x2 + (size_t)mm[q] * D) + lane;
#pragma unroll
                for (int j = 0; j < 8; ++j) v[q][j] = xr[64 * j];
#pragma unroll
                for (int k = 0; k < 2; ++k) { const int sl = sa[q][k]; const f16* yp = (const f16*)(ws + ((sl >> 8) < 128 ? WS_Y0 + (size_t)(sl >> 8) * MiB : WS_Y1 + (size_t)((sl >> 8) - 128) * MiB)) + (size_t)(sl & 255) * D;
#pragma unroll
                    for (int j = 0; j < 8; ++j) ya[q][k][j] = *((const f16x4*)yp + lane + 64 * j); } }
            const f32x4* gr = (const f32x4*)args.in[I_LNF] + lane; f32x4 gg[8];
#pragma unroll
            for (int j = 0; j < 8; ++j) gg[j] = gr[64 * j];
#pragma unroll
            for (int q = 0; q < 2; ++q) { float s = 0.f; const float w1 = wa[q][0], w2 = wa[q][1];
#pragma unroll
                for (int j = 0; j < 8; ++j) { const f16x4 a1 = ya[q][0][j], a2 = ya[q][1][j];
                    v[q][j].x += w1 * (float)a1.x + w2 * (float)a2.x; v[q][j].y += w1 * (float)a1.y + w2 * (float)a2.y; v[q][j].z += w1 * (float)a1.z + w2 * (float)a2.z; v[q][j].w += w1 * (float)a1.w + w2 * (float)a2.w;
                    s += v[q][j].x * v[q][j].x + v[q][j].y * v[q][j].y + v[q][j].z * v[q][j].z + v[q][j].w * v[q][j].w; }
                const float rstd = rsqrtf(wave_sum(s) * (1.f / D) + EPS);
                if (q == 0 || mm[1] != mm[0]) { f32x4* o = (f32x4*)(args.out + (size_t)mm[q] * D) + lane;
#pragma unroll
                    for (int j = 0; j < 8; ++j) o[64 * j] = (f32x4){v[q][j].x * rstd * gg[j].x, v[q][j].y * rstd * gg[j].y, v[q][j].z * rstd * gg[j].z, v[q][j].w * rstd * gg[j].w}; } }
        }
    }
#undef IN
#undef BOTH
#undef GRID_BAR
}

extern "C" void kernel_launch(void* const* d_in, const int* in_sizes, int n_in, void* d_out, int out_size, void* d_ws, size_t ws_size, hipStream_t stream) {
    static int grid = 0;
    if (grid == 0) {
        if (n_in != 38 || out_size != T * D || ws_size < WS_END) { fprintf(stderr, "kernel_launch: unexpected shapes (n_in %d out %d ws %zu)\n", n_in, out_size, ws_size); grid = -1; return; }
        int dev = 0, cus = 0;
        if (hipGetDevice(&dev) != hipSuccess || hipDeviceGetAttribute(&cus, hipDeviceAttributeMultiprocessorCount, dev) != hipSuccess) { grid = -1; return; }
        if (hipFuncSetAttribute((const void*)mega, hipFuncAttributeMaxDynamicSharedMemorySize, LDS_BYTES) != hipSuccess) { grid = -1; return; }
        int per_cu = 0; (void)hipOccupancyMaxActiveBlocksPerMultiprocessor(&per_cu, (const void*)mega, 512, LDS_BYTES); (void)hipGetLastError();
        grid = cus;
    }
    if (grid < 0) return;
    (void)hipMemsetAsync((char*)d_ws + WS_CTL, 0, CTL_ZERO_BYTES, stream);
    Args a{};
    for (int i = 0; i < 38; ++i) a.in[i] = (const float*)d_in[i];
    a.out = (float*)d_out; a.ws = (unsigned char*)d_ws;
#if MK_ONE_LAUNCH
    a.ph_lo = 0; a.ph_hi = NPH;
    hipLaunchKernelGGL(mega, dim3(grid), dim3(512), LDS_BYTES, stream, a);
#else
    for (int p = 0; p < NPH; ++p) { a.ph_lo = p; a.ph_hi = p + 1; hipLaunchKernelGGL(mega, dim3(grid), dim3(512), LDS_BYTES, stream, a); }
#endif
}
```

```cpp
#include <hip/hip_runtime.h>
#include <cstdio>
#include <cstdint>

#ifndef DUPMASK
#define DUPMASK 0u
#endif
#ifndef NSA_SELREP
#define NSA_SELREP 1
#endif
#ifndef NSA_CMPREP
#define NSA_CMPREP 1
#endif
#ifndef NSA_WINREP
#define NSA_WINREP 1
#endif
#ifndef DUPX
#define DUPX 0
#endif
#ifndef NSA_DECOUPLED
#define NSA_DECOUPLED 0
#endif
#ifndef MK_ONE_LAUNCH
#define MK_ONE_LAUNCH 1
#endif

#define LAS __attribute__((address_space(3)))
#define GAS __attribute__((address_space(1)))
typedef _Float16 f16;
typedef _Float16 f16x8 __attribute__((ext_vector_type(8)));
typedef _Float16 f16x4 __attribute__((ext_vector_type(4)));
typedef _Float16 f16x2 __attribute__((ext_vector_type(2)));
typedef float f32x4 __attribute__((ext_vector_type(4)));
typedef float f32x2 __attribute__((ext_vector_type(2)));
typedef unsigned u32x4 __attribute__((ext_vector_type(4)));
typedef unsigned u32x2 __attribute__((ext_vector_type(2)));
typedef __bf16 bf16;
typedef __bf16 bf16x8 __attribute__((ext_vector_type(8)));
typedef __bf16 bf16x4 __attribute__((ext_vector_type(4)));

constexpr int T = 16384, D = 2048, NZ = 6144;
constexpr int ZQ = 0, ZKC = 1024, ZVC = 1280, ZKS = 1536, ZVS = 1792, ZKW = 2048, ZVW = 2304, ZR = 2560, ZK = 3584, ZV = 4608, ZWD = 5632, ZAD = 5696, ZGD = 5760, ZGL = 5920;
constexpr int NCMP = 1023;
constexpr int NEXP = 32, EFF = 256, MAXSLOT = 40960, MAXTILES = 160;
constexpr float EPS = 1e-6f;

constexpr size_t MiB = 1u << 20;
constexpr size_t WS_CTL = 0, CTL_ZERO_BYTES = 192 * 1024, WS_ROWSS = 128 * 1024;
constexpr size_t WS_MEMN = 1 * MiB, WS_KM = 2 * MiB, WS_VM = 3 * MiB, WS_KCMP = 4 * MiB, WS_VCMP = 5 * MiB, WS_TOK = 6 * MiB, WS_CMPB = 7 * MiB;
constexpr size_t WS_WQK = 8 * MiB, WS_VOT = 12 * MiB, WS_WIN = 16 * MiB, WS_WOUT = 40 * MiB, WS_WQ16 = 48 * MiB, WS_WKT = 56 * MiB, WS_WVT = 64 * MiB, WS_WOT = 72 * MiB;
constexpr size_t WS_WGU = 80 * MiB, WS_WD = 144 * MiB, WS_H = 176 * MiB, WS_Z = 240 * MiB, WS_ONSA = 432 * MiB, WS_END = 512 * MiB;
constexpr size_t WS_MIX = 112 * MiB, WS_P = WS_H, WS_H2 = WS_Z, WS_X1 = 304 * MiB, WS_S = WS_ONSA, WS_HID = 16 * MiB;
constexpr size_t WS_Y0 = 176 * MiB, WS_Y1 = 432 * MiB;
constexpr size_t WS_RS = 200 * MiB, WS_SBON = 232 * MiB;
constexpr size_t WS_WUPT = WS_CMPB + 64 * 1024, WS_AUPT = WS_WUPT + 128 * 1024, WS_GUPT = WS_AUPT + 128 * 1024;
constexpr size_t WS_W1T = 496 * MiB, WS_W2T = 498 * MiB, WS_CBIAS = 498 * MiB + 65536;
constexpr size_t WS_WRH = 499 * MiB, WS_WRL = 499 * MiB + 256 * 1024;
constexpr size_t RO_M = 0, RO_N = 32 * MiB, RO_Q = 64 * MiB, RO_Y = 96 * MiB;
constexpr size_t TK_E = 0, TK_W = 128 * 1024, TK_SLOT = 256 * 1024, TK_STOK = 384 * 1024, TK_SW = 576 * 1024;
constexpr int CW_BAR = 0;
constexpr int CW_Q = 3584;
constexpr int CW_CNT = 4096, CW_CUR = 4160, CW_OFF = 4224, CW_NT = 4288  , CW_NGU = 4289, CW_NDN = 4290;
constexpr int CW_UGU = 6144  , CW_UDN = 8192  ;
static_assert((CW_UDN + MAXTILES * 8 * 2) * 4 <= (int)CTL_ZERO_BYTES, "ctl");

constexpr int RING_BYTES = 131072, LDS_BYTES = 163840, MISC_OFF = LDS_BYTES - 512;

__device__ __forceinline__ unsigned pkh(float a, float b) { f16x2 v = {(f16)a, (f16)b}; return __builtin_bit_cast(unsigned, v); }
__device__ __forceinline__ float wave_sum(float v) {
#pragma unroll
    for (int o = 1; o < 64; o <<= 1) v += __shfl_xor(v, o);
    return v;
}
__device__ __forceinline__ float wave_max(float v) {
#pragma unroll
    for (int o = 1; o < 64; o <<= 1) v = fmaxf(v, __shfl_xor(v, o));
    return v;
}
__device__ __forceinline__ int opaque_tid() { int t = threadIdx.x; asm volatile("" : "+v"(t)); return t; }
#define LDS_WAIT() asm volatile("s_waitcnt lgkmcnt(0)" ::: "memory")
#define VM_WAIT() asm volatile("s_waitcnt vmcnt(0)" ::: "memory")
__device__ __forceinline__ float sigmoidf_(float x) { return 1.f / (1.f + __expf(-x)); }

namespace pg8 {
constexpr int BM = 256, BK = 64, HALF = 128, HTB = HALF * BK * 2, STAGE_BYTES = 8 * HTB, NXCD = 8, WGM = 8;
__host__ __device__ __forceinline__ int lds_byte(int r, int c) { const int st = (r >> 4) * 2 + (c >> 5), rr = r & 15, cc = c & 31, ob = rr * 64 + cc * 2; return st * 1024 + (ob ^ (((ob >> 9) & 1) << 5)); }
__host__ __device__ __forceinline__ void stage_rc(int b, int& R, int& C) { const int st = b / 1024, sb = b % 1024, swz = sb ^ (((sb >> 9) & 1) << 5); R = (st >> 1) * 16 + swz / 64; C = (st & 1) * 32 + (swz % 64) / 2; }
__host__ __device__ __forceinline__ int perm32(int rho) { const int n = rho >> 4, i = rho & 15; return 8 * (i >> 2) + 4 * n + (i & 3); }

struct Unit { int pm, pn; };
struct Gemm { const f16* A; const f16* Bt; int lda, ldb, K; const int* gather; };

struct StaticOrder {
    int nM, nN, nwg, G, c;
    __host__ __device__ void init(int M, int N, int G_, int c_) { nM = M / BM; nN = N / BM; nwg = nM * nN; G = G_; c = c_; }
    __host__ __device__ bool next(int i, Unit& u) const {
        const long L = (long)i * G + c; if (L >= nwg) return false;
        int wgid = (int)L; { const int q = nwg / NXCD, r = nwg % NXCD, xcd = wgid % NXCD, off = wgid / NXCD; wgid = (xcd < r ? xcd * (q + 1) : r * (q + 1) + (xcd - r) * q) + off; }
        const int nig = WGM * nN, gid = wgid / nig, fm = gid * WGM, gsz = (nM - fm) < WGM ? (nM - fm) : WGM;
        u.pm = fm + ((wgid % nig) % gsz); u.pn = (wgid % nig) / gsz; return true;
    }
};
struct TableOrder {
    const int2* tab; int n, G, c;
    __device__ bool next(int i, Unit& u) const { const int L = i * G + c; if (L >= n) return false; const int2 v = tab[L]; u.pm = v.x; u.pn = v.y; return true; }
};

struct EpiF16 {
    static constexpr bool PERM = true;
    f16* O; int ldc; float scale;
    __device__ __forceinline__ void operator()(const f32x4 (&acc)[2][2][4][2], const Unit& u, int wr, int wc, int fr, int fq) const {
        const int row0 = u.pm * BM + wr * 64 + fr, col0 = u.pn * BM + wc * 32 + 8 * fq;
#pragma unroll
        for (int ai = 0; ai < 2; ++ai)
#pragma unroll
            for (int m = 0; m < 4; ++m) { f16* rowp = O + (size_t)(row0 + ai * HALF + m * 16) * ldc + col0;
#pragma unroll
                for (int bj = 0; bj < 2; ++bj) { const f32x4 v0 = acc[ai][bj][m][0] * scale, v1 = acc[ai][bj][m][1] * scale;
                    u32x4 w; w.x = pkh(v0[0], v0[1]); w.y = pkh(v0[2], v0[3]); w.z = pkh(v1[0], v1[1]); w.w = pkh(v1[2], v1[3]);
                    *(u32x4*)(rowp + bj * HALF) = w; } }
    }
};
struct EpiF32 {
    static constexpr bool PERM = false;
    float* C; const float* R; int ldc;
    __device__ __forceinline__ void operator()(const f32x4 (&acc)[2][2][4][2], const Unit& u, int wr, int wc, int fr, int fq) const {
        const int row0 = u.pm * BM + wr * 64 + fr, col0 = u.pn * BM + wc * 32 + 4 * fq;
#pragma unroll
        for (int ai = 0; ai < 2; ++ai)
#pragma unroll
            for (int m = 0; m < 4; ++m) { const size_t ro = (size_t)(row0 + ai * HALF + m * 16) * ldc + col0;
#pragma unroll
                for (int bj = 0; bj < 2; ++bj)
#pragma unroll
                    for (int n = 0; n < 2; ++n) { f32x4 v = acc[ai][bj][m][n]; if (R) v = v + *(const f32x4*)(R + ro + bj * HALF + n * 16); *(f32x4*)(C + ro + bj * HALF + n * 16) = v; } }
    }
};
struct EpiRes16 {
    static constexpr bool PERM = false;
    float* C; const float* R; f16* H; float* rowss; int ldc;
    __device__ __forceinline__ void operator()(const f32x4 (&acc)[2][2][4][2], const Unit& u, int wr, int wc, int fr, int fq) const {
        const int row0 = u.pm * BM + wr * 64 + fr, col0 = u.pn * BM + wc * 32 + 4 * fq;
#pragma unroll
        for (int ai = 0; ai < 2; ++ai)
#pragma unroll
            for (int m = 0; m < 4; ++m) { const int row = row0 + ai * HALF + m * 16; const size_t ro = (size_t)row * ldc + col0; float ss = 0.f;
                f32x4 v[2][2];
#pragma unroll
                for (int bj = 0; bj < 2; ++bj)
#pragma unroll
                    for (int n = 0; n < 2; ++n) v[bj][n] = acc[ai][bj][m][n] + *(const f32x4*)(R + ro + bj * HALF + n * 16);
#pragma unroll
                for (int bj = 0; bj < 2; ++bj)
#pragma unroll
                    for (int n = 0; n < 2; ++n) { const f32x4 x = v[bj][n]; *(f32x4*)(C + ro + bj * HALF + n * 16) = x; ss += x.x * x.x + x.y * x.y + x.z * x.z + x.w * x.w;
                        u32x2 hw; hw.x = pkh(x.x, x.y); hw.y = pkh(x.z, x.w); *(u32x2*)(H + ro + bj * HALF + n * 16) = hw; }
                ss += __shfl_xor(ss, 16); ss += __shfl_xor(ss, 32);
                if (fq == 0) atomicAdd(rowss + row, ss); }
    }
};
struct EpiSoftmax {
    static constexpr bool PERM = true;
    f16* O; int ldc; const float* rowss; LAS float* xm; LAS float* xs;
    __device__ __forceinline__ void operator()(const f32x4 (&acc)[2][2][4][2], const Unit& u, int wr, int wc, int fr, int fq) const {
        const int row0 = u.pm * BM + wr * 64 + fr, col0 = u.pn * BM + wc * 32 + 8 * fq;
        float rs[2][4], mx[2][4];
#pragma unroll
        for (int ai = 0; ai < 2; ++ai)
#pragma unroll
            for (int m = 0; m < 4; ++m) { rs[ai][m] = rsqrtf(rowss[row0 + ai * HALF + m * 16] * (1.f / D) + EPS); float v = -INFINITY;
#pragma unroll
                for (int bj = 0; bj < 2; ++bj)
#pragma unroll
                    for (int n = 0; n < 2; ++n)
#pragma unroll
                        for (int e = 0; e < 4; ++e) v = fmaxf(v, acc[ai][bj][m][n][e]);
                v *= rs[ai][m]; v = fmaxf(v, __shfl_xor(v, 16)); v = fmaxf(v, __shfl_xor(v, 32));
                if (fq == 0) xm[(ai * HALF + wr * 64 + m * 16 + fr) * 4 + wc] = v; }
        asm volatile("s_waitcnt lgkmcnt(0)" ::: "memory"); __builtin_amdgcn_s_barrier(); asm volatile("" ::: "memory");
        float e_[2][4][16]; float inv[2][4];
#pragma unroll
        for (int ai = 0; ai < 2; ++ai)
#pragma unroll
            for (int m = 0; m < 4; ++m) { const LAS f32x4* q = (const LAS f32x4*)(xm + (ai * HALF + wr * 64 + m * 16 + fr) * 4); const f32x4 mm = *q; mx[ai][m] = fmaxf(fmaxf(mm.x, mm.y), fmaxf(mm.z, mm.w)); float sm = 0.f;
#pragma unroll
                for (int bj = 0; bj < 2; ++bj)
#pragma unroll
                    for (int n = 0; n < 2; ++n)
#pragma unroll
                        for (int e = 0; e < 4; ++e) { const float ev = __expf(acc[ai][bj][m][n][e] * rs[ai][m] - mx[ai][m]); e_[ai][m][bj * 8 + n * 4 + e] = ev; sm += ev; }
                sm += __shfl_xor(sm, 16); sm += __shfl_xor(sm, 32);
                if (fq == 0) xs[(ai * HALF + wr * 64 + m * 16 + fr) * 4 + wc] = sm; }
        asm volatile("s_waitcnt lgkmcnt(0)" ::: "memory"); __builtin_amdgcn_s_barrier(); asm volatile("" ::: "memory");
#pragma unroll
        for (int ai = 0; ai < 2; ++ai)
#pragma unroll
            for (int m = 0; m < 4; ++m) { const f32x4 ssum = *(const LAS f32x4*)(xs + (ai * HALF + wr * 64 + m * 16 + fr) * 4); inv[ai][m] = 1.f / ((ssum.x + ssum.y) + (ssum.z + ssum.w));
                f16* rowp = O + (size_t)(row0 + ai * HALF + m * 16) * ldc + col0;
#pragma unroll
                for (int bj = 0; bj < 2; ++bj) { const float* ee = &e_[ai][m][bj * 8]; const float iv = inv[ai][m];
                    u32x4 w; w.x = pkh(ee[0] * iv, ee[1] * iv); w.y = pkh(ee[2] * iv, ee[3] * iv); w.z = pkh(ee[4] * iv, ee[5] * iv); w.w = pkh(ee[6] * iv, ee[7] * iv);
                    *(u32x4*)(rowp + bj * HALF) = w; } }
    }
};
struct EpiSilu {
    static constexpr bool PERM = true;
    f16* O;
    __device__ __forceinline__ void operator()(const f32x4 (&acc)[2][2][4][2], const Unit& u, int wr, int wc, int fr, int fq) const {
        const int row0 = u.pm * BM + wr * 64 + fr, col0 = (u.pn & 1) * 128 + wc * 32 + 8 * fq;
#pragma unroll
        for (int ai = 0; ai < 2; ++ai)
#pragma unroll
            for (int m = 0; m < 4; ++m) { f16* rowp = O + (size_t)(row0 + ai * HALF + m * 16) * EFF + col0;
                float h[8];
#pragma unroll
                for (int n = 0; n < 2; ++n)
#pragma unroll
                    for (int e = 0; e < 4; ++e) { const float gt = acc[ai][0][m][n][e], up = acc[ai][1][m][n][e]; h[n * 4 + e] = gt / (1.f + __expf(-gt)) * up; }
                u32x4 w; w.x = pkh(h[0], h[1]); w.y = pkh(h[2], h[3]); w.z = pkh(h[4], h[5]); w.w = pkh(h[6], h[7]);
                *(u32x4*)rowp = w; }
    }
};
struct EpiDown {
    static constexpr bool PERM = true;
    unsigned char* ws;
    __device__ __forceinline__ void operator()(const f32x4 (&acc)[2][2][4][2], const Unit& u, int wr, int wc, int fr, int fq) const {
        f16* tile = (f16*)(ws + (u.pm < 128 ? WS_Y0 + (size_t)u.pm * MiB : WS_Y1 + (size_t)(u.pm - 128) * MiB));
        const int r0 = wr * 64 + fr, col0 = (u.pn & 7) * BM + wc * 32 + 8 * fq;
#pragma unroll
        for (int ai = 0; ai < 2; ++ai)
#pragma unroll
            for (int m = 0; m < 4; ++m) { f16* rowp = tile + (size_t)(r0 + ai * HALF + m * 16) * D + col0;
#pragma unroll
                for (int bj = 0; bj < 2; ++bj) { const f32x4 v0 = acc[ai][bj][m][0], v1 = acc[ai][bj][m][1];
                    u32x4 w; w.x = pkh(v0[0], v0[1]); w.y = pkh(v0[2], v0[3]); w.z = pkh(v1[0], v1[1]); w.w = pkh(v1[2], v1[3]);
                    *(u32x4*)(rowp + bj * HALF) = w; } }
    }
};

template <class Epi, class Sched, bool ALIGN_EPI, bool GATHER = false>
__device__ __forceinline__ void gemm_phase(LAS unsigned char* lds, const Gemm g, const Sched& S, const Epi& E) {
    const int tid = opaque_tid(), wid = __builtin_amdgcn_readfirstlane(tid >> 6), lane = tid & 63, wr = wid >> 2, wc = wid & 3, fr = lane & 15, fq = lane >> 4;
    const int K = g.K, nt = K / BK;
    int RA[2], CA[2]; unsigned voffA[2], voffB[2];
#pragma unroll
    for (int i = 0; i < 2; ++i) { int R, C; stage_rc(tid * 16 + i * 8192, R, C); const int Rb = Epi::PERM ? ((R & ~31) + perm32(R & 31)) : R;
        RA[i] = R; CA[i] = C; voffA[i] = (unsigned)(R * g.lda + C) * 2u; voffB[i] = (unsigned)(Rb * g.ldb + C) * 2u; }
    const size_t kstep = (size_t)(BK * 2);
    const size_t hstepA = (size_t)HALF * g.lda * 2, tstepA = 2 * hstepA;
    const size_t hstepB = (size_t)HALF * g.ldb * 2, tstepB = 2 * hstepB;
    const unsigned ldsw = (unsigned)wid * 1024u;
    const int aoff = lds_byte(wr * 64 + fr, fq * 8), boff = lds_byte(wc * 32 + fr, fq * 8);
    const char* Ab = (const char*)g.A;
#define PG8_SA(b, h) (((b) * 2 + (h)) * HTB)
#define PG8_SB(b, h) ((4 + (b) * 2 + (h)) * HTB)
#define PG8_STAGE(bufoff, gbase, voff) do { _Pragma("unroll") for (int _i = 0; _i < 2; ++_i) \
        __builtin_amdgcn_global_load_lds((const unsigned*)((const char*)(gbase) + (voff)[_i]), (LAS unsigned*)(lds + (bufoff) + ldsw + _i * 8192), 16, 0, 0); } while (0)
#define PG8_STA_CUR(bufoff, h, kb) do { if constexpr (GATHER) { PG8_STAGE(bufoff, Ab + (kb), offC[h]); } else { PG8_STAGE(bufoff, cA + (h) * hstepA + (kb), voffA); } } while (0)
#define PG8_STA_SEL(bufoff, h, kb) do { if constexpr (GATHER) { PG8_STAGE(bufoff, Ab + (kb), o2[h]); } else { PG8_STAGE(bufoff, a2p + (h) * hstepA + (kb), voffA); } } while (0)
#define PG8_LDA(dst, b, h) do { _Pragma("unroll") for (int m = 0; m < 4; ++m) _Pragma("unroll") for (int k = 0; k < 2; ++k) dst[m][k] = *(const LAS f16x8*)(lds + PG8_SA(b, h) + aoff + m * 2048 + k * 1024); } while (0)
#define PG8_LDB(dst, b, h) do { _Pragma("unroll") for (int n = 0; n < 2; ++n) _Pragma("unroll") for (int k = 0; k < 2; ++k) dst[n][k] = *(const LAS f16x8*)(lds + PG8_SB(b, h) + boff + n * 2048 + k * 1024); } while (0)
#define PG8_MMA(ai, bj, At, Bt) do { __builtin_amdgcn_s_setprio(1); _Pragma("unroll") for (int m = 0; m < 4; ++m) _Pragma("unroll") for (int n = 0; n < 2; ++n) _Pragma("unroll") for (int k = 0; k < 2; ++k) \
        acc[ai][bj][m][n] = __builtin_amdgcn_mfma_f32_16x16x32_f16(Bt[n][k], At[m][k], acc[ai][bj][m][n], 0, 0, 0); __builtin_amdgcn_s_setprio(0); } while (0)
#define PG8_WAIT_V(n) asm volatile("s_waitcnt vmcnt(" #n ")" ::: "memory")
#define PG8_WAIT_L(n) asm volatile("s_waitcnt lgkmcnt(" #n ")" ::: "memory")
#define PG8_BAR __builtin_amdgcn_s_barrier()
#define PG8_SCHED __builtin_amdgcn_sched_barrier(0)
#define PG8_OFFS(dst, U) do { _Pragma("unroll") for (int _h = 0; _h < 2; ++_h) _Pragma("unroll") for (int _i = 0; _i < 2; ++_i) { \
        const int _r = (U).pm * BM + _h * HALF + RA[_i]; dst[_h][_i] = ((unsigned)g.gather[_r] * (unsigned)g.lda + (unsigned)CA[_i]) * 2u; } } while (0)
    Unit cur, nxt; int ui = 0;
    if (!S.next(0, cur)) return;
    f32x4 acc[2][2][4][2];
#pragma unroll
    for (int a = 0; a < 2; ++a)
#pragma unroll
        for (int b = 0; b < 2; ++b)
#pragma unroll
            for (int m = 0; m < 4; ++m)
#pragma unroll
                for (int n = 0; n < 2; ++n) acc[a][b][m][n] = (f32x4){0.f, 0.f, 0.f, 0.f};
    f16x8 At[4][2], B0[2][2], B1[2][2];
    unsigned offC[2][2], offN[2][2];
    if constexpr (GATHER) { PG8_OFFS(offC, cur); }
    const char* cA = Ab + (size_t)cur.pm * tstepA;
    const char* cB = (const char*)g.Bt + (size_t)cur.pn * tstepB;
    PG8_STAGE(PG8_SB(0, 0), cB, voffB); PG8_STAGE(PG8_SB(0, 1), cB + hstepB, voffB); PG8_STA_CUR(PG8_SA(0, 0), 0, 0); PG8_STA_CUR(PG8_SA(0, 1), 1, 0);
    if (wr == 1) PG8_BAR;
    PG8_WAIT_V(2); PG8_BAR;
    PG8_STAGE(PG8_SB(1, 0), cB + kstep, voffB); PG8_STA_CUR(PG8_SA(1, 0), 0, kstep); PG8_STAGE(PG8_SB(1, 1), cB + hstepB + kstep, voffB);
    PG8_WAIT_V(6); PG8_BAR;
    for (;;) {
        const bool has_next = S.next(ui + 1, nxt);
        if constexpr (GATHER) {
            if (has_next) { PG8_OFFS(offN, nxt); } else {
#pragma unroll
                for (int _h = 0; _h < 2; ++_h)
#pragma unroll
                    for (int _i = 0; _i < 2; ++_i) offN[_h][_i] = offC[_h][_i]; } }
        const char* nA = has_next ? Ab + (size_t)nxt.pm * tstepA : cA;
        const char* nB = has_next ? (const char*)g.Bt + (size_t)nxt.pn * tstepB : cB;
#pragma nounroll
        for (int t = 0; t < nt; t += 2) {
            const bool last = (t == nt - 2);
            const size_t kb1 = (size_t)(t + 1) * kstep;
            const size_t kb2 = last ? 0 : (size_t)(t + 2) * kstep, kb3 = kb2 + kstep;
            unsigned o2[2][2];
            if constexpr (GATHER) {
#pragma unroll
                for (int _h = 0; _h < 2; ++_h)
#pragma unroll
                    for (int _i = 0; _i < 2; ++_i) o2[_h][_i] = last ? offN[_h][_i] : offC[_h][_i]; }
            const char* a2p = last ? nA : cA;
            const char* b2 = last ? nB : cB + (size_t)(t + 2) * kstep; const char* b3 = b2 + kstep;
            PG8_LDB(B0, 0, 0); PG8_LDB(B1, 0, 1); PG8_SCHED; PG8_LDA(At, 0, 0); PG8_STA_CUR(PG8_SA(1, 1), 1, kb1);
            PG8_WAIT_V(8); PG8_WAIT_L(0); PG8_BAR; PG8_MMA(0, 0, At, B0); PG8_MMA(0, 1, At, B1); PG8_BAR; PG8_SCHED;
            PG8_LDA(At, 0, 1); PG8_STAGE(PG8_SB(0, 0), b2, voffB); PG8_STAGE(PG8_SB(0, 1), b2 + hstepB, voffB); PG8_STA_SEL(PG8_SA(0, 0), 0, kb2);
            PG8_WAIT_V(8); PG8_WAIT_L(0); PG8_BAR; PG8_MMA(1, 0, At, B0); PG8_MMA(1, 1, At, B1); PG8_BAR; PG8_SCHED;
            PG8_LDB(B0, 1, 0); PG8_LDB(B1, 1, 1); PG8_SCHED; PG8_LDA(At, 1, 0); PG8_STA_SEL(PG8_SA(0, 1), 1, kb2);
            PG8_WAIT_V(8); PG8_WAIT_L(0); PG8_BAR; PG8_MMA(0, 0, At, B0); PG8_MMA(0, 1, At, B1); PG8_BAR; PG8_SCHED;
            PG8_LDA(At, 1, 1); PG8_STAGE(PG8_SB(1, 0), b3, voffB); PG8_STAGE(PG8_SB(1, 1), b3 + hstepB, voffB); PG8_STA_SEL(PG8_SA(1, 0), 0, kb3);
            PG8_WAIT_V(8); PG8_WAIT_L(0); PG8_BAR; PG8_MMA(1, 0, At, B0); PG8_MMA(1, 1, At, B1); PG8_BAR; PG8_SCHED;
        }
        if constexpr (ALIGN_EPI) { if (wr == 0) PG8_BAR; }
        E(acc, cur, wr, wc, fr, fq);
        if (!has_next) break;
#pragma unroll
        for (int a = 0; a < 2; ++a)
#pragma unroll
            for (int b = 0; b < 2; ++b)
#pragma unroll
                for (int m = 0; m < 4; ++m)
#pragma unroll
                    for (int n = 0; n < 2; ++n) acc[a][b][m][n] = (f32x4){0.f, 0.f, 0.f, 0.f};
        cur = nxt; cA = nA; cB = nB; ++ui;
        if constexpr (GATHER) {
#pragma unroll
            for (int _h = 0; _h < 2; ++_h)
#pragma unroll
                for (int _i = 0; _i < 2; ++_i) offC[_h][_i] = offN[_h][_i]; }
        if constexpr (ALIGN_EPI) { if (wr == 1) PG8_BAR; }
    }
    PG8_WAIT_V(0);
    if constexpr (!ALIGN_EPI) { if (wr == 0) PG8_BAR; }
    PG8_BAR;
#undef PG8_SA
#undef PG8_SB
#undef PG8_STAGE
#undef PG8_STA_CUR
#undef PG8_STA_SEL
#undef PG8_LDA
#undef PG8_LDB
#undef PG8_MMA
#undef PG8_WAIT_V
#undef PG8_WAIT_L
#undef PG8_BAR
#undef PG8_SCHED
#undef PG8_OFFS
}
}

#define XB_TMO      128
#define XB_XCNT(j)  (256  + 64 * (j))
#define XB_XSUB(j)  (1280 + 64 * (j))
#define XB_XGEN(j)  (2304 + 64 * (j))
#define XB_TOP      3328
#define XB_TOPGEN   3392
#define XCD_BAR_WORDS 3456
#define XB_SPIN_CAP (1u << 22)
__device__ __forceinline__ unsigned xb_ld(unsigned* p)              { return __hip_atomic_load(p, __ATOMIC_RELAXED, __HIP_MEMORY_SCOPE_AGENT); }
__device__ __forceinline__ unsigned xb_add(unsigned* p, unsigned v) { return __hip_atomic_fetch_add(p, v, __ATOMIC_RELAXED, __HIP_MEMORY_SCOPE_AGENT); }
__device__ __forceinline__ unsigned xb_xcc_id() { return (unsigned)__builtin_amdgcn_s_getreg((3 << 11) | 20) & 0xFu; }
#define XB_SPIN(cond, bar) do { unsigned _sp = 0; while (cond) { __builtin_amdgcn_s_sleep(1); \
    if ((++_sp & 255u) == 0u) { if (xb_ld(&(bar)[XB_TMO])) break; if (_sp > XB_SPIN_CAP) { atomicAdd(&(bar)[XB_TMO], 1u); break; } } } } while (0)
struct XcdBarrier { unsigned* bar; unsigned x; volatile LAS unsigned* st; };
__device__ __forceinline__ XcdBarrier xcd_barrier_post(unsigned* bar, volatile LAS unsigned* st) {
    XcdBarrier b; b.bar = bar; b.x = xb_xcc_id(); b.st = st;
    if (threadIdx.x == 0) (void)xb_add(&bar[XB_XCNT(b.x)], 1u);
    return b;
}
__device__ __forceinline__ void xcd_barrier_complete(unsigned* bar, unsigned x, unsigned& nloc, unsigned& nx) {
    const unsigned G = gridDim.x * gridDim.y * gridDim.z;
    unsigned sum, cnt, mine, sp = 0u;
    for (;;) {
        sum = 0u; cnt = 0u; mine = 0u;
#pragma unroll
        for (unsigned j = 0; j < 16; ++j) { const unsigned c = xb_ld(&bar[XB_XCNT(j)]); sum += c; cnt += (c > 0u) ? 1u : 0u; mine = (j == x) ? c : mine; }
        if (sum == G) break;
        __builtin_amdgcn_s_sleep(1);
        if ((++sp & 255u) == 0u) { if (xb_ld(&bar[XB_TMO])) break; if (sp > XB_SPIN_CAP) { atomicAdd(&bar[XB_TMO], 1u); break; } }
    }
    nloc = mine > 0u ? mine : 1u; nx = cnt > 0u ? cnt : 1u;
}
__device__ __forceinline__ void xcd_barrier(const XcdBarrier& b) {
    asm volatile("s_waitcnt vmcnt(0)" ::: "memory");
    __syncthreads();
    if (threadIdx.x == 0) {
        unsigned* bar = b.bar;
        __builtin_amdgcn_s_waitcnt(0);
        unsigned nloc = b.st[0], nx = b.st[1];
        if (nloc == 0u) { xcd_barrier_complete(bar, b.x, nloc, nx); b.st[0] = nloc; b.st[1] = nx; }
        const unsigned old = xb_add(&bar[XB_XSUB(b.x)], 1u);
        const unsigned gen = old / nloc;
        if (old + 1u == (gen + 1u) * nloc) {
            __builtin_amdgcn_fence(__ATOMIC_RELEASE, "agent");
            asm volatile("s_waitcnt vmcnt(0)" ::: "memory");
            const unsigned og = xb_add(&bar[XB_TOP], 1u);
            const unsigned tg = og / nx;
            if (og + 1u == (tg + 1u) * nx) xb_add(&bar[XB_TOPGEN], 1u);
            else XB_SPIN(xb_ld(&bar[XB_TOPGEN]) == tg, bar);
            __builtin_amdgcn_fence(__ATOMIC_ACQUIRE, "agent");
            xb_add(&bar[XB_XGEN(b.x)], 1u);
            asm volatile("s_waitcnt vmcnt(0)" ::: "memory");
        } else {
            XB_SPIN(xb_ld(&bar[XB_XGEN(b.x)]) == gen, bar);
            __builtin_amdgcn_fence(__ATOMIC_ACQUIRE, "agent");
            asm volatile("s_waitcnt vmcnt(0)" ::: "memory");
        }
    }
    __syncthreads();
}

struct Args { const float* in[38]; float* out; unsigned char* ws; int ph_lo, ph_hi; };
enum { I_X = 0, I_MEM, I_LN1, I_WIN, I_PK, I_W1K, I_W2K, I_PV, I_W1V, I_W2V, I_NSAG, I_MU, I_W0, I_WUP, I_A0, I_AUP, I_GUP, I_KK, I_KA, I_RK, I_LNXG, I_LNXB,
       I_WOUT, I_LNMEM, I_LN2, I_WQ, I_WK, I_WV, I_WO, I_LN3, I_RGW, I_RGB, I_REW, I_REB, I_MG, I_MU2, I_MD, I_LNF };

struct TrItem { float tv[32]; f16* dst; size_t drow0; int dld, k0; };
__device__ __forceinline__ void tr_load(TrItem& it, const float* src, int sld, int k0, int scol0, int nvalid, f16* dst, size_t drow0, int dld, int lane) {
    const int nl = lane & 31; it.dst = dst; it.drow0 = drow0; it.dld = dld; it.k0 = k0;
#pragma unroll
    for (int i = 0; i < 32; ++i) { const int kk = 2 * i + (lane >> 5); it.tv[i] = (nl < nvalid) ? src[(size_t)(k0 + kk) * sld + scol0 + nl] : 0.f; }
}
__device__ __forceinline__ void tr_finish(const TrItem& it, LAS float* scr, int lane) {
    const int nl = lane & 31;
#pragma unroll
    for (int i = 0; i < 32; ++i) { const int kk = 2 * i + (lane >> 5); scr[kk * 33 + nl] = it.tv[i]; }
    LDS_WAIT(); asm volatile("" ::: "memory");
    const int c = lane & 7;
#pragma unroll
    for (int j = 0; j < 4; ++j) { const int n = (lane >> 3) + 8 * j; const LAS float* s = scr + (8 * c) * 33 + n;
        u32x4 o; o.x = pkh(s[0 * 33], s[1 * 33]); o.y = pkh(s[2 * 33], s[3 * 33]); o.z = pkh(s[4 * 33], s[5 * 33]); o.w = pkh(s[6 * 33], s[7 * 33]);
        *(u32x4*)(it.dst + (it.drow0 + n) * (size_t)it.dld + it.k0 + 8 * c) = o; }
    LDS_WAIT(); asm volatile("" ::: "memory");
}
__device__ __forceinline__ void tr_item(const float* src, int sld, int k0, int scol0, int nvalid, f16* dst, size_t drow0, int dld, LAS float* scr, int lane) {
    TrItem it; tr_load(it, src, sld, k0, scol0, nvalid, dst, drow0, dld, lane); tr_finish(it, scr, lane);
}
__device__ __forceinline__ void tr_matrix(const float* src, int K, int N, f16* dst, LAS float* scr, int gw, int NGW, int lane) {
    const int nblk = N / 32, items = (K / 64) * nblk;
    for (int it = gw; it < items; it += 2 * NGW) { TrItem a, b; const int it2 = it + NGW; const bool two = it2 < items;
        tr_load(a, src, N, (it / nblk) * 64, (it % nblk) * 32, 32, dst, (size_t)(it % nblk) * 32, K, lane);
        if (two) tr_load(b, src, N, (it2 / nblk) * 64, (it2 % nblk) * 32, 32, dst, (size_t)(it2 % nblk) * 32, K, lane);
        tr_finish(a, scr, lane); if (two) tr_finish(b, scr, lane); }
}
__device__ __forceinline__ void rms_row(const float* xrow, const float* gain, f16* o16, int lane) {
    const f32x4* xr = (const f32x4*)xrow + lane; f32x4 v[8]; float s = 0.f;
#pragma unroll
    for (int j = 0; j < 8; ++j) { v[j] = xr[64 * j]; s += v[j].x * v[j].x + v[j].y * v[j].y + v[j].z * v[j].z + v[j].w * v[j].w; }
    const f32x4* gr = (const f32x4*)gain + lane; f32x4 gg[8];
#pragma unroll
    for (int j = 0; j < 8; ++j) gg[j] = gr[64 * j];
    const float rstd = rsqrtf(wave_sum(s) * (1.f / D) + EPS);
    u32x2* o8 = (u32x2*)o16 + lane;
#pragma unroll
    for (int j = 0; j < 8; ++j) { u32x2 w; w.x = pkh(v[j].x * rstd * gg[j].x, v[j].y * rstd * gg[j].y); w.y = pkh(v[j].z * rstd * gg[j].z, v[j].w * rstd * gg[j].w); o8[64 * j] = w; }
}

__device__ __forceinline__ void p0_prologue(const Args& a, LAS unsigned char* lds) {
    const int tid = opaque_tid(), lane = tid & 63, wave = tid >> 6;
    const int gw = blockIdx.x * 8 + wave, NGW = gridDim.x * 8;
    LAS float* scr = (LAS float*)(lds + wave * 16384);
    unsigned char* ws = a.ws;
    { f16* dst = (f16*)(ws + WS_WIN); const float* src = a.in[I_WIN];
      const int nblk = NZ / 32, items = (D / 64) * nblk;
      for (int it0 = gw; it0 < items; it0 += 2 * NGW) { TrItem ta, tb; const bool two = it0 + NGW < items;
#pragma unroll
          for (int q = 0; q < 2; ++q) { if (q == 1 && !two) break; const int it = it0 + q * NGW; const int kb = it / nblk, nb = it % nblk, n0 = nb * 32;
              int sc = 0, nv = 32; if (n0 < 2560) sc = n0; else if (n0 < 5920) sc = n0 + 24; else if (n0 == 5920) { sc = 2560; nv = 24; } else { sc = 0; nv = 0; }
              tr_load(q ? tb : ta, src, 5944, kb * 64, sc, nv, dst, (size_t)n0, D, lane); }
          tr_finish(ta, scr, lane); if (two) tr_finish(tb, scr, lane); } }
    tr_matrix(a.in[I_WOUT], D, D, (f16*)(ws + WS_WOUT), scr, gw, NGW, lane);
    tr_matrix(a.in[I_WK], D, D, (f16*)(ws + WS_WKT), scr, gw, NGW, lane);
    tr_matrix(a.in[I_WV], D, D, (f16*)(ws + WS_WVT), scr, gw, NGW, lane);
    tr_matrix(a.in[I_WO], D, D, (f16*)(ws + WS_WOT), scr, gw, NGW, lane);
    { const f32x4* s = (const f32x4*)a.in[I_WQ]; u32x2* d = (u32x2*)(ws + WS_WQ16);
      for (size_t i = (size_t)blockIdx.x * 512 + tid; i < (size_t)D * D / 4; i += (size_t)gridDim.x * 512) { const f32x4 v = s[i]; const float gsc = a.in[I_LN2][i / (D / 4)]; u32x2 w; w.x = pkh(v.x * gsc, v.y * gsc); w.y = pkh(v.z * gsc, v.w * gsc); d[i] = w; } }
    tr_matrix(a.in[I_W1K], 4096, 128, (f16*)(ws + WS_W1T), scr, gw, NGW, lane);
    tr_matrix(a.in[I_W1V], 4096, 128, (f16*)(ws + WS_W1T) + 128 * 4096, scr, gw, NGW, lane);
    tr_matrix(a.in[I_W2K], 128, 128, (f16*)(ws + WS_W2T), scr, gw, NGW, lane);
    tr_matrix(a.in[I_W2V], 128, 128, (f16*)(ws + WS_W2T) + 128 * 128, scr, gw, NGW, lane);
    for (int o = gw; o < 256; o += NGW) { const int kv = o >> 7, n = o & 127; const float* pos = a.in[kv ? I_PV : I_PK]; const float* w1 = a.in[kv ? I_W1V : I_W1K]; float acc = 0.f;
        for (int k = lane; k < 4096; k += 64) acc += pos[k] * w1[(size_t)k * 128 + n];
        acc = wave_sum(acc); if (lane == 0) ((float*)(ws + WS_CBIAS))[o] = acc; }
    for (int i = blockIdx.x * 512 + tid; i < 48 * D; i += gridDim.x * 512) { const int c = i / D, k = i % D; float v = 0.f;
        if (c < 4) v = a.in[I_RGW][k * 4 + c]; else if (c < 36) v = a.in[I_REW][k * 32 + (c - 4)];
        v *= a.in[I_LN3][k]; const f16 hi = (f16)v; ((f16*)(ws + WS_WRH))[i] = hi; ((f16*)(ws + WS_WRL))[i] = (f16)(v - (float)hi); }
    { bf16* wu = (bf16*)(ws + WS_WUPT); bf16* au = (bf16*)(ws + WS_AUPT); bf16* gu = (bf16*)(ws + WS_GUPT);
      for (int i = blockIdx.x * 512 + tid; i < 1024 * 64; i += gridDim.x * 512) { const int ch = i >> 6, j = i & 63; wu[i] = (bf16)a.in[I_WUP][j * 1024 + ch]; au[i] = (bf16)a.in[I_AUP][j * 1024 + ch]; }
      for (int i = blockIdx.x * 512 + tid; i < 1024 * 160; i += gridDim.x * 512) { const int ch = i / 160, j = i % 160; gu[i] = (bf16)a.in[I_GUP][j * 1024 + ch]; } }
    for (int m = gw; m < T; m += NGW) rms_row(a.in[I_X] + (size_t)m * D, a.in[I_LN1], (f16*)(ws + WS_H) + (size_t)m * D, lane);
    for (int m = gw; m < 256; m += NGW) rms_row(a.in[I_MEM] + (size_t)m * D, a.in[I_LNMEM], (f16*)(ws + WS_MEMN) + (size_t)m * D, lane);
}

__device__ __forceinline__ void p_moe_weights(const Args& a, LAS unsigned char* lds) {
    const int tid = opaque_tid(), lane = tid & 63, wave = tid >> 6;
    const int gw = blockIdx.x * 8 + wave, NGW = gridDim.x * 8;
    LAS float* scr = (LAS float*)(lds + wave * 16384);
    unsigned char* ws = a.ws;
    { f16* dst = (f16*)(ws + WS_WGU); const int items = NEXP * (D / 64) * 16;
      for (int it = gw; it < items; it += NGW) { const int e = it / ((D / 64) * 16), r = it % ((D / 64) * 16), kb = r / 16, nb = r % 16, j0 = nb * 32, jt = j0 / 256, jj = j0 % 256;
          const float* src = (jj < 128 ? a.in[I_MG] : a.in[I_MU2]) + (size_t)e * D * EFF; const int sc = jt * 128 + (jj & 127);
          tr_item(src, EFF, kb * 64, sc, 32, dst, (size_t)e * 512 + j0, D, scr, lane); } }
    { f16* dst = (f16*)(ws + WS_WD); const int items = NEXP * (EFF / 64) * (D / 32);
      for (int it = gw; it < items; it += NGW) { const int e = it / ((EFF / 64) * (D / 32)), r = it % ((EFF / 64) * (D / 32)), kb = r / (D / 32), nb = r % (D / 32);
          tr_item(a.in[I_MD] + (size_t)e * EFF * D, D, kb * 64, nb * 32, 32, dst, (size_t)e * D + nb * 32, EFF, scr, lane); } }
}

__device__ __forceinline__ float gelu_tanh(float x) { const float u = 0.7978845608028654f * (x + 0.044715f * x * x * x); const float e = __expf(2.f * u); return 0.5f * x * (2.f - 2.f / (e + 1.f)); }
constexpr int CP_RS = 272, CP_HS = 136, CP_HID = 272 * CP_RS;
__device__ __forceinline__ void p_compress(const Args& a, LAS unsigned char* lds) {
    const int tid = opaque_tid(), lane = tid & 63, w = __builtin_amdgcn_readfirstlane(tid >> 6);
    const f16* z = (const f16*)(a.ws + WS_Z);
    LAS f16* HID = (LAS f16*)(lds + CP_HID);
    for (int it = blockIdx.x; it < 256; it += gridDim.x) {
        const int kv = it >> 7, g = (it >> 6) & 1, c0 = (it & 63) * 16, tok0 = 16 * c0;
        const int zc = (kv ? ZVC : ZKC) + g * 128;
        __syncthreads();
        for (int ck = tid; ck < 272 * 16; ck += 512) { const int tl = ck >> 4, c16 = ck & 15, tok = tok0 + tl; const int rp = (tl & 15) * 17 + (tl >> 4);
            u32x4 v = {0u, 0u, 0u, 0u}; if (tok < T) v = *(const u32x4*)(z + (size_t)tok * NZ + zc + c16 * 8);
            *(LAS u32x4*)(lds + rp * CP_RS + c16 * 16) = v; }
        __syncthreads();
        f32x4 acc = {0.f, 0.f, 0.f, 0.f};
        const f16* wp = (const f16*)(a.ws + WS_W1T) + ((size_t)kv * 128 + 16 * w + (lane & 15)) * 4096 + 8 * (lane >> 4);
        const LAS unsigned char* ap = lds + (lane & 15) * CP_RS + 16 * (lane >> 4);
#pragma unroll 8
        for (int ks = 0; ks < 128; ++ks) { const int l = ks >> 2;
            const f16x8 av = *(const LAS f16x8*)(ap + ((l & 15) * 17 + (l >> 4)) * CP_RS + (ks & 3) * 64);
            const f16x8 bv = *(const f16x8*)(wp + 32 * ks);
            acc = __builtin_amdgcn_mfma_f32_16x16x32_f16(av, bv, acc, 0, 0, 0); }
        { const int n = 16 * w + (lane & 15); const float bs = ((const float*)(a.ws + WS_CBIAS))[kv * 128 + n];
#pragma unroll
          for (int r = 0; r < 4; ++r) HID[(4 * (lane >> 4) + r) * CP_HS + n] = (f16)gelu_tanh(acc[r] + bs); }
        __syncthreads();
        f32x4 o = {0.f, 0.f, 0.f, 0.f};
        const f16* w2p = (const f16*)(a.ws + WS_W2T) + ((size_t)kv * 128 + 16 * w + (lane & 15)) * 128 + 8 * (lane >> 4);
#pragma unroll
        for (int ks = 0; ks < 4; ++ks) { const f16x8 av = *(const LAS f16x8*)(HID + (lane & 15) * CP_HS + 32 * ks + 8 * (lane >> 4)); const f16x8 bv = *(const f16x8*)(w2p + 32 * ks);
            o = __builtin_amdgcn_mfma_f32_16x16x32_f16(av, bv, o, 0, 0, 0); }
        f16* dst = (f16*)(a.ws + (kv ? WS_VCMP : WS_KCMP));
#pragma unroll
        for (int r = 0; r < 4; ++r) { const int c = c0 + 4 * (lane >> 4) + r; dst[((size_t)c * 2 + g) * 128 + 16 * w + (lane & 15)] = c < NCMP ? (f16)o[r] : (f16)0.f; }
    }
}

typedef float f32x16 __attribute__((ext_vector_type(16)));
typedef short v4i16_t __attribute__((ext_vector_type(4)));
constexpr int NS_PSEL = 65536, NS_PSTR = 257, NS_SELB = NS_PSEL + 64 * NS_PSTR * 4, NS_WANY = NS_SELB + 2048, NS_LIST = NS_WANY + 256, NS_CNT = NS_LIST + 512, NS_UNIT = NS_CNT + 64;
static_assert(NS_UNIT + 64 <= MISC_OFF, "nsa lds");
__device__ __forceinline__ unsigned offb(unsigned row, unsigned ch) { return 256u * row + 16u * (ch ^ (((row & 3u) << 2) | ((row >> 2) & 3u))); }
__device__ __forceinline__ void glds16(const void* gsrc, unsigned lds_dst) { unsigned keep;
    asm volatile("s_mov_b32 %0, m0\n\ts_mov_b32 m0, %2\n\ts_nop 0\n\tglobal_load_lds_dwordx4 %1, off\n\ts_mov_b32 m0, %0" : "=&s"(keep) : "v"(gsrc), "s"(lds_dst) : "memory"); }
__device__ __forceinline__ void ns_dma(const f16* g0, const unsigned (&doff)[2], unsigned lds_addr, int wv) {
#pragma unroll
    for (int i = 0; i < 2; ++i) glds16(g0 + doff[i], lds_addr + (wv * 2 + i) * 1024);
}
#define NS_VMW(n) asm volatile("s_waitcnt vmcnt(" #n ")" ::: "memory")
__device__ __forceinline__ void ns_qk(f32x16& s0, f32x16& s1, const LAS unsigned char* kb, const f16x8 (&qf)[8], int rho_, int hh_, float init) {
    unsigned rho = (unsigned)rho_, hh = (unsigned)hh_;
    asm volatile("" : "+v"(rho), "+v"(hh));
    const unsigned xr = ((rho & 3u) << 2) | ((rho >> 2) & 3u);
    const LAS unsigned char* kbase = kb + 256u * rho + 16u * ((hh ^ xr) & 1u); const unsigned xs = xr >> 1;
#pragma unroll
    for (int i = 0; i < 16; ++i) { s0[i] = init; s1[i] = init; }
    f16x8 af[8];
#pragma unroll
    for (int s = 0; s < 8; ++s) af[s] = *(const LAS f16x8*)(kbase + 32u * ((unsigned)s ^ xs));
#pragma unroll
    for (int s = 0; s < 8; ++s) s0 = __builtin_amdgcn_mfma_f32_32x32x16_f16(af[s], qf[s], s0, 0, 0, 0);
#pragma unroll
    for (int s = 0; s < 8; ++s) af[s] = *(const LAS f16x8*)(kbase + 32u * ((unsigned)s ^ xs) + 8192);
#pragma unroll
    for (int s = 0; s < 8; ++s) s1 = __builtin_amdgcn_mfma_f32_32x32x16_f16(af[s], qf[s], s1, 0, 0, 0);
}
__device__ __forceinline__ void ns_pv(f32x16 (&O)[4], const LAS unsigned char* vb, const f32x16& p0, const f32x16& p1, int lane_) {
    unsigned lane = (unsigned)lane_;
    asm volatile("" : "+v"(lane));
    const unsigned hh = lane >> 5, blk = (lane >> 4) & 1, q = (lane & 15) >> 2, pp = lane & 3;
    const unsigned x = 2 * blk + (pp >> 1);
    const LAS unsigned char* vbase[2];
#pragma unroll
    for (int t = 0; t < 2; ++t) { const unsigned w = (hh + 2 * t) & 3u; vbase[t] = vb + 256u * (4 * hh + 8 * t + q) + 16u * (x ^ w) + 8u * (pp & 1); }
    f16x8 pf[4];
#pragma unroll
    for (int kh = 0; kh < 2; ++kh)
#pragma unroll
        for (int sp = 0; sp < 2; ++sp)
#pragma unroll
            for (int j = 0; j < 8; ++j) pf[kh * 2 + sp][j] = (f16)(kh ? p1[8 * sp + j] : p0[8 * sp + j]);
#pragma unroll
    for (int c = 0; c < 4; ++c) { const unsigned cq = 64u * ((unsigned)c ^ q);
        const LAS unsigned char* b0 = vbase[0] + cq; const LAS unsigned char* b1 = vbase[1] + cq;
#pragma unroll
        for (int kh = 0; kh < 2; ++kh)
#pragma unroll
            for (int sp = 0; sp < 2; ++sp) {
                const v4i16_t lo = __builtin_amdgcn_ds_read_tr16_b64_v4i16((LAS v4i16_t*)(b0 + 256 * (32 * kh + 16 * sp)));
                const v4i16_t hi = __builtin_amdgcn_ds_read_tr16_b64_v4i16((LAS v4i16_t*)(b1 + 256 * (32 * kh + 16 * sp)));
                typedef short s16x8 __attribute__((ext_vector_type(8)));
                const s16x8 v8 = {lo[0], lo[1], lo[2], lo[3], hi[0], hi[1], hi[2], hi[3]};
                O[c] = __builtin_amdgcn_mfma_f32_32x32x16_f16(__builtin_bit_cast(f16x8, v8), pf[kh * 2 + sp], O[c], 0, 0, 0); }
    }
}
#define NS_KIDX(r, hh) ((int)(((r) & 3) + 8 * ((r) >> 2) + 4 * (hh)))
constexpr float NS_THR = 6.f;
template <bool WITH_O> __device__ __forceinline__ void ns_online(f32x16& y0, f32x16& y1, float& m, float& l, bool& seen, f32x16 (&O)[4]) {
    float mx = fmaxf(y0[0], y1[0]);
#pragma unroll
    for (int i = 1; i < 16; ++i) mx = fmaxf(mx, fmaxf(y0[i], y1[i]));
    mx = fmaxf(mx, __shfl_xor(mx, 32));
    const bool fin = mx > -INFINITY, first = !seen && fin;
    if (__any(first || mx > NS_THR)) {
        const float d = first ? mx : (mx > NS_THR ? mx : 0.f), alpha = __builtin_amdgcn_exp2f(-d);
        seen = seen || fin; m += d; l *= alpha;
        if (WITH_O) {
#pragma unroll
            for (int c = 0; c < 4; ++c) O[c] = O[c] * alpha; }
#pragma unroll
        for (int i = 0; i < 16; ++i) { y0[i] -= d; y1[i] -= d; }
    }
    float ls = 0.f;
#pragma unroll
    for (int i = 0; i < 16; ++i) { y0[i] = __builtin_amdgcn_exp2f(y0[i]); y1[i] = __builtin_amdgcn_exp2f(y1[i]); ls += y0[i] + y1[i]; }
    l += ls;
}
#define NS_ISSUE(j, NSL, HASV) do { const unsigned sa_ = lds_a + (unsigned)(((j) & ((NSL) - 1)) * 32768); ns_dma(NS_KPTR(j), NS_DOFF, sa_, w); if (HASV) ns_dma(NS_VPTR(j), NS_DOFF, sa_ + 16384u, w); } while (0)
#define NS_WAIT(nb, HASV) do { if (HASV) { if ((nb) >= 2) NS_VMW(8); else if ((nb) == 1) NS_VMW(4); else NS_VMW(0); } else { if ((nb) >= 2) NS_VMW(4); else if ((nb) == 1) NS_VMW(2); else NS_VMW(0); } } while (0)
#define NS_PROLOGUE(n, NSL, HASV) do { const int q_ = (n) < (NSL) - 1 ? (n) : (NSL) - 1; for (int j_ = 0; j_ < q_; ++j_) NS_ISSUE(j_, NSL, HASV); NS_WAIT(q_ - 1, HASV); __syncthreads(); } while (0)
#define NS_STEP_BEGIN(i, n, NSL, HASV) do { if ((i) + (NSL) - 1 < (n)) NS_ISSUE((i) + (NSL) - 1, NSL, HASV); } while (0)
#define NS_STEP_END(i, n, NSL, HASV) do { int nb_ = ((n) - 1 < (i) + (NSL) - 1 ? (n) - 1 : (i) + (NSL) - 1) - ((i) + 1); NS_WAIT(nb_, HASV); __syncthreads(); } while (0)
#define NS_KB(i, NSL) (lds + (((i) & ((NSL) - 1)) * 32768))
#define NS_VB(i, NSL) (lds + (((i) & ((NSL) - 1)) * 32768) + 16384)
__device__ __forceinline__ void p_nsa(const Args& a, LAS unsigned char* lds, int rep) {
    const int tid = opaque_tid(), lane = tid & 63, w = __builtin_amdgcn_readfirstlane(tid >> 6), rho = lane & 31, hh = lane >> 5, ql = rho >> 2, p = rho & 3;
    const unsigned lds_a = (unsigned)__builtin_amdgcn_readfirstlane((int)(unsigned)(size_t)lds);
    const f16* z = (const f16*)(a.ws + WS_Z); const f16* kcmp = (const f16*)(a.ws + WS_KCMP); const f16* vcmp = (const f16*)(a.ws + WS_VCMP);
    float* onsa = (float*)(a.ws + WS_ONSA); unsigned* ctl = (unsigned*)(a.ws + WS_CTL);
    LAS float* psel = (LAS float*)(lds + NS_PSEL); LAS unsigned* selb = (LAS unsigned*)(lds + NS_SELB); LAS unsigned* wany = (LAS unsigned*)(lds + NS_WANY);
    LAS unsigned char* list = lds + NS_LIST; LAS int* cnt = (LAS int*)(lds + NS_CNT); LAS int* unit_s = (LAS int*)(lds + NS_UNIT);
    const float c2 = 0.08838834764831845f * 1.4426950408889634f;
    unsigned doff_c[2], doff_z[2];
#pragma unroll
    for (int i = 0; i < 2; ++i) { const int piece = w * 2 + i, row = 4 * piece + (lane >> 4), ch = (lane & 15) ^ (((row & 3) << 2) | ((row >> 2) & 3)); doff_c[i] = (unsigned)(row * 256 + ch * 8); doff_z[i] = (unsigned)(row * NZ + ch * 8); }
    for (;;) {
        __syncthreads();
        if (tid == 0) { const int g0 = (int)(xb_xcc_id() & 1u); int k = (int)atomicAdd(&ctl[CW_Q + rep * 4 + g0], 1u), gg = g0;
            if (k >= 256) { gg = g0 ^ 1; k = (int)atomicAdd(&ctl[CW_Q + rep * 4 + gg], 1u); }
            unit_s[0] = k; unit_s[1] = gg; }
        __syncthreads();
        const int uk = unit_s[0]; if (uk >= 256) break;
        const int blk = 255 - uk, g = unit_s[1], t0 = blk * 64, tq = t0 + 8 * w + ql, hq = g * 4 + p;
        f16x8 qf[8];
        { const f16* qrow = z + (size_t)tq * NZ + ZQ + hq * 128 + 8 * hh;
#pragma unroll
          for (int s = 0; s < 8; ++s) { const f16x8 q8 = *(const f16x8*)(qrow + 16 * s);
#pragma unroll
              for (int j = 0; j < 8; ++j) qf[s][j] = (f16)((float)q8[j] * c2); } }
        const f16* zrow = z + (size_t)tq * NZ;
        const float gate_c = sigmoidf_((float)zrow[ZGL + hq]), gate_s = sigmoidf_((float)zrow[ZGL + 8 + hq]), gate_w = sigmoidf_((float)zrow[ZGL + 16 + hq]);
        f32x16 O[4];
        float* orow = onsa + (size_t)tq * 1024 + hq * 128 + 4 * hh;
#pragma unroll
        for (int c = 0; c < 4; ++c)
#pragma unroll
            for (int i = 0; i < 16; ++i) O[c][i] = 0.f;
        const int cmax = tq >= 31 ? (tq - 31) >> 4 : -1;
        const int ntc = (4 * blk + 3 + 63) >> 6;
        float m = 0.f, l = 0.f; bool seen = false;
        const int cmin_w = (t0 + 8 * w) >= 31 ? (t0 + 8 * w - 31) >> 4 : -1;
#define NS_KPTR(j) (kcmp + ((size_t)(64 * (j)) * 2 + g) * 128)
#define NS_VPTR(j) (vcmp + ((size_t)(64 * (j)) * 2 + g) * 128)
#define NS_DOFF doff_c
        { const int npc = (ntc + 1) >> 1;
#define NS_ISSUE_KPAIR(ip) do { const unsigned sa_ = lds_a + (unsigned)(((ip) & 1) * 65536); const int j0_ = 2 * (ip); ns_dma(NS_KPTR(j0_), NS_DOFF, sa_, w); if (j0_ + 1 < ntc) ns_dma(NS_KPTR(j0_ + 1), NS_DOFF, sa_ + 32768u, w); } while (0)
          NS_ISSUE_KPAIR(0); NS_VMW(0); __syncthreads();
          for (int ip = 0; ip < npc; ++ip) {
              if (ip + 1 < npc) NS_ISSUE_KPAIR(ip + 1);
#pragma unroll
              for (int hb = 0; hb < 2; ++hb) { const int i = 2 * ip + hb;
                  if (i < ntc) {
                      f32x16 x0, x1; ns_qk(x0, x1, lds + (ip & 1) * 65536 + hb * 32768, qf, rho, hh, -m);
                      if (64 * i + 63 > cmin_w) {
#pragma unroll
                          for (int r = 0; r < 16; ++r) { const int c0 = 64 * i + NS_KIDX(r, hh); x0[r] = (c0 <= cmax) ? x0[r] : -INFINITY; x1[r] = (c0 + 32 <= cmax) ? x1[r] : -INFINITY; } }
                      ns_online<false>(x0, x1, m, l, seen, O); } }
              NS_VMW(0); __syncthreads();
          } }
        l += __shfl_xor(l, 32);
        const float invl = 1.f / fmaxf(l, 1e-30f);
        for (int i = lane; i < 8 * NS_PSTR; i += 64) psel[(8 * w) * NS_PSTR + i] = 0.f;
        NS_PROLOGUE(ntc, 2, true);
        for (int i = 0; i < ntc; ++i) {
            NS_STEP_BEGIN(i, ntc, 2, true);
            f32x16 x0, x1; ns_qk(x0, x1, NS_KB(i, 2), qf, rho, hh, -m);
#pragma unroll
            for (int r = 0; r < 16; ++r) { x0[r] = __builtin_amdgcn_exp2f(x0[r]) * invl; x1[r] = __builtin_amdgcn_exp2f(x1[r]) * invl; }
            if (64 * i + 63 > cmin_w) {
#pragma unroll
                for (int r = 0; r < 16; ++r) { const int c0 = 64 * i + NS_KIDX(r, hh); x0[r] = (c0 <= cmax) ? x0[r] : 0.f; x1[r] = (c0 + 32 <= cmax) ? x1[r] : 0.f; } }
#pragma unroll
            for (int kh = 0; kh < 2; ++kh)
#pragma unroll
                for (int r4 = 0; r4 < 4; ++r4) {
                    const float pa = kh ? x1[4 * r4] : x0[4 * r4], pb = kh ? x1[4 * r4 + 1] : x0[4 * r4 + 1], pc_ = kh ? x1[4 * r4 + 2] : x0[4 * r4 + 2], pd = kh ? x1[4 * r4 + 3] : x0[4 * r4 + 3];
                    float mainv = pa + pb + pc_ + 0.5f * pd, carry = 0.5f * pd;
                    mainv += __shfl_xor(mainv, 1); mainv += __shfl_xor(mainv, 2); carry += __shfl_xor(carry, 1); carry += __shfl_xor(carry, 2);
                    if (p == 0) { const int sb = 16 * i + 8 * kh + 2 * r4 + hh; float* pr = (float*)(psel + (8 * w + ql) * NS_PSTR + sb); __hip_atomic_fetch_add(pr, mainv, __ATOMIC_RELAXED, __HIP_MEMORY_SCOPE_WORKGROUP); __hip_atomic_fetch_add(pr + 1, carry, __ATOMIC_RELAXED, __HIP_MEMORY_SCOPE_WORKGROUP); }
                }
            ns_pv(O, NS_VB(i, 2), x0, x1, lane);
            NS_STEP_END(i, ntc, 2, true);
        }
#undef NS_KPTR
#undef NS_VPTR
#undef NS_DOFF
#pragma unroll
        for (int c = 0; c < 4; ++c) {
#pragma unroll
            for (int r4 = 0; r4 < 4; ++r4) *(f32x4*)(orow + 32 * c + 8 * r4) = (f32x4){O[c][4 * r4] * gate_c, O[c][4 * r4 + 1] * gate_c, O[c][4 * r4 + 2] * gate_c, O[c][4 * r4 + 3] * gate_c};
#pragma unroll
            for (int i = 0; i < 16; ++i) O[c][i] = 0.f; }
        {
            unsigned anyw = 0u;
            for (int qq = 0; qq < 8; ++qq) {
                const LAS float* pr = psel + (8 * w + qq) * NS_PSTR;
                unsigned myw = 0u;
                if (lane == 0) myw |= 1u;
                if (lane == (blk >> 5)) myw |= 1u << (blk & 31);
                if (blk >= 1 && lane == ((blk - 1) >> 5)) myw |= 1u << ((blk - 1) & 31);
                const int ncand = blk >= 3 ? blk - 2 : 0;
                if (ncand <= 13) { if (ncand > 0 && lane == 0) myw |= ((2u << (blk - 2)) - 1u) & ~1u; }
                else {
                    unsigned key[4];
#pragma unroll
                    for (int jj = 0; jj < 4; ++jj) { const int s = 1 + lane + 64 * jj; key[jj] = (s <= blk - 2) ? __float_as_uint(fmaxf(pr[s], 0.f)) + 1u : 0u; }
                    unsigned thr = 0u;
                    for (int bit = 31; bit >= 0; --bit) { const unsigned cand = thr | (1u << bit); int cn = 0;
#pragma unroll
                        for (int jj = 0; jj < 4; ++jj) cn += __popcll(__ballot(key[jj] >= cand));
                        if (cn >= 13) thr = cand; }
                    int cgt = 0;
#pragma unroll
                    for (int jj = 0; jj < 4; ++jj) cgt += __popcll(__ballot(key[jj] > thr));
                    int remaining = 13 - cgt;
                    unsigned long long M[4];
#pragma unroll
                    for (int jj = 0; jj < 4; ++jj) { const bool eq = key[jj] == thr; const unsigned long long em = __ballot(eq); const int c = __popcll(em);
                        const bool take_eq = eq && (__popcll(em & ((1ull << lane) - 1ull)) < remaining);
                        remaining = remaining > c ? remaining - c : 0;
                        M[jj] = __ballot(key[jj] > thr || take_eq); }
#pragma unroll
                    for (int j = 0; j < 8; ++j) { const int k = j >> 1; const unsigned long long sh = (M[k] << 1) | (k > 0 ? (M[k - 1] >> 63) : 0ull);
                        const unsigned wj = (unsigned)(sh >> (32 * (j & 1))); if (lane == j) myw |= wj; }
                }
                if (lane < 8) selb[(8 * w + qq) * 8 + lane] = myw;
                anyw |= myw;
            }
            if (lane < 8) wany[w * 8 + lane] = anyw;
        }
        __syncthreads();
        unsigned sw8[8], aw8[8], un8[8];
#pragma unroll
        for (int j = 0; j < 8; ++j) { sw8[j] = selb[(8 * w + ql) * 8 + j]; aw8[j] = (unsigned)__builtin_amdgcn_readfirstlane((int)wany[w * 8 + j]); unsigned un = 0u;
#pragma unroll
            for (int ww = 0; ww < 8; ++ww) un |= wany[ww * 8 + j];
            un8[j] = (unsigned)__builtin_amdgcn_readfirstlane((int)un); }
        const int nlist = blk + 1;
        for (int rp_ = 0; rp_ < NSA_SELREP; ++rp_) {
        if (rp_) { asm volatile("" :: "v"(O[0][0]), "v"(O[1][0]), "v"(O[2][0]), "v"(O[3][0]), "v"(l));
#pragma unroll
            for (int c = 0; c < 4; ++c)
#pragma unroll
                for (int i = 0; i < 16; ++i) O[c][i] = 0.f; }
        m = 0.f; l = 0.f; seen = false;
#define NS_KPTR(j) (z + (size_t)((j) * 64) * NZ + ZKS + g * 128)
#define NS_VPTR(j) (z + (size_t)((j) * 64) * NZ + ZVS + g * 128)
#define NS_DOFF doff_z
#if NSA_DECOUPLED
        {
            volatile LAS int* dland = (volatile LAS int*)(lds + NS_CNT); volatile LAS int* dfin = dland + 4;
            if (tid < 8) dland[tid] = 0;
            __syncthreads();
            int ji = 0;
            for (; ji < 3 && ji < nlist; ++ji) { const unsigned sa_ = lds_a + (unsigned)((ji & 3) * 32768); ns_dma(NS_KPTR(ji), NS_DOFF, sa_, w); ns_dma(NS_VPTR(ji), NS_DOFF, sa_ + 16384u, w); }
            unsigned cw_s = 0u, cw_a = 0u;
#define NS_TRY_ISSUE() do { while (ji < nlist && ji <= i + 3 && dfin[ji & 3] >= 8 * (ji >> 2)) { const unsigned sa_ = lds_a + (unsigned)((ji & 3) * 32768); ns_dma(NS_KPTR(ji), NS_DOFF, sa_, w); ns_dma(NS_VPTR(ji), NS_DOFF, sa_ + 16384u, w); ++ji; } } while (0)
            for (int i = 0; i < nlist; ++i) {
                NS_TRY_ISSUE();
                if (ji <= i) {
                    for (int sp = 0; dfin[i & 3] < 8 * (i >> 2) && sp < (1 << 22); ++sp) __builtin_amdgcn_s_sleep(1);
                    NS_TRY_ISSUE(); }
                { const int nb = ji - 1 - i; if (nb >= 3) NS_VMW(12); else if (nb == 2) NS_VMW(8); else if (nb == 1) NS_VMW(4); else NS_VMW(0); }
                if (lane == 0) __hip_atomic_fetch_add((int*)(dland + (i & 3)), 1, __ATOMIC_RELAXED, __HIP_MEMORY_SCOPE_WORKGROUP);
                const int sb = i, bit = sb & 31;
                if (bit == 0) { const int wi = sb >> 5; cw_s = sw8[0]; cw_a = aw8[0];
#pragma unroll
                    for (int j = 1; j < 8; ++j) { if (wi == j) { cw_s = sw8[j]; cw_a = aw8[j]; } } }
                if ((cw_a >> bit) & 1u) {
                    const int tgt = 8 * ((i >> 2) + 1);
                    for (int sp = 0; dland[i & 3] < tgt && sp < (1 << 22); ++sp) __builtin_amdgcn_s_sleep(1);
                    asm volatile("" ::: "memory");
                    const bool rsel = (cw_s >> bit) & 1u;
                    const LAS unsigned char* kb = lds + (i & 3) * 32768;
                    f32x16 x0, x1; ns_qk(x0, x1, kb, qf, rho, hh, rsel ? -m : -INFINITY);
                    if (sb == blk) { const int kp0 = sb * 64;
#pragma unroll
                        for (int r = 0; r < 16; ++r) { const int kp = kp0 + NS_KIDX(r, hh); x0[r] = (kp <= tq) ? x0[r] : -INFINITY; x1[r] = (kp + 32 <= tq) ? x1[r] : -INFINITY; } }
                    ns_online<true>(x0, x1, m, l, seen, O);
                    NS_TRY_ISSUE();
                    ns_pv(O, kb + 16384, x0, x1, lane);
                    asm volatile("s_waitcnt lgkmcnt(0)" ::: "memory");
                }
                if (lane == 0) __hip_atomic_fetch_add((int*)(dfin + (i & 3)), 1, __ATOMIC_RELAXED, __HIP_MEMORY_SCOPE_WORKGROUP);
            }
#undef NS_TRY_ISSUE
            __syncthreads();
        }
        }
#else
        const int npair = (nlist + 1) >> 1;
#define NS_ISSUE_PAIR(ip) do { const unsigned sa_ = lds_a + (unsigned)(((ip) & 1) * 65536); const int j0_ = 2 * (ip); \
            ns_dma(NS_KPTR(j0_), NS_DOFF, sa_, w); ns_dma(NS_VPTR(j0_), NS_DOFF, sa_ + 16384u, w); \
            if (j0_ + 1 < nlist) { ns_dma(NS_KPTR(j0_ + 1), NS_DOFF, sa_ + 32768u, w); ns_dma(NS_VPTR(j0_ + 1), NS_DOFF, sa_ + 49152u, w); } } while (0)
        NS_ISSUE_PAIR(0); NS_VMW(0); __syncthreads();
        unsigned cw_s = 0u, cw_a = 0u;
        for (int ip = 0; ip < npair; ++ip) {
            if (ip + 1 < npair) NS_ISSUE_PAIR(ip + 1);
#pragma unroll
            for (int hb = 0; hb < 2; ++hb) {
                const int sb = 2 * ip + hb, bit = sb & 31;
                if (sb < nlist) {
                    if (bit == 0) { const int wi = sb >> 5; cw_s = sw8[0]; cw_a = aw8[0];
#pragma unroll
                        for (int j = 1; j < 8; ++j) { if (wi == j) { cw_s = sw8[j]; cw_a = aw8[j]; } } }
                    if ((cw_a >> bit) & 1u) {
                        const bool rsel = (cw_s >> bit) & 1u;
                        const LAS unsigned char* kb = lds + (ip & 1) * 65536 + hb * 32768;
                        f32x16 x0, x1; ns_qk(x0, x1, kb, qf, rho, hh, rsel ? -m : -INFINITY);
                        if (sb == blk) { const int kp0 = sb * 64;
#pragma unroll
                            for (int r = 0; r < 16; ++r) { const int kp = kp0 + NS_KIDX(r, hh); x0[r] = (kp <= tq) ? x0[r] : -INFINITY; x1[r] = (kp + 32 <= tq) ? x1[r] : -INFINITY; } }
                        ns_online<true>(x0, x1, m, l, seen, O);
                        ns_pv(O, kb + 16384, x0, x1, lane);
                    }
                }
            }
            NS_VMW(0); __syncthreads();
        }
        }
#endif
#undef NS_KPTR
#undef NS_VPTR
        l += __shfl_xor(l, 32);
        { const float sc = gate_s / fmaxf(l, 1e-30f); f32x4 ev[4][4];
#pragma unroll
          for (int c = 0; c < 4; ++c)
#pragma unroll
              for (int r4 = 0; r4 < 4; ++r4) ev[c][r4] = *(const f32x4*)(orow + 32 * c + 8 * r4);
#pragma unroll
          for (int c = 0; c < 4; ++c) {
#pragma unroll
              for (int r4 = 0; r4 < 4; ++r4) { const f32x4 e = ev[c][r4]; *(f32x4*)(orow + 32 * c + 8 * r4) = (f32x4){e.x + O[c][4 * r4] * sc, e.y + O[c][4 * r4 + 1] * sc, e.z + O[c][4 * r4 + 2] * sc, e.w + O[c][4 * r4 + 3] * sc}; }
#pragma unroll
              for (int i = 0; i < 16; ++i) O[c][i] = 0.f; } }
        const int wb0 = blk >= 8 ? blk - 8 : 0, nwt = blk - wb0 + 1;
        for (int rp_ = 0; rp_ < NSA_WINREP; ++rp_) {
        if (rp_) { asm volatile("" :: "v"(O[0][0]), "v"(O[1][0]), "v"(O[2][0]), "v"(O[3][0]), "v"(l));
#pragma unroll
            for (int c = 0; c < 4; ++c)
#pragma unroll
                for (int i = 0; i < 16; ++i) O[c][i] = 0.f; }
        m = 0.f; l = 0.f; seen = false;
#define NS_KPTR(j) (z + (size_t)((wb0 + (j)) * 64) * NZ + ZKW + g * 128)
#define NS_VPTR(j) (z + (size_t)((wb0 + (j)) * 64) * NZ + ZVW + g * 128)
        { const int npw = (nwt + 1) >> 1;
#define NS_ISSUE_WPAIR(ip) do { const unsigned sa_ = lds_a + (unsigned)(((ip) & 1) * 65536); const int j0_ = 2 * (ip); \
              ns_dma(NS_KPTR(j0_), NS_DOFF, sa_, w); ns_dma(NS_VPTR(j0_), NS_DOFF, sa_ + 16384u, w); \
              if (j0_ + 1 < nwt) { ns_dma(NS_KPTR(j0_ + 1), NS_DOFF, sa_ + 32768u, w); ns_dma(NS_VPTR(j0_ + 1), NS_DOFF, sa_ + 49152u, w); } } while (0)
          NS_ISSUE_WPAIR(0); NS_VMW(0); __syncthreads();
          for (int ip = 0; ip < npw; ++ip) {
              if (ip + 1 < npw) NS_ISSUE_WPAIR(ip + 1);
#pragma unroll
              for (int hb = 0; hb < 2; ++hb) { const int i = 2 * ip + hb;
                  if (i < nwt) { const int kb = wb0 + i; const LAS unsigned char* kbp = lds + (ip & 1) * 65536 + hb * 32768;
                      f32x16 x0, x1; ns_qk(x0, x1, kbp, qf, rho, hh, -m);
                      if (i == 0 || i == nwt - 1) { const int kp0 = kb * 64;
#pragma unroll
                          for (int r = 0; r < 16; ++r) { const int kp = kp0 + NS_KIDX(r, hh);
                              x0[r] = (kp <= tq && kp + 511 >= tq) ? x0[r] : -INFINITY; x1[r] = (kp + 32 <= tq && kp + 32 + 511 >= tq) ? x1[r] : -INFINITY; } }
                      ns_online<true>(x0, x1, m, l, seen, O);
                      ns_pv(O, kbp + 16384, x0, x1, lane); } }
              NS_VMW(0); __syncthreads();
          } }
        }
#undef NS_KPTR
#undef NS_VPTR
#undef NS_DOFF
        l += __shfl_xor(l, 32);
        { const float sc = gate_w / fmaxf(l, 1e-30f); f32x4 ev[4][4];
#pragma unroll
          for (int c = 0; c < 4; ++c)
#pragma unroll
              for (int r4 = 0; r4 < 4; ++r4) ev[c][r4] = *(const f32x4*)(orow + 32 * c + 8 * r4);
#pragma unroll
          for (int c = 0; c < 4; ++c)
#pragma unroll
              for (int r4 = 0; r4 < 4; ++r4) { const f32x4 e = ev[c][r4]; *(f32x4*)(orow + 32 * c + 8 * r4) = (f32x4){e.x + O[c][4 * r4] * sc, e.y + O[c][4 * r4 + 1] * sc, e.z + O[c][4 * r4 + 2] * sc, e.w + O[c][4 * r4 + 3] * sc}; } }
    }
}

constexpr int RS = 72, SLOT = 64 * RS * 2, RW_FS = 68, RW_GCL = 17 * SLOT;
#define RW_SLOT(lds, i) ((LAS bf16*)((lds) + (i) * SLOT))
template <int KS> __device__ __forceinline__ void mm_acc(f32x4 (&acc)[2], const LAS bf16* X, int xs, const LAS bf16* Y, int ys, int w, int lane) {
    const LAS bf16* xp = X + (16 * (w >> 1) + (lane & 15)) * xs + 8 * (lane >> 4);
    const LAS bf16* yp = Y + (32 * (w & 1) + (lane & 15)) * ys + 8 * (lane >> 4);
#pragma unroll
    for (int ks = 0; ks < KS; ++ks) { const bf16x8 av = *(const LAS bf16x8*)(xp + 32 * ks), b0 = *(const LAS bf16x8*)(yp + 32 * ks), b1 = *(const LAS bf16x8*)(yp + 16 * ys + 32 * ks);
        acc[0] = __builtin_amdgcn_mfma_f32_16x16x32_bf16(av, b0, acc[0], 0, 0, 0); acc[1] = __builtin_amdgcn_mfma_f32_16x16x32_bf16(av, b1, acc[1], 0, 0, 0); }
}
__device__ __forceinline__ void acc_zero(f32x4 (&acc)[2]) { acc[0] = (f32x4){0.f, 0.f, 0.f, 0.f}; acc[1] = (f32x4){0.f, 0.f, 0.f, 0.f}; }
__device__ __forceinline__ void st_n(const f32x4 (&acc)[2], LAS bf16* dst, int m0, int n0) {
#pragma unroll
    for (int tn = 0; tn < 2; ++tn)
#pragma unroll
        for (int r = 0; r < 4; ++r) dst[(m0 + r) * RS + n0 + 16 * tn] = (bf16)acc[tn][r];
}
__device__ __forceinline__ void st_t(const f32x4 (&acc)[2], LAS bf16* dst, int m0, int n0) {
#pragma unroll
    for (int tn = 0; tn < 2; ++tn) { const bf16x4 v = {(bf16)acc[tn][0], (bf16)acc[tn][1], (bf16)acc[tn][2], (bf16)acc[tn][3]}; *(LAS bf16x4*)(dst + (n0 + 16 * tn) * RS + m0) = v; }
}
__device__ __forceinline__ void ld_n(f32x4 (&acc)[2], const LAS bf16* src, int m0, int n0) {
#pragma unroll
    for (int tn = 0; tn < 2; ++tn)
#pragma unroll
        for (int r = 0; r < 4; ++r) acc[tn][r] = (float)src[(m0 + r) * RS + n0 + 16 * tn];
}
template <bool INCL> __device__ __forceinline__ void tri_mask(f32x4 (&acc)[2], int m0, int n0) {
#pragma unroll
    for (int tn = 0; tn < 2; ++tn)
#pragma unroll
        for (int r = 0; r < 4; ++r) { const int m = m0 + r, n = n0 + 16 * tn; if (INCL ? (n > m) : (n >= m)) acc[tn][r] = 0.f; }
}
__device__ __forceinline__ void st_acc_g(const f32x4 (&acc)[2], f16* base, int u, int w, int lane) {
#pragma unroll
    for (int tn = 0; tn < 2; ++tn) { const f16x4 v = {(f16)acc[tn][0], (f16)acc[tn][1], (f16)acc[tn][2], (f16)acc[tn][3]}; ((f16x4*)base)[((size_t)u * 16 + w * 2 + tn) * 64 + lane] = v; }
}
__device__ __forceinline__ float fast_tanh(float x) { const float e = __expf(2.f * x); return 1.f - 2.f / (e + 1.f); }

__device__ __forceinline__ void p_rwkv_local(const Args& a, LAS unsigned char* lds) {
    const int tid = opaque_tid(), lane = tid & 63, w = __builtin_amdgcn_readfirstlane(tid >> 6);
    const int m0 = 16 * (w >> 1) + 4 * (lane >> 4), n0 = 32 * (w & 1) + (lane & 15);
    const int et = tid >> 3, cg = tid & 7;
    const f16* z = (const f16*)(a.ws + WS_Z);
    unsigned char* ro = (unsigned char*)a.out;
    LAS float* FW = (LAS float*)(lds + 8 * SLOT); LAS float* FA = FW + 64 * RW_FS; LAS float* TOT = FA + 64 * RW_FS; LAS float* GCL = (LAS float*)(lds + RW_GCL); LAS float* PRM = GCL + 64;
    const int h = blockIdx.x & 15, cstep = gridDim.x >> 4, ch0 = h * 64 + 8 * cg;
    __syncthreads();
    if (tid < 64) { const int ch = h * 64 + tid; const float* mu = a.in[I_MU];
        PRM[tid] = mu[ch]; PRM[64 + tid] = mu[1024 + ch]; PRM[128 + tid] = mu[2048 + ch]; PRM[192 + tid] = mu[3072 + tid]; PRM[256 + tid] = mu[3136 + tid];
        PRM[320 + tid] = a.in[I_W0][ch]; PRM[384 + tid] = a.in[I_A0][ch]; PRM[448 + tid] = a.in[I_KK][ch]; PRM[512 + tid] = a.in[I_KA][ch]; PRM[576 + tid] = a.in[I_RK][ch]; }
    { bf16x8 id8;
#pragma unroll
      for (int e = 0; e < 8; ++e) id8[e] = (bf16)((8 * cg + e == et) ? 1.f : 0.f);
      *(LAS bf16x8*)(RW_SLOT(lds, 16) + et * RS + 8 * cg) = id8; }
    *(LAS u32x4*)(RW_SLOT(lds, 14) + et * RS + 8 * cg) = *(const u32x4*)((const bf16*)(a.ws + WS_WUPT) + (size_t)(h * 64 + et) * 64 + 8 * cg);
    *(LAS u32x4*)(RW_SLOT(lds, 15) + et * RS + 8 * cg) = *(const u32x4*)((const bf16*)(a.ws + WS_AUPT) + (size_t)(h * 64 + et) * 64 + 8 * cg);
    f16x8 zc[5], zp[5];
    const f16x8 zero8 = {0, 0, 0, 0, 0, 0, 0, 0};
#define RW_LOADZ(cc) do { const int t_ = (cc) * 64 + et; const f16* cur_ = z + (size_t)t_ * NZ; const bool hp_ = t_ > 0; \
        zc[0] = *(const f16x8*)(cur_ + ZR + ch0); zc[1] = *(const f16x8*)(cur_ + ZK + ch0); zc[2] = *(const f16x8*)(cur_ + ZV + ch0); zc[3] = *(const f16x8*)(cur_ + ZWD + 8 * cg); zc[4] = *(const f16x8*)(cur_ + ZAD + 8 * cg); \
        zp[0] = hp_ ? *(const f16x8*)(cur_ - NZ + ZR + ch0) : zero8; zp[1] = hp_ ? *(const f16x8*)(cur_ - NZ + ZK + ch0) : zero8; zp[2] = hp_ ? *(const f16x8*)(cur_ - NZ + ZV + ch0) : zero8; \
        zp[3] = hp_ ? *(const f16x8*)(cur_ - NZ + ZWD + 8 * cg) : zero8; zp[4] = hp_ ? *(const f16x8*)(cur_ - NZ + ZAD + 8 * cg) : zero8; } while (0)
    __syncthreads();
    if ((blockIdx.x >> 4) < 256) RW_LOADZ(blockIdx.x >> 4);
    for (int c = blockIdx.x >> 4; c < 256; c += cstep) {
        const int t0 = c * 64, uo = h * 256 + c;
        float r_[8], k_[8], v_[8];
        { bf16x8 x1, x2;
#pragma unroll
          for (int e = 0; e < 8; ++e) { const int jj = 8 * cg + e;
              r_[e] = (float)zc[0][e] + ((float)zp[0][e] - (float)zc[0][e]) * PRM[jj]; k_[e] = (float)zc[1][e] + ((float)zp[1][e] - (float)zc[1][e]) * PRM[64 + jj]; v_[e] = (float)zc[2][e] + ((float)zp[2][e] - (float)zc[2][e]) * PRM[128 + jj];
              x1[e] = (bf16)fast_tanh((float)zc[3][e] + ((float)zp[3][e] - (float)zc[3][e]) * PRM[192 + jj]); x2[e] = (bf16)((float)zc[4][e] + ((float)zp[4][e] - (float)zc[4][e]) * PRM[256 + jj]); }
          *(LAS bf16x8*)(RW_SLOT(lds, 0) + et * RS + 8 * cg) = x1; *(LAS bf16x8*)(RW_SLOT(lds, 1) + et * RS + 8 * cg) = x2; }
        if (c + cstep < 256) RW_LOADZ(c + cstep);
        __syncthreads();
        { f32x4 acc[2]; acc_zero(acc); mm_acc<2>(acc, RW_SLOT(lds, 0), RS, RW_SLOT(lds, 14), RS, w, lane);
#pragma unroll
          for (int tn = 0; tn < 2; ++tn)
#pragma unroll
              for (int r = 0; r < 4; ++r) FW[(m0 + r) * RW_FS + n0 + 16 * tn] = acc[tn][r];
          acc_zero(acc); mm_acc<2>(acc, RW_SLOT(lds, 1), RS, RW_SLOT(lds, 15), RS, w, lane);
#pragma unroll
          for (int tn = 0; tn < 2; ++tn)
#pragma unroll
              for (int r = 0; r < 4; ++r) FA[(m0 + r) * RW_FS + n0 + 16 * tn] = acc[tn][r]; }
        __syncthreads();
        float lw_[8], kk_[8], b_[8];
        { float ss = 0.f, sb = 0.f;
#pragma unroll
          for (int e = 0; e < 8; ++e) {
              const float wpre = PRM[320 + 8 * cg + e] + FW[et * RW_FS + 8 * cg + e]; const float y0 = -wpre; const float sp = fmaxf(y0, 0.f) + __logf(1.f + __expf(-fabsf(y0)));
              lw_[e] = -__expf(-sp - 0.5f);
              const float av = sigmoidf_(PRM[384 + 8 * cg + e] + FA[et * RW_FS + 8 * cg + e]);
              const float kkr = k_[e] * PRM[448 + 8 * cg + e]; ss += kkr * kkr; kk_[e] = kkr;
              k_[e] = k_[e] * (1.f + (av - 1.f) * PRM[512 + 8 * cg + e]); b_[e] = av;
              sb += r_[e] * k_[e] * PRM[576 + 8 * cg + e]; }
          ss += __shfl_xor(ss, 1); ss += __shfl_xor(ss, 2); ss += __shfl_xor(ss, 4);
          sb += __shfl_xor(sb, 1); sb += __shfl_xor(sb, 2); sb += __shfl_xor(sb, 4);
          const float rn = rsqrtf(fmaxf(ss, 1e-24f));
#pragma unroll
          for (int e = 0; e < 8; ++e) { kk_[e] *= rn; b_[e] *= kk_[e]; FW[et * RW_FS + 8 * cg + e] = lw_[e]; }
          if (cg == 0) ((float*)(a.ws + WS_SBON))[(size_t)(t0 + et) * 16 + h] = sb; }
        __syncthreads();
        { const int j = tid & 63, rg = tid >> 6; float run = 0.f;
#pragma unroll
          for (int i = 0; i < 8; ++i) { run += FW[(8 * rg + i) * RW_FS + j]; FW[(8 * rg + i) * RW_FS + j] = run; }
          TOT[rg * 64 + j] = run;
          __syncthreads();
          float off = 0.f;
          for (int q = 0; q < rg; ++q) off += TOT[q * 64 + j];
#pragma unroll
          for (int i = 0; i < 8; ++i) FW[(8 * rg + i) * RW_FS + j] += off; }
        __syncthreads();
        { bf16x8 at, bt, kt, rt, bh, kh, vv;
#pragma unroll
          for (int e = 0; e < 8; ++e) { const int jj = 8 * cg + e; const float cum = FW[et * RW_FS + jj], cl = FW[63 * RW_FS + jj];
              const float eA = __expf(cum - lw_[e]), eN = __expf(-cum), eP = __expf(cum), eH = __expf(cl - cum);
              at[e] = (bf16)(-kk_[e] * eA); bt[e] = (bf16)(b_[e] * eN); kt[e] = (bf16)(k_[e] * eN); rt[e] = (bf16)(r_[e] * eP);
              bh[e] = (bf16)(b_[e] * eH); kh[e] = (bf16)(k_[e] * eH); vv[e] = (bf16)v_[e];
              if (et == 63) GCL[jj] = __expf(cl); }
          *(LAS bf16x8*)(RW_SLOT(lds, 0) + et * RS + 8 * cg) = at; *(LAS bf16x8*)(RW_SLOT(lds, 2) + et * RS + 8 * cg) = bt;
          *(LAS bf16x8*)(RW_SLOT(lds, 3) + et * RS + 8 * cg) = kt; *(LAS bf16x8*)(RW_SLOT(lds, 4) + et * RS + 8 * cg) = rt;
          *(LAS bf16x8*)(RW_SLOT(lds, 5) + et * RS + 8 * cg) = bh; *(LAS bf16x8*)(RW_SLOT(lds, 6) + et * RS + 8 * cg) = kh; *(LAS bf16x8*)(RW_SLOT(lds, 7) + et * RS + 8 * cg) = vv; }
        __syncthreads();
#define RW_MM(acc, XS, YS) mm_acc<2>(acc, RW_SLOT(lds, XS), RS, RW_SLOT(lds, YS), RS, w, lane)
#define RW_ST(acc, DS) st_t(acc, RW_SLOT(lds, DS), m0, n0)
        { f32x4 acc[2];
          acc_zero(acc); RW_MM(acc, 0, 16); RW_ST(acc, 1);
          acc_zero(acc); RW_MM(acc, 5, 16); RW_ST(acc, 8);
          acc_zero(acc); RW_MM(acc, 6, 16); RW_ST(acc, 9);
          acc_zero(acc); RW_MM(acc, 7, 16); RW_ST(acc, 10);
          __syncthreads();
          acc_zero(acc); RW_MM(acc, 2, 0);
#pragma unroll
          for (int tn = 0; tn < 2; ++tn)
#pragma unroll
              for (int r = 0; r < 4; ++r) if (m0 + r >= n0 + 16 * tn) acc[tn][r] = 0.f;
          RW_ST(acc, 5);
#pragma unroll
          for (int tn = 0; tn < 2; ++tn)
#pragma unroll
              for (int r = 0; r < 4; ++r) if (m0 + r == n0 + 16 * tn) acc[tn][r] = 1.f;
          RW_ST(acc, 13);
          acc_zero(acc); RW_MM(acc, 0, 2); tri_mask<false>(acc, m0, n0); RW_ST(acc, 6);
          acc_zero(acc); RW_MM(acc, 0, 3); tri_mask<false>(acc, m0, n0); RW_ST(acc, 7);
          acc_zero(acc); RW_MM(acc, 2, 4);
#pragma unroll
          for (int tn = 0; tn < 2; ++tn)
#pragma unroll
              for (int r = 0; r < 4; ++r) if (m0 + r > n0 + 16 * tn) acc[tn][r] = 0.f;
          RW_ST(acc, 11);
          acc_zero(acc); RW_MM(acc, 3, 4);
#pragma unroll
          for (int tn = 0; tn < 2; ++tn)
#pragma unroll
              for (int r = 0; r < 4; ++r) if (m0 + r > n0 + 16 * tn) acc[tn][r] = 0.f;
          RW_ST(acc, 12);
          __syncthreads();
#define RW_LDT(acc, TS) do { _Pragma("unroll") for (int tn_ = 0; tn_ < 2; ++tn_) { const bf16x4 v_ = *(const LAS bf16x4*)(RW_SLOT(lds, TS) + (n0 + 16 * tn_) * RS + m0); acc[tn_] = (f32x4){(float)v_[0], (float)v_[1], (float)v_[2], (float)v_[3]}; } } while (0)
          acc_zero(acc); RW_MM(acc, 6, 5); RW_ST(acc, 0); acc_zero(acc); RW_MM(acc, 5, 6); RW_ST(acc, 2);
          __syncthreads();
          RW_LDT(acc, 13); RW_MM(acc, 2, 13); RW_ST(acc, 3);
          acc_zero(acc); RW_MM(acc, 2, 0); RW_ST(acc, 5); acc_zero(acc); RW_MM(acc, 0, 2); RW_ST(acc, 6);
          __syncthreads();
          RW_LDT(acc, 3); RW_MM(acc, 6, 3); RW_ST(acc, 13);
          acc_zero(acc); RW_MM(acc, 6, 5); RW_ST(acc, 0); acc_zero(acc); RW_MM(acc, 5, 6); RW_ST(acc, 2);
          __syncthreads();
          RW_LDT(acc, 13); RW_MM(acc, 2, 13); RW_ST(acc, 3);
          acc_zero(acc); RW_MM(acc, 2, 0); RW_ST(acc, 5); acc_zero(acc); RW_MM(acc, 0, 2); RW_ST(acc, 6);
          __syncthreads();
          RW_LDT(acc, 3); RW_MM(acc, 6, 3); RW_ST(acc, 13);
          acc_zero(acc); RW_MM(acc, 5, 6); RW_ST(acc, 2);
          __syncthreads();
          RW_LDT(acc, 13); RW_MM(acc, 2, 13); RW_ST(acc, 3);
          __syncthreads();
          acc_zero(acc); RW_MM(acc, 3, 1); RW_ST(acc, 0);
          acc_zero(acc); RW_MM(acc, 7, 3); RW_ST(acc, 5);
          __syncthreads();
          acc_zero(acc); RW_MM(acc, 5, 10); RW_ST(acc, 6);
          acc_zero(acc); RW_MM(acc, 0, 11);
#pragma unroll
          for (int tn = 0; tn < 2; ++tn) { const int tt = n0 + 16 * tn; const bf16x4 rr = *(const LAS bf16x4*)(RW_SLOT(lds, 4) + tt * RS + m0);
              const bf16x4 o = {(bf16)(acc[tn][0] + (float)rr[0]), (bf16)(acc[tn][1] + (float)rr[1]), (bf16)(acc[tn][2] + (float)rr[2]), (bf16)(acc[tn][3] + (float)rr[3])};
              *(bf16x4*)((bf16*)(ro + RO_Q) + (size_t)uo * 4096 + tt * 64 + m0) = o; }
          acc_zero(acc); RW_MM(acc, 0, 8);
#pragma unroll
          for (int tn = 0; tn < 2; ++tn) { const int jj = n0 + 16 * tn; const float gc = GCL[jj];
              const bf16x4 o = {(bf16)(acc[tn][0] + (m0 == jj ? gc : 0.f)), (bf16)(acc[tn][1] + (m0 + 1 == jj ? gc : 0.f)), (bf16)(acc[tn][2] + (m0 + 2 == jj ? gc : 0.f)), (bf16)(acc[tn][3] + (m0 + 3 == jj ? gc : 0.f))};
              *(bf16x4*)((bf16*)(ro + RO_M) + (size_t)uo * 4096 + jj * 64 + m0) = o; }
          __syncthreads();
          acc_zero(acc); RW_MM(acc, 11, 6); RW_MM(acc, 12, 10); st_acc_g(acc, (f16*)(ro + RO_Y), uo, w, lane);
          acc_zero(acc); RW_MM(acc, 6, 8); RW_MM(acc, 10, 9); st_acc_g(acc, (f16*)(ro + RO_N), uo, w, lane);
        }
#undef RW_MM
#undef RW_ST
#undef RW_LDT
    }
}
__device__ __forceinline__ void p_rwkv_scan(const Args& a, LAS unsigned char* lds, int h) {
    const int tid = opaque_tid(), lane = tid & 63, w = __builtin_amdgcn_readfirstlane(tid >> 6);
    const int m0 = 16 * (w >> 1) + 4 * (lane >> 4), n0 = 32 * (w & 1) + (lane & 15), row = tid >> 3, seg = tid & 7;
    const unsigned char* ro = (const unsigned char*)a.out;
    const bf16* Mg = (const bf16*)(ro + RO_M) + (size_t)h * 256 * 4096; const f16x4* Ng = (const f16x4*)(ro + RO_N) + (size_t)h * 256 * 1024; bf16* Sg = (bf16*)(a.ws + WS_RS) + (size_t)h * 256 * 4096;
    f32x4 acc[2]; acc_zero(acc);
    u32x4 mreg = *(const u32x4*)(Mg + row * 64 + seg * 8); f16x4 nreg[2] = {Ng[(w * 2) * 64 + lane], Ng[(w * 2 + 1) * 64 + lane]};
    for (int c = 0; c < 256; ++c) {
        LAS bf16* Sb = RW_SLOT(lds, c & 1); LAS bf16* Mb = RW_SLOT(lds, 2 + (c & 1));
        st_n(acc, Sb, m0, n0);
        *(LAS u32x4*)(Mb + row * RS + seg * 8) = mreg;
        const f16x4 nc0 = nreg[0], nc1 = nreg[1];
        if (c + 1 < 256) { mreg = *(const u32x4*)(Mg + (size_t)(c + 1) * 4096 + row * 64 + seg * 8); nreg[0] = Ng[(size_t)(c + 1) * 1024 + (w * 2) * 64 + lane]; nreg[1] = Ng[(size_t)(c + 1) * 1024 + (w * 2 + 1) * 64 + lane]; }
        __syncthreads();
        *(u32x4*)(Sg + (size_t)c * 4096 + row * 64 + seg * 8) = *(const LAS u32x4*)(Sb + row * RS + seg * 8);
        acc[0] = (f32x4){(float)nc0[0], (float)nc0[1], (float)nc0[2], (float)nc0[3]}; acc[1] = (f32x4){(float)nc1[0], (float)nc1[1], (float)nc1[2], (float)nc1[3]};
        mm_acc<2>(acc, Sb, RS, Mb, RS, w, lane);
    }
}
constexpr int RG_S = 168;
__device__ __forceinline__ void p_rwkv_out(const Args& a, LAS unsigned char* lds) {
    const int tid = opaque_tid(), lane = tid & 63, w = __builtin_amdgcn_readfirstlane(tid >> 6);
    const int m0 = 16 * (w >> 1) + 4 * (lane >> 4), n0 = 32 * (w & 1) + (lane & 15), row = tid >> 3, seg = tid & 7;
    const f16* z = (const f16*)(a.ws + WS_Z); const unsigned char* ro = (const unsigned char*)a.out; f16* mix = (f16*)(a.ws + WS_MIX);
    LAS bf16* SG = (LAS bf16*)(lds + 2 * SLOT); LAS bf16* GU = SG + 64 * RG_S; LAS float* YL = (LAS float*)(GU + 64 * RG_S); LAS float* GL = YL + 64 * RW_FS; LAS float* PRM = GL + 64 * RW_FS;
    const int h = blockIdx.x & 15, cstep = gridDim.x >> 4, et = row, cg = seg, ch0 = h * 64 + 8 * cg;
    __syncthreads();
    for (int ck = tid; ck < 64 * 20; ck += 512) { const int rr = ck / 20, c8 = ck % 20; *(LAS u32x4*)(GU + rr * RG_S + 8 * c8) = *(const u32x4*)((const bf16*)(a.ws + WS_GUPT) + (size_t)(h * 64 + rr) * 160 + 8 * c8); }
    if (tid < 160) PRM[tid] = a.in[I_MU][3200 + tid];
    if (tid < 64) { PRM[160 + tid] = a.in[I_MU][2048 + h * 64 + tid]; PRM[224 + tid] = a.in[I_LNXG][h * 64 + tid]; PRM[288 + tid] = a.in[I_LNXB][h * 64 + tid]; }
    const f16x8 zero8 = {0, 0, 0, 0, 0, 0, 0, 0};
    u32x4 qreg, sreg; f16x4 yreg[2]; f16x8 gc[3], gp[3], vc, vp; float sbn;
#define RO_LOAD(cc) do { const int uo_ = h * 256 + (cc), t0_ = (cc) * 64; \
        qreg = *(const u32x4*)((const bf16*)(ro + RO_Q) + (size_t)uo_ * 4096 + row * 64 + seg * 8); sreg = *(const u32x4*)((const bf16*)(a.ws + WS_RS) + (size_t)uo_ * 4096 + row * 64 + seg * 8); \
        { const f16x4* Yg_ = (const f16x4*)(ro + RO_Y) + (size_t)uo_ * 1024; yreg[0] = Yg_[(w * 2) * 64 + lane]; yreg[1] = Yg_[(w * 2 + 1) * 64 + lane]; } \
        _Pragma("unroll") for (int i_ = 0; i_ < 3; ++i_) { const int ck_ = tid + 512 * i_; if (ck_ < 64 * 20) { const int t_ = t0_ + ck_ / 20; const f16* cur_ = z + (size_t)t_ * NZ + ZGD + 8 * (ck_ % 20); gc[i_] = *(const f16x8*)cur_; gp[i_] = t_ > 0 ? *(const f16x8*)(cur_ - NZ) : zero8; } } \
        { const int t_ = t0_ + et; const f16* cur_ = z + (size_t)t_ * NZ + ZV + ch0; vc = *(const f16x8*)cur_; vp = t_ > 0 ? *(const f16x8*)(cur_ - NZ) : zero8; sbn = ((const float*)(a.ws + WS_SBON))[(size_t)t_ * 16 + h]; } } while (0)
    RO_LOAD(blockIdx.x >> 4);
    for (int c = blockIdx.x >> 4; c < 256; c += cstep) {
        const int t0 = c * 64;
        __syncthreads();
        *(LAS u32x4*)(RW_SLOT(lds, 0) + row * RS + seg * 8) = qreg; *(LAS u32x4*)(RW_SLOT(lds, 1) + row * RS + seg * 8) = sreg;
#pragma unroll
        for (int i = 0; i < 3; ++i) { const int ck = tid + 512 * i; if (ck < 64 * 20) { const int rr = ck / 20, c8 = ck % 20; bf16x8 o;
#pragma unroll
            for (int e = 0; e < 8; ++e) o[e] = (bf16)sigmoidf_((float)gc[i][e] + ((float)gp[i][e] - (float)gc[i][e]) * PRM[8 * c8 + e]);
            *(LAS bf16x8*)(SG + rr * RG_S + 8 * c8) = o; } }
        f32x4 y[2], g[2];
        y[0] = (f32x4){(float)yreg[0][0], (float)yreg[0][1], (float)yreg[0][2], (float)yreg[0][3]}; y[1] = (f32x4){(float)yreg[1][0], (float)yreg[1][1], (float)yreg[1][2], (float)yreg[1][3]};
        const f16x8 vcc = vc, vpp = vp; const float sbc = sbn;
        if (c + cstep < 256) RO_LOAD(c + cstep);
        __syncthreads();
        mm_acc<2>(y, RW_SLOT(lds, 0), RS, RW_SLOT(lds, 1), RS, w, lane);
        acc_zero(g); mm_acc<5>(g, SG, RG_S, GU, RG_S, w, lane);
#pragma unroll
        for (int tn = 0; tn < 2; ++tn)
#pragma unroll
            for (int r = 0; r < 4; ++r) { YL[(m0 + r) * RW_FS + n0 + 16 * tn] = y[tn][r]; GL[(m0 + r) * RW_FS + n0 + 16 * tn] = g[tn][r]; }
        __syncthreads();
        { const int t = t0 + et;
          float yv[8], gv[8]; float s1 = 0.f, s2 = 0.f;
#pragma unroll
          for (int e = 0; e < 8; ++e) { yv[e] = YL[et * RW_FS + 8 * cg + e]; gv[e] = GL[et * RW_FS + 8 * cg + e]; s1 += yv[e]; s2 += yv[e] * yv[e]; }
          s1 += __shfl_xor(s1, 1); s1 += __shfl_xor(s1, 2); s1 += __shfl_xor(s1, 4);
          s2 += __shfl_xor(s2, 1); s2 += __shfl_xor(s2, 2); s2 += __shfl_xor(s2, 4);
          const float mean = s1 * (1.f / 64.f), var = fmaxf(s2 * (1.f / 64.f) - mean * mean, 0.f), rstd = rsqrtf(var + 64e-5f);
          f16x8 o;
#pragma unroll
          for (int e = 0; e < 8; ++e) { const int jj = 8 * cg + e; const float vv = (float)vcc[e] + ((float)vpp[e] - (float)vcc[e]) * PRM[160 + jj];
              const float yn = (yv[e] - mean) * rstd * PRM[224 + jj] + PRM[288 + jj]; o[e] = (f16)((yn + sbc * vv) * gv[e]); }
          *(f16x8*)(mix + (size_t)t * D + 1024 + ch0) = o; }
    }
}

constexpr int RT_XS = 2048 + 8;
__device__ __forceinline__ void p_router(const Args& a, LAS unsigned char* lds, int rep) {
    const int tid = opaque_tid(), lane = tid & 63, wave = __builtin_amdgcn_readfirstlane(tid >> 6);
    const float* x2 = (const float*)(a.ws + WS_X1); f16* h3 = (f16*)a.out;
    unsigned* ctl = (unsigned*)(a.ws + WS_CTL);
    int* tke = (int*)(a.ws + WS_TOK + TK_E); float* tkw = (float*)(a.ws + WS_TOK + TK_W);
    const f16* WH = (const f16*)(a.ws + WS_WRH); const f16* WL = (const f16*)(a.ws + WS_WRL);
    LAS float* PART = (LAS float*)lds;
    LAS float* SSP = PART + 8 * 16 * 48;
    LAS float* LG = SSP + 128;
    LAS float* RSTD = LG + 16 * 48;
    LAS float* XT = RSTD + 16;
    const int row = lane & 15, kq = lane >> 4;
    for (int tile = blockIdx.x; tile < T / 16; tile += gridDim.x) {
        const int r0 = tile * 16;
        f32x4 acc[3]; acc[0] = (f32x4){0.f, 0.f, 0.f, 0.f}; acc[1] = acc[0]; acc[2] = acc[0];
        float ss = 0.f;
        const float* xp = x2 + (size_t)(r0 + row) * D + 256 * wave + 8 * kq;
        const f16* whp = WH + (size_t)row * D + 256 * wave + 8 * kq; const f16* wlp = WL + (size_t)row * D + 256 * wave + 8 * kq;
#pragma unroll 1
        for (int kb = 0; kb < 2; ++kb) {
            f32x4 xa[4], xb[4]; f16x8 bh[4][3], bl[4][3];
#pragma unroll
            for (int k4 = 0; k4 < 4; ++k4) { const int ks = kb * 4 + k4; xa[k4] = *(const f32x4*)(xp + 32 * ks); xb[k4] = *(const f32x4*)(xp + 32 * ks + 4);
#pragma unroll
                for (int nt = 0; nt < 3; ++nt) { bh[k4][nt] = *(const f16x8*)(whp + (size_t)nt * 16 * D + 32 * ks); bl[k4][nt] = *(const f16x8*)(wlp + (size_t)nt * 16 * D + 32 * ks); } }
            asm volatile("s_waitcnt vmcnt(0)" ::: "memory");
#pragma unroll
            for (int k4 = 0; k4 < 4; ++k4) {
                { LAS float* xd = XT + row * RT_XS + 256 * wave + 32 * (kb * 4 + k4) + 8 * kq; *(LAS f32x4*)xd = xa[k4]; *(LAS f32x4*)(xd + 4) = xb[k4]; }
                ss += xa[k4].x * xa[k4].x + xa[k4].y * xa[k4].y + xa[k4].z * xa[k4].z + xa[k4].w * xa[k4].w + xb[k4].x * xb[k4].x + xb[k4].y * xb[k4].y + xb[k4].z * xb[k4].z + xb[k4].w * xb[k4].w;
                f16x8 hi, lo;
#pragma unroll
                for (int j = 0; j < 4; ++j) { hi[j] = (f16)xa[k4][j]; lo[j] = (f16)(xa[k4][j] - (float)hi[j]); hi[4 + j] = (f16)xb[k4][j]; lo[4 + j] = (f16)(xb[k4][j] - (float)hi[4 + j]); }
#pragma unroll
                for (int nt = 0; nt < 3; ++nt) {
                    acc[nt] = __builtin_amdgcn_mfma_f32_16x16x32_f16(hi, bh[k4][nt], acc[nt], 0, 0, 0); acc[nt] = __builtin_amdgcn_mfma_f32_16x16x32_f16(lo, bh[k4][nt], acc[nt], 0, 0, 0); acc[nt] = __builtin_amdgcn_mfma_f32_16x16x32_f16(hi, bl[k4][nt], acc[nt], 0, 0, 0); }
            }
        }
        ss += __shfl_xor(ss, 16); ss += __shfl_xor(ss, 32);
        __syncthreads();
        if (kq == 0) SSP[wave * 16 + row] = ss;
#pragma unroll
        for (int nt = 0; nt < 3; ++nt)
#pragma unroll
            for (int r = 0; r < 4; ++r) PART[(wave * 16 + 4 * kq + r) * 48 + 16 * nt + row] = acc[nt][r];
        __syncthreads();
        for (int i = tid; i < 16 * 48; i += 512) { float v = 0.f;
#pragma unroll
            for (int ww = 0; ww < 8; ++ww) v += PART[ww * 768 + i];
            LG[i] = v; }
        if (tid < 16) { float v = 0.f;
#pragma unroll
            for (int ww = 0; ww < 8; ++ww) v += SSP[ww * 16 + tid];
            RSTD[tid] = rsqrtf(v * (1.f / D) + EPS); }
        __syncthreads();
        if (tid < 16) {
            const float rs = RSTD[tid]; const LAS float* L = LG + tid * 48;
            float lg[4];
#pragma unroll
            for (int c = 0; c < 4; ++c) lg[c] = L[c] * rs + a.in[I_RGB][c];
            int gi = 0; float gm = lg[0];
#pragma unroll
            for (int c = 1; c < 4; ++c) if (lg[c] > gm) { gm = lg[c]; gi = c; }
            float gs = 0.f;
#pragma unroll
            for (int c = 0; c < 4; ++c) gs += __expf(lg[c] - gm);
            const float pg = 1.f / gs;
            float le[8];
#pragma unroll
            for (int c = 0; c < 8; ++c) le[c] = L[4 + gi * 8 + c] * rs + a.in[I_REB][gi * 8 + c];
            int e1 = 0; float m1 = le[0];
#pragma unroll
            for (int c = 1; c < 8; ++c) if (le[c] > m1) { m1 = le[c]; e1 = c; }
            int e2 = -1; float m2 = -INFINITY;
#pragma unroll
            for (int c = 0; c < 8; ++c) if (c != e1 && le[c] > m2) { m2 = le[c]; e2 = c; }
            const float p2 = __expf(m2 - m1);
            const float w1 = pg / (1.f + p2), w2 = pg * p2 / (1.f + p2);
            const int m = r0 + tid, E1 = gi * 8 + e1, E2 = gi * 8 + e2; tke[m * 2] = E1; tke[m * 2 + 1] = E2; tkw[m * 2] = w1; tkw[m * 2 + 1] = w2;
            atomicAdd(&ctl[CW_CNT + rep * 8000 + E1], 1u); atomicAdd(&ctl[CW_CNT + rep * 8000 + E2], 1u);
        }
        { f32x4 xv[2][8], gg[8]; const f32x4* gr = (const f32x4*)a.in[I_LN3] + lane;
#pragma unroll
          for (int j = 0; j < 8; ++j) gg[j] = gr[64 * j];
#pragma unroll
          for (int rr2 = 0; rr2 < 2; ++rr2) { const LAS f32x4* xr = (const LAS f32x4*)(XT + (wave * 2 + rr2) * RT_XS) + lane;
#pragma unroll
              for (int j = 0; j < 8; ++j) xv[rr2][j] = xr[64 * j]; }
#pragma unroll
          for (int rr2 = 0; rr2 < 2; ++rr2) { const int rr = wave * 2 + rr2; const float rs = RSTD[rr]; u32x2* o8 = (u32x2*)(h3 + (size_t)(r0 + rr) * D) + lane;
#pragma unroll
              for (int j = 0; j < 8; ++j) { const f32x4 v = xv[rr2][j]; u32x2 wv; wv.x = pkh(v.x * rs * gg[j].x, v.y * rs * gg[j].y); wv.y = pkh(v.z * rs * gg[j].z, v.w * rs * gg[j].w); o8[64 * j] = wv; } } }
        __syncthreads();
    }
}
__device__ __forceinline__ void p_slots(const Args& a, LAS unsigned char* lds, int rep) {
    unsigned* ctl = (unsigned*)(a.ws + WS_CTL);
    const int* tke = (const int*)(a.ws + WS_TOK + TK_E); const float* tkw = (const float*)(a.ws + WS_TOK + TK_W); int* tks = (int*)(a.ws + WS_TOK + TK_SLOT);
    int* stok = (int*)(a.ws + WS_TOK + TK_STOK); float* sw = (float*)(a.ws + WS_TOK + TK_SW);
    const int tid = opaque_tid(), lane = tid & 63;
    LAS int* offl = (LAS int*)lds; LAS int* cntl = offl + 64;
    __syncthreads();
    if (tid < 64) {
        const int n = lane < NEXP ? (int)ctl[CW_CNT + lane] : 0, nt = (n + 255) >> 8;
        int pre = nt;
#pragma unroll
        for (int o = 1; o < 32; o <<= 1) { const int v = __shfl_up(pre, o); if ((lane & 31) >= o) pre += v; }
        const int tb = pre - nt;
        if (lane < NEXP) { offl[lane] = tb * 256; cntl[lane] = n; }
        if (lane == NEXP - 1) offl[NEXP] = pre * 256;
        if (blockIdx.x == 0 && lane < NEXP) {
            int2* ugu = (int2*)(ctl + CW_UGU); int2* udn = (int2*)(ctl + CW_UDN);
            for (int rt = 0; rt < nt; ++rt) { const int pm = tb + rt;
#pragma unroll
                for (int jt = 0; jt < 2; ++jt) ugu[pm * 2 + jt] = make_int2(pm, lane * 2 + jt);
#pragma unroll
                for (int jt = 0; jt < 8; ++jt) udn[pm * 8 + jt] = make_int2(pm, lane * 8 + jt); }
            if (lane == NEXP - 1) { ctl[CW_NT] = (unsigned)pre; ctl[CW_NGU] = (unsigned)(pre * 2); ctl[CW_NDN] = (unsigned)(pre * 8); }
        }
    }
    __syncthreads();
    if (blockIdx.x == 0 && rep == 0) {
        for (int e = 0; e < NEXP; ++e) { const int end = offl[e + 1];
            for (int sl = offl[e] + cntl[e] + tid; sl < end; sl += 512) { stok[sl] = 0; sw[sl] = 0.f; } } }
    LAS int* hist = cntl + 64; LAS int* gbase = hist + 64;
    for (int base = blockIdx.x * 512; base < T * 2; base += gridDim.x * 512) {
        __syncthreads();
        if (tid < 64) hist[tid] = 0;
        __syncthreads();
        const int i = base + tid; const bool ok = i < T * 2; const int e = ok ? tke[i] : 0;
        int rank = 0; if (ok) rank = __hip_atomic_fetch_add((int*)(hist + e), 1, __ATOMIC_RELAXED, __HIP_MEMORY_SCOPE_WORKGROUP);
        __syncthreads();
        if (tid < NEXP) { const int c = hist[tid]; gbase[tid] = c ? (int)atomicAdd(&ctl[CW_CUR + rep * 8000 + tid], (unsigned)c) : 0; }
        __syncthreads();
        if (ok) { const int slot = offl[e] + gbase[e] + rank; stok[slot] = i >> 1; sw[slot] = tkw[i]; tks[i] = slot; }
    }
}


constexpr int NPH = 17;
__global__ void __launch_bounds__(512, 2) mega(Args args) {
    extern __shared__ __attribute__((aligned(16))) unsigned char lds_raw[];
    LAS unsigned char* lds = (LAS unsigned char*)lds_raw;
    volatile LAS unsigned* MISC = (volatile LAS unsigned*)(lds + MISC_OFF);
    const int G = gridDim.x;
#define PH_IDS const int tid = opaque_tid(), lane = tid & 63, wave = tid >> 6, gw = blockIdx.x * 8 + wave, NGW = gridDim.x * 8; (void)tid; (void)lane; (void)gw; (void)NGW
    unsigned char* ws = args.ws;
    unsigned* ctl = (unsigned*)(ws + WS_CTL);
    if (threadIdx.x < 128) ((LAS unsigned*)(lds + MISC_OFF))[threadIdx.x] = 0u;
    __syncthreads();
    XcdBarrier bar; bar.bar = ctl + CW_BAR; bar.x = 0; bar.st = nullptr;
    const int lo = args.ph_lo, hi = args.ph_hi;
    if (hi - lo > 1 || DUPMASK != 0u) bar = xcd_barrier_post(ctl + CW_BAR, MISC + 8);
#ifndef PHMASK
#define PHMASK 0xFFFFFFFFu
#endif
#define IN(k) (((PHMASK >> (k)) & 1u) && lo <= (k) && (k) < hi)
#define BOTH(k) (IN(k) && IN((k) + 1))
#define GRID_BAR() xcd_barrier(bar)
#define NREP(k) ((((DUPMASK) >> (k)) & 1u) ? 2 : 1)

    for (int rep_ = 0; rep_ < NREP(0); ++rep_) if (IN(0)) { p0_prologue(args, lds); if (BOTH(0) || rep_ + 1 < NREP(0)) GRID_BAR(); }
    for (int rep_ = 0; rep_ < NREP(1); ++rep_) if (IN(1)) {
        { pg8::Gemm g{(const f16*)(ws + WS_H), (const f16*)(ws + WS_WIN), D, D, D, nullptr}; pg8::StaticOrder S; S.init(T, NZ, G, (int)blockIdx.x);
          pg8::EpiF16 E{(f16*)(ws + WS_Z), NZ, 1.f}; pg8::gemm_phase<pg8::EpiF16, pg8::StaticOrder, true>(lds, g, S, E); }
        if (BOTH(1) || rep_ + 1 < NREP(1)) GRID_BAR();
    }
    for (int rep_ = 0; rep_ < NREP(2); ++rep_) if (IN(2)) {
        for (int r2_ = 0; r2_ < ((DUPX & 1) ? 2 : 1); ++r2_) { p_compress(args, lds); __syncthreads(); }
        for (int r2_ = 0; r2_ < ((DUPX & 2) ? 2 : 1); ++r2_) { p_rwkv_local(args, lds); __syncthreads(); }
        if (BOTH(2) || rep_ + 1 < NREP(2)) GRID_BAR();
    }
    for (int rep_ = 0; rep_ < NREP(3); ++rep_) if (IN(3)) {
        if (blockIdx.x < 16) p_rwkv_scan(args, lds, blockIdx.x);
        else if (blockIdx.x < 32 && rep_ == 0) { const int b = blockIdx.x - 16; const int which = b / 8;
            pg8::Gemm g{(const f16*)(ws + WS_MEMN), (const f16*)(ws + (which == 0 ? WS_WKT : WS_WVT)), D, D, D, nullptr}; pg8::StaticOrder S; S.init(256, D, 8, b % 8);
            pg8::EpiF16 E{(f16*)(ws + (which == 0 ? WS_KM : WS_VM)), D, 1.f}; pg8::gemm_phase<pg8::EpiF16, pg8::StaticOrder, true>(lds, g, S, E); }
        __syncthreads();
        p_nsa(args, lds, rep_);
        if (BOTH(3) || rep_ + 1 < NREP(3)) GRID_BAR();
    }
    for (int rep_ = 0; rep_ < NREP(5); ++rep_) if (IN(5)) {
        p_rwkv_out(args, lds);
        __syncthreads();
        PH_IDS;
        if (blockIdx.x < 64) { const int b = blockIdx.x; const int grp = b / 8, c = b % 8;
          if (grp < 4) { const int h = grp;
              pg8::Gemm g{(const f16*)(ws + WS_KM) + h * 512, (const f16*)(ws + WS_WQ16) + h * 512, D, D, 512, nullptr}; pg8::StaticOrder S; S.init(256, D, 8, c);
              pg8::EpiF16 E{(f16*)(ws + WS_WQK) + (size_t)h * 256 * D, D, 0.04419417382415922f}; pg8::gemm_phase<pg8::EpiF16, pg8::StaticOrder, true>(lds, g, S, E); }
          else { const int h = grp - 4;
              pg8::Gemm g{(const f16*)(ws + WS_WOT) + h * 512, (const f16*)(ws + WS_VM) + h * 512, D, D, 512, nullptr}; pg8::StaticOrder S; S.init(D, 256, 8, c);
              pg8::EpiF16 E{(f16*)(ws + WS_VOT) + h * 256, 1024, 1.f}; pg8::gemm_phase<pg8::EpiF16, pg8::StaticOrder, true>(lds, g, S, E); } }
        else {
        const float* onsa = (const float*)(ws + WS_ONSA); f16* mix = (f16*)(ws + WS_MIX);
        for (int m = gw - 64 * 8; m < T; m += NGW - 64 * 8) { const f32x4* xr = (const f32x4*)(onsa + (size_t)m * 1024) + lane; f32x4 v[4]; float s = 0.f;
#pragma unroll
            for (int j = 0; j < 4; ++j) { v[j] = xr[64 * j]; s += v[j].x * v[j].x + v[j].y * v[j].y + v[j].z * v[j].z + v[j].w * v[j].w; }
            const f32x4* gr = (const f32x4*)args.in[I_NSAG] + lane; f32x4 gg[4];
#pragma unroll
            for (int j = 0; j < 4; ++j) gg[j] = gr[64 * j];
            const float rstd = rsqrtf(wave_sum(s) * (1.f / 1024.f) + EPS); u32x2* o8 = (u32x2*)(mix + (size_t)m * D) + lane;
#pragma unroll
            for (int j = 0; j < 4; ++j) { u32x2 w; w.x = pkh(v[j].x * rstd * gg[j].x, v[j].y * rstd * gg[j].y); w.y = pkh(v[j].z * rstd * gg[j].z, v[j].w * rstd * gg[j].w); o8[64 * j] = w; } }
        }
        if (BOTH(5) || rep_ + 1 < NREP(5)) GRID_BAR();
    }
    for (int rep_ = 0; rep_ < NREP(6); ++rep_) if (IN(6)) {
        pg8::Gemm g{(const f16*)(ws + WS_MIX), (const f16*)(ws + WS_WOUT), D, D, D, nullptr}; pg8::StaticOrder S; S.init(T, D, G, (int)blockIdx.x);
        pg8::EpiRes16 E{(float*)(ws + WS_X1), args.in[I_X], (f16*)(ws + WS_H2), (float*)(ws + WS_CTL + WS_ROWSS), D}; pg8::gemm_phase<pg8::EpiRes16, pg8::StaticOrder, true>(lds, g, S, E);
        if (BOTH(6) || rep_ + 1 < NREP(6)) GRID_BAR();
    }
    for (int rep_ = 0; rep_ < NREP(7); ++rep_) if (IN(7)) {
        PH_IDS;
        p_moe_weights(args, lds);
        if (BOTH(7) || rep_ + 1 < NREP(7)) GRID_BAR();
    }
    for (int rep_ = 0; rep_ < NREP(8); ++rep_) if (IN(8)) {
        pg8::Gemm g{(const f16*)(ws + WS_H2), (const f16*)(ws + WS_WQK), D, D, D, nullptr}; pg8::StaticOrder S; S.init(T, 1024, G, (int)blockIdx.x);
        pg8::EpiSoftmax E{(f16*)(ws + WS_P), 1024, (const float*)(ws + WS_CTL + WS_ROWSS), (LAS float*)(lds + RING_BYTES), (LAS float*)(lds + RING_BYTES + 4096)}; pg8::gemm_phase<pg8::EpiSoftmax, pg8::StaticOrder, true>(lds, g, S, E);
        if (BOTH(8) || rep_ + 1 < NREP(8)) GRID_BAR();
    }
    for (int rep_ = 0; rep_ < NREP(10); ++rep_) if (IN(10)) {
        pg8::Gemm g{(const f16*)(ws + WS_P), (const f16*)(ws + WS_VOT), 1024, 1024, 1024, nullptr}; pg8::StaticOrder S; S.init(T, D, G, (int)blockIdx.x);
        pg8::EpiF32 E{(float*)(ws + WS_X1), (const float*)(ws + WS_X1), D}; pg8::gemm_phase<pg8::EpiF32, pg8::StaticOrder, true>(lds, g, S, E);
        if (BOTH(10) || rep_ + 1 < NREP(10)) GRID_BAR();
    }
    for (int rep_ = 0; rep_ < NREP(11); ++rep_) if (IN(11)) { p_router(args, lds, rep_); if (BOTH(11) || rep_ + 1 < NREP(11)) GRID_BAR(); }
    for (int rep_ = 0; rep_ < NREP(13); ++rep_) if (IN(13)) { p_slots(args, lds, rep_); if (BOTH(13) || rep_ + 1 < NREP(13)) GRID_BAR(); }
    for (int rep_ = 0; rep_ < NREP(14); ++rep_) if (IN(14)) {
        pg8::Gemm g{(const f16*)args.out, (const f16*)(ws + WS_WGU), D, D, D, (const int*)(ws + WS_TOK + TK_STOK)};
        pg8::TableOrder S{(const int2*)(ctl + CW_UGU), (int)ctl[CW_NGU], G, (int)blockIdx.x};
        pg8::EpiSilu E{(f16*)(ws + WS_HID)}; pg8::gemm_phase<pg8::EpiSilu, pg8::TableOrder, true, true>(lds, g, S, E);
        if (BOTH(14) || rep_ + 1 < NREP(14)) GRID_BAR();
    }
    for (int rep_ = 0; rep_ < NREP(15); ++rep_) if (IN(15)) {
        pg8::Gemm g{(const f16*)(ws + WS_HID), (const f16*)(ws + WS_WD), EFF, EFF, EFF, nullptr};
        pg8::TableOrder S{(const int2*)(ctl + CW_UDN), (int)ctl[CW_NDN], G, (int)blockIdx.x};
        pg8::EpiDown E{ws}; pg8::gemm_phase<pg8::EpiDown, pg8::TableOrder, true>(lds, g, S, E);
        if (BOTH(15) || rep_ + 1 < NREP(15)) GRID_BAR();
    }
    for (int rep_ = 0; rep_ < NREP(16); ++rep_) if (IN(16)) {
        PH_IDS;
        const float* x2 = (const float*)(ws + WS_X1); const int* tks = (const int*)(ws + WS_TOK + TK_SLOT);
        const float* tkw = (const float*)(ws + WS_TOK + TK_W);
        for (int m0_ = gw; m0_ < T; m0_ += 2 * NGW) {
            const int mm[2] = {m0_, (m0_ + NGW < T) ? m0_ + NGW : m0_};
            int sa[2][2]; float wa[2][2];
#pragma unroll
            for (int q = 0; q < 2; ++q) { sa[q][0] = tks[mm[q] * 2]; sa[q][1] = tks[mm[q] * 2 + 1]; wa[q][0] = tkw[mm[q] * 2]; wa[q][1] = tkw[mm[q] * 2 + 1]; }
            f32x4 v[2][8]; f16x4 ya[2][2][8];
#pragma unroll
            for (int q = 0; q < 2; ++q) { const f32x4* xr = (const f32x4*)(x2 + (size_t)mm[q] * D) + lane;
#pragma unroll
                for (int j = 0; j < 8; ++j) v[q][j] = xr[64 * j];
#pragma unroll
                for (int k = 0; k < 2; ++k) { const int sl = sa[q][k]; const f16* yp = (const f16*)(ws + ((sl >> 8) < 128 ? WS_Y0 + (size_t)(sl >> 8) * MiB : WS_Y1 + (size_t)((sl >> 8) - 128) * MiB)) + (size_t)(sl & 255) * D;
#pragma unroll
                    for (int j = 0; j < 8; ++j) ya[q][k][j] = *((const f16x4*)yp + lane + 64 * j); } }
            const f32x4* gr = (const f32x4*)args.in[I_LNF] + lane; f32x4 gg[8];
#pragma unroll
            for (int j = 0; j < 8; ++j) gg[j] = gr[64 * j];
#pragma unroll
            for (int q = 0; q < 2; ++q) { float s = 0.f; const float w1 = wa[q][0], w2 = wa[q][1];
#pragma unroll
                for (int j = 0; j < 8; ++j) { const f16x4 a1 = ya[q][0][j], a2 = ya[q][1][j];
                    v[q][j].x += w1 * (float)a1.x + w2 * (float)a2.x; v[q][j].y += w1 * (float)a1.y + w2 * (float)a2.y; v[q][j].z += w1 * (float)a1.z + w2 * (float)a2.z; v[q][j].w += w1 * (float)a1.w + w2 * (float)a2.w;
                    s += v[q][j].x * v[q][j].x + v[q][j].y * v[q][j].y + v[q][j].z * v[q][j].z + v[q][j].w * v[q][j].w; }
                const float rstd = rsqrtf(wave_sum(s) * (1.f / D) + EPS);
                if (q == 0 || mm[1] != mm[0]) { f32x4* o = (f32x4*)(args.out + (size_t)mm[q] * D) + lane;
#pragma unroll
                    for (int j = 0; j < 8; ++j) o[64 * j] = (f32x4){v[q][j].x * rstd * gg[j].x, v[q][j].y * rstd * gg[j].y, v[q][j].z * rstd * gg[j].z, v[q][j].w * rstd * gg[j].w}; } }
        }
    }
#undef IN
#undef BOTH
#undef GRID_BAR
}

extern "C" void kernel_launch(void* const* d_in, const int* in_sizes, int n_in, void* d_out, int out_size, void* d_ws, size_t ws_size, hipStream_t stream) {
    static int grid = 0;
    if (grid == 0) {
        if (n_in != 38 || out_size != T * D || ws_size < WS_END) { fprintf(stderr, "kernel_launch: unexpected shapes (n_in %d out %d ws %zu)\n", n_in, out_size, ws_size); grid = -1; return; }
        int dev = 0, cus = 0;
        if (hipGetDevice(&dev) != hipSuccess || hipDeviceGetAttribute(&cus, hipDeviceAttributeMultiprocessorCount, dev) != hipSuccess) { grid = -1; return; }
        if (hipFuncSetAttribute((const void*)mega, hipFuncAttributeMaxDynamicSharedMemorySize, LDS_BYTES) != hipSuccess) { grid = -1; return; }
        int per_cu = 0; (void)hipOccupancyMaxActiveBlocksPerMultiprocessor(&per_cu, (const void*)mega, 512, LDS_BYTES); (void)hipGetLastError();
        grid = cus;
    }
    if (grid < 0) return;
    (void)hipMemsetAsync((char*)d_ws + WS_CTL, 0, CTL_ZERO_BYTES, stream);
    Args a{};
    for (int i = 0; i < 38; ++i) a.in[i] = (const float*)d_in[i];
    a.out = (float*)d_out; a.ws = (unsigned char*)d_ws;
#if MK_ONE_LAUNCH
    a.ph_lo = 0; a.ph_hi = NPH;
    hipLaunchKernelGGL(mega, dim3(grid), dim3(512), LDS_BYTES, stream, a);
#else
    for (int p = 0; p < NPH; ++p) { a.ph_lo = p; a.ph_hi = p + 1; hipLaunchKernelGGL(mega, dim3(grid), dim3(512), LDS_BYTES, stream, a); }
#endif
}
```

```cpp
#include <hip/hip_runtime.h>
#include <cstdio>
#include <cstdint>

#ifndef DUPMASK
#define DUPMASK 0u
#endif
#ifndef NSA_SELREP
#define NSA_SELREP 1
#endif
#ifndef NSA_CMPREP
#define NSA_CMPREP 1
#endif
#ifndef NSA_WINREP
#define NSA_WINREP 1
#endif
#ifndef DUPX
#define DUPX 0
#endif
#ifndef NSA_DECOUPLED
#define NSA_DECOUPLED 0
#endif
#ifndef MK_ONE_LAUNCH
#define MK_ONE_LAUNCH 1
#endif

#define LAS __attribute__((address_space(3)))
#define GAS __attribute__((address_space(1)))
typedef _Float16 f16;
typedef _Float16 f16x8 __attribute__((ext_vector_type(8)));
typedef _Float16 f16x4 __attribute__((ext_vector_type(4)));
typedef _Float16 f16x2 __attribute__((ext_vector_type(2)));
typedef float f32x4 __attribute__((ext_vector_type(4)));
typedef float f32x2 __attribute__((ext_vector_type(2)));
typedef unsigned u32x4 __attribute__((ext_vector_type(4)));
typedef unsigned u32x2 __attribute__((ext_vector_type(2)));
typedef __bf16 bf16;
typedef __bf16 bf16x8 __attribute__((ext_vector_type(8)));
typedef __bf16 bf16x4 __attribute__((ext_vector_type(4)));

constexpr int T = 16384, D = 2048, NZ = 6144;
constexpr int ZQ = 0, ZKC = 1024, ZVC = 1280, ZKS = 1536, ZVS = 1792, ZKW = 2048, ZVW = 2304, ZR = 2560, ZK = 3584, ZV = 4608, ZWD = 5632, ZAD = 5696, ZGD = 5760, ZGL = 5920;
constexpr int NCMP = 1023;
constexpr int NEXP = 32, EFF = 256, MAXSLOT = 40960, MAXTILES = 160;
constexpr float EPS = 1e-6f;

constexpr size_t MiB = 1u << 20;
constexpr size_t WS_CTL = 0, CTL_ZERO_BYTES = 192 * 1024, WS_ROWSS = 128 * 1024;
constexpr size_t WS_MEMN = 1 * MiB, WS_KM = 2 * MiB, WS_VM = 3 * MiB, WS_KCMP = 4 * MiB, WS_VCMP = 5 * MiB, WS_TOK = 6 * MiB, WS_CMPB = 7 * MiB;
constexpr size_t WS_WQK = 8 * MiB, WS_VOT = 12 * MiB, WS_WIN = 16 * MiB, WS_WOUT = 40 * MiB, WS_WQ16 = 48 * MiB, WS_WKT = 56 * MiB, WS_WVT = 64 * MiB, WS_WOT = 72 * MiB;
constexpr size_t WS_WGU = 80 * MiB, WS_WD = 144 * MiB, WS_H = 176 * MiB, WS_Z = 240 * MiB, WS_ONSA = 432 * MiB, WS_END = 512 * MiB;
constexpr size_t WS_MIX = 112 * MiB, WS_P = WS_H, WS_H2 = WS_Z, WS_X1 = 304 * MiB, WS_S = WS_ONSA, WS_HID = 16 * MiB;
constexpr size_t WS_Y0 = 176 * MiB, WS_Y1 = 432 * MiB;
constexpr size_t WS_RS = 200 * MiB, WS_SBON = 232 * MiB;
constexpr size_t WS_WUPT = WS_CMPB + 64 * 1024, WS_AUPT = WS_WUPT + 128 * 1024, WS_GUPT = WS_AUPT + 128 * 1024;
constexpr size_t WS_W1T = 496 * MiB, WS_W2T = 498 * MiB, WS_CBIAS = 498 * MiB + 65536;
constexpr size_t WS_WRH = 499 * MiB, WS_WRL = 499 * MiB + 256 * 1024;
constexpr size_t RO_M = 0, RO_N = 32 * MiB, RO_Q = 64 * MiB, RO_Y = 96 * MiB;
constexpr size_t TK_E = 0, TK_W = 128 * 1024, TK_SLOT = 256 * 1024, TK_STOK = 384 * 1024, TK_SW = 576 * 1024;
constexpr int CW_BAR = 0;
constexpr int CW_Q = 3584;
constexpr int CW_CNT = 4096, CW_CUR = 4160, CW_OFF = 4224, CW_NT = 4288  , CW_NGU = 4289, CW_NDN = 4290;
constexpr int CW_UGU = 6144  , CW_UDN = 8192  ;
static_assert((CW_UDN + MAXTILES * 8 * 2) * 4 <= (int)CTL_ZERO_BYTES, "ctl");

constexpr int RING_BYTES = 131072, LDS_BYTES = 163840, MISC_OFF = LDS_BYTES - 512;

__device__ __forceinline__ unsigned pkh(float a, float b) { f16x2 v = {(f16)a, (f16)b}; return __builtin_bit_cast(unsigned, v); }
__device__ __forceinline__ float wave_sum(float v) {
#pragma unroll
    for (int o = 1; o < 64; o <<= 1) v += __shfl_xor(v, o);
    return v;
}
__device__ __forceinline__ float wave_max(float v) {
#pragma unroll
    for (int o = 1; o < 64; o <<= 1) v = fmaxf(v, __shfl_xor(v, o));
    return v;
}
__device__ __forceinline__ int opaque_tid() { int t = threadIdx.x; asm volatile("" : "+v"(t)); return t; }
#define LDS_WAIT() asm volatile("s_waitcnt lgkmcnt(0)" ::: "memory")
#define VM_WAIT() asm volatile("s_waitcnt vmcnt(0)" ::: "memory")
__device__ __forceinline__ float sigmoidf_(float x) { return 1.f / (1.f + __expf(-x)); }

namespace pg8 {
constexpr int BM = 256, BK = 64, HALF = 128, HTB = HALF * BK * 2, STAGE_BYTES = 8 * HTB, NXCD = 8, WGM = 8;
__host__ __device__ __forceinline__ int lds_byte(int r, int c) { const int st = (r >> 4) * 2 + (c >> 5), rr = r & 15, cc = c & 31, ob = rr * 64 + cc * 2; return st * 1024 + (ob ^ (((ob >> 9) & 1) << 5)); }
__host__ __device__ __forceinline__ void stage_rc(int b, int& R, int& C) { const int st = b / 1024, sb = b % 1024, swz = sb ^ (((sb >> 9) & 1) << 5); R = (st >> 1) * 16 + swz / 64; C = (st & 1) * 32 + (swz % 64) / 2; }
__host__ __device__ __forceinline__ int perm32(int rho) { const int n = rho >> 4, i = rho & 15; return 8 * (i >> 2) + 4 * n + (i & 3); }

struct Unit { int pm, pn; };
struct Gemm { const f16* A; const f16* Bt; int lda, ldb, K; const int* gather; };

struct StaticOrder {
    int nM, nN, nwg, G, c;
    __host__ __device__ void init(int M, int N, int G_, int c_) { nM = M / BM; nN = N / BM; nwg = nM * nN; G = G_; c = c_; }
    __host__ __device__ bool next(int i, Unit& u) const {
        const long L = (long)i * G + c; if (L >= nwg) return false;
        int wgid = (int)L; { const int q = nwg / NXCD, r = nwg % NXCD, xcd = wgid % NXCD, off = wgid / NXCD; wgid = (xcd < r ? xcd * (q + 1) : r * (q + 1) + (xcd - r) * q) + off; }
        const int nig = WGM * nN, gid = wgid / nig, fm = gid * WGM, gsz = (nM - fm) < WGM ? (nM - fm) : WGM;
        u.pm = fm + ((wgid % nig) % gsz); u.pn = (wgid % nig) / gsz; return true;
    }
};
struct TableOrder {
    const int2* tab; int n, G, c;
    __device__ bool next(int i, Unit& u) const { const int L = i * G + c; if (L >= n) return false; const int2 v = tab[L]; u.pm = v.x; u.pn = v.y; return true; }
};

struct EpiF16 {
    static constexpr bool PERM = true;
    f16* O; int ldc; float scale;
    __device__ __forceinline__ void operator()(const f32x4 (&acc)[2][2][4][2], const Unit& u, int wr, int wc, int fr, int fq) const {
        const int row0 = u.pm * BM + wr * 64 + fr, col0 = u.pn * BM + wc * 32 + 8 * fq;
#pragma unroll
        for (int ai = 0; ai < 2; ++ai)
#pragma unroll
            for (int m = 0; m < 4; ++m) { f16* rowp = O + (size_t)(row0 + ai * HALF + m * 16) * ldc + col0;
#pragma unroll
                for (int bj = 0; bj < 2; ++bj) { const f32x4 v0 = acc[ai][bj][m][0] * scale, v1 = acc[ai][bj][m][1] * scale;
                    u32x4 w; w.x = pkh(v0[0], v0[1]); w.y = pkh(v0[2], v0[3]); w.z = pkh(v1[0], v1[1]); w.w = pkh(v1[2], v1[3]);
                    *(u32x4*)(rowp + bj * HALF) = w; } }
    }
};
struct EpiF32 {
    static constexpr bool PERM = false;
    float* C; const float* R; int ldc;
    __device__ __forceinline__ void operator()(const f32x4 (&acc)[2][2][4][2], const Unit& u, int wr, int wc, int fr, int fq) const {
        const int row0 = u.pm * BM + wr * 64 + fr, col0 = u.pn * BM + wc * 32 + 4 * fq;
#pragma unroll
        for (int ai = 0; ai < 2; ++ai)
#pragma unroll
            for (int m = 0; m < 4; ++m) { const size_t ro = (size_t)(row0 + ai * HALF + m * 16) * ldc + col0;
#pragma unroll
                for (int bj = 0; bj < 2; ++bj)
#pragma unroll
                    for (int n = 0; n < 2; ++n) { f32x4 v = acc[ai][bj][m][n]; if (R) v = v + *(const f32x4*)(R + ro + bj * HALF + n * 16); *(f32x4*)(C + ro + bj * HALF + n * 16) = v; } }
    }
};
struct EpiRes16 {
    static constexpr bool PERM = false;
    float* C; const float* R; f16* H; float* rowss; int ldc;
    __device__ __forceinline__ void operator()(const f32x4 (&acc)[2][2][4][2], const Unit& u, int wr, int wc, int fr, int fq) const {
        const int row0 = u.pm * BM + wr * 64 + fr, col0 = u.pn * BM + wc * 32 + 4 * fq;
#pragma unroll
        for (int ai = 0; ai < 2; ++ai)
#pragma unroll
            for (int m = 0; m < 4; ++m) { const int row = row0 + ai * HALF + m * 16; const size_t ro = (size_t)row * ldc + col0; float ss = 0.f;
                f32x4 v[2][2];
#pragma unroll
                for (int bj = 0; bj < 2; ++bj)
#pragma unroll
                    for (int n = 0; n < 2; ++n) v[bj][n] = acc[ai][bj][m][n] + *(const f32x4*)(R + ro + bj * HALF + n * 16);
#pragma unroll
                for (int bj = 0; bj < 2; ++bj)
#pragma unroll
                    for (int n = 0; n < 2; ++n) { const f32x4 x = v[bj][n]; *(f32x4*)(C + ro + bj * HALF + n * 16) = x; ss += x.x * x.x + x.y * x.y + x.z * x.z + x.w * x.w;
                        u32x2 hw; hw.x = pkh(x.x, x.y); hw.y = pkh(x.z, x.w); *(u32x2*)(H + ro + bj * HALF + n * 16) = hw; }
                ss += __shfl_xor(ss, 16); ss += __shfl_xor(ss, 32);
                if (fq == 0) atomicAdd(rowss + row, ss); }
    }
};
struct EpiSoftmax {
    static constexpr bool PERM = true;
    f16* O; int ldc; const float* rowss; LAS float* xm; LAS float* xs;
    __device__ __forceinline__ void operator()(const f32x4 (&acc)[2][2][4][2], const Unit& u, int wr, int wc, int fr, int fq) const {
        const int row0 = u.pm * BM + wr * 64 + fr, col0 = u.pn * BM + wc * 32 + 8 * fq;
        float rs[2][4], mx[2][4];
#pragma unroll
        for (int ai = 0; ai < 2; ++ai)
#pragma unroll
            for (int m = 0; m < 4; ++m) { rs[ai][m] = rsqrtf(rowss[row0 + ai * HALF + m * 16] * (1.f / D) + EPS); float v = -INFINITY;
#pragma unroll
                for (int bj = 0; bj < 2; ++bj)
#pragma unroll
                    for (int n = 0; n < 2; ++n)
#pragma unroll
                        for (int e = 0; e < 4; ++e) v = fmaxf(v, acc[ai][bj][m][n][e]);
                v *= rs[ai][m]; v = fmaxf(v, __shfl_xor(v, 16)); v = fmaxf(v, __shfl_xor(v, 32));
                if (fq == 0) xm[(ai * HALF + wr * 64 + m * 16 + fr) * 4 + wc] = v; }
        asm volatile("s_waitcnt lgkmcnt(0)" ::: "memory"); __builtin_amdgcn_s_barrier(); asm volatile("" ::: "memory");
        float e_[2][4][16]; float inv[2][4];
#pragma unroll
        for (int ai = 0; ai < 2; ++ai)
#pragma unroll
            for (int m = 0; m < 4; ++m) { const LAS f32x4* q = (const LAS f32x4*)(xm + (ai * HALF + wr * 64 + m * 16 + fr) * 4); const f32x4 mm = *q; mx[ai][m] = fmaxf(fmaxf(mm.x, mm.y), fmaxf(mm.z, mm.w)); float sm = 0.f;
#pragma unroll
                for (int bj = 0; bj < 2; ++bj)
#pragma unroll
                    for (int n = 0; n < 2; ++n)
#pragma unroll
                        for (int e = 0; e < 4; ++e) { const float ev = __expf(acc[ai][bj][m][n][e] * rs[ai][m] - mx[ai][m]); e_[ai][m][bj * 8 + n * 4 + e] = ev; sm += ev; }
                sm += __shfl_xor(sm, 16); sm += __shfl_xor(sm, 32);
                if (fq == 0) xs[(ai * HALF + wr * 64 + m * 16 + fr) * 4 + wc] = sm; }
        asm volatile("s_waitcnt lgkmcnt(0)" ::: "memory"); __builtin_amdgcn_s_barrier(); asm volatile("" ::: "memory");
#pragma unroll
        for (int ai = 0; ai < 2; ++ai)
#pragma unroll
            for (int m = 0; m < 4; ++m) { const f32x4 ssum = *(const LAS f32x4*)(xs + (ai * HALF + wr * 64 + m * 16 + fr) * 4); inv[ai][m] = 1.f / ((ssum.x + ssum.y) + (ssum.z + ssum.w));
                f16* rowp = O + (size_t)(row0 + ai * HALF + m * 16) * ldc + col0;
#pragma unroll
                for (int bj = 0; bj < 2; ++bj) { const float* ee = &e_[ai][m][bj * 8]; const float iv = inv[ai][m];
                    u32x4 w; w.x = pkh(ee[0] * iv, ee[1] * iv); w.y = pkh(ee[2] * iv, ee[3] * iv); w.z = pkh(ee[4] * iv, ee[5] * iv); w.w = pkh(ee[6] * iv, ee[7] * iv);
                    *(u32x4*)(rowp + bj * HALF) = w; } }
    }
};
struct EpiSilu {
    static constexpr bool PERM = true;
    f16* O;
    __device__ __forceinline__ void operator()(const f32x4 (&acc)[2][2][4][2], const Unit& u, int wr, int wc, int fr, int fq) const {
        const int row0 = u.pm * BM + wr * 64 + fr, col0 = (u.pn & 1) * 128 + wc * 32 + 8 * fq;
#pragma unroll
        for (int ai = 0; ai < 2; ++ai)
#pragma unroll
            for (int m = 0; m < 4; ++m) { f16* rowp = O + (size_t)(row0 + ai * HALF + m * 16) * EFF + col0;
                float h[8];
#pragma unroll
                for (int n = 0; n < 2; ++n)
#pragma unroll
                    for (int e = 0; e < 4; ++e) { const float gt = acc[ai][0][m][n][e], up = acc[ai][1][m][n][e]; h[n * 4 + e] = gt / (1.f + __expf(-gt)) * up; }
                u32x4 w; w.x = pkh(h[0], h[1]); w.y = pkh(h[2], h[3]); w.z = pkh(h[4], h[5]); w.w = pkh(h[6], h[7]);
                *(u32x4*)rowp = w; }
    }
};
struct EpiDown {
    static constexpr bool PERM = true;
    unsigned char* ws;
    __device__ __forceinline__ void operator()(const f32x4 (&acc)[2][2][4][2], const Unit& u, int wr, int wc, int fr, int fq) const {
        f16* tile = (f16*)(ws + (u.pm < 128 ? WS_Y0 + (size_t)u.pm * MiB : WS_Y1 + (size_t)(u.pm - 128) * MiB));
        const int r0 = wr * 64 + fr, col0 = (u.pn & 7) * BM + wc * 32 + 8 * fq;
#pragma unroll
        for (int ai = 0; ai < 2; ++ai)
#pragma unroll
            for (int m = 0; m < 4; ++m) { f16* rowp = tile + (size_t)(r0 + ai * HALF + m * 16) * D + col0;
#pragma unroll
                for (int bj = 0; bj < 2; ++bj) { const f32x4 v0 = acc[ai][bj][m][0], v1 = acc[ai][bj][m][1];
                    u32x4 w; w.x = pkh(v0[0], v0[1]); w.y = pkh(v0[2], v0[3]); w.z = pkh(v1[0], v1[1]); w.w = pkh(v1[2], v1[3]);
                    *(u32x4*)(rowp + bj * HALF) = w; } }
    }
};

template <class Epi, class Sched, bool ALIGN_EPI, bool GATHER = false>
__device__ __forceinline__ void gemm_phase(LAS unsigned char* lds, const Gemm g, const Sched& S, const Epi& E) {
    const int tid = opaque_tid(), wid = __builtin_amdgcn_readfirstlane(tid >> 6), lane = tid & 63, wr = wid >> 2, wc = wid & 3, fr = lane & 15, fq = lane >> 4;
    const int K = g.K, nt = K / BK;
    int RA[2], CA[2]; unsigned voffA[2], voffB[2];
#pragma unroll
    for (int i = 0; i < 2; ++i) { int R, C; stage_rc(tid * 16 + i * 8192, R, C); const int Rb = Epi::PERM ? ((R & ~31) + perm32(R & 31)) : R;
        RA[i] = R; CA[i] = C; voffA[i] = (unsigned)(R * g.lda + C) * 2u; voffB[i] = (unsigned)(Rb * g.ldb + C) * 2u; }
    const size_t kstep = (size_t)(BK * 2);
    const size_t hstepA = (size_t)HALF * g.lda * 2, tstepA = 2 * hstepA;
    const size_t hstepB = (size_t)HALF * g.ldb * 2, tstepB = 2 * hstepB;
    const unsigned ldsw = (unsigned)wid * 1024u;
    const int aoff = lds_byte(wr * 64 + fr, fq * 8), boff = lds_byte(wc * 32 + fr, fq * 8);
    const char* Ab = (const char*)g.A;
#define PG8_SA(b, h) (((b) * 2 + (h)) * HTB)
#define PG8_SB(b, h) ((4 + (b) * 2 + (h)) * HTB)
#define PG8_STAGE(bufoff, gbase, voff) do { _Pragma("unroll") for (int _i = 0; _i < 2; ++_i) \
        __builtin_amdgcn_global_load_lds((const unsigned*)((const char*)(gbase) + (voff)[_i]), (LAS unsigned*)(lds + (bufoff) + ldsw + _i * 8192), 16, 0, 0); } while (0)
#define PG8_STA_CUR(bufoff, h, kb) do { if constexpr (GATHER) { PG8_STAGE(bufoff, Ab + (kb), offC[h]); } else { PG8_STAGE(bufoff, cA + (h) * hstepA + (kb), voffA); } } while (0)
#define PG8_STA_SEL(bufoff, h, kb) do { if constexpr (GATHER) { PG8_STAGE(bufoff, Ab + (kb), o2[h]); } else { PG8_STAGE(bufoff, a2p + (h) * hstepA + (kb), voffA); } } while (0)
#define PG8_LDA(dst, b, h) do { _Pragma("unroll") for (int m = 0; m < 4; ++m) _Pragma("unroll") for (int k = 0; k < 2; ++k) dst[m][k] = *(const LAS f16x8*)(lds + PG8_SA(b, h) + aoff + m * 2048 + k * 1024); } while (0)
#define PG8_LDB(dst, b, h) do { _Pragma("unroll") for (int n = 0; n < 2; ++n) _Pragma("unroll") for (int k = 0; k < 2; ++k) dst[n][k] = *(const LAS f16x8*)(lds + PG8_SB(b, h) + boff + n * 2048 + k * 1024); } while (0)
#define PG8_MMA(ai, bj, At, Bt) do { __builtin_amdgcn_s_setprio(1); _Pragma("unroll") for (int m = 0; m < 4; ++m) _Pragma("unroll") for (int n = 0; n < 2; ++n) _Pragma("unroll") for (int k = 0; k < 2; ++k) \
        acc[ai][bj][m][n] = __builtin_amdgcn_mfma_f32_16x16x32_f16(Bt[n][k], At[m][k], acc[ai][bj][m][n], 0, 0, 0); __builtin_amdgcn_s_setprio(0); } while (0)
#define PG8_WAIT_V(n) asm volatile("s_waitcnt vmcnt(" #n ")" ::: "memory")
#define PG8_WAIT_L(n) asm volatile("s_waitcnt lgkmcnt(" #n ")" ::: "memory")
#define PG8_BAR __builtin_amdgcn_s_barrier()
#define PG8_SCHED __builtin_amdgcn_sched_barrier(0)
#define PG8_OFFS(dst, U) do { _Pragma("unroll") for (int _h = 0; _h < 2; ++_h) _Pragma("unroll") for (int _i = 0; _i < 2; ++_i) { \
        const int _r = (U).pm * BM + _h * HALF + RA[_i]; dst[_h][_i] = ((unsigned)g.gather[_r] * (unsigned)g.lda + (unsigned)CA[_i]) * 2u; } } while (0)
    Unit cur, nxt; int ui = 0;
    if (!S.next(0, cur)) return;
    f32x4 acc[2][2][4][2];
#pragma unroll
    for (int a = 0; a < 2; ++a)
#pragma unroll
        for (int b = 0; b < 2; ++b)
#pragma unroll
            for (int m = 0; m < 4; ++m)
#pragma unroll
                for (int n = 0; n < 2; ++n) acc[a][b][m][n] = (f32x4){0.f, 0.f, 0.f, 0.f};
    f16x8 At[4][2], B0[2][2], B1[2][2];
    unsigned offC[2][2], offN[2][2];
    if constexpr (GATHER) { PG8_OFFS(offC, cur); }
    const char* cA = Ab + (size_t)cur.pm * tstepA;
    const char* cB = (const char*)g.Bt + (size_t)cur.pn * tstepB;
    PG8_STAGE(PG8_SB(0, 0), cB, voffB); PG8_STAGE(PG8_SB(0, 1), cB + hstepB, voffB); PG8_STA_CUR(PG8_SA(0, 0), 0, 0); PG8_STA_CUR(PG8_SA(0, 1), 1, 0);
    if (wr == 1) PG8_BAR;
    PG8_WAIT_V(2); PG8_BAR;
    PG8_STAGE(PG8_SB(1, 0), cB + kstep, voffB); PG8_STA_CUR(PG8_SA(1, 0), 0, kstep); PG8_STAGE(PG8_SB(1, 1), cB + hstepB + kstep, voffB);
    PG8_WAIT_V(6); PG8_BAR;
    for (;;) {
        const bool has_next = S.next(ui + 1, nxt);
        if constexpr (GATHER) {
            if (has_next) { PG8_OFFS(offN, nxt); } else {
#pragma unroll
                for (int _h = 0; _h < 2; ++_h)
#pragma unroll
                    for (int _i = 0; _i < 2; ++_i) offN[_h][_i] = offC[_h][_i]; } }
        const char* nA = has_next ? Ab + (size_t)nxt.pm * tstepA : cA;
        const char* nB = has_next ? (const char*)g.Bt + (size_t)nxt.pn * tstepB : cB;
#pragma nounroll
        for (int t = 0; t < nt; t += 2) {
            const bool last = (t == nt - 2);
            const size_t kb1 = (size_t)(t + 1) * kstep;
            const size_t kb2 = last ? 0 : (size_t)(t + 2) * kstep, kb3 = kb2 + kstep;
            unsigned o2[2][2];
            if constexpr (GATHER) {
#pragma unroll
                for (int _h = 0; _h < 2; ++_h)
#pragma unroll
                    for (int _i = 0; _i < 2; ++_i) o2[_h][_i] = last ? offN[_h][_i] : offC[_h][_i]; }
            const char* a2p = last ? nA : cA;
            const char* b2 = last ? nB : cB + (size_t)(t + 2) * kstep; const char* b3 = b2 + kstep;
            PG8_LDB(B0, 0, 0); PG8_LDB(B1, 0, 1); PG8_SCHED; PG8_LDA(At, 0, 0); PG8_STA_CUR(PG8_SA(1, 1), 1, kb1);
            PG8_WAIT_V(8); PG8_WAIT_L(0); PG8_BAR; PG8_MMA(0, 0, At, B0); PG8_MMA(0, 1, At, B1); PG8_BAR; PG8_SCHED;
            PG8_LDA(At, 0, 1); PG8_STAGE(PG8_SB(0, 0), b2, voffB); PG8_STAGE(PG8_SB(0, 1), b2 + hstepB, voffB); PG8_STA_SEL(PG8_SA(0, 0), 0, kb2);
            PG8_WAIT_V(8); PG8_WAIT_L(0); PG8_BAR; PG8_MMA(1, 0, At, B0); PG8_MMA(1, 1, At, B1); PG8_BAR; PG8_SCHED;
            PG8_LDB(B0, 1, 0); PG8_LDB(B1, 1, 1); PG8_SCHED; PG8_LDA(At, 1, 0); PG8_STA_SEL(PG8_SA(0, 1), 1, kb2);
            PG8_WAIT_V(8); PG8_WAIT_L(0); PG8_BAR; PG8_MMA(0, 0, At, B0); PG8_MMA(0, 1, At, B1); PG8_BAR; PG8_SCHED;
            PG8_LDA(At, 1, 1); PG8_STAGE(PG8_SB(1, 0), b3, voffB); PG8_STAGE(PG8_SB(1, 1), b3 + hstepB, voffB); PG8_STA_SEL(PG8_SA(1, 0), 0, kb3);
            PG8_WAIT_V(8); PG8_WAIT_L(0); PG8_BAR; PG8_MMA(1, 0, At, B0); PG8_MMA(1, 1, At, B1); PG8_BAR; PG8_SCHED;
        }
        if constexpr (ALIGN_EPI) { if (wr == 0) PG8_BAR; }
        E(acc, cur, wr, wc, fr, fq);
        if (!has_next) break;
#pragma unroll
        for (int a = 0; a < 2; ++a)
#pragma unroll
            for (int b = 0; b < 2; ++b)
#pragma unroll
                for (int m = 0; m < 4; ++m)
#pragma unroll
                    for (int n = 0; n < 2; ++n) acc[a][b][m][n] = (f32x4){0.f, 0.f, 0.f, 0.f};
        cur = nxt; cA = nA; cB = nB; ++ui;
        if constexpr (GATHER) {
#pragma unroll
            for (int _h = 0; _h < 2; ++_h)
#pragma unroll
                for (int _i = 0; _i < 2; ++_i) offC[_h][_i] = offN[_h][_i]; }
        if constexpr (ALIGN_EPI) { if (wr == 1) PG8_BAR; }
    }
    PG8_WAIT_V(0);
    if constexpr (!ALIGN_EPI) { if (wr == 0) PG8_BAR; }
    PG8_BAR;
#undef PG8_SA
#undef PG8_SB
#undef PG8_STAGE
#undef PG8_STA_CUR
#undef PG8_STA_SEL
#undef PG8_LDA
#undef PG8_LDB
#undef PG8_MMA
#undef PG8_WAIT_V
#undef PG8_WAIT_L
#undef PG8_BAR
#undef PG8_SCHED
#undef PG8_OFFS
}
}

#define XB_TMO      128
#define XB_XCNT(j)  (256  + 64 * (j))
#define XB_XSUB(j)  (1280 + 64 * (j))
#define XB_XGEN(j)  (2304 + 64 * (j))
#define XB_TOP      3328
#define XB_TOPGEN   3392
#define XCD_BAR_WORDS 3456
#define XB_SPIN_CAP (1u << 22)
__device__ __forceinline__ unsigned xb_ld(unsigned* p)              { return __hip_atomic_load(p, __ATOMIC_RELAXED, __HIP_MEMORY_SCOPE_AGENT); }
__device__ __forceinline__ unsigned xb_add(unsigned* p, unsigned v) { return __hip_atomic_fetch_add(p, v, __ATOMIC_RELAXED, __HIP_MEMORY_SCOPE_AGENT); }
__device__ __forceinline__ unsigned xb_xcc_id() { return (unsigned)__builtin_amdgcn_s_getreg((3 << 11) | 20) & 0xFu; }
#define XB_SPIN(cond, bar) do { unsigned _sp = 0; while (cond) { __builtin_amdgcn_s_sleep(1); \
    if ((++_sp & 255u) == 0u) { if (xb_ld(&(bar)[XB_TMO])) break; if (_sp > XB_SPIN_CAP) { atomicAdd(&(bar)[XB_TMO], 1u); break; } } } } while (0)
struct XcdBarrier { unsigned* bar; unsigned x; volatile LAS unsigned* st; };
__device__ __forceinline__ XcdBarrier xcd_barrier_post(unsigned* bar, volatile LAS unsigned* st) {
    XcdBarrier b; b.bar = bar; b.x = xb_xcc_id(); b.st = st;
    if (threadIdx.x == 0) (void)xb_add(&bar[XB_XCNT(b.x)], 1u);
    return b;
}
__device__ __forceinline__ void xcd_barrier_complete(unsigned* bar, unsigned x, unsigned& nloc, unsigned& nx) {
    const unsigned G = gridDim.x * gridDim.y * gridDim.z;
    unsigned sum, cnt, mine, sp = 0u;
    for (;;) {
        sum = 0u; cnt = 0u; mine = 0u;
#pragma unroll
        for (unsigned j = 0; j < 16; ++j) { const unsigned c = xb_ld(&bar[XB_XCNT(j)]); sum += c; cnt += (c > 0u) ? 1u : 0u; mine = (j == x) ? c : mine; }
        if (sum == G) break;
        __builtin_amdgcn_s_sleep(1);
        if ((++sp & 255u) == 0u) { if (xb_ld(&bar[XB_TMO])) break; if (sp > XB_SPIN_CAP) { atomicAdd(&bar[XB_TMO], 1u); break; } }
    }
    nloc = mine > 0u ? mine : 1u; nx = cnt > 0u ? cnt : 1u;
}
__device__ __forceinline__ void xcd_barrier(const XcdBarrier& b) {
    asm volatile("s_waitcnt vmcnt(0)" ::: "memory");
    __syncthreads();
    if (threadIdx.x == 0) {
        unsigned* bar = b.bar;
        __builtin_amdgcn_s_waitcnt(0);
        unsigned nloc = b.st[0], nx = b.st[1];
        if (nloc == 0u) { xcd_barrier_complete(bar, b.x, nloc, nx); b.st[0] = nloc; b.st[1] = nx; }
        const unsigned old = xb_add(&bar[XB_XSUB(b.x)], 1u);
        const unsigned gen = old / nloc;
        if (old + 1u == (gen + 1u) * nloc) {
            __builtin_amdgcn_fence(__ATOMIC_RELEASE, "agent");
            asm volatile("s_waitcnt vmcnt(0)" ::: "memory");
            const unsigned og = xb_add(&bar[XB_TOP], 1u);
            const unsigned tg = og / nx;
            if (og + 1u == (tg + 1u) * nx) xb_add(&bar[XB_TOPGEN], 1u);
            else XB_SPIN(xb_ld(&bar[XB_TOPGEN]) == tg, bar);
            __builtin_amdgcn_fence(__ATOMIC_ACQUIRE, "agent");
            xb_add(&bar[XB_XGEN(b.x)], 1u);
            asm volatile("s_waitcnt vmcnt(0)" ::: "memory");
        } else {
            XB_SPIN(xb_ld(&bar[XB_XGEN(b.x)]) == gen, bar);
            __builtin_amdgcn_fence(__ATOMIC_ACQUIRE, "agent");
            asm volatile("s_waitcnt vmcnt(0)" ::: "memory");
        }
    }
    __syncthreads();
}

struct Args { const float* in[38]; float* out; unsigned char* ws; int ph_lo, ph_hi; };
enum { I_X = 0, I_MEM, I_LN1, I_WIN, I_PK, I_W1K, I_W2K, I_PV, I_W1V, I_W2V, I_NSAG, I_MU, I_W0, I_WUP, I_A0, I_AUP, I_GUP, I_KK, I_KA, I_RK, I_LNXG, I_LNXB,
       I_WOUT, I_LNMEM, I_LN2, I_WQ, I_WK, I_WV, I_WO, I_LN3, I_RGW, I_RGB, I_REW, I_REB, I_MG, I_MU2, I_MD, I_LNF };

struct TrItem { float tv[32]; f16* dst; size_t drow0; int dld, k0; };
__device__ __forceinline__ void tr_load(TrItem& it, const float* src, int sld, int k0, int scol0, int nvalid, f16* dst, size_t drow0, int dld, int lane) {
    const int nl = lane & 31; it.dst = dst; it.drow0 = drow0; it.dld = dld; it.k0 = k0;
#pragma unroll
    for (int i = 0; i < 32; ++i) { const int kk = 2 * i + (lane >> 5); it.tv[i] = (nl < nvalid) ? src[(size_t)(k0 + kk) * sld + scol0 + nl] : 0.f; }
}
__device__ __forceinline__ void tr_finish(const TrItem& it, LAS float* scr, int lane) {
    const int nl = lane & 31;
#pragma unroll
    for (int i = 0; i < 32; ++i) { const int kk = 2 * i + (lane >> 5); scr[kk * 33 + nl] = it.tv[i]; }
    LDS_WAIT(); asm volatile("" ::: "memory");
    const int c = lane & 7;
#pragma unroll
    for (int j = 0; j < 4; ++j) { const int n = (lane >> 3) + 8 * j; const LAS float* s = scr + (8 * c) * 33 + n;
        u32x4 o; o.x = pkh(s[0 * 33], s[1 * 33]); o.y = pkh(s[2 * 33], s[3 * 33]); o.z = pkh(s[4 * 33], s[5 * 33]); o.w = pkh(s[6 * 33], s[7 * 33]);
        *(u32x4*)(it.dst + (it.drow0 + n) * (size_t)it.dld + it.k0 + 8 * c) = o; }
    LDS_WAIT(); asm volatile("" ::: "memory");
}
__device__ __forceinline__ void tr_item(const float* src, int sld, int k0, int scol0, int nvalid, f16* dst, size_t drow0, int dld, LAS float* scr, int lane) {
    TrItem it; tr_load(it, src, sld, k0, scol0, nvalid, dst, drow0, dld, lane); tr_finish(it, scr, lane);
}
__device__ __forceinline__ void tr_matrix(const float* src, int K, int N, f16* dst, LAS float* scr, int gw, int NGW, int lane) {
    const int nblk = N / 32, items = (K / 64) * nblk;
    for (int it = gw; it < items; it += 2 * NGW) { TrItem a, b; const int it2 = it + NGW; const bool two = it2 < items;
        tr_load(a, src, N, (it / nblk) * 64, (it % nblk) * 32, 32, dst, (size_t)(it % nblk) * 32, K, lane);
        if (two) tr_load(b, src, N, (it2 / nblk) * 64, (it2 % nblk) * 32, 32, dst, (size_t)(it2 % nblk) * 32, K, lane);
        tr_finish(a, scr, lane); if (two) tr_finish(b, scr, lane); }
}
__device__ __forceinline__ void rms_row2(const float* xrow0, const float* xrow1, const float* gain, f16* o0, f16* o1, bool two, int lane) {
    const f32x4* xa = (const f32x4*)xrow0 + lane; const f32x4* xb = (const f32x4*)xrow1 + lane; f32x4 v[2][8], gg[8];
#pragma unroll
    for (int j = 0; j < 8; ++j) { v[0][j] = xa[64 * j]; v[1][j] = xb[64 * j]; }
    const f32x4* gr = (const f32x4*)gain + lane;
#pragma unroll
    for (int j = 0; j < 8; ++j) gg[j] = gr[64 * j];
#pragma unroll
    for (int q = 0; q < 2; ++q) { float s = 0.f;
#pragma unroll
        for (int j = 0; j < 8; ++j) s += v[q][j].x * v[q][j].x + v[q][j].y * v[q][j].y + v[q][j].z * v[q][j].z + v[q][j].w * v[q][j].w;
        const float rstd = rsqrtf(wave_sum(s) * (1.f / D) + EPS);
        if (q == 0 || two) { u32x2* o8 = (u32x2*)(q ? o1 : o0) + lane;
#pragma unroll
            for (int j = 0; j < 8; ++j) { u32x2 w; w.x = pkh(v[q][j].x * rstd * gg[j].x, v[q][j].y * rstd * gg[j].y); w.y = pkh(v[q][j].z * rstd * gg[j].z, v[q][j].w * rstd * gg[j].w); o8[64 * j] = w; } } }
}
__device__ __forceinline__ void p0_prologue(const Args& a, LAS unsigned char* lds) {
    const int tid = opaque_tid(), lane = tid & 63, wave = tid >> 6;
    const int gw = blockIdx.x * 8 + wave, NGW = gridDim.x * 8;
    LAS float* scr = (LAS float*)(lds + wave * 16384);
    unsigned char* ws = a.ws;
    { f16* dst = (f16*)(ws + WS_WIN); const float* src = a.in[I_WIN];
      const int nblk = NZ / 32, items = (D / 64) * nblk;
      for (int it0 = gw; it0 < items; it0 += 2 * NGW) { TrItem ta, tb; const bool two = it0 + NGW < items;
#pragma unroll
          for (int q = 0; q < 2; ++q) { if (q == 1 && !two) break; const int it = it0 + q * NGW; const int kb = it / nblk, nb = it % nblk, n0 = nb * 32;
              int sc = 0, nv = 32; if (n0 < 2560) sc = n0; else if (n0 < 5920) sc = n0 + 24; else if (n0 == 5920) { sc = 2560; nv = 24; } else { sc = 0; nv = 0; }
              tr_load(q ? tb : ta, src, 5944, kb * 64, sc, nv, dst, (size_t)n0, D, lane); }
          tr_finish(ta, scr, lane); if (two) tr_finish(tb, scr, lane); } }
    tr_matrix(a.in[I_WOUT], D, D, (f16*)(ws + WS_WOUT), scr, gw, NGW, lane);
    tr_matrix(a.in[I_WK], D, D, (f16*)(ws + WS_WKT), scr, gw, NGW, lane);
    tr_matrix(a.in[I_WV], D, D, (f16*)(ws + WS_WVT), scr, gw, NGW, lane);
    tr_matrix(a.in[I_WO], D, D, (f16*)(ws + WS_WOT), scr, gw, NGW, lane);
    { const f32x4* s = (const f32x4*)a.in[I_WQ]; u32x2* d = (u32x2*)(ws + WS_WQ16);
      for (size_t i = (size_t)blockIdx.x * 512 + tid; i < (size_t)D * D / 4; i += (size_t)gridDim.x * 512) { const f32x4 v = s[i]; const float gsc = a.in[I_LN2][i / (D / 4)]; u32x2 w; w.x = pkh(v.x * gsc, v.y * gsc); w.y = pkh(v.z * gsc, v.w * gsc); d[i] = w; } }
    tr_matrix(a.in[I_W1K], 4096, 128, (f16*)(ws + WS_W1T), scr, gw, NGW, lane);
    tr_matrix(a.in[I_W1V], 4096, 128, (f16*)(ws + WS_W1T) + 128 * 4096, scr, gw, NGW, lane);
    tr_matrix(a.in[I_W2K], 128, 128, (f16*)(ws + WS_W2T), scr, gw, NGW, lane);
    tr_matrix(a.in[I_W2V], 128, 128, (f16*)(ws + WS_W2T) + 128 * 128, scr, gw, NGW, lane);
    for (int o = gw; o < 256; o += NGW) { const int kv = o >> 7, n = o & 127; const float* pos = a.in[kv ? I_PV : I_PK]; const float* w1 = a.in[kv ? I_W1V : I_W1K]; float acc = 0.f;
        for (int k = lane; k < 4096; k += 64) acc += pos[k] * w1[(size_t)k * 128 + n];
        acc = wave_sum(acc); if (lane == 0) ((float*)(ws + WS_CBIAS))[o] = acc; }
    for (int i = blockIdx.x * 512 + tid; i < 48 * D; i += gridDim.x * 512) { const int c = i / D, k = i % D; float v = 0.f;
        if (c < 4) v = a.in[I_RGW][k * 4 + c]; else if (c < 36) v = a.in[I_REW][k * 32 + (c - 4)];
        v *= a.in[I_LN3][k]; const f16 hi = (f16)v; ((f16*)(ws + WS_WRH))[i] = hi; ((f16*)(ws + WS_WRL))[i] = (f16)(v - (float)hi); }
    { bf16* wu = (bf16*)(ws + WS_WUPT); bf16* au = (bf16*)(ws + WS_AUPT); bf16* gu = (bf16*)(ws + WS_GUPT);
      for (int i = blockIdx.x * 512 + tid; i < 1024 * 64; i += gridDim.x * 512) { const int ch = i >> 6, j = i & 63; wu[i] = (bf16)a.in[I_WUP][j * 1024 + ch]; au[i] = (bf16)a.in[I_AUP][j * 1024 + ch]; }
      for (int i = blockIdx.x * 512 + tid; i < 1024 * 160; i += gridDim.x * 512) { const int ch = i / 160, j = i % 160; gu[i] = (bf16)a.in[I_GUP][j * 1024 + ch]; } }
    for (int m = gw; m < T; m += 2 * NGW) { const bool two = m + NGW < T; const int m1 = two ? m + NGW : m;
        rms_row2(a.in[I_X] + (size_t)m * D, a.in[I_X] + (size_t)m1 * D, a.in[I_LN1], (f16*)(ws + WS_H) + (size_t)m * D, (f16*)(ws + WS_H) + (size_t)m1 * D, two, lane); }
    for (int m = gw; m < 256; m += NGW) rms_row2(a.in[I_MEM] + (size_t)m * D, a.in[I_MEM] + (size_t)m * D, a.in[I_LNMEM], (f16*)(ws + WS_MEMN) + (size_t)m * D, (f16*)(ws + WS_MEMN) + (size_t)m * D, false, lane);
}

__device__ __forceinline__ void p_moe_weights(const Args& a, LAS unsigned char* lds) {
    const int tid = opaque_tid(), lane = tid & 63, wave = tid >> 6;
    const int gw = blockIdx.x * 8 + wave, NGW = gridDim.x * 8;
    LAS float* scr = (LAS float*)(lds + wave * 16384);
    unsigned char* ws = a.ws;
    { f16* dst = (f16*)(ws + WS_WGU); const int items = NEXP * (D / 64) * 16;
      for (int it = gw; it < items; it += NGW) { const int e = it / ((D / 64) * 16), r = it % ((D / 64) * 16), kb = r / 16, nb = r % 16, j0 = nb * 32, jt = j0 / 256, jj = j0 % 256;
          const float* src = (jj < 128 ? a.in[I_MG] : a.in[I_MU2]) + (size_t)e * D * EFF; const int sc = jt * 128 + (jj & 127);
          tr_item(src, EFF, kb * 64, sc, 32, dst, (size_t)e * 512 + j0, D, scr, lane); } }
    { f16* dst = (f16*)(ws + WS_WD); const int items = NEXP * (EFF / 64) * (D / 32);
      for (int it = gw; it < items; it += NGW) { const int e = it / ((EFF / 64) * (D / 32)), r = it % ((EFF / 64) * (D / 32)), kb = r / (D / 32), nb = r % (D / 32);
          tr_item(a.in[I_MD] + (size_t)e * EFF * D, D, kb * 64, nb * 32, 32, dst, (size_t)e * D + nb * 32, EFF, scr, lane); } }
}

__device__ __forceinline__ float gelu_tanh(float x) { const float u = 0.7978845608028654f * (x + 0.044715f * x * x * x); const float e = __expf(2.f * u); return 0.5f * x * (2.f - 2.f / (e + 1.f)); }
constexpr int CP_RS = 272, CP_HS = 136, CP_HID = 272 * CP_RS;
__device__ __forceinline__ void p_compress(const Args& a, LAS unsigned char* lds) {
    const int tid = opaque_tid(), lane = tid & 63, w = __builtin_amdgcn_readfirstlane(tid >> 6);
    const f16* z = (const f16*)(a.ws + WS_Z);
    LAS f16* HID = (LAS f16*)(lds + CP_HID);
    for (int it = blockIdx.x; it < 256; it += gridDim.x) {
        const int kv = it >> 7, g = (it >> 6) & 1, c0 = (it & 63) * 16, tok0 = 16 * c0;
        const int zc = (kv ? ZVC : ZKC) + g * 128;
        __syncthreads();
        for (int ck = tid; ck < 272 * 16; ck += 512) { const int tl = ck >> 4, c16 = ck & 15, tok = tok0 + tl; const int rp = (tl & 15) * 17 + (tl >> 4);
            u32x4 v = {0u, 0u, 0u, 0u}; if (tok < T) v = *(const u32x4*)(z + (size_t)tok * NZ + zc + c16 * 8);
            *(LAS u32x4*)(lds + rp * CP_RS + c16 * 16) = v; }
        __syncthreads();
        f32x4 acc = {0.f, 0.f, 0.f, 0.f};
        const f16* wp = (const f16*)(a.ws + WS_W1T) + ((size_t)kv * 128 + 16 * w + (lane & 15)) * 4096 + 8 * (lane >> 4);
        const LAS unsigned char* ap = lds + (lane & 15) * CP_RS + 16 * (lane >> 4);
#pragma unroll 8
        for (int ks = 0; ks < 128; ++ks) { const int l = ks >> 2;
            const f16x8 av = *(const LAS f16x8*)(ap + ((l & 15) * 17 + (l >> 4)) * CP_RS + (ks & 3) * 64);
            const f16x8 bv = *(const f16x8*)(wp + 32 * ks);
            acc = __builtin_amdgcn_mfma_f32_16x16x32_f16(av, bv, acc, 0, 0, 0); }
        { const int n = 16 * w + (lane & 15); const float bs = ((const float*)(a.ws + WS_CBIAS))[kv * 128 + n];
#pragma unroll
          for (int r = 0; r < 4; ++r) HID[(4 * (lane >> 4) + r) * CP_HS + n] = (f16)gelu_tanh(acc[r] + bs); }
        __syncthreads();
        f32x4 o = {0.f, 0.f, 0.f, 0.f};
        const f16* w2p = (const f16*)(a.ws + WS_W2T) + ((size_t)kv * 128 + 16 * w + (lane & 15)) * 128 + 8 * (lane >> 4);
#pragma unroll
        for (int ks = 0; ks < 4; ++ks) { const f16x8 av = *(const LAS f16x8*)(HID + (lane & 15) * CP_HS + 32 * ks + 8 * (lane >> 4)); const f16x8 bv = *(const f16x8*)(w2p + 32 * ks);
            o = __builtin_amdgcn_mfma_f32_16x16x32_f16(av, bv, o, 0, 0, 0); }
        f16* dst = (f16*)(a.ws + (kv ? WS_VCMP : WS_KCMP));
#pragma unroll
        for (int r = 0; r < 4; ++r) { const int c = c0 + 4 * (lane >> 4) + r; dst[((size_t)c * 2 + g) * 128 + 16 * w + (lane & 15)] = c < NCMP ? (f16)o[r] : (f16)0.f; }
    }
}

typedef float f32x16 __attribute__((ext_vector_type(16)));
typedef short v4i16_t __attribute__((ext_vector_type(4)));
constexpr int NS_PSEL = 65536, NS_PSTR = 257, NS_SELB = NS_PSEL + 64 * NS_PSTR * 4, NS_WANY = NS_SELB + 2048, NS_LIST = NS_WANY + 256, NS_CNT = NS_LIST + 512, NS_UNIT = NS_CNT + 64;
static_assert(NS_UNIT + 64 <= MISC_OFF, "nsa lds");
__device__ __forceinline__ unsigned offb(unsigned row, unsigned ch) { return 256u * row + 16u * (ch ^ (((row & 3u) << 2) | ((row >> 2) & 3u))); }
__device__ __forceinline__ void glds16(const void* gsrc, unsigned lds_dst) { unsigned keep;
    asm volatile("s_mov_b32 %0, m0\n\ts_mov_b32 m0, %2\n\ts_nop 0\n\tglobal_load_lds_dwordx4 %1, off\n\ts_mov_b32 m0, %0" : "=&s"(keep) : "v"(gsrc), "s"(lds_dst) : "memory"); }
__device__ __forceinline__ void ns_dma(const f16* g0, const unsigned (&doff)[2], unsigned lds_addr, int wv) {
#pragma unroll
    for (int i = 0; i < 2; ++i) glds16(g0 + doff[i], lds_addr + (wv * 2 + i) * 1024);
}
#define NS_VMW(n) asm volatile("s_waitcnt vmcnt(" #n ")" ::: "memory")
__device__ __forceinline__ void ns_qk(f32x16& s0, f32x16& s1, const LAS unsigned char* kb, const f16x8 (&qf)[8], int rho_, int hh_, float init) {
    unsigned rho = (unsigned)rho_, hh = (unsigned)hh_;
    asm volatile("" : "+v"(rho), "+v"(hh));
    const unsigned xr = ((rho & 3u) << 2) | ((rho >> 2) & 3u);
    const LAS unsigned char* kbase = kb + 256u * rho + 16u * ((hh ^ xr) & 1u); const unsigned xs = xr >> 1;
#pragma unroll
    for (int i = 0; i < 16; ++i) { s0[i] = init; s1[i] = init; }
    f16x8 af[8];
#pragma unroll
    for (int s = 0; s < 8; ++s) af[s] = *(const LAS f16x8*)(kbase + 32u * ((unsigned)s ^ xs));
#pragma unroll
    for (int s = 0; s < 8; ++s) s0 = __builtin_amdgcn_mfma_f32_32x32x16_f16(af[s], qf[s], s0, 0, 0, 0);
#pragma unroll
    for (int s = 0; s < 8; ++s) af[s] = *(const LAS f16x8*)(kbase + 32u * ((unsigned)s ^ xs) + 8192);
#pragma unroll
    for (int s = 0; s < 8; ++s) s1 = __builtin_amdgcn_mfma_f32_32x32x16_f16(af[s], qf[s], s1, 0, 0, 0);
}
__device__ __forceinline__ void ns_pv(f32x16 (&O)[4], const LAS unsigned char* vb, const f32x16& p0, const f32x16& p1, int lane_) {
    unsigned lane = (unsigned)lane_;
    asm volatile("" : "+v"(lane));
    const unsigned hh = lane >> 5, blk = (lane >> 4) & 1, q = (lane & 15) >> 2, pp = lane & 3;
    const unsigned x = 2 * blk + (pp >> 1);
    const LAS unsigned char* vbase[2];
#pragma unroll
    for (int t = 0; t < 2; ++t) { const unsigned w = (hh + 2 * t) & 3u; vbase[t] = vb + 256u * (4 * hh + 8 * t + q) + 16u * (x ^ w) + 8u * (pp & 1); }
    f16x8 pf[4];
#pragma unroll
    for (int kh = 0; kh < 2; ++kh)
#pragma unroll
        for (int sp = 0; sp < 2; ++sp)
#pragma unroll
            for (int j = 0; j < 8; ++j) pf[kh * 2 + sp][j] = (f16)(kh ? p1[8 * sp + j] : p0[8 * sp + j]);
#pragma unroll
    for (int c = 0; c < 4; ++c) { const unsigned cq = 64u * ((unsigned)c ^ q);
        const LAS unsigned char* b0 = vbase[0] + cq; const LAS unsigned char* b1 = vbase[1] + cq;
#pragma unroll
        for (int kh = 0; kh < 2; ++kh)
#pragma unroll
            for (int sp = 0; sp < 2; ++sp) {
                const v4i16_t lo = __builtin_amdgcn_ds_read_tr16_b64_v4i16((LAS v4i16_t*)(b0 + 256 * (32 * kh + 16 * sp)));
                const v4i16_t hi = __builtin_amdgcn_ds_read_tr16_b64_v4i16((LAS v4i16_t*)(b1 + 256 * (32 * kh + 16 * sp)));
                typedef short s16x8 __attribute__((ext_vector_type(8)));
                const s16x8 v8 = {lo[0], lo[1], lo[2], lo[3], hi[0], hi[1], hi[2], hi[3]};
                O[c] = __builtin_amdgcn_mfma_f32_32x32x16_f16(__builtin_bit_cast(f16x8, v8), pf[kh * 2 + sp], O[c], 0, 0, 0); }
    }
}
#define NS_KIDX(r, hh) ((int)(((r) & 3) + 8 * ((r) >> 2) + 4 * (hh)))
constexpr float NS_THR = 6.f;
template <bool WITH_O> __device__ __forceinline__ void ns_online(f32x16& y0, f32x16& y1, float& m, float& l, bool& seen, f32x16 (&O)[4]) {
    float mx = fmaxf(y0[0], y1[0]);
#pragma unroll
    for (int i = 1; i < 16; ++i) mx = fmaxf(mx, fmaxf(y0[i], y1[i]));
    mx = fmaxf(mx, __shfl_xor(mx, 32));
    const bool fin = mx > -INFINITY, first = !seen && fin;
    if (__any(first || mx > NS_THR)) {
        const float d = first ? mx : (mx > NS_THR ? mx : 0.f), alpha = __builtin_amdgcn_exp2f(-d);
        seen = seen || fin; m += d; l *= alpha;
        if (WITH_O) {
#pragma unroll
            for (int c = 0; c < 4; ++c) O[c] = O[c] * alpha; }
#pragma unroll
        for (int i = 0; i < 16; ++i) { y0[i] -= d; y1[i] -= d; }
    }
    float ls = 0.f;
#pragma unroll
    for (int i = 0; i < 16; ++i) { y0[i] = __builtin_amdgcn_exp2f(y0[i]); y1[i] = __builtin_amdgcn_exp2f(y1[i]); ls += y0[i] + y1[i]; }
    l += ls;
}
#define NS_ISSUE(j, NSL, HASV) do { const unsigned sa_ = lds_a + (unsigned)(((j) & ((NSL) - 1)) * 32768); ns_dma(NS_KPTR(j), NS_DOFF, sa_, w); if (HASV) ns_dma(NS_VPTR(j), NS_DOFF, sa_ + 16384u, w); } while (0)
#define NS_WAIT(nb, HASV) do { if (HASV) { if ((nb) >= 2) NS_VMW(8); else if ((nb) == 1) NS_VMW(4); else NS_VMW(0); } else { if ((nb) >= 2) NS_VMW(4); else if ((nb) == 1) NS_VMW(2); else NS_VMW(0); } } while (0)
#define NS_PROLOGUE(n, NSL, HASV) do { const int q_ = (n) < (NSL) - 1 ? (n) : (NSL) - 1; for (int j_ = 0; j_ < q_; ++j_) NS_ISSUE(j_, NSL, HASV); NS_WAIT(q_ - 1, HASV); __syncthreads(); } while (0)
#define NS_STEP_BEGIN(i, n, NSL, HASV) do { if ((i) + (NSL) - 1 < (n)) NS_ISSUE((i) + (NSL) - 1, NSL, HASV); } while (0)
#define NS_STEP_END(i, n, NSL, HASV) do { int nb_ = ((n) - 1 < (i) + (NSL) - 1 ? (n) - 1 : (i) + (NSL) - 1) - ((i) + 1); NS_WAIT(nb_, HASV); __syncthreads(); } while (0)
#define NS_KB(i, NSL) (lds + (((i) & ((NSL) - 1)) * 32768))
#define NS_VB(i, NSL) (lds + (((i) & ((NSL) - 1)) * 32768) + 16384)
__device__ __forceinline__ void p_nsa(const Args& a, LAS unsigned char* lds, int rep) {
    const int tid = opaque_tid(), lane = tid & 63, w = __builtin_amdgcn_readfirstlane(tid >> 6), rho = lane & 31, hh = lane >> 5, ql = rho >> 2, p = rho & 3;
    const unsigned lds_a = (unsigned)__builtin_amdgcn_readfirstlane((int)(unsigned)(size_t)lds);
    const f16* z = (const f16*)(a.ws + WS_Z); const f16* kcmp = (const f16*)(a.ws + WS_KCMP); const f16* vcmp = (const f16*)(a.ws + WS_VCMP);
    float* onsa = (float*)(a.ws + WS_ONSA); unsigned* ctl = (unsigned*)(a.ws + WS_CTL);
    LAS float* psel = (LAS float*)(lds + NS_PSEL); LAS unsigned* selb = (LAS unsigned*)(lds + NS_SELB); LAS unsigned* wany = (LAS unsigned*)(lds + NS_WANY);
    LAS unsigned char* list = lds + NS_LIST; LAS int* cnt = (LAS int*)(lds + NS_CNT); LAS int* unit_s = (LAS int*)(lds + NS_UNIT);
    const float c2 = 0.08838834764831845f * 1.4426950408889634f;
    unsigned doff_c[2], doff_z[2];
#pragma unroll
    for (int i = 0; i < 2; ++i) { const int piece = w * 2 + i, row = 4 * piece + (lane >> 4), ch = (lane & 15) ^ (((row & 3) << 2) | ((row >> 2) & 3)); doff_c[i] = (unsigned)(row * 256 + ch * 8); doff_z[i] = (unsigned)(row * NZ + ch * 8); }
    for (;;) {
        __syncthreads();
        if (tid == 0) { const int g0 = (int)(xb_xcc_id() & 1u); int k = (int)atomicAdd(&ctl[CW_Q + rep * 4 + g0], 1u), gg = g0;
            if (k >= 256) { gg = g0 ^ 1; k = (int)atomicAdd(&ctl[CW_Q + rep * 4 + gg], 1u); }
            unit_s[0] = k; unit_s[1] = gg; }
        __syncthreads();
        const int uk = unit_s[0]; if (uk >= 256) break;
        const int blk = 255 - uk, g = unit_s[1], t0 = blk * 64, tq = t0 + 8 * w + ql, hq = g * 4 + p;
        f16x8 qf[8];
        { const f16* qrow = z + (size_t)tq * NZ + ZQ + hq * 128 + 8 * hh;
#pragma unroll
          for (int s = 0; s < 8; ++s) { const f16x8 q8 = *(const f16x8*)(qrow + 16 * s);
#pragma unroll
              for (int j = 0; j < 8; ++j) qf[s][j] = (f16)((float)q8[j] * c2); } }
        const f16* zrow = z + (size_t)tq * NZ;
        const float gate_c = sigmoidf_((float)zrow[ZGL + hq]), gate_s = sigmoidf_((float)zrow[ZGL + 8 + hq]), gate_w = sigmoidf_((float)zrow[ZGL + 16 + hq]);
        f32x16 O[4];
        float* orow = onsa + (size_t)tq * 1024 + hq * 128 + 4 * hh;
#pragma unroll
        for (int c = 0; c < 4; ++c)
#pragma unroll
            for (int i = 0; i < 16; ++i) O[c][i] = 0.f;
        const int cmax = tq >= 31 ? (tq - 31) >> 4 : -1;
        const int ntc = (4 * blk + 3 + 63) >> 6;
        float m = 0.f, l = 0.f; bool seen = false;
        const int cmin_w = (t0 + 8 * w) >= 31 ? (t0 + 8 * w - 31) >> 4 : -1;
#define NS_KPTR(j) (kcmp + ((size_t)(64 * (j)) * 2 + g) * 128)
#define NS_VPTR(j) (vcmp + ((size_t)(64 * (j)) * 2 + g) * 128)
#define NS_DOFF doff_c
        { const int npc = (ntc + 1) >> 1;
#define NS_ISSUE_KPAIR(ip) do { const unsigned sa_ = lds_a + (unsigned)(((ip) & 1) * 65536); const int j0_ = 2 * (ip); ns_dma(NS_KPTR(j0_), NS_DOFF, sa_, w); if (j0_ + 1 < ntc) ns_dma(NS_KPTR(j0_ + 1), NS_DOFF, sa_ + 32768u, w); } while (0)
          NS_ISSUE_KPAIR(0); NS_VMW(0); __syncthreads();
          for (int ip = 0; ip < npc; ++ip) {
              if (ip + 1 < npc) NS_ISSUE_KPAIR(ip + 1);
#pragma unroll
              for (int hb = 0; hb < 2; ++hb) { const int i = 2 * ip + hb;
                  if (i < ntc) {
                      f32x16 x0, x1; ns_qk(x0, x1, lds + (ip & 1) * 65536 + hb * 32768, qf, rho, hh, -m);
                      if (64 * i + 63 > cmin_w) {
#pragma unroll
                          for (int r = 0; r < 16; ++r) { const int c0 = 64 * i + NS_KIDX(r, hh); x0[r] = (c0 <= cmax) ? x0[r] : -INFINITY; x1[r] = (c0 + 32 <= cmax) ? x1[r] : -INFINITY; } }
                      ns_online<false>(x0, x1, m, l, seen, O); } }
              NS_VMW(0); __syncthreads();
          } }
        l += __shfl_xor(l, 32);
        const float invl = 1.f / fmaxf(l, 1e-30f);
        for (int i = lane; i < 8 * NS_PSTR; i += 64) psel[(8 * w) * NS_PSTR + i] = 0.f;
        NS_PROLOGUE(ntc, 2, true);
        for (int i = 0; i < ntc; ++i) {
            NS_STEP_BEGIN(i, ntc, 2, true);
            f32x16 x0, x1; ns_qk(x0, x1, NS_KB(i, 2), qf, rho, hh, -m);
#pragma unroll
            for (int r = 0; r < 16; ++r) { x0[r] = __builtin_amdgcn_exp2f(x0[r]) * invl; x1[r] = __builtin_amdgcn_exp2f(x1[r]) * invl; }
            if (64 * i + 63 > cmin_w) {
#pragma unroll
                for (int r = 0; r < 16; ++r) { const int c0 = 64 * i + NS_KIDX(r, hh); x0[r] = (c0 <= cmax) ? x0[r] : 0.f; x1[r] = (c0 + 32 <= cmax) ? x1[r] : 0.f; } }
#pragma unroll
            for (int kh = 0; kh < 2; ++kh)
#pragma unroll
                for (int r4 = 0; r4 < 4; ++r4) {
                    const float pa = kh ? x1[4 * r4] : x0[4 * r4], pb = kh ? x1[4 * r4 + 1] : x0[4 * r4 + 1], pc_ = kh ? x1[4 * r4 + 2] : x0[4 * r4 + 2], pd = kh ? x1[4 * r4 + 3] : x0[4 * r4 + 3];
                    float mainv = pa + pb + pc_ + 0.5f * pd, carry = 0.5f * pd;
                    mainv += __shfl_xor(mainv, 1); mainv += __shfl_xor(mainv, 2); carry += __shfl_xor(carry, 1); carry += __shfl_xor(carry, 2);
                    if (p == 0) { const int sb = 16 * i + 8 * kh + 2 * r4 + hh; float* pr = (float*)(psel + (8 * w + ql) * NS_PSTR + sb); __hip_atomic_fetch_add(pr, mainv, __ATOMIC_RELAXED, __HIP_MEMORY_SCOPE_WORKGROUP); __hip_atomic_fetch_add(pr + 1, carry, __ATOMIC_RELAXED, __HIP_MEMORY_SCOPE_WORKGROUP); }
                }
            ns_pv(O, NS_VB(i, 2), x0, x1, lane);
            NS_STEP_END(i, ntc, 2, true);
        }
#undef NS_KPTR
#undef NS_VPTR
#undef NS_DOFF
#pragma unroll
        for (int c = 0; c < 4; ++c) {
#pragma unroll
            for (int r4 = 0; r4 < 4; ++r4) *(f32x4*)(orow + 32 * c + 8 * r4) = (f32x4){O[c][4 * r4] * gate_c, O[c][4 * r4 + 1] * gate_c, O[c][4 * r4 + 2] * gate_c, O[c][4 * r4 + 3] * gate_c};
#pragma unroll
            for (int i = 0; i < 16; ++i) O[c][i] = 0.f; }
        {
            unsigned anyw = 0u;
            for (int qq = 0; qq < 8; ++qq) {
                const LAS float* pr = psel + (8 * w + qq) * NS_PSTR;
                unsigned myw = 0u;
                if (lane == 0) myw |= 1u;
                if (lane == (blk >> 5)) myw |= 1u << (blk & 31);
                if (blk >= 1 && lane == ((blk - 1) >> 5)) myw |= 1u << ((blk - 1) & 31);
                const int ncand = blk >= 3 ? blk - 2 : 0;
                if (ncand <= 13) { if (ncand > 0 && lane == 0) myw |= ((2u << (blk - 2)) - 1u) & ~1u; }
                else {
                    unsigned key[4];
#pragma unroll
                    for (int jj = 0; jj < 4; ++jj) { const int s = 1 + lane + 64 * jj; key[jj] = (s <= blk - 2) ? __float_as_uint(fmaxf(pr[s], 0.f)) + 1u : 0u; }
                    unsigned thr = 0u;
                    for (int bit = 31; bit >= 0; --bit) { const unsigned cand = thr | (1u << bit); int cn = 0;
#pragma unroll
                        for (int jj = 0; jj < 4; ++jj) cn += __popcll(__ballot(key[jj] >= cand));
                        if (cn >= 13) thr = cand; }
                    int cgt = 0;
#pragma unroll
                    for (int jj = 0; jj < 4; ++jj) cgt += __popcll(__ballot(key[jj] > thr));
                    int remaining = 13 - cgt;
                    unsigned long long M[4];
#pragma unroll
                    for (int jj = 0; jj < 4; ++jj) { const bool eq = key[jj] == thr; const unsigned long long em = __ballot(eq); const int c = __popcll(em);
                        const bool take_eq = eq && (__popcll(em & ((1ull << lane) - 1ull)) < remaining);
                        remaining = remaining > c ? remaining - c : 0;
                        M[jj] = __ballot(key[jj] > thr || take_eq); }
#pragma unroll
                    for (int j = 0; j < 8; ++j) { const int k = j >> 1; const unsigned long long sh = (M[k] << 1) | (k > 0 ? (M[k - 1] >> 63) : 0ull);
                        const unsigned wj = (unsigned)(sh >> (32 * (j & 1))); if (lane == j) myw |= wj; }
                }
                if (lane < 8) selb[(8 * w + qq) * 8 + lane] = myw;
                anyw |= myw;
            }
            if (lane < 8) wany[w * 8 + lane] = anyw;
        }
        __syncthreads();
        unsigned sw8[8], aw8[8], un8[8];
#pragma unroll
        for (int j = 0; j < 8; ++j) { sw8[j] = selb[(8 * w + ql) * 8 + j]; aw8[j] = (unsigned)__builtin_amdgcn_readfirstlane((int)wany[w * 8 + j]); unsigned un = 0u;
#pragma unroll
            for (int ww = 0; ww < 8; ++ww) un |= wany[ww * 8 + j];
            un8[j] = (unsigned)__builtin_amdgcn_readfirstlane((int)un); }
        const int nlist = blk + 1;
        for (int rp_ = 0; rp_ < NSA_SELREP; ++rp_) {
        if (rp_) { asm volatile("" :: "v"(O[0][0]), "v"(O[1][0]), "v"(O[2][0]), "v"(O[3][0]), "v"(l));
#pragma unroll
            for (int c = 0; c < 4; ++c)
#pragma unroll
                for (int i = 0; i < 16; ++i) O[c][i] = 0.f; }
        m = 0.f; l = 0.f; seen = false;
#define NS_KPTR(j) (z + (size_t)((j) * 64) * NZ + ZKS + g * 128)
#define NS_VPTR(j) (z + (size_t)((j) * 64) * NZ + ZVS + g * 128)
#define NS_DOFF doff_z
#if NSA_DECOUPLED
        {
            volatile LAS int* dland = (volatile LAS int*)(lds + NS_CNT); volatile LAS int* dfin = dland + 4;
            if (tid < 8) dland[tid] = 0;
            __syncthreads();
            int ji = 0;
            for (; ji < 3 && ji < nlist; ++ji) { const unsigned sa_ = lds_a + (unsigned)((ji & 3) * 32768); ns_dma(NS_KPTR(ji), NS_DOFF, sa_, w); ns_dma(NS_VPTR(ji), NS_DOFF, sa_ + 16384u, w); }
            unsigned cw_s = 0u, cw_a = 0u;
#define NS_TRY_ISSUE() do { while (ji < nlist && ji <= i + 3 && dfin[ji & 3] >= 8 * (ji >> 2)) { const unsigned sa_ = lds_a + (unsigned)((ji & 3) * 32768); ns_dma(NS_KPTR(ji), NS_DOFF, sa_, w); ns_dma(NS_VPTR(ji), NS_DOFF, sa_ + 16384u, w); ++ji; } } while (0)
            for (int i = 0; i < nlist; ++i) {
                NS_TRY_ISSUE();
                if (ji <= i) {
                    for (int sp = 0; dfin[i & 3] < 8 * (i >> 2) && sp < (1 << 22); ++sp) __builtin_amdgcn_s_sleep(1);
                    NS_TRY_ISSUE(); }
                { const int nb = ji - 1 - i; if (nb >= 3) NS_VMW(12); else if (nb == 2) NS_VMW(8); else if (nb == 1) NS_VMW(4); else NS_VMW(0); }
                if (lane == 0) __hip_atomic_fetch_add((int*)(dland + (i & 3)), 1, __ATOMIC_RELAXED, __HIP_MEMORY_SCOPE_WORKGROUP);
                const int sb = i, bit = sb & 31;
                if (bit == 0) { const int wi = sb >> 5; cw_s = sw8[0]; cw_a = aw8[0];
#pragma unroll
                    for (int j = 1; j < 8; ++j) { if (wi == j) { cw_s = sw8[j]; cw_a = aw8[j]; } } }
                if ((cw_a >> bit) & 1u) {
                    const int tgt = 8 * ((i >> 2) + 1);
                    for (int sp = 0; dland[i & 3] < tgt && sp < (1 << 22); ++sp) __builtin_amdgcn_s_sleep(1);
                    asm volatile("" ::: "memory");
                    const bool rsel = (cw_s >> bit) & 1u;
                    const LAS unsigned char* kb = lds + (i & 3) * 32768;
                    f32x16 x0, x1; ns_qk(x0, x1, kb, qf, rho, hh, rsel ? -m : -INFINITY);
                    if (sb == blk) { const int kp0 = sb * 64;
#pragma unroll
                        for (int r = 0; r < 16; ++r) { const int kp = kp0 + NS_KIDX(r, hh); x0[r] = (kp <= tq) ? x0[r] : -INFINITY; x1[r] = (kp + 32 <= tq) ? x1[r] : -INFINITY; } }
                    ns_online<true>(x0, x1, m, l, seen, O);
                    NS_TRY_ISSUE();
                    ns_pv(O, kb + 16384, x0, x1, lane);
                    asm volatile("s_waitcnt lgkmcnt(0)" ::: "memory");
                }
                if (lane == 0) __hip_atomic_fetch_add((int*)(dfin + (i & 3)), 1, __ATOMIC_RELAXED, __HIP_MEMORY_SCOPE_WORKGROUP);
            }
#undef NS_TRY_ISSUE
            __syncthreads();
        }
        }
#else
        const int npair = (nlist + 1) >> 1;
#define NS_ISSUE_PAIR(ip) do { const unsigned sa_ = lds_a + (unsigned)(((ip) & 1) * 65536); const int j0_ = 2 * (ip); \
            ns_dma(NS_KPTR(j0_), NS_DOFF, sa_, w); ns_dma(NS_VPTR(j0_), NS_DOFF, sa_ + 16384u, w); \
            if (j0_ + 1 < nlist) { ns_dma(NS_KPTR(j0_ + 1), NS_DOFF, sa_ + 32768u, w); ns_dma(NS_VPTR(j0_ + 1), NS_DOFF, sa_ + 49152u, w); } } while (0)
        NS_ISSUE_PAIR(0); NS_VMW(0); __syncthreads();
        unsigned cw_s = 0u, cw_a = 0u;
        for (int ip = 0; ip < npair; ++ip) {
            if (ip + 1 < npair) NS_ISSUE_PAIR(ip + 1);
#pragma unroll
            for (int hb = 0; hb < 2; ++hb) {
                const int sb = 2 * ip + hb, bit = sb & 31;
                if (sb < nlist) {
                    if (bit == 0) { const int wi = sb >> 5; cw_s = sw8[0]; cw_a = aw8[0];
#pragma unroll
                        for (int j = 1; j < 8; ++j) { if (wi == j) { cw_s = sw8[j]; cw_a = aw8[j]; } } }
                    if ((cw_a >> bit) & 1u) {
                        const bool rsel = (cw_s >> bit) & 1u;
                        const LAS unsigned char* kb = lds + (ip & 1) * 65536 + hb * 32768;
                        f32x16 x0, x1; ns_qk(x0, x1, kb, qf, rho, hh, rsel ? -m : -INFINITY);
                        if (sb == blk) { const int kp0 = sb * 64;
#pragma unroll
                            for (int r = 0; r < 16; ++r) { const int kp = kp0 + NS_KIDX(r, hh); x0[r] = (kp <= tq) ? x0[r] : -INFINITY; x1[r] = (kp + 32 <= tq) ? x1[r] : -INFINITY; } }
                        ns_online<true>(x0, x1, m, l, seen, O);
                        ns_pv(O, kb + 16384, x0, x1, lane);
                    }
                }
            }
            NS_VMW(0); __syncthreads();
        }
        }
#endif
#undef NS_KPTR
#undef NS_VPTR
        l += __shfl_xor(l, 32);
        { const float sc = gate_s / fmaxf(l, 1e-30f); f32x4 ev[4][4];
#pragma unroll
          for (int c = 0; c < 4; ++c)
#pragma unroll
              for (int r4 = 0; r4 < 4; ++r4) ev[c][r4] = *(const f32x4*)(orow + 32 * c + 8 * r4);
#pragma unroll
          for (int c = 0; c < 4; ++c) {
#pragma unroll
              for (int r4 = 0; r4 < 4; ++r4) { const f32x4 e = ev[c][r4]; *(f32x4*)(orow + 32 * c + 8 * r4) = (f32x4){e.x + O[c][4 * r4] * sc, e.y + O[c][4 * r4 + 1] * sc, e.z + O[c][4 * r4 + 2] * sc, e.w + O[c][4 * r4 + 3] * sc}; }
#pragma unroll
              for (int i = 0; i < 16; ++i) O[c][i] = 0.f; } }
        const int wb0 = blk >= 8 ? blk - 8 : 0, nwt = blk - wb0 + 1;
        for (int rp_ = 0; rp_ < NSA_WINREP; ++rp_) {
        if (rp_) { asm volatile("" :: "v"(O[0][0]), "v"(O[1][0]), "v"(O[2][0]), "v"(O[3][0]), "v"(l));
#pragma unroll
            for (int c = 0; c < 4; ++c)
#pragma unroll
                for (int i = 0; i < 16; ++i) O[c][i] = 0.f; }
        m = 0.f; l = 0.f; seen = false;
#define NS_KPTR(j) (z + (size_t)((wb0 + (j)) * 64) * NZ + ZKW + g * 128)
#define NS_VPTR(j) (z + (size_t)((wb0 + (j)) * 64) * NZ + ZVW + g * 128)
        { const int npw = (nwt + 1) >> 1;
#define NS_ISSUE_WPAIR(ip) do { const unsigned sa_ = lds_a + (unsigned)(((ip) & 1) * 65536); const int j0_ = 2 * (ip); \
              ns_dma(NS_KPTR(j0_), NS_DOFF, sa_, w); ns_dma(NS_VPTR(j0_), NS_DOFF, sa_ + 16384u, w); \
              if (j0_ + 1 < nwt) { ns_dma(NS_KPTR(j0_ + 1), NS_DOFF, sa_ + 32768u, w); ns_dma(NS_VPTR(j0_ + 1), NS_DOFF, sa_ + 49152u, w); } } while (0)
          NS_ISSUE_WPAIR(0); NS_VMW(0); __syncthreads();
          for (int ip = 0; ip < npw; ++ip) {
              if (ip + 1 < npw) NS_ISSUE_WPAIR(ip + 1);
#pragma unroll
              for (int hb = 0; hb < 2; ++hb) { const int i = 2 * ip + hb;
                  if (i < nwt) { const int kb = wb0 + i; const LAS unsigned char* kbp = lds + (ip & 1) * 65536 + hb * 32768;
                      f32x16 x0, x1; ns_qk(x0, x1, kbp, qf, rho, hh, -m);
                      if (i == 0 || i == nwt - 1) { const int kp0 = kb * 64;
#pragma unroll
                          for (int r = 0; r < 16; ++r) { const int kp = kp0 + NS_KIDX(r, hh);
                              x0[r] = (kp <= tq && kp + 511 >= tq) ? x0[r] : -INFINITY; x1[r] = (kp + 32 <= tq && kp + 32 + 511 >= tq) ? x1[r] : -INFINITY; } }
                      ns_online<true>(x0, x1, m, l, seen, O);
                      ns_pv(O, kbp + 16384, x0, x1, lane); } }
              NS_VMW(0); __syncthreads();
          } }
        }
#undef NS_KPTR
#undef NS_VPTR
#undef NS_DOFF
        l += __shfl_xor(l, 32);
        { const float sc = gate_w / fmaxf(l, 1e-30f); f32x4 ev[4][4];
#pragma unroll
          for (int c = 0; c < 4; ++c)
#pragma unroll
              for (int r4 = 0; r4 < 4; ++r4) ev[c][r4] = *(const f32x4*)(orow + 32 * c + 8 * r4);
#pragma unroll
          for (int c = 0; c < 4; ++c)
#pragma unroll
              for (int r4 = 0; r4 < 4; ++r4) { const f32x4 e = ev[c][r4]; *(f32x4*)(orow + 32 * c + 8 * r4) = (f32x4){e.x + O[c][4 * r4] * sc, e.y + O[c][4 * r4 + 1] * sc, e.z + O[c][4 * r4 + 2] * sc, e.w + O[c][4 * r4 + 3] * sc}; } }
    }
}

constexpr int RS = 72, SLOT = 64 * RS * 2, RW_FS = 68, RW_GCL = 17 * SLOT;
#define RW_SLOT(lds, i) ((LAS bf16*)((lds) + (i) * SLOT))
template <int KS> __device__ __forceinline__ void mm_acc(f32x4 (&acc)[2], const LAS bf16* X, int xs, const LAS bf16* Y, int ys, int w, int lane) {
    const LAS bf16* xp = X + (16 * (w >> 1) + (lane & 15)) * xs + 8 * (lane >> 4);
    const LAS bf16* yp = Y + (32 * (w & 1) + (lane & 15)) * ys + 8 * (lane >> 4);
#pragma unroll
    for (int ks = 0; ks < KS; ++ks) { const bf16x8 av = *(const LAS bf16x8*)(xp + 32 * ks), b0 = *(const LAS bf16x8*)(yp + 32 * ks), b1 = *(const LAS bf16x8*)(yp + 16 * ys + 32 * ks);
        acc[0] = __builtin_amdgcn_mfma_f32_16x16x32_bf16(av, b0, acc[0], 0, 0, 0); acc[1] = __builtin_amdgcn_mfma_f32_16x16x32_bf16(av, b1, acc[1], 0, 0, 0); }
}
__device__ __forceinline__ void acc_zero(f32x4 (&acc)[2]) { acc[0] = (f32x4){0.f, 0.f, 0.f, 0.f}; acc[1] = (f32x4){0.f, 0.f, 0.f, 0.f}; }
__device__ __forceinline__ void st_n(const f32x4 (&acc)[2], LAS bf16* dst, int m0, int n0) {
#pragma unroll
    for (int tn = 0; tn < 2; ++tn)
#pragma unroll
        for (int r = 0; r < 4; ++r) dst[(m0 + r) * RS + n0 + 16 * tn] = (bf16)acc[tn][r];
}
__device__ __forceinline__ void st_t(const f32x4 (&acc)[2], LAS bf16* dst, int m0, int n0) {
#pragma unroll
    for (int tn = 0; tn < 2; ++tn) { const bf16x4 v = {(bf16)acc[tn][0], (bf16)acc[tn][1], (bf16)acc[tn][2], (bf16)acc[tn][3]}; *(LAS bf16x4*)(dst + (n0 + 16 * tn) * RS + m0) = v; }
}
__device__ __forceinline__ void ld_n(f32x4 (&acc)[2], const LAS bf16* src, int m0, int n0) {
#pragma unroll
    for (int tn = 0; tn < 2; ++tn)
#pragma unroll
        for (int r = 0; r < 4; ++r) acc[tn][r] = (float)src[(m0 + r) * RS + n0 + 16 * tn];
}
template <bool INCL> __device__ __forceinline__ void tri_mask(f32x4 (&acc)[2], int m0, int n0) {
#pragma unroll
    for (int tn = 0; tn < 2; ++tn)
#pragma unroll
        for (int r = 0; r < 4; ++r) { const int m = m0 + r, n = n0 + 16 * tn; if (INCL ? (n > m) : (n >= m)) acc[tn][r] = 0.f; }
}
__device__ __forceinline__ void st_acc_g(const f32x4 (&acc)[2], f16* base, int u, int w, int lane) {
#pragma unroll
    for (int tn = 0; tn < 2; ++tn) { const f16x4 v = {(f16)acc[tn][0], (f16)acc[tn][1], (f16)acc[tn][2], (f16)acc[tn][3]}; ((f16x4*)base)[((size_t)u * 16 + w * 2 + tn) * 64 + lane] = v; }
}
__device__ __forceinline__ float fast_tanh(float x) { const float e = __expf(2.f * x); return 1.f - 2.f / (e + 1.f); }

__device__ __forceinline__ void p_rwkv_local(const Args& a, LAS unsigned char* lds) {
    const int tid = opaque_tid(), lane = tid & 63, w = __builtin_amdgcn_readfirstlane(tid >> 6);
    const int m0 = 16 * (w >> 1) + 4 * (lane >> 4), n0 = 32 * (w & 1) + (lane & 15);
    const int et = tid >> 3, cg = tid & 7;
    const f16* z = (const f16*)(a.ws + WS_Z);
    unsigned char* ro = (unsigned char*)a.out;
    LAS float* FW = (LAS float*)(lds + 8 * SLOT); LAS float* FA = FW + 64 * RW_FS; LAS float* TOT = FA + 64 * RW_FS; LAS float* GCL = (LAS float*)(lds + RW_GCL); LAS float* PRM = GCL + 64;
    const int h = blockIdx.x & 15, cstep = gridDim.x >> 4, ch0 = h * 64 + 8 * cg;
    __syncthreads();
    if (tid < 64) { const int ch = h * 64 + tid; const float* mu = a.in[I_MU];
        PRM[tid] = mu[ch]; PRM[64 + tid] = mu[1024 + ch]; PRM[128 + tid] = mu[2048 + ch]; PRM[192 + tid] = mu[3072 + tid]; PRM[256 + tid] = mu[3136 + tid];
        PRM[320 + tid] = a.in[I_W0][ch]; PRM[384 + tid] = a.in[I_A0][ch]; PRM[448 + tid] = a.in[I_KK][ch]; PRM[512 + tid] = a.in[I_KA][ch]; PRM[576 + tid] = a.in[I_RK][ch]; }
    { bf16x8 id8;
#pragma unroll
      for (int e = 0; e < 8; ++e) id8[e] = (bf16)((8 * cg + e == et) ? 1.f : 0.f);
      *(LAS bf16x8*)(RW_SLOT(lds, 16) + et * RS + 8 * cg) = id8; }
    *(LAS u32x4*)(RW_SLOT(lds, 14) + et * RS + 8 * cg) = *(const u32x4*)((const bf16*)(a.ws + WS_WUPT) + (size_t)(h * 64 + et) * 64 + 8 * cg);
    *(LAS u32x4*)(RW_SLOT(lds, 15) + et * RS + 8 * cg) = *(const u32x4*)((const bf16*)(a.ws + WS_AUPT) + (size_t)(h * 64 + et) * 64 + 8 * cg);
    f16x8 zc[5], zp[5];
    const f16x8 zero8 = {0, 0, 0, 0, 0, 0, 0, 0};
#define RW_LOADZ(cc) do { const int t_ = (cc) * 64 + et; const f16* cur_ = z + (size_t)t_ * NZ; const bool hp_ = t_ > 0; \
        zc[0] = *(const f16x8*)(cur_ + ZR + ch0); zc[1] = *(const f16x8*)(cur_ + ZK + ch0); zc[2] = *(const f16x8*)(cur_ + ZV + ch0); zc[3] = *(const f16x8*)(cur_ + ZWD + 8 * cg); zc[4] = *(const f16x8*)(cur_ + ZAD + 8 * cg); \
        zp[0] = hp_ ? *(const f16x8*)(cur_ - NZ + ZR + ch0) : zero8; zp[1] = hp_ ? *(const f16x8*)(cur_ - NZ + ZK + ch0) : zero8; zp[2] = hp_ ? *(const f16x8*)(cur_ - NZ + ZV + ch0) : zero8; \
        zp[3] = hp_ ? *(const f16x8*)(cur_ - NZ + ZWD + 8 * cg) : zero8; zp[4] = hp_ ? *(const f16x8*)(cur_ - NZ + ZAD + 8 * cg) : zero8; } while (0)
    __syncthreads();
    if ((blockIdx.x >> 4) < 256) RW_LOADZ(blockIdx.x >> 4);
    asm volatile("" :: "v"(zc[0]), "v"(zc[1]), "v"(zc[2]), "v"(zc[3]), "v"(zc[4]), "v"(zp[0]), "v"(zp[1]), "v"(zp[2]), "v"(zp[3]), "v"(zp[4]));
    for (int c = blockIdx.x >> 4; c < 256; c += cstep) {
        const int t0 = c * 64, uo = h * 256 + c;
        float r_[8], k_[8], v_[8];
        { bf16x8 x1, x2;
#pragma unroll
          for (int e = 0; e < 8; ++e) { const int jj = 8 * cg + e;
              r_[e] = (float)zc[0][e] + ((float)zp[0][e] - (float)zc[0][e]) * PRM[jj]; k_[e] = (float)zc[1][e] + ((float)zp[1][e] - (float)zc[1][e]) * PRM[64 + jj]; v_[e] = (float)zc[2][e] + ((float)zp[2][e] - (float)zc[2][e]) * PRM[128 + jj];
              x1[e] = (bf16)fast_tanh((float)zc[3][e] + ((float)zp[3][e] - (float)zc[3][e]) * PRM[192 + jj]); x2[e] = (bf16)((float)zc[4][e] + ((float)zp[4][e] - (float)zc[4][e]) * PRM[256 + jj]); }
          *(LAS bf16x8*)(RW_SLOT(lds, 0) + et * RS + 8 * cg) = x1; *(LAS bf16x8*)(RW_SLOT(lds, 1) + et * RS + 8 * cg) = x2; }
        if (c + cstep < 256) RW_LOADZ(c + cstep);
        __syncthreads();
        { f32x4 acc[2]; acc_zero(acc); mm_acc<2>(acc, RW_SLOT(lds, 0), RS, RW_SLOT(lds, 14), RS, w, lane);
#pragma unroll
          for (int tn = 0; tn < 2; ++tn)
#pragma unroll
              for (int r = 0; r < 4; ++r) FW[(m0 + r) * RW_FS + n0 + 16 * tn] = acc[tn][r];
          acc_zero(acc); mm_acc<2>(acc, RW_SLOT(lds, 1), RS, RW_SLOT(lds, 15), RS, w, lane);
#pragma unroll
          for (int tn = 0; tn < 2; ++tn)
#pragma unroll
              for (int r = 0; r < 4; ++r) FA[(m0 + r) * RW_FS + n0 + 16 * tn] = acc[tn][r]; }
        __syncthreads();
        float lw_[8], kk_[8], b_[8];
        { float ss = 0.f, sb = 0.f;
#pragma unroll
          for (int e = 0; e < 8; ++e) {
              const float wpre = PRM[320 + 8 * cg + e] + FW[et * RW_FS + 8 * cg + e]; const float y0 = -wpre; const float sp = fmaxf(y0, 0.f) + __logf(1.f + __expf(-fabsf(y0)));
              lw_[e] = -__expf(-sp - 0.5f);
              const float av = sigmoidf_(PRM[384 + 8 * cg + e] + FA[et * RW_FS + 8 * cg + e]);
              const float kkr = k_[e] * PRM[448 + 8 * cg + e]; ss += kkr * kkr; kk_[e] = kkr;
              k_[e] = k_[e] * (1.f + (av - 1.f) * PRM[512 + 8 * cg + e]); b_[e] = av;
              sb += r_[e] * k_[e] * PRM[576 + 8 * cg + e]; }
          ss += __shfl_xor(ss, 1); ss += __shfl_xor(ss, 2); ss += __shfl_xor(ss, 4);
          sb += __shfl_xor(sb, 1); sb += __shfl_xor(sb, 2); sb += __shfl_xor(sb, 4);
          const float rn = rsqrtf(fmaxf(ss, 1e-24f));
#pragma unroll
          for (int e = 0; e < 8; ++e) { kk_[e] *= rn; b_[e] *= kk_[e]; FW[et * RW_FS + 8 * cg + e] = lw_[e]; }
          if (cg == 0) ((float*)(a.ws + WS_SBON))[(size_t)(t0 + et) * 16 + h] = sb; }
        __syncthreads();
        { const int j = tid & 63, rg = tid >> 6; float run = 0.f;
#pragma unroll
          for (int i = 0; i < 8; ++i) { run += FW[(8 * rg + i) * RW_FS + j]; FW[(8 * rg + i) * RW_FS + j] = run; }
          TOT[rg * 64 + j] = run;
          __syncthreads();
          float off = 0.f;
          for (int q = 0; q < rg; ++q) off += TOT[q * 64 + j];
#pragma unroll
          for (int i = 0; i < 8; ++i) FW[(8 * rg + i) * RW_FS + j] += off; }
        __syncthreads();
        { bf16x8 at, bt, kt, rt, bh, kh, vv;
#pragma unroll
          for (int e = 0; e < 8; ++e) { const int jj = 8 * cg + e; const float cum = FW[et * RW_FS + jj], cl = FW[63 * RW_FS + jj];
              const float eA = __expf(cum - lw_[e]), eN = __expf(-cum), eP = __expf(cum), eH = __expf(cl - cum);
              at[e] = (bf16)(-kk_[e] * eA); bt[e] = (bf16)(b_[e] * eN); kt[e] = (bf16)(k_[e] * eN); rt[e] = (bf16)(r_[e] * eP);
              bh[e] = (bf16)(b_[e] * eH); kh[e] = (bf16)(k_[e] * eH); vv[e] = (bf16)v_[e];
              if (et == 63) GCL[jj] = __expf(cl); }
          *(LAS bf16x8*)(RW_SLOT(lds, 0) + et * RS + 8 * cg) = at; *(LAS bf16x8*)(RW_SLOT(lds, 2) + et * RS + 8 * cg) = bt;
          *(LAS bf16x8*)(RW_SLOT(lds, 3) + et * RS + 8 * cg) = kt; *(LAS bf16x8*)(RW_SLOT(lds, 4) + et * RS + 8 * cg) = rt;
          *(LAS bf16x8*)(RW_SLOT(lds, 5) + et * RS + 8 * cg) = bh; *(LAS bf16x8*)(RW_SLOT(lds, 6) + et * RS + 8 * cg) = kh; *(LAS bf16x8*)(RW_SLOT(lds, 7) + et * RS + 8 * cg) = vv; }
        __syncthreads();
#define RW_MM(acc, XS, YS) mm_acc<2>(acc, RW_SLOT(lds, XS), RS, RW_SLOT(lds, YS), RS, w, lane)
#define RW_ST(acc, DS) st_t(acc, RW_SLOT(lds, DS), m0, n0)
        { f32x4 acc[2];
          acc_zero(acc); RW_MM(acc, 0, 16); RW_ST(acc, 1);
          acc_zero(acc); RW_MM(acc, 5, 16); RW_ST(acc, 8);
          acc_zero(acc); RW_MM(acc, 6, 16); RW_ST(acc, 9);
          acc_zero(acc); RW_MM(acc, 7, 16); RW_ST(acc, 10);
          __syncthreads();
          acc_zero(acc); RW_MM(acc, 2, 0);
#pragma unroll
          for (int tn = 0; tn < 2; ++tn)
#pragma unroll
              for (int r = 0; r < 4; ++r) if (m0 + r >= n0 + 16 * tn) acc[tn][r] = 0.f;
          RW_ST(acc, 5);
#pragma unroll
          for (int tn = 0; tn < 2; ++tn)
#pragma unroll
              for (int r = 0; r < 4; ++r) if (m0 + r == n0 + 16 * tn) acc[tn][r] = 1.f;
          RW_ST(acc, 13);
          acc_zero(acc); RW_MM(acc, 0, 2); tri_mask<false>(acc, m0, n0); RW_ST(acc, 6);
          acc_zero(acc); RW_MM(acc, 0, 3); tri_mask<false>(acc, m0, n0); RW_ST(acc, 7);
          acc_zero(acc); RW_MM(acc, 2, 4);
#pragma unroll
          for (int tn = 0; tn < 2; ++tn)
#pragma unroll
              for (int r = 0; r < 4; ++r) if (m0 + r > n0 + 16 * tn) acc[tn][r] = 0.f;
          RW_ST(acc, 11);
          acc_zero(acc); RW_MM(acc, 3, 4);
#pragma unroll
          for (int tn = 0; tn < 2; ++tn)
#pragma unroll
              for (int r = 0; r < 4; ++r) if (m0 + r > n0 + 16 * tn) acc[tn][r] = 0.f;
          RW_ST(acc, 12);
          __syncthreads();
#define RW_LDT(acc, TS) do { _Pragma("unroll") for (int tn_ = 0; tn_ < 2; ++tn_) { const bf16x4 v_ = *(const LAS bf16x4*)(RW_SLOT(lds, TS) + (n0 + 16 * tn_) * RS + m0); acc[tn_] = (f32x4){(float)v_[0], (float)v_[1], (float)v_[2], (float)v_[3]}; } } while (0)
          acc_zero(acc); RW_MM(acc, 6, 5); RW_ST(acc, 0); acc_zero(acc); RW_MM(acc, 5, 6); RW_ST(acc, 2);
          __syncthreads();
          RW_LDT(acc, 13); RW_MM(acc, 2, 13); RW_ST(acc, 3);
          acc_zero(acc); RW_MM(acc, 2, 0); RW_ST(acc, 5); acc_zero(acc); RW_MM(acc, 0, 2); RW_ST(acc, 6);
          __syncthreads();
          RW_LDT(acc, 3); RW_MM(acc, 6, 3); RW_ST(acc, 13);
          acc_zero(acc); RW_MM(acc, 6, 5); RW_ST(acc, 0); acc_zero(acc); RW_MM(acc, 5, 6); RW_ST(acc, 2);
          __syncthreads();
          RW_LDT(acc, 13); RW_MM(acc, 2, 13); RW_ST(acc, 3);
          acc_zero(acc); RW_MM(acc, 2, 0); RW_ST(acc, 5); acc_zero(acc); RW_MM(acc, 0, 2); RW_ST(acc, 6);
          __syncthreads();
          RW_LDT(acc, 3); RW_MM(acc, 6, 3); RW_ST(acc, 13);
          acc_zero(acc); RW_MM(acc, 5, 6); RW_ST(acc, 2);
          __syncthreads();
          RW_LDT(acc, 13); RW_MM(acc, 2, 13); RW_ST(acc, 3);
          __syncthreads();
          acc_zero(acc); RW_MM(acc, 3, 1); RW_ST(acc, 0);
          acc_zero(acc); RW_MM(acc, 7, 3); RW_ST(acc, 5);
          __syncthreads();
          asm volatile("" :: "v"(zc[0]), "v"(zc[1]), "v"(zc[2]), "v"(zc[3]), "v"(zc[4]), "v"(zp[0]), "v"(zp[1]), "v"(zp[2]), "v"(zp[3]), "v"(zp[4]));
          acc_zero(acc); RW_MM(acc, 5, 10); RW_ST(acc, 6);
          acc_zero(acc); RW_MM(acc, 0, 11);
#pragma unroll
          for (int tn = 0; tn < 2; ++tn) { const int tt = n0 + 16 * tn; const bf16x4 rr = *(const LAS bf16x4*)(RW_SLOT(lds, 4) + tt * RS + m0);
              const bf16x4 o = {(bf16)(acc[tn][0] + (float)rr[0]), (bf16)(acc[tn][1] + (float)rr[1]), (bf16)(acc[tn][2] + (float)rr[2]), (bf16)(acc[tn][3] + (float)rr[3])};
              *(bf16x4*)((bf16*)(ro + RO_Q) + (size_t)uo * 4096 + tt * 64 + m0) = o; }
          acc_zero(acc); RW_MM(acc, 0, 8);
#pragma unroll
          for (int tn = 0; tn < 2; ++tn) { const int jj = n0 + 16 * tn; const float gc = GCL[jj];
              const bf16x4 o = {(bf16)(acc[tn][0] + (m0 == jj ? gc : 0.f)), (bf16)(acc[tn][1] + (m0 + 1 == jj ? gc : 0.f)), (bf16)(acc[tn][2] + (m0 + 2 == jj ? gc : 0.f)), (bf16)(acc[tn][3] + (m0 + 3 == jj ? gc : 0.f))};
              *(bf16x4*)((bf16*)(ro + RO_M) + (size_t)uo * 4096 + jj * 64 + m0) = o; }
          __syncthreads();
          acc_zero(acc); RW_MM(acc, 11, 6); RW_MM(acc, 12, 10); st_acc_g(acc, (f16*)(ro + RO_Y), uo, w, lane);
          acc_zero(acc); RW_MM(acc, 6, 8); RW_MM(acc, 10, 9); st_acc_g(acc, (f16*)(ro + RO_N), uo, w, lane);
        }
#undef RW_MM
#undef RW_ST
#undef RW_LDT
    }
}
__device__ __forceinline__ void p_rwkv_scan(const Args& a, LAS unsigned char* lds, int h) {
    const int tid = opaque_tid(), lane = tid & 63, w = __builtin_amdgcn_readfirstlane(tid >> 6);
    const int m0 = 16 * (w >> 1) + 4 * (lane >> 4), n0 = 32 * (w & 1) + (lane & 15), row = tid >> 3, seg = tid & 7;
    const unsigned char* ro = (const unsigned char*)a.out;
    const bf16* Mg = (const bf16*)(ro + RO_M) + (size_t)h * 256 * 4096; const f16x4* Ng = (const f16x4*)(ro + RO_N) + (size_t)h * 256 * 1024; bf16* Sg = (bf16*)(a.ws + WS_RS) + (size_t)h * 256 * 4096;
    f32x4 acc[2]; acc_zero(acc);
    u32x4 mreg = *(const u32x4*)(Mg + row * 64 + seg * 8); f16x4 nreg[2] = {Ng[(w * 2) * 64 + lane], Ng[(w * 2 + 1) * 64 + lane]};
    for (int c = 0; c < 256; ++c) {
        LAS bf16* Sb = RW_SLOT(lds, c & 1); LAS bf16* Mb = RW_SLOT(lds, 2 + (c & 1));
        st_n(acc, Sb, m0, n0);
        *(LAS u32x4*)(Mb + row * RS + seg * 8) = mreg;
        const f16x4 nc0 = nreg[0], nc1 = nreg[1];
        if (c + 1 < 256) { mreg = *(const u32x4*)(Mg + (size_t)(c + 1) * 4096 + row * 64 + seg * 8); nreg[0] = Ng[(size_t)(c + 1) * 1024 + (w * 2) * 64 + lane]; nreg[1] = Ng[(size_t)(c + 1) * 1024 + (w * 2 + 1) * 64 + lane]; }
        __syncthreads();
        *(u32x4*)(Sg + (size_t)c * 4096 + row * 64 + seg * 8) = *(const LAS u32x4*)(Sb + row * RS + seg * 8);
        acc[0] = (f32x4){(float)nc0[0], (float)nc0[1], (float)nc0[2], (float)nc0[3]}; acc[1] = (f32x4){(float)nc1[0], (float)nc1[1], (float)nc1[2], (float)nc1[3]};
        mm_acc<2>(acc, Sb, RS, Mb, RS, w, lane);
    }
}
constexpr int RG_S = 168;
__device__ __forceinline__ void p_rwkv_out(const Args& a, LAS unsigned char* lds) {
    const int tid = opaque_tid(), lane = tid & 63, w = __builtin_amdgcn_readfirstlane(tid >> 6);
    const int m0 = 16 * (w >> 1) + 4 * (lane >> 4), n0 = 32 * (w & 1) + (lane & 15), row = tid >> 3, seg = tid & 7;
    const f16* z = (const f16*)(a.ws + WS_Z); const unsigned char* ro = (const unsigned char*)a.out; f16* mix = (f16*)(a.ws + WS_MIX);
    LAS bf16* SG = (LAS bf16*)(lds + 2 * SLOT); LAS bf16* GU = SG + 64 * RG_S; LAS float* YL = (LAS float*)(GU + 64 * RG_S); LAS float* GL = YL + 64 * RW_FS; LAS float* PRM = GL + 64 * RW_FS;
    const int h = blockIdx.x & 15, cstep = gridDim.x >> 4, et = row, cg = seg, ch0 = h * 64 + 8 * cg;
    __syncthreads();
    for (int ck = tid; ck < 64 * 20; ck += 512) { const int rr = ck / 20, c8 = ck % 20; *(LAS u32x4*)(GU + rr * RG_S + 8 * c8) = *(const u32x4*)((const bf16*)(a.ws + WS_GUPT) + (size_t)(h * 64 + rr) * 160 + 8 * c8); }
    if (tid < 160) PRM[tid] = a.in[I_MU][3200 + tid];
    if (tid < 64) { PRM[160 + tid] = a.in[I_MU][2048 + h * 64 + tid]; PRM[224 + tid] = a.in[I_LNXG][h * 64 + tid]; PRM[288 + tid] = a.in[I_LNXB][h * 64 + tid]; }
    const f16x8 zero8 = {0, 0, 0, 0, 0, 0, 0, 0};
    u32x4 qreg, sreg; f16x4 yreg[2]; f16x8 gc[3], gp[3], vc, vp; float sbn;
#define RO_LOAD(cc) do { const int uo_ = h * 256 + (cc), t0_ = (cc) * 64; \
        qreg = *(const u32x4*)((const bf16*)(ro + RO_Q) + (size_t)uo_ * 4096 + row * 64 + seg * 8); sreg = *(const u32x4*)((const bf16*)(a.ws + WS_RS) + (size_t)uo_ * 4096 + row * 64 + seg * 8); \
        { const f16x4* Yg_ = (const f16x4*)(ro + RO_Y) + (size_t)uo_ * 1024; yreg[0] = Yg_[(w * 2) * 64 + lane]; yreg[1] = Yg_[(w * 2 + 1) * 64 + lane]; } \
        _Pragma("unroll") for (int i_ = 0; i_ < 3; ++i_) { const int ck_ = tid + 512 * i_; if (ck_ < 64 * 20) { const int t_ = t0_ + ck_ / 20; const f16* cur_ = z + (size_t)t_ * NZ + ZGD + 8 * (ck_ % 20); gc[i_] = *(const f16x8*)cur_; gp[i_] = t_ > 0 ? *(const f16x8*)(cur_ - NZ) : zero8; } } \
        { const int t_ = t0_ + et; const f16* cur_ = z + (size_t)t_ * NZ + ZV + ch0; vc = *(const f16x8*)cur_; vp = t_ > 0 ? *(const f16x8*)(cur_ - NZ) : zero8; sbn = ((const float*)(a.ws + WS_SBON))[(size_t)t_ * 16 + h]; } } while (0)
    RO_LOAD(blockIdx.x >> 4);
    asm volatile("" :: "v"(qreg), "v"(sreg), "v"(yreg[0]), "v"(yreg[1]), "v"(gc[0]), "v"(gp[0]), "v"(gc[1]), "v"(gp[1]), "v"(gc[2]), "v"(gp[2]), "v"(vc), "v"(vp), "v"(sbn));
    for (int c = blockIdx.x >> 4; c < 256; c += cstep) {
        const int t0 = c * 64;
        __syncthreads();
        *(LAS u32x4*)(RW_SLOT(lds, 0) + row * RS + seg * 8) = qreg; *(LAS u32x4*)(RW_SLOT(lds, 1) + row * RS + seg * 8) = sreg;
#pragma unroll
        for (int i = 0; i < 3; ++i) { const int ck = tid + 512 * i; if (ck < 64 * 20) { const int rr = ck / 20, c8 = ck % 20; bf16x8 o;
#pragma unroll
            for (int e = 0; e < 8; ++e) o[e] = (bf16)sigmoidf_((float)gc[i][e] + ((float)gp[i][e] - (float)gc[i][e]) * PRM[8 * c8 + e]);
            *(LAS bf16x8*)(SG + rr * RG_S + 8 * c8) = o; } }
        f32x4 y[2], g[2];
        y[0] = (f32x4){(float)yreg[0][0], (float)yreg[0][1], (float)yreg[0][2], (float)yreg[0][3]}; y[1] = (f32x4){(float)yreg[1][0], (float)yreg[1][1], (float)yreg[1][2], (float)yreg[1][3]};
        const f16x8 vcc = vc, vpp = vp; const float sbc = sbn;
        if (c + cstep < 256) RO_LOAD(c + cstep);
        __syncthreads();
        mm_acc<2>(y, RW_SLOT(lds, 0), RS, RW_SLOT(lds, 1), RS, w, lane);
        acc_zero(g); mm_acc<5>(g, SG, RG_S, GU, RG_S, w, lane);
#pragma unroll
        for (int tn = 0; tn < 2; ++tn)
#pragma unroll
            for (int r = 0; r < 4; ++r) { YL[(m0 + r) * RW_FS + n0 + 16 * tn] = y[tn][r]; GL[(m0 + r) * RW_FS + n0 + 16 * tn] = g[tn][r]; }
        __syncthreads();
        { const int t = t0 + et;
          float yv[8], gv[8]; float s1 = 0.f, s2 = 0.f;
#pragma unroll
          for (int e = 0; e < 8; ++e) { yv[e] = YL[et * RW_FS + 8 * cg + e]; gv[e] = GL[et * RW_FS + 8 * cg + e]; s1 += yv[e]; s2 += yv[e] * yv[e]; }
          s1 += __shfl_xor(s1, 1); s1 += __shfl_xor(s1, 2); s1 += __shfl_xor(s1, 4);
          s2 += __shfl_xor(s2, 1); s2 += __shfl_xor(s2, 2); s2 += __shfl_xor(s2, 4);
          const float mean = s1 * (1.f / 64.f), var = fmaxf(s2 * (1.f / 64.f) - mean * mean, 0.f), rstd = rsqrtf(var + 64e-5f);
          f16x8 o;
#pragma unroll
          for (int e = 0; e < 8; ++e) { const int jj = 8 * cg + e; const float vv = (float)vcc[e] + ((float)vpp[e] - (float)vcc[e]) * PRM[160 + jj];
              const float yn = (yv[e] - mean) * rstd * PRM[224 + jj] + PRM[288 + jj]; o[e] = (f16)((yn + sbc * vv) * gv[e]); }
          asm volatile("" :: "v"(qreg), "v"(sreg), "v"(yreg[0]), "v"(yreg[1]), "v"(gc[0]), "v"(gp[0]), "v"(gc[1]), "v"(gp[1]), "v"(gc[2]), "v"(gp[2]), "v"(vc), "v"(vp), "v"(sbn));
          *(f16x8*)(mix + (size_t)t * D + 1024 + ch0) = o; }
    }
}

constexpr int RT_XS = 2048 + 8;
__device__ __forceinline__ void p_router(const Args& a, LAS unsigned char* lds, int rep) {
    const int tid = opaque_tid(), lane = tid & 63, wave = __builtin_amdgcn_readfirstlane(tid >> 6);
    const float* x2 = (const float*)(a.ws + WS_X1); f16* h3 = (f16*)a.out;
    unsigned* ctl = (unsigned*)(a.ws + WS_CTL);
    int* tke = (int*)(a.ws + WS_TOK + TK_E); float* tkw = (float*)(a.ws + WS_TOK + TK_W);
    const f16* WH = (const f16*)(a.ws + WS_WRH); const f16* WL = (const f16*)(a.ws + WS_WRL);
    LAS float* PART = (LAS float*)lds;
    LAS float* SSP = PART + 8 * 16 * 48;
    LAS float* LG = SSP + 128;
    LAS float* RSTD = LG + 16 * 48;
    LAS float* XT = RSTD + 16;
    const int row = lane & 15, kq = lane >> 4;
    for (int tile = blockIdx.x; tile < T / 16; tile += gridDim.x) {
        const int r0 = tile * 16;
        f32x4 acc[3]; acc[0] = (f32x4){0.f, 0.f, 0.f, 0.f}; acc[1] = acc[0]; acc[2] = acc[0];
        float ss = 0.f;
        const float* xp = x2 + (size_t)(r0 + row) * D + 256 * wave + 8 * kq;
        const f16* whp = WH + (size_t)row * D + 256 * wave + 8 * kq; const f16* wlp = WL + (size_t)row * D + 256 * wave + 8 * kq;
#pragma unroll 1
        for (int kb = 0; kb < 2; ++kb) {
            f32x4 xa[4], xb[4]; f16x8 bh[4][3], bl[4][3];
#pragma unroll
            for (int k4 = 0; k4 < 4; ++k4) { const int ks = kb * 4 + k4; xa[k4] = *(const f32x4*)(xp + 32 * ks); xb[k4] = *(const f32x4*)(xp + 32 * ks + 4);
#pragma unroll
                for (int nt = 0; nt < 3; ++nt) { bh[k4][nt] = *(const f16x8*)(whp + (size_t)nt * 16 * D + 32 * ks); bl[k4][nt] = *(const f16x8*)(wlp + (size_t)nt * 16 * D + 32 * ks); } }
            asm volatile("s_waitcnt vmcnt(0)" ::: "memory");
#pragma unroll
            for (int k4 = 0; k4 < 4; ++k4) {
                { LAS float* xd = XT + row * RT_XS + 256 * wave + 32 * (kb * 4 + k4) + 8 * kq; *(LAS f32x4*)xd = xa[k4]; *(LAS f32x4*)(xd + 4) = xb[k4]; }
                ss += xa[k4].x * xa[k4].x + xa[k4].y * xa[k4].y + xa[k4].z * xa[k4].z + xa[k4].w * xa[k4].w + xb[k4].x * xb[k4].x + xb[k4].y * xb[k4].y + xb[k4].z * xb[k4].z + xb[k4].w * xb[k4].w;
                f16x8 hi, lo;
#pragma unroll
                for (int j = 0; j < 4; ++j) { hi[j] = (f16)xa[k4][j]; lo[j] = (f16)(xa[k4][j] - (float)hi[j]); hi[4 + j] = (f16)xb[k4][j]; lo[4 + j] = (f16)(xb[k4][j] - (float)hi[4 + j]); }
#pragma unroll
                for (int nt = 0; nt < 3; ++nt) {
                    acc[nt] = __builtin_amdgcn_mfma_f32_16x16x32_f16(hi, bh[k4][nt], acc[nt], 0, 0, 0); acc[nt] = __builtin_amdgcn_mfma_f32_16x16x32_f16(lo, bh[k4][nt], acc[nt], 0, 0, 0); acc[nt] = __builtin_amdgcn_mfma_f32_16x16x32_f16(hi, bl[k4][nt], acc[nt], 0, 0, 0); }
            }
        }
        ss += __shfl_xor(ss, 16); ss += __shfl_xor(ss, 32);
        __syncthreads();
        if (kq == 0) SSP[wave * 16 + row] = ss;
#pragma unroll
        for (int nt = 0; nt < 3; ++nt)
#pragma unroll
            for (int r = 0; r < 4; ++r) PART[(wave * 16 + 4 * kq + r) * 48 + 16 * nt + row] = acc[nt][r];
        __syncthreads();
        for (int i = tid; i < 16 * 48; i += 512) { float v = 0.f;
#pragma unroll
            for (int ww = 0; ww < 8; ++ww) v += PART[ww * 768 + i];
            LG[i] = v; }
        if (tid < 16) { float v = 0.f;
#pragma unroll
            for (int ww = 0; ww < 8; ++ww) v += SSP[ww * 16 + tid];
            RSTD[tid] = rsqrtf(v * (1.f / D) + EPS); }
        __syncthreads();
        if (tid < 16) {
            const float rs = RSTD[tid]; const LAS float* L = LG + tid * 48;
            float lg[4];
#pragma unroll
            for (int c = 0; c < 4; ++c) lg[c] = L[c] * rs + a.in[I_RGB][c];
            int gi = 0; float gm = lg[0];
#pragma unroll
            for (int c = 1; c < 4; ++c) if (lg[c] > gm) { gm = lg[c]; gi = c; }
            float gs = 0.f;
#pragma unroll
            for (int c = 0; c < 4; ++c) gs += __expf(lg[c] - gm);
            const float pg = 1.f / gs;
            float le[8];
#pragma unroll
            for (int c = 0; c < 8; ++c) le[c] = L[4 + gi * 8 + c] * rs + a.in[I_REB][gi * 8 + c];
            int e1 = 0; float m1 = le[0];
#pragma unroll
            for (int c = 1; c < 8; ++c) if (le[c] > m1) { m1 = le[c]; e1 = c; }
            int e2 = -1; float m2 = -INFINITY;
#pragma unroll
            for (int c = 0; c < 8; ++c) if (c != e1 && le[c] > m2) { m2 = le[c]; e2 = c; }
            const float p2 = __expf(m2 - m1);
            const float w1 = pg / (1.f + p2), w2 = pg * p2 / (1.f + p2);
            const int m = r0 + tid, E1 = gi * 8 + e1, E2 = gi * 8 + e2; tke[m * 2] = E1; tke[m * 2 + 1] = E2; tkw[m * 2] = w1; tkw[m * 2 + 1] = w2;
            atomicAdd(&ctl[CW_CNT + rep * 8000 + E1], 1u); atomicAdd(&ctl[CW_CNT + rep * 8000 + E2], 1u);
        }
        { f32x4 xv[2][8], gg[8]; const f32x4* gr = (const f32x4*)a.in[I_LN3] + lane;
#pragma unroll
          for (int j = 0; j < 8; ++j) gg[j] = gr[64 * j];
#pragma unroll
          for (int rr2 = 0; rr2 < 2; ++rr2) { const LAS f32x4* xr = (const LAS f32x4*)(XT + (wave * 2 + rr2) * RT_XS) + lane;
#pragma unroll
              for (int j = 0; j < 8; ++j) xv[rr2][j] = xr[64 * j]; }
#pragma unroll
          for (int rr2 = 0; rr2 < 2; ++rr2) { const int rr = wave * 2 + rr2; const float rs = RSTD[rr]; u32x2* o8 = (u32x2*)(h3 + (size_t)(r0 + rr) * D) + lane;
#pragma unroll
              for (int j = 0; j < 8; ++j) { const f32x4 v = xv[rr2][j]; u32x2 wv; wv.x = pkh(v.x * rs * gg[j].x, v.y * rs * gg[j].y); wv.y = pkh(v.z * rs * gg[j].z, v.w * rs * gg[j].w); o8[64 * j] = wv; } } }
        __syncthreads();
    }
}
__device__ __forceinline__ void p_slots(const Args& a, LAS unsigned char* lds, int rep) {
    unsigned* ctl = (unsigned*)(a.ws + WS_CTL);
    const int* tke = (const int*)(a.ws + WS_TOK + TK_E); const float* tkw = (const float*)(a.ws + WS_TOK + TK_W); int* tks = (int*)(a.ws + WS_TOK + TK_SLOT);
    int* stok = (int*)(a.ws + WS_TOK + TK_STOK); float* sw = (float*)(a.ws + WS_TOK + TK_SW);
    const int tid = opaque_tid(), lane = tid & 63;
    LAS int* offl = (LAS int*)lds; LAS int* cntl = offl + 64;
    __syncthreads();
    if (tid < 64) {
        const int n = lane < NEXP ? (int)ctl[CW_CNT + lane] : 0, nt = (n + 255) >> 8;
        int pre = nt;
#pragma unroll
        for (int o = 1; o < 32; o <<= 1) { const int v = __shfl_up(pre, o); if ((lane & 31) >= o) pre += v; }
        const int tb = pre - nt;
        if (lane < NEXP) { offl[lane] = tb * 256; cntl[lane] = n; }
        if (lane == NEXP - 1) offl[NEXP] = pre * 256;
        if (blockIdx.x == 0 && lane < NEXP) {
            int2* ugu = (int2*)(ctl + CW_UGU); int2* udn = (int2*)(ctl + CW_UDN);
            for (int rt = 0; rt < nt; ++rt) { const int pm = tb + rt;
#pragma unroll
                for (int jt = 0; jt < 2; ++jt) ugu[pm * 2 + jt] = make_int2(pm, lane * 2 + jt);
#pragma unroll
                for (int jt = 0; jt < 8; ++jt) udn[pm * 8 + jt] = make_int2(pm, lane * 8 + jt); }
            if (lane == NEXP - 1) { ctl[CW_NT] = (unsigned)pre; ctl[CW_NGU] = (unsigned)(pre * 2); ctl[CW_NDN] = (unsigned)(pre * 8); }
        }
    }
    __syncthreads();
    if (blockIdx.x == 0 && rep == 0) {
        for (int e = 0; e < NEXP; ++e) { const int end = offl[e + 1];
            for (int sl = offl[e] + cntl[e] + tid; sl < end; sl += 512) { stok[sl] = 0; sw[sl] = 0.f; } } }
    LAS int* hist = cntl + 64; LAS int* gbase = hist + 64;
    for (int base = blockIdx.x * 512; base < T * 2; base += gridDim.x * 512) {
        __syncthreads();
        if (tid < 64) hist[tid] = 0;
        __syncthreads();
        const int i = base + tid; const bool ok = i < T * 2; const int e = ok ? tke[i] : 0;
        int rank = 0; if (ok) rank = __hip_atomic_fetch_add((int*)(hist + e), 1, __ATOMIC_RELAXED, __HIP_MEMORY_SCOPE_WORKGROUP);
        __syncthreads();
        if (tid < NEXP) { const int c = hist[tid]; gbase[tid] = c ? (int)atomicAdd(&ctl[CW_CUR + rep * 8000 + tid], (unsigned)c) : 0; }
        __syncthreads();
        if (ok) { const int slot = offl[e] + gbase[e] + rank; stok[slot] = i >> 1; sw[slot] = tkw[i]; tks[i] = slot; }
    }
}


constexpr int NPH = 17;
__global__ void __launch_bounds__(512, 2) mega(Args args) {
    extern __shared__ __attribute__((aligned(16))) unsigned char lds_raw[];
    LAS unsigned char* lds = (LAS unsigned char*)lds_raw;
    volatile LAS unsigned* MISC = (volatile LAS unsigned*)(lds + MISC_OFF);
    const int G = gridDim.x;
#define PH_IDS const int tid = opaque_tid(), lane = tid & 63, wave = tid >> 6, gw = blockIdx.x * 8 + wave, NGW = gridDim.x * 8; (void)tid; (void)lane; (void)gw; (void)NGW
    unsigned char* ws = args.ws;
    unsigned* ctl = (unsigned*)(ws + WS_CTL);
    if (threadIdx.x < 128) ((LAS unsigned*)(lds + MISC_OFF))[threadIdx.x] = 0u;
    __syncthreads();
    XcdBarrier bar; bar.bar = ctl + CW_BAR; bar.x = 0; bar.st = nullptr;
    const int lo = args.ph_lo, hi = args.ph_hi;
    if (hi - lo > 1 || DUPMASK != 0u) bar = xcd_barrier_post(ctl + CW_BAR, MISC + 8);
#ifndef PHMASK
#define PHMASK 0xFFFFFFFFu
#endif
#define IN(k) (((PHMASK >> (k)) & 1u) && lo <= (k) && (k) < hi)
#define BOTH(k) (IN(k) && IN((k) + 1))
#define GRID_BAR() xcd_barrier(bar)
#define NREP(k) ((((DUPMASK) >> (k)) & 1u) ? 2 : 1)

    for (int rep_ = 0; rep_ < NREP(0); ++rep_) if (IN(0)) { p0_prologue(args, lds); if (BOTH(0) || rep_ + 1 < NREP(0)) GRID_BAR(); }
    for (int rep_ = 0; rep_ < NREP(1); ++rep_) if (IN(1)) {
        { pg8::Gemm g{(const f16*)(ws + WS_H), (const f16*)(ws + WS_WIN), D, D, D, nullptr}; pg8::StaticOrder S; S.init(T, NZ, G, (int)blockIdx.x);
          pg8::EpiF16 E{(f16*)(ws + WS_Z), NZ, 1.f}; pg8::gemm_phase<pg8::EpiF16, pg8::StaticOrder, true>(lds, g, S, E); }
        if (BOTH(1) || rep_ + 1 < NREP(1)) GRID_BAR();
    }
    for (int rep_ = 0; rep_ < NREP(2); ++rep_) if (IN(2)) {
        for (int r2_ = 0; r2_ < ((DUPX & 1) ? 2 : 1); ++r2_) { p_compress(args, lds); __syncthreads(); }
        for (int r2_ = 0; r2_ < ((DUPX & 2) ? 2 : 1); ++r2_) { p_rwkv_local(args, lds); __syncthreads(); }
        if (BOTH(2) || rep_ + 1 < NREP(2)) GRID_BAR();
    }
    for (int rep_ = 0; rep_ < NREP(3); ++rep_) if (IN(3)) {
        if (blockIdx.x < 16) p_rwkv_scan(args, lds, blockIdx.x);
        else if (blockIdx.x < 32 && rep_ == 0) { const int b = blockIdx.x - 16; const int which = b / 8;
            pg8::Gemm g{(const f16*)(ws + WS_MEMN), (const f16*)(ws + (which == 0 ? WS_WKT : WS_WVT)), D, D, D, nullptr}; pg8::StaticOrder S; S.init(256, D, 8, b % 8);
            pg8::EpiF16 E{(f16*)(ws + (which == 0 ? WS_KM : WS_VM)), D, 1.f}; pg8::gemm_phase<pg8::EpiF16, pg8::StaticOrder, true>(lds, g, S, E); }
        __syncthreads();
        p_nsa(args, lds, rep_);
        if (BOTH(3) || rep_ + 1 < NREP(3)) GRID_BAR();
    }
    for (int rep_ = 0; rep_ < NREP(5); ++rep_) if (IN(5)) {
        p_rwkv_out(args, lds);
        __syncthreads();
        PH_IDS;
        if (blockIdx.x < 64) { const int b = blockIdx.x; const int grp = b / 8, c = b % 8;
          if (grp < 4) { const int h = grp;
              pg8::Gemm g{(const f16*)(ws + WS_KM) + h * 512, (const f16*)(ws + WS_WQ16) + h * 512, D, D, 512, nullptr}; pg8::StaticOrder S; S.init(256, D, 8, c);
              pg8::EpiF16 E{(f16*)(ws + WS_WQK) + (size_t)h * 256 * D, D, 0.04419417382415922f}; pg8::gemm_phase<pg8::EpiF16, pg8::StaticOrder, true>(lds, g, S, E); }
          else { const int h = grp - 4;
              pg8::Gemm g{(const f16*)(ws + WS_WOT) + h * 512, (const f16*)(ws + WS_VM) + h * 512, D, D, 512, nullptr}; pg8::StaticOrder S; S.init(D, 256, 8, c);
              pg8::EpiF16 E{(f16*)(ws + WS_VOT) + h * 256, 1024, 1.f}; pg8::gemm_phase<pg8::EpiF16, pg8::StaticOrder, true>(lds, g, S, E); } }
        else {
        const float* onsa = (const float*)(ws + WS_ONSA); f16* mix = (f16*)(ws + WS_MIX);
        for (int m = gw - 64 * 8; m < T; m += NGW - 64 * 8) { const f32x4* xr = (const f32x4*)(onsa + (size_t)m * 1024) + lane; f32x4 v[4]; float s = 0.f;
#pragma unroll
            for (int j = 0; j < 4; ++j) { v[j] = xr[64 * j]; s += v[j].x * v[j].x + v[j].y * v[j].y + v[j].z * v[j].z + v[j].w * v[j].w; }
            const f32x4* gr = (const f32x4*)args.in[I_NSAG] + lane; f32x4 gg[4];
#pragma unroll
            for (int j = 0; j < 4; ++j) gg[j] = gr[64 * j];
            const float rstd = rsqrtf(wave_sum(s) * (1.f / 1024.f) + EPS); u32x2* o8 = (u32x2*)(mix + (size_t)m * D) + lane;
#pragma unroll
            for (int j = 0; j < 4; ++j) { u32x2 w; w.x = pkh(v[j].x * rstd * gg[j].x, v[j].y * rstd * gg[j].y); w.y = pkh(v[j].z * rstd * gg[j].z, v[j].w * rstd * gg[j].w); o8[64 * j] = w; } }
        }
        if (BOTH(5) || rep_ + 1 < NREP(5)) GRID_BAR();
    }
    for (int rep_ = 0; rep_ < NREP(6); ++rep_) if (IN(6)) {
        pg8::Gemm g{(const f16*)(ws + WS_MIX), (const f16*)(ws + WS_WOUT), D, D, D, nullptr}; pg8::StaticOrder S; S.init(T, D, G, (int)blockIdx.x);
        pg8::EpiRes16 E{(float*)(ws + WS_X1), args.in[I_X], (f16*)(ws + WS_H2), (float*)(ws + WS_CTL + WS_ROWSS), D}; pg8::gemm_phase<pg8::EpiRes16, pg8::StaticOrder, true>(lds, g, S, E);
        if (BOTH(6) || rep_ + 1 < NREP(6)) GRID_BAR();
    }
    for (int rep_ = 0; rep_ < NREP(7); ++rep_) if (IN(7)) {
        PH_IDS;
        p_moe_weights(args, lds);
        if (BOTH(7) || rep_ + 1 < NREP(7)) GRID_BAR();
    }
    for (int rep_ = 0; rep_ < NREP(8); ++rep_) if (IN(8)) {
        pg8::Gemm g{(const f16*)(ws + WS_H2), (const f16*)(ws + WS_WQK), D, D, D, nullptr}; pg8::StaticOrder S; S.init(T, 1024, G, (int)blockIdx.x);
        pg8::EpiSoftmax E{(f16*)(ws + WS_P), 1024, (const float*)(ws + WS_CTL + WS_ROWSS), (LAS float*)(lds + RING_BYTES), (LAS float*)(lds + RING_BYTES + 4096)}; pg8::gemm_phase<pg8::EpiSoftmax, pg8::StaticOrder, true>(lds, g, S, E);
        if (BOTH(8) || rep_ + 1 < NREP(8)) GRID_BAR();
    }
    for (int rep_ = 0; rep_ < NREP(10); ++rep_) if (IN(10)) {
        pg8::Gemm g{(const f16*)(ws + WS_P), (const f16*)(ws + WS_VOT), 1024, 1024, 1024, nullptr}; pg8::StaticOrder S; S.init(T, D, G, (int)blockIdx.x);
        pg8::EpiF32 E{(float*)(ws + WS_X1), (const float*)(ws + WS_X1), D}; pg8::gemm_phase<pg8::EpiF32, pg8::StaticOrder, true>(lds, g, S, E);
        if (BOTH(10) || rep_ + 1 < NREP(10)) GRID_BAR();
    }
    for (int rep_ = 0; rep_ < NREP(11); ++rep_) if (IN(11)) { p_router(args, lds, rep_); if (BOTH(11) || rep_ + 1 < NREP(11)) GRID_BAR(); }
    for (int rep_ = 0; rep_ < NREP(13); ++rep_) if (IN(13)) { p_slots(args, lds, rep_); if (BOTH(13) || rep_ + 1 < NREP(13)) GRID_BAR(); }
    for (int rep_ = 0; rep_ < NREP(14); ++rep_) if (IN(14)) {
        pg8::Gemm g{(const f16*)args.out, (const f16*)(ws + WS_WGU), D, D, D, (const int*)(ws + WS_TOK + TK_STOK)};
        pg8::TableOrder S{(const int2*)(ctl + CW_UGU), (int)ctl[CW_NGU], G, (int)blockIdx.x};
        pg8::EpiSilu E{(f16*)(ws + WS_HID)}; pg8::gemm_phase<pg8::EpiSilu, pg8::TableOrder, true, true>(lds, g, S, E);
        if (BOTH(14) || rep_ + 1 < NREP(14)) GRID_BAR();
    }
    for (int rep_ = 0; rep_ < NREP(15); ++rep_) if (IN(15)) {
        pg8::Gemm g{(const f16*)(ws + WS_HID), (const f16*)(ws + WS_WD), EFF, EFF, EFF, nullptr};
        pg8::TableOrder S{(const int2*)(ctl + CW_UDN), (int)ctl[CW_NDN], G, (int)blockIdx.x};
        pg8::EpiDown E{ws}; pg8::gemm_phase<pg8::EpiDown, pg8::TableOrder, true>(lds, g, S, E);
        if (BOTH(15) || rep_ + 1 < NREP(15)) GRID_BAR();
    }
    for (int rep_ = 0; rep_ < NREP(16); ++rep_) if (IN(16)) {
        PH_IDS;
        const float* x2 = (const float*)(ws + WS_X1); const int* tks = (const int*)(ws + WS_TOK + TK_SLOT);
        const float* tkw = (const float*)(ws + WS_TOK + TK_W);
        for (int m0_ = gw; m0_ < T; m0_ += 2 * NGW) {
            const int mm[2] = {m0_, (m0_ + NGW < T) ? m0_ + NGW : m0_};
            int sa[2][2]; float wa[2][2];
#pragma unroll
            for (int q = 0; q < 2; ++q) { sa[q][0] = tks[mm[q] * 2]; sa[q][1] = tks[mm[q] * 2 + 1]; wa[q][0] = tkw[mm[q] * 2]; wa[q][1] = tkw[mm[q] * 2 + 1]; }
            f32x4 v[2][8]; f16x4 ya[2][2][8];
#pragma unroll
            for (int q = 0; q < 2; ++q) { const f32x4* xr = (const f32x4*)(x2 + (size_t)mm[q] * D) + lane;
#pragma unroll
                for (int j = 0; j < 8; ++j) v[q][j] = xr[64 * j];
#pragma unroll
                for (int k = 0; k < 2; ++k) { const int sl = sa[q][k]; const f16* yp = (const f16*)(ws + ((sl >> 8) < 128 ? WS_Y0 + (size_t)(sl >> 8) * MiB : WS_Y1 + (size_t)((sl >> 8) - 128) * MiB)) + (size_t)(sl & 255) * D;
#pragma unroll
                    for (int j = 0; j < 8; ++j) ya[q][k][j] = *((const f16x4*)yp + lane + 64 * j); } }
            const f32x4* gr = (const f32x4*)args.in[I_LNF] + lane; f32x4 gg[8];
#pragma unroll
            for (int j = 0; j < 8; ++j) gg[j] = gr[64 * j];
#pragma unroll
            for (int q = 0; q < 2; ++q) { float s = 0.f; const float w1 = wa[q][0], w2 = wa[q][1];
#pragma unroll
                for (int j = 0; j < 8; ++j) { const f16x4 a1 = ya[q][0][j], a2 = ya[q][1][j];
                    v[q][j].x += w1 * (float)a1.x + w2 * (float)a2.x; v[q][j].y += w1 * (float)a1.y + w2 * (float)a2.y; v[q][j].z += w1 * (float)a1.z + w2 * (float)a2.z; v[q][j].w += w1 * (float)a1.w + w2 * (float)a2.w;
                    s += v[q][j].x * v[q][j].x + v[q][j].y * v[q][j].y + v[q][j].z * v[q][j].z + v[q][j].w * v[q][j].w; }
                const float rstd = rsqrtf(wave_sum(s) * (1.f / D) + EPS);
                if (q == 0 || mm[1] != mm[0]) { f32x4* o = (f32x4*)(args.out + (size_t)mm[q] * D) + lane;
#pragma unroll
                    for (int j = 0; j < 8; ++j) o[64 * j] = (f32x4){v[q][j].x * rstd * gg[j].x, v[q][j].y * rstd * gg[j].y, v[q][j].z * rstd * gg[j].z, v[q][j].w * rstd * gg[j].w}; } }
        }
    }
#undef IN
#undef BOTH
#undef GRID_BAR
}

extern "C" void kernel_launch(void* const* d_in, const int* in_sizes, int n_in, void* d_out, int out_size, void* d_ws, size_t ws_size, hipStream_t stream) {
    static int grid = 0;
    if (grid == 0) {
        if (n_in != 38 || out_size != T * D || ws_size < WS_END) { fprintf(stderr, "kernel_launch: unexpected shapes (n_in %d out %d ws %zu)\n", n_in, out_size, ws_size); grid = -1; return; }
        int dev = 0, cus = 0;
        if (hipGetDevice(&dev) != hipSuccess || hipDeviceGetAttribute(&cus, hipDeviceAttributeMultiprocessorCount, dev) != hipSuccess) { grid = -1; return; }
        if (hipFuncSetAttribute((const void*)mega, hipFuncAttributeMaxDynamicSharedMemorySize, LDS_BYTES) != hipSuccess) { grid = -1; return; }
        int per_cu = 0; (void)hipOccupancyMaxActiveBlocksPerMultiprocessor(&per_cu, (const void*)mega, 512, LDS_BYTES); (void)hipGetLastError();
        grid = cus;
    }
    if (grid < 0) return;
    (void)hipMemsetAsync((char*)d_ws + WS_CTL, 0, CTL_ZERO_BYTES, stream);
    Args a{};
    for (int i = 0; i < 38; ++i) a.in[i] = (const float*)d_in[i];
    a.out = (float*)d_out; a.ws = (unsigned char*)d_ws;
#if MK_ONE_LAUNCH
    a.ph_lo = 0; a.ph_hi = NPH;
    hipLaunchKernelGGL(mega, dim3(grid), dim3(512), LDS_BYTES, stream, a);
#else
    for (int p = 0; p < NPH; ++p) { a.ph_lo = p; a.ph_hi = p + 1; hipLaunchKernelGGL(mega, dim3(grid), dim3(512), LDS_BYTES, stream, a); }
#endif
}
```

```cpp
#include <hip/hip_runtime.h>
#include <cstdio>
#include <cstdint>

#ifndef DUPMASK
#define DUPMASK 0u
#endif
#ifndef NSA_SELREP
#define NSA_SELREP 1
#endif
#ifndef NSA_CMPREP
#define NSA_CMPREP 1
#endif
#ifndef NSA_WINREP
#define NSA_WINREP 1
#endif
#ifndef DUPX
#define DUPX 0
#endif
#ifndef NSA_DECOUPLED
#define NSA_DECOUPLED 0
#endif
#ifndef MK_ONE_LAUNCH
#define MK_ONE_LAUNCH 1
#endif

#define LAS __attribute__((address_space(3)))
#define GAS __attribute__((address_space(1)))
typedef _Float16 f16;
typedef _Float16 f16x8 __attribute__((ext_vector_type(8)));
typedef _Float16 f16x4 __attribute__((ext_vector_type(4)));
typedef _Float16 f16x2 __attribute__((ext_vector_type(2)));
typedef float f32x4 __attribute__((ext_vector_type(4)));
typedef float f32x2 __attribute__((ext_vector_type(2)));
typedef unsigned u32x4 __attribute__((ext_vector_type(4)));
typedef unsigned u32x2 __attribute__((ext_vector_type(2)));
typedef __bf16 bf16;
typedef __bf16 bf16x8 __attribute__((ext_vector_type(8)));
typedef __bf16 bf16x4 __attribute__((ext_vector_type(4)));

constexpr int T = 16384, D = 2048, NZ = 6144;
constexpr int ZQ = 0, ZKC = 1024, ZVC = 1280, ZKS = 1536, ZVS = 1792, ZKW = 2048, ZVW = 2304, ZR = 2560, ZK = 3584, ZV = 4608, ZWD = 5632, ZAD = 5696, ZGD = 5760, ZGL = 5920;
constexpr int NCMP = 1023;
constexpr int NEXP = 32, EFF = 256, MAXSLOT = 40960, MAXTILES = 160;
constexpr float EPS = 1e-6f;

constexpr size_t MiB = 1u << 20;
constexpr size_t WS_CTL = 0, CTL_ZERO_BYTES = 192 * 1024, WS_ROWSS = 128 * 1024;
constexpr size_t WS_MEMN = 1 * MiB, WS_KM = 2 * MiB, WS_VM = 3 * MiB, WS_KCMP = 4 * MiB, WS_VCMP = 5 * MiB, WS_TOK = 6 * MiB, WS_CMPB = 7 * MiB;
constexpr size_t WS_WQK = 8 * MiB, WS_VOT = 12 * MiB, WS_WIN = 16 * MiB, WS_WOUT = 40 * MiB, WS_WQ16 = 48 * MiB, WS_WKT = 56 * MiB, WS_WVT = 64 * MiB, WS_WOT = 72 * MiB;
constexpr size_t WS_WGU = 80 * MiB, WS_WD = 144 * MiB, WS_H = 176 * MiB, WS_Z = 240 * MiB, WS_ONSA = 432 * MiB, WS_END = 512 * MiB;
constexpr size_t WS_MIX = 112 * MiB, WS_P = WS_H, WS_H2 = WS_Z, WS_X1 = 304 * MiB, WS_S = WS_ONSA, WS_HID = 16 * MiB;
constexpr size_t WS_Y0 = 176 * MiB, WS_Y1 = 432 * MiB;
constexpr size_t WS_RS = 200 * MiB, WS_SBON = 232 * MiB;
constexpr size_t WS_WUPT = WS_CMPB + 64 * 1024, WS_AUPT = WS_WUPT + 128 * 1024, WS_GUPT = WS_AUPT + 128 * 1024;
constexpr size_t WS_W1T = 496 * MiB, WS_W2T = 498 * MiB, WS_CBIAS = 498 * MiB + 65536;
constexpr size_t WS_WRH = 499 * MiB, WS_WRL = 499 * MiB + 256 * 1024;
constexpr size_t RO_M = 0, RO_N = 32 * MiB, RO_Q = 64 * MiB, RO_Y = 96 * MiB;
constexpr size_t TK_E = 0, TK_W = 128 * 1024, TK_SLOT = 256 * 1024, TK_STOK = 384 * 1024, TK_SW = 576 * 1024;
constexpr int CW_BAR = 0;
constexpr int CW_Q = 3584;
constexpr int CW_CNT = 4096, CW_CUR = 4160, CW_OFF = 4224, CW_NT = 4288  , CW_NGU = 4289, CW_NDN = 4290;
constexpr int CW_UGU = 6144  , CW_UDN = 8192  ;
static_assert((CW_UDN + MAXTILES * 8 * 2) * 4 <= (int)CTL_ZERO_BYTES, "ctl");

constexpr int RING_BYTES = 131072, LDS_BYTES = 163840, MISC_OFF = LDS_BYTES - 512;

__device__ __forceinline__ unsigned pkh(float a, float b) { f16x2 v = {(f16)a, (f16)b}; return __builtin_bit_cast(unsigned, v); }
__device__ __forceinline__ float wave_sum(float v) {
#pragma unroll
    for (int o = 1; o < 64; o <<= 1) v += __shfl_xor(v, o);
    return v;
}
__device__ __forceinline__ float wave_max(float v) {
#pragma unroll
    for (int o = 1; o < 64; o <<= 1) v = fmaxf(v, __shfl_xor(v, o));
    return v;
}
__device__ __forceinline__ int opaque_tid() { int t = threadIdx.x; asm volatile("" : "+v"(t)); return t; }
#define LDS_WAIT() asm volatile("s_waitcnt lgkmcnt(0)" ::: "memory")
#define VM_WAIT() asm volatile("s_waitcnt vmcnt(0)" ::: "memory")
__device__ __forceinline__ float sigmoidf_(float x) { return 1.f / (1.f + __expf(-x)); }

namespace pg8 {
constexpr int BM = 256, BK = 64, HALF = 128, HTB = HALF * BK * 2, STAGE_BYTES = 8 * HTB, NXCD = 8, WGM = 8;
__host__ __device__ __forceinline__ int lds_byte(int r, int c) { const int st = (r >> 4) * 2 + (c >> 5), rr = r & 15, cc = c & 31, ob = rr * 64 + cc * 2; return st * 1024 + (ob ^ (((ob >> 9) & 1) << 5)); }
__host__ __device__ __forceinline__ void stage_rc(int b, int& R, int& C) { const int st = b / 1024, sb = b % 1024, swz = sb ^ (((sb >> 9) & 1) << 5); R = (st >> 1) * 16 + swz / 64; C = (st & 1) * 32 + (swz % 64) / 2; }
__host__ __device__ __forceinline__ int perm32(int rho) { const int n = rho >> 4, i = rho & 15; return 8 * (i >> 2) + 4 * n + (i & 3); }

struct Unit { int pm, pn; };
struct Gemm { const f16* A; const f16* Bt; int lda, ldb, K; const int* gather; };

struct StaticOrder {
    int nM, nN, nwg, G, c;
    __host__ __device__ void init(int M, int N, int G_, int c_) { nM = M / BM; nN = N / BM; nwg = nM * nN; G = G_; c = c_; }
    __host__ __device__ bool next(int i, Unit& u) const {
        const long L = (long)i * G + c; if (L >= nwg) return false;
        int wgid = (int)L; { const int q = nwg / NXCD, r = nwg % NXCD, xcd = wgid % NXCD, off = wgid / NXCD; wgid = (xcd < r ? xcd * (q + 1) : r * (q + 1) + (xcd - r) * q) + off; }
        const int nig = WGM * nN, gid = wgid / nig, fm = gid * WGM, gsz = (nM - fm) < WGM ? (nM - fm) : WGM;
        u.pm = fm + ((wgid % nig) % gsz); u.pn = (wgid % nig) / gsz; return true;
    }
};
struct TableOrder {
    const int2* tab; int n, G, c;
    __device__ bool next(int i, Unit& u) const { const int L = i * G + c; if (L >= n) return false; const int2 v = tab[L]; u.pm = v.x; u.pn = v.y; return true; }
};

struct EpiF16 {
    static constexpr bool PERM = true;
    f16* O; int ldc; float scale;
    __device__ __forceinline__ void operator()(const f32x4 (&acc)[2][2][4][2], const Unit& u, int wr, int wc, int fr, int fq) const {
        const int row0 = u.pm * BM + wr * 64 + fr, col0 = u.pn * BM + wc * 32 + 8 * fq;
#pragma unroll
        for (int ai = 0; ai < 2; ++ai)
#pragma unroll
            for (int m = 0; m < 4; ++m) { f16* rowp = O + (size_t)(row0 + ai * HALF + m * 16) * ldc + col0;
#pragma unroll
                for (int bj = 0; bj < 2; ++bj) { const f32x4 v0 = acc[ai][bj][m][0] * scale, v1 = acc[ai][bj][m][1] * scale;
                    u32x4 w; w.x = pkh(v0[0], v0[1]); w.y = pkh(v0[2], v0[3]); w.z = pkh(v1[0], v1[1]); w.w = pkh(v1[2], v1[3]);
                    *(u32x4*)(rowp + bj * HALF) = w; } }
    }
};
struct EpiF32 {
    static constexpr bool PERM = false;
    float* C; const float* R; int ldc;
    __device__ __forceinline__ void operator()(const f32x4 (&acc)[2][2][4][2], const Unit& u, int wr, int wc, int fr, int fq) const {
        const int row0 = u.pm * BM + wr * 64 + fr, col0 = u.pn * BM + wc * 32 + 4 * fq;
#pragma unroll
        for (int ai = 0; ai < 2; ++ai)
#pragma unroll
            for (int m = 0; m < 4; ++m) { const size_t ro = (size_t)(row0 + ai * HALF + m * 16) * ldc + col0;
#pragma unroll
                for (int bj = 0; bj < 2; ++bj)
#pragma unroll
                    for (int n = 0; n < 2; ++n) { f32x4 v = acc[ai][bj][m][n]; if (R) v = v + *(const f32x4*)(R + ro + bj * HALF + n * 16); *(f32x4*)(C + ro + bj * HALF + n * 16) = v; } }
    }
};
struct EpiRes16 {
    static constexpr bool PERM = false;
    float* C; const float* R; f16* H; float* rowss; int ldc;
    __device__ __forceinline__ void operator()(const f32x4 (&acc)[2][2][4][2], const Unit& u, int wr, int wc, int fr, int fq) const {
        const int row0 = u.pm * BM + wr * 64 + fr, col0 = u.pn * BM + wc * 32 + 4 * fq;
#pragma unroll
        for (int ai = 0; ai < 2; ++ai)
#pragma unroll
            for (int m = 0; m < 4; ++m) { const int row = row0 + ai * HALF + m * 16; const size_t ro = (size_t)row * ldc + col0; float ss = 0.f;
                f32x4 v[2][2];
#pragma unroll
                for (int bj = 0; bj < 2; ++bj)
#pragma unroll
                    for (int n = 0; n < 2; ++n) v[bj][n] = acc[ai][bj][m][n] + *(const f32x4*)(R + ro + bj * HALF + n * 16);
#pragma unroll
                for (int bj = 0; bj < 2; ++bj)
#pragma unroll
                    for (int n = 0; n < 2; ++n) { const f32x4 x = v[bj][n]; *(f32x4*)(C + ro + bj * HALF + n * 16) = x; ss += x.x * x.x + x.y * x.y + x.z * x.z + x.w * x.w;
                        u32x2 hw; hw.x = pkh(x.x, x.y); hw.y = pkh(x.z, x.w); *(u32x2*)(H + ro + bj * HALF + n * 16) = hw; }
                ss += __shfl_xor(ss, 16); ss += __shfl_xor(ss, 32);
                if (fq == 0) atomicAdd(rowss + row, ss); }
    }
};
struct EpiSoftmax {
    static constexpr bool PERM = true;
    f16* O; int ldc; const float* rowss; LAS float* xm; LAS float* xs;
    __device__ __forceinline__ void operator()(const f32x4 (&acc)[2][2][4][2], const Unit& u, int wr, int wc, int fr, int fq) const {
        const int row0 = u.pm * BM + wr * 64 + fr, col0 = u.pn * BM + wc * 32 + 8 * fq;
        float rs[2][4], mx[2][4];
#pragma unroll
        for (int ai = 0; ai < 2; ++ai)
#pragma unroll
            for (int m = 0; m < 4; ++m) { rs[ai][m] = rsqrtf(rowss[row0 + ai * HALF + m * 16] * (1.f / D) + EPS); float v = -INFINITY;
#pragma unroll
                for (int bj = 0; bj < 2; ++bj)
#pragma unroll
                    for (int n = 0; n < 2; ++n)
#pragma unroll
                        for (int e = 0; e < 4; ++e) v = fmaxf(v, acc[ai][bj][m][n][e]);
                v *= rs[ai][m]; v = fmaxf(v, __shfl_xor(v, 16)); v = fmaxf(v, __shfl_xor(v, 32));
                if (fq == 0) xm[(ai * HALF + wr * 64 + m * 16 + fr) * 4 + wc] = v; }
        asm volatile("s_waitcnt lgkmcnt(0)" ::: "memory"); __builtin_amdgcn_s_barrier(); asm volatile("" ::: "memory");
        float e_[2][4][16]; float inv[2][4];
#pragma unroll
        for (int ai = 0; ai < 2; ++ai)
#pragma unroll
            for (int m = 0; m < 4; ++m) { const LAS f32x4* q = (const LAS f32x4*)(xm + (ai * HALF + wr * 64 + m * 16 + fr) * 4); const f32x4 mm = *q; mx[ai][m] = fmaxf(fmaxf(mm.x, mm.y), fmaxf(mm.z, mm.w)); float sm = 0.f;
#pragma unroll
                for (int bj = 0; bj < 2; ++bj)
#pragma unroll
                    for (int n = 0; n < 2; ++n)
#pragma unroll
                        for (int e = 0; e < 4; ++e) { const float ev = __expf(acc[ai][bj][m][n][e] * rs[ai][m] - mx[ai][m]); e_[ai][m][bj * 8 + n * 4 + e] = ev; sm += ev; }
                sm += __shfl_xor(sm, 16); sm += __shfl_xor(sm, 32);
                if (fq == 0) xs[(ai * HALF + wr * 64 + m * 16 + fr) * 4 + wc] = sm; }
        asm volatile("s_waitcnt lgkmcnt(0)" ::: "memory"); __builtin_amdgcn_s_barrier(); asm volatile("" ::: "memory");
#pragma unroll
        for (int ai = 0; ai < 2; ++ai)
#pragma unroll
            for (int m = 0; m < 4; ++m) { const f32x4 ssum = *(const LAS f32x4*)(xs + (ai * HALF + wr * 64 + m * 16 + fr) * 4); inv[ai][m] = 1.f / ((ssum.x + ssum.y) + (ssum.z + ssum.w));
                f16* rowp = O + (size_t)(row0 + ai * HALF + m * 16) * ldc + col0;
#pragma unroll
                for (int bj = 0; bj < 2; ++bj) { const float* ee = &e_[ai][m][bj * 8]; const float iv = inv[ai][m];
                    u32x4 w; w.x = pkh(ee[0] * iv, ee[1] * iv); w.y = pkh(ee[2] * iv, ee[3] * iv); w.z = pkh(ee[4] * iv, ee[5] * iv); w.w = pkh(ee[6] * iv, ee[7] * iv);
                    *(u32x4*)(rowp + bj * HALF) = w; } }
    }
};
struct EpiSilu {
    static constexpr bool PERM = true;
    f16* O;
    __device__ __forceinline__ void operator()(const f32x4 (&acc)[2][2][4][2], const Unit& u, int wr, int wc, int fr, int fq) const {
        const int row0 = u.pm * BM + wr * 64 + fr, col0 = (u.pn & 1) * 128 + wc * 32 + 8 * fq;
#pragma unroll
        for (int ai = 0; ai < 2; ++ai)
#pragma unroll
            for (int m = 0; m < 4; ++m) { f16* rowp = O + (size_t)(row0 + ai * HALF + m * 16) * EFF + col0;
                float h[8];
#pragma unroll
                for (int n = 0; n < 2; ++n)
#pragma unroll
                    for (int e = 0; e < 4; ++e) { const float gt = acc[ai][0][m][n][e], up = acc[ai][1][m][n][e]; h[n * 4 + e] = gt / (1.f + __expf(-gt)) * up; }
                u32x4 w; w.x = pkh(h[0], h[1]); w.y = pkh(h[2], h[3]); w.z = pkh(h[4], h[5]); w.w = pkh(h[6], h[7]);
                *(u32x4*)rowp = w; }
    }
};
struct EpiDown {
    static constexpr bool PERM = true;
    unsigned char* ws;
    __device__ __forceinline__ void operator()(const f32x4 (&acc)[2][2][4][2], const Unit& u, int wr, int wc, int fr, int fq) const {
        f16* tile = (f16*)(ws + (u.pm < 128 ? WS_Y0 + (size_t)u.pm * MiB : WS_Y1 + (size_t)(u.pm - 128) * MiB));
        const int r0 = wr * 64 + fr, col0 = (u.pn & 7) * BM + wc * 32 + 8 * fq;
#pragma unroll
        for (int ai = 0; ai < 2; ++ai)
#pragma unroll
            for (int m = 0; m < 4; ++m) { f16* rowp = tile + (size_t)(r0 + ai * HALF + m * 16) * D + col0;
#pragma unroll
                for (int bj = 0; bj < 2; ++bj) { const f32x4 v0 = acc[ai][bj][m][0], v1 = acc[ai][bj][m][1];
                    u32x4 w; w.x = pkh(v0[0], v0[1]); w.y = pkh(v0[2], v0[3]); w.z = pkh(v1[0], v1[1]); w.w = pkh(v1[2], v1[3]);
                    *(u32x4*)(rowp + bj * HALF) = w; } }
    }
};

template <class Epi, class Sched, bool ALIGN_EPI, bool GATHER = false>
__device__ __forceinline__ void gemm_phase(LAS unsigned char* lds, const Gemm g, const Sched& S, const Epi& E) {
    const int tid = opaque_tid(), wid = __builtin_amdgcn_readfirstlane(tid >> 6), lane = tid & 63, wr = wid >> 2, wc = wid & 3, fr = lane & 15, fq = lane >> 4;
    const int K = g.K, nt = K / BK;
    int RA[2], CA[2]; unsigned voffA[2], voffB[2];
#pragma unroll
    for (int i = 0; i < 2; ++i) { int R, C; stage_rc(tid * 16 + i * 8192, R, C); const int Rb = Epi::PERM ? ((R & ~31) + perm32(R & 31)) : R;
        RA[i] = R; CA[i] = C; voffA[i] = (unsigned)(R * g.lda + C) * 2u; voffB[i] = (unsigned)(Rb * g.ldb + C) * 2u; }
    const size_t kstep = (size_t)(BK * 2);
    const size_t hstepA = (size_t)HALF * g.lda * 2, tstepA = 2 * hstepA;
    const size_t hstepB = (size_t)HALF * g.ldb * 2, tstepB = 2 * hstepB;
    const unsigned ldsw = (unsigned)wid * 1024u;
    const int aoff = lds_byte(wr * 64 + fr, fq * 8), boff = lds_byte(wc * 32 + fr, fq * 8);
    const char* Ab = (const char*)g.A;
#define PG8_SA(b, h) (((b) * 2 + (h)) * HTB)
#define PG8_SB(b, h) ((4 + (b) * 2 + (h)) * HTB)
#define PG8_STAGE(bufoff, gbase, voff) do { _Pragma("unroll") for (int _i = 0; _i < 2; ++_i) \
        __builtin_amdgcn_global_load_lds((const unsigned*)((const char*)(gbase) + (voff)[_i]), (LAS unsigned*)(lds + (bufoff) + ldsw + _i * 8192), 16, 0, 0); } while (0)
#define PG8_STA_CUR(bufoff, h, kb) do { if constexpr (GATHER) { PG8_STAGE(bufoff, Ab + (kb), offC[h]); } else { PG8_STAGE(bufoff, cA + (h) * hstepA + (kb), voffA); } } while (0)
#define PG8_STA_SEL(bufoff, h, kb) do { if constexpr (GATHER) { PG8_STAGE(bufoff, Ab + (kb), o2[h]); } else { PG8_STAGE(bufoff, a2p + (h) * hstepA + (kb), voffA); } } while (0)
#define PG8_LDA(dst, b, h) do { _Pragma("unroll") for (int m = 0; m < 4; ++m) _Pragma("unroll") for (int k = 0; k < 2; ++k) dst[m][k] = *(const LAS f16x8*)(lds + PG8_SA(b, h) + aoff + m * 2048 + k * 1024); } while (0)
#define PG8_LDB(dst, b, h) do { _Pragma("unroll") for (int n = 0; n < 2; ++n) _Pragma("unroll") for (int k = 0; k < 2; ++k) dst[n][k] = *(const LAS f16x8*)(lds + PG8_SB(b, h) + boff + n * 2048 + k * 1024); } while (0)
#define PG8_MMA(ai, bj, At, Bt) do { __builtin_amdgcn_s_setprio(1); _Pragma("unroll") for (int m = 0; m < 4; ++m) _Pragma("unroll") for (int n = 0; n < 2; ++n) _Pragma("unroll") for (int k = 0; k < 2; ++k) \
        acc[ai][bj][m][n] = __builtin_amdgcn_mfma_f32_16x16x32_f16(Bt[n][k], At[m][k], acc[ai][bj][m][n], 0, 0, 0); __builtin_amdgcn_s_setprio(0); } while (0)
#define PG8_WAIT_V(n) asm volatile("s_waitcnt vmcnt(" #n ")" ::: "memory")
#define PG8_WAIT_L(n) asm volatile("s_waitcnt lgkmcnt(" #n ")" ::: "memory")
#define PG8_BAR __builtin_amdgcn_s_barrier()
#define PG8_SCHED __builtin_amdgcn_sched_barrier(0)
#define PG8_OFFS(dst, U) do { _Pragma("unroll") for (int _h = 0; _h < 2; ++_h) _Pragma("unroll") for (int _i = 0; _i < 2; ++_i) { \
        const int _r = (U).pm * BM + _h * HALF + RA[_i]; dst[_h][_i] = ((unsigned)g.gather[_r] * (unsigned)g.lda + (unsigned)CA[_i]) * 2u; } } while (0)
    Unit cur, nxt; int ui = 0;
    if (!S.next(0, cur)) return;
    f32x4 acc[2][2][4][2];
#pragma unroll
    for (int a = 0; a < 2; ++a)
#pragma unroll
        for (int b = 0; b < 2; ++b)
#pragma unroll
            for (int m = 0; m < 4; ++m)
#pragma unroll
                for (int n = 0; n < 2; ++n) acc[a][b][m][n] = (f32x4){0.f, 0.f, 0.f, 0.f};
    f16x8 At[4][2], B0[2][2], B1[2][2];
    unsigned offC[2][2], offN[2][2];
    if constexpr (GATHER) { PG8_OFFS(offC, cur); }
    const char* cA = Ab + (size_t)cur.pm * tstepA;
    const char* cB = (const char*)g.Bt + (size_t)cur.pn * tstepB;
    PG8_STAGE(PG8_SB(0, 0), cB, voffB); PG8_STAGE(PG8_SB(0, 1), cB + hstepB, voffB); PG8_STA_CUR(PG8_SA(0, 0), 0, 0); PG8_STA_CUR(PG8_SA(0, 1), 1, 0);
    if (wr == 1) PG8_BAR;
    PG8_WAIT_V(2); PG8_BAR;
    PG8_STAGE(PG8_SB(1, 0), cB + kstep, voffB); PG8_STA_CUR(PG8_SA(1, 0), 0, kstep); PG8_STAGE(PG8_SB(1, 1), cB + hstepB + kstep, voffB);
    PG8_WAIT_V(6); PG8_BAR;
    for (;;) {
        const bool has_next = S.next(ui + 1, nxt);
        if constexpr (GATHER) {
            if (has_next) { PG8_OFFS(offN, nxt); } else {
#pragma unroll
                for (int _h = 0; _h < 2; ++_h)
#pragma unroll
                    for (int _i = 0; _i < 2; ++_i) offN[_h][_i] = offC[_h][_i]; } }
        const char* nA = has_next ? Ab + (size_t)nxt.pm * tstepA : cA;
        const char* nB = has_next ? (const char*)g.Bt + (size_t)nxt.pn * tstepB : cB;
#pragma nounroll
        for (int t = 0; t < nt; t += 2) {
            const bool last = (t == nt - 2);
            const size_t kb1 = (size_t)(t + 1) * kstep;
            const size_t kb2 = last ? 0 : (size_t)(t + 2) * kstep, kb3 = kb2 + kstep;
            unsigned o2[2][2];
            if constexpr (GATHER) {
#pragma unroll
                for (int _h = 0; _h < 2; ++_h)
#pragma unroll
                    for (int _i = 0; _i < 2; ++_i) o2[_h][_i] = last ? offN[_h][_i] : offC[_h][_i]; }
            const char* a2p = last ? nA : cA;
            const char* b2 = last ? nB : cB + (size_t)(t + 2) * kstep; const char* b3 = b2 + kstep;
            PG8_LDB(B0, 0, 0); PG8_LDB(B1, 0, 1); PG8_SCHED; PG8_LDA(At, 0, 0); PG8_STA_CUR(PG8_SA(1, 1), 1, kb1);
            PG8_WAIT_V(8); PG8_WAIT_L(0); PG8_BAR; PG8_MMA(0, 0, At, B0); PG8_MMA(0, 1, At, B1); PG8_BAR; PG8_SCHED;
            PG8_LDA(At, 0, 1); PG8_STAGE(PG8_SB(0, 0), b2, voffB); PG8_STAGE(PG8_SB(0, 1), b2 + hstepB, voffB); PG8_STA_SEL(PG8_SA(0, 0), 0, kb2);
            PG8_WAIT_V(8); PG8_WAIT_L(0); PG8_BAR; PG8_MMA(1, 0, At, B0); PG8_MMA(1, 1, At, B1); PG8_BAR; PG8_SCHED;
            PG8_LDB(B0, 1, 0); PG8_LDB(B1, 1, 1); PG8_SCHED; PG8_LDA(At, 1, 0); PG8_STA_SEL(PG8_SA(0, 1), 1, kb2);
            PG8_WAIT_V(8); PG8_WAIT_L(0); PG8_BAR; PG8_MMA(0, 0, At, B0); PG8_MMA(0, 1, At, B1); PG8_BAR; PG8_SCHED;
            PG8_LDA(At, 1, 1); PG8_STAGE(PG8_SB(1, 0), b3, voffB); PG8_STAGE(PG8_SB(1, 1), b3 + hstepB, voffB); PG8_STA_SEL(PG8_SA(1, 0), 0, kb3);
            PG8_WAIT_V(8); PG8_WAIT_L(0); PG8_BAR; PG8_MMA(1, 0, At, B0); PG8_MMA(1, 1, At, B1); PG8_BAR; PG8_SCHED;
        }
        if constexpr (ALIGN_EPI) { if (wr == 0) PG8_BAR; }
        E(acc, cur, wr, wc, fr, fq);
        if (!has_next) break;
#pragma unroll
        for (int a = 0; a < 2; ++a)
#pragma unroll
            for (int b = 0; b < 2; ++b)
#pragma unroll
                for (int m = 0; m < 4; ++m)
#pragma unroll
                    for (int n = 0; n < 2; ++n) acc[a][b][m][n] = (f32x4){0.f, 0.f, 0.f, 0.f};
        cur = nxt; cA = nA; cB = nB; ++ui;
        if constexpr (GATHER) {
#pragma unroll
            for (int _h = 0; _h < 2; ++_h)
#pragma unroll
                for (int _i = 0; _i < 2; ++_i) offC[_h][_i] = offN[_h][_i]; }
        if constexpr (ALIGN_EPI) { if (wr == 1) PG8_BAR; }
    }
    PG8_WAIT_V(0);
    if constexpr (!ALIGN_EPI) { if (wr == 0) PG8_BAR; }
    PG8_BAR;
#undef PG8_SA
#undef PG8_SB
#undef PG8_STAGE
#undef PG8_STA_CUR
#undef PG8_STA_SEL
#undef PG8_LDA
#undef PG8_LDB
#undef PG8_MMA
#undef PG8_WAIT_V
#undef PG8_WAIT_L
#undef PG8_BAR
#undef PG8_SCHED
#undef PG8_OFFS
}
}

#define XB_TMO      128
#define XB_XCNT(j)  (256  + 64 * (j))
#define XB_XSUB(j)  (1280 + 64 * (j))
#define XB_XGEN(j)  (2304 + 64 * (j))
#define XB_TOP      3328
#define XB_TOPGEN   3392
#define XCD_BAR_WORDS 3456
#define XB_SPIN_CAP (1u << 22)
__device__ __forceinline__ unsigned xb_ld(unsigned* p)              { return __hip_atomic_load(p, __ATOMIC_RELAXED, __HIP_MEMORY_SCOPE_AGENT); }
__device__ __forceinline__ unsigned xb_add(unsigned* p, unsigned v) { return __hip_atomic_fetch_add(p, v, __ATOMIC_RELAXED, __HIP_MEMORY_SCOPE_AGENT); }
__device__ __forceinline__ unsigned xb_xcc_id() { return (unsigned)__builtin_amdgcn_s_getreg((3 << 11) | 20) & 0xFu; }
#define XB_SPIN(cond, bar) do { unsigned _sp = 0; while (cond) { __builtin_amdgcn_s_sleep(1); \
    if ((++_sp & 255u) == 0u) { if (xb_ld(&(bar)[XB_TMO])) break; if (_sp > XB_SPIN_CAP) { atomicAdd(&(bar)[XB_TMO], 1u); break; } } } } while (0)
struct XcdBarrier { unsigned* bar; unsigned x; volatile LAS unsigned* st; };
__device__ __forceinline__ XcdBarrier xcd_barrier_post(unsigned* bar, volatile LAS unsigned* st) {
    XcdBarrier b; b.bar = bar; b.x = xb_xcc_id(); b.st = st;
    if (threadIdx.x == 0) (void)xb_add(&bar[XB_XCNT(b.x)], 1u);
    return b;
}
__device__ __forceinline__ void xcd_barrier_complete(unsigned* bar, unsigned x, unsigned& nloc, unsigned& nx) {
    const unsigned G = gridDim.x * gridDim.y * gridDim.z;
    unsigned sum, cnt, mine, sp = 0u;
    for (;;) {
        sum = 0u; cnt = 0u; mine = 0u;
#pragma unroll
        for (unsigned j = 0; j < 16; ++j) { const unsigned c = xb_ld(&bar[XB_XCNT(j)]); sum += c; cnt += (c > 0u) ? 1u : 0u; mine = (j == x) ? c : mine; }
        if (sum == G) break;
        __builtin_amdgcn_s_sleep(1);
        if ((++sp & 255u) == 0u) { if (xb_ld(&bar[XB_TMO])) break; if (sp > XB_SPIN_CAP) { atomicAdd(&bar[XB_TMO], 1u); break; } }
    }
    nloc = mine > 0u ? mine : 1u; nx = cnt > 0u ? cnt : 1u;
}
__device__ __forceinline__ void xcd_barrier(const XcdBarrier& b) {
    asm volatile("s_waitcnt vmcnt(0)" ::: "memory");
    __syncthreads();
    if (threadIdx.x == 0) {
        unsigned* bar = b.bar;
        __builtin_amdgcn_s_waitcnt(0);
        unsigned nloc = b.st[0], nx = b.st[1];
        if (nloc == 0u) { xcd_barrier_complete(bar, b.x, nloc, nx); b.st[0] = nloc; b.st[1] = nx; }
        const unsigned old = xb_add(&bar[XB_XSUB(b.x)], 1u);
        const unsigned gen = old / nloc;
        if (old + 1u == (gen + 1u) * nloc) {
            __builtin_amdgcn_fence(__ATOMIC_RELEASE, "agent");
            asm volatile("s_waitcnt vmcnt(0)" ::: "memory");
            const unsigned og = xb_add(&bar[XB_TOP], 1u);
            const unsigned tg = og / nx;
            if (og + 1u == (tg + 1u) * nx) xb_add(&bar[XB_TOPGEN], 1u);
            else XB_SPIN(xb_ld(&bar[XB_TOPGEN]) == tg, bar);
            __builtin_amdgcn_fence(__ATOMIC_ACQUIRE, "agent");
            xb_add(&bar[XB_XGEN(b.x)], 1u);
            asm volatile("s_waitcnt vmcnt(0)" ::: "memory");
        } else {
            XB_SPIN(xb_ld(&bar[XB_XGEN(b.x)]) == gen, bar);
            __builtin_amdgcn_fence(__ATOMIC_ACQUIRE, "agent");
            asm volatile("s_waitcnt vmcnt(0)" ::: "memory");
        }
    }
    __syncthreads();
}

struct Args { const float* in[38]; float* out; unsigned char* ws; int ph_lo, ph_hi; };
enum { I_X = 0, I_MEM, I_LN1, I_WIN, I_PK, I_W1K, I_W2K, I_PV, I_W1V, I_W2V, I_NSAG, I_MU, I_W0, I_WUP, I_A0, I_AUP, I_GUP, I_KK, I_KA, I_RK, I_LNXG, I_LNXB,
       I_WOUT, I_LNMEM, I_LN2, I_WQ, I_WK, I_WV, I_WO, I_LN3, I_RGW, I_RGB, I_REW, I_REB, I_MG, I_MU2, I_MD, I_LNF };

struct TrItem { float tv[32]; f16* dst; size_t drow0; int dld, k0; };
__device__ __forceinline__ void tr_load(TrItem& it, const float* src, int sld, int k0, int scol0, int nvalid, f16* dst, size_t drow0, int dld, int lane) {
    const int nl = lane & 31; it.dst = dst; it.drow0 = drow0; it.dld = dld; it.k0 = k0;
#pragma unroll
    for (int i = 0; i < 32; ++i) { const int kk = 2 * i + (lane >> 5); it.tv[i] = (nl < nvalid) ? src[(size_t)(k0 + kk) * sld + scol0 + nl] : 0.f; }
}
__device__ __forceinline__ void tr_finish(const TrItem& it, LAS float* scr, int lane) {
    const int nl = lane & 31;
#pragma unroll
    for (int i = 0; i < 32; ++i) { const int kk = 2 * i + (lane >> 5); scr[kk * 33 + nl] = it.tv[i]; }
    LDS_WAIT(); asm volatile("" ::: "memory");
    const int c = lane & 7;
#pragma unroll
    for (int j = 0; j < 4; ++j) { const int n = (lane >> 3) + 8 * j; const LAS float* s = scr + (8 * c) * 33 + n;
        u32x4 o; o.x = pkh(s[0 * 33], s[1 * 33]); o.y = pkh(s[2 * 33], s[3 * 33]); o.z = pkh(s[4 * 33], s[5 * 33]); o.w = pkh(s[6 * 33], s[7 * 33]);
        *(u32x4*)(it.dst + (it.drow0 + n) * (size_t)it.dld + it.k0 + 8 * c) = o; }
    LDS_WAIT(); asm volatile("" ::: "memory");
}
__device__ __forceinline__ void tr_item(const float* src, int sld, int k0, int scol0, int nvalid, f16* dst, size_t drow0, int dld, LAS float* scr, int lane) {
    TrItem it; tr_load(it, src, sld, k0, scol0, nvalid, dst, drow0, dld, lane); tr_finish(it, scr, lane);
}
__device__ __forceinline__ void tr_matrix(const float* src, int K, int N, f16* dst, LAS float* scr, int gw, int NGW, int lane) {
    const int nblk = N / 32, items = (K / 64) * nblk;
    for (int it = gw; it < items; it += 2 * NGW) { TrItem a, b; const int it2 = it + NGW; const bool two = it2 < items;
        tr_load(a, src, N, (it / nblk) * 64, (it % nblk) * 32, 32, dst, (size_t)(it % nblk) * 32, K, lane);
        if (two) tr_load(b, src, N, (it2 / nblk) * 64, (it2 % nblk) * 32, 32, dst, (size_t)(it2 % nblk) * 32, K, lane);
        tr_finish(a, scr, lane); if (two) tr_finish(b, scr, lane); }
}
__device__ __forceinline__ void rms_row2(const float* xrow0, const float* xrow1, const float* gain, f16* o0, f16* o1, bool two, int lane) {
    const f32x4* xa = (const f32x4*)xrow0 + lane; const f32x4* xb = (const f32x4*)xrow1 + lane; f32x4 v[2][8], gg[8];
#pragma unroll
    for (int j = 0; j < 8; ++j) { v[0][j] = xa[64 * j]; v[1][j] = xb[64 * j]; }
    const f32x4* gr = (const f32x4*)gain + lane;
#pragma unroll
    for (int j = 0; j < 8; ++j) gg[j] = gr[64 * j];
#pragma unroll
    for (int q = 0; q < 2; ++q) { float s = 0.f;
#pragma unroll
        for (int j = 0; j < 8; ++j) s += v[q][j].x * v[q][j].x + v[q][j].y * v[q][j].y + v[q][j].z * v[q][j].z + v[q][j].w * v[q][j].w;
        const float rstd = rsqrtf(wave_sum(s) * (1.f / D) + EPS);
        if (q == 0 || two) { u32x2* o8 = (u32x2*)(q ? o1 : o0) + lane;
#pragma unroll
            for (int j = 0; j < 8; ++j) { u32x2 w; w.x = pkh(v[q][j].x * rstd * gg[j].x, v[q][j].y * rstd * gg[j].y); w.y = pkh(v[q][j].z * rstd * gg[j].z, v[q][j].w * rstd * gg[j].w); o8[64 * j] = w; } } }
}
__device__ __forceinline__ void p0_prologue(const Args& a, LAS unsigned char* lds) {
    const int tid = opaque_tid(), lane = tid & 63, wave = tid >> 6;
    const int gw = blockIdx.x * 8 + wave, NGW = gridDim.x * 8;
    LAS float* scr = (LAS float*)(lds + wave * 16384);
    unsigned char* ws = a.ws;
    { f16* dst = (f16*)(ws + WS_WIN); const float* src = a.in[I_WIN];
      const int nblk = NZ / 32, items = (D / 64) * nblk;
      for (int it0 = gw; it0 < items; it0 += 2 * NGW) { TrItem ta, tb; const bool two = it0 + NGW < items;
#pragma unroll
          for (int q = 0; q < 2; ++q) { if (q == 1 && !two) break; const int it = it0 + q * NGW; const int kb = it / nblk, nb = it % nblk, n0 = nb * 32;
              int sc = 0, nv = 32; if (n0 < 2560) sc = n0; else if (n0 < 5920) sc = n0 + 24; else if (n0 == 5920) { sc = 2560; nv = 24; } else { sc = 0; nv = 0; }
              tr_load(q ? tb : ta, src, 5944, kb * 64, sc, nv, dst, (size_t)n0, D, lane); }
          tr_finish(ta, scr, lane); if (two) tr_finish(tb, scr, lane); } }
    tr_matrix(a.in[I_WOUT], D, D, (f16*)(ws + WS_WOUT), scr, gw, NGW, lane);
    tr_matrix(a.in[I_WK], D, D, (f16*)(ws + WS_WKT), scr, gw, NGW, lane);
    tr_matrix(a.in[I_WV], D, D, (f16*)(ws + WS_WVT), scr, gw, NGW, lane);
    tr_matrix(a.in[I_WO], D, D, (f16*)(ws + WS_WOT), scr, gw, NGW, lane);
    { const f32x4* s = (const f32x4*)a.in[I_WQ]; u32x2* d = (u32x2*)(ws + WS_WQ16);
      for (size_t i = (size_t)blockIdx.x * 512 + tid; i < (size_t)D * D / 4; i += (size_t)gridDim.x * 512) { const f32x4 v = s[i]; const float gsc = a.in[I_LN2][i / (D / 4)]; u32x2 w; w.x = pkh(v.x * gsc, v.y * gsc); w.y = pkh(v.z * gsc, v.w * gsc); d[i] = w; } }
    tr_matrix(a.in[I_W1K], 4096, 128, (f16*)(ws + WS_W1T), scr, gw, NGW, lane);
    tr_matrix(a.in[I_W1V], 4096, 128, (f16*)(ws + WS_W1T) + 128 * 4096, scr, gw, NGW, lane);
    tr_matrix(a.in[I_W2K], 128, 128, (f16*)(ws + WS_W2T), scr, gw, NGW, lane);
    tr_matrix(a.in[I_W2V], 128, 128, (f16*)(ws + WS_W2T) + 128 * 128, scr, gw, NGW, lane);
    for (int o = gw; o < 256; o += NGW) { const int kv = o >> 7, n = o & 127; const float* pos = a.in[kv ? I_PV : I_PK]; const float* w1 = a.in[kv ? I_W1V : I_W1K]; float acc = 0.f;
        for (int k = lane; k < 4096; k += 64) acc += pos[k] * w1[(size_t)k * 128 + n];
        acc = wave_sum(acc); if (lane == 0) ((float*)(ws + WS_CBIAS))[o] = acc; }
    for (int i = blockIdx.x * 512 + tid; i < 48 * D; i += gridDim.x * 512) { const int c = i / D, k = i % D; float v = 0.f;
        if (c < 4) v = a.in[I_RGW][k * 4 + c]; else if (c < 36) v = a.in[I_REW][k * 32 + (c - 4)];
        v *= a.in[I_LN3][k]; const f16 hi = (f16)v; ((f16*)(ws + WS_WRH))[i] = hi; ((f16*)(ws + WS_WRL))[i] = (f16)(v - (float)hi); }
    { bf16* wu = (bf16*)(ws + WS_WUPT); bf16* au = (bf16*)(ws + WS_AUPT); bf16* gu = (bf16*)(ws + WS_GUPT);
      for (int i = blockIdx.x * 512 + tid; i < 1024 * 64; i += gridDim.x * 512) { const int ch = i >> 6, j = i & 63; wu[i] = (bf16)a.in[I_WUP][j * 1024 + ch]; au[i] = (bf16)a.in[I_AUP][j * 1024 + ch]; }
      for (int i = blockIdx.x * 512 + tid; i < 1024 * 160; i += gridDim.x * 512) { const int ch = i / 160, j = i % 160; gu[i] = (bf16)a.in[I_GUP][j * 1024 + ch]; } }
    for (int m = gw; m < T; m += 2 * NGW) { const bool two = m + NGW < T; const int m1 = two ? m + NGW : m;
        rms_row2(a.in[I_X] + (size_t)m * D, a.in[I_X] + (size_t)m1 * D, a.in[I_LN1], (f16*)(ws + WS_H) + (size_t)m * D, (f16*)(ws + WS_H) + (size_t)m1 * D, two, lane); }
    for (int m = gw; m < 256; m += NGW) rms_row2(a.in[I_MEM] + (size_t)m * D, a.in[I_MEM] + (size_t)m * D, a.in[I_LNMEM], (f16*)(ws + WS_MEMN) + (size_t)m * D, (f16*)(ws + WS_MEMN) + (size_t)m * D, false, lane);
}

__device__ __forceinline__ void p_moe_weights(const Args& a, LAS unsigned char* lds) {
    const int tid = opaque_tid(), lane = tid & 63, wave = tid >> 6;
    const int gw = blockIdx.x * 8 + wave, NGW = gridDim.x * 8;
    LAS float* scr = (LAS float*)(lds + wave * 16384);
    unsigned char* ws = a.ws;
    { f16* dst = (f16*)(ws + WS_WGU); const int items = NEXP * (D / 64) * 16;
      for (int it = gw; it < items; it += NGW) { const int e = it / ((D / 64) * 16), r = it % ((D / 64) * 16), kb = r / 16, nb = r % 16, j0 = nb * 32, jt = j0 / 256, jj = j0 % 256;
          const float* src = (jj < 128 ? a.in[I_MG] : a.in[I_MU2]) + (size_t)e * D * EFF; const int sc = jt * 128 + (jj & 127);
          tr_item(src, EFF, kb * 64, sc, 32, dst, (size_t)e * 512 + j0, D, scr, lane); } }
    { f16* dst = (f16*)(ws + WS_WD); const int items = NEXP * (EFF / 64) * (D / 32);
      for (int it = gw; it < items; it += NGW) { const int e = it / ((EFF / 64) * (D / 32)), r = it % ((EFF / 64) * (D / 32)), kb = r / (D / 32), nb = r % (D / 32);
          tr_item(a.in[I_MD] + (size_t)e * EFF * D, D, kb * 64, nb * 32, 32, dst, (size_t)e * D + nb * 32, EFF, scr, lane); } }
}

__device__ __forceinline__ float gelu_tanh(float x) { const float u = 0.7978845608028654f * (x + 0.044715f * x * x * x); const float e = __expf(2.f * u); return 0.5f * x * (2.f - 2.f / (e + 1.f)); }
constexpr int CP_RS = 272, CP_HS = 136, CP_HID = 272 * CP_RS;
__device__ __forceinline__ void p_compress(const Args& a, LAS unsigned char* lds) {
    const int tid = opaque_tid(), lane = tid & 63, w = __builtin_amdgcn_readfirstlane(tid >> 6);
    const f16* z = (const f16*)(a.ws + WS_Z);
    LAS f16* HID = (LAS f16*)(lds + CP_HID);
    for (int it = blockIdx.x; it < 256; it += gridDim.x) {
        const int kv = it >> 7, g = (it >> 6) & 1, c0 = (it & 63) * 16, tok0 = 16 * c0;
        const int zc = (kv ? ZVC : ZKC) + g * 128;
        __syncthreads();
        for (int ck = tid; ck < 272 * 16; ck += 512) { const int tl = ck >> 4, c16 = ck & 15, tok = tok0 + tl; const int rp = (tl & 15) * 17 + (tl >> 4);
            u32x4 v = {0u, 0u, 0u, 0u}; if (tok < T) v = *(const u32x4*)(z + (size_t)tok * NZ + zc + c16 * 8);
            *(LAS u32x4*)(lds + rp * CP_RS + c16 * 16) = v; }
        __syncthreads();
        f32x4 acc = {0.f, 0.f, 0.f, 0.f};
        const f16* wp = (const f16*)(a.ws + WS_W1T) + ((size_t)kv * 128 + 16 * w + (lane & 15)) * 4096 + 8 * (lane >> 4);
        const LAS unsigned char* ap = lds + (lane & 15) * CP_RS + 16 * (lane >> 4);
#pragma unroll 8
        for (int ks = 0; ks < 128; ++ks) { const int l = ks >> 2;
            const f16x8 av = *(const LAS f16x8*)(ap + ((l & 15) * 17 + (l >> 4)) * CP_RS + (ks & 3) * 64);
            const f16x8 bv = *(const f16x8*)(wp + 32 * ks);
            acc = __builtin_amdgcn_mfma_f32_16x16x32_f16(av, bv, acc, 0, 0, 0); }
        { const int n = 16 * w + (lane & 15); const float bs = ((const float*)(a.ws + WS_CBIAS))[kv * 128 + n];
#pragma unroll
          for (int r = 0; r < 4; ++r) HID[(4 * (lane >> 4) + r) * CP_HS + n] = (f16)gelu_tanh(acc[r] + bs); }
        __syncthreads();
        f32x4 o = {0.f, 0.f, 0.f, 0.f};
        const f16* w2p = (const f16*)(a.ws + WS_W2T) + ((size_t)kv * 128 + 16 * w + (lane & 15)) * 128 + 8 * (lane >> 4);
#pragma unroll
        for (int ks = 0; ks < 4; ++ks) { const f16x8 av = *(const LAS f16x8*)(HID + (lane & 15) * CP_HS + 32 * ks + 8 * (lane >> 4)); const f16x8 bv = *(const f16x8*)(w2p + 32 * ks);
            o = __builtin_amdgcn_mfma_f32_16x16x32_f16(av, bv, o, 0, 0, 0); }
        f16* dst = (f16*)(a.ws + (kv ? WS_VCMP : WS_KCMP));
#pragma unroll
        for (int r = 0; r < 4; ++r) { const int c = c0 + 4 * (lane >> 4) + r; dst[((size_t)c * 2 + g) * 128 + 16 * w + (lane & 15)] = c < NCMP ? (f16)o[r] : (f16)0.f; }
    }
}

typedef short v4i16_t __attribute__((ext_vector_type(4)));
constexpr int NS_PSEL = 65536, NS_PSTR = 257, NS_SELB = NS_PSEL + 64 * NS_PSTR * 4, NS_WANY = NS_SELB + 2048, NS_CNT = NS_WANY + 512, NS_UNIT = NS_CNT + 64;
static_assert(NS_UNIT + 64 <= MISC_OFF, "nsa lds");
__device__ __forceinline__ void glds16(const void* gsrc, unsigned lds_dst) { unsigned keep;
    asm volatile("s_mov_b32 %0, m0\n\ts_mov_b32 m0, %2\n\ts_nop 0\n\tglobal_load_lds_dwordx4 %1, off\n\ts_mov_b32 m0, %0" : "=&s"(keep) : "v"(gsrc), "s"(lds_dst) : "memory"); }
template <bool ISV> __device__ __forceinline__ void ns_dma(const f16* g0, int stride, unsigned lds_addr, int wv, int lane_) {
    unsigned lane = (unsigned)lane_;
    asm volatile("" : "+v"(lane));
#pragma unroll
    for (int i = 0; i < 2; ++i) { const unsigned row = 8u * (unsigned)wv + 4u * i + (lane >> 4), ch = (lane & 15u) ^ (ISV ? ((row & 7u) << 1) : (row & 15u));
        glds16(g0 + (row * (unsigned)stride + ch * 8u), lds_addr + (wv * 2 + i) * 1024); }
}
#define NS_VMW(n) asm volatile("s_waitcnt vmcnt(" #n ")" ::: "memory")
__device__ __forceinline__ f32x4 mfma16(const f16x8 a, const f16x8 b, const f32x4 c) { return __builtin_amdgcn_mfma_f32_16x16x32_f16(a, b, c, 0, 0, 0); }
template <bool A0, bool A1>
__device__ __forceinline__ void ns_qk(f32x4 (&s)[2][4], const LAS unsigned char* kb, const f16x8 (&qf)[2][4], int lane_, float i0, float i1) {
    unsigned lane = (unsigned)lane_;
    asm volatile("" : "+v"(lane));
    const unsigned r = lane & 15u, g = lane >> 4, xs = r >> 2;
    const LAS unsigned char* kbase = kb + 256u * r + 16u * (g ^ (r & 3u));
    f16x8 av[4][4];
#pragma unroll
    for (int ks = 0; ks < 4; ++ks) { const LAS unsigned char* kp = kbase + 64u * ((unsigned)ks ^ xs);
#pragma unroll
        for (int kt = 0; kt < 4; ++kt) av[ks][kt] = *(const LAS f16x8*)(kp + 4096 * kt); }
#pragma unroll
    for (int kt = 0; kt < 4; ++kt) { if (A0) s[0][kt] = (f32x4){i0, i0, i0, i0}; if (A1) s[1][kt] = (f32x4){i1, i1, i1, i1}; }
    __builtin_amdgcn_sched_barrier(0);
#pragma unroll
    for (int ks = 0; ks < 4; ++ks) {
#pragma unroll
        for (int kt = 0; kt < 4; ++kt) {
            if (A0) s[0][kt] = mfma16(av[ks][kt], qf[0][ks], s[0][kt]);
            if (A1) s[1][kt] = mfma16(av[ks][kt], qf[1][ks], s[1][kt]); } }
}
template <bool A0, bool A1>
__device__ __forceinline__ void ns_pv(f32x4 (&O)[2][8], const LAS unsigned char* vb, const f32x4 (&s)[2][4], int lane_) {
    unsigned lane = (unsigned)lane_;
    asm volatile("" : "+v"(lane));
    const unsigned g = lane >> 4, q = (lane & 15u) >> 2, p = lane & 3u, x = 4u * (g & 1u) + q;
    const LAS unsigned char* vrow = vb + 256u * (4u * g + q) + 8u * p;
    f16x8 pf[2][2];
#pragma unroll
    for (int h = 0; h < 2; ++h) if (h == 0 ? A0 : A1) {
#pragma unroll
        for (int k2 = 0; k2 < 2; ++k2)
#pragma unroll
            for (int j = 0; j < 4; ++j) { pf[h][k2][j] = (f16)s[h][2 * k2][j]; pf[h][k2][4 + j] = (f16)s[h][2 * k2 + 1][j]; } }
    typedef short s16x8 __attribute__((ext_vector_type(8)));
#pragma unroll
    for (int dh = 0; dh < 2; ++dh) {
        v4i16_t lo[4][2], hi[4][2];
#pragma unroll
        for (int d4 = 0; d4 < 4; ++d4) { const LAS unsigned char* b = vrow + 32u * ((unsigned)(4 * dh + d4) ^ x);
#pragma unroll
            for (int k2 = 0; k2 < 2; ++k2) {
                lo[d4][k2] = __builtin_amdgcn_ds_read_tr16_b64_v4i16((LAS v4i16_t*)(b + 8192 * k2));
                hi[d4][k2] = __builtin_amdgcn_ds_read_tr16_b64_v4i16((LAS v4i16_t*)(b + 8192 * k2 + 4096)); } }
#pragma unroll
        for (int k2 = 0; k2 < 2; ++k2)
#pragma unroll
            for (int d4 = 0; d4 < 4; ++d4) { const int dt = 4 * dh + d4;
                const s16x8 v8 = {lo[d4][k2][0], lo[d4][k2][1], lo[d4][k2][2], lo[d4][k2][3], hi[d4][k2][0], hi[d4][k2][1], hi[d4][k2][2], hi[d4][k2][3]};
                if (A0) O[0][dt] = mfma16(__builtin_bit_cast(f16x8, v8), pf[0][k2], O[0][dt]);
                if (A1) O[1][dt] = mfma16(__builtin_bit_cast(f16x8, v8), pf[1][k2], O[1][dt]); }
    }
}
constexpr float NS_THR = 6.f;
template <bool WITH_O> __device__ __forceinline__ void ns_online(f32x4 (&y)[4], float& m, float& l, bool& seen, f32x4 (&O)[8]) {
    float mx = fmaxf(fmaxf(y[0][0], y[0][1]), fmaxf(y[0][2], y[0][3]));
#pragma unroll
    for (int kt = 1; kt < 4; ++kt) mx = fmaxf(mx, fmaxf(fmaxf(y[kt][0], y[kt][1]), fmaxf(y[kt][2], y[kt][3])));
    mx = fmaxf(mx, __shfl_xor(mx, 16)); mx = fmaxf(mx, __shfl_xor(mx, 32));
    const bool fin = mx > -INFINITY, first = !seen && fin;
    if (__any(first || mx > NS_THR)) {
        const float d = first ? mx : (mx > NS_THR ? mx : 0.f), alpha = __builtin_amdgcn_exp2f(-d);
        seen = seen || fin; m += d; l *= alpha;
        if (WITH_O) {
#pragma unroll
            for (int dt = 0; dt < 8; ++dt) O[dt] = O[dt] * alpha; }
#pragma unroll
        for (int kt = 0; kt < 4; ++kt)
#pragma unroll
            for (int j = 0; j < 4; ++j) y[kt][j] -= d;
    }
    float ls = 0.f;
#pragma unroll
    for (int kt = 0; kt < 4; ++kt)
#pragma unroll
        for (int j = 0; j < 4; ++j) { y[kt][j] = __builtin_amdgcn_exp2f(y[kt][j]); ls += y[kt][j]; }
    l += ls;
}
#define NS_ISSUE(j, NSL, HASV) do { const unsigned sa_ = lds_a + (unsigned)(((j) & ((NSL) - 1)) * 32768); ns_dma<false>(NS_KPTR(j), NS_STRIDE, sa_, w, lane); if (HASV) ns_dma<true>(NS_VPTR(j), NS_STRIDE, sa_ + 16384u, w, lane); } while (0)
#define NS_WAIT(nb, HASV) do { if (HASV) { if ((nb) >= 2) NS_VMW(8); else if ((nb) == 1) NS_VMW(4); else NS_VMW(0); } else { if ((nb) >= 2) NS_VMW(4); else if ((nb) == 1) NS_VMW(2); else NS_VMW(0); } } while (0)
#define NS_PROLOGUE(n, NSL, HASV) do { const int q_ = (n) < (NSL) - 1 ? (n) : (NSL) - 1; for (int j_ = 0; j_ < q_; ++j_) NS_ISSUE(j_, NSL, HASV); NS_WAIT(q_ - 1, HASV); __syncthreads(); } while (0)
#define NS_STEP_BEGIN(i, n, NSL, HASV) do { if ((i) + (NSL) - 1 < (n)) NS_ISSUE((i) + (NSL) - 1, NSL, HASV); } while (0)
#define NS_STEP_END(i, n, NSL, HASV) do { int nb_ = ((n) - 1 < (i) + (NSL) - 1 ? (n) - 1 : (i) + (NSL) - 1) - ((i) + 1); NS_WAIT(nb_, HASV); __syncthreads(); } while (0)
#define NS_KB(i, NSL) (lds + (((i) & ((NSL) - 1)) * 32768))
#define NS_VB(i, NSL) (lds + (((i) & ((NSL) - 1)) * 32768) + 16384)
#define NS_FORALL(h, kt, j) _Pragma("unroll") for (int h = 0; h < 2; ++h) _Pragma("unroll") for (int kt = 0; kt < 4; ++kt) _Pragma("unroll") for (int j = 0; j < 4; ++j)
__device__ __forceinline__ void p_nsa(const Args& a, LAS unsigned char* lds, int rep) {
    const int tid = opaque_tid(), lane = tid & 63, w = __builtin_amdgcn_readfirstlane(tid >> 6);
#define NS_LANE(L) unsigned L = (unsigned)lane; asm volatile("" : "+v"(L))
#define NS_LANE_IDS(L) NS_LANE(L); const int n = (int)(L & 15u), g = (int)(L >> 4), q4 = n >> 2, p = n & 3, tq0 = t0 + 8 * w + q4, hq = grp * 4 + p; (void)g; (void)q4; (void)p; (void)tq0; (void)hq
    const unsigned lds_a = (unsigned)__builtin_amdgcn_readfirstlane((int)(unsigned)(size_t)lds);
    const f16* z = (const f16*)(a.ws + WS_Z); const f16* kcmp = (const f16*)(a.ws + WS_KCMP); const f16* vcmp = (const f16*)(a.ws + WS_VCMP);
    float* onsa = (float*)(a.ws + WS_ONSA); unsigned* ctl = (unsigned*)(a.ws + WS_CTL);
    LAS float* psel = (LAS float*)(lds + NS_PSEL); LAS unsigned* selb = (LAS unsigned*)(lds + NS_SELB); LAS unsigned* wany = (LAS unsigned*)(lds + NS_WANY);
    LAS int* unit_s = (LAS int*)(lds + NS_UNIT);
    const float c2 = 0.08838834764831845f * 1.4426950408889634f;
    for (;;) {
        __syncthreads();
        if (tid == 0) { const int g0 = (int)(xb_xcc_id() & 1u); int k = (int)atomicAdd(&ctl[CW_Q + rep * 4 + g0], 1u), gg = g0;
            if (k >= 256) { gg = g0 ^ 1; k = (int)atomicAdd(&ctl[CW_Q + rep * 4 + gg], 1u); }
            unit_s[0] = k; unit_s[1] = gg; }
        __syncthreads();
        const int uk = unit_s[0]; if (uk >= 256) break;
        const int blk = 255 - uk, grp = unit_s[1], t0 = blk * 64;
        f16x8 qf[2][4];
        { NS_LANE_IDS(la);
#pragma unroll
          for (int h = 0; h < 2; ++h) { const f16* qrow = z + (size_t)(tq0 + 4 * h) * NZ + ZQ + hq * 128 + 8 * g;
#pragma unroll
            for (int ks = 0; ks < 4; ++ks) { const f16x8 q8 = *(const f16x8*)(qrow + 32 * ks);
#pragma unroll
                for (int j = 0; j < 8; ++j) qf[h][ks][j] = (f16)((float)q8[j] * c2); } } }
        f32x4 O[2][8];
#pragma unroll
        for (int h = 0; h < 2; ++h)
#pragma unroll
            for (int dt = 0; dt < 8; ++dt) O[h][dt] = (f32x4){0.f, 0.f, 0.f, 0.f};
#define NS_OROW(h) (onsa + (size_t)(tq0 + 4 * (h)) * 1024 + hq * 128 + 4 * g)
#define NS_GATE(h, k) sigmoidf_((float)z[(size_t)(tq0 + 4 * (h)) * NZ + ZGL + 8 * (k) + hq])
#define NS_CMAX(h) ((tq0 + 4 * (h)) >= 31 ? ((tq0 + 4 * (h)) - 31) >> 4 : -1)
        const int ntc = (4 * blk + 3 + 63) >> 6;
        float m[2] = {0.f, 0.f}, l[2] = {0.f, 0.f}; bool seen[2] = {false, false};
        const int cmin_w = (t0 + 8 * w) >= 31 ? (t0 + 8 * w - 31) >> 4 : -1;
#define NS_KPTR(j) (kcmp + ((size_t)(64 * (j)) * 2 + grp) * 128)
#define NS_VPTR(j) (vcmp + ((size_t)(64 * (j)) * 2 + grp) * 128)
#define NS_STRIDE 256
        { const int npc = (ntc + 1) >> 1;
#define NS_ISSUE_KPAIR(ip) do { const unsigned sa_ = lds_a + (unsigned)(((ip) & 1) * 65536); const int j0_ = 2 * (ip); ns_dma<false>(NS_KPTR(j0_), NS_STRIDE, sa_, w, lane); if (j0_ + 1 < ntc) ns_dma<false>(NS_KPTR(j0_ + 1), NS_STRIDE, sa_ + 32768u, w, lane); } while (0)
          NS_ISSUE_KPAIR(0); NS_VMW(0); __syncthreads();
          for (int ip = 0; ip < npc; ++ip) {
              if (ip + 1 < npc) NS_ISSUE_KPAIR(ip + 1);
#pragma unroll
              for (int hb = 0; hb < 2; ++hb) { const int i = 2 * ip + hb;
                  if (i < ntc) {
                      f32x4 s[2][4]; ns_qk<true, true>(s, lds + (ip & 1) * 65536 + hb * 32768, qf, lane, -m[0], -m[1]);
                      if (64 * i + 63 > cmin_w) { NS_LANE_IDS(la); const int cmax[2] = {NS_CMAX(0), NS_CMAX(1)};
                          NS_FORALL(h, kt, j) { const int c0 = 64 * i + 16 * kt + 4 * g + j; s[h][kt][j] = (c0 <= cmax[h]) ? s[h][kt][j] : -INFINITY; } }
                      ns_online<false>(s[0], m[0], l[0], seen[0], O[0]); ns_online<false>(s[1], m[1], l[1], seen[1], O[1]); } }
              NS_VMW(0); __syncthreads();
          } }
        float invl[2];
#pragma unroll
        for (int h = 0; h < 2; ++h) { l[h] += __shfl_xor(l[h], 16); l[h] += __shfl_xor(l[h], 32); invl[h] = 1.f / fmaxf(l[h], 1e-30f); }
        for (int i = lane; i < 8 * NS_PSTR; i += 64) psel[(8 * w) * NS_PSTR + i] = 0.f;
        NS_PROLOGUE(ntc, 2, true);
        for (int i = 0; i < ntc; ++i) {
            NS_STEP_BEGIN(i, ntc, 2, true);
            f32x4 s[2][4]; ns_qk<true, true>(s, NS_KB(i, 2), qf, lane, -m[0], -m[1]);
            NS_FORALL(h, kt, j) s[h][kt][j] = __builtin_amdgcn_exp2f(s[h][kt][j]) * invl[h];
            NS_LANE_IDS(la);
            if (64 * i + 63 > cmin_w) { const int cmax[2] = {NS_CMAX(0), NS_CMAX(1)};
                NS_FORALL(h, kt, j) { const int c0 = 64 * i + 16 * kt + 4 * g + j; s[h][kt][j] = (c0 <= cmax[h]) ? s[h][kt][j] : 0.f; } }
#pragma unroll
            for (int h = 0; h < 2; ++h)
#pragma unroll
                for (int kt = 0; kt < 4; ++kt) {
                    float mainv = s[h][kt][0] + s[h][kt][1] + s[h][kt][2] + 0.5f * s[h][kt][3], carry = 0.5f * s[h][kt][3];
                    mainv += __shfl_xor(mainv, 1); mainv += __shfl_xor(mainv, 2); carry += __shfl_xor(carry, 1); carry += __shfl_xor(carry, 2);
                    if (p == 0) { const int sb = 16 * i + 4 * kt + g; float* pr = (float*)(psel + (8 * w + 4 * h + q4) * NS_PSTR + sb); __hip_atomic_fetch_add(pr, mainv, __ATOMIC_RELAXED, __HIP_MEMORY_SCOPE_WORKGROUP); __hip_atomic_fetch_add(pr + 1, carry, __ATOMIC_RELAXED, __HIP_MEMORY_SCOPE_WORKGROUP); }
                }
            ns_pv<true, true>(O, NS_VB(i, 2), s, lane);
            NS_STEP_END(i, ntc, 2, true);
        }
#undef NS_KPTR
#undef NS_VPTR
#undef NS_STRIDE
#pragma unroll
        for (int h = 0; h < 2; ++h) { NS_LANE_IDS(la); float* orow = NS_OROW(h); const float gate_c = NS_GATE(h, 0);
#pragma unroll
            for (int dt = 0; dt < 8; ++dt) { *(f32x4*)(orow + 16 * dt) = O[h][dt] * gate_c; O[h][dt] = (f32x4){0.f, 0.f, 0.f, 0.f}; } }
        {
            unsigned anyw0 = 0u, anyw1 = 0u;
            NS_LANE(lt_); const int lane = (int)lt_;
            for (int qq = 0; qq < 8; ++qq) {
                const LAS float* pr = psel + (8 * w + qq) * NS_PSTR;
                unsigned myw = 0u;
                if (lane == 0) myw |= 1u;
                if (lane == (blk >> 5)) myw |= 1u << (blk & 31);
                if (blk >= 1 && lane == ((blk - 1) >> 5)) myw |= 1u << ((blk - 1) & 31);
                const int ncand = blk >= 3 ? blk - 2 : 0;
                if (ncand <= 13) { if (ncand > 0 && lane == 0) myw |= ((2u << (blk - 2)) - 1u) & ~1u; }
                else {
                    unsigned key[4];
#pragma unroll
                    for (int jj = 0; jj < 4; ++jj) { const int s = 1 + lane + 64 * jj; key[jj] = (s <= blk - 2) ? __float_as_uint(fmaxf(pr[s], 0.f)) + 1u : 0u; }
                    unsigned thr = 0u;
                    for (int bit = 31; bit >= 0; --bit) { const unsigned cand = thr | (1u << bit); int cn = 0;
#pragma unroll
                        for (int jj = 0; jj < 4; ++jj) cn += __popcll(__ballot(key[jj] >= cand));
                        if (cn >= 13) thr = cand; }
                    int cgt = 0;
#pragma unroll
                    for (int jj = 0; jj < 4; ++jj) cgt += __popcll(__ballot(key[jj] > thr));
                    int remaining = 13 - cgt;
                    unsigned long long M[4];
#pragma unroll
                    for (int jj = 0; jj < 4; ++jj) { const bool eq = key[jj] == thr; const unsigned long long em = __ballot(eq); const int c = __popcll(em);
                        const bool take_eq = eq && (__popcll(em & ((1ull << lane) - 1ull)) < remaining);
                        remaining = remaining > c ? remaining - c : 0;
                        M[jj] = __ballot(key[jj] > thr || take_eq); }
#pragma unroll
                    for (int j = 0; j < 8; ++j) { const int k = j >> 1; const unsigned long long sh = (M[k] << 1) | (k > 0 ? (M[k - 1] >> 63) : 0ull);
                        const unsigned wj = (unsigned)(sh >> (32 * (j & 1))); if (lane == j) myw |= wj; }
                }
                if (lane < 8) selb[(8 * w + qq) * 8 + lane] = myw;
                if (qq < 4) anyw0 |= myw; else anyw1 |= myw;
            }
            if (lane < 8) { wany[(w * 2) * 8 + lane] = anyw0; wany[(w * 2 + 1) * 8 + lane] = anyw1; }
        }
        __syncthreads();
        const int nlist = blk + 1;
        for (int rp_ = 0; rp_ < NSA_SELREP; ++rp_) {
        if (rp_) { asm volatile("" :: "v"(O[0][0]), "v"(O[0][7]), "v"(O[1][0]), "v"(O[1][7]), "v"(l[0]), "v"(l[1]));
#pragma unroll
            for (int h = 0; h < 2; ++h)
#pragma unroll
                for (int dt = 0; dt < 8; ++dt) O[h][dt] = (f32x4){0.f, 0.f, 0.f, 0.f}; }
        m[0] = m[1] = 0.f; l[0] = l[1] = 0.f; seen[0] = seen[1] = false;
#define NS_KPTR(j) (z + (size_t)((j) * 64) * NZ + ZKS + grp * 128)
#define NS_VPTR(j) (z + (size_t)((j) * 64) * NZ + ZVS + grp * 128)
#define NS_STRIDE NZ
        {
        const int npair = (nlist + 1) >> 1;
#define NS_ISSUE_PAIR(ip) do { const unsigned sa_ = lds_a + (unsigned)(((ip) & 1) * 65536); const int j0_ = 2 * (ip); \
            ns_dma<false>(NS_KPTR(j0_), NS_STRIDE, sa_, w, lane); ns_dma<true>(NS_VPTR(j0_), NS_STRIDE, sa_ + 16384u, w, lane); \
            if (j0_ + 1 < nlist) { ns_dma<false>(NS_KPTR(j0_ + 1), NS_STRIDE, sa_ + 32768u, w, lane); ns_dma<true>(NS_VPTR(j0_ + 1), NS_STRIDE, sa_ + 49152u, w, lane); } } while (0)
        NS_ISSUE_PAIR(0); NS_VMW(0); __syncthreads();
        unsigned cs0 = 0u, cs1 = 0u; int ca0 = 0, ca1 = 0;
        for (int ip = 0; ip < npair; ++ip) {
            if (ip + 1 < npair) NS_ISSUE_PAIR(ip + 1);
#pragma unroll
            for (int hb = 0; hb < 2; ++hb) {
                const int sb = 2 * ip + hb, bit = sb & 31;
                if (sb < nlist) {
                    if (bit == 0) { const int wi = sb >> 5; NS_LANE(la); const int q4 = (int)((la & 15u) >> 2); cs0 = selb[(8 * w + q4) * 8 + wi]; cs1 = selb[(8 * w + 4 + q4) * 8 + wi];
                        ca0 = __builtin_amdgcn_readfirstlane((int)wany[(w * 2) * 8 + wi]); ca1 = __builtin_amdgcn_readfirstlane((int)wany[(w * 2 + 1) * 8 + wi]); }
                    const bool a0 = (ca0 >> bit) & 1, a1 = (ca1 >> bit) & 1;
                    if (a0 || a1) {
                        const float i0 = ((cs0 >> bit) & 1u) ? -m[0] : -INFINITY, i1 = ((cs1 >> bit) & 1u) ? -m[1] : -INFINITY;
                        const LAS unsigned char* kb = lds + (ip & 1) * 65536 + hb * 32768;
                        f32x4 s[2][4];
#define NS_SEL_BODY(A0, A1) do { ns_qk<A0, A1>(s, kb, qf, lane, i0, i1); \
                            if (sb == blk) { NS_LANE_IDS(la); const int kp0 = sb * 64 + 4 * g; \
                                _Pragma("unroll") for (int kt = 0; kt < 4; ++kt) _Pragma("unroll") for (int j = 0; j < 4; ++j) { const int kp = kp0 + 16 * kt + j; \
                                    if (A0) s[0][kt][j] = (kp <= tq0) ? s[0][kt][j] : -INFINITY; if (A1) s[1][kt][j] = (kp <= tq0 + 4) ? s[1][kt][j] : -INFINITY; } } \
                            if (A0) ns_online<true>(s[0], m[0], l[0], seen[0], O[0]); if (A1) ns_online<true>(s[1], m[1], l[1], seen[1], O[1]); \
                            ns_pv<A0, A1>(O, kb + 16384, s, lane); } while (0)
                        if (a0 && a1) NS_SEL_BODY(true, true); else if (a0) NS_SEL_BODY(true, false); else NS_SEL_BODY(false, true);
                    }
                }
            }
            NS_VMW(0); __syncthreads();
        }
        }
#undef NS_KPTR
#undef NS_VPTR
        }
        { f32x4 ev[2][8]; float sc[2]; NS_LANE_IDS(la);
#pragma unroll
          for (int h = 0; h < 2; ++h) { l[h] += __shfl_xor(l[h], 16); l[h] += __shfl_xor(l[h], 32); sc[h] = NS_GATE(h, 1) / fmaxf(l[h], 1e-30f); const float* orow = NS_OROW(h);
#pragma unroll
              for (int dt = 0; dt < 8; ++dt) ev[h][dt] = *(const f32x4*)(orow + 16 * dt); }
#pragma unroll
          for (int h = 0; h < 2; ++h) { float* orow = NS_OROW(h);
#pragma unroll
              for (int dt = 0; dt < 8; ++dt) { *(f32x4*)(orow + 16 * dt) = ev[h][dt] + O[h][dt] * sc[h]; O[h][dt] = (f32x4){0.f, 0.f, 0.f, 0.f}; } } }
        const int wb0 = blk >= 8 ? blk - 8 : 0, nwt = blk - wb0 + 1;
        for (int rp_ = 0; rp_ < NSA_WINREP; ++rp_) {
        if (rp_) { asm volatile("" :: "v"(O[0][0]), "v"(O[0][7]), "v"(O[1][0]), "v"(O[1][7]), "v"(l[0]), "v"(l[1]));
#pragma unroll
            for (int h = 0; h < 2; ++h)
#pragma unroll
                for (int dt = 0; dt < 8; ++dt) O[h][dt] = (f32x4){0.f, 0.f, 0.f, 0.f}; }
        m[0] = m[1] = 0.f; l[0] = l[1] = 0.f; seen[0] = seen[1] = false;
#define NS_KPTR(j) (z + (size_t)((wb0 + (j)) * 64) * NZ + ZKW + grp * 128)
#define NS_VPTR(j) (z + (size_t)((wb0 + (j)) * 64) * NZ + ZVW + grp * 128)
        { const int npw = (nwt + 1) >> 1;
#define NS_ISSUE_WPAIR(ip) do { const unsigned sa_ = lds_a + (unsigned)(((ip) & 1) * 65536); const int j0_ = 2 * (ip); \
              ns_dma<false>(NS_KPTR(j0_), NS_STRIDE, sa_, w, lane); ns_dma<true>(NS_VPTR(j0_), NS_STRIDE, sa_ + 16384u, w, lane); \
              if (j0_ + 1 < nwt) { ns_dma<false>(NS_KPTR(j0_ + 1), NS_STRIDE, sa_ + 32768u, w, lane); ns_dma<true>(NS_VPTR(j0_ + 1), NS_STRIDE, sa_ + 49152u, w, lane); } } while (0)
          NS_ISSUE_WPAIR(0); NS_VMW(0); __syncthreads();
          for (int ip = 0; ip < npw; ++ip) {
              if (ip + 1 < npw) NS_ISSUE_WPAIR(ip + 1);
#pragma unroll
              for (int hb = 0; hb < 2; ++hb) { const int i = 2 * ip + hb;
                  if (i < nwt) { const int kb = wb0 + i; const LAS unsigned char* kbp = lds + (ip & 1) * 65536 + hb * 32768;
                      f32x4 s[2][4]; ns_qk<true, true>(s, kbp, qf, lane, -m[0], -m[1]);
                      if (i == 0 || i == nwt - 1) { NS_LANE_IDS(la); const int kp0 = kb * 64 + 4 * g;
                          NS_FORALL(h, kt, j) { const int kp = kp0 + 16 * kt + j, tqx = tq0 + 4 * h; s[h][kt][j] = (kp <= tqx && kp + 511 >= tqx) ? s[h][kt][j] : -INFINITY; } }
                      ns_online<true>(s[0], m[0], l[0], seen[0], O[0]); ns_online<true>(s[1], m[1], l[1], seen[1], O[1]);
                      ns_pv<true, true>(O, kbp + 16384, s, lane); } }
              NS_VMW(0); __syncthreads();
          } }
        }
#undef NS_KPTR
#undef NS_VPTR
#undef NS_STRIDE
        { f32x4 ev[2][8]; float sc[2]; NS_LANE_IDS(la);
#pragma unroll
          for (int h = 0; h < 2; ++h) { l[h] += __shfl_xor(l[h], 16); l[h] += __shfl_xor(l[h], 32); sc[h] = NS_GATE(h, 2) / fmaxf(l[h], 1e-30f); const float* orow = NS_OROW(h);
#pragma unroll
              for (int dt = 0; dt < 8; ++dt) ev[h][dt] = *(const f32x4*)(orow + 16 * dt); }
#pragma unroll
          for (int h = 0; h < 2; ++h) { float* orow = NS_OROW(h);
#pragma unroll
              for (int dt = 0; dt < 8; ++dt) *(f32x4*)(orow + 16 * dt) = ev[h][dt] + O[h][dt] * sc[h]; } }
#undef NS_OROW
#undef NS_GATE
#undef NS_CMAX
    }
}

constexpr int RS = 72, SLOT = 64 * RS * 2, RW_FS = 68, RW_GCL = 17 * SLOT;
#define RW_SLOT(lds, i) ((LAS bf16*)((lds) + (i) * SLOT))
template <int KS> __device__ __forceinline__ void mm_acc(f32x4 (&acc)[2], const LAS bf16* X, int xs, const LAS bf16* Y, int ys, int w, int lane) {
    const LAS bf16* xp = X + (16 * (w >> 1) + (lane & 15)) * xs + 8 * (lane >> 4);
    const LAS bf16* yp = Y + (32 * (w & 1) + (lane & 15)) * ys + 8 * (lane >> 4);
#pragma unroll
    for (int ks = 0; ks < KS; ++ks) { const bf16x8 av = *(const LAS bf16x8*)(xp + 32 * ks), b0 = *(const LAS bf16x8*)(yp + 32 * ks), b1 = *(const LAS bf16x8*)(yp + 16 * ys + 32 * ks);
        acc[0] = __builtin_amdgcn_mfma_f32_16x16x32_bf16(av, b0, acc[0], 0, 0, 0); acc[1] = __builtin_amdgcn_mfma_f32_16x16x32_bf16(av, b1, acc[1], 0, 0, 0); }
}
__device__ __forceinline__ void acc_zero(f32x4 (&acc)[2]) { acc[0] = (f32x4){0.f, 0.f, 0.f, 0.f}; acc[1] = (f32x4){0.f, 0.f, 0.f, 0.f}; }
__device__ __forceinline__ void st_n(const f32x4 (&acc)[2], LAS bf16* dst, int m0, int n0) {
#pragma unroll
    for (int tn = 0; tn < 2; ++tn)
#pragma unroll
        for (int r = 0; r < 4; ++r) dst[(m0 + r) * RS + n0 + 16 * tn] = (bf16)acc[tn][r];
}
__device__ __forceinline__ void st_t(const f32x4 (&acc)[2], LAS bf16* dst, int m0, int n0) {
#pragma unroll
    for (int tn = 0; tn < 2; ++tn) { const bf16x4 v = {(bf16)acc[tn][0], (bf16)acc[tn][1], (bf16)acc[tn][2], (bf16)acc[tn][3]}; *(LAS bf16x4*)(dst + (n0 + 16 * tn) * RS + m0) = v; }
}
__device__ __forceinline__ void ld_n(f32x4 (&acc)[2], const LAS bf16* src, int m0, int n0) {
#pragma unroll
    for (int tn = 0; tn < 2; ++tn)
#pragma unroll
        for (int r = 0; r < 4; ++r) acc[tn][r] = (float)src[(m0 + r) * RS + n0 + 16 * tn];
}
template <bool INCL> __device__ __forceinline__ void tri_mask(f32x4 (&acc)[2], int m0, int n0) {
#pragma unroll
    for (int tn = 0; tn < 2; ++tn)
#pragma unroll
        for (int r = 0; r < 4; ++r) { const int m = m0 + r, n = n0 + 16 * tn; if (INCL ? (n > m) : (n >= m)) acc[tn][r] = 0.f; }
}
__device__ __forceinline__ void st_acc_g(const f32x4 (&acc)[2], f16* base, int u, int w, int lane) {
#pragma unroll
    for (int tn = 0; tn < 2; ++tn) { const f16x4 v = {(f16)acc[tn][0], (f16)acc[tn][1], (f16)acc[tn][2], (f16)acc[tn][3]}; ((f16x4*)base)[((size_t)u * 16 + w * 2 + tn) * 64 + lane] = v; }
}
__device__ __forceinline__ float fast_tanh(float x) { const float e = __expf(2.f * x); return 1.f - 2.f / (e + 1.f); }

__device__ __forceinline__ void p_rwkv_local(const Args& a, LAS unsigned char* lds) {
    const int tid = opaque_tid(), lane = tid & 63, w = __builtin_amdgcn_readfirstlane(tid >> 6);
    const int m0 = 16 * (w >> 1) + 4 * (lane >> 4), n0 = 32 * (w & 1) + (lane & 15);
    const int et = tid >> 3, cg = tid & 7;
    const f16* z = (const f16*)(a.ws + WS_Z);
    unsigned char* ro = (unsigned char*)a.out;
    LAS float* FW = (LAS float*)(lds + 8 * SLOT); LAS float* FA = FW + 64 * RW_FS; LAS float* TOT = FA + 64 * RW_FS; LAS float* GCL = (LAS float*)(lds + RW_GCL); LAS float* PRM = GCL + 64;
    const int h = blockIdx.x & 15, cstep = gridDim.x >> 4, ch0 = h * 64 + 8 * cg;
    __syncthreads();
    if (tid < 64) { const int ch = h * 64 + tid; const float* mu = a.in[I_MU];
        PRM[tid] = mu[ch]; PRM[64 + tid] = mu[1024 + ch]; PRM[128 + tid] = mu[2048 + ch]; PRM[192 + tid] = mu[3072 + tid]; PRM[256 + tid] = mu[3136 + tid];
        PRM[320 + tid] = a.in[I_W0][ch]; PRM[384 + tid] = a.in[I_A0][ch]; PRM[448 + tid] = a.in[I_KK][ch]; PRM[512 + tid] = a.in[I_KA][ch]; PRM[576 + tid] = a.in[I_RK][ch]; }
    { bf16x8 id8;
#pragma unroll
      for (int e = 0; e < 8; ++e) id8[e] = (bf16)((8 * cg + e == et) ? 1.f : 0.f);
      *(LAS bf16x8*)(RW_SLOT(lds, 16) + et * RS + 8 * cg) = id8; }
    *(LAS u32x4*)(RW_SLOT(lds, 14) + et * RS + 8 * cg) = *(const u32x4*)((const bf16*)(a.ws + WS_WUPT) + (size_t)(h * 64 + et) * 64 + 8 * cg);
    *(LAS u32x4*)(RW_SLOT(lds, 15) + et * RS + 8 * cg) = *(const u32x4*)((const bf16*)(a.ws + WS_AUPT) + (size_t)(h * 64 + et) * 64 + 8 * cg);
    f16x8 zc[5], zp[5];
    const f16x8 zero8 = {0, 0, 0, 0, 0, 0, 0, 0};
#define RW_LOADZ(cc) do { const int t_ = (cc) * 64 + et; const f16* cur_ = z + (size_t)t_ * NZ; const bool hp_ = t_ > 0; \
        zc[0] = *(const f16x8*)(cur_ + ZR + ch0); zc[1] = *(const f16x8*)(cur_ + ZK + ch0); zc[2] = *(const f16x8*)(cur_ + ZV + ch0); zc[3] = *(const f16x8*)(cur_ + ZWD + 8 * cg); zc[4] = *(const f16x8*)(cur_ + ZAD + 8 * cg); \
        zp[0] = hp_ ? *(const f16x8*)(cur_ - NZ + ZR + ch0) : zero8; zp[1] = hp_ ? *(const f16x8*)(cur_ - NZ + ZK + ch0) : zero8; zp[2] = hp_ ? *(const f16x8*)(cur_ - NZ + ZV + ch0) : zero8; \
        zp[3] = hp_ ? *(const f16x8*)(cur_ - NZ + ZWD + 8 * cg) : zero8; zp[4] = hp_ ? *(const f16x8*)(cur_ - NZ + ZAD + 8 * cg) : zero8; } while (0)
    __syncthreads();
    if ((blockIdx.x >> 4) < 256) RW_LOADZ(blockIdx.x >> 4);
    asm volatile("" :: "v"(zc[0]), "v"(zc[1]), "v"(zc[2]), "v"(zc[3]), "v"(zc[4]), "v"(zp[0]), "v"(zp[1]), "v"(zp[2]), "v"(zp[3]), "v"(zp[4]));
    for (int c = blockIdx.x >> 4; c < 256; c += cstep) {
        const int t0 = c * 64, uo = h * 256 + c;
        float r_[8], k_[8], v_[8];
        { bf16x8 x1, x2;
#pragma unroll
          for (int e = 0; e < 8; ++e) { const int jj = 8 * cg + e;
              r_[e] = (float)zc[0][e] + ((float)zp[0][e] - (float)zc[0][e]) * PRM[jj]; k_[e] = (float)zc[1][e] + ((float)zp[1][e] - (float)zc[1][e]) * PRM[64 + jj]; v_[e] = (float)zc[2][e] + ((float)zp[2][e] - (float)zc[2][e]) * PRM[128 + jj];
              x1[e] = (bf16)fast_tanh((float)zc[3][e] + ((float)zp[3][e] - (float)zc[3][e]) * PRM[192 + jj]); x2[e] = (bf16)((float)zc[4][e] + ((float)zp[4][e] - (float)zc[4][e]) * PRM[256 + jj]); }
          *(LAS bf16x8*)(RW_SLOT(lds, 0) + et * RS + 8 * cg) = x1; *(LAS bf16x8*)(RW_SLOT(lds, 1) + et * RS + 8 * cg) = x2; }
        if (c + cstep < 256) RW_LOADZ(c + cstep);
        __syncthreads();
        { f32x4 acc[2]; acc_zero(acc); mm_acc<2>(acc, RW_SLOT(lds, 0), RS, RW_SLOT(lds, 14), RS, w, lane);
#pragma unroll
          for (int tn = 0; tn < 2; ++tn)
#pragma unroll
              for (int r = 0; r < 4; ++r) FW[(m0 + r) * RW_FS + n0 + 16 * tn] = acc[tn][r];
          acc_zero(acc); mm_acc<2>(acc, RW_SLOT(lds, 1), RS, RW_SLOT(lds, 15), RS, w, lane);
#pragma unroll
          for (int tn = 0; tn < 2; ++tn)
#pragma unroll
              for (int r = 0; r < 4; ++r) FA[(m0 + r) * RW_FS + n0 + 16 * tn] = acc[tn][r]; }
        __syncthreads();
        float lw_[8], kk_[8], b_[8];
        { float ss = 0.f, sb = 0.f;
#pragma unroll
          for (int e = 0; e < 8; ++e) {
              const float wpre = PRM[320 + 8 * cg + e] + FW[et * RW_FS + 8 * cg + e]; const float y0 = -wpre; const float sp = fmaxf(y0, 0.f) + __logf(1.f + __expf(-fabsf(y0)));
              lw_[e] = -__expf(-sp - 0.5f);
              const float av = sigmoidf_(PRM[384 + 8 * cg + e] + FA[et * RW_FS + 8 * cg + e]);
              const float kkr = k_[e] * PRM[448 + 8 * cg + e]; ss += kkr * kkr; kk_[e] = kkr;
              k_[e] = k_[e] * (1.f + (av - 1.f) * PRM[512 + 8 * cg + e]); b_[e] = av;
              sb += r_[e] * k_[e] * PRM[576 + 8 * cg + e]; }
          ss += __shfl_xor(ss, 1); ss += __shfl_xor(ss, 2); ss += __shfl_xor(ss, 4);
          sb += __shfl_xor(sb, 1); sb += __shfl_xor(sb, 2); sb += __shfl_xor(sb, 4);
          const float rn = rsqrtf(fmaxf(ss, 1e-24f));
#pragma unroll
          for (int e = 0; e < 8; ++e) { kk_[e] *= rn; b_[e] *= kk_[e]; FW[et * RW_FS + 8 * cg + e] = lw_[e]; }
          if (cg == 0) ((float*)(a.ws + WS_SBON))[(size_t)(t0 + et) * 16 + h] = sb; }
        __syncthreads();
        { const int j = tid & 63, rg = tid >> 6; float run = 0.f;
#pragma unroll
          for (int i = 0; i < 8; ++i) { run += FW[(8 * rg + i) * RW_FS + j]; FW[(8 * rg + i) * RW_FS + j] = run; }
          TOT[rg * 64 + j] = run;
          __syncthreads();
          float off = 0.f;
          for (int q = 0; q < rg; ++q) off += TOT[q * 64 + j];
#pragma unroll
          for (int i = 0; i < 8; ++i) FW[(8 * rg + i) * RW_FS + j] += off; }
        __syncthreads();
        { bf16x8 at, bt, kt, rt, bh, kh, vv;
#pragma unroll
          for (int e = 0; e < 8; ++e) { const int jj = 8 * cg + e; const float cum = FW[et * RW_FS + jj], cl = FW[63 * RW_FS + jj];
              const float eA = __expf(cum - lw_[e]), eN = __expf(-cum), eP = __expf(cum), eH = __expf(cl - cum);
              at[e] = (bf16)(-kk_[e] * eA); bt[e] = (bf16)(b_[e] * eN); kt[e] = (bf16)(k_[e] * eN); rt[e] = (bf16)(r_[e] * eP);
              bh[e] = (bf16)(b_[e] * eH); kh[e] = (bf16)(k_[e] * eH); vv[e] = (bf16)v_[e];
              if (et == 63) GCL[jj] = __expf(cl); }
          *(LAS bf16x8*)(RW_SLOT(lds, 0) + et * RS + 8 * cg) = at; *(LAS bf16x8*)(RW_SLOT(lds, 2) + et * RS + 8 * cg) = bt;
          *(LAS bf16x8*)(RW_SLOT(lds, 3) + et * RS + 8 * cg) = kt; *(LAS bf16x8*)(RW_SLOT(lds, 4) + et * RS + 8 * cg) = rt;
          *(LAS bf16x8*)(RW_SLOT(lds, 5) + et * RS + 8 * cg) = bh; *(LAS bf16x8*)(RW_SLOT(lds, 6) + et * RS + 8 * cg) = kh; *(LAS bf16x8*)(RW_SLOT(lds, 7) + et * RS + 8 * cg) = vv; }
        __syncthreads();
#define RW_MM(acc, XS, YS) mm_acc<2>(acc, RW_SLOT(lds, XS), RS, RW_SLOT(lds, YS), RS, w, lane)
#define RW_ST(acc, DS) st_t(acc, RW_SLOT(lds, DS), m0, n0)
        { f32x4 acc[2];
          acc_zero(acc); RW_MM(acc, 0, 16); RW_ST(acc, 1);
          acc_zero(acc); RW_MM(acc, 5, 16); RW_ST(acc, 8);
          acc_zero(acc); RW_MM(acc, 6, 16); RW_ST(acc, 9);
          acc_zero(acc); RW_MM(acc, 7, 16); RW_ST(acc, 10);
          __syncthreads();
          acc_zero(acc); RW_MM(acc, 2, 0);
#pragma unroll
          for (int tn = 0; tn < 2; ++tn)
#pragma unroll
              for (int r = 0; r < 4; ++r) if (m0 + r >= n0 + 16 * tn) acc[tn][r] = 0.f;
          RW_ST(acc, 5);
#pragma unroll
          for (int tn = 0; tn < 2; ++tn)
#pragma unroll
              for (int r = 0; r < 4; ++r) if (m0 + r == n0 + 16 * tn) acc[tn][r] = 1.f;
          RW_ST(acc, 13);
          acc_zero(acc); RW_MM(acc, 0, 2); tri_mask<false>(acc, m0, n0); RW_ST(acc, 6);
          acc_zero(acc); RW_MM(acc, 0, 3); tri_mask<false>(acc, m0, n0); RW_ST(acc, 7);
          acc_zero(acc); RW_MM(acc, 2, 4);
#pragma unroll
          for (int tn = 0; tn < 2; ++tn)
#pragma unroll
              for (int r = 0; r < 4; ++r) if (m0 + r > n0 + 16 * tn) acc[tn][r] = 0.f;
          RW_ST(acc, 11);
          acc_zero(acc); RW_MM(acc, 3, 4);
#pragma unroll
          for (int tn = 0; tn < 2; ++tn)
#pragma unroll
              for (int r = 0; r < 4; ++r) if (m0 + r > n0 + 16 * tn) acc[tn][r] = 0.f;
          RW_ST(acc, 12);
          __syncthreads();
#define RW_LDT(acc, TS) do { _Pragma("unroll") for (int tn_ = 0; tn_ < 2; ++tn_) { const bf16x4 v_ = *(const LAS bf16x4*)(RW_SLOT(lds, TS) + (n0 + 16 * tn_) * RS + m0); acc[tn_] = (f32x4){(float)v_[0], (float)v_[1], (float)v_[2], (float)v_[3]}; } } while (0)
          acc_zero(acc); RW_MM(acc, 6, 5); RW_ST(acc, 0); acc_zero(acc); RW_MM(acc, 5, 6); RW_ST(acc, 2);
          __syncthreads();
          RW_LDT(acc, 13); RW_MM(acc, 2, 13); RW_ST(acc, 3);
          acc_zero(acc); RW_MM(acc, 2, 0); RW_ST(acc, 5); acc_zero(acc); RW_MM(acc, 0, 2); RW_ST(acc, 6);
          __syncthreads();
          RW_LDT(acc, 3); RW_MM(acc, 6, 3); RW_ST(acc, 13);
          acc_zero(acc); RW_MM(acc, 6, 5); RW_ST(acc, 0); acc_zero(acc); RW_MM(acc, 5, 6); RW_ST(acc, 2);
          __syncthreads();
          RW_LDT(acc, 13); RW_MM(acc, 2, 13); RW_ST(acc, 3);
          acc_zero(acc); RW_MM(acc, 2, 0); RW_ST(acc, 5); acc_zero(acc); RW_MM(acc, 0, 2); RW_ST(acc, 6);
          __syncthreads();
          RW_LDT(acc, 3); RW_MM(acc, 6, 3); RW_ST(acc, 13);
          acc_zero(acc); RW_MM(acc, 5, 6); RW_ST(acc, 2);
          __syncthreads();
          RW_LDT(acc, 13); RW_MM(acc, 2, 13); RW_ST(acc, 3);
          __syncthreads();
          acc_zero(acc); RW_MM(acc, 3, 1); RW_ST(acc, 0);
          acc_zero(acc); RW_MM(acc, 7, 3); RW_ST(acc, 5);
          __syncthreads();
          asm volatile("" :: "v"(zc[0]), "v"(zc[1]), "v"(zc[2]), "v"(zc[3]), "v"(zc[4]), "v"(zp[0]), "v"(zp[1]), "v"(zp[2]), "v"(zp[3]), "v"(zp[4]));
          acc_zero(acc); RW_MM(acc, 5, 10); RW_ST(acc, 6);
          acc_zero(acc); RW_MM(acc, 0, 11);
#pragma unroll
          for (int tn = 0; tn < 2; ++tn) { const int tt = n0 + 16 * tn; const bf16x4 rr = *(const LAS bf16x4*)(RW_SLOT(lds, 4) + tt * RS + m0);
              const bf16x4 o = {(bf16)(acc[tn][0] + (float)rr[0]), (bf16)(acc[tn][1] + (float)rr[1]), (bf16)(acc[tn][2] + (float)rr[2]), (bf16)(acc[tn][3] + (float)rr[3])};
              *(bf16x4*)((bf16*)(ro + RO_Q) + (size_t)uo * 4096 + tt * 64 + m0) = o; }
          acc_zero(acc); RW_MM(acc, 0, 8);
#pragma unroll
          for (int tn = 0; tn < 2; ++tn) { const int jj = n0 + 16 * tn; const float gc = GCL[jj];
              const bf16x4 o = {(bf16)(acc[tn][0] + (m0 == jj ? gc : 0.f)), (bf16)(acc[tn][1] + (m0 + 1 == jj ? gc : 0.f)), (bf16)(acc[tn][2] + (m0 + 2 == jj ? gc : 0.f)), (bf16)(acc[tn][3] + (m0 + 3 == jj ? gc : 0.f))};
              *(bf16x4*)((bf16*)(ro + RO_M) + (size_t)uo * 4096 + jj * 64 + m0) = o; }
          __syncthreads();
          acc_zero(acc); RW_MM(acc, 11, 6); RW_MM(acc, 12, 10); st_acc_g(acc, (f16*)(ro + RO_Y), uo, w, lane);
          acc_zero(acc); RW_MM(acc, 6, 8); RW_MM(acc, 10, 9); st_acc_g(acc, (f16*)(ro + RO_N), uo, w, lane);
        }
#undef RW_MM
#undef RW_ST
#undef RW_LDT
    }
}
__device__ __forceinline__ void p_rwkv_scan(const Args& a, LAS unsigned char* lds, int h) {
    const int tid = opaque_tid(), lane = tid & 63, w = __builtin_amdgcn_readfirstlane(tid >> 6);
    const int m0 = 16 * (w >> 1) + 4 * (lane >> 4), n0 = 32 * (w & 1) + (lane & 15), row = tid >> 3, seg = tid & 7;
    const unsigned char* ro = (const unsigned char*)a.out;
    const bf16* Mg = (const bf16*)(ro + RO_M) + (size_t)h * 256 * 4096; const f16x4* Ng = (const f16x4*)(ro + RO_N) + (size_t)h * 256 * 1024; bf16* Sg = (bf16*)(a.ws + WS_RS) + (size_t)h * 256 * 4096;
    f32x4 acc[2]; acc_zero(acc);
    u32x4 mreg = *(const u32x4*)(Mg + row * 64 + seg * 8); f16x4 nreg[2] = {Ng[(w * 2) * 64 + lane], Ng[(w * 2 + 1) * 64 + lane]};
    for (int c = 0; c < 256; ++c) {
        LAS bf16* Sb = RW_SLOT(lds, c & 1); LAS bf16* Mb = RW_SLOT(lds, 2 + (c & 1));
        st_n(acc, Sb, m0, n0);
        *(LAS u32x4*)(Mb + row * RS + seg * 8) = mreg;
        const f16x4 nc0 = nreg[0], nc1 = nreg[1];
        if (c + 1 < 256) { mreg = *(const u32x4*)(Mg + (size_t)(c + 1) * 4096 + row * 64 + seg * 8); nreg[0] = Ng[(size_t)(c + 1) * 1024 + (w * 2) * 64 + lane]; nreg[1] = Ng[(size_t)(c + 1) * 1024 + (w * 2 + 1) * 64 + lane]; }
        __syncthreads();
        *(u32x4*)(Sg + (size_t)c * 4096 + row * 64 + seg * 8) = *(const LAS u32x4*)(Sb + row * RS + seg * 8);
        acc[0] = (f32x4){(float)nc0[0], (float)nc0[1], (float)nc0[2], (float)nc0[3]}; acc[1] = (f32x4){(float)nc1[0], (float)nc1[1], (float)nc1[2], (float)nc1[3]};
        mm_acc<2>(acc, Sb, RS, Mb, RS, w, lane);
    }
}
constexpr int RG_S = 168;
__device__ __forceinline__ void p_rwkv_out(const Args& a, LAS unsigned char* lds) {
    const int tid = opaque_tid(), lane = tid & 63, w = __builtin_amdgcn_readfirstlane(tid >> 6);
    const int m0 = 16 * (w >> 1) + 4 * (lane >> 4), n0 = 32 * (w & 1) + (lane & 15), row = tid >> 3, seg = tid & 7;
    const f16* z = (const f16*)(a.ws + WS_Z); const unsigned char* ro = (const unsigned char*)a.out; f16* mix = (f16*)(a.ws + WS_MIX);
    LAS bf16* SG = (LAS bf16*)(lds + 2 * SLOT); LAS bf16* GU = SG + 64 * RG_S; LAS float* YL = (LAS float*)(GU + 64 * RG_S); LAS float* GL = YL + 64 * RW_FS; LAS float* PRM = GL + 64 * RW_FS;
    const int h = blockIdx.x & 15, cstep = gridDim.x >> 4, et = row, cg = seg, ch0 = h * 64 + 8 * cg;
    __syncthreads();
    for (int ck = tid; ck < 64 * 20; ck += 512) { const int rr = ck / 20, c8 = ck % 20; *(LAS u32x4*)(GU + rr * RG_S + 8 * c8) = *(const u32x4*)((const bf16*)(a.ws + WS_GUPT) + (size_t)(h * 64 + rr) * 160 + 8 * c8); }
    if (tid < 160) PRM[tid] = a.in[I_MU][3200 + tid];
    if (tid < 64) { PRM[160 + tid] = a.in[I_MU][2048 + h * 64 + tid]; PRM[224 + tid] = a.in[I_LNXG][h * 64 + tid]; PRM[288 + tid] = a.in[I_LNXB][h * 64 + tid]; }
    const f16x8 zero8 = {0, 0, 0, 0, 0, 0, 0, 0};
    u32x4 qreg, sreg; f16x4 yreg[2]; f16x8 gc[3], gp[3], vc, vp; float sbn;
#define RO_LOAD(cc) do { const int uo_ = h * 256 + (cc), t0_ = (cc) * 64; \
        qreg = *(const u32x4*)((const bf16*)(ro + RO_Q) + (size_t)uo_ * 4096 + row * 64 + seg * 8); sreg = *(const u32x4*)((const bf16*)(a.ws + WS_RS) + (size_t)uo_ * 4096 + row * 64 + seg * 8); \
        { const f16x4* Yg_ = (const f16x4*)(ro + RO_Y) + (size_t)uo_ * 1024; yreg[0] = Yg_[(w * 2) * 64 + lane]; yreg[1] = Yg_[(w * 2 + 1) * 64 + lane]; } \
        _Pragma("unroll") for (int i_ = 0; i_ < 3; ++i_) { const int ck_ = tid + 512 * i_; if (ck_ < 64 * 20) { const int t_ = t0_ + ck_ / 20; const f16* cur_ = z + (size_t)t_ * NZ + ZGD + 8 * (ck_ % 20); gc[i_] = *(const f16x8*)cur_; gp[i_] = t_ > 0 ? *(const f16x8*)(cur_ - NZ) : zero8; } } \
        { const int t_ = t0_ + et; const f16* cur_ = z + (size_t)t_ * NZ + ZV + ch0; vc = *(const f16x8*)cur_; vp = t_ > 0 ? *(const f16x8*)(cur_ - NZ) : zero8; sbn = ((const float*)(a.ws + WS_SBON))[(size_t)t_ * 16 + h]; } } while (0)
    RO_LOAD(blockIdx.x >> 4);
    asm volatile("" :: "v"(qreg), "v"(sreg), "v"(yreg[0]), "v"(yreg[1]), "v"(gc[0]), "v"(gp[0]), "v"(gc[1]), "v"(gp[1]), "v"(gc[2]), "v"(gp[2]), "v"(vc), "v"(vp), "v"(sbn));
    for (int c = blockIdx.x >> 4; c < 256; c += cstep) {
        const int t0 = c * 64;
        __syncthreads();
        *(LAS u32x4*)(RW_SLOT(lds, 0) + row * RS + seg * 8) = qreg; *(LAS u32x4*)(RW_SLOT(lds, 1) + row * RS + seg * 8) = sreg;
#pragma unroll
        for (int i = 0; i < 3; ++i) { const int ck = tid + 512 * i; if (ck < 64 * 20) { const int rr = ck / 20, c8 = ck % 20; bf16x8 o;
#pragma unroll
            for (int e = 0; e < 8; ++e) o[e] = (bf16)sigmoidf_((float)gc[i][e] + ((float)gp[i][e] - (float)gc[i][e]) * PRM[8 * c8 + e]);
            *(LAS bf16x8*)(SG + rr * RG_S + 8 * c8) = o; } }
        f32x4 y[2], g[2];
        y[0] = (f32x4){(float)yreg[0][0], (float)yreg[0][1], (float)yreg[0][2], (float)yreg[0][3]}; y[1] = (f32x4){(float)yreg[1][0], (float)yreg[1][1], (float)yreg[1][2], (float)yreg[1][3]};
        const f16x8 vcc = vc, vpp = vp; const float sbc = sbn;
        if (c + cstep < 256) RO_LOAD(c + cstep);
        __syncthreads();
        mm_acc<2>(y, RW_SLOT(lds, 0), RS, RW_SLOT(lds, 1), RS, w, lane);
        acc_zero(g); mm_acc<5>(g, SG, RG_S, GU, RG_S, w, lane);
#pragma unroll
        for (int tn = 0; tn < 2; ++tn)
#pragma unroll
            for (int r = 0; r < 4; ++r) { YL[(m0 + r) * RW_FS + n0 + 16 * tn] = y[tn][r]; GL[(m0 + r) * RW_FS + n0 + 16 * tn] = g[tn][r]; }
        __syncthreads();
        { const int t = t0 + et;
          float yv[8], gv[8]; float s1 = 0.f, s2 = 0.f;
#pragma unroll
          for (int e = 0; e < 8; ++e) { yv[e] = YL[et * RW_FS + 8 * cg + e]; gv[e] = GL[et * RW_FS + 8 * cg + e]; s1 += yv[e]; s2 += yv[e] * yv[e]; }
          s1 += __shfl_xor(s1, 1); s1 += __shfl_xor(s1, 2); s1 += __shfl_xor(s1, 4);
          s2 += __shfl_xor(s2, 1); s2 += __shfl_xor(s2, 2); s2 += __shfl_xor(s2, 4);
          const float mean = s1 * (1.f / 64.f), var = fmaxf(s2 * (1.f / 64.f) - mean * mean, 0.f), rstd = rsqrtf(var + 64e-5f);
          f16x8 o;
#pragma unroll
          for (int e = 0; e < 8; ++e) { const int jj = 8 * cg + e; const float vv = (float)vcc[e] + ((float)vpp[e] - (float)vcc[e]) * PRM[160 + jj];
              const float yn = (yv[e] - mean) * rstd * PRM[224 + jj] + PRM[288 + jj]; o[e] = (f16)((yn + sbc * vv) * gv[e]); }
          asm volatile("" :: "v"(qreg), "v"(sreg), "v"(yreg[0]), "v"(yreg[1]), "v"(gc[0]), "v"(gp[0]), "v"(gc[1]), "v"(gp[1]), "v"(gc[2]), "v"(gp[2]), "v"(vc), "v"(vp), "v"(sbn));
          *(f16x8*)(mix + (size_t)t * D + 1024 + ch0) = o; }
    }
}

constexpr int RT_XS = 2048 + 8;
__device__ __forceinline__ void p_router(const Args& a, LAS unsigned char* lds, int rep) {
    const int tid = opaque_tid(), lane = tid & 63, wave = __builtin_amdgcn_readfirstlane(tid >> 6);
    const float* x2 = (const float*)(a.ws + WS_X1); f16* h3 = (f16*)a.out;
    unsigned* ctl = (unsigned*)(a.ws + WS_CTL);
    int* tke = (int*)(a.ws + WS_TOK + TK_E); float* tkw = (float*)(a.ws + WS_TOK + TK_W);
    const f16* WH = (const f16*)(a.ws + WS_WRH); const f16* WL = (const f16*)(a.ws + WS_WRL);
    LAS float* PART = (LAS float*)lds;
    LAS float* SSP = PART + 8 * 16 * 48;
    LAS float* LG = SSP + 128;
    LAS float* RSTD = LG + 16 * 48;
    LAS float* XT = RSTD + 16;
    const int row = lane & 15, kq = lane >> 4;
    for (int tile = blockIdx.x; tile < T / 16; tile += gridDim.x) {
        const int r0 = tile * 16;
        f32x4 acc[3]; acc[0] = (f32x4){0.f, 0.f, 0.f, 0.f}; acc[1] = acc[0]; acc[2] = acc[0];
        float ss = 0.f;
        const float* xp = x2 + (size_t)(r0 + row) * D + 256 * wave + 8 * kq;
        const f16* whp = WH + (size_t)row * D + 256 * wave + 8 * kq; const f16* wlp = WL + (size_t)row * D + 256 * wave + 8 * kq;
#pragma unroll 1
        for (int kb = 0; kb < 2; ++kb) {
            f32x4 xa[4], xb[4]; f16x8 bh[4][3], bl[4][3];
#pragma unroll
            for (int k4 = 0; k4 < 4; ++k4) { const int ks = kb * 4 + k4; xa[k4] = *(const f32x4*)(xp + 32 * ks); xb[k4] = *(const f32x4*)(xp + 32 * ks + 4);
#pragma unroll
                for (int nt = 0; nt < 3; ++nt) { bh[k4][nt] = *(const f16x8*)(whp + (size_t)nt * 16 * D + 32 * ks); bl[k4][nt] = *(const f16x8*)(wlp + (size_t)nt * 16 * D + 32 * ks); } }
            asm volatile("s_waitcnt vmcnt(0)" ::: "memory");
#pragma unroll
            for (int k4 = 0; k4 < 4; ++k4) {
                { LAS float* xd = XT + row * RT_XS + 256 * wave + 32 * (kb * 4 + k4) + 8 * kq; *(LAS f32x4*)xd = xa[k4]; *(LAS f32x4*)(xd + 4) = xb[k4]; }
                ss += xa[k4].x * xa[k4].x + xa[k4].y * xa[k4].y + xa[k4].z * xa[k4].z + xa[k4].w * xa[k4].w + xb[k4].x * xb[k4].x + xb[k4].y * xb[k4].y + xb[k4].z * xb[k4].z + xb[k4].w * xb[k4].w;
                f16x8 hi, lo;
#pragma unroll
                for (int j = 0; j < 4; ++j) { hi[j] = (f16)xa[k4][j]; lo[j] = (f16)(xa[k4][j] - (float)hi[j]); hi[4 + j] = (f16)xb[k4][j]; lo[4 + j] = (f16)(xb[k4][j] - (float)hi[4 + j]); }
#pragma unroll
                for (int nt = 0; nt < 3; ++nt) {
                    acc[nt] = __builtin_amdgcn_mfma_f32_16x16x32_f16(hi, bh[k4][nt], acc[nt], 0, 0, 0); acc[nt] = __builtin_amdgcn_mfma_f32_16x16x32_f16(lo, bh[k4][nt], acc[nt], 0, 0, 0); acc[nt] = __builtin_amdgcn_mfma_f32_16x16x32_f16(hi, bl[k4][nt], acc[nt], 0, 0, 0); }
            }
        }
        ss += __shfl_xor(ss, 16); ss += __shfl_xor(ss, 32);
        __syncthreads();
        if (kq == 0) SSP[wave * 16 + row] = ss;
#pragma unroll
        for (int nt = 0; nt < 3; ++nt)
#pragma unroll
            for (int r = 0; r < 4; ++r) PART[(wave * 16 + 4 * kq + r) * 48 + 16 * nt + row] = acc[nt][r];
        __syncthreads();
        for (int i = tid; i < 16 * 48; i += 512) { float v = 0.f;
#pragma unroll
            for (int ww = 0; ww < 8; ++ww) v += PART[ww * 768 + i];
            LG[i] = v; }
        if (tid < 16) { float v = 0.f;
#pragma unroll
            for (int ww = 0; ww < 8; ++ww) v += SSP[ww * 16 + tid];
            RSTD[tid] = rsqrtf(v * (1.f / D) + EPS); }
        __syncthreads();
        if (tid < 16) {
            const float rs = RSTD[tid]; const LAS float* L = LG + tid * 48;
            float lg[4];
#pragma unroll
            for (int c = 0; c < 4; ++c) lg[c] = L[c] * rs + a.in[I_RGB][c];
            int gi = 0; float gm = lg[0];
#pragma unroll
            for (int c = 1; c < 4; ++c) if (lg[c] > gm) { gm = lg[c]; gi = c; }
            float gs = 0.f;
#pragma unroll
            for (int c = 0; c < 4; ++c) gs += __expf(lg[c] - gm);
            const float pg = 1.f / gs;
            float le[8];
#pragma unroll
            for (int c = 0; c < 8; ++c) le[c] = L[4 + gi * 8 + c] * rs + a.in[I_REB][gi * 8 + c];
            int e1 = 0; float m1 = le[0];
#pragma unroll
            for (int c = 1; c < 8; ++c) if (le[c] > m1) { m1 = le[c]; e1 = c; }
            int e2 = -1; float m2 = -INFINITY;
#pragma unroll
            for (int c = 0; c < 8; ++c) if (c != e1 && le[c] > m2) { m2 = le[c]; e2 = c; }
            const float p2 = __expf(m2 - m1);
            const float w1 = pg / (1.f + p2), w2 = pg * p2 / (1.f + p2);
            const int m = r0 + tid, E1 = gi * 8 + e1, E2 = gi * 8 + e2; tke[m * 2] = E1; tke[m * 2 + 1] = E2; tkw[m * 2] = w1; tkw[m * 2 + 1] = w2;
            atomicAdd(&ctl[CW_CNT + rep * 8000 + E1], 1u); atomicAdd(&ctl[CW_CNT + rep * 8000 + E2], 1u);
        }
        { f32x4 xv[2][8], gg[8]; const f32x4* gr = (const f32x4*)a.in[I_LN3] + lane;
#pragma unroll
          for (int j = 0; j < 8; ++j) gg[j] = gr[64 * j];
#pragma unroll
          for (int rr2 = 0; rr2 < 2; ++rr2) { const LAS f32x4* xr = (const LAS f32x4*)(XT + (wave * 2 + rr2) * RT_XS) + lane;
#pragma unroll
              for (int j = 0; j < 8; ++j) xv[rr2][j] = xr[64 * j]; }
#pragma unroll
          for (int rr2 = 0; rr2 < 2; ++rr2) { const int rr = wave * 2 + rr2; const float rs = RSTD[rr]; u32x2* o8 = (u32x2*)(h3 + (size_t)(r0 + rr) * D) + lane;
#pragma unroll
              for (int j = 0; j < 8; ++j) { const f32x4 v = xv[rr2][j]; u32x2 wv; wv.x = pkh(v.x * rs * gg[j].x, v.y * rs * gg[j].y); wv.y = pkh(v.z * rs * gg[j].z, v.w * rs * gg[j].w); o8[64 * j] = wv; } } }
        __syncthreads();
    }
}
__device__ __forceinline__ void p_slots(const Args& a, LAS unsigned char* lds, int rep) {
    unsigned* ctl = (unsigned*)(a.ws + WS_CTL);
    const int* tke = (const int*)(a.ws + WS_TOK + TK_E); const float* tkw = (const float*)(a.ws + WS_TOK + TK_W); int* tks = (int*)(a.ws + WS_TOK + TK_SLOT);
    int* stok = (int*)(a.ws + WS_TOK + TK_STOK); float* sw = (float*)(a.ws + WS_TOK + TK_SW);
    const int tid = opaque_tid(), lane = tid & 63;
    LAS int* offl = (LAS int*)lds; LAS int* cntl = offl + 64;
    __syncthreads();
    if (tid < 64) {
        const int n = lane < NEXP ? (int)ctl[CW_CNT + lane] : 0, nt = (n + 255) >> 8;
        int pre = nt;
#pragma unroll
        for (int o = 1; o < 32; o <<= 1) { const int v = __shfl_up(pre, o); if ((lane & 31) >= o) pre += v; }
        const int tb = pre - nt;
        if (lane < NEXP) { offl[lane] = tb * 256; cntl[lane] = n; }
        if (lane == NEXP - 1) offl[NEXP] = pre * 256;
        if (blockIdx.x == 0 && lane < NEXP) {
            int2* ugu = (int2*)(ctl + CW_UGU); int2* udn = (int2*)(ctl + CW_UDN);
            for (int rt = 0; rt < nt; ++rt) { const int pm = tb + rt;
#pragma unroll
                for (int jt = 0; jt < 2; ++jt) ugu[pm * 2 + jt] = make_int2(pm, lane * 2 + jt);
#pragma unroll
                for (int jt = 0; jt < 8; ++jt) udn[pm * 8 + jt] = make_int2(pm, lane * 8 + jt); }
            if (lane == NEXP - 1) { ctl[CW_NT] = (unsigned)pre; ctl[CW_NGU] = (unsigned)(pre * 2); ctl[CW_NDN] = (unsigned)(pre * 8); }
        }
    }
    __syncthreads();
    if (blockIdx.x == 0 && rep == 0) {
        for (int e = 0; e < NEXP; ++e) { const int end = offl[e + 1];
            for (int sl = offl[e] + cntl[e] + tid; sl < end; sl += 512) { stok[sl] = 0; sw[sl] = 0.f; } } }
    LAS int* hist = cntl + 64; LAS int* gbase = hist + 64;
    for (int base = blockIdx.x * 512; base < T * 2; base += gridDim.x * 512) {
        __syncthreads();
        if (tid < 64) hist[tid] = 0;
        __syncthreads();
        const int i = base + tid; const bool ok = i < T * 2; const int e = ok ? tke[i] : 0;
        int rank = 0; if (ok) rank = __hip_atomic_fetch_add((int*)(hist + e), 1, __ATOMIC_RELAXED, __HIP_MEMORY_SCOPE_WORKGROUP);
        __syncthreads();
        if (tid < NEXP) { const int c = hist[tid]; gbase[tid] = c ? (int)atomicAdd(&ctl[CW_CUR + rep * 8000 + tid], (unsigned)c) : 0; }
        __syncthreads();
        if (ok) { const int slot = offl[e] + gbase[e] + rank; stok[slot] = i >> 1; sw[slot] = tkw[i]; tks[i] = slot; }
    }
}


constexpr int NPH = 17;
__global__ void __launch_bounds__(512, 2) mega(Args args) {
    extern __shared__ __attribute__((aligned(16))) unsigned char lds_raw[];
    LAS unsigned char* lds = (LAS unsigned char*)lds_raw;
    volatile LAS unsigned* MISC = (volatile LAS unsigned*)(lds + MISC_OFF);
    const int G = gridDim.x;
#define PH_IDS const int tid = opaque_tid(), lane = tid & 63, wave = tid >> 6, gw = blockIdx.x * 8 + wave, NGW = gridDim.x * 8; (void)tid; (void)lane; (void)gw; (void)NGW
    unsigned char* ws = args.ws;
    unsigned* ctl = (unsigned*)(ws + WS_CTL);
    if (threadIdx.x < 128) ((LAS unsigned*)(lds + MISC_OFF))[threadIdx.x] = 0u;
    __syncthreads();
    XcdBarrier bar; bar.bar = ctl + CW_BAR; bar.x = 0; bar.st = nullptr;
    const int lo = args.ph_lo, hi = args.ph_hi;
    if (hi - lo > 1 || DUPMASK != 0u) bar = xcd_barrier_post(ctl + CW_BAR, MISC + 8);
#ifndef PHMASK
#define PHMASK 0xFFFFFFFFu
#endif
#define IN(k) (((PHMASK >> (k)) & 1u) && lo <= (k) && (k) < hi)
#define BOTH(k) (IN(k) && IN((k) + 1))
#define GRID_BAR() xcd_barrier(bar)
#define NREP(k) ((((DUPMASK) >> (k)) & 1u) ? 2 : 1)

    for (int rep_ = 0; rep_ < NREP(0); ++rep_) if (IN(0)) { p0_prologue(args, lds); if (BOTH(0) || rep_ + 1 < NREP(0)) GRID_BAR(); }
    for (int rep_ = 0; rep_ < NREP(1); ++rep_) if (IN(1)) {
        { pg8::Gemm g{(const f16*)(ws + WS_H), (const f16*)(ws + WS_WIN), D, D, D, nullptr}; pg8::StaticOrder S; S.init(T, NZ, G, (int)blockIdx.x);
          pg8::EpiF16 E{(f16*)(ws + WS_Z), NZ, 1.f}; pg8::gemm_phase<pg8::EpiF16, pg8::StaticOrder, true>(lds, g, S, E); }
        if (BOTH(1) || rep_ + 1 < NREP(1)) GRID_BAR();
    }
    for (int rep_ = 0; rep_ < NREP(2); ++rep_) if (IN(2)) {
        for (int r2_ = 0; r2_ < ((DUPX & 1) ? 2 : 1); ++r2_) { p_compress(args, lds); __syncthreads(); }
        for (int r2_ = 0; r2_ < ((DUPX & 2) ? 2 : 1); ++r2_) { p_rwkv_local(args, lds); __syncthreads(); }
        if (BOTH(2) || rep_ + 1 < NREP(2)) GRID_BAR();
    }
    for (int rep_ = 0; rep_ < NREP(3); ++rep_) if (IN(3)) {
        if (blockIdx.x < 16) p_rwkv_scan(args, lds, blockIdx.x);
        else if (blockIdx.x < 32 && rep_ == 0) { const int b = blockIdx.x - 16; const int which = b / 8;
            pg8::Gemm g{(const f16*)(ws + WS_MEMN), (const f16*)(ws + (which == 0 ? WS_WKT : WS_WVT)), D, D, D, nullptr}; pg8::StaticOrder S; S.init(256, D, 8, b % 8);
            pg8::EpiF16 E{(f16*)(ws + (which == 0 ? WS_KM : WS_VM)), D, 1.f}; pg8::gemm_phase<pg8::EpiF16, pg8::StaticOrder, true>(lds, g, S, E); }
        __syncthreads();
        p_nsa(args, lds, rep_);
        if (BOTH(3) || rep_ + 1 < NREP(3)) GRID_BAR();
    }
    for (int rep_ = 0; rep_ < NREP(5); ++rep_) if (IN(5)) {
        p_rwkv_out(args, lds);
        __syncthreads();
        PH_IDS;
        if (blockIdx.x < 64) { const int b = blockIdx.x; const int grp = b / 8, c = b % 8;
          if (grp < 4) { const int h = grp;
              pg8::Gemm g{(const f16*)(ws + WS_KM) + h * 512, (const f16*)(ws + WS_WQ16) + h * 512, D, D, 512, nullptr}; pg8::StaticOrder S; S.init(256, D, 8, c);
              pg8::EpiF16 E{(f16*)(ws + WS_WQK) + (size_t)h * 256 * D, D, 0.04419417382415922f}; pg8::gemm_phase<pg8::EpiF16, pg8::StaticOrder, true>(lds, g, S, E); }
          else { const int h = grp - 4;
              pg8::Gemm g{(const f16*)(ws + WS_WOT) + h * 512, (const f16*)(ws + WS_VM) + h * 512, D, D, 512, nullptr}; pg8::StaticOrder S; S.init(D, 256, 8, c);
              pg8::EpiF16 E{(f16*)(ws + WS_VOT) + h * 256, 1024, 1.f}; pg8::gemm_phase<pg8::EpiF16, pg8::StaticOrder, true>(lds, g, S, E); } }
        else {
        const float* onsa = (const float*)(ws + WS_ONSA); f16* mix = (f16*)(ws + WS_MIX);
        for (int m = gw - 64 * 8; m < T; m += NGW - 64 * 8) { const f32x4* xr = (const f32x4*)(onsa + (size_t)m * 1024) + lane; f32x4 v[4]; float s = 0.f;
#pragma unroll
            for (int j = 0; j < 4; ++j) { v[j] = xr[64 * j]; s += v[j].x * v[j].x + v[j].y * v[j].y + v[j].z * v[j].z + v[j].w * v[j].w; }
            const f32x4* gr = (const f32x4*)args.in[I_NSAG] + lane; f32x4 gg[4];
#pragma unroll
            for (int j = 0; j < 4; ++j) gg[j] = gr[64 * j];
            const float rstd = rsqrtf(wave_sum(s) * (1.f / 1024.f) + EPS); u32x2* o8 = (u32x2*)(mix + (size_t)m * D) + lane;
#pragma unroll
            for (int j = 0; j < 4; ++j) { u32x2 w; w.x = pkh(v[j].x * rstd * gg[j].x, v[j].y * rstd * gg[j].y); w.y = pkh(v[j].z * rstd * gg[j].z, v[j].w * rstd * gg[j].w); o8[64 * j] = w; } }
        }
        if (BOTH(5) || rep_ + 1 < NREP(5)) GRID_BAR();
    }
    for (int rep_ = 0; rep_ < NREP(6); ++rep_) if (IN(6)) {
        pg8::Gemm g{(const f16*)(ws + WS_MIX), (const f16*)(ws + WS_WOUT), D, D, D, nullptr}; pg8::StaticOrder S; S.init(T, D, G, (int)blockIdx.x);
        pg8::EpiRes16 E{(float*)(ws + WS_X1), args.in[I_X], (f16*)(ws + WS_H2), (float*)(ws + WS_CTL + WS_ROWSS), D}; pg8::gemm_phase<pg8::EpiRes16, pg8::StaticOrder, true>(lds, g, S, E);
        if (BOTH(6) || rep_ + 1 < NREP(6)) GRID_BAR();
    }
    for (int rep_ = 0; rep_ < NREP(7); ++rep_) if (IN(7)) {
        PH_IDS;
        p_moe_weights(args, lds);
        if (BOTH(7) || rep_ + 1 < NREP(7)) GRID_BAR();
    }
    for (int rep_ = 0; rep_ < NREP(8); ++rep_) if (IN(8)) {
        pg8::Gemm g{(const f16*)(ws + WS_H2), (const f16*)(ws + WS_WQK), D, D, D, nullptr}; pg8::StaticOrder S; S.init(T, 1024, G, (int)blockIdx.x);
        pg8::EpiSoftmax E{(f16*)(ws + WS_P), 1024, (const float*)(ws + WS_CTL + WS_ROWSS), (LAS float*)(lds + RING_BYTES), (LAS float*)(lds + RING_BYTES + 4096)}; pg8::gemm_phase<pg8::EpiSoftmax, pg8::StaticOrder, true>(lds, g, S, E);
        if (BOTH(8) || rep_ + 1 < NREP(8)) GRID_BAR();
    }
    for (int rep_ = 0; rep_ < NREP(10); ++rep_) if (IN(10)) {
        pg8::Gemm g{(const f16*)(ws + WS_P), (const f16*)(ws + WS_VOT), 1024, 1024, 1024, nullptr}; pg8::StaticOrder S; S.init(T, D, G, (int)blockIdx.x);
        pg8::EpiF32 E{(float*)(ws + WS_X1), (const float*)(ws + WS_X1), D}; pg8::gemm_phase<pg8::EpiF32, pg8::StaticOrder, true>(lds, g, S, E);
        if (BOTH(10) || rep_ + 1 < NREP(10)) GRID_BAR();
    }
    for (int rep_ = 0; rep_ < NREP(11); ++rep_) if (IN(11)) { p_router(args, lds, rep_); if (BOTH(11) || rep_ + 1 < NREP(11)) GRID_BAR(); }
    for (int rep_ = 0; rep_ < NREP(13); ++rep_) if (IN(13)) { p_slots(args, lds, rep_); if (BOTH(13) || rep_ + 1 < NREP(13)) GRID_BAR(); }
    for (int rep_ = 0; rep_ < NREP(14); ++rep_) if (IN(14)) {
        pg8::Gemm g{(const f16*)args.out, (const f16*)(ws + WS_WGU), D, D, D, (const int*)(ws + WS_TOK + TK_STOK)};
        pg8::TableOrder S{(const int2*)(ctl + CW_UGU), (int)ctl[CW_NGU], G, (int)blockIdx.x};
        pg8::EpiSilu E{(f16*)(ws + WS_HID)}; pg8::gemm_phase<pg8::EpiSilu, pg8::TableOrder, true, true>(lds, g, S, E);
        if (BOTH(14) || rep_ + 1 < NREP(14)) GRID_BAR();
    }
    for (int rep_ = 0; rep_ < NREP(15); ++rep_) if (IN(15)) {
        pg8::Gemm g{(const f16*)(ws + WS_HID), (const f16*)(ws + WS_WD), EFF, EFF, EFF, nullptr};
        pg8::TableOrder S{(const int2*)(ctl + CW_UDN), (int)ctl[CW_NDN], G, (int)blockIdx.x};
        pg8::EpiDown E{ws}; pg8::gemm_phase<pg8::EpiDown, pg8::TableOrder, true>(lds, g, S, E);
        if (BOTH(15) || rep_ + 1 < NREP(15)) GRID_BAR();
    }
    for (int rep_ = 0; rep_ < NREP(16); ++rep_) if (IN(16)) {
        PH_IDS;
        const float* x2 = (const float*)(ws + WS_X1); const int* tks = (const int*)(ws + WS_TOK + TK_SLOT);
        const float* tkw = (const float*)(ws + WS_TOK + TK_W);
        for (int m0_ = gw; m0_ < T; m0_ += 2 * NGW) {
            const int mm[2] = {m0_, (m0_ + NGW < T) ? m0_ + NGW : m0_};
            int sa[2][2]; float wa[2][2];
#pragma unroll
            for (int q = 0; q < 2; ++q) { sa[q][0] = tks[mm[q] * 2]; sa[q][1] = tks[mm[q] * 2 + 1]; wa[q][0] = tkw[mm[q] * 2]; wa[q][1] = tkw[mm[q] * 2 + 1]; }
            f32x4 v[2][8]; f16x4 ya[2][2][8];
#pragma unroll
            for (int q = 0; q < 2; ++q) { const f32x4* xr = (const f32x4*)(x2 + (size_t)mm[q] * D) + lane;
#pragma unroll
                for (int j = 0; j < 8; ++j) v[q][j] = xr[64 * j];
#pragma unroll
                for (int k = 0; k < 2; ++k) { const int sl = sa[q][k]; const f16* yp = (const f16*)(ws + ((sl >> 8) < 128 ? WS_Y0 + (size_t)(sl >> 8) * MiB : WS_Y1 + (size_t)((sl >> 8) - 128) * MiB)) + (size_t)(sl & 255) * D;
#pragma unroll
                    for (int j = 0; j < 8; ++j) ya[q][k][j] = *((const f16x4*)yp + lane + 64 * j); } }
            const f32x4* gr = (const f32x4*)args.in[I_LNF] + lane; f32x4 gg[8];
#pragma unroll
            for (int j = 0; j < 8; ++j) gg[j] = gr[64 * j];
#pragma unroll
            for (int q = 0; q < 2; ++q) { float s = 0.f; const float w1 = wa[q][0], w2 = wa[q][1];
#pragma unroll
                for (int j = 0; j < 8; ++j) { const f16x4 a1 = ya[q][0][j], a2 = ya[q][1][j];
                    v[q][j].x += w1 * (float)a1.x + w2 * (float)a2.x; v[q][j].y += w1 * (float)a1.y + w2 * (float)a2.y; v[q][j].z += w1 * (float)a1.z + w2 * (float)a2.z; v[q][j].w += w1 * (float)a1.w + w2 * (float)a2.w;
                    s += v[q][j].x * v[q][j].x + v[q][j].y * v[q][j].y + v[q][j].z * v[q][j].z + v[q][j].w * v[q][j].w; }
                const float rstd = rsqrtf(wave_sum(s) * (1.f / D) + EPS);
                if (q == 0 || mm[1] != mm[0]) { f32x4* o = (f32x4*)(args.out + (size_t)mm[q] * D) + lane;
#pragma unroll
                    for (int j = 0; j < 8; ++j) o[64 * j] = (f32x4){v[q][j].x * rstd * gg[j].x, v[q][j].y * rstd * gg[j].y, v[q][j].z * rstd * gg[j].z, v[q][j].w * rstd * gg[j].w}; } }
        }
    }
#undef IN
#undef BOTH
#undef GRID_BAR
}

extern "C" void kernel_launch(void* const* d_in, const int* in_sizes, int n_in, void* d_out, int out_size, void* d_ws, size_t ws_size, hipStream_t stream) {
    static int grid = 0;
    if (grid == 0) {
        if (n_in != 38 || out_size != T * D || ws_size < WS_END) { fprintf(stderr, "kernel_launch: unexpected shapes (n_in %d out %d ws %zu)\n", n_in, out_size, ws_size); grid = -1; return; }
        int dev = 0, cus = 0;
        if (hipGetDevice(&dev) != hipSuccess || hipDeviceGetAttribute(&cus, hipDeviceAttributeMultiprocessorCount, dev) != hipSuccess) { grid = -1; return; }
        if (hipFuncSetAttribute((const void*)mega, hipFuncAttributeMaxDynamicSharedMemorySize, LDS_BYTES) != hipSuccess) { grid = -1; return; }
        int per_cu = 0; (void)hipOccupancyMaxActiveBlocksPerMultiprocessor(&per_cu, (const void*)mega, 512, LDS_BYTES); (void)hipGetLastError();
        grid = cus;
    }
    if (grid < 0) return;
    (void)hipMemsetAsync((char*)d_ws + WS_CTL, 0, CTL_ZERO_BYTES, stream);
    Args a{};
    for (int i = 0; i < 38; ++i) a.in[i] = (const float*)d_in[i];
    a.out = (float*)d_out; a.ws = (unsigned char*)d_ws;
#if MK_ONE_LAUNCH
    a.ph_lo = 0; a.ph_hi = NPH;
    hipLaunchKernelGGL(mega, dim3(grid), dim3(512), LDS_BYTES, stream, a);
#else
    for (int p = 0; p < NPH; ++p) { a.ph_lo = p; a.ph_hi = p + 1; hipLaunchKernelGGL(mega, dim3(grid), dim3(512), LDS_BYTES, stream, a); }
#endif
}
```

```cpp
#include <hip/hip_runtime.h>
#include <cstdio>
#include <cstdint>

#ifndef DUPMASK
#define DUPMASK 0u
#endif
#ifndef NSA_PROBE_DMA
#define NSA_PROBE_DMA 0
#endif
#ifndef NSA_SELREP
#define NSA_SELREP 1
#endif
#ifndef NSA_CMPREP
#define NSA_CMPREP 1
#endif
#ifndef NSA_WINREP
#define NSA_WINREP 1
#endif
#ifndef DUPX
#define DUPX 0
#endif
#ifndef NSA_DECOUPLED
#define NSA_DECOUPLED 0
#endif
#ifndef MK_ONE_LAUNCH
#define MK_ONE_LAUNCH 1
#endif

#define LAS __attribute__((address_space(3)))
#define GAS __attribute__((address_space(1)))
typedef _Float16 f16;
typedef _Float16 f16x8 __attribute__((ext_vector_type(8)));
typedef _Float16 f16x4 __attribute__((ext_vector_type(4)));
typedef _Float16 f16x2 __attribute__((ext_vector_type(2)));
typedef float f32x4 __attribute__((ext_vector_type(4)));
typedef float f32x2 __attribute__((ext_vector_type(2)));
typedef unsigned u32x4 __attribute__((ext_vector_type(4)));
typedef unsigned u32x2 __attribute__((ext_vector_type(2)));
typedef __bf16 bf16;
typedef __bf16 bf16x8 __attribute__((ext_vector_type(8)));
typedef __bf16 bf16x4 __attribute__((ext_vector_type(4)));

constexpr int T = 16384, D = 2048, NZ = 6144;
constexpr int ZQ = 0, ZKC = 1024, ZVC = 1280, ZKS = 1536, ZVS = 1792, ZKW = 2048, ZVW = 2304, ZR = 2560, ZK = 3584, ZV = 4608, ZWD = 5632, ZAD = 5696, ZGD = 5760, ZGL = 5920;
constexpr int NCMP = 1023;
constexpr int NEXP = 32, EFF = 256, MAXSLOT = 40960, MAXTILES = 160;
constexpr float EPS = 1e-6f;

constexpr size_t MiB = 1u << 20;
constexpr size_t WS_CTL = 0, CTL_ZERO_BYTES = 256 * 1024, WS_ROWSS = 128 * 1024, WS_ROWSS2 = 192 * 1024;
constexpr size_t WS_MEMN = 1 * MiB, WS_KM = 2 * MiB, WS_VM = 3 * MiB, WS_KCMP = 4 * MiB, WS_VCMP = 5 * MiB, WS_TOK = 6 * MiB, WS_CMPB = 7 * MiB;
constexpr size_t WS_WQK = 8 * MiB, WS_VOT = 12 * MiB, WS_WIN = 16 * MiB, WS_WOUT = 40 * MiB, WS_WQ16 = 48 * MiB, WS_WKT = 56 * MiB, WS_WVT = 64 * MiB, WS_WOT = 72 * MiB;
constexpr size_t WS_WGU = 80 * MiB, WS_WD = 144 * MiB, WS_H = 176 * MiB, WS_Z = 240 * MiB, WS_ONSA = 432 * MiB, WS_END = 512 * MiB;
constexpr size_t WS_MIX = 112 * MiB, WS_P = WS_H, WS_H2 = WS_Z, WS_X1 = 304 * MiB, WS_S = WS_ONSA, WS_HID = 16 * MiB;
constexpr size_t WS_Y0 = 176 * MiB, WS_Y1 = 432 * MiB;
constexpr size_t WS_RS = 200 * MiB, WS_SBON = 232 * MiB;
constexpr size_t WS_WUPT = WS_CMPB + 64 * 1024, WS_AUPT = WS_WUPT + 128 * 1024, WS_GUPT = WS_AUPT + 128 * 1024;
constexpr size_t WS_W1T = 496 * MiB, WS_W2T = 498 * MiB, WS_CBIAS = 498 * MiB + 65536;
constexpr size_t WS_WRH = 499 * MiB, WS_WRL = 499 * MiB + 256 * 1024;
constexpr size_t RO_M = 0, RO_N = 32 * MiB, RO_Q = 64 * MiB, RO_Y = 96 * MiB;
constexpr size_t TK_E = 0, TK_W = 128 * 1024, TK_SLOT = 256 * 1024, TK_STOK = 384 * 1024, TK_SW = 576 * 1024, TK_SRS = 768 * 1024;
constexpr int CW_BAR = 0;
constexpr int CW_Q = 3584;
constexpr int CW_CNT = 4096, CW_CUR = 4160, CW_OFF = 4224, CW_NT = 4288  , CW_NGU = 4289, CW_NDN = 4290;
constexpr int CW_UGU = 6144  , CW_UDN = 8192  ;
static_assert((CW_UDN + MAXTILES * 8 * 2) * 4 <= (int)CTL_ZERO_BYTES, "ctl");

constexpr int RING_BYTES = 131072, LDS_BYTES = 163840, MISC_OFF = LDS_BYTES - 512;

__device__ __forceinline__ unsigned pkh(float a, float b) { f16x2 v = {(f16)a, (f16)b}; return __builtin_bit_cast(unsigned, v); }
__device__ __forceinline__ float wave_sum(float v) {
#pragma unroll
    for (int o = 1; o < 64; o <<= 1) v += __shfl_xor(v, o);
    return v;
}
__device__ __forceinline__ float wave_max(float v) {
#pragma unroll
    for (int o = 1; o < 64; o <<= 1) v = fmaxf(v, __shfl_xor(v, o));
    return v;
}
__device__ __forceinline__ int opaque_tid() { int t = threadIdx.x; asm volatile("" : "+v"(t)); return t; }
#define LDS_WAIT() asm volatile("s_waitcnt lgkmcnt(0)" ::: "memory")
#define VM_WAIT() asm volatile("s_waitcnt vmcnt(0)" ::: "memory")
__device__ __forceinline__ float sigmoidf_(float x) { return 1.f / (1.f + __expf(-x)); }

namespace pg8 {
constexpr int BM = 256, BK = 64, HALF = 128, HTB = HALF * BK * 2, STAGE_BYTES = 8 * HTB, NXCD = 8, WGM = 8;
__host__ __device__ __forceinline__ int lds_byte(int r, int c) { const int st = (r >> 4) * 2 + (c >> 5), rr = r & 15, cc = c & 31, ob = rr * 64 + cc * 2; return st * 1024 + (ob ^ (((ob >> 9) & 1) << 5)); }
__host__ __device__ __forceinline__ void stage_rc(int b, int& R, int& C) { const int st = b / 1024, sb = b % 1024, swz = sb ^ (((sb >> 9) & 1) << 5); R = (st >> 1) * 16 + swz / 64; C = (st & 1) * 32 + (swz % 64) / 2; }
__host__ __device__ __forceinline__ int perm32(int rho) { const int n = rho >> 4, i = rho & 15; return 8 * (i >> 2) + 4 * n + (i & 3); }

struct Unit { int pm, pn; };
struct Gemm { const f16* A; const f16* Bt; int lda, ldb, K; const int* gather; };

struct StaticOrder {
    int nM, nN, nwg, G, c;
    __host__ __device__ void init(int M, int N, int G_, int c_) { nM = M / BM; nN = N / BM; nwg = nM * nN; G = G_; c = c_; }
    __host__ __device__ bool next(int i, Unit& u) const {
        const long L = (long)i * G + c; if (L >= nwg) return false;
        int wgid = (int)L; { const int q = nwg / NXCD, r = nwg % NXCD, xcd = wgid % NXCD, off = wgid / NXCD; wgid = (xcd < r ? xcd * (q + 1) : r * (q + 1) + (xcd - r) * q) + off; }
        const int nig = WGM * nN, gid = wgid / nig, fm = gid * WGM, gsz = (nM - fm) < WGM ? (nM - fm) : WGM;
        u.pm = fm + ((wgid % nig) % gsz); u.pn = (wgid % nig) / gsz; return true;
    }
};
struct TableOrder {
    const int2* tab; int n, G, c;
    __device__ bool next(int i, Unit& u) const { const int L = i * G + c; if (L >= n) return false; const int2 v = tab[L]; u.pm = v.x; u.pn = v.y; return true; }
};

struct EpiF16 {
    static constexpr bool PERM = true;
    f16* O; int ldc; float scale;
    __device__ __forceinline__ void operator()(const f32x4 (&acc)[2][2][4][2], const Unit& u, int wr, int wc, int fr, int fq) const {
        const int row0 = u.pm * BM + wr * 64 + fr, col0 = u.pn * BM + wc * 32 + 8 * fq;
#pragma unroll
        for (int ai = 0; ai < 2; ++ai)
#pragma unroll
            for (int m = 0; m < 4; ++m) { f16* rowp = O + (size_t)(row0 + ai * HALF + m * 16) * ldc + col0;
#pragma unroll
                for (int bj = 0; bj < 2; ++bj) { const f32x4 v0 = acc[ai][bj][m][0] * scale, v1 = acc[ai][bj][m][1] * scale;
                    u32x4 w; w.x = pkh(v0[0], v0[1]); w.y = pkh(v0[2], v0[3]); w.z = pkh(v1[0], v1[1]); w.w = pkh(v1[2], v1[3]);
                    *(u32x4*)(rowp + bj * HALF) = w; } }
    }
};
struct EpiF32 {
    static constexpr bool PERM = false;
    float* C; const float* R; int ldc;
    __device__ __forceinline__ void operator()(const f32x4 (&acc)[2][2][4][2], const Unit& u, int wr, int wc, int fr, int fq) const {
        const int row0 = u.pm * BM + wr * 64 + fr, col0 = u.pn * BM + wc * 32 + 4 * fq;
#pragma unroll
        for (int ai = 0; ai < 2; ++ai)
#pragma unroll
            for (int m = 0; m < 4; ++m) { const size_t ro = (size_t)(row0 + ai * HALF + m * 16) * ldc + col0;
#pragma unroll
                for (int bj = 0; bj < 2; ++bj)
#pragma unroll
                    for (int n = 0; n < 2; ++n) { f32x4 v = acc[ai][bj][m][n]; if (R) v = v + *(const f32x4*)(R + ro + bj * HALF + n * 16); *(f32x4*)(C + ro + bj * HALF + n * 16) = v; } }
    }
};
struct EpiRes16 {
    static constexpr bool PERM = false;
    float* C; const float* R; f16* H; float* rowss; int ldc;
    __device__ __forceinline__ void operator()(const f32x4 (&acc)[2][2][4][2], const Unit& u, int wr, int wc, int fr, int fq) const {
        const int row0 = u.pm * BM + wr * 64 + fr, col0 = u.pn * BM + wc * 32 + 4 * fq;
#pragma unroll
        for (int ai = 0; ai < 2; ++ai)
#pragma unroll
            for (int m = 0; m < 4; ++m) { const int row = row0 + ai * HALF + m * 16; const size_t ro = (size_t)row * ldc + col0; float ss = 0.f;
                f32x4 v[2][2];
#pragma unroll
                for (int bj = 0; bj < 2; ++bj)
#pragma unroll
                    for (int n = 0; n < 2; ++n) v[bj][n] = acc[ai][bj][m][n] + *(const f32x4*)(R + ro + bj * HALF + n * 16);
#pragma unroll
                for (int bj = 0; bj < 2; ++bj)
#pragma unroll
                    for (int n = 0; n < 2; ++n) { const f32x4 x = v[bj][n]; *(f32x4*)(C + ro + bj * HALF + n * 16) = x; ss += x.x * x.x + x.y * x.y + x.z * x.z + x.w * x.w;
                        u32x2 hw; hw.x = pkh(x.x, x.y); hw.y = pkh(x.z, x.w); *(u32x2*)(H + ro + bj * HALF + n * 16) = hw; }
                ss += __shfl_xor(ss, 16); ss += __shfl_xor(ss, 32);
                if (fq == 0) atomicAdd(rowss + row, ss); }
    }
};
struct EpiSoftmax {
    static constexpr bool PERM = true;
    f16* O; int ldc; const float* rowss; LAS float* xm; LAS float* xs;
    __device__ __forceinline__ void operator()(const f32x4 (&acc)[2][2][4][2], const Unit& u, int wr, int wc, int fr, int fq) const {
        const int row0 = u.pm * BM + wr * 64 + fr, col0 = u.pn * BM + wc * 32 + 8 * fq;
        float rs[2][4], mx[2][4];
#pragma unroll
        for (int ai = 0; ai < 2; ++ai)
#pragma unroll
            for (int m = 0; m < 4; ++m) { rs[ai][m] = rsqrtf(rowss[row0 + ai * HALF + m * 16] * (1.f / D) + EPS); float v = -INFINITY;
#pragma unroll
                for (int bj = 0; bj < 2; ++bj)
#pragma unroll
                    for (int n = 0; n < 2; ++n)
#pragma unroll
                        for (int e = 0; e < 4; ++e) v = fmaxf(v, acc[ai][bj][m][n][e]);
                v *= rs[ai][m]; v = fmaxf(v, __shfl_xor(v, 16)); v = fmaxf(v, __shfl_xor(v, 32));
                if (fq == 0) xm[(ai * HALF + wr * 64 + m * 16 + fr) * 4 + wc] = v; }
        asm volatile("s_waitcnt lgkmcnt(0)" ::: "memory"); __builtin_amdgcn_s_barrier(); asm volatile("" ::: "memory");
        float e_[2][4][16]; float inv[2][4];
#pragma unroll
        for (int ai = 0; ai < 2; ++ai)
#pragma unroll
            for (int m = 0; m < 4; ++m) { const LAS f32x4* q = (const LAS f32x4*)(xm + (ai * HALF + wr * 64 + m * 16 + fr) * 4); const f32x4 mm = *q; mx[ai][m] = fmaxf(fmaxf(mm.x, mm.y), fmaxf(mm.z, mm.w)); float sm = 0.f;
#pragma unroll
                for (int bj = 0; bj < 2; ++bj)
#pragma unroll
                    for (int n = 0; n < 2; ++n)
#pragma unroll
                        for (int e = 0; e < 4; ++e) { const float ev = __expf(acc[ai][bj][m][n][e] * rs[ai][m] - mx[ai][m]); e_[ai][m][bj * 8 + n * 4 + e] = ev; sm += ev; }
                sm += __shfl_xor(sm, 16); sm += __shfl_xor(sm, 32);
                if (fq == 0) xs[(ai * HALF + wr * 64 + m * 16 + fr) * 4 + wc] = sm; }
        asm volatile("s_waitcnt lgkmcnt(0)" ::: "memory"); __builtin_amdgcn_s_barrier(); asm volatile("" ::: "memory");
#pragma unroll
        for (int ai = 0; ai < 2; ++ai)
#pragma unroll
            for (int m = 0; m < 4; ++m) { const f32x4 ssum = *(const LAS f32x4*)(xs + (ai * HALF + wr * 64 + m * 16 + fr) * 4); inv[ai][m] = 1.f / ((ssum.x + ssum.y) + (ssum.z + ssum.w));
                f16* rowp = O + (size_t)(row0 + ai * HALF + m * 16) * ldc + col0;
#pragma unroll
                for (int bj = 0; bj < 2; ++bj) { const float* ee = &e_[ai][m][bj * 8]; const float iv = inv[ai][m];
                    u32x4 w; w.x = pkh(ee[0] * iv, ee[1] * iv); w.y = pkh(ee[2] * iv, ee[3] * iv); w.z = pkh(ee[4] * iv, ee[5] * iv); w.w = pkh(ee[6] * iv, ee[7] * iv);
                    *(u32x4*)(rowp + bj * HALF) = w; } }
    }
};
struct EpiSilu {
    static constexpr bool PERM = true;
    f16* O; const float* srs;
    __device__ __forceinline__ void operator()(const f32x4 (&acc)[2][2][4][2], const Unit& u, int wr, int wc, int fr, int fq) const {
        const int row0 = u.pm * BM + wr * 64 + fr, col0 = (u.pn & 1) * 128 + wc * 32 + 8 * fq;
        float rsv[2][4];
#pragma unroll
        for (int ai = 0; ai < 2; ++ai)
#pragma unroll
            for (int m = 0; m < 4; ++m) rsv[ai][m] = srs[row0 + ai * HALF + m * 16];
#pragma unroll
        for (int ai = 0; ai < 2; ++ai)
#pragma unroll
            for (int m = 0; m < 4; ++m) { f16* rowp = O + (size_t)(row0 + ai * HALF + m * 16) * EFF + col0; const float rs = rsv[ai][m];
                float h[8];
#pragma unroll
                for (int n = 0; n < 2; ++n)
#pragma unroll
                    for (int e = 0; e < 4; ++e) { const float gt = acc[ai][0][m][n][e] * rs, up = acc[ai][1][m][n][e] * rs; h[n * 4 + e] = gt / (1.f + __expf(-gt)) * up; }
                u32x4 w; w.x = pkh(h[0], h[1]); w.y = pkh(h[2], h[3]); w.z = pkh(h[4], h[5]); w.w = pkh(h[6], h[7]);
                *(u32x4*)rowp = w; }
    }
};
struct EpiDown {
    static constexpr bool PERM = true;
    unsigned char* ws;
    __device__ __forceinline__ void operator()(const f32x4 (&acc)[2][2][4][2], const Unit& u, int wr, int wc, int fr, int fq) const {
        f16* tile = (f16*)(ws + (u.pm < 128 ? WS_Y0 + (size_t)u.pm * MiB : WS_Y1 + (size_t)(u.pm - 128) * MiB));
        const int r0 = wr * 64 + fr, col0 = (u.pn & 7) * BM + wc * 32 + 8 * fq;
#pragma unroll
        for (int ai = 0; ai < 2; ++ai)
#pragma unroll
            for (int m = 0; m < 4; ++m) { f16* rowp = tile + (size_t)(r0 + ai * HALF + m * 16) * D + col0;
#pragma unroll
                for (int bj = 0; bj < 2; ++bj) { const f32x4 v0 = acc[ai][bj][m][0], v1 = acc[ai][bj][m][1];
                    u32x4 w; w.x = pkh(v0[0], v0[1]); w.y = pkh(v0[2], v0[3]); w.z = pkh(v1[0], v1[1]); w.w = pkh(v1[2], v1[3]);
                    *(u32x4*)(rowp + bj * HALF) = w; } }
    }
};

template <class Epi, class Sched, bool ALIGN_EPI, bool GATHER = false>
__device__ __forceinline__ void gemm_phase(LAS unsigned char* lds, const Gemm g, const Sched& S, const Epi& E) {
    const int tid = opaque_tid(), wid = __builtin_amdgcn_readfirstlane(tid >> 6), lane = tid & 63, wr = wid >> 2, wc = wid & 3, fr = lane & 15, fq = lane >> 4;
    const int K = g.K, nt = K / BK;
    int RA[2], CA[2]; unsigned voffA[2], voffB[2];
#pragma unroll
    for (int i = 0; i < 2; ++i) { int R, C; stage_rc(tid * 16 + i * 8192, R, C); const int Rb = Epi::PERM ? ((R & ~31) + perm32(R & 31)) : R;
        RA[i] = R; CA[i] = C; voffA[i] = (unsigned)(R * g.lda + C) * 2u; voffB[i] = (unsigned)(Rb * g.ldb + C) * 2u; }
    const size_t kstep = (size_t)(BK * 2);
    const size_t hstepA = (size_t)HALF * g.lda * 2, tstepA = 2 * hstepA;
    const size_t hstepB = (size_t)HALF * g.ldb * 2, tstepB = 2 * hstepB;
    const unsigned ldsw = (unsigned)wid * 1024u;
    const int aoff = lds_byte(wr * 64 + fr, fq * 8), boff = lds_byte(wc * 32 + fr, fq * 8);
    const char* Ab = (const char*)g.A;
#define PG8_SA(b, h) (((b) * 2 + (h)) * HTB)
#define PG8_SB(b, h) ((4 + (b) * 2 + (h)) * HTB)
#define PG8_STAGE(bufoff, gbase, voff) do { _Pragma("unroll") for (int _i = 0; _i < 2; ++_i) \
        __builtin_amdgcn_global_load_lds((const unsigned*)((const char*)(gbase) + (voff)[_i]), (LAS unsigned*)(lds + (bufoff) + ldsw + _i * 8192), 16, 0, 0); } while (0)
#define PG8_STA_CUR(bufoff, h, kb) do { if constexpr (GATHER) { PG8_STAGE(bufoff, Ab + (kb), offC[h]); } else { PG8_STAGE(bufoff, cA + (h) * hstepA + (kb), voffA); } } while (0)
#define PG8_STA_SEL(bufoff, h, kb) do { if constexpr (GATHER) { PG8_STAGE(bufoff, Ab + (kb), o2[h]); } else { PG8_STAGE(bufoff, a2p + (h) * hstepA + (kb), voffA); } } while (0)
#define PG8_LDA(dst, b, h) do { _Pragma("unroll") for (int m = 0; m < 4; ++m) _Pragma("unroll") for (int k = 0; k < 2; ++k) dst[m][k] = *(const LAS f16x8*)(lds + PG8_SA(b, h) + aoff + m * 2048 + k * 1024); } while (0)
#define PG8_LDB(dst, b, h) do { _Pragma("unroll") for (int n = 0; n < 2; ++n) _Pragma("unroll") for (int k = 0; k < 2; ++k) dst[n][k] = *(const LAS f16x8*)(lds + PG8_SB(b, h) + boff + n * 2048 + k * 1024); } while (0)
#define PG8_MMA(ai, bj, At, Bt) do { __builtin_amdgcn_s_setprio(1); _Pragma("unroll") for (int m = 0; m < 4; ++m) _Pragma("unroll") for (int n = 0; n < 2; ++n) _Pragma("unroll") for (int k = 0; k < 2; ++k) \
        acc[ai][bj][m][n] = __builtin_amdgcn_mfma_f32_16x16x32_f16(Bt[n][k], At[m][k], acc[ai][bj][m][n], 0, 0, 0); __builtin_amdgcn_s_setprio(0); } while (0)
#define PG8_WAIT_V(n) asm volatile("s_waitcnt vmcnt(" #n ")" ::: "memory")
#define PG8_WAIT_L(n) asm volatile("s_waitcnt lgkmcnt(" #n ")" ::: "memory")
#define PG8_BAR __builtin_amdgcn_s_barrier()
#define PG8_SCHED __builtin_amdgcn_sched_barrier(0)
#define PG8_OFFS(dst, U) do { _Pragma("unroll") for (int _h = 0; _h < 2; ++_h) _Pragma("unroll") for (int _i = 0; _i < 2; ++_i) { \
        const int _r = (U).pm * BM + _h * HALF + RA[_i]; dst[_h][_i] = ((unsigned)g.gather[_r] * (unsigned)g.lda + (unsigned)CA[_i]) * 2u; } } while (0)
    Unit cur, nxt; int ui = 0;
    if (!S.next(0, cur)) return;
    f32x4 acc[2][2][4][2];
#pragma unroll
    for (int a = 0; a < 2; ++a)
#pragma unroll
        for (int b = 0; b < 2; ++b)
#pragma unroll
            for (int m = 0; m < 4; ++m)
#pragma unroll
                for (int n = 0; n < 2; ++n) acc[a][b][m][n] = (f32x4){0.f, 0.f, 0.f, 0.f};
    f16x8 At[4][2], B0[2][2], B1[2][2];
    unsigned offC[2][2], offN[2][2];
    if constexpr (GATHER) { PG8_OFFS(offC, cur); }
    const char* cA = Ab + (size_t)cur.pm * tstepA;
    const char* cB = (const char*)g.Bt + (size_t)cur.pn * tstepB;
    PG8_STAGE(PG8_SB(0, 0), cB, voffB); PG8_STAGE(PG8_SB(0, 1), cB + hstepB, voffB); PG8_STA_CUR(PG8_SA(0, 0), 0, 0); PG8_STA_CUR(PG8_SA(0, 1), 1, 0);
    if (wr == 1) PG8_BAR;
    PG8_WAIT_V(2); PG8_BAR;
    PG8_STAGE(PG8_SB(1, 0), cB + kstep, voffB); PG8_STA_CUR(PG8_SA(1, 0), 0, kstep); PG8_STAGE(PG8_SB(1, 1), cB + hstepB + kstep, voffB);
    PG8_WAIT_V(6); PG8_BAR;
    for (;;) {
        const bool has_next = S.next(ui + 1, nxt);
        if constexpr (GATHER) {
            if (has_next) { PG8_OFFS(offN, nxt); } else {
#pragma unroll
                for (int _h = 0; _h < 2; ++_h)
#pragma unroll
                    for (int _i = 0; _i < 2; ++_i) offN[_h][_i] = offC[_h][_i]; } }
        const char* nA = has_next ? Ab + (size_t)nxt.pm * tstepA : cA;
        const char* nB = has_next ? (const char*)g.Bt + (size_t)nxt.pn * tstepB : cB;
#pragma nounroll
        for (int t = 0; t < nt; t += 2) {
            const bool last = (t == nt - 2);
            const size_t kb1 = (size_t)(t + 1) * kstep;
            const size_t kb2 = last ? 0 : (size_t)(t + 2) * kstep, kb3 = kb2 + kstep;
            unsigned o2[2][2];
            if constexpr (GATHER) {
#pragma unroll
                for (int _h = 0; _h < 2; ++_h)
#pragma unroll
                    for (int _i = 0; _i < 2; ++_i) o2[_h][_i] = last ? offN[_h][_i] : offC[_h][_i]; }
            const char* a2p = last ? nA : cA;
            const char* b2 = last ? nB : cB + (size_t)(t + 2) * kstep; const char* b3 = b2 + kstep;
            PG8_LDB(B0, 0, 0); PG8_LDB(B1, 0, 1); PG8_SCHED; PG8_LDA(At, 0, 0); PG8_STA_CUR(PG8_SA(1, 1), 1, kb1);
            PG8_WAIT_V(8); PG8_WAIT_L(0); PG8_BAR; PG8_MMA(0, 0, At, B0); PG8_MMA(0, 1, At, B1); PG8_BAR; PG8_SCHED;
            PG8_LDA(At, 0, 1); PG8_STAGE(PG8_SB(0, 0), b2, voffB); PG8_STAGE(PG8_SB(0, 1), b2 + hstepB, voffB); PG8_STA_SEL(PG8_SA(0, 0), 0, kb2);
            PG8_WAIT_V(8); PG8_WAIT_L(0); PG8_BAR; PG8_MMA(1, 0, At, B0); PG8_MMA(1, 1, At, B1); PG8_BAR; PG8_SCHED;
            PG8_LDB(B0, 1, 0); PG8_LDB(B1, 1, 1); PG8_SCHED; PG8_LDA(At, 1, 0); PG8_STA_SEL(PG8_SA(0, 1), 1, kb2);
            PG8_WAIT_V(8); PG8_WAIT_L(0); PG8_BAR; PG8_MMA(0, 0, At, B0); PG8_MMA(0, 1, At, B1); PG8_BAR; PG8_SCHED;
            PG8_LDA(At, 1, 1); PG8_STAGE(PG8_SB(1, 0), b3, voffB); PG8_STAGE(PG8_SB(1, 1), b3 + hstepB, voffB); PG8_STA_SEL(PG8_SA(1, 0), 0, kb3);
            PG8_WAIT_V(8); PG8_WAIT_L(0); PG8_BAR; PG8_MMA(1, 0, At, B0); PG8_MMA(1, 1, At, B1); PG8_BAR; PG8_SCHED;
        }
        if constexpr (ALIGN_EPI) { if (wr == 0) PG8_BAR; }
        E(acc, cur, wr, wc, fr, fq);
        if (!has_next) break;
#pragma unroll
        for (int a = 0; a < 2; ++a)
#pragma unroll
            for (int b = 0; b < 2; ++b)
#pragma unroll
                for (int m = 0; m < 4; ++m)
#pragma unroll
                    for (int n = 0; n < 2; ++n) acc[a][b][m][n] = (f32x4){0.f, 0.f, 0.f, 0.f};
        cur = nxt; cA = nA; cB = nB; ++ui;
        if constexpr (GATHER) {
#pragma unroll
            for (int _h = 0; _h < 2; ++_h)
#pragma unroll
                for (int _i = 0; _i < 2; ++_i) offC[_h][_i] = offN[_h][_i]; }
        if constexpr (ALIGN_EPI) { if (wr == 1) PG8_BAR; }
    }
    PG8_WAIT_V(0);
    if constexpr (!ALIGN_EPI) { if (wr == 0) PG8_BAR; }
    PG8_BAR;
#undef PG8_SA
#undef PG8_SB
#undef PG8_STAGE
#undef PG8_STA_CUR
#undef PG8_STA_SEL
#undef PG8_LDA
#undef PG8_LDB
#undef PG8_MMA
#undef PG8_WAIT_V
#undef PG8_WAIT_L
#undef PG8_BAR
#undef PG8_SCHED
#undef PG8_OFFS
}
}

#define XB_TMO      128
#define XB_XCNT(j)  (256  + 64 * (j))
#define XB_XSUB(j)  (1280 + 64 * (j))
#define XB_XGEN(j)  (2304 + 64 * (j))
#define XB_TOP      3328
#define XB_TOPGEN   3392
#define XCD_BAR_WORDS 3456
#define XB_SPIN_CAP (1u << 22)
__device__ __forceinline__ unsigned xb_ld(unsigned* p)              { return __hip_atomic_load(p, __ATOMIC_RELAXED, __HIP_MEMORY_SCOPE_AGENT); }
__device__ __forceinline__ unsigned xb_add(unsigned* p, unsigned v) { return __hip_atomic_fetch_add(p, v, __ATOMIC_RELAXED, __HIP_MEMORY_SCOPE_AGENT); }
__device__ __forceinline__ unsigned xb_xcc_id() { return (unsigned)__builtin_amdgcn_s_getreg((3 << 11) | 20) & 0xFu; }
#define XB_SPIN(cond, bar) do { unsigned _sp = 0; while (cond) { __builtin_amdgcn_s_sleep(1); \
    if ((++_sp & 255u) == 0u) { if (xb_ld(&(bar)[XB_TMO])) break; if (_sp > XB_SPIN_CAP) { atomicAdd(&(bar)[XB_TMO], 1u); break; } } } } while (0)
struct XcdBarrier { unsigned* bar; unsigned x; volatile LAS unsigned* st; };
__device__ __forceinline__ XcdBarrier xcd_barrier_post(unsigned* bar, volatile LAS unsigned* st) {
    XcdBarrier b; b.bar = bar; b.x = xb_xcc_id(); b.st = st;
    if (threadIdx.x == 0) (void)xb_add(&bar[XB_XCNT(b.x)], 1u);
    return b;
}
__device__ __forceinline__ void xcd_barrier_complete(unsigned* bar, unsigned x, unsigned& nloc, unsigned& nx) {
    const unsigned G = gridDim.x * gridDim.y * gridDim.z;
    unsigned sum, cnt, mine, sp = 0u;
    for (;;) {
        sum = 0u; cnt = 0u; mine = 0u;
#pragma unroll
        for (unsigned j = 0; j < 16; ++j) { const unsigned c = xb_ld(&bar[XB_XCNT(j)]); sum += c; cnt += (c > 0u) ? 1u : 0u; mine = (j == x) ? c : mine; }
        if (sum == G) break;
        __builtin_amdgcn_s_sleep(1);
        if ((++sp & 255u) == 0u) { if (xb_ld(&bar[XB_TMO])) break; if (sp > XB_SPIN_CAP) { atomicAdd(&bar[XB_TMO], 1u); break; } }
    }
    nloc = mine > 0u ? mine : 1u; nx = cnt > 0u ? cnt : 1u;
}
__device__ __forceinline__ void xcd_barrier(const XcdBarrier& b) {
    asm volatile("s_waitcnt vmcnt(0)" ::: "memory");
    __syncthreads();
    if (threadIdx.x == 0) {
        unsigned* bar = b.bar;
        __builtin_amdgcn_s_waitcnt(0);
        unsigned nloc = b.st[0], nx = b.st[1];
        if (nloc == 0u) { xcd_barrier_complete(bar, b.x, nloc, nx); b.st[0] = nloc; b.st[1] = nx; }
        const unsigned old = xb_add(&bar[XB_XSUB(b.x)], 1u);
        const unsigned gen = old / nloc;
        if (old + 1u == (gen + 1u) * nloc) {
            __builtin_amdgcn_fence(__ATOMIC_RELEASE, "agent");
            asm volatile("s_waitcnt vmcnt(0)" ::: "memory");
            const unsigned og = xb_add(&bar[XB_TOP], 1u);
            const unsigned tg = og / nx;
            if (og + 1u == (tg + 1u) * nx) xb_add(&bar[XB_TOPGEN], 1u);
            else XB_SPIN(xb_ld(&bar[XB_TOPGEN]) == tg, bar);
            __builtin_amdgcn_fence(__ATOMIC_ACQUIRE, "agent");
            xb_add(&bar[XB_XGEN(b.x)], 1u);
            asm volatile("s_waitcnt vmcnt(0)" ::: "memory");
        } else {
            XB_SPIN(xb_ld(&bar[XB_XGEN(b.x)]) == gen, bar);
            __builtin_amdgcn_fence(__ATOMIC_ACQUIRE, "agent");
            asm volatile("s_waitcnt vmcnt(0)" ::: "memory");
        }
    }
    __syncthreads();
}

struct Args { const float* in[38]; float* out; unsigned char* ws; int ph_lo, ph_hi; };
enum { I_X = 0, I_MEM, I_LN1, I_WIN, I_PK, I_W1K, I_W2K, I_PV, I_W1V, I_W2V, I_NSAG, I_MU, I_W0, I_WUP, I_A0, I_AUP, I_GUP, I_KK, I_KA, I_RK, I_LNXG, I_LNXB,
       I_WOUT, I_LNMEM, I_LN2, I_WQ, I_WK, I_WV, I_WO, I_LN3, I_RGW, I_RGB, I_REW, I_REB, I_MG, I_MU2, I_MD, I_LNF };

struct TrItem { float tv[32]; f16* dst; size_t drow0; int dld, k0; };
__device__ __forceinline__ void tr_load(TrItem& it, const float* src, int sld, int k0, int scol0, int nvalid, f16* dst, size_t drow0, int dld, int lane) {
    const int nl = lane & 31; it.dst = dst; it.drow0 = drow0; it.dld = dld; it.k0 = k0;
#pragma unroll
    for (int i = 0; i < 32; ++i) { const int kk = 2 * i + (lane >> 5); it.tv[i] = (nl < nvalid) ? src[(size_t)(k0 + kk) * sld + scol0 + nl] : 0.f; }
}
__device__ __forceinline__ void tr_load_scaled(TrItem& it, const float* src, const float* ksc, int sld, int k0, int scol0, f16* dst, size_t drow0, int dld, int lane) {
    const int nl = lane & 31; it.dst = dst; it.drow0 = drow0; it.dld = dld; it.k0 = k0;
    float gv[32];
#pragma unroll
    for (int i = 0; i < 32; ++i) { const int kk = 2 * i + (lane >> 5); it.tv[i] = src[(size_t)(k0 + kk) * sld + scol0 + nl]; gv[i] = ksc[k0 + kk]; }
#pragma unroll
    for (int i = 0; i < 32; ++i) it.tv[i] *= gv[i];
}
__device__ __forceinline__ void tr_finish(const TrItem& it, LAS float* scr, int lane) {
    const int nl = lane & 31;
#pragma unroll
    for (int i = 0; i < 32; ++i) { const int kk = 2 * i + (lane >> 5); scr[kk * 33 + nl] = it.tv[i]; }
    LDS_WAIT(); asm volatile("" ::: "memory");
    const int c = lane & 7;
#pragma unroll
    for (int j = 0; j < 4; ++j) { const int n = (lane >> 3) + 8 * j; const LAS float* s = scr + (8 * c) * 33 + n;
        u32x4 o; o.x = pkh(s[0 * 33], s[1 * 33]); o.y = pkh(s[2 * 33], s[3 * 33]); o.z = pkh(s[4 * 33], s[5 * 33]); o.w = pkh(s[6 * 33], s[7 * 33]);
        *(u32x4*)(it.dst + (it.drow0 + n) * (size_t)it.dld + it.k0 + 8 * c) = o; }
    LDS_WAIT(); asm volatile("" ::: "memory");
}
__device__ __forceinline__ void tr_item(const float* src, int sld, int k0, int scol0, int nvalid, f16* dst, size_t drow0, int dld, LAS float* scr, int lane) {
    TrItem it; tr_load(it, src, sld, k0, scol0, nvalid, dst, drow0, dld, lane); tr_finish(it, scr, lane);
}
__device__ __forceinline__ void tr_matrix(const float* src, int K, int N, f16* dst, LAS float* scr, int gw, int NGW, int lane) {
    const int nblk = N / 32, items = (K / 64) * nblk;
    for (int it = gw; it < items; it += 2 * NGW) { TrItem a, b; const int it2 = it + NGW; const bool two = it2 < items;
        tr_load(a, src, N, (it / nblk) * 64, (it % nblk) * 32, 32, dst, (size_t)(it % nblk) * 32, K, lane);
        if (two) tr_load(b, src, N, (it2 / nblk) * 64, (it2 % nblk) * 32, 32, dst, (size_t)(it2 % nblk) * 32, K, lane);
        tr_finish(a, scr, lane); if (two) tr_finish(b, scr, lane); }
}
__device__ __forceinline__ void rms_row2(const float* xrow0, const float* xrow1, const float* gain, f16* o0, f16* o1, bool two, int lane) {
    const f32x4* xa = (const f32x4*)xrow0 + lane; const f32x4* xb = (const f32x4*)xrow1 + lane; f32x4 v[2][8], gg[8];
#pragma unroll
    for (int j = 0; j < 8; ++j) { v[0][j] = xa[64 * j]; v[1][j] = xb[64 * j]; }
    const f32x4* gr = (const f32x4*)gain + lane;
#pragma unroll
    for (int j = 0; j < 8; ++j) gg[j] = gr[64 * j];
#pragma unroll
    for (int q = 0; q < 2; ++q) { float s = 0.f;
#pragma unroll
        for (int j = 0; j < 8; ++j) s += v[q][j].x * v[q][j].x + v[q][j].y * v[q][j].y + v[q][j].z * v[q][j].z + v[q][j].w * v[q][j].w;
        const float rstd = rsqrtf(wave_sum(s) * (1.f / D) + EPS);
        if (q == 0 || two) { u32x2* o8 = (u32x2*)(q ? o1 : o0) + lane;
#pragma unroll
            for (int j = 0; j < 8; ++j) { u32x2 w; w.x = pkh(v[q][j].x * rstd * gg[j].x, v[q][j].y * rstd * gg[j].y); w.y = pkh(v[q][j].z * rstd * gg[j].z, v[q][j].w * rstd * gg[j].w); o8[64 * j] = w; } } }
}
__device__ __forceinline__ void p0_prologue(const Args& a, LAS unsigned char* lds) {
    const int tid = opaque_tid(), lane = tid & 63, wave = tid >> 6;
    const int gw = blockIdx.x * 8 + wave, NGW = gridDim.x * 8;
    LAS float* scr = (LAS float*)(lds + wave * 16384);
    unsigned char* ws = a.ws;
    { f16* dst = (f16*)(ws + WS_WIN); const float* src = a.in[I_WIN];
      const int nblk = NZ / 32, items = (D / 64) * nblk;
      for (int it0 = gw; it0 < items; it0 += 2 * NGW) { TrItem ta, tb; const bool two = it0 + NGW < items;
#pragma unroll
          for (int q = 0; q < 2; ++q) { if (q == 1 && !two) break; const int it = it0 + q * NGW; const int kb = it / nblk, nb = it % nblk, n0 = nb * 32;
              int sc = 0, nv = 32; if (n0 < 2560) sc = n0; else if (n0 < 5920) sc = n0 + 24; else if (n0 == 5920) { sc = 2560; nv = 24; } else { sc = 0; nv = 0; }
              tr_load(q ? tb : ta, src, 5944, kb * 64, sc, nv, dst, (size_t)n0, D, lane); }
          tr_finish(ta, scr, lane); if (two) tr_finish(tb, scr, lane); } }
    tr_matrix(a.in[I_WOUT], D, D, (f16*)(ws + WS_WOUT), scr, gw, NGW, lane);
    tr_matrix(a.in[I_WK], D, D, (f16*)(ws + WS_WKT), scr, gw, NGW, lane);
    tr_matrix(a.in[I_WV], D, D, (f16*)(ws + WS_WVT), scr, gw, NGW, lane);
    tr_matrix(a.in[I_WO], D, D, (f16*)(ws + WS_WOT), scr, gw, NGW, lane);
    { const f32x4* s = (const f32x4*)a.in[I_WQ]; u32x2* d = (u32x2*)(ws + WS_WQ16);
      for (size_t i = (size_t)blockIdx.x * 512 + tid; i < (size_t)D * D / 4; i += (size_t)gridDim.x * 512) { const f32x4 v = s[i]; const float gsc = a.in[I_LN2][i / (D / 4)]; u32x2 w; w.x = pkh(v.x * gsc, v.y * gsc); w.y = pkh(v.z * gsc, v.w * gsc); d[i] = w; } }
    tr_matrix(a.in[I_W1K], 4096, 128, (f16*)(ws + WS_W1T), scr, gw, NGW, lane);
    tr_matrix(a.in[I_W1V], 4096, 128, (f16*)(ws + WS_W1T) + 128 * 4096, scr, gw, NGW, lane);
    tr_matrix(a.in[I_W2K], 128, 128, (f16*)(ws + WS_W2T), scr, gw, NGW, lane);
    tr_matrix(a.in[I_W2V], 128, 128, (f16*)(ws + WS_W2T) + 128 * 128, scr, gw, NGW, lane);
    for (int o = gw; o < 256; o += NGW) { const int kv = o >> 7, n = o & 127; const float* pos = a.in[kv ? I_PV : I_PK]; const float* w1 = a.in[kv ? I_W1V : I_W1K]; float acc = 0.f;
        for (int k = lane; k < 4096; k += 64) acc += pos[k] * w1[(size_t)k * 128 + n];
        acc = wave_sum(acc); if (lane == 0) ((float*)(ws + WS_CBIAS))[o] = acc; }
    for (int i = blockIdx.x * 512 + tid; i < 48 * D; i += gridDim.x * 512) { const int c = i / D, k = i % D; float v = 0.f;
        if (c < 4) v = a.in[I_RGW][k * 4 + c]; else if (c < 36) v = a.in[I_REW][k * 32 + (c - 4)];
        v *= a.in[I_LN3][k]; const f16 hi = (f16)v; ((f16*)(ws + WS_WRH))[i] = hi; ((f16*)(ws + WS_WRL))[i] = (f16)(v - (float)hi); }
    { bf16* wu = (bf16*)(ws + WS_WUPT); bf16* au = (bf16*)(ws + WS_AUPT); bf16* gu = (bf16*)(ws + WS_GUPT);
      for (int i = blockIdx.x * 512 + tid; i < 1024 * 64; i += gridDim.x * 512) { const int ch = i >> 6, j = i & 63; wu[i] = (bf16)a.in[I_WUP][j * 1024 + ch]; au[i] = (bf16)a.in[I_AUP][j * 1024 + ch]; }
      for (int i = blockIdx.x * 512 + tid; i < 1024 * 160; i += gridDim.x * 512) { const int ch = i / 160, j = i % 160; gu[i] = (bf16)a.in[I_GUP][j * 1024 + ch]; } }
    for (int m = gw; m < T; m += 2 * NGW) { const bool two = m + NGW < T; const int m1 = two ? m + NGW : m;
        rms_row2(a.in[I_X] + (size_t)m * D, a.in[I_X] + (size_t)m1 * D, a.in[I_LN1], (f16*)(ws + WS_H) + (size_t)m * D, (f16*)(ws + WS_H) + (size_t)m1 * D, two, lane); }
    for (int m = gw; m < 256; m += NGW) rms_row2(a.in[I_MEM] + (size_t)m * D, a.in[I_MEM] + (size_t)m * D, a.in[I_LNMEM], (f16*)(ws + WS_MEMN) + (size_t)m * D, (f16*)(ws + WS_MEMN) + (size_t)m * D, false, lane);
}

__device__ __forceinline__ void p_moe_weights(const Args& a, LAS unsigned char* lds) {
    const int tid = opaque_tid(), lane = tid & 63, wave = tid >> 6;
    const int gw = blockIdx.x * 8 + wave, NGW = gridDim.x * 8;
    LAS float* scr = (LAS float*)(lds + wave * 16384);
    unsigned char* ws = a.ws;
    { f16* dst = (f16*)(ws + WS_WGU); const int items = NEXP * (D / 64) * 16;
      for (int it = gw; it < items; it += NGW) { const int e = it / ((D / 64) * 16), r = it % ((D / 64) * 16), kb = r / 16, nb = r % 16, j0 = nb * 32, jt = j0 / 256, jj = j0 % 256;
          const float* src = (jj < 128 ? a.in[I_MG] : a.in[I_MU2]) + (size_t)e * D * EFF; const int sc = jt * 128 + (jj & 127);
          TrItem ti; tr_load_scaled(ti, src, a.in[I_LN3], EFF, kb * 64, sc, dst, (size_t)e * 512 + j0, D, lane); tr_finish(ti, scr, lane); } }
    { f16* dst = (f16*)(ws + WS_WD); const int items = NEXP * (EFF / 64) * (D / 32);
      for (int it = gw; it < items; it += NGW) { const int e = it / ((EFF / 64) * (D / 32)), r = it % ((EFF / 64) * (D / 32)), kb = r / (D / 32), nb = r % (D / 32);
          tr_item(a.in[I_MD] + (size_t)e * EFF * D, D, kb * 64, nb * 32, 32, dst, (size_t)e * D + nb * 32, EFF, scr, lane); } }
}

__device__ __forceinline__ float gelu_tanh(float x) { const float u = 0.7978845608028654f * (x + 0.044715f * x * x * x); const float e = __expf(2.f * u); return 0.5f * x * (2.f - 2.f / (e + 1.f)); }
constexpr int CP_RS = 272, CP_HS = 136, CP_HID = 272 * CP_RS;
__device__ __forceinline__ void p_compress(const Args& a, LAS unsigned char* lds) {
    const int tid = opaque_tid(), lane = tid & 63, w = __builtin_amdgcn_readfirstlane(tid >> 6);
    const f16* z = (const f16*)(a.ws + WS_Z);
    LAS f16* HID = (LAS f16*)(lds + CP_HID);
    for (int it = blockIdx.x; it < 256; it += gridDim.x) {
        const int kv = it >> 7, g = (it >> 6) & 1, c0 = (it & 63) * 16, tok0 = 16 * c0;
        const int zc = (kv ? ZVC : ZKC) + g * 128;
        __syncthreads();
        for (int ck = tid; ck < 272 * 16; ck += 512) { const int tl = ck >> 4, c16 = ck & 15, tok = tok0 + tl; const int rp = (tl & 15) * 17 + (tl >> 4);
            u32x4 v = {0u, 0u, 0u, 0u}; if (tok < T) v = *(const u32x4*)(z + (size_t)tok * NZ + zc + c16 * 8);
            *(LAS u32x4*)(lds + rp * CP_RS + c16 * 16) = v; }
        __syncthreads();
        f32x4 acc = {0.f, 0.f, 0.f, 0.f};
        const f16* wp = (const f16*)(a.ws + WS_W1T) + ((size_t)kv * 128 + 16 * w + (lane & 15)) * 4096 + 8 * (lane >> 4);
        const LAS unsigned char* ap = lds + (lane & 15) * CP_RS + 16 * (lane >> 4);
#pragma unroll 8
        for (int ks = 0; ks < 128; ++ks) { const int l = ks >> 2;
            const f16x8 av = *(const LAS f16x8*)(ap + ((l & 15) * 17 + (l >> 4)) * CP_RS + (ks & 3) * 64);
            const f16x8 bv = *(const f16x8*)(wp + 32 * ks);
            acc = __builtin_amdgcn_mfma_f32_16x16x32_f16(av, bv, acc, 0, 0, 0); }
        { const int n = 16 * w + (lane & 15); const float bs = ((const float*)(a.ws + WS_CBIAS))[kv * 128 + n];
#pragma unroll
          for (int r = 0; r < 4; ++r) HID[(4 * (lane >> 4) + r) * CP_HS + n] = (f16)gelu_tanh(acc[r] + bs); }
        __syncthreads();
        f32x4 o = {0.f, 0.f, 0.f, 0.f};
        const f16* w2p = (const f16*)(a.ws + WS_W2T) + ((size_t)kv * 128 + 16 * w + (lane & 15)) * 128 + 8 * (lane >> 4);
#pragma unroll
        for (int ks = 0; ks < 4; ++ks) { const f16x8 av = *(const LAS f16x8*)(HID + (lane & 15) * CP_HS + 32 * ks + 8 * (lane >> 4)); const f16x8 bv = *(const f16x8*)(w2p + 32 * ks);
            o = __builtin_amdgcn_mfma_f32_16x16x32_f16(av, bv, o, 0, 0, 0); }
        f16* dst = (f16*)(a.ws + (kv ? WS_VCMP : WS_KCMP));
#pragma unroll
        for (int r = 0; r < 4; ++r) { const int c = c0 + 4 * (lane >> 4) + r; dst[((size_t)c * 2 + g) * 128 + 16 * w + (lane & 15)] = c < NCMP ? (f16)o[r] : (f16)0.f; }
    }
}

typedef short v4i16_t __attribute__((ext_vector_type(4)));
constexpr int NS_PSEL = 65536, NS_PSTR = 257, NS_SELB = NS_PSEL + 64 * NS_PSTR * 4, NS_WANY = NS_SELB + 2048, NS_CNT = NS_WANY + 512, NS_UNIT = NS_CNT + 64;
static_assert(NS_UNIT + 64 <= MISC_OFF, "nsa lds");
__device__ __forceinline__ void glds16(const void* gsrc, unsigned lds_dst) { unsigned keep;
    asm volatile("s_mov_b32 %0, m0\n\ts_mov_b32 m0, %2\n\ts_nop 0\n\tglobal_load_lds_dwordx4 %1, off\n\ts_mov_b32 m0, %0" : "=&s"(keep) : "v"(gsrc), "s"(lds_dst) : "memory"); }
__device__ __forceinline__ void ns_dma_pre(const f16* g0, const unsigned (&doff)[2], unsigned lds_addr, int wv) {
#pragma unroll
    for (int i = 0; i < 2; ++i) glds16(g0 + doff[i], lds_addr + (wv * 2 + i) * 1024);
}
template <bool ISV> __device__ __forceinline__ void ns_dma(const f16* g0, int stride, unsigned lds_addr, int wv, int lane_) {
    unsigned lane = (unsigned)lane_;
    asm volatile("" : "+v"(lane));
#pragma unroll
    for (int i = 0; i < 2; ++i) { const unsigned row = 8u * (unsigned)wv + 4u * i + (lane >> 4), ch = (lane & 15u) ^ (ISV ? ((row & 7u) << 1) : (row & 15u));
        glds16(g0 + (row * (unsigned)stride + ch * 8u), lds_addr + (wv * 2 + i) * 1024); }
}
#define NS_VMW(n) asm volatile("s_waitcnt vmcnt(" #n ")" ::: "memory")
__device__ __forceinline__ f32x4 mfma16(const f16x8 a, const f16x8 b, const f32x4 c) { return __builtin_amdgcn_mfma_f32_16x16x32_f16(a, b, c, 0, 0, 0); }
template <bool A0, bool A1>
__device__ __forceinline__ void ns_qk(f32x4 (&s)[2][4], const LAS unsigned char* kb, const f16x8 (&qf)[2][4], int lane_, float i0, float i1) {
    unsigned lane = (unsigned)lane_;
    asm volatile("" : "+v"(lane));
    const unsigned r = lane & 15u, g = lane >> 4, xs = r >> 2;
    const LAS unsigned char* kbase = kb + 256u * r + 16u * (g ^ (r & 3u));
    f16x8 av[4][4];
#pragma unroll
    for (int ks = 0; ks < 4; ++ks) { const LAS unsigned char* kp = kbase + 64u * ((unsigned)ks ^ xs);
#pragma unroll
        for (int kt = 0; kt < 4; ++kt) av[ks][kt] = *(const LAS f16x8*)(kp + 4096 * kt); }
#pragma unroll
    for (int kt = 0; kt < 4; ++kt) { if (A0) s[0][kt] = (f32x4){i0, i0, i0, i0}; if (A1) s[1][kt] = (f32x4){i1, i1, i1, i1}; }
    __builtin_amdgcn_sched_barrier(0);
#pragma unroll
    for (int ks = 0; ks < 4; ++ks) {
#pragma unroll
        for (int kt = 0; kt < 4; ++kt) {
            if (A0) s[0][kt] = mfma16(av[ks][kt], qf[0][ks], s[0][kt]);
            if (A1) s[1][kt] = mfma16(av[ks][kt], qf[1][ks], s[1][kt]); } }
}
template <bool A0, bool A1>
__device__ __forceinline__ void ns_pv(f32x4 (&O)[2][8], const LAS unsigned char* vb, const f32x4 (&s)[2][4], int lane_) {
    unsigned lane = (unsigned)lane_;
    asm volatile("" : "+v"(lane));
    const unsigned g = lane >> 4, q = (lane & 15u) >> 2, p = lane & 3u, x = 4u * (g & 1u) + q;
    const LAS unsigned char* vrow = vb + 256u * (4u * g + q) + 8u * p;
    f16x8 pf[2][2];
#pragma unroll
    for (int h = 0; h < 2; ++h) if (h == 0 ? A0 : A1) {
#pragma unroll
        for (int k2 = 0; k2 < 2; ++k2)
#pragma unroll
            for (int j = 0; j < 4; ++j) { pf[h][k2][j] = (f16)s[h][2 * k2][j]; pf[h][k2][4 + j] = (f16)s[h][2 * k2 + 1][j]; } }
    typedef short s16x8 __attribute__((ext_vector_type(8)));
#pragma unroll
    for (int dh = 0; dh < 2; ++dh) {
        v4i16_t lo[4][2], hi[4][2];
#pragma unroll
        for (int d4 = 0; d4 < 4; ++d4) { const LAS unsigned char* b = vrow + 32u * ((unsigned)(4 * dh + d4) ^ x);
#pragma unroll
            for (int k2 = 0; k2 < 2; ++k2) {
                lo[d4][k2] = __builtin_amdgcn_ds_read_tr16_b64_v4i16((LAS v4i16_t*)(b + 8192 * k2));
                hi[d4][k2] = __builtin_amdgcn_ds_read_tr16_b64_v4i16((LAS v4i16_t*)(b + 8192 * k2 + 4096)); } }
#pragma unroll
        for (int k2 = 0; k2 < 2; ++k2)
#pragma unroll
            for (int d4 = 0; d4 < 4; ++d4) { const int dt = 4 * dh + d4;
                const s16x8 v8 = {lo[d4][k2][0], lo[d4][k2][1], lo[d4][k2][2], lo[d4][k2][3], hi[d4][k2][0], hi[d4][k2][1], hi[d4][k2][2], hi[d4][k2][3]};
                if (A0) O[0][dt] = mfma16(__builtin_bit_cast(f16x8, v8), pf[0][k2], O[0][dt]);
                if (A1) O[1][dt] = mfma16(__builtin_bit_cast(f16x8, v8), pf[1][k2], O[1][dt]); }
    }
}
constexpr float NS_THR = 6.f;
typedef unsigned ns_u2 __attribute__((ext_vector_type(2)));
__device__ __forceinline__ float ns_xmax(float x) {
    unsigned u = __float_as_uint(x); ns_u2 r = __builtin_amdgcn_permlane16_swap(u, u, false, false); x = fmaxf(__uint_as_float(r[0]), __uint_as_float(r[1]));
    u = __float_as_uint(x); r = __builtin_amdgcn_permlane32_swap(u, u, false, false); return fmaxf(__uint_as_float(r[0]), __uint_as_float(r[1])); }
__device__ __forceinline__ float ns_xsum(float x) {
    unsigned u = __float_as_uint(x); ns_u2 r = __builtin_amdgcn_permlane16_swap(u, u, false, false); x = __uint_as_float(r[0]) + __uint_as_float(r[1]);
    u = __float_as_uint(x); r = __builtin_amdgcn_permlane32_swap(u, u, false, false); return __uint_as_float(r[0]) + __uint_as_float(r[1]); }
template <bool WITH_O> __device__ __forceinline__ void ns_online(f32x4 (&y)[4], float& m, float& l, bool& seen, f32x4 (&O)[8]) {
    float mx = fmaxf(fmaxf(y[0][0], y[0][1]), fmaxf(y[0][2], y[0][3]));
#pragma unroll
    for (int kt = 1; kt < 4; ++kt) mx = fmaxf(mx, fmaxf(fmaxf(y[kt][0], y[kt][1]), fmaxf(y[kt][2], y[kt][3])));
    mx = ns_xmax(mx);
    const bool fin = mx > -INFINITY, first = !seen && fin;
    if (__any(first || mx > NS_THR)) {
        const float d = first ? mx : (mx > NS_THR ? mx : 0.f), alpha = __builtin_amdgcn_exp2f(-d);
        seen = seen || fin; m += d; l *= alpha;
        if (WITH_O) {
#pragma unroll
            for (int dt = 0; dt < 8; ++dt) O[dt] = O[dt] * alpha; }
#pragma unroll
        for (int kt = 0; kt < 4; ++kt)
#pragma unroll
            for (int j = 0; j < 4; ++j) y[kt][j] -= d;
    }
    float ls = 0.f;
#pragma unroll
    for (int kt = 0; kt < 4; ++kt)
#pragma unroll
        for (int j = 0; j < 4; ++j) { y[kt][j] = __builtin_amdgcn_exp2f(y[kt][j]); ls += y[kt][j]; }
    l += ls;
}
#define NS_ISSUE(j, NSL, HASV) do { const unsigned sa_ = lds_a + (unsigned)(((j) & ((NSL) - 1)) * 32768); ns_dma<false>(NS_KPTR(j), NS_STRIDE, sa_, w, lane); if (HASV) ns_dma<true>(NS_VPTR(j), NS_STRIDE, sa_ + 16384u, w, lane); } while (0)
#define NS_WAIT(nb, HASV) do { if (HASV) { if ((nb) >= 2) NS_VMW(8); else if ((nb) == 1) NS_VMW(4); else NS_VMW(0); } else { if ((nb) >= 2) NS_VMW(4); else if ((nb) == 1) NS_VMW(2); else NS_VMW(0); } } while (0)
#define NS_PROLOGUE(n, NSL, HASV) do { const int q_ = (n) < (NSL) - 1 ? (n) : (NSL) - 1; for (int j_ = 0; j_ < q_; ++j_) NS_ISSUE(j_, NSL, HASV); NS_WAIT(q_ - 1, HASV); __syncthreads(); } while (0)
#define NS_STEP_BEGIN(i, n, NSL, HASV) do { if ((i) + (NSL) - 1 < (n)) NS_ISSUE((i) + (NSL) - 1, NSL, HASV); } while (0)
#define NS_STEP_END(i, n, NSL, HASV) do { int nb_ = ((n) - 1 < (i) + (NSL) - 1 ? (n) - 1 : (i) + (NSL) - 1) - ((i) + 1); NS_WAIT(nb_, HASV); __syncthreads(); } while (0)
#define NS_KB(i, NSL) (lds + (((i) & ((NSL) - 1)) * 32768))
#define NS_VB(i, NSL) (lds + (((i) & ((NSL) - 1)) * 32768) + 16384)
#define NS_FORALL(h, kt, j) _Pragma("unroll") for (int h = 0; h < 2; ++h) _Pragma("unroll") for (int kt = 0; kt < 4; ++kt) _Pragma("unroll") for (int j = 0; j < 4; ++j)
__device__ __forceinline__ void p_nsa(const Args& a, LAS unsigned char* lds, int rep) {
    const int tid = opaque_tid(), lane = tid & 63, w = __builtin_amdgcn_readfirstlane(tid >> 6);
#define NS_LANE(L) unsigned L = (unsigned)lane; asm volatile("" : "+v"(L))
#define NS_LANE_IDS(L) NS_LANE(L); const int n = (int)(L & 15u), g = (int)(L >> 4), q4 = n >> 2, p = n & 3, tq0 = t0 + 8 * w + q4, hq = grp * 4 + p; (void)g; (void)q4; (void)p; (void)tq0; (void)hq
    const unsigned lds_a = (unsigned)__builtin_amdgcn_readfirstlane((int)(unsigned)(size_t)lds);
    const f16* z = (const f16*)(a.ws + WS_Z); const f16* kcmp = (const f16*)(a.ws + WS_KCMP); const f16* vcmp = (const f16*)(a.ws + WS_VCMP);
    float* onsa = (float*)(a.ws + WS_ONSA); unsigned* ctl = (unsigned*)(a.ws + WS_CTL);
    LAS float* psel = (LAS float*)(lds + NS_PSEL); LAS unsigned* selb = (LAS unsigned*)(lds + NS_SELB); LAS unsigned* wany = (LAS unsigned*)(lds + NS_WANY);
    LAS int* unit_s = (LAS int*)(lds + NS_UNIT);
    const float c2 = 0.08838834764831845f * 1.4426950408889634f;
    for (;;) {
        __syncthreads();
        if (tid == 0) { const int g0 = (int)(xb_xcc_id() & 1u); int k = (int)atomicAdd(&ctl[CW_Q + rep * 4 + g0], 1u), gg = g0;
            if (k >= 256) { gg = g0 ^ 1; k = (int)atomicAdd(&ctl[CW_Q + rep * 4 + gg], 1u); }
            unit_s[0] = k; unit_s[1] = gg; }
        __syncthreads();
        const int uk = unit_s[0]; if (uk >= 256) break;
        const int blk = 255 - uk, grp = unit_s[1], t0 = blk * 64;
        f16x8 qf[2][4];
        { NS_LANE_IDS(la);
#pragma unroll
          for (int h = 0; h < 2; ++h) { const f16* qrow = z + (size_t)(tq0 + 4 * h) * NZ + ZQ + hq * 128 + 8 * g;
#pragma unroll
            for (int ks = 0; ks < 4; ++ks) { const f16x8 q8 = *(const f16x8*)(qrow + 32 * ks);
#pragma unroll
                for (int j = 0; j < 8; ++j) qf[h][ks][j] = (f16)((float)q8[j] * c2); } } }
        f32x4 O[2][8];
#pragma unroll
        for (int h = 0; h < 2; ++h)
#pragma unroll
            for (int dt = 0; dt < 8; ++dt) O[h][dt] = (f32x4){0.f, 0.f, 0.f, 0.f};
#define NS_OROW(h) (onsa + (size_t)(tq0 + 4 * (h)) * 1024 + hq * 128 + 4 * g)
#define NS_GATE(h, k) sigmoidf_((float)z[(size_t)(tq0 + 4 * (h)) * NZ + ZGL + 8 * (k) + hq])
#define NS_CMAX(h) ((tq0 + 4 * (h)) >= 31 ? ((tq0 + 4 * (h)) - 31) >> 4 : -1)
        const int ntc = (4 * blk + 3 + 63) >> 6;
        float m[2] = {0.f, 0.f}, l[2] = {0.f, 0.f}; bool seen[2] = {false, false};
        const int cmin_w = (t0 + 8 * w) >= 31 ? (t0 + 8 * w - 31) >> 4 : -1;
#define NS_KPTR(j) (kcmp + ((size_t)(64 * (j)) * 2 + grp) * 128)
#define NS_VPTR(j) (vcmp + ((size_t)(64 * (j)) * 2 + grp) * 128)
#define NS_STRIDE 256
        { const int npc = (ntc + 1) >> 1;
#define NS_ISSUE_KPAIR(ip) do { const unsigned sa_ = lds_a + (unsigned)(((ip) & 1) * 65536); const int j0_ = 2 * (ip); ns_dma<false>(NS_KPTR(j0_), NS_STRIDE, sa_, w, lane); if (j0_ + 1 < ntc) ns_dma<false>(NS_KPTR(j0_ + 1), NS_STRIDE, sa_ + 32768u, w, lane); } while (0)
          NS_ISSUE_KPAIR(0); NS_VMW(0); __syncthreads();
          for (int ip = 0; ip < npc; ++ip) {
              if (ip + 1 < npc) NS_ISSUE_KPAIR(ip + 1);
#pragma unroll
              for (int hb = 0; hb < 2; ++hb) { const int i = 2 * ip + hb;
                  if (i < ntc) {
                      f32x4 s[2][4]; ns_qk<true, true>(s, lds + (ip & 1) * 65536 + hb * 32768, qf, lane, -m[0], -m[1]);
                      if (64 * i + 63 > cmin_w) { NS_LANE_IDS(la); const int cmax[2] = {NS_CMAX(0), NS_CMAX(1)};
                          NS_FORALL(h, kt, j) { const int c0 = 64 * i + 16 * kt + 4 * g + j; s[h][kt][j] = (c0 <= cmax[h]) ? s[h][kt][j] : -INFINITY; } }
                      ns_online<false>(s[0], m[0], l[0], seen[0], O[0]); ns_online<false>(s[1], m[1], l[1], seen[1], O[1]); } }
              NS_VMW(0); __syncthreads();
          } }
        float invl[2];
#pragma unroll
        for (int h = 0; h < 2; ++h) { l[h] = ns_xsum(l[h]); invl[h] = 1.f / fmaxf(l[h], 1e-30f); }
        for (int i = lane; i < 8 * NS_PSTR; i += 64) psel[(8 * w) * NS_PSTR + i] = 0.f;
        NS_PROLOGUE(ntc, 2, true);
        for (int i = 0; i < ntc; ++i) {
            NS_STEP_BEGIN(i, ntc, 2, true);
            f32x4 s[2][4]; ns_qk<true, true>(s, NS_KB(i, 2), qf, lane, -m[0], -m[1]);
            NS_FORALL(h, kt, j) s[h][kt][j] = __builtin_amdgcn_exp2f(s[h][kt][j]) * invl[h];
            NS_LANE_IDS(la);
            if (64 * i + 63 > cmin_w) { const int cmax[2] = {NS_CMAX(0), NS_CMAX(1)};
                NS_FORALL(h, kt, j) { const int c0 = 64 * i + 16 * kt + 4 * g + j; s[h][kt][j] = (c0 <= cmax[h]) ? s[h][kt][j] : 0.f; } }
#pragma unroll
            for (int h = 0; h < 2; ++h)
#pragma unroll
                for (int kt = 0; kt < 4; ++kt) {
                    float mainv = s[h][kt][0] + s[h][kt][1] + s[h][kt][2] + 0.5f * s[h][kt][3], carry = 0.5f * s[h][kt][3];
                    mainv += __shfl_xor(mainv, 1); mainv += __shfl_xor(mainv, 2); carry += __shfl_xor(carry, 1); carry += __shfl_xor(carry, 2);
                    if (p == 0) { const int sb = 16 * i + 4 * kt + g; float* pr = (float*)(psel + (8 * w + 4 * h + q4) * NS_PSTR + sb); __hip_atomic_fetch_add(pr, mainv, __ATOMIC_RELAXED, __HIP_MEMORY_SCOPE_WORKGROUP); __hip_atomic_fetch_add(pr + 1, carry, __ATOMIC_RELAXED, __HIP_MEMORY_SCOPE_WORKGROUP); }
                }
            ns_pv<true, true>(O, NS_VB(i, 2), s, lane);
            NS_STEP_END(i, ntc, 2, true);
        }
#undef NS_KPTR
#undef NS_VPTR
#undef NS_STRIDE
#pragma unroll
        for (int h = 0; h < 2; ++h) { NS_LANE_IDS(la); float* orow = NS_OROW(h); const float gate_c = NS_GATE(h, 0);
#pragma unroll
            for (int dt = 0; dt < 8; ++dt) { *(f32x4*)(orow + 16 * dt) = O[h][dt] * gate_c; O[h][dt] = (f32x4){0.f, 0.f, 0.f, 0.f}; } }
        {
            unsigned anyw0 = 0u, anyw1 = 0u;
            NS_LANE(lt_); const int lane = (int)lt_;
            for (int qq = 0; qq < 8; ++qq) {
                const LAS float* pr = psel + (8 * w + qq) * NS_PSTR;
                unsigned myw = 0u;
                if (lane == 0) myw |= 1u;
                if (lane == (blk >> 5)) myw |= 1u << (blk & 31);
                if (blk >= 1 && lane == ((blk - 1) >> 5)) myw |= 1u << ((blk - 1) & 31);
                const int ncand = blk >= 3 ? blk - 2 : 0;
                if (ncand <= 13) { if (ncand > 0 && lane == 0) myw |= ((2u << (blk - 2)) - 1u) & ~1u; }
                else {
                    unsigned key[4];
#pragma unroll
                    for (int jj = 0; jj < 4; ++jj) { const int s = 1 + lane + 64 * jj; key[jj] = (s <= blk - 2) ? __float_as_uint(fmaxf(pr[s], 0.f)) + 1u : 0u; }
                    unsigned thr = 0u;
                    for (int bit = 31; bit >= 0; --bit) { const unsigned cand = thr | (1u << bit); int cn = 0;
#pragma unroll
                        for (int jj = 0; jj < 4; ++jj) cn += __popcll(__ballot(key[jj] >= cand));
                        if (cn >= 13) thr = cand; }
                    int cgt = 0;
#pragma unroll
                    for (int jj = 0; jj < 4; ++jj) cgt += __popcll(__ballot(key[jj] > thr));
                    int remaining = 13 - cgt;
                    unsigned long long M[4];
#pragma unroll
                    for (int jj = 0; jj < 4; ++jj) { const bool eq = key[jj] == thr; const unsigned long long em = __ballot(eq); const int c = __popcll(em);
                        const bool take_eq = eq && (__popcll(em & ((1ull << lane) - 1ull)) < remaining);
                        remaining = remaining > c ? remaining - c : 0;
                        M[jj] = __ballot(key[jj] > thr || take_eq); }
#pragma unroll
                    for (int j = 0; j < 8; ++j) { const int k = j >> 1; const unsigned long long sh = (M[k] << 1) | (k > 0 ? (M[k - 1] >> 63) : 0ull);
                        const unsigned wj = (unsigned)(sh >> (32 * (j & 1))); if (lane == j) myw |= wj; }
                }
                if (lane < 8) selb[(8 * w + qq) * 8 + lane] = myw;
                if (qq < 4) anyw0 |= myw; else anyw1 |= myw;
            }
            if (lane < 8) { wany[(w * 2) * 8 + lane] = anyw0; wany[(w * 2 + 1) * 8 + lane] = anyw1; }
        }
        __syncthreads();
        const int nlist = blk + 1;
        unsigned doff_zk[2], doff_zv[2];
        { NS_LANE(la);
#pragma unroll
          for (int i = 0; i < 2; ++i) { const unsigned row = 8u * (unsigned)w + 4u * i + (la >> 4); doff_zk[i] = row * NZ + (((la & 15u) ^ (row & 15u)) << 3); doff_zv[i] = row * NZ + (((la & 15u) ^ ((row & 7u) << 1)) << 3); } }
        for (int rp_ = 0; rp_ < NSA_SELREP; ++rp_) {
        if (rp_ && !NSA_PROBE_DMA) { asm volatile("" :: "v"(O[0][0]), "v"(O[0][7]), "v"(O[1][0]), "v"(O[1][7]), "v"(l[0]), "v"(l[1]));
#pragma unroll
            for (int h = 0; h < 2; ++h)
#pragma unroll
                for (int dt = 0; dt < 8; ++dt) O[h][dt] = (f32x4){0.f, 0.f, 0.f, 0.f}; }
        if (!(rp_ && NSA_PROBE_DMA)) { m[0] = m[1] = 0.f; l[0] = l[1] = 0.f; seen[0] = seen[1] = false; }
#define NS_KPTR(j) (z + (size_t)((j) * 64) * NZ + ZKS + grp * 128)
#define NS_VPTR(j) (z + (size_t)((j) * 64) * NZ + ZVS + grp * 128)
#define NS_STRIDE NZ
        {
        const int npair = (nlist + 1) >> 1;
#define NS_ISSUE_PAIR(ip) do { const unsigned sa_ = lds_a + (unsigned)(((ip) & 1) * 65536); const int j0_ = 2 * (ip); \
            ns_dma_pre(NS_KPTR(j0_), doff_zk, sa_, w); ns_dma_pre(NS_VPTR(j0_), doff_zv, sa_ + 16384u, w); \
            if (j0_ + 1 < nlist) { ns_dma_pre(NS_KPTR(j0_ + 1), doff_zk, sa_ + 32768u, w); ns_dma_pre(NS_VPTR(j0_ + 1), doff_zv, sa_ + 49152u, w); } } while (0)
        NS_ISSUE_PAIR(0); NS_VMW(0); __syncthreads();
        unsigned cs0 = 0u, cs1 = 0u; int ca0 = 0, ca1 = 0;
        for (int ip = 0; ip < npair; ++ip) {
            if (ip + 1 < npair) NS_ISSUE_PAIR(ip + 1);
#pragma unroll
            for (int hb = 0; hb < 2; ++hb) {
                const int sb = 2 * ip + hb, bit = sb & 31;
                if (sb < nlist) {
                    if (bit == 0) { const int wi = sb >> 5; NS_LANE(la); const int q4 = (int)((la & 15u) >> 2); cs0 = selb[(8 * w + q4) * 8 + wi]; cs1 = selb[(8 * w + 4 + q4) * 8 + wi];
                        ca0 = __builtin_amdgcn_readfirstlane((int)wany[(w * 2) * 8 + wi]); ca1 = __builtin_amdgcn_readfirstlane((int)wany[(w * 2 + 1) * 8 + wi]); }
                    const bool a0 = (ca0 >> bit) & 1, a1 = (ca1 >> bit) & 1;
                    if ((a0 || a1) && !(rp_ && NSA_PROBE_DMA)) {
                        const float i0 = ((cs0 >> bit) & 1u) ? -m[0] : -INFINITY, i1 = ((cs1 >> bit) & 1u) ? -m[1] : -INFINITY;
                        const LAS unsigned char* kb = lds + (ip & 1) * 65536 + hb * 32768;
                        f32x4 s[2][4];
#define NS_SEL_BODY(A0, A1) do { ns_qk<A0, A1>(s, kb, qf, lane, i0, i1); \
                            if (sb == blk) { NS_LANE_IDS(la); const int kp0 = sb * 64 + 4 * g; \
                                _Pragma("unroll") for (int kt = 0; kt < 4; ++kt) _Pragma("unroll") for (int j = 0; j < 4; ++j) { const int kp = kp0 + 16 * kt + j; \
                                    if (A0) s[0][kt][j] = (kp <= tq0) ? s[0][kt][j] : -INFINITY; if (A1) s[1][kt][j] = (kp <= tq0 + 4) ? s[1][kt][j] : -INFINITY; } } \
                            if (A0) ns_online<true>(s[0], m[0], l[0], seen[0], O[0]); if (A1) ns_online<true>(s[1], m[1], l[1], seen[1], O[1]); \
                            ns_pv<A0, A1>(O, kb + 16384, s, lane); } while (0)
                        if (a0 && a1) NS_SEL_BODY(true, true); else if (a0) NS_SEL_BODY(true, false); else NS_SEL_BODY(false, true);
                    }
                }
            }
            NS_VMW(0); __syncthreads();
        }
        }
#undef NS_KPTR
#undef NS_VPTR
        }
        { f32x4 ev[2][8]; float sc[2]; NS_LANE_IDS(la);
#pragma unroll
          for (int h = 0; h < 2; ++h) { l[h] = ns_xsum(l[h]); sc[h] = NS_GATE(h, 1) / fmaxf(l[h], 1e-30f); const float* orow = NS_OROW(h);
#pragma unroll
              for (int dt = 0; dt < 8; ++dt) ev[h][dt] = *(const f32x4*)(orow + 16 * dt); }
#pragma unroll
          for (int h = 0; h < 2; ++h) { float* orow = NS_OROW(h);
#pragma unroll
              for (int dt = 0; dt < 8; ++dt) { *(f32x4*)(orow + 16 * dt) = ev[h][dt] + O[h][dt] * sc[h]; O[h][dt] = (f32x4){0.f, 0.f, 0.f, 0.f}; } } }
        const int wb0 = blk >= 8 ? blk - 8 : 0, nwt = blk - wb0 + 1;
        for (int rp_ = 0; rp_ < NSA_WINREP; ++rp_) {
        if (rp_) { asm volatile("" :: "v"(O[0][0]), "v"(O[0][7]), "v"(O[1][0]), "v"(O[1][7]), "v"(l[0]), "v"(l[1]));
#pragma unroll
            for (int h = 0; h < 2; ++h)
#pragma unroll
                for (int dt = 0; dt < 8; ++dt) O[h][dt] = (f32x4){0.f, 0.f, 0.f, 0.f}; }
        m[0] = m[1] = 0.f; l[0] = l[1] = 0.f; seen[0] = seen[1] = false;
#define NS_KPTR(j) (z + (size_t)((wb0 + (j)) * 64) * NZ + ZKW + grp * 128)
#define NS_VPTR(j) (z + (size_t)((wb0 + (j)) * 64) * NZ + ZVW + grp * 128)
        { const int npw = (nwt + 1) >> 1;
#define NS_ISSUE_WPAIR(ip) do { const unsigned sa_ = lds_a + (unsigned)(((ip) & 1) * 65536); const int j0_ = 2 * (ip); \
              ns_dma<false>(NS_KPTR(j0_), NS_STRIDE, sa_, w, lane); ns_dma<true>(NS_VPTR(j0_), NS_STRIDE, sa_ + 16384u, w, lane); \
              if (j0_ + 1 < nwt) { ns_dma<false>(NS_KPTR(j0_ + 1), NS_STRIDE, sa_ + 32768u, w, lane); ns_dma<true>(NS_VPTR(j0_ + 1), NS_STRIDE, sa_ + 49152u, w, lane); } } while (0)
          NS_ISSUE_WPAIR(0); NS_VMW(0); __syncthreads();
          for (int ip = 0; ip < npw; ++ip) {
              if (ip + 1 < npw) NS_ISSUE_WPAIR(ip + 1);
#pragma unroll
              for (int hb = 0; hb < 2; ++hb) { const int i = 2 * ip + hb;
                  if (i < nwt) { const int kb = wb0 + i; const LAS unsigned char* kbp = lds + (ip & 1) * 65536 + hb * 32768;
                      f32x4 s[2][4]; ns_qk<true, true>(s, kbp, qf, lane, -m[0], -m[1]);
                      if (i == 0 || i == nwt - 1) { NS_LANE_IDS(la); const int kp0 = kb * 64 + 4 * g;
                          NS_FORALL(h, kt, j) { const int kp = kp0 + 16 * kt + j, tqx = tq0 + 4 * h; s[h][kt][j] = (kp <= tqx && kp + 511 >= tqx) ? s[h][kt][j] : -INFINITY; } }
                      ns_online<true>(s[0], m[0], l[0], seen[0], O[0]); ns_online<true>(s[1], m[1], l[1], seen[1], O[1]);
                      ns_pv<true, true>(O, kbp + 16384, s, lane); } }
              NS_VMW(0); __syncthreads();
          } }
        }
#undef NS_KPTR
#undef NS_VPTR
#undef NS_STRIDE
        { f32x4 ev[2][8]; float sc[2]; NS_LANE_IDS(la);
#pragma unroll
          for (int h = 0; h < 2; ++h) { l[h] = ns_xsum(l[h]); sc[h] = NS_GATE(h, 2) / fmaxf(l[h], 1e-30f); const float* orow = NS_OROW(h);
#pragma unroll
              for (int dt = 0; dt < 8; ++dt) ev[h][dt] = *(const f32x4*)(orow + 16 * dt); }
#pragma unroll
          for (int h = 0; h < 2; ++h) { float* orow = NS_OROW(h);
#pragma unroll
              for (int dt = 0; dt < 8; ++dt) *(f32x4*)(orow + 16 * dt) = ev[h][dt] + O[h][dt] * sc[h]; } }
#undef NS_OROW
#undef NS_GATE
#undef NS_CMAX
    }
}

constexpr int RS = 72, SLOT = 64 * RS * 2, RW_FS = 68, RW_GCL = 17 * SLOT;
#define RW_SLOT(lds, i) ((LAS bf16*)((lds) + (i) * SLOT))
template <int KS> __device__ __forceinline__ void mm_acc(f32x4 (&acc)[2], const LAS bf16* X, int xs, const LAS bf16* Y, int ys, int w, int lane) {
    const LAS bf16* xp = X + (16 * (w >> 1) + (lane & 15)) * xs + 8 * (lane >> 4);
    const LAS bf16* yp = Y + (32 * (w & 1) + (lane & 15)) * ys + 8 * (lane >> 4);
#pragma unroll
    for (int ks = 0; ks < KS; ++ks) { const bf16x8 av = *(const LAS bf16x8*)(xp + 32 * ks), b0 = *(const LAS bf16x8*)(yp + 32 * ks), b1 = *(const LAS bf16x8*)(yp + 16 * ys + 32 * ks);
        acc[0] = __builtin_amdgcn_mfma_f32_16x16x32_bf16(av, b0, acc[0], 0, 0, 0); acc[1] = __builtin_amdgcn_mfma_f32_16x16x32_bf16(av, b1, acc[1], 0, 0, 0); }
}
__device__ __forceinline__ void acc_zero(f32x4 (&acc)[2]) { acc[0] = (f32x4){0.f, 0.f, 0.f, 0.f}; acc[1] = (f32x4){0.f, 0.f, 0.f, 0.f}; }
__device__ __forceinline__ void st_n(const f32x4 (&acc)[2], LAS bf16* dst, int m0, int n0) {
#pragma unroll
    for (int tn = 0; tn < 2; ++tn)
#pragma unroll
        for (int r = 0; r < 4; ++r) dst[(m0 + r) * RS + n0 + 16 * tn] = (bf16)acc[tn][r];
}
__device__ __forceinline__ void st_t(const f32x4 (&acc)[2], LAS bf16* dst, int m0, int n0) {
#pragma unroll
    for (int tn = 0; tn < 2; ++tn) { const bf16x4 v = {(bf16)acc[tn][0], (bf16)acc[tn][1], (bf16)acc[tn][2], (bf16)acc[tn][3]}; *(LAS bf16x4*)(dst + (n0 + 16 * tn) * RS + m0) = v; }
}
__device__ __forceinline__ void ld_n(f32x4 (&acc)[2], const LAS bf16* src, int m0, int n0) {
#pragma unroll
    for (int tn = 0; tn < 2; ++tn)
#pragma unroll
        for (int r = 0; r < 4; ++r) acc[tn][r] = (float)src[(m0 + r) * RS + n0 + 16 * tn];
}
template <bool INCL> __device__ __forceinline__ void tri_mask(f32x4 (&acc)[2], int m0, int n0) {
#pragma unroll
    for (int tn = 0; tn < 2; ++tn)
#pragma unroll
        for (int r = 0; r < 4; ++r) { const int m = m0 + r, n = n0 + 16 * tn; if (INCL ? (n > m) : (n >= m)) acc[tn][r] = 0.f; }
}
__device__ __forceinline__ void st_acc_g(const f32x4 (&acc)[2], f16* base, int u, int w, int lane) {
#pragma unroll
    for (int tn = 0; tn < 2; ++tn) { const f16x4 v = {(f16)acc[tn][0], (f16)acc[tn][1], (f16)acc[tn][2], (f16)acc[tn][3]}; ((f16x4*)base)[((size_t)u * 16 + w * 2 + tn) * 64 + lane] = v; }
}
__device__ __forceinline__ float fast_tanh(float x) { const float e = __expf(2.f * x); return 1.f - 2.f / (e + 1.f); }

__device__ __forceinline__ void p_rwkv_local(const Args& a, LAS unsigned char* lds) {
    const int tid = opaque_tid(), lane = tid & 63, w = __builtin_amdgcn_readfirstlane(tid >> 6);
    const int m0 = 16 * (w >> 1) + 4 * (lane >> 4), n0 = 32 * (w & 1) + (lane & 15);
    const int et = tid >> 3, cg = tid & 7;
    const f16* z = (const f16*)(a.ws + WS_Z);
    unsigned char* ro = (unsigned char*)a.out;
    LAS float* FW = (LAS float*)(lds + 8 * SLOT); LAS float* FA = FW + 64 * RW_FS; LAS float* TOT = FA + 64 * RW_FS; LAS float* GCL = (LAS float*)(lds + RW_GCL); LAS float* PRM = GCL + 64;
    const int h = blockIdx.x & 15, cstep = gridDim.x >> 4, ch0 = h * 64 + 8 * cg;
    __syncthreads();
    if (tid < 64) { const int ch = h * 64 + tid; const float* mu = a.in[I_MU];
        PRM[tid] = mu[ch]; PRM[64 + tid] = mu[1024 + ch]; PRM[128 + tid] = mu[2048 + ch]; PRM[192 + tid] = mu[3072 + tid]; PRM[256 + tid] = mu[3136 + tid];
        PRM[320 + tid] = a.in[I_W0][ch]; PRM[384 + tid] = a.in[I_A0][ch]; PRM[448 + tid] = a.in[I_KK][ch]; PRM[512 + tid] = a.in[I_KA][ch]; PRM[576 + tid] = a.in[I_RK][ch]; }
    { bf16x8 id8;
#pragma unroll
      for (int e = 0; e < 8; ++e) id8[e] = (bf16)((8 * cg + e == et) ? 1.f : 0.f);
      *(LAS bf16x8*)(RW_SLOT(lds, 16) + et * RS + 8 * cg) = id8; }
    *(LAS u32x4*)(RW_SLOT(lds, 14) + et * RS + 8 * cg) = *(const u32x4*)((const bf16*)(a.ws + WS_WUPT) + (size_t)(h * 64 + et) * 64 + 8 * cg);
    *(LAS u32x4*)(RW_SLOT(lds, 15) + et * RS + 8 * cg) = *(const u32x4*)((const bf16*)(a.ws + WS_AUPT) + (size_t)(h * 64 + et) * 64 + 8 * cg);
    f16x8 zc[5], zp[5];
    const f16x8 zero8 = {0, 0, 0, 0, 0, 0, 0, 0};
#define RW_LOADZ(cc) do { const int t_ = (cc) * 64 + et; const f16* cur_ = z + (size_t)t_ * NZ; const bool hp_ = t_ > 0; \
        zc[0] = *(const f16x8*)(cur_ + ZR + ch0); zc[1] = *(const f16x8*)(cur_ + ZK + ch0); zc[2] = *(const f16x8*)(cur_ + ZV + ch0); zc[3] = *(const f16x8*)(cur_ + ZWD + 8 * cg); zc[4] = *(const f16x8*)(cur_ + ZAD + 8 * cg); \
        zp[0] = hp_ ? *(const f16x8*)(cur_ - NZ + ZR + ch0) : zero8; zp[1] = hp_ ? *(const f16x8*)(cur_ - NZ + ZK + ch0) : zero8; zp[2] = hp_ ? *(const f16x8*)(cur_ - NZ + ZV + ch0) : zero8; \
        zp[3] = hp_ ? *(const f16x8*)(cur_ - NZ + ZWD + 8 * cg) : zero8; zp[4] = hp_ ? *(const f16x8*)(cur_ - NZ + ZAD + 8 * cg) : zero8; } while (0)
    __syncthreads();
    if ((blockIdx.x >> 4) < 256) RW_LOADZ(blockIdx.x >> 4);
    asm volatile("" :: "v"(zc[0]), "v"(zc[1]), "v"(zc[2]), "v"(zc[3]), "v"(zc[4]), "v"(zp[0]), "v"(zp[1]), "v"(zp[2]), "v"(zp[3]), "v"(zp[4]));
    for (int c = blockIdx.x >> 4; c < 256; c += cstep) {
        const int t0 = c * 64, uo = h * 256 + c;
        float r_[8], k_[8], v_[8];
        { bf16x8 x1, x2;
#pragma unroll
          for (int e = 0; e < 8; ++e) { const int jj = 8 * cg + e;
              r_[e] = (float)zc[0][e] + ((float)zp[0][e] - (float)zc[0][e]) * PRM[jj]; k_[e] = (float)zc[1][e] + ((float)zp[1][e] - (float)zc[1][e]) * PRM[64 + jj]; v_[e] = (float)zc[2][e] + ((float)zp[2][e] - (float)zc[2][e]) * PRM[128 + jj];
              x1[e] = (bf16)fast_tanh((float)zc[3][e] + ((float)zp[3][e] - (float)zc[3][e]) * PRM[192 + jj]); x2[e] = (bf16)((float)zc[4][e] + ((float)zp[4][e] - (float)zc[4][e]) * PRM[256 + jj]); }
          *(LAS bf16x8*)(RW_SLOT(lds, 0) + et * RS + 8 * cg) = x1; *(LAS bf16x8*)(RW_SLOT(lds, 1) + et * RS + 8 * cg) = x2; }
        if (c + cstep < 256) RW_LOADZ(c + cstep);
        __syncthreads();
        { f32x4 acc[2]; acc_zero(acc); mm_acc<2>(acc, RW_SLOT(lds, 0), RS, RW_SLOT(lds, 14), RS, w, lane);
#pragma unroll
          for (int tn = 0; tn < 2; ++tn)
#pragma unroll
              for (int r = 0; r < 4; ++r) FW[(m0 + r) * RW_FS + n0 + 16 * tn] = acc[tn][r];
          acc_zero(acc); mm_acc<2>(acc, RW_SLOT(lds, 1), RS, RW_SLOT(lds, 15), RS, w, lane);
#pragma unroll
          for (int tn = 0; tn < 2; ++tn)
#pragma unroll
              for (int r = 0; r < 4; ++r) FA[(m0 + r) * RW_FS + n0 + 16 * tn] = acc[tn][r]; }
        __syncthreads();
        float lw_[8], kk_[8], b_[8];
        { float ss = 0.f, sb = 0.f;
#pragma unroll
          for (int e = 0; e < 8; ++e) {
              const float wpre = PRM[320 + 8 * cg + e] + FW[et * RW_FS + 8 * cg + e]; const float y0 = -wpre; const float sp = fmaxf(y0, 0.f) + __logf(1.f + __expf(-fabsf(y0)));
              lw_[e] = -__expf(-sp - 0.5f);
              const float av = sigmoidf_(PRM[384 + 8 * cg + e] + FA[et * RW_FS + 8 * cg + e]);
              const float kkr = k_[e] * PRM[448 + 8 * cg + e]; ss += kkr * kkr; kk_[e] = kkr;
              k_[e] = k_[e] * (1.f + (av - 1.f) * PRM[512 + 8 * cg + e]); b_[e] = av;
              sb += r_[e] * k_[e] * PRM[576 + 8 * cg + e]; }
          ss += __shfl_xor(ss, 1); ss += __shfl_xor(ss, 2); ss += __shfl_xor(ss, 4);
          sb += __shfl_xor(sb, 1); sb += __shfl_xor(sb, 2); sb += __shfl_xor(sb, 4);
          const float rn = rsqrtf(fmaxf(ss, 1e-24f));
#pragma unroll
          for (int e = 0; e < 8; ++e) { kk_[e] *= rn; b_[e] *= kk_[e]; FW[et * RW_FS + 8 * cg + e] = lw_[e]; }
          if (cg == 0) ((float*)(a.ws + WS_SBON))[(size_t)(t0 + et) * 16 + h] = sb; }
        __syncthreads();
        { const int j = tid & 63, rg = tid >> 6; float run = 0.f;
#pragma unroll
          for (int i = 0; i < 8; ++i) { run += FW[(8 * rg + i) * RW_FS + j]; FW[(8 * rg + i) * RW_FS + j] = run; }
          TOT[rg * 64 + j] = run;
          __syncthreads();
          float off = 0.f;
          for (int q = 0; q < rg; ++q) off += TOT[q * 64 + j];
#pragma unroll
          for (int i = 0; i < 8; ++i) FW[(8 * rg + i) * RW_FS + j] += off; }
        __syncthreads();
        { bf16x8 at, bt, kt, rt, bh, kh, vv;
#pragma unroll
          for (int e = 0; e < 8; ++e) { const int jj = 8 * cg + e; const float cum = FW[et * RW_FS + jj], cl = FW[63 * RW_FS + jj];
              const float eA = __expf(cum - lw_[e]), eN = __expf(-cum), eP = __expf(cum), eH = __expf(cl - cum);
              at[e] = (bf16)(-kk_[e] * eA); bt[e] = (bf16)(b_[e] * eN); kt[e] = (bf16)(k_[e] * eN); rt[e] = (bf16)(r_[e] * eP);
              bh[e] = (bf16)(b_[e] * eH); kh[e] = (bf16)(k_[e] * eH); vv[e] = (bf16)v_[e];
              if (et == 63) GCL[jj] = __expf(cl); }
          *(LAS bf16x8*)(RW_SLOT(lds, 0) + et * RS + 8 * cg) = at; *(LAS bf16x8*)(RW_SLOT(lds, 2) + et * RS + 8 * cg) = bt;
          *(LAS bf16x8*)(RW_SLOT(lds, 3) + et * RS + 8 * cg) = kt; *(LAS bf16x8*)(RW_SLOT(lds, 4) + et * RS + 8 * cg) = rt;
          *(LAS bf16x8*)(RW_SLOT(lds, 5) + et * RS + 8 * cg) = bh; *(LAS bf16x8*)(RW_SLOT(lds, 6) + et * RS + 8 * cg) = kh; *(LAS bf16x8*)(RW_SLOT(lds, 7) + et * RS + 8 * cg) = vv; }
        __syncthreads();
#define RW_MM(acc, XS, YS) mm_acc<2>(acc, RW_SLOT(lds, XS), RS, RW_SLOT(lds, YS), RS, w, lane)
#define RW_ST(acc, DS) st_t(acc, RW_SLOT(lds, DS), m0, n0)
        { f32x4 acc[2];
          acc_zero(acc); RW_MM(acc, 0, 16); RW_ST(acc, 1);
          acc_zero(acc); RW_MM(acc, 5, 16); RW_ST(acc, 8);
          acc_zero(acc); RW_MM(acc, 6, 16); RW_ST(acc, 9);
          acc_zero(acc); RW_MM(acc, 7, 16); RW_ST(acc, 10);
          __syncthreads();
          acc_zero(acc); RW_MM(acc, 2, 0);
#pragma unroll
          for (int tn = 0; tn < 2; ++tn)
#pragma unroll
              for (int r = 0; r < 4; ++r) if (m0 + r >= n0 + 16 * tn) acc[tn][r] = 0.f;
          RW_ST(acc, 5);
#pragma unroll
          for (int tn = 0; tn < 2; ++tn)
#pragma unroll
              for (int r = 0; r < 4; ++r) if (m0 + r == n0 + 16 * tn) acc[tn][r] = 1.f;
          RW_ST(acc, 13);
          acc_zero(acc); RW_MM(acc, 0, 2); tri_mask<false>(acc, m0, n0); RW_ST(acc, 6);
          acc_zero(acc); RW_MM(acc, 0, 3); tri_mask<false>(acc, m0, n0); RW_ST(acc, 7);
          acc_zero(acc); RW_MM(acc, 2, 4);
#pragma unroll
          for (int tn = 0; tn < 2; ++tn)
#pragma unroll
              for (int r = 0; r < 4; ++r) if (m0 + r > n0 + 16 * tn) acc[tn][r] = 0.f;
          RW_ST(acc, 11);
          acc_zero(acc); RW_MM(acc, 3, 4);
#pragma unroll
          for (int tn = 0; tn < 2; ++tn)
#pragma unroll
              for (int r = 0; r < 4; ++r) if (m0 + r > n0 + 16 * tn) acc[tn][r] = 0.f;
          RW_ST(acc, 12);
          __syncthreads();
#define RW_LDT(acc, TS) do { _Pragma("unroll") for (int tn_ = 0; tn_ < 2; ++tn_) { const bf16x4 v_ = *(const LAS bf16x4*)(RW_SLOT(lds, TS) + (n0 + 16 * tn_) * RS + m0); acc[tn_] = (f32x4){(float)v_[0], (float)v_[1], (float)v_[2], (float)v_[3]}; } } while (0)
          acc_zero(acc); RW_MM(acc, 6, 5); RW_ST(acc, 0); acc_zero(acc); RW_MM(acc, 5, 6); RW_ST(acc, 2);
          __syncthreads();
          RW_LDT(acc, 13); RW_MM(acc, 2, 13); RW_ST(acc, 3);
          acc_zero(acc); RW_MM(acc, 2, 0); RW_ST(acc, 5); acc_zero(acc); RW_MM(acc, 0, 2); RW_ST(acc, 6);
          __syncthreads();
          RW_LDT(acc, 3); RW_MM(acc, 6, 3); RW_ST(acc, 13);
          acc_zero(acc); RW_MM(acc, 6, 5); RW_ST(acc, 0); acc_zero(acc); RW_MM(acc, 5, 6); RW_ST(acc, 2);
          __syncthreads();
          RW_LDT(acc, 13); RW_MM(acc, 2, 13); RW_ST(acc, 3);
          acc_zero(acc); RW_MM(acc, 2, 0); RW_ST(acc, 5); acc_zero(acc); RW_MM(acc, 0, 2); RW_ST(acc, 6);
          __syncthreads();
          RW_LDT(acc, 3); RW_MM(acc, 6, 3); RW_ST(acc, 13);
          acc_zero(acc); RW_MM(acc, 5, 6); RW_ST(acc, 2);
          __syncthreads();
          RW_LDT(acc, 13); RW_MM(acc, 2, 13); RW_ST(acc, 3);
          __syncthreads();
          acc_zero(acc); RW_MM(acc, 3, 1); RW_ST(acc, 0);
          acc_zero(acc); RW_MM(acc, 7, 3); RW_ST(acc, 5);
          __syncthreads();
          asm volatile("" :: "v"(zc[0]), "v"(zc[1]), "v"(zc[2]), "v"(zc[3]), "v"(zc[4]), "v"(zp[0]), "v"(zp[1]), "v"(zp[2]), "v"(zp[3]), "v"(zp[4]));
          acc_zero(acc); RW_MM(acc, 5, 10); RW_ST(acc, 6);
          acc_zero(acc); RW_MM(acc, 0, 11);
#pragma unroll
          for (int tn = 0; tn < 2; ++tn) { const int tt = n0 + 16 * tn; const bf16x4 rr = *(const LAS bf16x4*)(RW_SLOT(lds, 4) + tt * RS + m0);
              const bf16x4 o = {(bf16)(acc[tn][0] + (float)rr[0]), (bf16)(acc[tn][1] + (float)rr[1]), (bf16)(acc[tn][2] + (float)rr[2]), (bf16)(acc[tn][3] + (float)rr[3])};
              *(bf16x4*)((bf16*)(ro + RO_Q) + (size_t)uo * 4096 + tt * 64 + m0) = o; }
          acc_zero(acc); RW_MM(acc, 0, 8);
#pragma unroll
          for (int tn = 0; tn < 2; ++tn) { const int jj = n0 + 16 * tn; const float gc = GCL[jj];
              const bf16x4 o = {(bf16)(acc[tn][0] + (m0 == jj ? gc : 0.f)), (bf16)(acc[tn][1] + (m0 + 1 == jj ? gc : 0.f)), (bf16)(acc[tn][2] + (m0 + 2 == jj ? gc : 0.f)), (bf16)(acc[tn][3] + (m0 + 3 == jj ? gc : 0.f))};
              *(bf16x4*)((bf16*)(ro + RO_M) + (size_t)uo * 4096 + jj * 64 + m0) = o; }
          __syncthreads();
          acc_zero(acc); RW_MM(acc, 11, 6); RW_MM(acc, 12, 10); st_acc_g(acc, (f16*)(ro + RO_Y), uo, w, lane);
          acc_zero(acc); RW_MM(acc, 6, 8); RW_MM(acc, 10, 9); st_acc_g(acc, (f16*)(ro + RO_N), uo, w, lane);
        }
#undef RW_MM
#undef RW_ST
#undef RW_LDT
    }
}
__device__ __forceinline__ void p_rwkv_scan(const Args& a, LAS unsigned char* lds, int h) {
    const int tid = opaque_tid(), lane = tid & 63, w = __builtin_amdgcn_readfirstlane(tid >> 6);
    const int m0 = 16 * (w >> 1) + 4 * (lane >> 4), n0 = 32 * (w & 1) + (lane & 15), row = tid >> 3, seg = tid & 7;
    const unsigned char* ro = (const unsigned char*)a.out;
    const bf16* Mg = (const bf16*)(ro + RO_M) + (size_t)h * 256 * 4096; const f16x4* Ng = (const f16x4*)(ro + RO_N) + (size_t)h * 256 * 1024; bf16* Sg = (bf16*)(a.ws + WS_RS) + (size_t)h * 256 * 4096;
    f32x4 acc[2]; acc_zero(acc);
    u32x4 mreg = *(const u32x4*)(Mg + row * 64 + seg * 8); f16x4 nreg[2] = {Ng[(w * 2) * 64 + lane], Ng[(w * 2 + 1) * 64 + lane]};
    for (int c = 0; c < 256; ++c) {
        LAS bf16* Sb = RW_SLOT(lds, c & 1); LAS bf16* Mb = RW_SLOT(lds, 2 + (c & 1));
        st_n(acc, Sb, m0, n0);
        *(LAS u32x4*)(Mb + row * RS + seg * 8) = mreg;
        const f16x4 nc0 = nreg[0], nc1 = nreg[1];
        if (c + 1 < 256) { mreg = *(const u32x4*)(Mg + (size_t)(c + 1) * 4096 + row * 64 + seg * 8); nreg[0] = Ng[(size_t)(c + 1) * 1024 + (w * 2) * 64 + lane]; nreg[1] = Ng[(size_t)(c + 1) * 1024 + (w * 2 + 1) * 64 + lane]; }
        __syncthreads();
        *(u32x4*)(Sg + (size_t)c * 4096 + row * 64 + seg * 8) = *(const LAS u32x4*)(Sb + row * RS + seg * 8);
        acc[0] = (f32x4){(float)nc0[0], (float)nc0[1], (float)nc0[2], (float)nc0[3]}; acc[1] = (f32x4){(float)nc1[0], (float)nc1[1], (float)nc1[2], (float)nc1[3]};
        mm_acc<2>(acc, Sb, RS, Mb, RS, w, lane);
    }
}
constexpr int RG_S = 168;
__device__ __forceinline__ void p_rwkv_out(const Args& a, LAS unsigned char* lds) {
    const int tid = opaque_tid(), lane = tid & 63, w = __builtin_amdgcn_readfirstlane(tid >> 6);
    const int m0 = 16 * (w >> 1) + 4 * (lane >> 4), n0 = 32 * (w & 1) + (lane & 15), row = tid >> 3, seg = tid & 7;
    const f16* z = (const f16*)(a.ws + WS_Z); const unsigned char* ro = (const unsigned char*)a.out; f16* mix = (f16*)(a.ws + WS_MIX);
    LAS bf16* SG = (LAS bf16*)(lds + 2 * SLOT); LAS bf16* GU = SG + 64 * RG_S; LAS float* YL = (LAS float*)(GU + 64 * RG_S); LAS float* GL = YL + 64 * RW_FS; LAS float* PRM = GL + 64 * RW_FS;
    const int h = blockIdx.x & 15, cstep = gridDim.x >> 4, et = row, cg = seg, ch0 = h * 64 + 8 * cg;
    __syncthreads();
    for (int ck = tid; ck < 64 * 20; ck += 512) { const int rr = ck / 20, c8 = ck % 20; *(LAS u32x4*)(GU + rr * RG_S + 8 * c8) = *(const u32x4*)((const bf16*)(a.ws + WS_GUPT) + (size_t)(h * 64 + rr) * 160 + 8 * c8); }
    if (tid < 160) PRM[tid] = a.in[I_MU][3200 + tid];
    if (tid < 64) { PRM[160 + tid] = a.in[I_MU][2048 + h * 64 + tid]; PRM[224 + tid] = a.in[I_LNXG][h * 64 + tid]; PRM[288 + tid] = a.in[I_LNXB][h * 64 + tid]; }
    const f16x8 zero8 = {0, 0, 0, 0, 0, 0, 0, 0};
    u32x4 qreg, sreg; f16x4 yreg[2]; f16x8 gc[3], gp[3], vc, vp; float sbn;
#define RO_LOAD(cc) do { const int uo_ = h * 256 + (cc), t0_ = (cc) * 64; \
        qreg = *(const u32x4*)((const bf16*)(ro + RO_Q) + (size_t)uo_ * 4096 + row * 64 + seg * 8); sreg = *(const u32x4*)((const bf16*)(a.ws + WS_RS) + (size_t)uo_ * 4096 + row * 64 + seg * 8); \
        { const f16x4* Yg_ = (const f16x4*)(ro + RO_Y) + (size_t)uo_ * 1024; yreg[0] = Yg_[(w * 2) * 64 + lane]; yreg[1] = Yg_[(w * 2 + 1) * 64 + lane]; } \
        _Pragma("unroll") for (int i_ = 0; i_ < 3; ++i_) { const int ck_ = tid + 512 * i_; if (ck_ < 64 * 20) { const int t_ = t0_ + ck_ / 20; const f16* cur_ = z + (size_t)t_ * NZ + ZGD + 8 * (ck_ % 20); gc[i_] = *(const f16x8*)cur_; gp[i_] = t_ > 0 ? *(const f16x8*)(cur_ - NZ) : zero8; } } \
        { const int t_ = t0_ + et; const f16* cur_ = z + (size_t)t_ * NZ + ZV + ch0; vc = *(const f16x8*)cur_; vp = t_ > 0 ? *(const f16x8*)(cur_ - NZ) : zero8; sbn = ((const float*)(a.ws + WS_SBON))[(size_t)t_ * 16 + h]; } } while (0)
    RO_LOAD(blockIdx.x >> 4);
    asm volatile("" :: "v"(qreg), "v"(sreg), "v"(yreg[0]), "v"(yreg[1]), "v"(gc[0]), "v"(gp[0]), "v"(gc[1]), "v"(gp[1]), "v"(gc[2]), "v"(gp[2]), "v"(vc), "v"(vp), "v"(sbn));
    for (int c = blockIdx.x >> 4; c < 256; c += cstep) {
        const int t0 = c * 64;
        __syncthreads();
        *(LAS u32x4*)(RW_SLOT(lds, 0) + row * RS + seg * 8) = qreg; *(LAS u32x4*)(RW_SLOT(lds, 1) + row * RS + seg * 8) = sreg;
#pragma unroll
        for (int i = 0; i < 3; ++i) { const int ck = tid + 512 * i; if (ck < 64 * 20) { const int rr = ck / 20, c8 = ck % 20; bf16x8 o;
#pragma unroll
            for (int e = 0; e < 8; ++e) o[e] = (bf16)sigmoidf_((float)gc[i][e] + ((float)gp[i][e] - (float)gc[i][e]) * PRM[8 * c8 + e]);
            *(LAS bf16x8*)(SG + rr * RG_S + 8 * c8) = o; } }
        f32x4 y[2], g[2];
        y[0] = (f32x4){(float)yreg[0][0], (float)yreg[0][1], (float)yreg[0][2], (float)yreg[0][3]}; y[1] = (f32x4){(float)yreg[1][0], (float)yreg[1][1], (float)yreg[1][2], (float)yreg[1][3]};
        const f16x8 vcc = vc, vpp = vp; const float sbc = sbn;
        if (c + cstep < 256) RO_LOAD(c + cstep);
        __syncthreads();
        mm_acc<2>(y, RW_SLOT(lds, 0), RS, RW_SLOT(lds, 1), RS, w, lane);
        acc_zero(g); mm_acc<5>(g, SG, RG_S, GU, RG_S, w, lane);
#pragma unroll
        for (int tn = 0; tn < 2; ++tn)
#pragma unroll
            for (int r = 0; r < 4; ++r) { YL[(m0 + r) * RW_FS + n0 + 16 * tn] = y[tn][r]; GL[(m0 + r) * RW_FS + n0 + 16 * tn] = g[tn][r]; }
        __syncthreads();
        { const int t = t0 + et;
          float yv[8], gv[8]; float s1 = 0.f, s2 = 0.f;
#pragma unroll
          for (int e = 0; e < 8; ++e) { yv[e] = YL[et * RW_FS + 8 * cg + e]; gv[e] = GL[et * RW_FS + 8 * cg + e]; s1 += yv[e]; s2 += yv[e] * yv[e]; }
          s1 += __shfl_xor(s1, 1); s1 += __shfl_xor(s1, 2); s1 += __shfl_xor(s1, 4);
          s2 += __shfl_xor(s2, 1); s2 += __shfl_xor(s2, 2); s2 += __shfl_xor(s2, 4);
          const float mean = s1 * (1.f / 64.f), var = fmaxf(s2 * (1.f / 64.f) - mean * mean, 0.f), rstd = rsqrtf(var + 64e-5f);
          f16x8 o;
#pragma unroll
          for (int e = 0; e < 8; ++e) { const int jj = 8 * cg + e; const float vv = (float)vcc[e] + ((float)vpp[e] - (float)vcc[e]) * PRM[160 + jj];
              const float yn = (yv[e] - mean) * rstd * PRM[224 + jj] + PRM[288 + jj]; o[e] = (f16)((yn + sbc * vv) * gv[e]); }
          asm volatile("" :: "v"(qreg), "v"(sreg), "v"(yreg[0]), "v"(yreg[1]), "v"(gc[0]), "v"(gp[0]), "v"(gc[1]), "v"(gp[1]), "v"(gc[2]), "v"(gp[2]), "v"(vc), "v"(vp), "v"(sbn));
          *(f16x8*)(mix + (size_t)t * D + 1024 + ch0) = o; }
    }
}

constexpr int RT_XS = 2048 + 8;
__device__ __forceinline__ void p_router(const Args& a, LAS unsigned char* lds, int rep) {
    const int tid = opaque_tid(), lane = tid & 63, wave = __builtin_amdgcn_readfirstlane(tid >> 6);
    const float* x2 = (const float*)(a.ws + WS_X1); const float* rowss2 = (const float*)(a.ws + WS_CTL + WS_ROWSS2);
    unsigned* ctl = (unsigned*)(a.ws + WS_CTL);
    int* tke = (int*)(a.ws + WS_TOK + TK_E); float* tkw = (float*)(a.ws + WS_TOK + TK_W);
    const f16* WH = (const f16*)(a.ws + WS_WRH); const f16* WL = (const f16*)(a.ws + WS_WRL);
    LAS float* PART = (LAS float*)lds;
    LAS float* LG = PART + 8 * 16 * 48;
    LAS float* BIAS = LG + 16 * 48;
    LAS int* ECNT = (LAS int*)(BIAS + 64);
    __syncthreads();
    if (tid < 4) BIAS[tid] = a.in[I_RGB][tid]; else if (tid < 36) BIAS[tid] = a.in[I_REB][tid - 4];
    if (tid >= 64 && tid < 96) ECNT[tid - 64] = 0;
    const int row = lane & 15, kq = lane >> 4;
    f32x4 xa[8], xb[8]; f16x8 bh[4][3], bl[4][3];
#define RT_LOADX(tl) do { const float* xp_ = x2 + (size_t)((tl) * 16 + row) * D + 256 * wave + 8 * kq; \
        _Pragma("unroll") for (int ks_ = 0; ks_ < 8; ++ks_) { xa[ks_] = *(const f32x4*)(xp_ + 32 * ks_); xb[ks_] = *(const f32x4*)(xp_ + 32 * ks_ + 4); } } while (0)
#define RT_LOADW(kb) do { unsigned lo_ = (unsigned)lane; asm volatile("" : "+v"(lo_)); const unsigned wo_ = (lo_ & 15u) * D + 256 * wave + 8 * (lo_ >> 4) + 128 * (kb); const f16* whp_ = WH + wo_; const f16* wlp_ = WL + wo_; \
        _Pragma("unroll") for (int k4_ = 0; k4_ < 4; ++k4_) _Pragma("unroll") for (int nt_ = 0; nt_ < 3; ++nt_) { bh[k4_][nt_] = *(const f16x8*)(whp_ + (size_t)nt_ * 16 * D + 32 * k4_); bl[k4_][nt_] = *(const f16x8*)(wlp_ + (size_t)nt_ * 16 * D + 32 * k4_); } } while (0)
    if ((int)blockIdx.x < T / 16) { RT_LOADX(blockIdx.x); RT_LOADW(0); }
    for (int tile = blockIdx.x; tile < T / 16; tile += gridDim.x) {
        const int r0 = tile * 16;
        f32x4 acc[3]; acc[0] = (f32x4){0.f, 0.f, 0.f, 0.f}; acc[1] = acc[0]; acc[2] = acc[0];
#pragma unroll
        for (int kb = 0; kb < 2; ++kb) {
            if (kb == 1) RT_LOADW(1);
            asm volatile("s_waitcnt vmcnt(0)" ::: "memory");
#pragma unroll
            for (int k4 = 0; k4 < 4; ++k4) { const f32x4 va = xa[kb * 4 + k4], vb = xb[kb * 4 + k4];
                f16x8 hi, lo;
#pragma unroll
                for (int j = 0; j < 4; ++j) { hi[j] = (f16)va[j]; lo[j] = (f16)(va[j] - (float)hi[j]); hi[4 + j] = (f16)vb[j]; lo[4 + j] = (f16)(vb[j] - (float)hi[4 + j]); }
#pragma unroll
                for (int nt = 0; nt < 3; ++nt) {
                    acc[nt] = __builtin_amdgcn_mfma_f32_16x16x32_f16(hi, bh[k4][nt], acc[nt], 0, 0, 0); acc[nt] = __builtin_amdgcn_mfma_f32_16x16x32_f16(lo, bh[k4][nt], acc[nt], 0, 0, 0); acc[nt] = __builtin_amdgcn_mfma_f32_16x16x32_f16(hi, bl[k4][nt], acc[nt], 0, 0, 0); }
            }
        }
        if (tile + (int)gridDim.x < T / 16) { RT_LOADX(tile + gridDim.x); RT_LOADW(0); }
#pragma unroll
        for (int nt = 0; nt < 3; ++nt)
#pragma unroll
            for (int r = 0; r < 4; ++r) PART[(wave * 16 + 4 * kq + r) * 48 + 16 * nt + row] = acc[nt][r];
        __syncthreads();
        for (int i = tid; i < 16 * 48; i += 512) { float v = 0.f;
#pragma unroll
            for (int ww = 0; ww < 8; ++ww) v += PART[ww * 768 + i];
            LG[i] = v; }
        __syncthreads();
        if (tid < 16) {
            const float rs = rsqrtf(rowss2[r0 + tid] * (1.f / D) + EPS); const LAS float* L = LG + tid * 48;
            float lg[4];
#pragma unroll
            for (int c = 0; c < 4; ++c) lg[c] = L[c] * rs + BIAS[c];
            int gi = 0; float gm = lg[0];
#pragma unroll
            for (int c = 1; c < 4; ++c) if (lg[c] > gm) { gm = lg[c]; gi = c; }
            float gs = 0.f;
#pragma unroll
            for (int c = 0; c < 4; ++c) gs += __expf(lg[c] - gm);
            const float pg = 1.f / gs;
            float le[8];
#pragma unroll
            for (int c = 0; c < 8; ++c) le[c] = L[4 + gi * 8 + c] * rs + BIAS[4 + gi * 8 + c];
            int e1 = 0; float m1 = le[0];
#pragma unroll
            for (int c = 1; c < 8; ++c) if (le[c] > m1) { m1 = le[c]; e1 = c; }
            int e2 = -1; float m2 = -INFINITY;
#pragma unroll
            for (int c = 0; c < 8; ++c) if (c != e1 && le[c] > m2) { m2 = le[c]; e2 = c; }
            const float p2 = __expf(m2 - m1);
            const float w1 = pg / (1.f + p2), w2 = pg * p2 / (1.f + p2);
            const int m = r0 + tid, E1 = gi * 8 + e1, E2 = gi * 8 + e2; tke[m * 2] = E1; tke[m * 2 + 1] = E2; tkw[m * 2] = w1; tkw[m * 2 + 1] = w2;
            __hip_atomic_fetch_add((int*)(ECNT + E1), 1, __ATOMIC_RELAXED, __HIP_MEMORY_SCOPE_WORKGROUP); __hip_atomic_fetch_add((int*)(ECNT + E2), 1, __ATOMIC_RELAXED, __HIP_MEMORY_SCOPE_WORKGROUP);
        }
        __syncthreads();
    }
    if (tid < NEXP) { const int c = ECNT[tid]; if (c) atomicAdd(&ctl[CW_CNT + rep * 8000 + tid], (unsigned)c); }
#undef RT_LOADX
#undef RT_LOADW
}
__device__ __forceinline__ void p_slots(const Args& a, LAS unsigned char* lds, int rep) {
    unsigned* ctl = (unsigned*)(a.ws + WS_CTL);
    const int* tke = (const int*)(a.ws + WS_TOK + TK_E); const float* tkw = (const float*)(a.ws + WS_TOK + TK_W); int* tks = (int*)(a.ws + WS_TOK + TK_SLOT);
    int* stok = (int*)(a.ws + WS_TOK + TK_STOK); float* sw = (float*)(a.ws + WS_TOK + TK_SW); float* srs = (float*)(a.ws + WS_TOK + TK_SRS);
    const float* rowss2 = (const float*)(a.ws + WS_CTL + WS_ROWSS2);
    const int tid = opaque_tid(), lane = tid & 63;
    LAS int* offl = (LAS int*)lds; LAS int* cntl = offl + 64;
    __syncthreads();
    if (tid < 64) {
        const int n = lane < NEXP ? (int)ctl[CW_CNT + lane] : 0, nt = (n + 255) >> 8;
        int pre = nt;
#pragma unroll
        for (int o = 1; o < 32; o <<= 1) { const int v = __shfl_up(pre, o); if ((lane & 31) >= o) pre += v; }
        const int tb = pre - nt;
        if (lane < NEXP) { offl[lane] = tb * 256; cntl[lane] = n; }
        if (lane == NEXP - 1) offl[NEXP] = pre * 256;
        if (blockIdx.x == 0 && lane < NEXP) {
            int2* ugu = (int2*)(ctl + CW_UGU); int2* udn = (int2*)(ctl + CW_UDN);
            for (int rt = 0; rt < nt; ++rt) { const int pm = tb + rt;
#pragma unroll
                for (int jt = 0; jt < 2; ++jt) ugu[pm * 2 + jt] = make_int2(pm, lane * 2 + jt);
#pragma unroll
                for (int jt = 0; jt < 8; ++jt) udn[pm * 8 + jt] = make_int2(pm, lane * 8 + jt); }
            if (lane == NEXP - 1) { ctl[CW_NT] = (unsigned)pre; ctl[CW_NGU] = (unsigned)(pre * 2); ctl[CW_NDN] = (unsigned)(pre * 8); }
        }
    }
    __syncthreads();
    if (blockIdx.x == 0 && rep == 0) {
        for (int e = 0; e < NEXP; ++e) { const int end = offl[e + 1];
            for (int sl = offl[e] + cntl[e] + tid; sl < end; sl += 512) { stok[sl] = 0; sw[sl] = 0.f; srs[sl] = 0.f; } } }
    LAS int* hist = cntl + 64; LAS int* gbase = hist + 64;
    for (int base = blockIdx.x * 512; base < T * 2; base += gridDim.x * 512) {
        __syncthreads();
        if (tid < 64) hist[tid] = 0;
        __syncthreads();
        const int i = base + tid; const bool ok = i < T * 2; const int e = ok ? tke[i] : 0;
        int rank = 0; if (ok) rank = __hip_atomic_fetch_add((int*)(hist + e), 1, __ATOMIC_RELAXED, __HIP_MEMORY_SCOPE_WORKGROUP);
        __syncthreads();
        if (tid < NEXP) { const int c = hist[tid]; gbase[tid] = c ? (int)atomicAdd(&ctl[CW_CUR + rep * 8000 + tid], (unsigned)c) : 0; }
        __syncthreads();
        const float rsi = ok ? rsqrtf(rowss2[i >> 1] * (1.f / D) + EPS) : 0.f;
        if (ok) { const int slot = offl[e] + gbase[e] + rank; stok[slot] = i >> 1; sw[slot] = tkw[i]; srs[slot] = rsi; tks[i] = slot; }
    }
}


constexpr int NPH = 17;
__global__ void __launch_bounds__(512, 2) mega(Args args) {
    extern __shared__ __attribute__((aligned(16))) unsigned char lds_raw[];
    LAS unsigned char* lds = (LAS unsigned char*)lds_raw;
    volatile LAS unsigned* MISC = (volatile LAS unsigned*)(lds + MISC_OFF);
    const int G = gridDim.x;
#define PH_IDS const int tid = opaque_tid(), lane = tid & 63, wave = tid >> 6, gw = blockIdx.x * 8 + wave, NGW = gridDim.x * 8; (void)tid; (void)lane; (void)gw; (void)NGW
    unsigned char* ws = args.ws;
    unsigned* ctl = (unsigned*)(ws + WS_CTL);
    if (threadIdx.x < 128) ((LAS unsigned*)(lds + MISC_OFF))[threadIdx.x] = 0u;
    __syncthreads();
    XcdBarrier bar; bar.bar = ctl + CW_BAR; bar.x = 0; bar.st = nullptr;
    const int lo = args.ph_lo, hi = args.ph_hi;
    if (hi - lo > 1 || DUPMASK != 0u) bar = xcd_barrier_post(ctl + CW_BAR, MISC + 8);
#ifndef PHMASK
#define PHMASK 0xFFFFFFFFu
#endif
#define IN(k) (((PHMASK >> (k)) & 1u) && lo <= (k) && (k) < hi)
#define BOTH(k) (IN(k) && IN((k) + 1))
#define GRID_BAR() xcd_barrier(bar)
#define NREP(k) ((((DUPMASK) >> (k)) & 1u) ? 2 : 1)

    for (int rep_ = 0; rep_ < NREP(0); ++rep_) if (IN(0)) { p0_prologue(args, lds); if (BOTH(0) || rep_ + 1 < NREP(0)) GRID_BAR(); }
    for (int rep_ = 0; rep_ < NREP(1); ++rep_) if (IN(1)) {
        { pg8::Gemm g{(const f16*)(ws + WS_H), (const f16*)(ws + WS_WIN), D, D, D, nullptr}; pg8::StaticOrder S; S.init(T, NZ, G, (int)blockIdx.x);
          pg8::EpiF16 E{(f16*)(ws + WS_Z), NZ, 1.f}; pg8::gemm_phase<pg8::EpiF16, pg8::StaticOrder, true>(lds, g, S, E); }
        if (BOTH(1) || rep_ + 1 < NREP(1)) GRID_BAR();
    }
    for (int rep_ = 0; rep_ < NREP(2); ++rep_) if (IN(2)) {
        for (int r2_ = 0; r2_ < ((DUPX & 1) ? 2 : 1); ++r2_) { p_compress(args, lds); __syncthreads(); }
        for (int r2_ = 0; r2_ < ((DUPX & 2) ? 2 : 1); ++r2_) { p_rwkv_local(args, lds); __syncthreads(); }
        if (BOTH(2) || rep_ + 1 < NREP(2)) GRID_BAR();
    }
    for (int rep_ = 0; rep_ < NREP(3); ++rep_) if (IN(3)) {
        if (blockIdx.x < 16) p_rwkv_scan(args, lds, blockIdx.x);
        else if (blockIdx.x < 32 && rep_ == 0) { const int b = blockIdx.x - 16; const int which = b / 8;
            pg8::Gemm g{(const f16*)(ws + WS_MEMN), (const f16*)(ws + (which == 0 ? WS_WKT : WS_WVT)), D, D, D, nullptr}; pg8::StaticOrder S; S.init(256, D, 8, b % 8);
            pg8::EpiF16 E{(f16*)(ws + (which == 0 ? WS_KM : WS_VM)), D, 1.f}; pg8::gemm_phase<pg8::EpiF16, pg8::StaticOrder, true>(lds, g, S, E); }
        __syncthreads();
        p_nsa(args, lds, rep_);
        if (BOTH(3) || rep_ + 1 < NREP(3)) GRID_BAR();
    }
    for (int rep_ = 0; rep_ < NREP(5); ++rep_) if (IN(5)) {
        p_rwkv_out(args, lds);
        __syncthreads();
        PH_IDS;
        if (blockIdx.x < 64) { const int b = blockIdx.x; const int grp = b / 8, c = b % 8;
          if (grp < 4) { const int h = grp;
              pg8::Gemm g{(const f16*)(ws + WS_KM) + h * 512, (const f16*)(ws + WS_WQ16) + h * 512, D, D, 512, nullptr}; pg8::StaticOrder S; S.init(256, D, 8, c);
              pg8::EpiF16 E{(f16*)(ws + WS_WQK) + (size_t)h * 256 * D, D, 0.04419417382415922f}; pg8::gemm_phase<pg8::EpiF16, pg8::StaticOrder, true>(lds, g, S, E); }
          else { const int h = grp - 4;
              pg8::Gemm g{(const f16*)(ws + WS_WOT) + h * 512, (const f16*)(ws + WS_VM) + h * 512, D, D, 512, nullptr}; pg8::StaticOrder S; S.init(D, 256, 8, c);
              pg8::EpiF16 E{(f16*)(ws + WS_VOT) + h * 256, 1024, 1.f}; pg8::gemm_phase<pg8::EpiF16, pg8::StaticOrder, true>(lds, g, S, E); } }
        else {
        const float* onsa = (const float*)(ws + WS_ONSA); f16* mix = (f16*)(ws + WS_MIX);
        for (int m = gw - 64 * 8; m < T; m += NGW - 64 * 8) { const f32x4* xr = (const f32x4*)(onsa + (size_t)m * 1024) + lane; f32x4 v[4]; float s = 0.f;
#pragma unroll
            for (int j = 0; j < 4; ++j) { v[j] = xr[64 * j]; s += v[j].x * v[j].x + v[j].y * v[j].y + v[j].z * v[j].z + v[j].w * v[j].w; }
            const f32x4* gr = (const f32x4*)args.in[I_NSAG] + lane; f32x4 gg[4];
#pragma unroll
            for (int j = 0; j < 4; ++j) gg[j] = gr[64 * j];
            const float rstd = rsqrtf(wave_sum(s) * (1.f / 1024.f) + EPS); u32x2* o8 = (u32x2*)(mix + (size_t)m * D) + lane;
#pragma unroll
            for (int j = 0; j < 4; ++j) { u32x2 w; w.x = pkh(v[j].x * rstd * gg[j].x, v[j].y * rstd * gg[j].y); w.y = pkh(v[j].z * rstd * gg[j].z, v[j].w * rstd * gg[j].w); o8[64 * j] = w; } }
        }
        if (BOTH(5) || rep_ + 1 < NREP(5)) GRID_BAR();
    }
    for (int rep_ = 0; rep_ < NREP(6); ++rep_) if (IN(6)) {
        pg8::Gemm g{(const f16*)(ws + WS_MIX), (const f16*)(ws + WS_WOUT), D, D, D, nullptr}; pg8::StaticOrder S; S.init(T, D, G, (int)blockIdx.x);
        pg8::EpiRes16 E{(float*)(ws + WS_X1), args.in[I_X], (f16*)(ws + WS_H2), (float*)(ws + WS_CTL + WS_ROWSS), D}; pg8::gemm_phase<pg8::EpiRes16, pg8::StaticOrder, true>(lds, g, S, E);
        if (BOTH(6) || rep_ + 1 < NREP(6)) GRID_BAR();
    }
    for (int rep_ = 0; rep_ < NREP(7); ++rep_) if (IN(7)) {
        PH_IDS;
        p_moe_weights(args, lds);
        if (BOTH(7) || rep_ + 1 < NREP(7)) GRID_BAR();
    }
    for (int rep_ = 0; rep_ < NREP(8); ++rep_) if (IN(8)) {
        pg8::Gemm g{(const f16*)(ws + WS_H2), (const f16*)(ws + WS_WQK), D, D, D, nullptr}; pg8::StaticOrder S; S.init(T, 1024, G, (int)blockIdx.x);
        pg8::EpiSoftmax E{(f16*)(ws + WS_P), 1024, (const float*)(ws + WS_CTL + WS_ROWSS), (LAS float*)(lds + RING_BYTES), (LAS float*)(lds + RING_BYTES + 4096)}; pg8::gemm_phase<pg8::EpiSoftmax, pg8::StaticOrder, true>(lds, g, S, E);
        if (BOTH(8) || rep_ + 1 < NREP(8)) GRID_BAR();
    }
    for (int rep_ = 0; rep_ < NREP(10); ++rep_) if (IN(10)) {
        pg8::Gemm g{(const f16*)(ws + WS_P), (const f16*)(ws + WS_VOT), 1024, 1024, 1024, nullptr}; pg8::StaticOrder S; S.init(T, D, G, (int)blockIdx.x);
        pg8::EpiRes16 E{(float*)(ws + WS_X1), (const float*)(ws + WS_X1), (f16*)args.out, (float*)(ws + WS_CTL + WS_ROWSS2), D}; pg8::gemm_phase<pg8::EpiRes16, pg8::StaticOrder, true>(lds, g, S, E);
        if (BOTH(10) || rep_ + 1 < NREP(10)) GRID_BAR();
    }
    for (int rep_ = 0; rep_ < NREP(11); ++rep_) if (IN(11)) { p_router(args, lds, rep_); if (BOTH(11) || rep_ + 1 < NREP(11)) GRID_BAR(); }
    for (int rep_ = 0; rep_ < NREP(13); ++rep_) if (IN(13)) { p_slots(args, lds, rep_); if (BOTH(13) || rep_ + 1 < NREP(13)) GRID_BAR(); }
    for (int rep_ = 0; rep_ < NREP(14); ++rep_) if (IN(14)) {
        pg8::Gemm g{(const f16*)args.out, (const f16*)(ws + WS_WGU), D, D, D, (const int*)(ws + WS_TOK + TK_STOK)};
        pg8::TableOrder S{(const int2*)(ctl + CW_UGU), (int)ctl[CW_NGU], G, (int)blockIdx.x};
        pg8::EpiSilu E{(f16*)(ws + WS_HID), (const float*)(ws + WS_TOK + TK_SRS)}; pg8::gemm_phase<pg8::EpiSilu, pg8::TableOrder, true, true>(lds, g, S, E);
        if (BOTH(14) || rep_ + 1 < NREP(14)) GRID_BAR();
    }
    for (int rep_ = 0; rep_ < NREP(15); ++rep_) if (IN(15)) {
        pg8::Gemm g{(const f16*)(ws + WS_HID), (const f16*)(ws + WS_WD), EFF, EFF, EFF, nullptr};
        pg8::TableOrder S{(const int2*)(ctl + CW_UDN), (int)ctl[CW_NDN], G, (int)blockIdx.x};
        pg8::EpiDown E{ws}; pg8::gemm_phase<pg8::EpiDown, pg8::TableOrder, true>(lds, g, S, E);
        if (BOTH(15) || rep_ + 1 < NREP(15)) GRID_BAR();
    }
    for (int rep_ = 0; rep_ < NREP(16); ++rep_) if (IN(16)) {
        PH_IDS;
        const float* x2 = (const float*)(ws + WS_X1); const int* tks = (const int*)(ws + WS_TOK + TK_SLOT);
        const float* tkw = (const float*)(ws + WS_TOK + TK_W);
        for (int m0_ = gw; m0_ < T; m0_ += 2 * NGW) {
            const int mm[2] = {m0_, (m0_ + NGW < T) ? m0_ + NGW : m0_};
            int sa[2][2]; float wa[2][2];
#pragma unroll
            for (int q = 0; q < 2; ++q) { sa[q][0] = tks[mm[q] * 2]; sa[q][1] = tks[mm[q] * 2 + 1]; wa[q][0] = tkw[mm[q] * 2]; wa[q][1] = tkw[mm[q] * 2 + 1]; }
            f32x4 v[2][8]; f16x4 ya[2][2][8];
#pragma unroll
            for (int q = 0; q < 2; ++q) { const f32x4* xr = (const f32x4*)(x2 + (size_t)mm[q] * D) + lane;
#pragma unroll
                for (int j = 0; j < 8; ++j) v[q][j] = xr[64 * j];
#pragma unroll
                for (int k = 0; k < 2; ++k) { const int sl = sa[q][k]; const f16* yp = (const f16*)(ws + ((sl >> 8) < 128 ? WS_Y0 + (size_t)(sl >> 8) * MiB : WS_Y1 + (size_t)((sl >> 8) - 128) * MiB)) + (size_t)(sl & 255) * D;
#pragma unroll
                    for (int j = 0; j < 8; ++j) ya[q][k][j] = *((const f16x4*)yp + lane + 64 * j); } }
            const f32x4* gr = (const f32x4*)args.in[I_LNF] + lane; f32x4 gg[8];
#pragma unroll
            for (int j = 0; j < 8; ++j) gg[j] = gr[64 * j];
#pragma unroll
            for (int q = 0; q < 2; ++q) { float s = 0.f; const float w1 = wa[q][0], w2 = wa[q][1];
#pragma unroll
                for (int j = 0; j < 8; ++j) { const f16x4 a1 = ya[q][0][j], a2 = ya[q][1][j];
                    v[q][j].x += w1 * (float)a1.x + w2 * (float)a2.x; v[q][j].y += w1 * (float)a1.y + w2 * (float)a2.y; v[q][j].z += w1 * (float)a1.z + w2 * (float)a2.z; v[q][j].w += w1 * (float)a1.w + w2 * (float)a2.w;
                    s += v[q][j].x * v[q][j].x + v[q][j].y * v[q][j].y + v[q][j].z * v[q][j].z + v[q][j].w * v[q][j].w; }
                const float rstd = rsqrtf(wave_sum(s) * (1.f / D) + EPS);
                if (q == 0 || mm[1] != mm[0]) { f32x4* o = (f32x4*)(args.out + (size_t)mm[q] * D) + lane;
#pragma unroll
                    for (int j = 0; j < 8; ++j) o[64 * j] = (f32x4){v[q][j].x * rstd * gg[j].x, v[q][j].y * rstd * gg[j].y, v[q][j].z * rstd * gg[j].z, v[q][j].w * rstd * gg[j].w}; } }
        }
    }
#undef IN
#undef BOTH
#undef GRID_BAR
}

extern "C" void kernel_launch(void* const* d_in, const int* in_sizes, int n_in, void* d_out, int out_size, void* d_ws, size_t ws_size, hipStream_t stream) {
    static int grid = 0;
    if (grid == 0) {
        if (n_in != 38 || out_size != T * D || ws_size < WS_END) { fprintf(stderr, "kernel_launch: unexpected shapes (n_in %d out %d ws %zu)\n", n_in, out_size, ws_size); grid = -1; return; }
        int dev = 0, cus = 0;
        if (hipGetDevice(&dev) != hipSuccess || hipDeviceGetAttribute(&cus, hipDeviceAttributeMultiprocessorCount, dev) != hipSuccess) { grid = -1; return; }
        if (hipFuncSetAttribute((const void*)mega, hipFuncAttributeMaxDynamicSharedMemorySize, LDS_BYTES) != hipSuccess) { grid = -1; return; }
        int per_cu = 0; (void)hipOccupancyMaxActiveBlocksPerMultiprocessor(&per_cu, (const void*)mega, 512, LDS_BYTES); (void)hipGetLastError();
        grid = cus;
    }
    if (grid < 0) return;
    (void)hipMemsetAsync((char*)d_ws + WS_CTL, 0, CTL_ZERO_BYTES, stream);
    Args a{};
    for (int i = 0; i < 38; ++i) a.in[i] = (const float*)d_in[i];
    a.out = (float*)d_out; a.ws = (unsigned char*)d_ws;
#if MK_ONE_LAUNCH
    a.ph_lo = 0; a.ph_hi = NPH;
    hipLaunchKernelGGL(mega, dim3(grid), dim3(512), LDS_BYTES, stream, a);
#else
    for (int p = 0; p < NPH; ++p) { a.ph_lo = p; a.ph_hi = p + 1; hipLaunchKernelGGL(mega, dim3(grid), dim3(512), LDS_BYTES, stream, a); }
#endif
}
```
